# Optimizing an MI355X kernel written in HIP

```python
import jax
import jax.numpy as jnp
from jax import lax
import numpy as np

D_MODEL = 1024
BATCH = 16
SEQ = 4096
DEPTH = 4

POOL_WINDOWS = (2, 4, 8, 16)
POOL_GROUP = D_MODEL // 8
D_POOL = POOL_GROUP * len(POOL_WINDOWS)
D_REC = D_MODEL // 2
N_REC_HEADS = 8
REC_HEAD = D_REC // N_REC_HEADS
CONV_WIDTH = 4
LRU_C = 8.0
D_IN_AB = D_POOL + 2 * D_REC
D_MIX_AB = D_POOL + D_REC
CHUNK = 128
D_SGU = D_MODEL
N_SGU_HEADS = 8
SGU_HEAD = D_SGU // N_SGU_HEADS
N_EXPERTS = 32
TOP_K = 4
D_FF = D_MODEL
SWIGLU_LIMIT = 7.0
SWIGLU_ALPHA = 1.702
EXPERT_BLOCK = 512
LN_EPS = 1e-5
DEEPNORM_ALPHA = (2 * DEPTH) ** 0.25
DEEPNORM_BETA = (8 * DEPTH) ** -0.25
N_EVEN = (DEPTH + 1) // 2
N_ODD = DEPTH // 2

kernel_name = "hybrid_pool_rglru_sgu_moe_trunk"


def _layer_norm(x, g, b):
    xf = x.astype(jnp.float32)
    mu = jnp.mean(xf, axis=-1, keepdims=True)
    var = jnp.mean(jnp.square(xf - mu), axis=-1, keepdims=True)
    return ((xf - mu) * lax.rsqrt(var + LN_EPS) * g + b).astype(x.dtype)


def _modulation(c_act, w_mod, b_mod):
    m = c_act @ w_mod + b_mod
    shift, scale, gate = jnp.split(m, 3, axis=-1)
    return shift[:, None], scale[:, None], 1.0 + gate[:, None]


def _pool_mixer(xp, pool_w, pool_scale):
    B_, S_, _ = xp.shape
    xf = xp.astype(jnp.float32)
    cs = jnp.pad(jnp.cumsum(xf, axis=1), ((0, 0), (1, 0), (0, 0)))
    t = jnp.arange(S_)
    outs = []
    for g, w in enumerate(POOL_WINDOWS):
        lo, hi = g * POOL_GROUP, (g + 1) * POOL_GROUP
        start = jnp.maximum(t + 1 - w, 0)
        window_sum = cs[:, 1:, lo:hi] - cs[:, start, lo:hi]
        count = jnp.minimum(t + 1, w).astype(jnp.float32)
        outs.append(window_sum / count[None, :, None] - xf[..., lo:hi])
    pooled = jnp.stack(outs, axis=2).astype(xp.dtype)
    mixed = jnp.einsum('bsgc,gcd->bsgd', pooled, pool_w)
    return mixed.reshape(B_, S_, D_POOL) * pool_scale


def _combine_linear(p, q):
    a1, b1 = p
    a2, b2 = q
    return a1 * a2, a2 * b1 + b2


def _rg_lru(xr, gr, conv_w, conv_b, w_a, b_a, w_x, b_x, lam):
    B_, S_, _ = xr.shape
    xpad = jnp.pad(xr, ((0, 0), (CONV_WIDTH - 1, 0), (0, 0)))
    xc = conv_b
    for k in range(CONV_WIDTH):
        xc = xc + xpad[:, k:k + S_] * conv_w[k]
    xh = xc.reshape(B_, S_, N_REC_HEADS, REC_HEAD)
    r = jax.nn.sigmoid(jnp.einsum('bshi,hij->bshj', xh, w_a).reshape(B_, S_, D_REC) + b_a)
    i = jax.nn.sigmoid(jnp.einsum('bshi,hij->bshj', xh, w_x).reshape(B_, S_, D_REC) + b_x)
    log_a = -LRU_C * r.astype(jnp.float32) * jax.nn.softplus(-lam.astype(jnp.float32))
    a = jnp.exp(log_a)
    mult = jnp.sqrt(-jnp.expm1(2.0 * log_a))
    b_in = mult * (i * xc).astype(jnp.float32)
    _, h = lax.associative_scan(_combine_linear, (a, b_in), axis=1)
    return h.astype(xr.dtype) * jax.nn.gelu(gr)


def _mixer_pool_lru(h, w_in, pool_w, pool_scale, conv_w, conv_b, w_a, b_a, w_x, b_x, lam,
                    w_out, b_out):
    z = h @ w_in
    xp = z[..., :D_POOL]
    xr = z[..., D_POOL:D_POOL + D_REC]
    gr = z[..., D_POOL + D_REC:]
    y_pool = _pool_mixer(xp, pool_w, pool_scale)
    y_rec = _rg_lru(xr, gr, conv_w, conv_b, w_a, b_a, w_x, b_x, lam)
    return jnp.concatenate([y_pool, y_rec], axis=-1) @ w_out + b_out


def _mixer_sgu(h, w_in, b_in, ln_g, ln_b, w_s, b_s, w_out, b_out):
    B_, S_, _ = h.shape
    z = jax.nn.gelu(h @ w_in + b_in)
    u, v = jnp.split(z, 2, axis=-1)
    v = _layer_norm(v, ln_g, ln_b)
    vc = v.reshape(B_, S_ // CHUNK, CHUNK, N_SGU_HEADS, SGU_HEAD)
    mask = jnp.tril(jnp.ones((CHUNK, CHUNK), dtype=bool))
    ws = jnp.where(mask[None], w_s, jnp.zeros_like(w_s))
    sv = jnp.einsum('hts,bnshc->bnthc', ws, vc) + b_s.T[None, None, :, :, None]
    return (u * sv.reshape(B_, S_, D_SGU)) @ w_out + b_out


def _moe_ffn(h, w_router, b_router, w1, b1, w2, b2):
    B_, S_, D = h.shape
    T = B_ * S_
    TK = T * TOP_K
    xt = h.reshape(T, D)
    logits = (xt @ w_router + b_router).astype(jnp.float32)
    top_vals, top_idx = lax.top_k(logits, TOP_K)
    gates = jax.nn.softmax(top_vals, axis=-1).astype(h.dtype)
    flat_e = top_idx.reshape(-1)
    flat_tok = jnp.repeat(jnp.arange(T, dtype=jnp.int32), TOP_K)
    flat_g = gates.reshape(-1)
    order = jnp.argsort(flat_e)
    se, stok, sg = flat_e[order], flat_tok[order], flat_g[order]
    counts = jnp.zeros((N_EXPERTS,), jnp.int32).at[flat_e].add(1)
    padded = ((counts + EXPERT_BLOCK - 1) // EXPERT_BLOCK) * EXPERT_BLOCK
    starts = jnp.cumsum(counts) - counts
    pends = jnp.cumsum(padded)
    pstarts = pends - padded
    dest = pstarts[se] + (jnp.arange(TK, dtype=jnp.int32) - starts[se])
    n_blocks = -(-TK // EXPERT_BLOCK) + N_EXPERTS
    cap = n_blocks * EXPERT_BLOCK
    buf_tok = jnp.full((cap,), T, jnp.int32).at[dest].set(stok)
    buf_g = jnp.zeros((cap,), h.dtype).at[dest].set(sg)
    block_start = jnp.arange(n_blocks, dtype=jnp.int32) * EXPERT_BLOCK
    block_e = jnp.clip(jnp.searchsorted(pends, block_start, side='right'), 0, N_EXPERTS - 1)
    x_pad = jnp.concatenate([xt, jnp.zeros((1, D), xt.dtype)], axis=0)

    def expert_block(args):
        tok_blk, g_blk, e = args
        hb = x_pad[tok_blk] @ w1[e] + b1[e]
        x_glu = jnp.minimum(hb[:, 0::2], SWIGLU_LIMIT)
        x_lin = jnp.clip(hb[:, 1::2], -SWIGLU_LIMIT, SWIGLU_LIMIT)
        act = x_glu * jax.nn.sigmoid(SWIGLU_ALPHA * x_glu) * (x_lin + 1.0)
        return (act @ w2[e] + b2[e]) * g_blk[:, None]

    yb = lax.map(expert_block, (buf_tok.reshape(n_blocks, EXPERT_BLOCK),
                                buf_g.reshape(n_blocks, EXPERT_BLOCK), block_e))
    out = jnp.zeros((T + 1, D), yb.dtype).at[buf_tok].add(yb.reshape(cap, D))[:T]
    return out.reshape(B_, S_, D)


def setup_inputs(seed: int = 0) -> dict:
    key = jax.random.key(seed)
    ks = iter(jax.random.split(key, 40))

    def nrm(shape, std):
        return jax.random.normal(next(ks), shape, jnp.float32) * std

    d = D_MODEL
    u = jax.random.uniform(next(ks), (N_EVEN, D_REC), jnp.float32, minval=0.9, maxval=0.999)
    a0 = u ** (1.0 / LRU_C)
    lru_lambda = jnp.log(a0) - jnp.log1p(-a0)
    return {
        'x': nrm((BATCH, SEQ, d), 1.0),
        'c': nrm((BATCH, d), 1.0),
        'mod_w': nrm((DEPTH, 2, d, 3 * d), 0.5 * d ** -0.5),
        'mod_b': nrm((DEPTH, 2, 3 * d), 0.01),
        'ln_g': 1.0 + nrm((DEPTH, 2, d), 0.05),
        'ln_b': nrm((DEPTH, 2, d), 0.01),
        'ab_w_in': nrm((N_EVEN, d, D_IN_AB), d ** -0.5),
        'pool_w': nrm((N_EVEN, len(POOL_WINDOWS), POOL_GROUP, POOL_GROUP), POOL_GROUP ** -0.5),
        'pool_scale': 1.0 + nrm((N_EVEN, D_POOL), 0.05),
        'conv_w': nrm((N_EVEN, CONV_WIDTH, D_REC), CONV_WIDTH ** -0.5),
        'conv_b': nrm((N_EVEN, D_REC), 0.01),
        'lru_w_a': nrm((N_EVEN, N_REC_HEADS, REC_HEAD, REC_HEAD), REC_HEAD ** -0.5),
        'lru_b_a': nrm((N_EVEN, D_REC), 0.01),
        'lru_w_x': nrm((N_EVEN, N_REC_HEADS, REC_HEAD, REC_HEAD), REC_HEAD ** -0.5),
        'lru_b_x': nrm((N_EVEN, D_REC), 0.01),
        'lru_lambda': lru_lambda,
        'ab_w_out': nrm((N_EVEN, D_MIX_AB, d), DEEPNORM_BETA * D_MIX_AB ** -0.5),
        'ab_b_out': nrm((N_EVEN, d), 0.01),
        'sgu_w_in': nrm((N_ODD, d, 2 * D_SGU), d ** -0.5),
        'sgu_b_in': nrm((N_ODD, 2 * D_SGU), 0.01),
        'sgu_ln_g': 1.0 + nrm((N_ODD, D_SGU), 0.05),
        'sgu_ln_b': nrm((N_ODD, D_SGU), 0.01),
        'sgu_w_s': nrm((N_ODD, N_SGU_HEADS, CHUNK, CHUNK), CHUNK ** -0.5),
        'sgu_b_s': 1.0 + nrm((N_ODD, N_SGU_HEADS, CHUNK), 0.01),
        'sgu_w_out': nrm((N_ODD, D_SGU, d), DEEPNORM_BETA * D_SGU ** -0.5),
        'sgu_b_out': nrm((N_ODD, d), 0.01),
        'router_w': nrm((DEPTH, d, N_EXPERTS), d ** -0.5),
        'router_b': nrm((DEPTH, N_EXPERTS), 0.01),
        'moe_w1': nrm((DEPTH, N_EXPERTS, d, 2 * D_FF), d ** -0.5),
        'moe_b1': nrm((DEPTH, N_EXPERTS, 2 * D_FF), 0.01),
        'moe_w2': nrm((DEPTH, N_EXPERTS, D_FF, d), DEEPNORM_BETA * D_FF ** -0.5),
        'moe_b2': nrm((DEPTH, N_EXPERTS, d), 0.01),
    }


def reference(x, c, mod_w, mod_b, ln_g, ln_b,
              ab_w_in, pool_w, pool_scale, conv_w, conv_b, lru_w_a, lru_b_a, lru_w_x, lru_b_x,
              lru_lambda, ab_w_out, ab_b_out,
              sgu_w_in, sgu_b_in, sgu_ln_g, sgu_ln_b, sgu_w_s, sgu_b_s, sgu_w_out, sgu_b_out,
              router_w, router_b, moe_w1, moe_b1, moe_w2, moe_b2):
    c_act = jax.nn.silu(c)
    for layer in range(DEPTH):
        j = layer // 2
        shift, scale, gate = _modulation(c_act, mod_w[layer, 0], mod_b[layer, 0])
        h = x * (1.0 + scale) + shift
        if layer % 2 == 0:
            y = _mixer_pool_lru(h, ab_w_in[j], pool_w[j], pool_scale[j], conv_w[j], conv_b[j],
                                lru_w_a[j], lru_b_a[j], lru_w_x[j], lru_b_x[j], lru_lambda[j],
                                ab_w_out[j], ab_b_out[j])
        else:
            y = _mixer_sgu(h, sgu_w_in[j], sgu_b_in[j], sgu_ln_g[j], sgu_ln_b[j], sgu_w_s[j],
                           sgu_b_s[j], sgu_w_out[j], sgu_b_out[j])
        x = _layer_norm(DEEPNORM_ALPHA * x + gate * y, ln_g[layer, 0], ln_b[layer, 0])
        shift, scale, gate = _modulation(c_act, mod_w[layer, 1], mod_b[layer, 1])
        h = x * (1.0 + scale) + shift
        y = _moe_ffn(h, router_w[layer], router_b[layer], moe_w1[layer], moe_b1[layer],
                     moe_w2[layer], moe_b2[layer])
        x = _layer_norm(DEEPNORM_ALPHA * x + gate * y, ln_g[layer, 1], ln_b[layer, 1])
    return x
```

```cpp
#include <hip/hip_runtime.h>
#include <cstdio>
#include <cstdint>

#ifndef PIN_ACC
#define PIN_ACC 0
#endif
#ifndef FP8_M1
#define FP8_M1 1
#endif
#ifndef FP8_M2
#define FP8_M2 1
#endif
#ifndef FP8_YS
#define FP8_YS 1
#endif
#ifndef MK_ONE_LAUNCH
#define MK_ONE_LAUNCH 1
#endif

#ifndef PHMASK
#define PHMASK 0xFFFFF
#endif
#define PHEN(k) (((PHMASK) >> (k)) & 1)
#define LAS __attribute__((address_space(3)))
#define GAS __attribute__((address_space(1)))
typedef unsigned short bf16_t;
typedef short bf16x8 __attribute__((ext_vector_type(8)));
typedef float f32x4 __attribute__((ext_vector_type(4)));
typedef float f32x2 __attribute__((ext_vector_type(2)));
typedef unsigned u32x4 __attribute__((ext_vector_type(4)));
typedef unsigned u32x2 __attribute__((ext_vector_type(2)));

constexpr int D = 1024, NBATCH = 16, SEQ = 4096, T = NBATCH * SEQ, DEPTH = 4;
constexpr int NE = 32, TOPK = 4, TKTOT = T * TOPK;
constexpr int DPOOL = 512, DREC = 512, DINAB = 1536;
constexpr float LN_EPS = 1e-5f;
constexpr float DN_ALPHA = 1.6817928305074292f;

constexpr size_t MiB = 1ull << 20;
constexpr size_t WS_CTL = 0, CTL_ZERO_BYTES = 1 * MiB;
constexpr size_t WS_MOD = 1 * MiB;
constexpr size_t WS_BR = 3 * MiB;
constexpr size_t WS_BPOOL = 5 * MiB;
constexpr size_t WS_BGATE = 6 * MiB;
constexpr size_t WS_WSM = 8 * MiB;
constexpr size_t WS_BIASRI = 8 * MiB + 512 * 1024;
constexpr size_t WS_B1P = 9 * MiB;
constexpr size_t WS_SUMM = 10 * MiB;
constexpr size_t WS_TOPG = 12 * MiB;
constexpr size_t WS_ABIN = 16 * MiB;
constexpr size_t WS_ABOUT = 22 * MiB;
constexpr size_t WS_SGIN = 26 * MiB;
constexpr size_t WS_SGOUT = 34 * MiB;
constexpr size_t WS_LOG = 40 * MiB;
constexpr size_t WS_LIST = 64 * MiB;
constexpr size_t WS_W1T = 128 * MiB;
constexpr size_t WS_W2T = 640 * MiB;
constexpr size_t WS_H = 896 * MiB;
constexpr size_t WS_Z = 1024 * MiB;
constexpr size_t WS_A2 = 1280 * MiB;
constexpr size_t WS_RI = 1408 * MiB;
constexpr size_t WS_YMIX = 1536 * MiB;
constexpr size_t WS_Y = 1664 * MiB;
constexpr size_t WS_ACT = 1792 * MiB;
constexpr size_t WS_YS = 2304 * MiB;
constexpr size_t WS_W1T8 = 2944 * MiB;
constexpr size_t WS_W2T8 = 3200 * MiB;
constexpr size_t WS_H8 = 3328 * MiB;
constexpr size_t WS_ACT8 = 3392 * MiB;
constexpr size_t WS_XB = 2816 * MiB;
constexpr size_t WS_END = 3648 * MiB;

constexpr int CW_BAR = 4096;
constexpr int CW_CNT = 16384;

constexpr int PH_CONV = 0, PH_H0 = 1, PH_L0 = 2, PH_PER_LAYER = 12, NPH = PH_L0 + PH_PER_LAYER * DEPTH;
__host__ __device__ constexpr bool phase_exists(int ph) {
    if (ph < PH_L0) return true;
    const int l = (ph - PH_L0) / PH_PER_LAYER, s = (ph - PH_L0) % PH_PER_LAYER;
    if ((l & 1) && (s == 2 || s == 3 || s == 4)) return false;
    return true;
}

constexpr int LDS_BYTES = 155648;
constexpr int LDSCTL_OFF = 154624;
constexpr int NXT_OFF = 131072;
constexpr int TAB_OFF = 147456;
constexpr int UTAB_OFF = 153600;

__device__ __forceinline__ unsigned f2bf(float f) { unsigned u = __builtin_bit_cast(unsigned, f); return (u + 0x7fffu + ((u >> 16) & 1u)) >> 16; }
typedef __bf16 bf16v2_t __attribute__((ext_vector_type(2)));
__device__ __forceinline__ unsigned pk2(float lo, float hi) { const f32x2 f = {lo, hi}; return __builtin_bit_cast(unsigned, __builtin_convertvector(f, bf16v2_t)); }
__device__ __forceinline__ float bflo(unsigned w) { return __builtin_bit_cast(float, w << 16); }
__device__ __forceinline__ float bfhi(unsigned w) { return __builtin_bit_cast(float, w & 0xffff0000u); }
__device__ __forceinline__ float bf2f(bf16_t h) { return __builtin_bit_cast(float, ((unsigned)h) << 16); }
__device__ __forceinline__ unsigned cvt_pk_bf16(float lo, float hi) { return pk2(lo, hi); }
__device__ __forceinline__ unsigned pk4_fp8(float a, float b, float c, float d) { int w = 0; w = __builtin_amdgcn_cvt_pk_fp8_f32(a, b, w, false); w = __builtin_amdgcn_cvt_pk_fp8_f32(c, d, w, true); return (unsigned)w; }
__device__ __forceinline__ float fast_sigmoid(float x) { return __builtin_amdgcn_rcpf(1.0f + __builtin_amdgcn_exp2f(-1.4426950408889634f * x)); }
__device__ __forceinline__ float gelu_tanh(float x) { const float u = x * (1.5957691216057308f + 0.07135481627362202f * x * x); return x * fast_sigmoid(u); }
__device__ __forceinline__ f32x2 pk_sigmoid_scaled(f32x2 x, float nk) {
    const f32x2 t = x * nk; f32x2 e; e.x = __builtin_amdgcn_exp2f(t.x); e.y = __builtin_amdgcn_exp2f(t.y);
    const f32x2 d = e + 1.0f; f32x2 r; r.x = __builtin_amdgcn_rcpf(d.x); r.y = __builtin_amdgcn_rcpf(d.y); return r; }
__device__ __forceinline__ f32x2 pk_gelu_tanh(f32x2 x) {
    const f32x2 t = x * ((x * x) * (-0.07135481627362202f * 1.4426950408889634f) + (-1.5957691216057308f * 1.4426950408889634f));
    f32x2 e; e.x = __builtin_amdgcn_exp2f(t.x); e.y = __builtin_amdgcn_exp2f(t.y);
    const f32x2 d = e + 1.0f; f32x2 r; r.x = __builtin_amdgcn_rcpf(d.x); r.y = __builtin_amdgcn_rcpf(d.y); return x * r; }
__device__ __forceinline__ float wave_sum(float v, int lane) {
#pragma unroll
    for (int o = 1; o < 64; o <<= 1) v += __builtin_bit_cast(float, __builtin_amdgcn_ds_bpermute((lane ^ o) << 2, __builtin_bit_cast(int, v)));
    return v;
}

__device__ __forceinline__ int lane_id_asm() { int l; asm volatile("v_mbcnt_lo_u32_b32 %0, -1, 0\n\tv_mbcnt_hi_u32_b32 %0, -1, %0" : "=v"(l)); return l; }
#define XB_TMO      128
#define XB_XCNT(j)  (256  + 64 * (j))
#define XB_XSUB(j)  (1280 + 64 * (j))
#define XB_XGEN(j)  (2304 + 64 * (j))
#define XB_TOP      3328
#define XB_TOPGEN   3392
#define XCD_BAR_WORDS 3456
#define XB_SPIN_CAP (1u << 18)

__device__ __forceinline__ unsigned xb_ld(unsigned* p)              { return __hip_atomic_load(p, __ATOMIC_RELAXED, __HIP_MEMORY_SCOPE_AGENT); }
__device__ __forceinline__ unsigned xb_add(unsigned* p, unsigned v) { return __hip_atomic_fetch_add(p, v, __ATOMIC_RELAXED, __HIP_MEMORY_SCOPE_AGENT); }
__device__ __forceinline__ unsigned xb_xcc_id() { return (unsigned)__builtin_amdgcn_s_getreg((3 << 11) | 20) & 0xFu; }
#define XB_SPIN(cond, bar) do { unsigned _sp = 0; while (cond) { __builtin_amdgcn_s_sleep(1); \
    if ((++_sp & 255u) == 0u) { if (xb_ld(&(bar)[XB_TMO])) break; if (_sp > XB_SPIN_CAP) { atomicAdd(&(bar)[XB_TMO], 1u); break; } } } } while (0)

struct XcdBarrier {
    unsigned* bar; unsigned x; int wv;
    volatile LAS unsigned* st;
};

__device__ __forceinline__ XcdBarrier xcd_barrier_post(unsigned* bar, volatile LAS unsigned* st, int wv) {
    XcdBarrier b; b.bar = bar; b.x = xb_xcc_id(); b.st = st; b.wv = wv;
    if (wv == 0 && lane_id_asm() == 0) (void)xb_add(&bar[XB_XCNT(b.x)], 1u);
    return b;
}
__device__ __forceinline__ void xcd_barrier_complete(unsigned* bar, unsigned x, unsigned& nloc, unsigned& nx) {
    const unsigned G = gridDim.x * gridDim.y * gridDim.z;
    unsigned sum, cnt, mine, sp = 0u;
    for (;;) {
        sum = 0u; cnt = 0u; mine = 0u;
#pragma unroll
        for (unsigned j = 0; j < 16; ++j) { const unsigned c = xb_ld(&bar[XB_XCNT(j)]); sum += c; cnt += (c > 0u) ? 1u : 0u; mine = (j == x) ? c : mine; }
        if (sum == G) break;
        __builtin_amdgcn_s_sleep(1);
        if ((++sp & 255u) == 0u) { if (xb_ld(&bar[XB_TMO])) break; if (sp > XB_SPIN_CAP) { atomicAdd(&bar[XB_TMO], 1u); break; } }
    }
    nloc = mine > 0u ? mine : 1u; nx = cnt > 0u ? cnt : 1u;
}

__device__ __forceinline__ void xcd_barrier(const XcdBarrier& b) {
    asm volatile("s_waitcnt vmcnt(0)" ::: "memory");
    __syncthreads();
    if (b.wv == 0 && lane_id_asm() == 0) {
        unsigned* bar = b.bar;
        __builtin_amdgcn_s_waitcnt(0);
        unsigned nloc = b.st[0], nx = b.st[1];
        if (nloc == 0u) { xcd_barrier_complete(bar, b.x, nloc, nx); b.st[0] = nloc; b.st[1] = nx; }
        const unsigned old = xb_add(&bar[XB_XSUB(b.x)], 1u);
        const unsigned gen = old / nloc;
        if (old + 1u == (gen + 1u) * nloc) {
            __builtin_amdgcn_fence(__ATOMIC_RELEASE, "agent");
            asm volatile("s_waitcnt vmcnt(0)" ::: "memory");
            const unsigned og = xb_add(&bar[XB_TOP], 1u);
            const unsigned tg = og / nx;
            if (og + 1u == (tg + 1u) * nx) xb_add(&bar[XB_TOPGEN], 1u);
            else XB_SPIN(xb_ld(&bar[XB_TOPGEN]) == tg, bar);
            __builtin_amdgcn_fence(__ATOMIC_ACQUIRE, "agent");
            xb_add(&bar[XB_XGEN(b.x)], 1u);
            asm volatile("s_waitcnt vmcnt(0)" ::: "memory");
        } else {
            XB_SPIN(xb_ld(&bar[XB_XGEN(b.x)]) == gen, bar);
            __builtin_amdgcn_fence(__ATOMIC_ACQUIRE, "agent");
            asm volatile("s_waitcnt vmcnt(0)" ::: "memory");
        }
    }
    __syncthreads();
}

#ifdef PROBE_VARIANTS
__device__ __forceinline__ int kvariant() { return *(const __attribute__((address_space(4))) int*)((const __attribute__((address_space(4))) unsigned char*)__builtin_amdgcn_kernarg_segment_ptr() + 280); }
#endif
__device__ __forceinline__ void glds16(const char* sbase, unsigned voff, unsigned lds_dst) {
    unsigned keep;
    asm volatile("s_mov_b32 %0, m0\n\ts_mov_b32 m0, %3\n\ts_nop 0\n\tglobal_load_lds_dwordx4 %1, %2\n\ts_mov_b32 m0, %0" : "=&s"(keep) : "v"(voff), "s"(sbase), "s"(lds_dst) : "memory");
}
__device__ __forceinline__ void glds4(const char* sbase, unsigned voff, unsigned lds_dst) {
    unsigned keep;
    asm volatile("s_mov_b32 %0, m0\n\ts_mov_b32 m0, %3\n\ts_nop 0\n\tglobal_load_lds_dword %1, %2\n\ts_mov_b32 m0, %0" : "=&s"(keep) : "v"(voff), "s"(sbase), "s"(lds_dst) : "memory");
}
namespace pg8 {
constexpr int BM = 256, BK = 64, HALF = 128, HTB = HALF * BK * 2, STAGE_BYTES = 8 * HTB, NXCD = 8, WGM = 8;
__host__ __device__ __forceinline__ int perm32(int rho) { const int n = rho >> 4, i = rho & 15; return 8 * (i >> 2) + 4 * n + (i & 3); }

template <bool F8> __host__ __device__ __forceinline__ int chunk_xor(int r15) { const int rp = (r15 >> 1) & 7; return F8 ? ((rp & 4) | ((rp & 1) << 1) | ((rp >> 1) & 1)) : rp; }
struct Unit { int arow, brow, pn, e, rt, cnt, slot; };
struct Gemm { const void* A; const void* Bt; int lda, ldb, K, wscale; };
typedef int i32x4 __attribute__((ext_vector_type(4)));
typedef int i32x8 __attribute__((ext_vector_type(8)));
__device__ __forceinline__ i32x8 cat8(bf16x8 lo, bf16x8 hi) { return __builtin_shufflevector(__builtin_bit_cast(i32x4, lo), __builtin_bit_cast(i32x4, hi), 0, 1, 2, 3, 4, 5, 6, 7); }

struct DenseSched {
    static constexpr bool GATHER = false;
    int nM, nN, nwg, G, c;
    __device__ __forceinline__ void init(int M, int N, int G_, int c_) { nM = M / BM; nN = N / BM; nwg = nM * nN; G = G_; c = c_; }
    __device__ __forceinline__ bool next(int i, Unit& u) const {
        const long L = (long)i * G + c; if (L >= nwg) return false;
        int wgid = (int)L; { const int q = nwg / NXCD, r = nwg % NXCD, xcd = wgid % NXCD, off = wgid / NXCD; wgid = (xcd < r ? xcd * (q + 1) : r * (q + 1) + (xcd - r) * q) + off; }
        const int nig = WGM * nN, gid = wgid / nig, fm = gid * WGM, gsz = (nM - fm) < WGM ? (nM - fm) : WGM;
        const int pm = fm + ((wgid % nig) % gsz), pn = (wgid % nig) / gsz;
        u.arow = pm * BM; u.brow = pn * BM; u.pn = pn; u.e = 0; u.rt = pm; u.cnt = BM; u.slot = 0; return true;
    }
    __device__ __forceinline__ void a_off(const Unit& u, LAS unsigned char*, int R0, int C0, int lda2, unsigned (&off)[2][2]) const {
#pragma unroll
        for (int h = 0; h < 2; ++h)
#pragma unroll
            for (int i = 0; i < 2; ++i) off[h][i] = (unsigned)((u.arow + 128 * h + 64 * i + R0) * lda2 + C0);
    }
};

struct MoeSched {
    static constexpr bool GATHER = true;
    const LAS int* utab;
    const int* list;
    const float* bias;
    int nunits, nexp_rows, shift;
    __device__ __forceinline__ bool next(int i, Unit& u) const {
        if (i >= nunits) return false;
        const LAS int* p = utab + 4 * i;
        u.e = __builtin_amdgcn_readfirstlane(p[0]); u.rt = __builtin_amdgcn_readfirstlane(p[1]); u.pn = __builtin_amdgcn_readfirstlane(p[2]); u.cnt = __builtin_amdgcn_readfirstlane(p[3]);
        u.arow = 0; u.brow = u.e * nexp_rows + u.pn * BM; u.slot = i % 3; return true;
    }
    __device__ __forceinline__ void tab_issue(const Unit& u, unsigned ldsb, int wid, int lane) const {
        if (wid < 4) { int p = u.rt * BM + 64 * wid + lane; p = p < u.cnt ? p : u.cnt - 1;
            glds4((const char*)(list + (size_t)u.e * TKTOT), (unsigned)p * 4u, ldsb + TAB_OFF + u.slot * 1024 + wid * 256); }
        else glds4((const char*)(bias + (size_t)u.e * nexp_rows + u.pn * BM), (unsigned)(64 * (wid - 4) + lane) * 4u, ldsb + TAB_OFF + 3072 + u.slot * 1024 + (wid - 4) * 256);
    }
    __device__ __forceinline__ void a_off(const Unit& u, LAS unsigned char* lds, int R0, int C0, int lda2, unsigned (&off)[2][2]) const {
        const LAS int* ids = (const LAS int*)(lds + TAB_OFF + u.slot * 1024);
#pragma unroll
        for (int h = 0; h < 2; ++h)
#pragma unroll
            for (int i = 0; i < 2; ++i) off[h][i] = (unsigned)((ids[128 * h + 64 * i + R0] >> shift) * lda2 + C0);
    }
};
__device__ __forceinline__ int moe_build_units(LAS int* utab, const volatile LAS int* tstart, const volatile LAS int* cnts, int NP, int G, int c, int tid) {
    const int total = tstart[NE] * NP;
    if (tid < 64) { const int L = tid * G + c;
        if (L < total) { int e = 0;
            for (int q = 0; q < NE - 1; ++q) if (tstart[q + 1] * NP <= L) e = q + 1;
            const int t0 = tstart[e], nte = tstart[e + 1] - t0, idx = L - t0 * NP;
            utab[4 * tid + 0] = e; utab[4 * tid + 1] = idx % nte; utab[4 * tid + 2] = idx / nte; utab[4 * tid + 3] = cnts[e]; } }
    return total > c ? (total - c + G - 1) / G : 0;
}

template <int ACT  , bool HAS_BIAS, bool HAS_SCALE> struct EpiDense {
    static constexpr bool PERM = true;
    bf16_t* O; int ldc; const float* bias; const float* scale;
    __device__ __forceinline__ void operator()(const f32x4 (&acc)[2][2][4][2], const Unit& u, int wr, int wc, int fr, int fq) const {
        const int row0 = u.arow + wr * 64 + fr, col0 = u.pn * BM + wc * 32 + 8 * fq;
        f32x4 bv[2][2], sv[2][2];
#pragma unroll
        for (int bj = 0; bj < 2; ++bj)
#pragma unroll
            for (int n = 0; n < 2; ++n) {
                if (HAS_BIAS) bv[bj][n] = *(const f32x4*)(bias + col0 + bj * HALF + 4 * n);
                if (HAS_SCALE) sv[bj][n] = *(const f32x4*)(scale + col0 + bj * HALF + 4 * n);
            }
#pragma unroll
        for (int ai = 0; ai < 2; ++ai)
#pragma unroll
            for (int m = 0; m < 4; ++m) { bf16_t* rowp = O + (size_t)(row0 + ai * HALF + m * 16) * ldc + col0;
#pragma unroll
                for (int bj = 0; bj < 2; ++bj) { f32x4 v0 = acc[ai][bj][m][0], v1 = acc[ai][bj][m][1];
                    if (HAS_BIAS) { v0 = v0 + bv[bj][0]; v1 = v1 + bv[bj][1]; }
                    if (ACT == 1) { const f32x2 a = pk_gelu_tanh((f32x2){v0[0], v0[1]}), b = pk_gelu_tanh((f32x2){v0[2], v0[3]}), c = pk_gelu_tanh((f32x2){v1[0], v1[1]}), d = pk_gelu_tanh((f32x2){v1[2], v1[3]});
                        v0 = (f32x4){a.x, a.y, b.x, b.y}; v1 = (f32x4){c.x, c.y, d.x, d.y}; }
                    if (ACT == 2) { const float nk = -1.4426950408889634f;
                        const f32x2 a = pk_sigmoid_scaled((f32x2){v0[0], v0[1]}, nk), b = pk_sigmoid_scaled((f32x2){v0[2], v0[3]}, nk), c = pk_sigmoid_scaled((f32x2){v1[0], v1[1]}, nk), d = pk_sigmoid_scaled((f32x2){v1[2], v1[3]}, nk);
                        v0 = (f32x4){a.x, a.y, b.x, b.y}; v1 = (f32x4){c.x, c.y, d.x, d.y}; }
                    if (HAS_SCALE) { v0 = v0 * sv[bj][0]; v1 = v1 * sv[bj][1]; }
                    u32x4 w; w.x = cvt_pk_bf16(v0[0], v0[1]); w.y = cvt_pk_bf16(v0[2], v0[3]); w.z = cvt_pk_bf16(v1[0], v1[1]); w.w = cvt_pk_bf16(v1[2], v1[3]);
                    *(u32x4*)(rowp + bj * HALF) = w; } }
    }
};
struct EpiRouter {
    static constexpr bool PERM = false;
    float* LOG;
    __device__ __forceinline__ void operator()(const f32x4 (&acc)[2][2][4][2], const Unit& u, int wr, int wc, int fr, int fq) const {
        if (wc < 2) {
#pragma unroll
            for (int ai = 0; ai < 2; ++ai)
#pragma unroll
                for (int m = 0; m < 4; ++m) { float* rowp = LOG + (size_t)(u.arow + ai * HALF + wr * 64 + m * 16 + fr) * 64 + wc * 32 + 4 * fq;
#pragma unroll
                    for (int n = 0; n < 2; ++n) *(f32x4*)(rowp + 16 * n) = acc[ai][0][m][n]; }
        }
    }
};
template <bool OUT8> struct EpiMoe1 {
    static constexpr bool PERM = false;
    bf16_t* ACT; LAS unsigned char* lds; float oscale;
    __device__ __forceinline__ void operator()(const f32x4 (&acc)[2][2][4][2], const Unit& u, int wr, int wc, int fr, int fq) const {
        const LAS int* ids = (const LAS int*)(lds + TAB_OFF + u.slot * 1024);
        const LAS float* bp = (const LAS float*)(lds + TAB_OFF + 3072 + u.slot * 1024) + wc * 32 + 4 * fq;
        f32x4 bg[2], bl[2];
#pragma unroll
        for (int bj = 0; bj < 2; ++bj) { bg[bj] = *(const LAS f32x4*)(bp + bj * HALF); bl[bj] = *(const LAS f32x4*)(bp + bj * HALF + 16) + 1.0f; }
        const int j0 = u.pn * 128 + wc * 32 + 8 * fq;
#pragma unroll
        for (int ai = 0; ai < 2; ++ai)
#pragma unroll
            for (int m = 0; m < 4; ++m) {
                const int pl = ai * HALF + wr * 64 + m * 16 + fr;
                if (u.rt * BM + pl < u.cnt) {
                    const int flat = ids[pl];
                    float o[8];
#pragma unroll
                    for (int bj = 0; bj < 2; ++bj) { const f32x4 g = acc[ai][bj][m][0] * oscale + bg[bj], l = acc[ai][bj][m][1] * oscale + bl[bj];
#pragma unroll
                        for (int hh = 0; hh < 2; ++hh) {
                            const f32x2 xg = {fminf(g[2 * hh], 7.0f), fminf(g[2 * hh + 1], 7.0f)};
                            const f32x2 xl = {__builtin_amdgcn_fmed3f(l[2 * hh], -6.0f, 8.0f), __builtin_amdgcn_fmed3f(l[2 * hh + 1], -6.0f, 8.0f)};
                            const f32x2 r = pk_sigmoid_scaled(xg, -1.702f * 1.4426950408889634f), oo = (xg * xl) * r;
                            o[bj * 4 + 2 * hh] = oo.x; o[bj * 4 + 2 * hh + 1] = oo.y; } }
                    if constexpr (OUT8) { u32x2 w; w.x = pk4_fp8(o[0], o[1], o[2], o[3]); w.y = pk4_fp8(o[4], o[5], o[6], o[7]);
                        *(u32x2*)((unsigned char*)ACT + (size_t)flat * 1024 + j0) = w; }
                    else { u32x4 w; w.x = cvt_pk_bf16(o[0], o[1]); w.y = cvt_pk_bf16(o[2], o[3]); w.z = cvt_pk_bf16(o[4], o[5]); w.w = cvt_pk_bf16(o[6], o[7]);
                        *(u32x4*)(ACT + (size_t)flat * 1024 + j0) = w; }
                }
            }
    }
};
struct EpiMoe2 {
    static constexpr bool PERM = true;
    bf16_t* YS; LAS unsigned char* lds; float oscale;
    __device__ __forceinline__ void operator()(const f32x4 (&acc)[2][2][4][2], const Unit& u, int wr, int wc, int fr, int fq) const {
        const LAS int* ids = (const LAS int*)(lds + TAB_OFF + u.slot * 1024);
        const LAS float* bp = (const LAS float*)(lds + TAB_OFF + 3072 + u.slot * 1024) + wc * 32 + 8 * fq;
        const int col0 = u.pn * BM + wc * 32 + 8 * fq;
#pragma unroll
        for (int bj = 0; bj < 2; ++bj) {
            const float os = FP8_YS ? 16.0f * oscale : oscale;
            const f32x4 b0 = *(const LAS f32x4*)(bp + bj * HALF) * (FP8_YS ? 16.0f : 1.0f), b1 = *(const LAS f32x4*)(bp + bj * HALF + 4) * (FP8_YS ? 16.0f : 1.0f);
#pragma unroll
            for (int ai = 0; ai < 2; ++ai)
#pragma unroll
                for (int m = 0; m < 4; ++m) {
                    const int pl = ai * HALF + wr * 64 + m * 16 + fr;
                    if (u.rt * BM + pl < u.cnt) {
                        const int flat = ids[pl];
                        const f32x4 v0 = acc[ai][bj][m][0] * os + b0, v1 = acc[ai][bj][m][1] * os + b1;
                        if (FP8_YS) { u32x2 w; w.x = pk4_fp8(v0[0], v0[1], v0[2], v0[3]); w.y = pk4_fp8(v1[0], v1[1], v1[2], v1[3]);
                            *(u32x2*)((unsigned char*)YS + (size_t)flat * 1024 + col0 + bj * HALF) = w; }
                        else { u32x4 w; w.x = cvt_pk_bf16(v0[0], v0[1]); w.y = cvt_pk_bf16(v0[2], v0[3]); w.z = cvt_pk_bf16(v1[0], v1[1]); w.w = cvt_pk_bf16(v1[2], v1[3]);
                            *(u32x4*)(YS + (size_t)flat * 1024 + col0 + bj * HALF) = w; }
                    }
                }
        }
    }
};

template <bool F8, class Epi, class Sched>
__device__ __forceinline__ void gemm_phase(LAS unsigned char* lds, const Gemm g, const Sched& S, const Epi& E, const int wave0) {
    const int tid = (wave0 << 6) | lane_id_asm();
    const int wid = __builtin_amdgcn_readfirstlane(tid >> 6), lane = tid & 63, wr = wid >> 2, wc = wid & 3, fr = lane & 15, fq = lane >> 4;
    constexpr unsigned ESZ = F8 ? 1u : 2u;
    const int nt = (int)((unsigned)g.K * ESZ / 128u);
    int R0, C0;
    R0 = 8 * wid + (lane >> 3); C0 = 16 * ((lane & 7) ^ chunk_xor<F8>(R0 & 15));
    const unsigned lda2 = (unsigned)g.lda * ESZ, ldb2 = (unsigned)g.ldb * ESZ;
    const unsigned voffB = (unsigned)((Epi::PERM ? ((R0 & ~31) + perm32(R0 & 31)) : R0) * (int)ldb2 + C0);
    const unsigned aoffl = (unsigned)(R0 * (int)lda2 + C0);
    const unsigned kstep = 128;
    const size_t hstepB = (size_t)HALF * ldb2;
    const unsigned ldsw = (unsigned)wid * 1024u;
    const int ab = fr * 128 + 16 * ((F8 ? 2 * fq : fq) ^ chunk_xor<F8>(fr));
    const int aoff0 = wr * 8192 + ab, boff0 = wc * 4096 + ab;
    constexpr int KX = F8 ? 16 : 64;
    const char* const Abase = (const char*)g.A;
    const unsigned ldsb = (unsigned)(size_t)lds;
#define PG8_SA(b, h) (((b) * 2 + (h)) * HTB)
#define PG8_SB(b, h) ((4 + (b) * 2 + (h)) * HTB)
#define PG8_GOFF(h, NXT) do { if constexpr (Sched::GATHER) go = *(const LAS u32x2*)(lds + NXT_OFF + ((((NXT) ? ui + 1 : ui) & 1) << 13) + tid * 16 + (h) * 8); } while (0)
#define PG8_STAGE_A(bufoff, h, NXT, kb) do { _Pragma("unroll") for (int _i = 0; _i < 2; ++_i) { \
        if constexpr (Sched::GATHER) glds16(Abase + (kb), _i ? go.y : go.x, ldsb + (bufoff) + ldsw + _i * 8192); \
        else glds16(Abase + ((NXT) ? nxtA : curA) + (size_t)((h) * 128 + _i * 64) * lda2 + (kb), aoffl, ldsb + (bufoff) + ldsw + _i * 8192); } } while (0)
#define PG8_STAGE_B(bufoff, bptr, kb) do { _Pragma("unroll") for (int _i = 0; _i < 2; ++_i) \
        glds16((bptr) + (size_t)(_i * 64) * ldb2 + (kb), voffB, ldsb + (bufoff) + ldsw + _i * 8192); } while (0)
#define PG8_LDA(dst, b, h) do { int _a1 = aoff0 ^ KX; asm volatile("" : "+v"(_a1)); \
        _Pragma("unroll") for (int m = 0; m < 4; ++m) _Pragma("unroll") for (int k = 0; k < 2; ++k) dst[m][k] = *(const LAS bf16x8*)(lds + PG8_SA(b, h) + (k ? _a1 : aoff0) + m * 2048); } while (0)
#define PG8_LDB(dst, b, h) do { int _b1 = boff0 ^ KX; asm volatile("" : "+v"(_b1)); \
        _Pragma("unroll") for (int n = 0; n < 2; ++n) _Pragma("unroll") for (int k = 0; k < 2; ++k) dst[n][k] = *(const LAS bf16x8*)(lds + PG8_SB(b, h) + (k ? _b1 : boff0) + n * 2048); } while (0)
#define PG8_MMA(ai, bj, At, Bt) do { __builtin_amdgcn_s_setprio(1); _Pragma("unroll") for (int m = 0; m < 4; ++m) _Pragma("unroll") for (int n = 0; n < 2; ++n) { \
        if constexpr (F8) acc[ai][bj][m][n] = __builtin_amdgcn_mfma_scale_f32_16x16x128_f8f6f4(cat8(Bt[n][0], Bt[n][1]), cat8(At[m][0], At[m][1]), acc[ai][bj][m][n], 0, 0, 0, 0, 0, 0); \
        else { _Pragma("unroll") for (int k = 0; k < 2; ++k) acc[ai][bj][m][n] = __builtin_amdgcn_mfma_f32_16x16x32_bf16(Bt[n][k], At[m][k], acc[ai][bj][m][n], 0, 0, 0); } } \
        __builtin_amdgcn_s_setprio(0); } while (0)
#define PG8_WAIT_V(n) asm volatile("s_waitcnt vmcnt(" #n ")" ::: "memory")
#define PG8_WAIT_L(n) asm volatile("s_waitcnt lgkmcnt(" #n ")" ::: "memory")
#define PG8_BAR __builtin_amdgcn_s_barrier()
#define PG8_SCHED __builtin_amdgcn_sched_barrier(0)
#define PG8_KITER(k1, b2, NXT, k2, k3) do { \
        PG8_GOFF(1, 0); PG8_LDB(B0, 0, 0); PG8_LDB(B1, 0, 1); PG8_SCHED; PG8_LDA(At, 0, 0); PG8_STAGE_A(PG8_SA(1, 1), 1, 0, (k1)); \
        PG8_WAIT_V(8); PG8_WAIT_L(0); PG8_BAR; PG8_MMA(0, 0, At, B0); PG8_MMA(0, 1, At, B1); PG8_BAR; PG8_SCHED; \
        PG8_GOFF(0, NXT); PG8_LDA(At, 0, 1); PG8_STAGE_B(PG8_SB(0, 0), (b2), (k2)); PG8_STAGE_B(PG8_SB(0, 1), (b2) + hstepB, (k2)); PG8_STAGE_A(PG8_SA(0, 0), 0, NXT, (k2)); \
        PG8_WAIT_V(8); PG8_WAIT_L(0); PG8_BAR; PG8_MMA(1, 0, At, B0); PG8_MMA(1, 1, At, B1); PG8_BAR; PG8_SCHED; \
        PG8_GOFF(1, NXT); PG8_LDB(B0, 1, 0); PG8_LDB(B1, 1, 1); PG8_SCHED; PG8_LDA(At, 1, 0); PG8_STAGE_A(PG8_SA(0, 1), 1, NXT, (k2)); \
        PG8_WAIT_V(8); PG8_WAIT_L(0); PG8_BAR; PG8_MMA(0, 0, At, B0); PG8_MMA(0, 1, At, B1); PG8_BAR; PG8_SCHED; \
        PG8_GOFF(0, NXT); PG8_LDA(At, 1, 1); PG8_STAGE_B(PG8_SB(1, 0), (b2), (k3)); PG8_STAGE_B(PG8_SB(1, 1), (b2) + hstepB, (k3)); PG8_STAGE_A(PG8_SA(1, 0), 0, NXT, (k3)); \
        PG8_WAIT_V(8); PG8_WAIT_L(0); PG8_BAR; PG8_MMA(1, 0, At, B0); PG8_MMA(1, 1, At, B1); PG8_BAR; PG8_SCHED; } while (0)

    Unit cur, nxt; int ui = 0;
    if (!S.next(0, cur)) return;
    unsigned curoff[2][2], nxtoff[2][2];
    size_t curA = 0, nxtA = 0;
    bool has_next = S.next(1, nxt);
#define PG8_NXT_SLOT ((LAS u32x4*)(lds + NXT_OFF) + tid)
    if constexpr (Sched::GATHER) {
        S.tab_issue(cur, ldsb, wid, lane); if (has_next) S.tab_issue(nxt, ldsb, wid, lane);
        asm volatile("s_waitcnt vmcnt(0)" ::: "memory"); __builtin_amdgcn_s_barrier(); asm volatile("" ::: "memory");
        S.a_off(cur, lds, R0, C0, (int)lda2, curoff);
        if (has_next) S.a_off(nxt, lds, R0, C0, (int)lda2, nxtoff);
        else {
#pragma unroll
            for (int h = 0; h < 2; ++h)
#pragma unroll
                for (int i = 0; i < 2; ++i) nxtoff[h][i] = curoff[h][i]; }
        ((LAS u32x4*)(lds + NXT_OFF))[tid] = (u32x4){curoff[0][0], curoff[0][1], curoff[1][0], curoff[1][1]};
        ((LAS u32x4*)(lds + NXT_OFF + 8192))[tid] = (u32x4){nxtoff[0][0], nxtoff[0][1], nxtoff[1][0], nxtoff[1][1]};
    } else { curA = (size_t)cur.arow * lda2; nxtA = has_next ? (size_t)nxt.arow * lda2 : curA; }
    f32x4 acc[2][2][4][2];
#pragma unroll
    for (int a = 0; a < 2; ++a)
#pragma unroll
        for (int b = 0; b < 2; ++b)
#pragma unroll
            for (int m = 0; m < 4; ++m)
#pragma unroll
                for (int n = 0; n < 2; ++n) acc[a][b][m][n] = (f32x4){0.f, 0.f, 0.f, 0.f};
    bf16x8 At[4][2], B0[2][2], B1[2][2];
    const char* cB = (const char*)g.Bt + (size_t)cur.brow * ldb2;
    u32x2 go = {0u, 0u};
    PG8_STAGE_B(PG8_SB(0, 0), cB, 0u); PG8_STAGE_B(PG8_SB(0, 1), cB + hstepB, 0u); PG8_GOFF(0, 0); PG8_STAGE_A(PG8_SA(0, 0), 0, 0, 0u); PG8_GOFF(1, 0); PG8_STAGE_A(PG8_SA(0, 1), 1, 0, 0u);
    if (wr == 1) PG8_BAR;
    PG8_WAIT_V(2); PG8_BAR;
    PG8_GOFF(0, 0); PG8_STAGE_B(PG8_SB(1, 0), cB, kstep); PG8_STAGE_A(PG8_SA(1, 0), 0, 0, kstep); PG8_STAGE_B(PG8_SB(1, 1), cB + hstepB, kstep);
    PG8_WAIT_V(6); PG8_BAR;
    for (;;) {
        const char* nB = has_next ? (const char*)g.Bt + (size_t)nxt.brow * ldb2 : cB;
        Unit u2; bool has2 = false;
        if constexpr (Sched::GATHER) has2 = has_next && S.next(ui + 2, u2);
#pragma unroll 1
        for (int t = 0; t < nt - 2; t += 2) {
            const unsigned k1 = (unsigned)(t + 1) * kstep, k2 = (unsigned)(t + 2) * kstep, k3 = (unsigned)(t + 3) * kstep;
            if constexpr (Sched::GATHER) { if (t == 2 && has2) S.tab_issue(u2, ldsb, wid, lane); }
            PG8_KITER(k1, cB, 0, k2, k3);
        }
        { const unsigned k1 = (unsigned)(nt - 1) * kstep; PG8_KITER(k1, nB, 1, 0u, kstep); }
#if PIN_ACC
#pragma unroll
        for (int a = 0; a < 2; ++a)
#pragma unroll
            for (int b = 0; b < 2; ++b)
#pragma unroll
                for (int m = 0; m < 4; ++m) asm volatile("" : "+v"(acc[a][b][m][0]), "+v"(acc[a][b][m][1]));
#endif
        if (wr == 0) PG8_BAR;
#ifdef PROBE_VARIANTS
        if (!(kvariant() & 4))
#endif
        { const int l2 = lane_id_asm(); E(acc, cur, wr, wc, l2 & 15, l2 >> 4); }
        if (!has_next) break;
#pragma unroll
        for (int a = 0; a < 2; ++a)
#pragma unroll
            for (int b = 0; b < 2; ++b)
#pragma unroll
                for (int m = 0; m < 4; ++m)
#pragma unroll
                    for (int n = 0; n < 2; ++n) acc[a][b][m][n] = (f32x4){0.f, 0.f, 0.f, 0.f};
        cur = nxt; cB = nB; ++ui; curA = nxtA;
        has_next = S.next(ui + 1, nxt);
        if (has_next) {
            if constexpr (Sched::GATHER) { const int tz = (wave0 << 6) | lane_id_asm(); int R0z, C0z;
                { const int lz = tz & 63; R0z = 8 * wid + (lz >> 3); C0z = 16 * ((lz & 7) ^ chunk_xor<F8>(R0z & 15)); }
                S.a_off(nxt, lds, R0z, C0z, (int)lda2, nxtoff);
                ((LAS u32x4*)(lds + NXT_OFF + (((ui + 1) & 1) << 13)))[tz] = (u32x4){nxtoff[0][0], nxtoff[0][1], nxtoff[1][0], nxtoff[1][1]}; }
            else nxtA = (size_t)nxt.arow * lda2;
        } else if constexpr (Sched::GATHER) { const int tz = (wave0 << 6) | lane_id_asm();
            ((LAS u32x4*)(lds + NXT_OFF + (((ui + 1) & 1) << 13)))[tz] = ((const LAS u32x4*)(lds + NXT_OFF + ((ui & 1) << 13)))[tz]; }
        if (wr == 1) PG8_BAR;
    }
    PG8_WAIT_V(0);
    PG8_BAR;
#undef PG8_SA
#undef PG8_SB
#undef PG8_STAGE_A
#undef PG8_GOFF
#undef PG8_STAGE_B
#undef PG8_LDA
#undef PG8_LDB
#undef PG8_MMA
#undef PG8_WAIT_V
#undef PG8_WAIT_L
#undef PG8_BAR
#undef PG8_SCHED
#undef PG8_KITER
#undef PG8_NXT_SLOT
}
}

struct Args { const float* in[32]; float* out; unsigned char* ws; int ph_lo, ph_hi, variant, pad; };
typedef const __attribute__((address_space(4))) unsigned char* kptr_t;
__device__ __forceinline__ const float* kin(int i) { kptr_t p = (kptr_t)__builtin_amdgcn_kernarg_segment_ptr(); asm volatile("" : "+s"(p)); return *(const float* const __attribute__((address_space(4)))*)(p + 8 * i); }
enum { I_X = 0, I_C, I_MODW, I_MODB, I_LNG, I_LNB, I_ABWIN, I_POOLW, I_POOLS, I_CONVW, I_CONVB, I_WA, I_BA, I_WX, I_BX, I_LAM, I_ABWOUT, I_ABBOUT,
       I_SGWIN, I_SGBIN, I_SGLNG, I_SGLNB, I_SGWS, I_SGBS, I_SGWOUT, I_SGBOUT, I_RW, I_RB, I_W1, I_B1, I_W2, I_B2 };

__device__ __forceinline__ int w1_rho(int n) { const int nn = n & 1, j = n >> 1; return ((j >> 7) << 8) | (((j >> 2) & 1) << 7) | (((j >> 5) & 3) << 5) | (nn << 4) | (((j >> 3) & 3) << 2) | (j & 3); }
__device__ __forceinline__ int w1_n_of_rho(int rho) { const int pn = rho >> 8, bj = (rho >> 7) & 1, wc = (rho >> 5) & 3, nn = (rho >> 4) & 1, fq = (rho >> 2) & 3, i = rho & 3; return 2 * (128 * pn + 32 * wc + 8 * fq + 4 * bj + i) + nn; }
template <bool W1MAP>
__device__ __forceinline__ void conv_item(const float* W, int N, bf16_t* WT, int item, int lane) {
    const int nblk = N >> 5, kb = item / nblk, nb = item - kb * nblk;
    const int kg = lane >> 3, nl = lane & 7, k0 = kb * 64 + kg * 8, n0 = nb * 32 + nl * 4;
    f32x4 v[8];
#pragma unroll
    for (int q = 0; q < 8; ++q) v[q] = *(const f32x4*)(W + (size_t)(k0 + q) * N + n0);
#pragma unroll
    for (int i = 0; i < 4; ++i) {
        const int n = n0 + i, row = W1MAP ? w1_rho(n) : n;
        u32x4 o; o.x = pk2(v[0][i], v[1][i]); o.y = pk2(v[2][i], v[3][i]); o.z = pk2(v[4][i], v[5][i]); o.w = pk2(v[6][i], v[7][i]);
        *(u32x4*)(WT + (size_t)row * 1024 + k0) = o;
    }
}

template <bool W1MAP>
__device__ __forceinline__ void conv_item_f8(const float* W, int N, unsigned char* WT8, int item, int lane, float scale) {
    const int nblk = N >> 5, kb = item / nblk, nb = item - kb * nblk;
    const int kg = lane >> 3, nl = lane & 7, k0 = kb * 128 + kg * 16, n0 = nb * 32 + nl * 4;
    f32x4 v[16];
#pragma unroll
    for (int q = 0; q < 16; ++q) v[q] = *(const f32x4*)(W + (size_t)(k0 + q) * N + n0) * scale;
#pragma unroll
    for (int i = 0; i < 4; ++i) {
        const int n = n0 + i, row = W1MAP ? w1_rho(n) : n;
        u32x4 o; o.x = pk4_fp8(v[0][i], v[1][i], v[2][i], v[3][i]); o.y = pk4_fp8(v[4][i], v[5][i], v[6][i], v[7][i]);
        o.z = pk4_fp8(v[8][i], v[9][i], v[10][i], v[11][i]); o.w = pk4_fp8(v[12][i], v[13][i], v[14][i], v[15][i]);
        *(u32x4*)(WT8 + (size_t)row * 1024 + k0) = o;
    }
}

#define IN(k) (lo <= (k) && (k) < hi)
#define SEAM(k) do { if ((k) + 1 < hi) xcd_barrier(bar); } while (0)
#define PH_LOCALS \
    const int tid = (wave0 << 6) | lane_id_asm(); \
    const int lane = tid & 63, wave = wave0; \
    int bx = blockIdx.x; asm volatile("" : "+s"(bx)); \
    const int vcu = (G % 8 == 0) ? (bx % 8) * (G / 8) + bx / 8 : bx; \
    const int gw = vcu * 8 + wave, NGW = G * 8; \
    unsigned char* ws; { kptr_t kp_ = (kptr_t)__builtin_amdgcn_kernarg_segment_ptr(); asm volatile("" : "+s"(kp_)); ws = *(unsigned char* const __attribute__((address_space(4)))*)(kp_ + 264); } \
    float* Xf; { kptr_t kp_ = (kptr_t)__builtin_amdgcn_kernarg_segment_ptr(); asm volatile("" : "+s"(kp_)); Xf = *(float* const __attribute__((address_space(4)))*)(kp_ + 256); } \
    unsigned* const ctl = (unsigned*)(ws + WS_CTL); \
    float* const MOD = (float*)(ws + WS_MOD); bf16_t* const Hb = (bf16_t*)(ws + WS_H); bf16_t* const Zb = (bf16_t*)(ws + WS_Z); bf16_t* const A2b = (bf16_t*)(ws + WS_A2); \
    bf16_t* const RIb = (bf16_t*)(ws + WS_RI); bf16_t* const YMb = (bf16_t*)(ws + WS_YMIX); bf16_t* const Yb = (bf16_t*)(ws + WS_Y); bf16_t* const ACTb = (bf16_t*)(ws + WS_ACT); \
    bf16_t* const YSb = (bf16_t*)(ws + WS_YS); float* const LOGf = (float*)(ws + WS_LOG); float* const TOPG = (float*)(ws + WS_TOPG); int* const LIST = (int*)(ws + WS_LIST); \
    float* const SUMM = (float*)(ws + WS_SUMM); \
    (void)lane; (void)wave; (void)gw; (void)NGW; (void)ctl; (void)MOD; (void)Hb; (void)Zb; (void)A2b; (void)RIb; (void)YMb; (void)Yb; (void)ACTb; (void)YSb; (void)LOGf; (void)TOPG; (void)LIST; (void)SUMM; (void)Xf; (void)vcu


template <int L, int PASS>
__device__ __forceinline__ void scan_phase(const int lo, const int hi, const int G, const XcdBarrier& bar, const int wave0) {
    constexpr int l = L, pass = PASS, P = PH_L0 + PH_PER_LAYER * L, jj = L >> 1; constexpr bool odd = (L & 1) != 0;
            if (PHEN(6) && !odd && IN(P + 3 + pass)) {
            PH_LOCALS;
                for (int it = gw; it < 16 * 32 * 4; it += NGW) {
                    const int b = it >> 7, n = (it >> 2) & 31, cg = it & 3;
                    const int ch = cg * 128 + 2 * lane;
                    float sp[2];
#pragma unroll
                    for (int q = 0; q < 2; ++q) { const float x = -kin(I_LAM)[jj * 512 + ch + q]; sp[q] = 8.0f * 1.4426950408889634f * (fmaxf(x, 0.f) + log1pf(__expf(-fabsf(x)))); }
                    float one = 1.0f; asm volatile("" : "+v"(one));
                    float h0 = 0.f, h1 = 0.f, p0 = one, p1 = one;
                    if (pass == 1) {
#pragma unroll 1
                        for (int m = 0; m < n; ++m) { const f32x4 s = *(const f32x4*)(SUMM + (((size_t)b * 32 + m) * 512 + ch) * 2); h0 = s[0] * h0 + s[1]; h1 = s[2] * h1 + s[3]; }
                    }
                    const size_t row0 = (size_t)b * SEQ + n * 128;
#pragma unroll 4
                    for (int t = 0; t < 128; ++t) {
                        const size_t r = row0 + t;
                        const unsigned rw = *(const unsigned*)(RIb + r * 1024 + ch), iw = *(const unsigned*)(RIb + r * 1024 + 512 + ch), xw = *(const unsigned*)(A2b + r * 1024 + 512 + ch);
                        const float a0 = __builtin_amdgcn_exp2f(-bflo(rw) * sp[0]), a1 = __builtin_amdgcn_exp2f(-bfhi(rw) * sp[1]);
                        const float m0 = __builtin_amdgcn_sqrtf(fmaxf(__builtin_fmaf(-a0, a0, 1.0f), 0.f)), m1 = __builtin_amdgcn_sqrtf(fmaxf(__builtin_fmaf(-a1, a1, 1.0f), 0.f));
                        h0 = a0 * h0 + m0 * (bflo(iw) * bflo(xw)); h1 = a1 * h1 + m1 * (bfhi(iw) * bfhi(xw));
                        if (pass == 0) { p0 *= a0; p1 *= a1; }
                        else { const unsigned gwd = *(const unsigned*)(Zb + r * DINAB + 1024 + ch);
                            *(unsigned*)(YMb + r * 1024 + 512 + ch) = pk2(h0 * gelu_tanh(bflo(gwd)), h1 * gelu_tanh(bfhi(gwd))); }
                    }
                    if (pass == 0) *(f32x4*)(SUMM + (((size_t)b * 32 + n) * 512 + ch) * 2) = (f32x4){p0, h0, p1, h1};
                }
                SEAM(P + 3 + pass);
            }
}

template <int L, int SUB>
__device__ __forceinline__ void ln_phase(const int lo, const int hi, const int G, const XcdBarrier& bar, const int wave0) {
    constexpr int l = L, sub = SUB, P = PH_L0 + PH_PER_LAYER * L; constexpr int ph = SUB == 0 ? P + 6 : P + 11;
    constexpr bool XIN_F32 = (L == 0 && SUB == 0), XOUT_F32 = (L == DEPTH - 1 && SUB == 1);
    if (PHEN(8) && IN(ph)) {
        PH_LOCALS;
        const int rows_per = T / NGW, r0 = gw * rows_per, b = r0 / SEQ;
        constexpr int ls = 2 * l + sub, lsn = ls + 1;
        const float* gp = MOD + ((size_t)ls * 16 + b) * 3072 + 2048;
        const float* lgp = kin(I_LNG) + ls * 1024, * lbp = kin(I_LNB) + ls * 1024;
        constexpr bool has_nextmod = lsn < 2 * DEPTH;
        const float* nsh = MOD + ((size_t)(has_nextmod ? lsn : 0) * 16 + b) * 3072, * nsc = nsh + 1024;
        f32x4 gt[4], lg[4], lb[4], sh[4], sc[4];
#pragma unroll
        for (int j = 0; j < 4; ++j) { const int o = 4 * (64 * j + lane); gt[j] = *(const f32x4*)(gp + o) + 1.0f; lg[j] = *(const f32x4*)(lgp + o); lb[j] = *(const f32x4*)(lbp + o);
            sh[j] = *(const f32x4*)(nsh + o); sc[j] = *(const f32x4*)(nsc + o) + 1.0f; }
        const float* xin32 = kin(I_X);
        bf16_t* const Xb = (bf16_t*)(ws + WS_XB);
        constexpr int RPI = 2;
        for (int r = r0; r < r0 + rows_per; r += RPI) {
            f32x4 xf[XIN_F32 ? RPI : 1][4]; u32x2 xb[XIN_F32 ? 1 : RPI][4]; u32x2 yv[sub == 0 ? RPI : 1][4]; u32x2 ys[sub == 0 ? 1 : RPI][4][4]; f32x4 gk[RPI];
#pragma unroll
            for (int q = 0; q < RPI; ++q) {
                if constexpr (XIN_F32) { const f32x4* xr = (const f32x4*)(xin32 + (size_t)(r + q) * D) + lane;
#pragma unroll
                    for (int j = 0; j < 4; ++j) xf[q][j] = xr[64 * j]; }
                else { const u32x2* xr = (const u32x2*)(Xb + (size_t)(r + q) * D) + lane;
#pragma unroll
                    for (int j = 0; j < 4; ++j) xb[q][j] = xr[64 * j]; }
                if constexpr (sub == 0) { const u32x2* yr = (const u32x2*)(Yb + (size_t)(r + q) * D) + lane;
#pragma unroll
                    for (int j = 0; j < 4; ++j) yv[q][j] = yr[64 * j]; }
                else { gk[q] = *(const f32x4*)(TOPG + (size_t)(r + q) * 4);
#pragma unroll
                    for (int k = 0; k < 4; ++k) {
                        if (FP8_YS) { const unsigned* yr = (const unsigned*)((const unsigned char*)YSb + ((size_t)(r + q) * 4 + k) * D) + lane;
#pragma unroll
                            for (int j = 0; j < 4; ++j) ys[q][k][j].x = yr[64 * j]; }
                        else { const u32x2* yr = (const u32x2*)(YSb + ((size_t)(r + q) * 4 + k) * D) + lane;
#pragma unroll
                            for (int j = 0; j < 4; ++j) ys[q][k][j] = yr[64 * j]; } } }
            }
            f32x4 v[RPI][4]; float s[RPI];
#pragma unroll
            for (int q = 0; q < RPI; ++q) {
                s[q] = 0.f;
#pragma unroll
                for (int j = 0; j < 4; ++j) {
                    f32x4 y, x;
                    if constexpr (XIN_F32) x = xf[q][j]; else x = (f32x4){bflo(xb[q][j].x), bfhi(xb[q][j].x), bflo(xb[q][j].y), bfhi(xb[q][j].y)};
                    if constexpr (sub == 0) y = (f32x4){bflo(yv[q][j].x), bfhi(yv[q][j].x), bflo(yv[q][j].y), bfhi(yv[q][j].y)};
                    else { y = (f32x4){0.f, 0.f, 0.f, 0.f};
#pragma unroll
                        for (int k = 0; k < 4; ++k) { const u32x2 w = ys[q][k][j];
                            if (FP8_YS) { const f32x2 lo2 = __builtin_amdgcn_cvt_pk_f32_fp8((int)w.x, false), hi2 = __builtin_amdgcn_cvt_pk_f32_fp8((int)w.x, true);
                                y = y + (f32x4){lo2.x, lo2.y, hi2.x, hi2.y} * (gk[q][k] * 0.0625f); }
                            else y = y + (f32x4){bflo(w.x), bfhi(w.x), bflo(w.y), bfhi(w.y)} * gk[q][k]; } }
                    v[q][j] = x * DN_ALPHA + gt[j] * y;
                    s[q] += (v[q][j][0] + v[q][j][1]) + (v[q][j][2] + v[q][j][3]);
                }
            }
#pragma unroll
            for (int o = 1; o < 64; o <<= 1) {
#pragma unroll
                for (int q = 0; q < RPI; ++q) s[q] += __builtin_bit_cast(float, __builtin_amdgcn_ds_bpermute((lane ^ o) << 2, __builtin_bit_cast(int, s[q])));
            }
            float s2[RPI];
#pragma unroll
            for (int q = 0; q < RPI; ++q) { const float mean = s[q] * (1.0f / D); s2[q] = 0.f;
#pragma unroll
                for (int j = 0; j < 4; ++j) { v[q][j] = v[q][j] - mean; s2[q] += (v[q][j][0] * v[q][j][0] + v[q][j][1] * v[q][j][1]) + (v[q][j][2] * v[q][j][2] + v[q][j][3] * v[q][j][3]); } }
#pragma unroll
            for (int o = 1; o < 64; o <<= 1) {
#pragma unroll
                for (int q = 0; q < RPI; ++q) s2[q] += __builtin_bit_cast(float, __builtin_amdgcn_ds_bpermute((lane ^ o) << 2, __builtin_bit_cast(int, s2[q])));
            }
#pragma unroll
            for (int q = 0; q < RPI; ++q) {
                const float rstd = 1.0f / sqrtf(s2[q] * (1.0f / D) + LN_EPS);
                u32x2* hr = (u32x2*)(Hb + (size_t)(r + q) * D) + lane;
#pragma unroll
                for (int j = 0; j < 4; ++j) { const f32x4 xn = v[q][j] * rstd * lg[j] + lb[j];
                    if (XOUT_F32) ((f32x4*)(Xf + (size_t)(r + q) * D) + lane)[64 * j] = xn;
                    else { u32x2 w; w.x = pk2(xn[0], xn[1]); w.y = pk2(xn[2], xn[3]); ((u32x2*)(Xb + (size_t)(r + q) * D) + lane)[64 * j] = w; }
                    if (has_nextmod) { const f32x4 h = xn * sc[j] + sh[j]; u32x2 w; w.x = pk2(h[0], h[1]); w.y = pk2(h[2], h[3]); hr[64 * j] = w;
                        if (FP8_M1 && sub == 0) ((unsigned*)(ws + WS_H8 + (size_t)(r + q) * D) + lane)[64 * j] = pk4_fp8(h[0], h[1], h[2], h[3]); } }
            }
        }
        if (ph + 1 < NPH) SEAM(ph);
    }
}

template <int L>
__device__ __forceinline__ void layer_body(LAS unsigned char* const lds, volatile LAS unsigned* const LCTL, const int lo, const int hi, const int G, const XcdBarrier& bar, const int wave0) {
    constexpr int l = L;
        const int P = PH_L0 + PH_PER_LAYER * l, jj = l >> 1;
        const bool odd = (l & 1) != 0;
        if (PHEN(2) && IN(P + 0)) {
            PH_LOCALS;
            if (!odd) {
                pg8::Gemm g{Hb, (const bf16_t*)(ws + WS_ABIN) + (size_t)jj * 1536 * 1024, 1024, 1024, 1024, 127};
                pg8::DenseSched S; S.init(T, 1536, G, bx);
                pg8::EpiDense<0, false, false> E{Zb, 1536, nullptr, nullptr};
                pg8::gemm_phase<false>(lds, g, S, E, wave0);
            } else {
                pg8::Gemm g{Hb, (const bf16_t*)(ws + WS_SGIN) + (size_t)jj * 2048 * 1024, 1024, 1024, 1024, 127};
                pg8::DenseSched S; S.init(T, 2048, G, bx);
                pg8::EpiDense<1, true, false> E{Zb, 2048, kin(I_SGBIN) + jj * 2048, nullptr};
                pg8::gemm_phase<false>(lds, g, S, E, wave0);
            }
            SEAM(P + 0);
        }
        if (PHEN(3) && !odd && IN(P + 1)) {
            PH_LOCALS;
            const int rows_per = T / NGW, r0 = gw * rows_per;
            const int g4 = lane >> 4, w = 2 << g4;
            float cw[4][8], cb[8];
#pragma unroll
            for (int k = 0; k < 4; ++k)
#pragma unroll
                for (int q = 0; q < 8; ++q) cw[k][q] = kin(I_CONVW)[((size_t)jj * 4 + k) * 512 + 8 * lane + q];
#pragma unroll
            for (int q = 0; q < 8; ++q) cb[q] = kin(I_CONVB)[jj * 512 + 8 * lane + q];
            const int ts0 = r0 & (SEQ - 1);
            u32x4 ring[16], cr[3];
            float sw[8];
#pragma unroll
            for (int q = 0; q < 8; ++q) sw[q] = 0.f;
#pragma unroll
            for (int d = 0; d < 16; ++d) {
                const int k = 15 - d;
                u32x4 v = {0u, 0u, 0u, 0u};
                if (ts0 > d) v = *(const u32x4*)(Zb + (size_t)(r0 - 1 - d) * DINAB + 8 * lane);
                ring[k] = v;
                if (d + 1 < w) { const float f[8] = {bflo(v.x), bfhi(v.x), bflo(v.y), bfhi(v.y), bflo(v.z), bfhi(v.z), bflo(v.w), bfhi(v.w)};
#pragma unroll
                    for (int q = 0; q < 8; ++q) sw[q] += f[q]; }
            }
#pragma unroll
            for (int d = 0; d < 3; ++d) { u32x4 v = {0u, 0u, 0u, 0u}; if (ts0 > d) v = *(const u32x4*)(Zb + (size_t)(r0 - 1 - d) * DINAB + 512 + 8 * lane); cr[2 - d] = v; }
#pragma unroll 1
            for (int rb = 0; rb < rows_per; rb += 16) {
#pragma unroll
                for (int i = 0; i < 16; ++i) {
                    const int r = r0 + rb + i, ts = r & (SEQ - 1);
                    const u32x4 vn = *(const u32x4*)(Zb + (size_t)r * DINAB + 8 * lane), cn = *(const u32x4*)(Zb + (size_t)r * DINAB + 512 + 8 * lane);
                    const u32x4 c2 = ring[(i + 15) & 15], c4 = ring[(i + 13) & 15], c8 = ring[(i + 9) & 15], c16 = ring[(i + 1) & 15];
                    u32x4 vo;
                    vo.x = g4 == 0 ? c2.x : g4 == 1 ? c4.x : g4 == 2 ? c8.x : c16.x; vo.y = g4 == 0 ? c2.y : g4 == 1 ? c4.y : g4 == 2 ? c8.y : c16.y;
                    vo.z = g4 == 0 ? c2.z : g4 == 1 ? c4.z : g4 == 2 ? c8.z : c16.z; vo.w = g4 == 0 ? c2.w : g4 == 1 ? c4.w : g4 == 2 ? c8.w : c16.w;
                    ring[i] = vn;
                    const float fn[8] = {bflo(vn.x), bfhi(vn.x), bflo(vn.y), bfhi(vn.y), bflo(vn.z), bfhi(vn.z), bflo(vn.w), bfhi(vn.w)};
                    const float fo[8] = {bflo(vo.x), bfhi(vo.x), bflo(vo.y), bfhi(vo.y), bflo(vo.z), bfhi(vo.z), bflo(vo.w), bfhi(vo.w)};
                    const int cntw = (ts + 1) < w ? (ts + 1) : w;
                    const float inv = __builtin_amdgcn_rcpf((float)cntw);
                    float pz[8];
#pragma unroll
                    for (int q = 0; q < 8; ++q) { sw[q] += fn[q]; pz[q] = sw[q] * inv - fn[q]; sw[q] -= fo[q]; }
                    u32x4 o; o.x = pk2(pz[0], pz[1]); o.y = pk2(pz[2], pz[3]); o.z = pk2(pz[4], pz[5]); o.w = pk2(pz[6], pz[7]);
                    *(u32x4*)(A2b + (size_t)r * 1024 + 8 * lane) = o;
                    float xc[8];
                    const u32x4 t0 = cr[0], t1 = cr[1], t2 = cr[2];
                    const float f0[8] = {bflo(t0.x), bfhi(t0.x), bflo(t0.y), bfhi(t0.y), bflo(t0.z), bfhi(t0.z), bflo(t0.w), bfhi(t0.w)};
                    const float f1[8] = {bflo(t1.x), bfhi(t1.x), bflo(t1.y), bfhi(t1.y), bflo(t1.z), bfhi(t1.z), bflo(t1.w), bfhi(t1.w)};
                    const float f2[8] = {bflo(t2.x), bfhi(t2.x), bflo(t2.y), bfhi(t2.y), bflo(t2.z), bfhi(t2.z), bflo(t2.w), bfhi(t2.w)};
                    const float f3[8] = {bflo(cn.x), bfhi(cn.x), bflo(cn.y), bfhi(cn.y), bflo(cn.z), bfhi(cn.z), bflo(cn.w), bfhi(cn.w)};
#pragma unroll
                    for (int q = 0; q < 8; ++q) xc[q] = cb[q] + f0[q] * cw[0][q] + f1[q] * cw[1][q] + f2[q] * cw[2][q] + f3[q] * cw[3][q];
                    cr[0] = t1; cr[1] = t2; cr[2] = cn;
                    u32x4 o2; o2.x = pk2(xc[0], xc[1]); o2.y = pk2(xc[2], xc[3]); o2.z = pk2(xc[4], xc[5]); o2.w = pk2(xc[6], xc[7]);
                    *(u32x4*)(A2b + (size_t)r * 1024 + 512 + 8 * lane) = o2;
                }
            }
            SEAM(P + 1);
        }
        if (PHEN(4) && odd && IN(P + 1)) {
            PH_LOCALS;
            LAS float* STAT = (LAS float*)lds;
            LAS unsigned char* WSS = lds + 1024;
            LAS unsigned char* VT = lds + 1024 + 34816;
            const float* lng = kin(I_SGLNG) + jj * 1024, * lnb = kin(I_SGLNB) + jj * 1024;
            const bf16_t* WSMp = (const bf16_t*)(ws + WS_WSM) + (size_t)jj * 8 * 128 * 128;
            const float* bs = kin(I_SGBS) + jj * 8 * 128;
            const int fr = lane & 15, fq = lane >> 4;
            for (int it = vcu; it < T / 128; it += G) {
                const size_t row0 = (size_t)it * 128;
#pragma unroll 1
                for (int rb = 0; rb < 2; ++rb) {
                    u32x4 a8[8], b8[8];
#pragma unroll
                    for (int q = 0; q < 8; ++q) { const bf16_t* vp = Zb + (row0 + wave * 16 + rb * 8 + q) * 2048 + 1024; a8[q] = *(const u32x4*)(vp + 8 * lane); b8[q] = *(const u32x4*)(vp + 512 + 8 * lane); }
                    float sm[8], sq[8];
#pragma unroll
                    for (int q = 0; q < 8; ++q) {
                        const float f[16] = {bflo(a8[q].x), bfhi(a8[q].x), bflo(a8[q].y), bfhi(a8[q].y), bflo(a8[q].z), bfhi(a8[q].z), bflo(a8[q].w), bfhi(a8[q].w),
                                             bflo(b8[q].x), bfhi(b8[q].x), bflo(b8[q].y), bfhi(b8[q].y), bflo(b8[q].z), bfhi(b8[q].z), bflo(b8[q].w), bfhi(b8[q].w)};
                        float s1 = 0.f, s2 = 0.f;
#pragma unroll
                        for (int e = 0; e < 16; ++e) { s1 += f[e]; s2 += f[e] * f[e]; }
                        sm[q] = s1; sq[q] = s2;
                    }
#pragma unroll
                    for (int o = 1; o < 64; o <<= 1) {
#pragma unroll
                        for (int q = 0; q < 8; ++q) { sm[q] += __builtin_bit_cast(float, __builtin_amdgcn_ds_bpermute((lane ^ o) << 2, __builtin_bit_cast(int, sm[q])));
                            sq[q] += __builtin_bit_cast(float, __builtin_amdgcn_ds_bpermute((lane ^ o) << 2, __builtin_bit_cast(int, sq[q]))); }
                    }
                    if (lane < 8) { float m_ = sm[0], q_ = sq[0];
#pragma unroll
                        for (int q = 1; q < 8; ++q) { m_ = lane == q ? sm[q] : m_; q_ = lane == q ? sq[q] : q_; }
                        const float mean = m_ * (1.0f / 1024.0f), var = fmaxf(q_ * (1.0f / 1024.0f) - mean * mean, 0.f);
                        const int r = wave * 16 + rb * 8 + lane; STAT[2 * r] = mean; STAT[2 * r + 1] = 1.0f / sqrtf(var + LN_EPS); }
                }
                __syncthreads();
                u32x4 wv[4], vv[4];
#pragma unroll
                for (int i = 0; i < 4; ++i) { const int q = tid + 512 * i, row = q >> 4, c16 = q & 15;
                    wv[i] = *(const u32x4*)(WSMp + ((size_t)0 * 128 + row) * 128 + c16 * 8);
                    vv[i] = *(const u32x4*)(Zb + (row0 + row) * 2048 + 1024 + 0 * 128 + c16 * 8); }
#pragma unroll 1
                for (int hd = 0; hd < 8; ++hd) {
#pragma unroll
                    for (int i = 0; i < 4; ++i) {
                        const int q = tid + 512 * i, row = q >> 4, c16 = q & 15;
                        *(LAS u32x4*)(WSS + row * 272 + c16 * 16) = wv[i];
                        const u32x4 v4 = vv[i];
                        const float mean = STAT[2 * row], rstd = STAT[2 * row + 1];
                        const float f[8] = {bflo(v4.x), bfhi(v4.x), bflo(v4.y), bfhi(v4.y), bflo(v4.z), bfhi(v4.z), bflo(v4.w), bfhi(v4.w)};
                        const f32x4 g0 = *(const f32x4*)(lng + hd * 128 + c16 * 8), g1 = *(const f32x4*)(lng + hd * 128 + c16 * 8 + 4);
                        const f32x4 b0 = *(const f32x4*)(lnb + hd * 128 + c16 * 8), b1 = *(const f32x4*)(lnb + hd * 128 + c16 * 8 + 4);
                        const float gg[8] = {g0[0], g0[1], g0[2], g0[3], g1[0], g1[1], g1[2], g1[3]}, bb[8] = {b0[0], b0[1], b0[2], b0[3], b1[0], b1[1], b1[2], b1[3]};
#pragma unroll
                        for (int q2 = 0; q2 < 8; ++q2) {
                            const int c = c16 * 8 + q2;
                            const int rho = (c & ~31) | (((c >> 2) & 1) << 4) | (((c >> 3) & 3) << 2) | (c & 3);
                            *(LAS bf16_t*)(VT + rho * 272 + row * 2) = (bf16_t)f2bf((f[q2] - mean) * rstd * gg[q2] + bb[q2]);
                        }
                    }
                    const int hn = hd < 7 ? hd + 1 : 7;
#pragma unroll
                    for (int i = 0; i < 4; ++i) { const int q = tid + 512 * i, row = q >> 4, c16 = q & 15;
                        wv[i] = *(const u32x4*)(WSMp + ((size_t)hn * 128 + row) * 128 + c16 * 8);
                        vv[i] = *(const u32x4*)(Zb + (row0 + row) * 2048 + 1024 + hn * 128 + c16 * 8); }
                    const int t = 16 * wave + fr; const float bst = bs[hd * 128 + t];
                    const size_t rowg = row0 + t;
                    u32x4 uv[4];
#pragma unroll
                    for (int q = 0; q < 4; ++q) uv[q] = *(const u32x4*)(Zb + rowg * 2048 + hd * 128 + 32 * q + 8 * fq);
                    __syncthreads();
                    bf16x8 afr[4];
#pragma unroll
                    for (int ks = 0; ks < 4; ++ks) afr[ks] = *(const LAS bf16x8*)(WSS + (16 * wave + fr) * 272 + (32 * ks + 8 * fq) * 2);
                    f32x4 acc[8];
#pragma unroll
                    for (int tn = 0; tn < 8; ++tn) { acc[tn] = (f32x4){0.f, 0.f, 0.f, 0.f};
#pragma unroll
                        for (int ks = 0; ks < 4; ++ks) { const bf16x8 vfr = *(const LAS bf16x8*)(VT + (16 * tn + fr) * 272 + (32 * ks + 8 * fq) * 2);
                            acc[tn] = __builtin_amdgcn_mfma_f32_16x16x32_bf16(vfr, afr[ks], acc[tn], 0, 0, 0); } }
#pragma unroll
                    for (int q = 0; q < 4; ++q) {
                        const int c0 = hd * 128 + 32 * q + 8 * fq;
                        const u32x4 u4 = uv[q];
                        const f32x4 s0 = acc[2 * q] + bst, s1 = acc[2 * q + 1] + bst;
                        u32x4 o; o.x = pk2(bflo(u4.x) * s0[0], bfhi(u4.x) * s0[1]); o.y = pk2(bflo(u4.y) * s0[2], bfhi(u4.y) * s0[3]);
                        o.z = pk2(bflo(u4.z) * s1[0], bfhi(u4.z) * s1[1]); o.w = pk2(bflo(u4.w) * s1[2], bfhi(u4.w) * s1[3]);
                        *(u32x4*)(YMb + rowg * 1024 + c0) = o;
                    }
                    __syncthreads();
                }
            }
            SEAM(P + 1);
        }
        if (PHEN(5) && !odd && IN(P + 2)) {
            PH_LOCALS;
            {
                pg8::Gemm g{A2b, (const bf16_t*)(ws + WS_BPOOL) + (size_t)jj * 512 * 512, 1024, 512, 512, 127};
                pg8::DenseSched S; S.init(T, 512, G, bx);
                pg8::EpiDense<0, false, true> E{YMb, 1024, nullptr, kin(I_POOLS) + jj * 512};
                pg8::gemm_phase<false>(lds, g, S, E, wave0);
            }
            {
                pg8::Gemm g{A2b + 512, (const bf16_t*)(ws + WS_BGATE) + (size_t)jj * 1024 * 512, 1024, 512, 512, 127};
                pg8::DenseSched S; S.init(T, 1024, G, bx);
                pg8::EpiDense<2, true, false> E{RIb, 1024, (const float*)(ws + WS_BIASRI) + jj * 1024, nullptr};
                pg8::gemm_phase<false>(lds, g, S, E, wave0);
            }
            SEAM(P + 2);
        }
        scan_phase<L, 0>(lo, hi, G, bar, wave0); scan_phase<L, 1>(lo, hi, G, bar, wave0);
        if (PHEN(7) && IN(P + 5)) {
            PH_LOCALS;
            const bf16_t* wt = odd ? (const bf16_t*)(ws + WS_SGOUT) + (size_t)jj * 1024 * 1024 : (const bf16_t*)(ws + WS_ABOUT) + (size_t)jj * 1024 * 1024;
            const float* bo = odd ? kin(I_SGBOUT) + jj * 1024 : kin(I_ABBOUT) + jj * 1024;
            pg8::Gemm g{YMb, wt, 1024, 1024, 1024, 127};
            pg8::DenseSched S; S.init(T, 1024, G, bx);
            pg8::EpiDense<0, true, false> E{Yb, 1024, bo, nullptr};
            pg8::gemm_phase<false>(lds, g, S, E, wave0);
            SEAM(P + 5);
        }
        ln_phase<L, 0>(lo, hi, G, bar, wave0);
            if (PHEN(9) && IN(P + 7)) {
            PH_LOCALS;
                pg8::Gemm g{Hb, (const bf16_t*)(ws + WS_BR) + (size_t)l * 256 * 1024, 1024, 1024, 1024, 127};
                pg8::DenseSched S; S.init(T, 256, G, bx);
                pg8::EpiRouter E{LOGf};
                pg8::gemm_phase<false>(lds, g, S, E, wave0);
                SEAM(P + 7);
            }
            if (PHEN(10) && IN(P + 8)) {
            PH_LOCALS;
                volatile LAS unsigned* hist = LCTL + 96; volatile LAS unsigned* basev = LCTL + 128;
                unsigned* gcnt = ctl + CW_CNT + 64 * l;
                for (int t0 = vcu * 512; t0 < T; t0 += G * 512) {
                    if (tid < 32) hist[tid] = 0u;
                    __syncthreads();
                    const int tok = t0 + tid;
                    float lv[32];
                    { const f32x4* lp = (const f32x4*)(LOGf + (size_t)tok * 64);
#pragma unroll
                      for (int q = 0; q < 8; ++q) { const f32x4 a = lp[q], b2 = lp[8 + q], rb = *(const f32x4*)(kin(I_RB) + l * 32 + 4 * q);
                          lv[4 * q + 0] = a[0] + b2[0] + rb[0]; lv[4 * q + 1] = a[1] + b2[1] + rb[1]; lv[4 * q + 2] = a[2] + b2[2] + rb[2]; lv[4 * q + 3] = a[3] + b2[3] + rb[3]; } }
                    float v0 = -3.0e38f, v1 = -3.0e38f, v2 = -3.0e38f, v3 = -3.0e38f; int i0 = 0, i1 = 0, i2 = 0, i3 = 0;
#pragma unroll
                    for (int e = 0; e < 32; ++e) {
                        const float x = lv[e];
                        if (x > v3) {
                            if (x > v0) { v3 = v2; i3 = i2; v2 = v1; i2 = i1; v1 = v0; i1 = i0; v0 = x; i0 = e; }
                            else if (x > v1) { v3 = v2; i3 = i2; v2 = v1; i2 = i1; v1 = x; i1 = e; }
                            else if (x > v2) { v3 = v2; i3 = i2; v2 = x; i2 = e; }
                            else { v3 = x; i3 = e; }
                        }
                    }
                    const float e1 = __expf(v1 - v0), e2 = __expf(v2 - v0), e3 = __expf(v3 - v0), inv = 1.0f / (1.0f + e1 + e2 + e3);
                    *(f32x4*)(TOPG + (size_t)tok * 4) = (f32x4){inv, e1 * inv, e2 * inv, e3 * inv};
                    LAS unsigned* hp = (LAS unsigned*)hist;
                    const unsigned r0 = __hip_atomic_fetch_add(hp + i0, 1u, __ATOMIC_RELAXED, __HIP_MEMORY_SCOPE_WORKGROUP), r1 = __hip_atomic_fetch_add(hp + i1, 1u, __ATOMIC_RELAXED, __HIP_MEMORY_SCOPE_WORKGROUP),
                                   r2 = __hip_atomic_fetch_add(hp + i2, 1u, __ATOMIC_RELAXED, __HIP_MEMORY_SCOPE_WORKGROUP), r3 = __hip_atomic_fetch_add(hp + i3, 1u, __ATOMIC_RELAXED, __HIP_MEMORY_SCOPE_WORKGROUP);
                    __syncthreads();
                    if (tid < 32) basev[tid] = __hip_atomic_fetch_add(gcnt + tid, hist[tid], __ATOMIC_RELAXED, __HIP_MEMORY_SCOPE_AGENT);
                    __syncthreads();
                    LIST[(size_t)i0 * TKTOT + basev[i0] + r0] = tok * 4 + 0;
                    LIST[(size_t)i1 * TKTOT + basev[i1] + r1] = tok * 4 + 1;
                    LIST[(size_t)i2 * TKTOT + basev[i2] + r2] = tok * 4 + 2;
                    LIST[(size_t)i3 * TKTOT + basev[i3] + r3] = tok * 4 + 3;
                    __syncthreads();
                }
                SEAM(P + 8);
            }
            if (PHEN(11) && IN(P + 9)) {
                PH_LOCALS;
                volatile LAS int* cnts = (volatile LAS int*)(LCTL + 16); volatile LAS int* tstart = (volatile LAS int*)(LCTL + 48);
                if (tid < 32) cnts[tid] = (int)__hip_atomic_load(ctl + CW_CNT + 64 * l + tid, __ATOMIC_RELAXED, __HIP_MEMORY_SCOPE_AGENT);
                __syncthreads();
                if (tid == 0) { int s = 0; for (int e = 0; e < 32; ++e) { tstart[e] = s; s += (cnts[e] + 255) >> 8; } tstart[32] = s; }
                __syncthreads();
                LAS int* const utab = (LAS int*)(lds + UTAB_OFF);
                const int nunits = pg8::moe_build_units(utab, tstart, cnts, 8, G, bx, tid);
                __syncthreads();
                pg8::MoeSched S{(const LAS int*)utab, LIST, (const float*)(ws + WS_B1P) + (size_t)l * 32 * 2048, nunits, 2048, 2};
                pg8::EpiMoe1<FP8_M2 != 0> E{FP8_M2 ? (bf16_t*)(ws + WS_ACT8) : ACTb, lds, FP8_M1 ? 1.0f / 32.0f : 1.0f};
                if (FP8_M1) { pg8::Gemm g{ws + WS_H8, ws + WS_W1T8 + (size_t)l * 32 * 2048 * 1024, 1024, 1024, 1024, 122};
                    pg8::gemm_phase<true>(lds, g, S, E, wave0); }
                else { pg8::Gemm g{Hb, (const bf16_t*)(ws + WS_W1T) + (size_t)l * 32 * 2048 * 1024, 1024, 1024, 1024, 127};
                    pg8::gemm_phase<false>(lds, g, S, E, wave0); }
                SEAM(P + 9);
            }
            if (PHEN(12) && IN(P + 10)) {
                PH_LOCALS;
                volatile LAS int* cnts = (volatile LAS int*)(LCTL + 16); volatile LAS int* tstart = (volatile LAS int*)(LCTL + 48);
                __syncthreads();
                if (tid < 32) cnts[tid] = (int)__hip_atomic_load(ctl + CW_CNT + 64 * l + tid, __ATOMIC_RELAXED, __HIP_MEMORY_SCOPE_AGENT);
                __syncthreads();
                if (tid == 0) { int s = 0; for (int e = 0; e < 32; ++e) { tstart[e] = s; s += (cnts[e] + 255) >> 8; } tstart[32] = s; }
                __syncthreads();
                LAS int* const utab = (LAS int*)(lds + UTAB_OFF);
                const int nunits = pg8::moe_build_units(utab, tstart, cnts, 4, G, bx, tid);
                __syncthreads();
                pg8::MoeSched S{(const LAS int*)utab, LIST, kin(I_B2) + (size_t)l * 32 * 1024, nunits, 1024, 0};
                pg8::EpiMoe2 E{YSb, lds, FP8_M2 ? 1.0f / 64.0f : 1.0f};
                if (FP8_M2) { pg8::Gemm g{ws + WS_ACT8, ws + WS_W2T8 + (size_t)l * 32 * 1024 * 1024, 1024, 1024, 1024, 121};
                    pg8::gemm_phase<true>(lds, g, S, E, wave0); }
                else { pg8::Gemm g{ACTb, (const bf16_t*)(ws + WS_W2T) + (size_t)l * 32 * 1024 * 1024, 1024, 1024, 1024, 127};
                    pg8::gemm_phase<false>(lds, g, S, E, wave0); }
                SEAM(P + 10);
            }
        ln_phase<L, 1>(lo, hi, G, bar, wave0);
}

__global__ void __launch_bounds__(512, 2) fwd_kernel(Args args) {
    extern __shared__ __attribute__((aligned(16))) unsigned char lds_raw[];
    LAS unsigned char* const lds = (LAS unsigned char*)lds_raw;
    volatile LAS unsigned* const LCTL = (volatile LAS unsigned*)(lds + LDSCTL_OFF);
    const int G = gridDim.x;
    int lo, hi; unsigned* ctl0;
    { kptr_t kp = (kptr_t)__builtin_amdgcn_kernarg_segment_ptr(); lo = *(const __attribute__((address_space(4))) int*)(kp + 272); hi = *(const __attribute__((address_space(4))) int*)(kp + 276);
      ctl0 = (unsigned*)(*(unsigned char* const __attribute__((address_space(4)))*)(kp + 264) + WS_CTL); }
    const int wave0 = __builtin_amdgcn_readfirstlane((int)threadIdx.x >> 6);
    for (int u = threadIdx.x; u < (LDS_BYTES - LDSCTL_OFF) / 4; u += 512) LCTL[u] = 0u;
    __syncthreads();
    XcdBarrier bar; bar.bar = ctl0 + CW_BAR; bar.x = 0; bar.st = LCTL; bar.wv = wave0;
    if (hi - lo > 1) bar = xcd_barrier_post(ctl0 + CW_BAR, LCTL, wave0);
    if (PHEN(0) && IN(PH_CONV)) {
            PH_LOCALS;
        {
            LAS float* cact = (LAS float*)lds;
            LAS float* part = (LAS float*)(lds + 65536);
            if (bx < 384) {
                for (int i = tid; i < 16 * 1024; i += 512) { const float c = kin(I_C)[i]; cact[i] = c / (1.0f + __expf(-c)); }
                __syncthreads();
                for (int it = bx; it < 384; it += G) {
                    const int ls = it / 48, col0 = (it % 48) * 64;
                    const int kq = tid >> 6, cl = tid & 63;
                    const float* wp = kin(I_MODW) + (size_t)ls * 1024 * 3072 + col0 + cl;
                    float a[16];
#pragma unroll
                    for (int b = 0; b < 16; ++b) a[b] = 0.f;
#pragma unroll 4
                    for (int k = kq * 128; k < kq * 128 + 128; ++k) {
                        const float w = wp[(size_t)k * 3072];
#pragma unroll
                        for (int b = 0; b < 16; ++b) a[b] += cact[b * 1024 + k] * w;
                    }
#pragma unroll
                    for (int b = 0; b < 16; ++b) part[(kq * 16 + b) * 64 + cl] = a[b];
                    __syncthreads();
                    for (int o = tid; o < 1024; o += 512) {
                        const int b = o >> 6, c2 = o & 63; float s = 0.f;
#pragma unroll
                        for (int q = 0; q < 8; ++q) s += part[(q * 16 + b) * 64 + c2];
                        MOD[((size_t)ls * 16 + b) * 3072 + col0 + c2] = s + kin(I_MODB)[ls * 3072 + col0 + c2];
                    }
                    __syncthreads();
                }
            }
        }
        {
            constexpr int IT_ABIN = 2 * 16 * 48, IT_ABOUT = 2 * 16 * 32, IT_SGIN = 2 * 16 * 64, IT_SGOUT = 2 * 16 * 32, IT_W1 = 128 * (FP8_M1 ? 8 : 16) * 64, IT_W2 = 128 * (FP8_M2 ? 8 : 16) * 32;
            constexpr int IT_ALL = IT_ABIN + IT_ABOUT + IT_SGIN + IT_SGOUT + IT_W1 + IT_W2;
            for (int it = gw; it < IT_ALL; it += NGW) {
                int r = it;
                if (r < IT_ABIN) { const int mat = r / (16 * 48); conv_item<false>(kin(I_ABWIN) + (size_t)mat * 1024 * 1536, 1536, (bf16_t*)(ws + WS_ABIN) + (size_t)mat * 1536 * 1024, r % (16 * 48), lane); continue; } r -= IT_ABIN;
                if (r < IT_ABOUT) { const int mat = r / (16 * 32); conv_item<false>(kin(I_ABWOUT) + (size_t)mat * 1024 * 1024, 1024, (bf16_t*)(ws + WS_ABOUT) + (size_t)mat * 1024 * 1024, r % (16 * 32), lane); continue; } r -= IT_ABOUT;
                if (r < IT_SGIN) { const int mat = r / (16 * 64); conv_item<false>(kin(I_SGWIN) + (size_t)mat * 1024 * 2048, 2048, (bf16_t*)(ws + WS_SGIN) + (size_t)mat * 2048 * 1024, r % (16 * 64), lane); continue; } r -= IT_SGIN;
                if (r < IT_SGOUT) { const int mat = r / (16 * 32); conv_item<false>(kin(I_SGWOUT) + (size_t)mat * 1024 * 1024, 1024, (bf16_t*)(ws + WS_SGOUT) + (size_t)mat * 1024 * 1024, r % (16 * 32), lane); continue; } r -= IT_SGOUT;
                if (r < IT_W1) {
                    if (FP8_M1) { const int mat = r / (8 * 64); conv_item_f8<true>(kin(I_W1) + (size_t)mat * 1024 * 2048, 2048, ws + WS_W1T8 + (size_t)mat * 2048 * 1024, r % (8 * 64), lane, 32.0f); }
                    else { const int mat = r / (16 * 64); conv_item<true>(kin(I_W1) + (size_t)mat * 1024 * 2048, 2048, (bf16_t*)(ws + WS_W1T) + (size_t)mat * 2048 * 1024, r % (16 * 64), lane); }
                    continue; } r -= IT_W1;
                if (FP8_M2) { const int mat = r / (8 * 32); conv_item_f8<false>(kin(I_W2) + (size_t)mat * 1024 * 1024, 1024, ws + WS_W2T8 + (size_t)mat * 1024 * 1024, r % (8 * 32), lane, 64.0f); }
                else { const int mat = r / (16 * 32); conv_item<false>(kin(I_W2) + (size_t)mat * 1024 * 1024, 1024, (bf16_t*)(ws + WS_W2T) + (size_t)mat * 1024 * 1024, r % (16 * 32), lane); }
            }
        }
        {
            const int gt = vcu * 512 + tid, NGT = G * 512;
            bf16_t* BR = (bf16_t*)(ws + WS_BR);
            for (int i = gt; i < 4 * 256 * 1024; i += NGT) {
                const int l = i >> 18, n = (i >> 10) & 255, k = i & 1023; unsigned v = 0;
                if (n < 64) { const float w = kin(I_RW)[((size_t)l * 1024 + k) * 32 + (n & 31)]; const unsigned h = f2bf(w); v = h;
                    if (n >= 32) v = f2bf(w - __builtin_bit_cast(float, h << 16)); }
                BR[i] = (bf16_t)v;
            }
            bf16_t* BP = (bf16_t*)(ws + WS_BPOOL);
            for (int i = gt; i < 2 * 512 * 512; i += NGT) {
                const int j = i >> 18, n = (i >> 9) & 511, k = i & 511; unsigned v = 0;
                if ((n >> 7) == (k >> 7)) v = f2bf(kin(I_POOLW)[(((size_t)j * 4 + (n >> 7)) * 128 + (k & 127)) * 128 + (n & 127)]);
                BP[i] = (bf16_t)v;
            }
            bf16_t* BG = (bf16_t*)(ws + WS_BGATE);
            for (int i = gt; i < 2 * 1024 * 512; i += NGT) {
                const int j = i >> 19, n = (i >> 9) & 1023, k = i & 511; unsigned v = 0; const int nn = n & 511;
                if ((nn >> 6) == (k >> 6)) { const float* w = (n < 512) ? kin(I_WA) : kin(I_WX); v = f2bf(w[(((size_t)j * 8 + (nn >> 6)) * 64 + (k & 63)) * 64 + (nn & 63)]); }
                BG[i] = (bf16_t)v;
            }
            bf16_t* WSMp = (bf16_t*)(ws + WS_WSM);
            for (int i = gt; i < 2 * 8 * 128 * 128; i += NGT) {
                const int t = (i >> 7) & 127, s = i & 127; WSMp[i] = (bf16_t)((s <= t) ? f2bf(kin(I_SGWS)[i]) : 0u);
            }
            float* BRI = (float*)(ws + WS_BIASRI);
            for (int i = gt; i < 2 * 1024; i += NGT) { const int j = i >> 10, n = i & 1023; BRI[i] = (n < 512) ? kin(I_BA)[j * 512 + n] : kin(I_BX)[j * 512 + n - 512]; }
            float* B1P = (float*)(ws + WS_B1P);
            for (int i = gt; i < 4 * 32 * 2048; i += NGT) { const int le = i >> 11, rho = i & 2047; B1P[i] = kin(I_B1)[(size_t)le * 2048 + w1_n_of_rho(rho)]; }
        }
        SEAM(PH_CONV);
    }

    if (PHEN(1) && IN(PH_H0)) {
            PH_LOCALS;
        const int rows_per = T / NGW, r0 = gw * rows_per;
        const int b = r0 / SEQ;
        const float* shp = MOD + ((size_t)0 * 16 + b) * 3072, * scp = shp + 1024;
        f32x4 sh[4], sc[4];
#pragma unroll
        for (int j = 0; j < 4; ++j) { sh[j] = *(const f32x4*)(shp + 4 * (64 * j + lane)); sc[j] = *(const f32x4*)(scp + 4 * (64 * j + lane)); }
        for (int r = r0; r < r0 + rows_per; ++r) {
            const f32x4* xr = (const f32x4*)(kin(I_X) + (size_t)r * D) + lane;
            u32x2* hr = (u32x2*)(Hb + (size_t)r * D) + lane;
#pragma unroll
            for (int j = 0; j < 4; ++j) { const f32x4 v = xr[64 * j]; const f32x4 h = v * (sc[j] + 1.0f) + sh[j]; u32x2 w; w.x = pk2(h[0], h[1]); w.y = pk2(h[2], h[3]); hr[64 * j] = w; }
        }
        SEAM(PH_H0);
    }

    layer_body<0>(lds, LCTL, lo, hi, G, bar, wave0); layer_body<1>(lds, LCTL, lo, hi, G, bar, wave0); layer_body<2>(lds, LCTL, lo, hi, G, bar, wave0); layer_body<3>(lds, LCTL, lo, hi, G, bar, wave0);
}
#undef IN
#undef SEAM

#ifdef DUMP_SPEC
struct DumpSrc { size_t off; int ld; int col0; };
__global__ void dump_kernel(const unsigned char* ws, float* out) {
    const DumpSrc srcs[8] = DUMP_SPEC;
    const size_t i = (size_t)blockIdx.x * blockDim.x + threadIdx.x;
    const int r = (int)(i >> 10), c = (int)(i & 1023), blk = c >> 7, cc = c & 127;
    const DumpSrc d = srcs[blk];
    const bf16_t* p = (const bf16_t*)(ws + d.off);
    out[i] = bf2f(p[(size_t)r * d.ld + d.col0 + cc]);
}
#endif
extern "C" void kernel_launch(void* const* d_in, const int* in_sizes, int n_in, void* d_out, int out_size, void* d_ws, size_t ws_size, hipStream_t stream) {
    static int grid = 0;
    if (grid == 0) {
        if (n_in != 32 || out_size != T * D || ws_size < WS_END) { fprintf(stderr, "kernel_launch: unexpected problem (n_in %d, out %d, ws %zu)\n", n_in, out_size, ws_size); grid = -1; return; }
        int dev = 0, cus = 0, per_cu = 0;
        if (hipGetDevice(&dev) != hipSuccess || hipDeviceGetAttribute(&cus, hipDeviceAttributeMultiprocessorCount, dev) != hipSuccess) { grid = -1; return; }
        if (hipFuncSetAttribute((const void*)fwd_kernel, hipFuncAttributeMaxDynamicSharedMemorySize, LDS_BYTES) != hipSuccess) { fprintf(stderr, "kernel_launch: hipFuncSetAttribute failed\n"); grid = -1; return; }
        if (hipOccupancyMaxActiveBlocksPerMultiprocessor(&per_cu, (const void*)fwd_kernel, 512, LDS_BYTES) != hipSuccess || per_cu < 1) fprintf(stderr, "kernel_launch: occupancy query says %d\n", per_cu);
        (void)hipGetLastError();
        grid = cus;
        if (grid * 8 > T || (T % (grid * 8)) != 0) { fprintf(stderr, "kernel_launch: grid %d does not divide the rows\n", grid); grid = -1; return; }
    }
    if (grid < 0) return;
    (void)hipMemsetAsync((char*)d_ws + WS_CTL, 0, CTL_ZERO_BYTES, stream);
    Args a{};
    for (int i = 0; i < 32; ++i) a.in[i] = (const float*)d_in[i];
    a.out = (float*)d_out; a.ws = (unsigned char*)d_ws;
#if MK_ONE_LAUNCH
    a.ph_lo = 0; a.ph_hi = NPH;
    hipLaunchKernelGGL(fwd_kernel, dim3(grid), dim3(512), LDS_BYTES, stream, a);
#else
#ifndef STOP_PH
#define STOP_PH NPH
#endif
    for (int ph = 0; ph < STOP_PH; ++ph) {
        if (!phase_exists(ph)) continue;
        a.ph_lo = ph; a.ph_hi = ph + 1;
        hipLaunchKernelGGL(fwd_kernel, dim3(grid), dim3(512), LDS_BYTES, stream, a);
#ifdef REP_SLOTS
        { const int slot = ph < PH_L0 ? ph : 2 + (ph - PH_L0) % PH_PER_LAYER; if ((REP_SLOTS >> slot) & 1) {
#ifdef PROBE_VARIANTS
            a.variant = PROBE_VARIANTS;
#endif
            hipLaunchKernelGGL(fwd_kernel, dim3(grid), dim3(512), LDS_BYTES, stream, a); a.variant = 0; } }
#endif
    }
#ifdef DUMP_SPEC
    hipLaunchKernelGGL(dump_kernel, dim3(T * 1024 / 256), dim3(256), 0, stream, (const unsigned char*)d_ws, (float*)d_out);
#endif
#endif
}
```

```cpp
#include <hip/hip_runtime.h>
#include <cstdio>
#include <cstdint>

#ifndef PIN_ACC
#define PIN_ACC 0
#endif
#ifndef FP8_M1
#define FP8_M1 1
#endif
#ifndef FP8_M2
#define FP8_M2 1
#endif
#ifndef FP8_YS
#define FP8_YS 1
#endif
#ifndef MK_ONE_LAUNCH
#define MK_ONE_LAUNCH 1
#endif

#ifndef PHMASK
#define PHMASK 0xFFFFF
#endif
#define PHEN(k) (((PHMASK) >> (k)) & 1)
#define LAS __attribute__((address_space(3)))
#define GAS __attribute__((address_space(1)))
typedef unsigned short bf16_t;
typedef short bf16x8 __attribute__((ext_vector_type(8)));
typedef float f32x4 __attribute__((ext_vector_type(4)));
typedef float f32x2 __attribute__((ext_vector_type(2)));
typedef unsigned u32x4 __attribute__((ext_vector_type(4)));
typedef unsigned u32x2 __attribute__((ext_vector_type(2)));

constexpr int D = 1024, NBATCH = 16, SEQ = 4096, T = NBATCH * SEQ, DEPTH = 4;
constexpr int NE = 32, TOPK = 4, TKTOT = T * TOPK;
constexpr int DPOOL = 512, DREC = 512, DINAB = 1536;
constexpr float LN_EPS = 1e-5f;
constexpr float DN_ALPHA = 1.6817928305074292f;

constexpr size_t MiB = 1ull << 20;
constexpr size_t WS_CTL = 0, CTL_ZERO_BYTES = 1 * MiB;
constexpr size_t WS_MOD = 1 * MiB;
constexpr size_t WS_BR = 3 * MiB;
constexpr size_t WS_BPOOL = 5 * MiB;
constexpr size_t WS_BGATE = 6 * MiB;
constexpr size_t WS_WSM = 8 * MiB;
constexpr size_t WS_BIASRI = 8 * MiB + 512 * 1024;
constexpr size_t WS_B1P = 9 * MiB;
constexpr size_t WS_SUMM = 10 * MiB;
constexpr size_t WS_TOPG = 12 * MiB;
constexpr size_t WS_ABIN = 16 * MiB;
constexpr size_t WS_ABOUT = 22 * MiB;
constexpr size_t WS_SGIN = 26 * MiB;
constexpr size_t WS_SGOUT = 34 * MiB;
constexpr size_t WS_LOG = 40 * MiB;
constexpr size_t WS_LIST = 64 * MiB;
constexpr size_t WS_W1T = 128 * MiB;
constexpr size_t WS_W2T = 640 * MiB;
constexpr size_t WS_H = 896 * MiB;
constexpr size_t WS_Z = 1024 * MiB;
constexpr size_t WS_A2 = 1280 * MiB;
constexpr size_t WS_RI = 1408 * MiB;
constexpr size_t WS_YMIX = 1536 * MiB;
constexpr size_t WS_Y = 1664 * MiB;
constexpr size_t WS_ACT = 1792 * MiB;
constexpr size_t WS_YS = 2304 * MiB;
constexpr size_t WS_W1T8 = 2944 * MiB;
constexpr size_t WS_W2T8 = 3200 * MiB;
constexpr size_t WS_H8 = 3328 * MiB;
constexpr size_t WS_ACT8 = 3392 * MiB;
constexpr size_t WS_XB = 2816 * MiB;
constexpr size_t WS_END = 3648 * MiB;

constexpr int CW_BAR = 4096;
constexpr int CW_CNT = 16384;

constexpr int PH_CONV = 0, PH_H0 = 1, PH_L0 = 2, PH_PER_LAYER = 12, NPH = PH_L0 + PH_PER_LAYER * DEPTH;
__host__ __device__ constexpr bool phase_exists(int ph) {
    if (ph < PH_L0) return true;
    const int l = (ph - PH_L0) / PH_PER_LAYER, s = (ph - PH_L0) % PH_PER_LAYER;
    if ((l & 1) && (s == 2 || s == 3 || s == 4)) return false;
    return true;
}

constexpr int LDS_BYTES = 155648;
constexpr int LDSCTL_OFF = 154624;
constexpr int NXT_OFF = 131072;
constexpr int TAB_OFF = 147456;
constexpr int UTAB_OFF = 153600;

__device__ __forceinline__ unsigned f2bf(float f) { unsigned u = __builtin_bit_cast(unsigned, f); return (u + 0x7fffu + ((u >> 16) & 1u)) >> 16; }
typedef __bf16 bf16v2_t __attribute__((ext_vector_type(2)));
__device__ __forceinline__ unsigned pk2(float lo, float hi) { const f32x2 f = {lo, hi}; return __builtin_bit_cast(unsigned, __builtin_convertvector(f, bf16v2_t)); }
__device__ __forceinline__ float bflo(unsigned w) { return __builtin_bit_cast(float, w << 16); }
__device__ __forceinline__ float bfhi(unsigned w) { return __builtin_bit_cast(float, w & 0xffff0000u); }
__device__ __forceinline__ float bf2f(bf16_t h) { return __builtin_bit_cast(float, ((unsigned)h) << 16); }
__device__ __forceinline__ unsigned cvt_pk_bf16(float lo, float hi) { return pk2(lo, hi); }
__device__ __forceinline__ unsigned pk4_fp8(float a, float b, float c, float d) { int w = 0; w = __builtin_amdgcn_cvt_pk_fp8_f32(a, b, w, false); w = __builtin_amdgcn_cvt_pk_fp8_f32(c, d, w, true); return (unsigned)w; }
__device__ __forceinline__ float fast_sigmoid(float x) { return __builtin_amdgcn_rcpf(1.0f + __builtin_amdgcn_exp2f(-1.4426950408889634f * x)); }
__device__ __forceinline__ float gelu_tanh(float x) { const float u = x * (1.5957691216057308f + 0.07135481627362202f * x * x); return x * fast_sigmoid(u); }
__device__ __forceinline__ f32x2 pk_sigmoid_scaled(f32x2 x, float nk) {
    const f32x2 t = x * nk; f32x2 e; e.x = __builtin_amdgcn_exp2f(t.x); e.y = __builtin_amdgcn_exp2f(t.y);
    const f32x2 d = e + 1.0f; f32x2 r; r.x = __builtin_amdgcn_rcpf(d.x); r.y = __builtin_amdgcn_rcpf(d.y); return r; }
__device__ __forceinline__ f32x2 pk_gelu_tanh(f32x2 x) {
    const f32x2 t = x * ((x * x) * (-0.07135481627362202f * 1.4426950408889634f) + (-1.5957691216057308f * 1.4426950408889634f));
    f32x2 e; e.x = __builtin_amdgcn_exp2f(t.x); e.y = __builtin_amdgcn_exp2f(t.y);
    const f32x2 d = e + 1.0f; f32x2 r; r.x = __builtin_amdgcn_rcpf(d.x); r.y = __builtin_amdgcn_rcpf(d.y); return x * r; }
__device__ __forceinline__ float wave_sum(float v, int lane) {
#pragma unroll
    for (int o = 1; o < 64; o <<= 1) v += __builtin_bit_cast(float, __builtin_amdgcn_ds_bpermute((lane ^ o) << 2, __builtin_bit_cast(int, v)));
    return v;
}

__device__ __forceinline__ int lane_id_asm() { int l; asm volatile("v_mbcnt_lo_u32_b32 %0, -1, 0\n\tv_mbcnt_hi_u32_b32 %0, -1, %0" : "=v"(l)); return l; }
#define XB_TMO      128
#define XB_XCNT(j)  (256  + 64 * (j))
#define XB_XSUB(j)  (1280 + 64 * (j))
#define XB_XGEN(j)  (2304 + 64 * (j))
#define XB_TOP      3328
#define XB_TOPGEN   3392
#define XCD_BAR_WORDS 3456
#define XB_SPIN_CAP (1u << 18)

__device__ __forceinline__ unsigned xb_ld(unsigned* p)              { return __hip_atomic_load(p, __ATOMIC_RELAXED, __HIP_MEMORY_SCOPE_AGENT); }
__device__ __forceinline__ unsigned xb_add(unsigned* p, unsigned v) { return __hip_atomic_fetch_add(p, v, __ATOMIC_RELAXED, __HIP_MEMORY_SCOPE_AGENT); }
__device__ __forceinline__ unsigned xb_xcc_id() { return (unsigned)__builtin_amdgcn_s_getreg((3 << 11) | 20) & 0xFu; }
#define XB_SPIN(cond, bar) do { unsigned _sp = 0; while (cond) { __builtin_amdgcn_s_sleep(1); \
    if ((++_sp & 255u) == 0u) { if (xb_ld(&(bar)[XB_TMO])) break; if (_sp > XB_SPIN_CAP) { atomicAdd(&(bar)[XB_TMO], 1u); break; } } } } while (0)

struct XcdBarrier {
    unsigned* bar; unsigned x; int wv;
    volatile LAS unsigned* st;
};

__device__ __forceinline__ XcdBarrier xcd_barrier_post(unsigned* bar, volatile LAS unsigned* st, int wv) {
    XcdBarrier b; b.bar = bar; b.x = xb_xcc_id(); b.st = st; b.wv = wv;
    if (wv == 0 && lane_id_asm() == 0) (void)xb_add(&bar[XB_XCNT(b.x)], 1u);
    return b;
}
__device__ __forceinline__ void xcd_barrier_complete(unsigned* bar, unsigned x, unsigned& nloc, unsigned& nx) {
    const unsigned G = gridDim.x * gridDim.y * gridDim.z;
    unsigned sum, cnt, mine, sp = 0u;
    for (;;) {
        sum = 0u; cnt = 0u; mine = 0u;
#pragma unroll
        for (unsigned j = 0; j < 16; ++j) { const unsigned c = xb_ld(&bar[XB_XCNT(j)]); sum += c; cnt += (c > 0u) ? 1u : 0u; mine = (j == x) ? c : mine; }
        if (sum == G) break;
        __builtin_amdgcn_s_sleep(1);
        if ((++sp & 255u) == 0u) { if (xb_ld(&bar[XB_TMO])) break; if (sp > XB_SPIN_CAP) { atomicAdd(&bar[XB_TMO], 1u); break; } }
    }
    nloc = mine > 0u ? mine : 1u; nx = cnt > 0u ? cnt : 1u;
}

__device__ __forceinline__ void xcd_barrier(const XcdBarrier& b) {
    asm volatile("s_waitcnt vmcnt(0)" ::: "memory");
    __syncthreads();
    if (b.wv == 0 && lane_id_asm() == 0) {
        unsigned* bar = b.bar;
        __builtin_amdgcn_s_waitcnt(0);
        unsigned nloc = b.st[0], nx = b.st[1];
        if (nloc == 0u) { xcd_barrier_complete(bar, b.x, nloc, nx); b.st[0] = nloc; b.st[1] = nx; }
        const unsigned old = xb_add(&bar[XB_XSUB(b.x)], 1u);
        const unsigned gen = old / nloc;
        if (old + 1u == (gen + 1u) * nloc) {
            __builtin_amdgcn_fence(__ATOMIC_RELEASE, "agent");
            asm volatile("s_waitcnt vmcnt(0)" ::: "memory");
            const unsigned og = xb_add(&bar[XB_TOP], 1u);
            const unsigned tg = og / nx;
            if (og + 1u == (tg + 1u) * nx) xb_add(&bar[XB_TOPGEN], 1u);
            else XB_SPIN(xb_ld(&bar[XB_TOPGEN]) == tg, bar);
            __builtin_amdgcn_fence(__ATOMIC_ACQUIRE, "agent");
            xb_add(&bar[XB_XGEN(b.x)], 1u);
            asm volatile("s_waitcnt vmcnt(0)" ::: "memory");
        } else {
            XB_SPIN(xb_ld(&bar[XB_XGEN(b.x)]) == gen, bar);
            __builtin_amdgcn_fence(__ATOMIC_ACQUIRE, "agent");
            asm volatile("s_waitcnt vmcnt(0)" ::: "memory");
        }
    }
    __syncthreads();
}

#ifdef PROBE_VARIANTS
__device__ __forceinline__ int kvariant() { return *(const __attribute__((address_space(4))) int*)((const __attribute__((address_space(4))) unsigned char*)__builtin_amdgcn_kernarg_segment_ptr() + 280); }
#endif
__device__ __forceinline__ void glds16(const char* sbase, unsigned voff, unsigned lds_dst) {
    unsigned keep;
    asm volatile("s_mov_b32 %0, m0\n\ts_mov_b32 m0, %3\n\ts_nop 0\n\tglobal_load_lds_dwordx4 %1, %2\n\ts_mov_b32 m0, %0" : "=&s"(keep) : "v"(voff), "s"(sbase), "s"(lds_dst) : "memory");
}
__device__ __forceinline__ void glds4(const char* sbase, unsigned voff, unsigned lds_dst) {
    unsigned keep;
    asm volatile("s_mov_b32 %0, m0\n\ts_mov_b32 m0, %3\n\ts_nop 0\n\tglobal_load_lds_dword %1, %2\n\ts_mov_b32 m0, %0" : "=&s"(keep) : "v"(voff), "s"(sbase), "s"(lds_dst) : "memory");
}
namespace pg8 {
constexpr int BM = 256, BK = 64, HALF = 128, HTB = HALF * BK * 2, STAGE_BYTES = 8 * HTB, NXCD = 8, WGM = 8;
__host__ __device__ __forceinline__ int perm32(int rho) { const int n = rho >> 4, i = rho & 15; return 8 * (i >> 2) + 4 * n + (i & 3); }

template <bool F8> __host__ __device__ __forceinline__ int chunk_xor(int r15) { const int rp = (r15 >> 1) & 7; return F8 ? ((rp & 4) | ((rp & 1) << 1) | ((rp >> 1) & 1)) : rp; }
struct Unit { int arow, brow, pn, e, rt, cnt, slot, koff; };
struct Gemm { const void* A; const void* Bt; int lda, ldb, K, wscale; };
typedef int i32x4 __attribute__((ext_vector_type(4)));
typedef int i32x8 __attribute__((ext_vector_type(8)));
__device__ __forceinline__ i32x8 cat8(bf16x8 lo, bf16x8 hi) { return __builtin_shufflevector(__builtin_bit_cast(i32x4, lo), __builtin_bit_cast(i32x4, hi), 0, 1, 2, 3, 4, 5, 6, 7); }

struct DenseSched {
    static constexpr bool GATHER = false;
    int nM, nN, nwg, G, c, kblk = 0;
    __device__ __forceinline__ void init(int M, int N, int G_, int c_) { nM = M / BM; nN = N / BM; nwg = nM * nN; G = G_; c = c_; }
    __device__ __forceinline__ bool next(int i, Unit& u) const {
        const long L = (long)i * G + c; if (L >= nwg) return false;
        int wgid = (int)L; { const int q = nwg / NXCD, r = nwg % NXCD, xcd = wgid % NXCD, off = wgid / NXCD; wgid = (xcd < r ? xcd * (q + 1) : r * (q + 1) + (xcd - r) * q) + off; }
        const int nig = WGM * nN, gid = wgid / nig, fm = gid * WGM, gsz = (nM - fm) < WGM ? (nM - fm) : WGM;
        const int pm = fm + ((wgid % nig) % gsz), pn = (wgid % nig) / gsz;
        u.arow = pm * BM; u.brow = pn * BM; u.pn = pn; u.e = 0; u.rt = pm; u.cnt = BM; u.slot = 0; u.koff = (pn & 1) * kblk; return true;
    }
    __device__ __forceinline__ void a_off(const Unit& u, LAS unsigned char*, int R0, int C0, int lda2, unsigned (&off)[2][2]) const {
#pragma unroll
        for (int h = 0; h < 2; ++h)
#pragma unroll
            for (int i = 0; i < 2; ++i) off[h][i] = (unsigned)((u.arow + 128 * h + 64 * i + R0) * lda2 + C0);
    }
};

struct MoeSched {
    static constexpr bool GATHER = true;
    const LAS int* utab;
    const int* list;
    const float* bias;
    int nunits, nexp_rows, shift;
    __device__ __forceinline__ bool next(int i, Unit& u) const {
        if (i >= nunits) return false;
        const LAS int* p = utab + 4 * i;
        u.e = __builtin_amdgcn_readfirstlane(p[0]); u.rt = __builtin_amdgcn_readfirstlane(p[1]); u.pn = __builtin_amdgcn_readfirstlane(p[2]); u.cnt = __builtin_amdgcn_readfirstlane(p[3]);
        u.arow = 0; u.brow = u.e * nexp_rows + u.pn * BM; u.slot = i % 3; u.koff = 0; return true;
    }
    __device__ __forceinline__ void tab_issue(const Unit& u, unsigned ldsb, int wid, int lane) const {
        if (wid < 4) { int p = u.rt * BM + 64 * wid + lane; p = p < u.cnt ? p : u.cnt - 1;
            glds4((const char*)(list + (size_t)u.e * TKTOT), (unsigned)p * 4u, ldsb + TAB_OFF + u.slot * 1024 + wid * 256); }
        else glds4((const char*)(bias + (size_t)u.e * nexp_rows + u.pn * BM), (unsigned)(64 * (wid - 4) + lane) * 4u, ldsb + TAB_OFF + 3072 + u.slot * 1024 + (wid - 4) * 256);
    }
    __device__ __forceinline__ void a_off(const Unit& u, LAS unsigned char* lds, int R0, int C0, int lda2, unsigned (&off)[2][2]) const {
        const LAS int* ids = (const LAS int*)(lds + TAB_OFF + u.slot * 1024);
#pragma unroll
        for (int h = 0; h < 2; ++h)
#pragma unroll
            for (int i = 0; i < 2; ++i) off[h][i] = (unsigned)((ids[128 * h + 64 * i + R0] >> shift) * lda2 + C0);
    }
};
__device__ __forceinline__ int moe_build_units(LAS int* utab, const volatile LAS int* tstart, const volatile LAS int* cnts, int NP, int G, int c, int tid) {
    const int total = tstart[NE] * NP;
    if (tid < 64) { const int L = tid * G + c;
        if (L < total) { int e = 0;
            for (int q = 0; q < NE - 1; ++q) if (tstart[q + 1] * NP <= L) e = q + 1;
            const int t0 = tstart[e], nte = tstart[e + 1] - t0, idx = L - t0 * NP;
            utab[4 * tid + 0] = e; utab[4 * tid + 1] = idx % nte; utab[4 * tid + 2] = idx / nte; utab[4 * tid + 3] = cnts[e]; } }
    return total > c ? (total - c + G - 1) / G : 0;
}

template <int ACT  , bool HAS_BIAS, bool HAS_SCALE> struct EpiDense {
    static constexpr bool PERM = true;
    bf16_t* O; int ldc; const float* bias; const float* scale;
    __device__ __forceinline__ void operator()(const f32x4 (&acc)[2][2][4][2], const Unit& u, int wr, int wc, int fr, int fq) const {
        const int row0 = u.arow + wr * 64 + fr, col0 = u.pn * BM + wc * 32 + 8 * fq;
        f32x4 bv[2][2], sv[2][2];
#pragma unroll
        for (int bj = 0; bj < 2; ++bj)
#pragma unroll
            for (int n = 0; n < 2; ++n) {
                if (HAS_BIAS) bv[bj][n] = *(const f32x4*)(bias + col0 + bj * HALF + 4 * n);
                if (HAS_SCALE) sv[bj][n] = *(const f32x4*)(scale + col0 + bj * HALF + 4 * n);
            }
#pragma unroll
        for (int ai = 0; ai < 2; ++ai)
#pragma unroll
            for (int m = 0; m < 4; ++m) { bf16_t* rowp = O + (size_t)(row0 + ai * HALF + m * 16) * ldc + col0;
#pragma unroll
                for (int bj = 0; bj < 2; ++bj) { f32x4 v0 = acc[ai][bj][m][0], v1 = acc[ai][bj][m][1];
                    if (HAS_BIAS) { v0 = v0 + bv[bj][0]; v1 = v1 + bv[bj][1]; }
                    if (ACT == 1) { const f32x2 a = pk_gelu_tanh((f32x2){v0[0], v0[1]}), b = pk_gelu_tanh((f32x2){v0[2], v0[3]}), c = pk_gelu_tanh((f32x2){v1[0], v1[1]}), d = pk_gelu_tanh((f32x2){v1[2], v1[3]});
                        v0 = (f32x4){a.x, a.y, b.x, b.y}; v1 = (f32x4){c.x, c.y, d.x, d.y}; }
                    if (ACT == 2) { const float nk = -1.4426950408889634f;
                        const f32x2 a = pk_sigmoid_scaled((f32x2){v0[0], v0[1]}, nk), b = pk_sigmoid_scaled((f32x2){v0[2], v0[3]}, nk), c = pk_sigmoid_scaled((f32x2){v1[0], v1[1]}, nk), d = pk_sigmoid_scaled((f32x2){v1[2], v1[3]}, nk);
                        v0 = (f32x4){a.x, a.y, b.x, b.y}; v1 = (f32x4){c.x, c.y, d.x, d.y}; }
                    if (HAS_SCALE) { v0 = v0 * sv[bj][0]; v1 = v1 * sv[bj][1]; }
                    u32x4 w; w.x = cvt_pk_bf16(v0[0], v0[1]); w.y = cvt_pk_bf16(v0[2], v0[3]); w.z = cvt_pk_bf16(v1[0], v1[1]); w.w = cvt_pk_bf16(v1[2], v1[3]);
                    *(u32x4*)(rowp + bj * HALF) = w; } }
    }
};
struct EpiRouter {
    static constexpr bool PERM = false;
    float* LOG;
    __device__ __forceinline__ void operator()(const f32x4 (&acc)[2][2][4][2], const Unit& u, int wr, int wc, int fr, int fq) const {
        if (wc < 2) {
#pragma unroll
            for (int ai = 0; ai < 2; ++ai)
#pragma unroll
                for (int m = 0; m < 4; ++m) { float* rowp = LOG + (size_t)(u.arow + ai * HALF + wr * 64 + m * 16 + fr) * 64 + wc * 32 + 4 * fq;
#pragma unroll
                    for (int n = 0; n < 2; ++n) *(f32x4*)(rowp + 16 * n) = acc[ai][0][m][n]; }
        }
    }
};
template <bool OUT8> struct EpiMoe1 {
    static constexpr bool PERM = false;
    bf16_t* ACT; LAS unsigned char* lds; float oscale;
    __device__ __forceinline__ void operator()(const f32x4 (&acc)[2][2][4][2], const Unit& u, int wr, int wc, int fr, int fq) const {
        const LAS int* ids = (const LAS int*)(lds + TAB_OFF + u.slot * 1024);
        const LAS float* bp = (const LAS float*)(lds + TAB_OFF + 3072 + u.slot * 1024) + wc * 32 + 4 * fq;
        f32x4 bg[2], bl[2];
#pragma unroll
        for (int bj = 0; bj < 2; ++bj) { bg[bj] = *(const LAS f32x4*)(bp + bj * HALF); bl[bj] = *(const LAS f32x4*)(bp + bj * HALF + 16) + 1.0f; }
        const int j0 = u.pn * 128 + wc * 32 + 8 * fq;
#pragma unroll
        for (int ai = 0; ai < 2; ++ai)
#pragma unroll
            for (int m = 0; m < 4; ++m) {
                const int pl = ai * HALF + wr * 64 + m * 16 + fr;
                if (u.rt * BM + pl < u.cnt) {
                    const int flat = ids[pl];
                    float o[8];
#pragma unroll
                    for (int bj = 0; bj < 2; ++bj) { const f32x4 g = acc[ai][bj][m][0] * oscale + bg[bj], l = acc[ai][bj][m][1] * oscale + bl[bj];
#pragma unroll
                        for (int hh = 0; hh < 2; ++hh) {
                            const f32x2 xg = {fminf(g[2 * hh], 7.0f), fminf(g[2 * hh + 1], 7.0f)};
                            const f32x2 xl = {__builtin_amdgcn_fmed3f(l[2 * hh], -6.0f, 8.0f), __builtin_amdgcn_fmed3f(l[2 * hh + 1], -6.0f, 8.0f)};
                            const f32x2 r = pk_sigmoid_scaled(xg, -1.702f * 1.4426950408889634f), oo = (xg * xl) * r;
                            o[bj * 4 + 2 * hh] = oo.x; o[bj * 4 + 2 * hh + 1] = oo.y; } }
                    if constexpr (OUT8) { u32x2 w; w.x = pk4_fp8(o[0], o[1], o[2], o[3]); w.y = pk4_fp8(o[4], o[5], o[6], o[7]);
                        *(u32x2*)((unsigned char*)ACT + (size_t)flat * 1024 + j0) = w; }
                    else { u32x4 w; w.x = cvt_pk_bf16(o[0], o[1]); w.y = cvt_pk_bf16(o[2], o[3]); w.z = cvt_pk_bf16(o[4], o[5]); w.w = cvt_pk_bf16(o[6], o[7]);
                        *(u32x4*)(ACT + (size_t)flat * 1024 + j0) = w; }
                }
            }
    }
};
struct EpiMoe2 {
    static constexpr bool PERM = true;
    bf16_t* YS; LAS unsigned char* lds; float oscale;
    __device__ __forceinline__ void operator()(const f32x4 (&acc)[2][2][4][2], const Unit& u, int wr, int wc, int fr, int fq) const {
        const LAS int* ids = (const LAS int*)(lds + TAB_OFF + u.slot * 1024);
        const LAS float* bp = (const LAS float*)(lds + TAB_OFF + 3072 + u.slot * 1024) + wc * 32 + 8 * fq;
        const int col0 = u.pn * BM + wc * 32 + 8 * fq;
#pragma unroll
        for (int bj = 0; bj < 2; ++bj) {
            const float os = FP8_YS ? 16.0f * oscale : oscale;
            const f32x4 b0 = *(const LAS f32x4*)(bp + bj * HALF) * (FP8_YS ? 16.0f : 1.0f), b1 = *(const LAS f32x4*)(bp + bj * HALF + 4) * (FP8_YS ? 16.0f : 1.0f);
#pragma unroll
            for (int ai = 0; ai < 2; ++ai)
#pragma unroll
                for (int m = 0; m < 4; ++m) {
                    const int pl = ai * HALF + wr * 64 + m * 16 + fr;
                    if (u.rt * BM + pl < u.cnt) {
                        const int flat = ids[pl];
                        const f32x4 v0 = acc[ai][bj][m][0] * os + b0, v1 = acc[ai][bj][m][1] * os + b1;
                        if (FP8_YS) { u32x2 w; w.x = pk4_fp8(v0[0], v0[1], v0[2], v0[3]); w.y = pk4_fp8(v1[0], v1[1], v1[2], v1[3]);
                            *(u32x2*)((unsigned char*)YS + (size_t)flat * 1024 + col0 + bj * HALF) = w; }
                        else { u32x4 w; w.x = cvt_pk_bf16(v0[0], v0[1]); w.y = cvt_pk_bf16(v0[2], v0[3]); w.z = cvt_pk_bf16(v1[0], v1[1]); w.w = cvt_pk_bf16(v1[2], v1[3]);
                            *(u32x4*)(YS + (size_t)flat * 1024 + col0 + bj * HALF) = w; }
                    }
                }
        }
    }
};

template <bool F8, class Epi, class Sched>
__device__ __forceinline__ void gemm_phase(LAS unsigned char* lds, const Gemm g, const Sched& S, const Epi& E, const int wave0) {
    const int tid = (wave0 << 6) | lane_id_asm();
    const int wid = __builtin_amdgcn_readfirstlane(tid >> 6), lane = tid & 63, wr = wid >> 2, wc = wid & 3, fr = lane & 15, fq = lane >> 4;
    constexpr unsigned ESZ = F8 ? 1u : 2u;
    const int nt = (int)((unsigned)g.K * ESZ / 128u);
    int R0, C0;
    R0 = 8 * wid + (lane >> 3); C0 = 16 * ((lane & 7) ^ chunk_xor<F8>(R0 & 15));
    const unsigned lda2 = (unsigned)g.lda * ESZ, ldb2 = (unsigned)g.ldb * ESZ;
    const unsigned voffB = (unsigned)((Epi::PERM ? ((R0 & ~31) + perm32(R0 & 31)) : R0) * (int)ldb2 + C0);
    const unsigned aoffl = (unsigned)(R0 * (int)lda2 + C0);
    const unsigned kstep = 128;
    const size_t hstepB = (size_t)HALF * ldb2;
    const unsigned ldsw = (unsigned)wid * 1024u;
    const int ab = fr * 128 + 16 * ((F8 ? 2 * fq : fq) ^ chunk_xor<F8>(fr));
    const int aoff0 = wr * 8192 + ab, boff0 = wc * 4096 + ab;
    constexpr int KX = F8 ? 16 : 64;
    const char* const Abase = (const char*)g.A;
    const unsigned ldsb = (unsigned)(size_t)lds;
#define PG8_SA(b, h) (((b) * 2 + (h)) * HTB)
#define PG8_SB(b, h) ((4 + (b) * 2 + (h)) * HTB)
#define PG8_GOFF(h, NXT) do { if constexpr (Sched::GATHER) go = *(const LAS u32x2*)(lds + NXT_OFF + ((((NXT) ? ui + 1 : ui) & 1) << 13) + tid * 16 + (h) * 8); } while (0)
#define PG8_STAGE_A(bufoff, h, NXT, kb) do { _Pragma("unroll") for (int _i = 0; _i < 2; ++_i) { \
        if constexpr (Sched::GATHER) glds16(Abase + (kb), _i ? go.y : go.x, ldsb + (bufoff) + ldsw + _i * 8192); \
        else glds16(Abase + ((NXT) ? nxtA : curA) + (size_t)((h) * 128 + _i * 64) * lda2 + (kb), aoffl, ldsb + (bufoff) + ldsw + _i * 8192); } } while (0)
#define PG8_STAGE_B(bufoff, bptr, kb) do { _Pragma("unroll") for (int _i = 0; _i < 2; ++_i) \
        glds16((bptr) + (size_t)(_i * 64) * ldb2 + (kb), voffB, ldsb + (bufoff) + ldsw + _i * 8192); } while (0)
#define PG8_LDA(dst, b, h) do { int _a1 = aoff0 ^ KX; asm volatile("" : "+v"(_a1)); \
        _Pragma("unroll") for (int m = 0; m < 4; ++m) _Pragma("unroll") for (int k = 0; k < 2; ++k) dst[m][k] = *(const LAS bf16x8*)(lds + PG8_SA(b, h) + (k ? _a1 : aoff0) + m * 2048); } while (0)
#define PG8_LDB(dst, b, h) do { int _b1 = boff0 ^ KX; asm volatile("" : "+v"(_b1)); \
        _Pragma("unroll") for (int n = 0; n < 2; ++n) _Pragma("unroll") for (int k = 0; k < 2; ++k) dst[n][k] = *(const LAS bf16x8*)(lds + PG8_SB(b, h) + (k ? _b1 : boff0) + n * 2048); } while (0)
#define PG8_MMA(ai, bj, At, Bt) do { __builtin_amdgcn_s_setprio(1); _Pragma("unroll") for (int m = 0; m < 4; ++m) _Pragma("unroll") for (int n = 0; n < 2; ++n) { \
        if constexpr (F8) acc[ai][bj][m][n] = __builtin_amdgcn_mfma_scale_f32_16x16x128_f8f6f4(cat8(Bt[n][0], Bt[n][1]), cat8(At[m][0], At[m][1]), acc[ai][bj][m][n], 0, 0, 0, 0, 0, 0); \
        else { _Pragma("unroll") for (int k = 0; k < 2; ++k) acc[ai][bj][m][n] = __builtin_amdgcn_mfma_f32_16x16x32_bf16(Bt[n][k], At[m][k], acc[ai][bj][m][n], 0, 0, 0); } } \
        __builtin_amdgcn_s_setprio(0); } while (0)
#define PG8_WAIT_V(n) asm volatile("s_waitcnt vmcnt(" #n ")" ::: "memory")
#define PG8_WAIT_L(n) asm volatile("s_waitcnt lgkmcnt(" #n ")" ::: "memory")
#define PG8_BAR __builtin_amdgcn_s_barrier()
#define PG8_SCHED __builtin_amdgcn_sched_barrier(0)
#define PG8_KITER(k1, b2, NXT, k2, k3) do { \
        PG8_GOFF(1, 0); PG8_LDB(B0, 0, 0); PG8_LDB(B1, 0, 1); PG8_SCHED; PG8_LDA(At, 0, 0); PG8_STAGE_A(PG8_SA(1, 1), 1, 0, (k1)); \
        PG8_WAIT_V(8); PG8_WAIT_L(0); PG8_BAR; PG8_MMA(0, 0, At, B0); PG8_MMA(0, 1, At, B1); PG8_BAR; PG8_SCHED; \
        PG8_GOFF(0, NXT); PG8_LDA(At, 0, 1); PG8_STAGE_B(PG8_SB(0, 0), (b2), (k2)); PG8_STAGE_B(PG8_SB(0, 1), (b2) + hstepB, (k2)); PG8_STAGE_A(PG8_SA(0, 0), 0, NXT, (k2)); \
        PG8_WAIT_V(8); PG8_WAIT_L(0); PG8_BAR; PG8_MMA(1, 0, At, B0); PG8_MMA(1, 1, At, B1); PG8_BAR; PG8_SCHED; \
        PG8_GOFF(1, NXT); PG8_LDB(B0, 1, 0); PG8_LDB(B1, 1, 1); PG8_SCHED; PG8_LDA(At, 1, 0); PG8_STAGE_A(PG8_SA(0, 1), 1, NXT, (k2)); \
        PG8_WAIT_V(8); PG8_WAIT_L(0); PG8_BAR; PG8_MMA(0, 0, At, B0); PG8_MMA(0, 1, At, B1); PG8_BAR; PG8_SCHED; \
        PG8_GOFF(0, NXT); PG8_LDA(At, 1, 1); PG8_STAGE_B(PG8_SB(1, 0), (b2), (k3)); PG8_STAGE_B(PG8_SB(1, 1), (b2) + hstepB, (k3)); PG8_STAGE_A(PG8_SA(1, 0), 0, NXT, (k3)); \
        PG8_WAIT_V(8); PG8_WAIT_L(0); PG8_BAR; PG8_MMA(1, 0, At, B0); PG8_MMA(1, 1, At, B1); PG8_BAR; PG8_SCHED; } while (0)

    Unit cur, nxt; int ui = 0;
    if (!S.next(0, cur)) return;
    unsigned curoff[2][2], nxtoff[2][2];
    size_t curA = 0, nxtA = 0;
    bool has_next = S.next(1, nxt);
#define PG8_NXT_SLOT ((LAS u32x4*)(lds + NXT_OFF) + tid)
    if constexpr (Sched::GATHER) {
        S.tab_issue(cur, ldsb, wid, lane); if (has_next) S.tab_issue(nxt, ldsb, wid, lane);
        asm volatile("s_waitcnt vmcnt(0)" ::: "memory"); __builtin_amdgcn_s_barrier(); asm volatile("" ::: "memory");
        S.a_off(cur, lds, R0, C0, (int)lda2, curoff);
        if (has_next) S.a_off(nxt, lds, R0, C0, (int)lda2, nxtoff);
        else {
#pragma unroll
            for (int h = 0; h < 2; ++h)
#pragma unroll
                for (int i = 0; i < 2; ++i) nxtoff[h][i] = curoff[h][i]; }
        ((LAS u32x4*)(lds + NXT_OFF))[tid] = (u32x4){curoff[0][0], curoff[0][1], curoff[1][0], curoff[1][1]};
        ((LAS u32x4*)(lds + NXT_OFF + 8192))[tid] = (u32x4){nxtoff[0][0], nxtoff[0][1], nxtoff[1][0], nxtoff[1][1]};
    } else { curA = (size_t)cur.arow * lda2 + cur.koff; nxtA = has_next ? (size_t)nxt.arow * lda2 + nxt.koff : curA; }
    f32x4 acc[2][2][4][2];
#pragma unroll
    for (int a = 0; a < 2; ++a)
#pragma unroll
        for (int b = 0; b < 2; ++b)
#pragma unroll
            for (int m = 0; m < 4; ++m)
#pragma unroll
                for (int n = 0; n < 2; ++n) acc[a][b][m][n] = (f32x4){0.f, 0.f, 0.f, 0.f};
    bf16x8 At[4][2], B0[2][2], B1[2][2];
    const char* cB = (const char*)g.Bt + (size_t)cur.brow * ldb2 + cur.koff;
    u32x2 go = {0u, 0u};
    PG8_STAGE_B(PG8_SB(0, 0), cB, 0u); PG8_STAGE_B(PG8_SB(0, 1), cB + hstepB, 0u); PG8_GOFF(0, 0); PG8_STAGE_A(PG8_SA(0, 0), 0, 0, 0u); PG8_GOFF(1, 0); PG8_STAGE_A(PG8_SA(0, 1), 1, 0, 0u);
    if (wr == 1) PG8_BAR;
    PG8_WAIT_V(2); PG8_BAR;
    PG8_GOFF(0, 0); PG8_STAGE_B(PG8_SB(1, 0), cB, kstep); PG8_STAGE_A(PG8_SA(1, 0), 0, 0, kstep); PG8_STAGE_B(PG8_SB(1, 1), cB + hstepB, kstep);
    PG8_WAIT_V(6); PG8_BAR;
    for (;;) {
        const char* nB = has_next ? (const char*)g.Bt + (size_t)nxt.brow * ldb2 + nxt.koff : cB;
        Unit u2; bool has2 = false;
        if constexpr (Sched::GATHER) has2 = has_next && S.next(ui + 2, u2);
#pragma unroll 1
        for (int t = 0; t < nt - 2; t += 2) {
            const unsigned k1 = (unsigned)(t + 1) * kstep, k2 = (unsigned)(t + 2) * kstep, k3 = (unsigned)(t + 3) * kstep;
            if constexpr (Sched::GATHER) { if (t == 2 && has2) S.tab_issue(u2, ldsb, wid, lane); }
            PG8_KITER(k1, cB, 0, k2, k3);
        }
        { const unsigned k1 = (unsigned)(nt - 1) * kstep; PG8_KITER(k1, nB, 1, 0u, kstep); }
#if PIN_ACC
#pragma unroll
        for (int a = 0; a < 2; ++a)
#pragma unroll
            for (int b = 0; b < 2; ++b)
#pragma unroll
                for (int m = 0; m < 4; ++m) asm volatile("" : "+v"(acc[a][b][m][0]), "+v"(acc[a][b][m][1]));
#endif
        if (wr == 0) PG8_BAR;
#ifdef PROBE_VARIANTS
        if (!(kvariant() & 4))
#endif
        { const int l2 = lane_id_asm(); E(acc, cur, wr, wc, l2 & 15, l2 >> 4); }
        if (!has_next) break;
#pragma unroll
        for (int a = 0; a < 2; ++a)
#pragma unroll
            for (int b = 0; b < 2; ++b)
#pragma unroll
                for (int m = 0; m < 4; ++m)
#pragma unroll
                    for (int n = 0; n < 2; ++n) acc[a][b][m][n] = (f32x4){0.f, 0.f, 0.f, 0.f};
        cur = nxt; cB = nB; ++ui; curA = nxtA;
        has_next = S.next(ui + 1, nxt);
        if (has_next) {
            if constexpr (Sched::GATHER) { const int tz = (wave0 << 6) | lane_id_asm(); int R0z, C0z;
                { const int lz = tz & 63; R0z = 8 * wid + (lz >> 3); C0z = 16 * ((lz & 7) ^ chunk_xor<F8>(R0z & 15)); }
                S.a_off(nxt, lds, R0z, C0z, (int)lda2, nxtoff);
                ((LAS u32x4*)(lds + NXT_OFF + (((ui + 1) & 1) << 13)))[tz] = (u32x4){nxtoff[0][0], nxtoff[0][1], nxtoff[1][0], nxtoff[1][1]}; }
            else nxtA = (size_t)nxt.arow * lda2 + nxt.koff;
        } else if constexpr (Sched::GATHER) { const int tz = (wave0 << 6) | lane_id_asm();
            ((LAS u32x4*)(lds + NXT_OFF + (((ui + 1) & 1) << 13)))[tz] = ((const LAS u32x4*)(lds + NXT_OFF + ((ui & 1) << 13)))[tz]; }
        if (wr == 1) PG8_BAR;
    }
    PG8_WAIT_V(0);
    PG8_BAR;
#undef PG8_SA
#undef PG8_SB
#undef PG8_STAGE_A
#undef PG8_GOFF
#undef PG8_STAGE_B
#undef PG8_LDA
#undef PG8_LDB
#undef PG8_MMA
#undef PG8_WAIT_V
#undef PG8_WAIT_L
#undef PG8_BAR
#undef PG8_SCHED
#undef PG8_KITER
#undef PG8_NXT_SLOT
}
}

struct Args { const float* in[32]; float* out; unsigned char* ws; int ph_lo, ph_hi, variant, pad; };
typedef const __attribute__((address_space(4))) unsigned char* kptr_t;
__device__ __forceinline__ const float* kin(int i) { kptr_t p = (kptr_t)__builtin_amdgcn_kernarg_segment_ptr(); asm volatile("" : "+s"(p)); return *(const float* const __attribute__((address_space(4)))*)(p + 8 * i); }
enum { I_X = 0, I_C, I_MODW, I_MODB, I_LNG, I_LNB, I_ABWIN, I_POOLW, I_POOLS, I_CONVW, I_CONVB, I_WA, I_BA, I_WX, I_BX, I_LAM, I_ABWOUT, I_ABBOUT,
       I_SGWIN, I_SGBIN, I_SGLNG, I_SGLNB, I_SGWS, I_SGBS, I_SGWOUT, I_SGBOUT, I_RW, I_RB, I_W1, I_B1, I_W2, I_B2 };

__device__ __forceinline__ int w1_rho(int n) { const int nn = n & 1, j = n >> 1; return ((j >> 7) << 8) | (((j >> 2) & 1) << 7) | (((j >> 5) & 3) << 5) | (nn << 4) | (((j >> 3) & 3) << 2) | (j & 3); }
__device__ __forceinline__ int w1_n_of_rho(int rho) { const int pn = rho >> 8, bj = (rho >> 7) & 1, wc = (rho >> 5) & 3, nn = (rho >> 4) & 1, fq = (rho >> 2) & 3, i = rho & 3; return 2 * (128 * pn + 32 * wc + 8 * fq + 4 * bj + i) + nn; }
template <bool W1MAP>
__device__ __forceinline__ void conv_item(const float* W, int N, bf16_t* WT, int item, int lane) {
    const int nblk = N >> 5, kb = item / nblk, nb = item - kb * nblk;
    const int kg = lane >> 3, nl = lane & 7, k0 = kb * 64 + kg * 8, n0 = nb * 32 + nl * 4;
    f32x4 v[8];
#pragma unroll
    for (int q = 0; q < 8; ++q) v[q] = *(const f32x4*)(W + (size_t)(k0 + q) * N + n0);
#pragma unroll
    for (int i = 0; i < 4; ++i) {
        const int n = n0 + i, row = W1MAP ? w1_rho(n) : n;
        u32x4 o; o.x = pk2(v[0][i], v[1][i]); o.y = pk2(v[2][i], v[3][i]); o.z = pk2(v[4][i], v[5][i]); o.w = pk2(v[6][i], v[7][i]);
        *(u32x4*)(WT + (size_t)row * 1024 + k0) = o;
    }
}

template <bool W1MAP>
__device__ __forceinline__ void conv_item_f8(const float* W, int N, unsigned char* WT8, int item, int lane, float scale) {
    const int nblk = N >> 5, kb = item / nblk, nb = item - kb * nblk;
    const int kg = lane >> 3, nl = lane & 7, k0 = kb * 128 + kg * 16, n0 = nb * 32 + nl * 4;
    f32x4 v[16];
#pragma unroll
    for (int q = 0; q < 16; ++q) v[q] = *(const f32x4*)(W + (size_t)(k0 + q) * N + n0) * scale;
#pragma unroll
    for (int i = 0; i < 4; ++i) {
        const int n = n0 + i, row = W1MAP ? w1_rho(n) : n;
        u32x4 o; o.x = pk4_fp8(v[0][i], v[1][i], v[2][i], v[3][i]); o.y = pk4_fp8(v[4][i], v[5][i], v[6][i], v[7][i]);
        o.z = pk4_fp8(v[8][i], v[9][i], v[10][i], v[11][i]); o.w = pk4_fp8(v[12][i], v[13][i], v[14][i], v[15][i]);
        *(u32x4*)(WT8 + (size_t)row * 1024 + k0) = o;
    }
}

#define IN(k) (lo <= (k) && (k) < hi)
#define SEAM(k) do { if ((k) + 1 < hi) xcd_barrier(bar); } while (0)
#define PH_LOCALS \
    const int tid = (wave0 << 6) | lane_id_asm(); \
    const int lane = tid & 63, wave = wave0; \
    int bx = blockIdx.x; asm volatile("" : "+s"(bx)); \
    const int vcu = (G % 8 == 0) ? (bx % 8) * (G / 8) + bx / 8 : bx; \
    const int gw = vcu * 8 + wave, NGW = G * 8; \
    unsigned char* ws; { kptr_t kp_ = (kptr_t)__builtin_amdgcn_kernarg_segment_ptr(); asm volatile("" : "+s"(kp_)); ws = *(unsigned char* const __attribute__((address_space(4)))*)(kp_ + 264); } \
    float* Xf; { kptr_t kp_ = (kptr_t)__builtin_amdgcn_kernarg_segment_ptr(); asm volatile("" : "+s"(kp_)); Xf = *(float* const __attribute__((address_space(4)))*)(kp_ + 256); } \
    unsigned* const ctl = (unsigned*)(ws + WS_CTL); \
    float* const MOD = (float*)(ws + WS_MOD); bf16_t* const Hb = (bf16_t*)(ws + WS_H); bf16_t* const Zb = (bf16_t*)(ws + WS_Z); bf16_t* const A2b = (bf16_t*)(ws + WS_A2); \
    bf16_t* const RIb = (bf16_t*)(ws + WS_RI); bf16_t* const YMb = (bf16_t*)(ws + WS_YMIX); bf16_t* const Yb = (bf16_t*)(ws + WS_Y); bf16_t* const ACTb = (bf16_t*)(ws + WS_ACT); \
    bf16_t* const YSb = (bf16_t*)(ws + WS_YS); float* const LOGf = (float*)(ws + WS_LOG); float* const TOPG = (float*)(ws + WS_TOPG); int* const LIST = (int*)(ws + WS_LIST); \
    float* const SUMM = (float*)(ws + WS_SUMM); \
    (void)lane; (void)wave; (void)gw; (void)NGW; (void)ctl; (void)MOD; (void)Hb; (void)Zb; (void)A2b; (void)RIb; (void)YMb; (void)Yb; (void)ACTb; (void)YSb; (void)LOGf; (void)TOPG; (void)LIST; (void)SUMM; (void)Xf; (void)vcu


template <int L, int PASS>
__device__ __forceinline__ void scan_phase(const int lo, const int hi, const int G, const XcdBarrier& bar, const int wave0) {
    constexpr int l = L, pass = PASS, P = PH_L0 + PH_PER_LAYER * L, jj = L >> 1; constexpr bool odd = (L & 1) != 0;
            if (PHEN(6) && !odd && IN(P + 3 + pass)) {
            PH_LOCALS;
                for (int it = gw; it < 16 * 32 * 4; it += NGW) {
                    const int b = it >> 7, n = (it >> 2) & 31, cg = it & 3;
                    const int ch = cg * 128 + 2 * lane;
                    float sp[2];
#pragma unroll
                    for (int q = 0; q < 2; ++q) { const float x = -kin(I_LAM)[jj * 512 + ch + q]; sp[q] = 8.0f * 1.4426950408889634f * (fmaxf(x, 0.f) + log1pf(__expf(-fabsf(x)))); }
                    float one = 1.0f; asm volatile("" : "+v"(one));
                    float h0 = 0.f, h1 = 0.f, p0 = one, p1 = one;
                    if (pass == 1) {
#pragma unroll 1
                        for (int m = 0; m < n; ++m) { const f32x4 s = *(const f32x4*)(SUMM + (((size_t)b * 32 + m) * 512 + ch) * 2); h0 = s[0] * h0 + s[1]; h1 = s[2] * h1 + s[3]; }
                    }
                    const size_t row0 = (size_t)b * SEQ + n * 128;
#pragma unroll 4
                    for (int t = 0; t < 128; ++t) {
                        const size_t r = row0 + t;
                        const unsigned rw = *(const unsigned*)(RIb + r * 1024 + ch), iw = *(const unsigned*)(RIb + r * 1024 + 512 + ch), xw = *(const unsigned*)(A2b + r * 1024 + 512 + ch);
                        const float a0 = __builtin_amdgcn_exp2f(-bflo(rw) * sp[0]), a1 = __builtin_amdgcn_exp2f(-bfhi(rw) * sp[1]);
                        const float m0 = __builtin_amdgcn_sqrtf(fmaxf(__builtin_fmaf(-a0, a0, 1.0f), 0.f)), m1 = __builtin_amdgcn_sqrtf(fmaxf(__builtin_fmaf(-a1, a1, 1.0f), 0.f));
                        h0 = a0 * h0 + m0 * (bflo(iw) * bflo(xw)); h1 = a1 * h1 + m1 * (bfhi(iw) * bfhi(xw));
                        if (pass == 0) { p0 *= a0; p1 *= a1; }
                        else { const unsigned gwd = *(const unsigned*)(Zb + r * DINAB + 1024 + ch);
                            *(unsigned*)(YMb + r * 1024 + 512 + ch) = pk2(h0 * gelu_tanh(bflo(gwd)), h1 * gelu_tanh(bfhi(gwd))); }
                    }
                    if (pass == 0) *(f32x4*)(SUMM + (((size_t)b * 32 + n) * 512 + ch) * 2) = (f32x4){p0, h0, p1, h1};
                }
                SEAM(P + 3 + pass);
            }
}

template <int L, int SUB>
__device__ __forceinline__ void ln_phase(const int lo, const int hi, const int G, const XcdBarrier& bar, const int wave0) {
    constexpr int l = L, sub = SUB, P = PH_L0 + PH_PER_LAYER * L; constexpr int ph = SUB == 0 ? P + 6 : P + 11;
    constexpr bool XIN_F32 = (L == 0 && SUB == 0), XOUT_F32 = (L == DEPTH - 1 && SUB == 1);
    if (PHEN(8) && IN(ph)) {
        PH_LOCALS;
        const int rows_per = T / NGW, r0 = gw * rows_per, b = r0 / SEQ;
        constexpr int ls = 2 * l + sub, lsn = ls + 1;
        const float* gp = MOD + ((size_t)ls * 16 + b) * 3072 + 2048;
        const float* lgp = kin(I_LNG) + ls * 1024, * lbp = kin(I_LNB) + ls * 1024;
        constexpr bool has_nextmod = lsn < 2 * DEPTH;
        const float* nsh = MOD + ((size_t)(has_nextmod ? lsn : 0) * 16 + b) * 3072, * nsc = nsh + 1024;
        f32x4 gt[4], lg[4], lb[4], sh[4], sc[4];
#pragma unroll
        for (int j = 0; j < 4; ++j) { const int o = 4 * (64 * j + lane); gt[j] = *(const f32x4*)(gp + o) + 1.0f; lg[j] = *(const f32x4*)(lgp + o); lb[j] = *(const f32x4*)(lbp + o);
            sh[j] = *(const f32x4*)(nsh + o); sc[j] = *(const f32x4*)(nsc + o) + 1.0f; }
        const float* xin32 = kin(I_X);
        bf16_t* const Xb = (bf16_t*)(ws + WS_XB);
        constexpr int RPI = 2;
        for (int r = r0; r < r0 + rows_per; r += RPI) {
            f32x4 xf[XIN_F32 ? RPI : 1][4]; u32x2 xb[XIN_F32 ? 1 : RPI][4]; u32x2 yv[sub == 0 ? RPI : 1][4]; u32x2 ys[sub == 0 ? 1 : RPI][4][4]; f32x4 gk[RPI];
#pragma unroll
            for (int q = 0; q < RPI; ++q) {
                if constexpr (XIN_F32) { const f32x4* xr = (const f32x4*)(xin32 + (size_t)(r + q) * D) + lane;
#pragma unroll
                    for (int j = 0; j < 4; ++j) xf[q][j] = xr[64 * j]; }
                else { const u32x2* xr = (const u32x2*)(Xb + (size_t)(r + q) * D) + lane;
#pragma unroll
                    for (int j = 0; j < 4; ++j) xb[q][j] = xr[64 * j]; }
                if constexpr (sub == 0) { const u32x2* yr = (const u32x2*)(Yb + (size_t)(r + q) * D) + lane;
#pragma unroll
                    for (int j = 0; j < 4; ++j) yv[q][j] = yr[64 * j]; }
                else { gk[q] = *(const f32x4*)(TOPG + (size_t)(r + q) * 4);
#pragma unroll
                    for (int k = 0; k < 4; ++k) {
                        if (FP8_YS) { const unsigned* yr = (const unsigned*)((const unsigned char*)YSb + ((size_t)(r + q) * 4 + k) * D) + lane;
#pragma unroll
                            for (int j = 0; j < 4; ++j) ys[q][k][j].x = yr[64 * j]; }
                        else { const u32x2* yr = (const u32x2*)(YSb + ((size_t)(r + q) * 4 + k) * D) + lane;
#pragma unroll
                            for (int j = 0; j < 4; ++j) ys[q][k][j] = yr[64 * j]; } } }
            }
            f32x4 v[RPI][4]; float s[RPI];
#pragma unroll
            for (int q = 0; q < RPI; ++q) {
                s[q] = 0.f;
#pragma unroll
                for (int j = 0; j < 4; ++j) {
                    f32x4 y, x;
                    if constexpr (XIN_F32) x = xf[q][j]; else x = (f32x4){bflo(xb[q][j].x), bfhi(xb[q][j].x), bflo(xb[q][j].y), bfhi(xb[q][j].y)};
                    if constexpr (sub == 0) y = (f32x4){bflo(yv[q][j].x), bfhi(yv[q][j].x), bflo(yv[q][j].y), bfhi(yv[q][j].y)};
                    else { y = (f32x4){0.f, 0.f, 0.f, 0.f};
#pragma unroll
                        for (int k = 0; k < 4; ++k) { const u32x2 w = ys[q][k][j];
                            if (FP8_YS) { const f32x2 lo2 = __builtin_amdgcn_cvt_pk_f32_fp8((int)w.x, false), hi2 = __builtin_amdgcn_cvt_pk_f32_fp8((int)w.x, true);
                                y = y + (f32x4){lo2.x, lo2.y, hi2.x, hi2.y} * (gk[q][k] * 0.0625f); }
                            else y = y + (f32x4){bflo(w.x), bfhi(w.x), bflo(w.y), bfhi(w.y)} * gk[q][k]; } }
                    v[q][j] = x * DN_ALPHA + gt[j] * y;
                    s[q] += (v[q][j][0] + v[q][j][1]) + (v[q][j][2] + v[q][j][3]);
                }
            }
#pragma unroll
            for (int o = 1; o < 64; o <<= 1) {
#pragma unroll
                for (int q = 0; q < RPI; ++q) s[q] += __builtin_bit_cast(float, __builtin_amdgcn_ds_bpermute((lane ^ o) << 2, __builtin_bit_cast(int, s[q])));
            }
            float s2[RPI];
#pragma unroll
            for (int q = 0; q < RPI; ++q) { const float mean = s[q] * (1.0f / D); s2[q] = 0.f;
#pragma unroll
                for (int j = 0; j < 4; ++j) { v[q][j] = v[q][j] - mean; s2[q] += (v[q][j][0] * v[q][j][0] + v[q][j][1] * v[q][j][1]) + (v[q][j][2] * v[q][j][2] + v[q][j][3] * v[q][j][3]); } }
#pragma unroll
            for (int o = 1; o < 64; o <<= 1) {
#pragma unroll
                for (int q = 0; q < RPI; ++q) s2[q] += __builtin_bit_cast(float, __builtin_amdgcn_ds_bpermute((lane ^ o) << 2, __builtin_bit_cast(int, s2[q])));
            }
#pragma unroll
            for (int q = 0; q < RPI; ++q) {
                const float rstd = 1.0f / sqrtf(s2[q] * (1.0f / D) + LN_EPS);
                u32x2* hr = (u32x2*)(Hb + (size_t)(r + q) * D) + lane;
#pragma unroll
                for (int j = 0; j < 4; ++j) { const f32x4 xn = v[q][j] * rstd * lg[j] + lb[j];
                    if (XOUT_F32) ((f32x4*)(Xf + (size_t)(r + q) * D) + lane)[64 * j] = xn;
                    else { u32x2 w; w.x = pk2(xn[0], xn[1]); w.y = pk2(xn[2], xn[3]); ((u32x2*)(Xb + (size_t)(r + q) * D) + lane)[64 * j] = w; }
                    if (has_nextmod) { const f32x4 h = xn * sc[j] + sh[j]; u32x2 w; w.x = pk2(h[0], h[1]); w.y = pk2(h[2], h[3]); hr[64 * j] = w;
                        if (FP8_M1 && sub == 0) ((unsigned*)(ws + WS_H8 + (size_t)(r + q) * D) + lane)[64 * j] = pk4_fp8(h[0], h[1], h[2], h[3]); } }
            }
        }
        if (ph + 1 < NPH) SEAM(ph);
    }
}

template <int L>
__device__ __forceinline__ void layer_body(LAS unsigned char* const lds, volatile LAS unsigned* const LCTL, const int lo, const int hi, const int G, const XcdBarrier& bar, const int wave0) {
    constexpr int l = L;
        const int P = PH_L0 + PH_PER_LAYER * l, jj = l >> 1;
        const bool odd = (l & 1) != 0;
        if (PHEN(2) && IN(P + 0)) {
            PH_LOCALS;
            if (!odd) {
                pg8::Gemm g{Hb, (const bf16_t*)(ws + WS_ABIN) + (size_t)jj * 1536 * 1024, 1024, 1024, 1024, 127};
                pg8::DenseSched S; S.init(T, 1536, G, bx);
                pg8::EpiDense<0, false, false> E{Zb, 1536, nullptr, nullptr};
                pg8::gemm_phase<false>(lds, g, S, E, wave0);
            } else {
                pg8::Gemm g{Hb, (const bf16_t*)(ws + WS_SGIN) + (size_t)jj * 2048 * 1024, 1024, 1024, 1024, 127};
                pg8::DenseSched S; S.init(T, 2048, G, bx);
                pg8::EpiDense<1, true, false> E{Zb, 2048, kin(I_SGBIN) + jj * 2048, nullptr};
                pg8::gemm_phase<false>(lds, g, S, E, wave0);
            }
            SEAM(P + 0);
        }
        if (PHEN(3) && !odd && IN(P + 1)) {
            PH_LOCALS;
            const int rows_per = T / NGW, r0 = gw * rows_per;
            const int g4 = lane >> 4, w = 2 << g4;
            float cw[4][8], cb[8];
#pragma unroll
            for (int k = 0; k < 4; ++k)
#pragma unroll
                for (int q = 0; q < 8; ++q) cw[k][q] = kin(I_CONVW)[((size_t)jj * 4 + k) * 512 + 8 * lane + q];
#pragma unroll
            for (int q = 0; q < 8; ++q) cb[q] = kin(I_CONVB)[jj * 512 + 8 * lane + q];
            const int ts0 = r0 & (SEQ - 1);
            u32x4 ring[16], cr[3];
            float sw[8];
#pragma unroll
            for (int q = 0; q < 8; ++q) sw[q] = 0.f;
#pragma unroll
            for (int d = 0; d < 16; ++d) {
                const int k = 15 - d;
                u32x4 v = {0u, 0u, 0u, 0u};
                if (ts0 > d) v = *(const u32x4*)(Zb + (size_t)(r0 - 1 - d) * DINAB + 8 * lane);
                ring[k] = v;
                if (d + 1 < w) { const float f[8] = {bflo(v.x), bfhi(v.x), bflo(v.y), bfhi(v.y), bflo(v.z), bfhi(v.z), bflo(v.w), bfhi(v.w)};
#pragma unroll
                    for (int q = 0; q < 8; ++q) sw[q] += f[q]; }
            }
#pragma unroll
            for (int d = 0; d < 3; ++d) { u32x4 v = {0u, 0u, 0u, 0u}; if (ts0 > d) v = *(const u32x4*)(Zb + (size_t)(r0 - 1 - d) * DINAB + 512 + 8 * lane); cr[2 - d] = v; }
#pragma unroll 1
            for (int rb = 0; rb < rows_per; rb += 16) {
#pragma unroll
                for (int i = 0; i < 16; ++i) {
                    const int r = r0 + rb + i, ts = r & (SEQ - 1);
                    const u32x4 vn = *(const u32x4*)(Zb + (size_t)r * DINAB + 8 * lane), cn = *(const u32x4*)(Zb + (size_t)r * DINAB + 512 + 8 * lane);
                    const u32x4 c2 = ring[(i + 15) & 15], c4 = ring[(i + 13) & 15], c8 = ring[(i + 9) & 15], c16 = ring[(i + 1) & 15];
                    u32x4 vo;
                    vo.x = g4 == 0 ? c2.x : g4 == 1 ? c4.x : g4 == 2 ? c8.x : c16.x; vo.y = g4 == 0 ? c2.y : g4 == 1 ? c4.y : g4 == 2 ? c8.y : c16.y;
                    vo.z = g4 == 0 ? c2.z : g4 == 1 ? c4.z : g4 == 2 ? c8.z : c16.z; vo.w = g4 == 0 ? c2.w : g4 == 1 ? c4.w : g4 == 2 ? c8.w : c16.w;
                    ring[i] = vn;
                    const float fn[8] = {bflo(vn.x), bfhi(vn.x), bflo(vn.y), bfhi(vn.y), bflo(vn.z), bfhi(vn.z), bflo(vn.w), bfhi(vn.w)};
                    const float fo[8] = {bflo(vo.x), bfhi(vo.x), bflo(vo.y), bfhi(vo.y), bflo(vo.z), bfhi(vo.z), bflo(vo.w), bfhi(vo.w)};
                    const int cntw = (ts + 1) < w ? (ts + 1) : w;
                    const float inv = __builtin_amdgcn_rcpf((float)cntw);
                    float pz[8];
#pragma unroll
                    for (int q = 0; q < 8; ++q) { sw[q] += fn[q]; pz[q] = sw[q] * inv - fn[q]; sw[q] -= fo[q]; }
                    u32x4 o; o.x = pk2(pz[0], pz[1]); o.y = pk2(pz[2], pz[3]); o.z = pk2(pz[4], pz[5]); o.w = pk2(pz[6], pz[7]);
                    *(u32x4*)(A2b + (size_t)r * 1024 + 8 * lane) = o;
                    float xc[8];
                    const u32x4 t0 = cr[0], t1 = cr[1], t2 = cr[2];
                    const float f0[8] = {bflo(t0.x), bfhi(t0.x), bflo(t0.y), bfhi(t0.y), bflo(t0.z), bfhi(t0.z), bflo(t0.w), bfhi(t0.w)};
                    const float f1[8] = {bflo(t1.x), bfhi(t1.x), bflo(t1.y), bfhi(t1.y), bflo(t1.z), bfhi(t1.z), bflo(t1.w), bfhi(t1.w)};
                    const float f2[8] = {bflo(t2.x), bfhi(t2.x), bflo(t2.y), bfhi(t2.y), bflo(t2.z), bfhi(t2.z), bflo(t2.w), bfhi(t2.w)};
                    const float f3[8] = {bflo(cn.x), bfhi(cn.x), bflo(cn.y), bfhi(cn.y), bflo(cn.z), bfhi(cn.z), bflo(cn.w), bfhi(cn.w)};
#pragma unroll
                    for (int q = 0; q < 8; ++q) xc[q] = cb[q] + f0[q] * cw[0][q] + f1[q] * cw[1][q] + f2[q] * cw[2][q] + f3[q] * cw[3][q];
                    cr[0] = t1; cr[1] = t2; cr[2] = cn;
                    u32x4 o2; o2.x = pk2(xc[0], xc[1]); o2.y = pk2(xc[2], xc[3]); o2.z = pk2(xc[4], xc[5]); o2.w = pk2(xc[6], xc[7]);
                    *(u32x4*)(A2b + (size_t)r * 1024 + 512 + 8 * lane) = o2;
                }
            }
            SEAM(P + 1);
        }
        if (PHEN(4) && odd && IN(P + 1)) {
            PH_LOCALS;
            LAS float* STAT = (LAS float*)lds;
            LAS unsigned char* WSS = lds + 1024;
            LAS unsigned char* VT = lds + 1024 + 34816;
            const float* lng = kin(I_SGLNG) + jj * 1024, * lnb = kin(I_SGLNB) + jj * 1024;
            const bf16_t* WSMp = (const bf16_t*)(ws + WS_WSM) + (size_t)jj * 8 * 128 * 128;
            const float* bs = kin(I_SGBS) + jj * 8 * 128;
            const int fr = lane & 15, fq = lane >> 4;
            for (int it = vcu; it < T / 128; it += G) {
                const size_t row0 = (size_t)it * 128;
#pragma unroll 1
                for (int rb = 0; rb < 2; ++rb) {
                    u32x4 a8[8], b8[8];
#pragma unroll
                    for (int q = 0; q < 8; ++q) { const bf16_t* vp = Zb + (row0 + wave * 16 + rb * 8 + q) * 2048 + 1024; a8[q] = *(const u32x4*)(vp + 8 * lane); b8[q] = *(const u32x4*)(vp + 512 + 8 * lane); }
                    float sm[8], sq[8];
#pragma unroll
                    for (int q = 0; q < 8; ++q) {
                        const float f[16] = {bflo(a8[q].x), bfhi(a8[q].x), bflo(a8[q].y), bfhi(a8[q].y), bflo(a8[q].z), bfhi(a8[q].z), bflo(a8[q].w), bfhi(a8[q].w),
                                             bflo(b8[q].x), bfhi(b8[q].x), bflo(b8[q].y), bfhi(b8[q].y), bflo(b8[q].z), bfhi(b8[q].z), bflo(b8[q].w), bfhi(b8[q].w)};
                        float s1 = 0.f, s2 = 0.f;
#pragma unroll
                        for (int e = 0; e < 16; ++e) { s1 += f[e]; s2 += f[e] * f[e]; }
                        sm[q] = s1; sq[q] = s2;
                    }
#pragma unroll
                    for (int o = 1; o < 64; o <<= 1) {
#pragma unroll
                        for (int q = 0; q < 8; ++q) { sm[q] += __builtin_bit_cast(float, __builtin_amdgcn_ds_bpermute((lane ^ o) << 2, __builtin_bit_cast(int, sm[q])));
                            sq[q] += __builtin_bit_cast(float, __builtin_amdgcn_ds_bpermute((lane ^ o) << 2, __builtin_bit_cast(int, sq[q]))); }
                    }
                    if (lane < 8) { float m_ = sm[0], q_ = sq[0];
#pragma unroll
                        for (int q = 1; q < 8; ++q) { m_ = lane == q ? sm[q] : m_; q_ = lane == q ? sq[q] : q_; }
                        const float mean = m_ * (1.0f / 1024.0f), var = fmaxf(q_ * (1.0f / 1024.0f) - mean * mean, 0.f);
                        const int r = wave * 16 + rb * 8 + lane; STAT[2 * r] = mean; STAT[2 * r + 1] = 1.0f / sqrtf(var + LN_EPS); }
                }
                __syncthreads();
                u32x4 wv[4], vv[4];
#pragma unroll
                for (int i = 0; i < 4; ++i) { const int q = tid + 512 * i, row = q >> 4, c16 = q & 15;
                    wv[i] = *(const u32x4*)(WSMp + ((size_t)0 * 128 + row) * 128 + c16 * 8);
                    vv[i] = *(const u32x4*)(Zb + (row0 + row) * 2048 + 1024 + 0 * 128 + c16 * 8); }
#pragma unroll 1
                for (int hd = 0; hd < 8; ++hd) {
#pragma unroll
                    for (int i = 0; i < 4; ++i) {
                        const int q = tid + 512 * i, row = q >> 4, c16 = q & 15;
                        *(LAS u32x4*)(WSS + row * 272 + c16 * 16) = wv[i];
                        const u32x4 v4 = vv[i];
                        const float mean = STAT[2 * row], rstd = STAT[2 * row + 1];
                        const float f[8] = {bflo(v4.x), bfhi(v4.x), bflo(v4.y), bfhi(v4.y), bflo(v4.z), bfhi(v4.z), bflo(v4.w), bfhi(v4.w)};
                        const f32x4 g0 = *(const f32x4*)(lng + hd * 128 + c16 * 8), g1 = *(const f32x4*)(lng + hd * 128 + c16 * 8 + 4);
                        const f32x4 b0 = *(const f32x4*)(lnb + hd * 128 + c16 * 8), b1 = *(const f32x4*)(lnb + hd * 128 + c16 * 8 + 4);
                        const float gg[8] = {g0[0], g0[1], g0[2], g0[3], g1[0], g1[1], g1[2], g1[3]}, bb[8] = {b0[0], b0[1], b0[2], b0[3], b1[0], b1[1], b1[2], b1[3]};
#pragma unroll
                        for (int q2 = 0; q2 < 8; ++q2) {
                            const int c = c16 * 8 + q2;
                            const int rho = (c & ~31) | (((c >> 2) & 1) << 4) | (((c >> 3) & 3) << 2) | (c & 3);
                            *(LAS bf16_t*)(VT + rho * 272 + row * 2) = (bf16_t)f2bf((f[q2] - mean) * rstd * gg[q2] + bb[q2]);
                        }
                    }
                    const int hn = hd < 7 ? hd + 1 : 7;
#pragma unroll
                    for (int i = 0; i < 4; ++i) { const int q = tid + 512 * i, row = q >> 4, c16 = q & 15;
                        wv[i] = *(const u32x4*)(WSMp + ((size_t)hn * 128 + row) * 128 + c16 * 8);
                        vv[i] = *(const u32x4*)(Zb + (row0 + row) * 2048 + 1024 + hn * 128 + c16 * 8); }
                    const int t = 16 * wave + fr; const float bst = bs[hd * 128 + t];
                    const size_t rowg = row0 + t;
                    u32x4 uv[4];
#pragma unroll
                    for (int q = 0; q < 4; ++q) uv[q] = *(const u32x4*)(Zb + rowg * 2048 + hd * 128 + 32 * q + 8 * fq);
                    __syncthreads();
                    bf16x8 afr[4];
#pragma unroll
                    for (int ks = 0; ks < 4; ++ks) afr[ks] = *(const LAS bf16x8*)(WSS + (16 * wave + fr) * 272 + (32 * ks + 8 * fq) * 2);
                    f32x4 acc[8];
#pragma unroll
                    for (int tn = 0; tn < 8; ++tn) { acc[tn] = (f32x4){0.f, 0.f, 0.f, 0.f};
#pragma unroll
                        for (int ks = 0; ks < 4; ++ks) { const bf16x8 vfr = *(const LAS bf16x8*)(VT + (16 * tn + fr) * 272 + (32 * ks + 8 * fq) * 2);
                            acc[tn] = __builtin_amdgcn_mfma_f32_16x16x32_bf16(vfr, afr[ks], acc[tn], 0, 0, 0); } }
#pragma unroll
                    for (int q = 0; q < 4; ++q) {
                        const int c0 = hd * 128 + 32 * q + 8 * fq;
                        const u32x4 u4 = uv[q];
                        const f32x4 s0 = acc[2 * q] + bst, s1 = acc[2 * q + 1] + bst;
                        u32x4 o; o.x = pk2(bflo(u4.x) * s0[0], bfhi(u4.x) * s0[1]); o.y = pk2(bflo(u4.y) * s0[2], bfhi(u4.y) * s0[3]);
                        o.z = pk2(bflo(u4.z) * s1[0], bfhi(u4.z) * s1[1]); o.w = pk2(bflo(u4.w) * s1[2], bfhi(u4.w) * s1[3]);
                        *(u32x4*)(YMb + rowg * 1024 + c0) = o;
                    }
                    __syncthreads();
                }
            }
            SEAM(P + 1);
        }
        if (PHEN(5) && !odd && IN(P + 2)) {
            PH_LOCALS;
            {
                pg8::Gemm g{A2b, (const bf16_t*)(ws + WS_BPOOL) + (size_t)jj * 512 * 512, 1024, 512, 256, 127};
                pg8::DenseSched S; S.init(T, 512, G, bx); S.kblk = 512;
                pg8::EpiDense<0, false, true> E{YMb, 1024, nullptr, kin(I_POOLS) + jj * 512};
                pg8::gemm_phase<false>(lds, g, S, E, wave0);
            }
            {
                pg8::Gemm g{A2b + 512, (const bf16_t*)(ws + WS_BGATE) + (size_t)jj * 1024 * 512, 1024, 512, 256, 127};
                pg8::DenseSched S; S.init(T, 1024, G, bx); S.kblk = 512;
                pg8::EpiDense<2, true, false> E{RIb, 1024, (const float*)(ws + WS_BIASRI) + jj * 1024, nullptr};
                pg8::gemm_phase<false>(lds, g, S, E, wave0);
            }
            SEAM(P + 2);
        }
        scan_phase<L, 0>(lo, hi, G, bar, wave0); scan_phase<L, 1>(lo, hi, G, bar, wave0);
        if (PHEN(7) && IN(P + 5)) {
            PH_LOCALS;
            const bf16_t* wt = odd ? (const bf16_t*)(ws + WS_SGOUT) + (size_t)jj * 1024 * 1024 : (const bf16_t*)(ws + WS_ABOUT) + (size_t)jj * 1024 * 1024;
            const float* bo = odd ? kin(I_SGBOUT) + jj * 1024 : kin(I_ABBOUT) + jj * 1024;
            pg8::Gemm g{YMb, wt, 1024, 1024, 1024, 127};
            pg8::DenseSched S; S.init(T, 1024, G, bx);
            pg8::EpiDense<0, true, false> E{Yb, 1024, bo, nullptr};
            pg8::gemm_phase<false>(lds, g, S, E, wave0);
            SEAM(P + 5);
        }
        ln_phase<L, 0>(lo, hi, G, bar, wave0);
            if (PHEN(9) && IN(P + 7)) {
            PH_LOCALS;
                pg8::Gemm g{Hb, (const bf16_t*)(ws + WS_BR) + (size_t)l * 256 * 1024, 1024, 1024, 1024, 127};
                pg8::DenseSched S; S.init(T, 256, G, bx);
                pg8::EpiRouter E{LOGf};
                pg8::gemm_phase<false>(lds, g, S, E, wave0);
                SEAM(P + 7);
            }
            if (PHEN(10) && IN(P + 8)) {
            PH_LOCALS;
                volatile LAS unsigned* hist = LCTL + 96; volatile LAS unsigned* basev = LCTL + 128;
                unsigned* gcnt = ctl + CW_CNT + 64 * l;
                for (int t0 = vcu * 512; t0 < T; t0 += G * 512) {
                    if (tid < 32) hist[tid] = 0u;
                    __syncthreads();
                    const int tok = t0 + tid;
                    float lv[32];
                    { const f32x4* lp = (const f32x4*)(LOGf + (size_t)tok * 64);
#pragma unroll
                      for (int q = 0; q < 8; ++q) { const f32x4 a = lp[q], b2 = lp[8 + q], rb = *(const f32x4*)(kin(I_RB) + l * 32 + 4 * q);
                          lv[4 * q + 0] = a[0] + b2[0] + rb[0]; lv[4 * q + 1] = a[1] + b2[1] + rb[1]; lv[4 * q + 2] = a[2] + b2[2] + rb[2]; lv[4 * q + 3] = a[3] + b2[3] + rb[3]; } }
                    float v0 = -3.0e38f, v1 = -3.0e38f, v2 = -3.0e38f, v3 = -3.0e38f; int i0 = 0, i1 = 0, i2 = 0, i3 = 0;
#pragma unroll
                    for (int e = 0; e < 32; ++e) {
                        const float x = lv[e];
                        if (x > v3) {
                            if (x > v0) { v3 = v2; i3 = i2; v2 = v1; i2 = i1; v1 = v0; i1 = i0; v0 = x; i0 = e; }
                            else if (x > v1) { v3 = v2; i3 = i2; v2 = v1; i2 = i1; v1 = x; i1 = e; }
                            else if (x > v2) { v3 = v2; i3 = i2; v2 = x; i2 = e; }
                            else { v3 = x; i3 = e; }
                        }
                    }
                    const float e1 = __expf(v1 - v0), e2 = __expf(v2 - v0), e3 = __expf(v3 - v0), inv = 1.0f / (1.0f + e1 + e2 + e3);
                    *(f32x4*)(TOPG + (size_t)tok * 4) = (f32x4){inv, e1 * inv, e2 * inv, e3 * inv};
                    LAS unsigned* hp = (LAS unsigned*)hist;
                    const unsigned r0 = __hip_atomic_fetch_add(hp + i0, 1u, __ATOMIC_RELAXED, __HIP_MEMORY_SCOPE_WORKGROUP), r1 = __hip_atomic_fetch_add(hp + i1, 1u, __ATOMIC_RELAXED, __HIP_MEMORY_SCOPE_WORKGROUP),
                                   r2 = __hip_atomic_fetch_add(hp + i2, 1u, __ATOMIC_RELAXED, __HIP_MEMORY_SCOPE_WORKGROUP), r3 = __hip_atomic_fetch_add(hp + i3, 1u, __ATOMIC_RELAXED, __HIP_MEMORY_SCOPE_WORKGROUP);
                    __syncthreads();
                    if (tid < 32) basev[tid] = __hip_atomic_fetch_add(gcnt + tid, hist[tid], __ATOMIC_RELAXED, __HIP_MEMORY_SCOPE_AGENT);
                    __syncthreads();
                    LIST[(size_t)i0 * TKTOT + basev[i0] + r0] = tok * 4 + 0;
                    LIST[(size_t)i1 * TKTOT + basev[i1] + r1] = tok * 4 + 1;
                    LIST[(size_t)i2 * TKTOT + basev[i2] + r2] = tok * 4 + 2;
                    LIST[(size_t)i3 * TKTOT + basev[i3] + r3] = tok * 4 + 3;
                    __syncthreads();
                }
                SEAM(P + 8);
            }
            if (PHEN(11) && IN(P + 9)) {
                PH_LOCALS;
                volatile LAS int* cnts = (volatile LAS int*)(LCTL + 16); volatile LAS int* tstart = (volatile LAS int*)(LCTL + 48);
                if (tid < 32) cnts[tid] = (int)__hip_atomic_load(ctl + CW_CNT + 64 * l + tid, __ATOMIC_RELAXED, __HIP_MEMORY_SCOPE_AGENT);
                __syncthreads();
                if (tid == 0) { int s = 0; for (int e = 0; e < 32; ++e) { tstart[e] = s; s += (cnts[e] + 255) >> 8; } tstart[32] = s; }
                __syncthreads();
                LAS int* const utab = (LAS int*)(lds + UTAB_OFF);
                const int nunits = pg8::moe_build_units(utab, tstart, cnts, 8, G, bx, tid);
                __syncthreads();
                pg8::MoeSched S{(const LAS int*)utab, LIST, (const float*)(ws + WS_B1P) + (size_t)l * 32 * 2048, nunits, 2048, 2};
                pg8::EpiMoe1<FP8_M2 != 0> E{FP8_M2 ? (bf16_t*)(ws + WS_ACT8) : ACTb, lds, FP8_M1 ? 1.0f / 32.0f : 1.0f};
                if (FP8_M1) { pg8::Gemm g{ws + WS_H8, ws + WS_W1T8 + (size_t)l * 32 * 2048 * 1024, 1024, 1024, 1024, 122};
                    pg8::gemm_phase<true>(lds, g, S, E, wave0); }
                else { pg8::Gemm g{Hb, (const bf16_t*)(ws + WS_W1T) + (size_t)l * 32 * 2048 * 1024, 1024, 1024, 1024, 127};
                    pg8::gemm_phase<false>(lds, g, S, E, wave0); }
                SEAM(P + 9);
            }
            if (PHEN(12) && IN(P + 10)) {
                PH_LOCALS;
                volatile LAS int* cnts = (volatile LAS int*)(LCTL + 16); volatile LAS int* tstart = (volatile LAS int*)(LCTL + 48);
                __syncthreads();
                if (tid < 32) cnts[tid] = (int)__hip_atomic_load(ctl + CW_CNT + 64 * l + tid, __ATOMIC_RELAXED, __HIP_MEMORY_SCOPE_AGENT);
                __syncthreads();
                if (tid == 0) { int s = 0; for (int e = 0; e < 32; ++e) { tstart[e] = s; s += (cnts[e] + 255) >> 8; } tstart[32] = s; }
                __syncthreads();
                LAS int* const utab = (LAS int*)(lds + UTAB_OFF);
                const int nunits = pg8::moe_build_units(utab, tstart, cnts, 4, G, bx, tid);
                __syncthreads();
                pg8::MoeSched S{(const LAS int*)utab, LIST, kin(I_B2) + (size_t)l * 32 * 1024, nunits, 1024, 0};
                pg8::EpiMoe2 E{YSb, lds, FP8_M2 ? 1.0f / 64.0f : 1.0f};
                if (FP8_M2) { pg8::Gemm g{ws + WS_ACT8, ws + WS_W2T8 + (size_t)l * 32 * 1024 * 1024, 1024, 1024, 1024, 121};
                    pg8::gemm_phase<true>(lds, g, S, E, wave0); }
                else { pg8::Gemm g{ACTb, (const bf16_t*)(ws + WS_W2T) + (size_t)l * 32 * 1024 * 1024, 1024, 1024, 1024, 127};
                    pg8::gemm_phase<false>(lds, g, S, E, wave0); }
                SEAM(P + 10);
            }
        ln_phase<L, 1>(lo, hi, G, bar, wave0);
}

__global__ void __launch_bounds__(512, 2) fwd_kernel(Args args) {
    extern __shared__ __attribute__((aligned(16))) unsigned char lds_raw[];
    LAS unsigned char* const lds = (LAS unsigned char*)lds_raw;
    volatile LAS unsigned* const LCTL = (volatile LAS unsigned*)(lds + LDSCTL_OFF);
    const int G = gridDim.x;
    int lo, hi; unsigned* ctl0;
    { kptr_t kp = (kptr_t)__builtin_amdgcn_kernarg_segment_ptr(); lo = *(const __attribute__((address_space(4))) int*)(kp + 272); hi = *(const __attribute__((address_space(4))) int*)(kp + 276);
      ctl0 = (unsigned*)(*(unsigned char* const __attribute__((address_space(4)))*)(kp + 264) + WS_CTL); }
    const int wave0 = __builtin_amdgcn_readfirstlane((int)threadIdx.x >> 6);
    for (int u = threadIdx.x; u < (LDS_BYTES - LDSCTL_OFF) / 4; u += 512) LCTL[u] = 0u;
    __syncthreads();
    XcdBarrier bar; bar.bar = ctl0 + CW_BAR; bar.x = 0; bar.st = LCTL; bar.wv = wave0;
    if (hi - lo > 1) bar = xcd_barrier_post(ctl0 + CW_BAR, LCTL, wave0);
    if (PHEN(0) && IN(PH_CONV)) {
            PH_LOCALS;
        {
            LAS float* cact = (LAS float*)lds;
            LAS float* part = (LAS float*)(lds + 65536);
            if (bx < 384) {
                for (int i = tid; i < 16 * 1024; i += 512) { const float c = kin(I_C)[i]; cact[i] = c / (1.0f + __expf(-c)); }
                __syncthreads();
                for (int it = bx; it < 384; it += G) {
                    const int ls = it / 48, col0 = (it % 48) * 64;
                    const int kq = tid >> 6, cl = tid & 63;
                    const float* wp = kin(I_MODW) + (size_t)ls * 1024 * 3072 + col0 + cl;
                    float a[16];
#pragma unroll
                    for (int b = 0; b < 16; ++b) a[b] = 0.f;
#pragma unroll 4
                    for (int k = kq * 128; k < kq * 128 + 128; ++k) {
                        const float w = wp[(size_t)k * 3072];
#pragma unroll
                        for (int b = 0; b < 16; ++b) a[b] += cact[b * 1024 + k] * w;
                    }
#pragma unroll
                    for (int b = 0; b < 16; ++b) part[(kq * 16 + b) * 64 + cl] = a[b];
                    __syncthreads();
                    for (int o = tid; o < 1024; o += 512) {
                        const int b = o >> 6, c2 = o & 63; float s = 0.f;
#pragma unroll
                        for (int q = 0; q < 8; ++q) s += part[(q * 16 + b) * 64 + c2];
                        MOD[((size_t)ls * 16 + b) * 3072 + col0 + c2] = s + kin(I_MODB)[ls * 3072 + col0 + c2];
                    }
                    __syncthreads();
                }
            }
        }
        {
            constexpr int IT_ABIN = 2 * 16 * 48, IT_ABOUT = 2 * 16 * 32, IT_SGIN = 2 * 16 * 64, IT_SGOUT = 2 * 16 * 32, IT_W1 = 128 * (FP8_M1 ? 8 : 16) * 64, IT_W2 = 128 * (FP8_M2 ? 8 : 16) * 32;
            constexpr int IT_ALL = IT_ABIN + IT_ABOUT + IT_SGIN + IT_SGOUT + IT_W1 + IT_W2;
            for (int it = gw; it < IT_ALL; it += NGW) {
                int r = it;
                if (r < IT_ABIN) { const int mat = r / (16 * 48); conv_item<false>(kin(I_ABWIN) + (size_t)mat * 1024 * 1536, 1536, (bf16_t*)(ws + WS_ABIN) + (size_t)mat * 1536 * 1024, r % (16 * 48), lane); continue; } r -= IT_ABIN;
                if (r < IT_ABOUT) { const int mat = r / (16 * 32); conv_item<false>(kin(I_ABWOUT) + (size_t)mat * 1024 * 1024, 1024, (bf16_t*)(ws + WS_ABOUT) + (size_t)mat * 1024 * 1024, r % (16 * 32), lane); continue; } r -= IT_ABOUT;
                if (r < IT_SGIN) { const int mat = r / (16 * 64); conv_item<false>(kin(I_SGWIN) + (size_t)mat * 1024 * 2048, 2048, (bf16_t*)(ws + WS_SGIN) + (size_t)mat * 2048 * 1024, r % (16 * 64), lane); continue; } r -= IT_SGIN;
                if (r < IT_SGOUT) { const int mat = r / (16 * 32); conv_item<false>(kin(I_SGWOUT) + (size_t)mat * 1024 * 1024, 1024, (bf16_t*)(ws + WS_SGOUT) + (size_t)mat * 1024 * 1024, r % (16 * 32), lane); continue; } r -= IT_SGOUT;
                if (r < IT_W1) {
                    if (FP8_M1) { const int mat = r / (8 * 64); conv_item_f8<true>(kin(I_W1) + (size_t)mat * 1024 * 2048, 2048, ws + WS_W1T8 + (size_t)mat * 2048 * 1024, r % (8 * 64), lane, 32.0f); }
                    else { const int mat = r / (16 * 64); conv_item<true>(kin(I_W1) + (size_t)mat * 1024 * 2048, 2048, (bf16_t*)(ws + WS_W1T) + (size_t)mat * 2048 * 1024, r % (16 * 64), lane); }
                    continue; } r -= IT_W1;
                if (FP8_M2) { const int mat = r / (8 * 32); conv_item_f8<false>(kin(I_W2) + (size_t)mat * 1024 * 1024, 1024, ws + WS_W2T8 + (size_t)mat * 1024 * 1024, r % (8 * 32), lane, 64.0f); }
                else { const int mat = r / (16 * 32); conv_item<false>(kin(I_W2) + (size_t)mat * 1024 * 1024, 1024, (bf16_t*)(ws + WS_W2T) + (size_t)mat * 1024 * 1024, r % (16 * 32), lane); }
            }
        }
        {
            const int gt = vcu * 512 + tid, NGT = G * 512;
            bf16_t* BR = (bf16_t*)(ws + WS_BR);
            for (int i = gt; i < 4 * 256 * 1024; i += NGT) {
                const int l = i >> 18, n = (i >> 10) & 255, k = i & 1023; unsigned v = 0;
                if (n < 64) { const float w = kin(I_RW)[((size_t)l * 1024 + k) * 32 + (n & 31)]; const unsigned h = f2bf(w); v = h;
                    if (n >= 32) v = f2bf(w - __builtin_bit_cast(float, h << 16)); }
                BR[i] = (bf16_t)v;
            }
            bf16_t* BP = (bf16_t*)(ws + WS_BPOOL);
            for (int i = gt; i < 2 * 512 * 512; i += NGT) {
                const int j = i >> 18, n = (i >> 9) & 511, k = i & 511; unsigned v = 0;
                if ((n >> 7) == (k >> 7)) v = f2bf(kin(I_POOLW)[(((size_t)j * 4 + (n >> 7)) * 128 + (k & 127)) * 128 + (n & 127)]);
                BP[i] = (bf16_t)v;
            }
            bf16_t* BG = (bf16_t*)(ws + WS_BGATE);
            for (int i = gt; i < 2 * 1024 * 512; i += NGT) {
                const int j = i >> 19, n = (i >> 9) & 1023, k = i & 511; unsigned v = 0; const int nn = n & 511;
                if ((nn >> 6) == (k >> 6)) { const float* w = (n < 512) ? kin(I_WA) : kin(I_WX); v = f2bf(w[(((size_t)j * 8 + (nn >> 6)) * 64 + (k & 63)) * 64 + (nn & 63)]); }
                BG[i] = (bf16_t)v;
            }
            bf16_t* WSMp = (bf16_t*)(ws + WS_WSM);
            for (int i = gt; i < 2 * 8 * 128 * 128; i += NGT) {
                const int t = (i >> 7) & 127, s = i & 127; WSMp[i] = (bf16_t)((s <= t) ? f2bf(kin(I_SGWS)[i]) : 0u);
            }
            float* BRI = (float*)(ws + WS_BIASRI);
            for (int i = gt; i < 2 * 1024; i += NGT) { const int j = i >> 10, n = i & 1023; BRI[i] = (n < 512) ? kin(I_BA)[j * 512 + n] : kin(I_BX)[j * 512 + n - 512]; }
            float* B1P = (float*)(ws + WS_B1P);
            for (int i = gt; i < 4 * 32 * 2048; i += NGT) { const int le = i >> 11, rho = i & 2047; B1P[i] = kin(I_B1)[(size_t)le * 2048 + w1_n_of_rho(rho)]; }
        }
        SEAM(PH_CONV);
    }

    if (PHEN(1) && IN(PH_H0)) {
            PH_LOCALS;
        const int rows_per = T / NGW, r0 = gw * rows_per;
        const int b = r0 / SEQ;
        const float* shp = MOD + ((size_t)0 * 16 + b) * 3072, * scp = shp + 1024;
        f32x4 sh[4], sc[4];
#pragma unroll
        for (int j = 0; j < 4; ++j) { sh[j] = *(const f32x4*)(shp + 4 * (64 * j + lane)); sc[j] = *(const f32x4*)(scp + 4 * (64 * j + lane)); }
        for (int r = r0; r < r0 + rows_per; ++r) {
            const f32x4* xr = (const f32x4*)(kin(I_X) + (size_t)r * D) + lane;
            u32x2* hr = (u32x2*)(Hb + (size_t)r * D) + lane;
#pragma unroll
            for (int j = 0; j < 4; ++j) { const f32x4 v = xr[64 * j]; const f32x4 h = v * (sc[j] + 1.0f) + sh[j]; u32x2 w; w.x = pk2(h[0], h[1]); w.y = pk2(h[2], h[3]); hr[64 * j] = w; }
        }
        SEAM(PH_H0);
    }

    layer_body<0>(lds, LCTL, lo, hi, G, bar, wave0); layer_body<1>(lds, LCTL, lo, hi, G, bar, wave0); layer_body<2>(lds, LCTL, lo, hi, G, bar, wave0); layer_body<3>(lds, LCTL, lo, hi, G, bar, wave0);
}
#undef IN
#undef SEAM

#ifdef DUMP_SPEC
struct DumpSrc { size_t off; int ld; int col0; };
__global__ void dump_kernel(const unsigned char* ws, float* out) {
    const DumpSrc srcs[8] = DUMP_SPEC;
    const size_t i = (size_t)blockIdx.x * blockDim.x + threadIdx.x;
    const int r = (int)(i >> 10), c = (int)(i & 1023), blk = c >> 7, cc = c & 127;
    const DumpSrc d = srcs[blk];
    const bf16_t* p = (const bf16_t*)(ws + d.off);
    out[i] = bf2f(p[(size_t)r * d.ld + d.col0 + cc]);
}
#endif
extern "C" void kernel_launch(void* const* d_in, const int* in_sizes, int n_in, void* d_out, int out_size, void* d_ws, size_t ws_size, hipStream_t stream) {
    static int grid = 0;
    if (grid == 0) {
        if (n_in != 32 || out_size != T * D || ws_size < WS_END) { fprintf(stderr, "kernel_launch: unexpected problem (n_in %d, out %d, ws %zu)\n", n_in, out_size, ws_size); grid = -1; return; }
        int dev = 0, cus = 0, per_cu = 0;
        if (hipGetDevice(&dev) != hipSuccess || hipDeviceGetAttribute(&cus, hipDeviceAttributeMultiprocessorCount, dev) != hipSuccess) { grid = -1; return; }
        if (hipFuncSetAttribute((const void*)fwd_kernel, hipFuncAttributeMaxDynamicSharedMemorySize, LDS_BYTES) != hipSuccess) { fprintf(stderr, "kernel_launch: hipFuncSetAttribute failed\n"); grid = -1; return; }
        if (hipOccupancyMaxActiveBlocksPerMultiprocessor(&per_cu, (const void*)fwd_kernel, 512, LDS_BYTES) != hipSuccess || per_cu < 1) fprintf(stderr, "kernel_launch: occupancy query says %d\n", per_cu);
        (void)hipGetLastError();
        grid = cus;
        if (grid * 8 > T || (T % (grid * 8)) != 0) { fprintf(stderr, "kernel_launch: grid %d does not divide the rows\n", grid); grid = -1; return; }
    }
    if (grid < 0) return;
    (void)hipMemsetAsync((char*)d_ws + WS_CTL, 0, CTL_ZERO_BYTES, stream);
    Args a{};
    for (int i = 0; i < 32; ++i) a.in[i] = (const float*)d_in[i];
    a.out = (float*)d_out; a.ws = (unsigned char*)d_ws;
#if MK_ONE_LAUNCH
    a.ph_lo = 0; a.ph_hi = NPH;
    hipLaunchKernelGGL(fwd_kernel, dim3(grid), dim3(512), LDS_BYTES, stream, a);
#else
#ifndef STOP_PH
#define STOP_PH NPH
#endif
    for (int ph = 0; ph < STOP_PH; ++ph) {
        if (!phase_exists(ph)) continue;
        a.ph_lo = ph; a.ph_hi = ph + 1;
        hipLaunchKernelGGL(fwd_kernel, dim3(grid), dim3(512), LDS_BYTES, stream, a);
#ifdef REP_SLOTS
        { const int slot = ph < PH_L0 ? ph : 2 + (ph - PH_L0) % PH_PER_LAYER; if ((REP_SLOTS >> slot) & 1) {
#ifdef PROBE_VARIANTS
            a.variant = PROBE_VARIANTS;
#endif
            hipLaunchKernelGGL(fwd_kernel, dim3(grid), dim3(512), LDS_BYTES, stream, a); a.variant = 0; } }
#endif
    }
#ifdef DUMP_SPEC
    hipLaunchKernelGGL(dump_kernel, dim3(T * 1024 / 256), dim3(256), 0, stream, (const unsigned char*)d_ws, (float*)d_out);
#endif
#endif
}
```

```cpp
#include <hip/hip_runtime.h>
#include <cstdio>
#include <cstdint>

#ifndef PIN_ACC
#define PIN_ACC 0
#endif
#ifndef FP8_M1
#define FP8_M1 1
#endif
#ifndef FP8_M2
#define FP8_M2 1
#endif
#ifndef FP8_YS
#define FP8_INP 0
#define FP8_OUTP 1
#define FP8_YS 1
#endif
#ifndef MK_ONE_LAUNCH
#define MK_ONE_LAUNCH 1
#endif

#ifndef PHMASK
#define PHMASK 0xFFFFF
#endif
#define PHEN(k) (((PHMASK) >> (k)) & 1)
#define LAS __attribute__((address_space(3)))
#define GAS __attribute__((address_space(1)))
typedef unsigned short bf16_t;
typedef short bf16x8 __attribute__((ext_vector_type(8)));
typedef float f32x4 __attribute__((ext_vector_type(4)));
typedef float f32x2 __attribute__((ext_vector_type(2)));
typedef unsigned u32x4 __attribute__((ext_vector_type(4)));
typedef unsigned u32x2 __attribute__((ext_vector_type(2)));

constexpr int D = 1024, NBATCH = 16, SEQ = 4096, T = NBATCH * SEQ, DEPTH = 4;
constexpr int NE = 32, TOPK = 4, TKTOT = T * TOPK;
constexpr int DPOOL = 512, DREC = 512, DINAB = 1536;
constexpr float LN_EPS = 1e-5f;
constexpr float DN_ALPHA = 1.6817928305074292f;

constexpr size_t MiB = 1ull << 20;
constexpr size_t WS_CTL = 0, CTL_ZERO_BYTES = 1 * MiB;
constexpr size_t WS_MOD = 1 * MiB;
constexpr size_t WS_BR = 3 * MiB;
constexpr size_t WS_BPOOL = 5 * MiB;
constexpr size_t WS_BGATE = 6 * MiB;
constexpr size_t WS_WSM = 8 * MiB;
constexpr size_t WS_BIASRI = 8 * MiB + 512 * 1024;
constexpr size_t WS_B1P = 9 * MiB;
constexpr size_t WS_SUMM = 10 * MiB;
constexpr size_t WS_TOPG = 12 * MiB;
constexpr size_t WS_ABIN = 16 * MiB;
constexpr size_t WS_ABOUT = 22 * MiB;
constexpr size_t WS_SGIN = 26 * MiB;
constexpr size_t WS_SGOUT = 34 * MiB;
constexpr size_t WS_LOG = 40 * MiB;
constexpr size_t WS_LIST = 64 * MiB;
constexpr size_t WS_W1T = 128 * MiB;
constexpr size_t WS_W2T = 640 * MiB;
constexpr size_t WS_H = 896 * MiB;
constexpr size_t WS_Z = 1024 * MiB;
constexpr size_t WS_A2 = 1280 * MiB;
constexpr size_t WS_RI = 1408 * MiB;
constexpr size_t WS_YMIX = 1536 * MiB;
constexpr size_t WS_Y = 1664 * MiB;
constexpr size_t WS_ACT = 1792 * MiB;
constexpr size_t WS_YS = 2304 * MiB;
constexpr size_t WS_W1T8 = 2944 * MiB;
constexpr size_t WS_W2T8 = 3200 * MiB;
constexpr size_t WS_H8 = 3328 * MiB;
constexpr size_t WS_ACT8 = 3392 * MiB;
constexpr size_t WS_XB = 2816 * MiB;
constexpr size_t WS_END = 3648 * MiB;

constexpr int CW_BAR = 4096;
constexpr int CW_CNT = 16384;

constexpr int PH_CONV = 0, PH_H0 = 1, PH_L0 = 2, PH_PER_LAYER = 12, NPH = PH_L0 + PH_PER_LAYER * DEPTH;
__host__ __device__ constexpr bool phase_exists(int ph) {
    if (ph < PH_L0) return true;
    const int l = (ph - PH_L0) / PH_PER_LAYER, s = (ph - PH_L0) % PH_PER_LAYER;
    if ((l & 1) && (s == 2 || s == 3 || s == 4)) return false;
    return true;
}

constexpr int LDS_BYTES = 155648;
constexpr int LDSCTL_OFF = 154624;
constexpr int NXT_OFF = 131072;
constexpr int TAB_OFF = 147456;
constexpr int UTAB_OFF = 153600;

__device__ __forceinline__ unsigned f2bf(float f) { unsigned u = __builtin_bit_cast(unsigned, f); return (u + 0x7fffu + ((u >> 16) & 1u)) >> 16; }
typedef __bf16 bf16v2_t __attribute__((ext_vector_type(2)));
__device__ __forceinline__ unsigned pk2(float lo, float hi) { const f32x2 f = {lo, hi}; return __builtin_bit_cast(unsigned, __builtin_convertvector(f, bf16v2_t)); }
__device__ __forceinline__ float bflo(unsigned w) { return __builtin_bit_cast(float, w << 16); }
__device__ __forceinline__ float bfhi(unsigned w) { return __builtin_bit_cast(float, w & 0xffff0000u); }
__device__ __forceinline__ float bf2f(bf16_t h) { return __builtin_bit_cast(float, ((unsigned)h) << 16); }
__device__ __forceinline__ unsigned cvt_pk_bf16(float lo, float hi) { return pk2(lo, hi); }
__device__ __forceinline__ unsigned pk4_fp8(float a, float b, float c, float d) { int w = 0; w = __builtin_amdgcn_cvt_pk_fp8_f32(a, b, w, false); w = __builtin_amdgcn_cvt_pk_fp8_f32(c, d, w, true); return (unsigned)w; }
__device__ __forceinline__ float fast_sigmoid(float x) { return __builtin_amdgcn_rcpf(1.0f + __builtin_amdgcn_exp2f(-1.4426950408889634f * x)); }
__device__ __forceinline__ float gelu_tanh(float x) { const float u = x * (1.5957691216057308f + 0.07135481627362202f * x * x); return x * fast_sigmoid(u); }
__device__ __forceinline__ f32x2 pk_sigmoid_scaled(f32x2 x, float nk) {
    const f32x2 t = x * nk; f32x2 e; e.x = __builtin_amdgcn_exp2f(t.x); e.y = __builtin_amdgcn_exp2f(t.y);
    const f32x2 d = e + 1.0f; f32x2 r; r.x = __builtin_amdgcn_rcpf(d.x); r.y = __builtin_amdgcn_rcpf(d.y); return r; }
__device__ __forceinline__ f32x2 pk_gelu_tanh(f32x2 x) {
    const f32x2 t = x * ((x * x) * (-0.07135481627362202f * 1.4426950408889634f) + (-1.5957691216057308f * 1.4426950408889634f));
    f32x2 e; e.x = __builtin_amdgcn_exp2f(t.x); e.y = __builtin_amdgcn_exp2f(t.y);
    const f32x2 d = e + 1.0f; f32x2 r; r.x = __builtin_amdgcn_rcpf(d.x); r.y = __builtin_amdgcn_rcpf(d.y); return x * r; }
__device__ __forceinline__ float wave_sum(float v, int lane) {
#pragma unroll
    for (int o = 1; o < 64; o <<= 1) v += __builtin_bit_cast(float, __builtin_amdgcn_ds_bpermute((lane ^ o) << 2, __builtin_bit_cast(int, v)));
    return v;
}

__device__ __forceinline__ int lane_id_asm() { int l; asm volatile("v_mbcnt_lo_u32_b32 %0, -1, 0\n\tv_mbcnt_hi_u32_b32 %0, -1, %0" : "=v"(l)); return l; }
#define XB_TMO      128
#define XB_XCNT(j)  (256  + 64 * (j))
#define XB_XSUB(j)  (1280 + 64 * (j))
#define XB_XGEN(j)  (2304 + 64 * (j))
#define XB_TOP      3328
#define XB_TOPGEN   3392
#define XCD_BAR_WORDS 3456
#define XB_SPIN_CAP (1u << 18)

__device__ __forceinline__ unsigned xb_ld(unsigned* p)              { return __hip_atomic_load(p, __ATOMIC_RELAXED, __HIP_MEMORY_SCOPE_AGENT); }
__device__ __forceinline__ unsigned xb_add(unsigned* p, unsigned v) { return __hip_atomic_fetch_add(p, v, __ATOMIC_RELAXED, __HIP_MEMORY_SCOPE_AGENT); }
__device__ __forceinline__ unsigned xb_xcc_id() { return (unsigned)__builtin_amdgcn_s_getreg((3 << 11) | 20) & 0xFu; }
#define XB_SPIN(cond, bar) do { unsigned _sp = 0; while (cond) { __builtin_amdgcn_s_sleep(1); \
    if ((++_sp & 255u) == 0u) { if (xb_ld(&(bar)[XB_TMO])) break; if (_sp > XB_SPIN_CAP) { atomicAdd(&(bar)[XB_TMO], 1u); break; } } } } while (0)

struct XcdBarrier {
    unsigned* bar; unsigned x; int wv;
    volatile LAS unsigned* st;
};

__device__ __forceinline__ XcdBarrier xcd_barrier_post(unsigned* bar, volatile LAS unsigned* st, int wv) {
    XcdBarrier b; b.bar = bar; b.x = xb_xcc_id(); b.st = st; b.wv = wv;
    if (wv == 0 && lane_id_asm() == 0) (void)xb_add(&bar[XB_XCNT(b.x)], 1u);
    return b;
}
__device__ __forceinline__ void xcd_barrier_complete(unsigned* bar, unsigned x, unsigned& nloc, unsigned& nx) {
    const unsigned G = gridDim.x * gridDim.y * gridDim.z;
    unsigned sum, cnt, mine, sp = 0u;
    for (;;) {
        sum = 0u; cnt = 0u; mine = 0u;
#pragma unroll
        for (unsigned j = 0; j < 16; ++j) { const unsigned c = xb_ld(&bar[XB_XCNT(j)]); sum += c; cnt += (c > 0u) ? 1u : 0u; mine = (j == x) ? c : mine; }
        if (sum == G) break;
        __builtin_amdgcn_s_sleep(1);
        if ((++sp & 255u) == 0u) { if (xb_ld(&bar[XB_TMO])) break; if (sp > XB_SPIN_CAP) { atomicAdd(&bar[XB_TMO], 1u); break; } }
    }
    nloc = mine > 0u ? mine : 1u; nx = cnt > 0u ? cnt : 1u;
}

__device__ __forceinline__ void xcd_barrier(const XcdBarrier& b) {
    asm volatile("s_waitcnt vmcnt(0)" ::: "memory");
    __syncthreads();
    if (b.wv == 0 && lane_id_asm() == 0) {
        unsigned* bar = b.bar;
        __builtin_amdgcn_s_waitcnt(0);
        unsigned nloc = b.st[0], nx = b.st[1];
        if (nloc == 0u) { xcd_barrier_complete(bar, b.x, nloc, nx); b.st[0] = nloc; b.st[1] = nx; }
        const unsigned old = xb_add(&bar[XB_XSUB(b.x)], 1u);
        const unsigned gen = old / nloc;
        if (old + 1u == (gen + 1u) * nloc) {
            __builtin_amdgcn_fence(__ATOMIC_RELEASE, "agent");
            asm volatile("s_waitcnt vmcnt(0)" ::: "memory");
            const unsigned og = xb_add(&bar[XB_TOP], 1u);
            const unsigned tg = og / nx;
            if (og + 1u == (tg + 1u) * nx) xb_add(&bar[XB_TOPGEN], 1u);
            else XB_SPIN(xb_ld(&bar[XB_TOPGEN]) == tg, bar);
            __builtin_amdgcn_fence(__ATOMIC_ACQUIRE, "agent");
            xb_add(&bar[XB_XGEN(b.x)], 1u);
            asm volatile("s_waitcnt vmcnt(0)" ::: "memory");
        } else {
            XB_SPIN(xb_ld(&bar[XB_XGEN(b.x)]) == gen, bar);
            __builtin_amdgcn_fence(__ATOMIC_ACQUIRE, "agent");
            asm volatile("s_waitcnt vmcnt(0)" ::: "memory");
        }
    }
    __syncthreads();
}

#ifdef PROBE_VARIANTS
__device__ __forceinline__ int kvariant() { return *(const __attribute__((address_space(4))) int*)((const __attribute__((address_space(4))) unsigned char*)__builtin_amdgcn_kernarg_segment_ptr() + 280); }
#endif
__device__ __forceinline__ void glds16(const char* sbase, unsigned voff, unsigned lds_dst) {
    unsigned keep;
    asm volatile("s_mov_b32 %0, m0\n\ts_mov_b32 m0, %3\n\ts_nop 0\n\tglobal_load_lds_dwordx4 %1, %2\n\ts_mov_b32 m0, %0" : "=&s"(keep) : "v"(voff), "s"(sbase), "s"(lds_dst) : "memory");
}
__device__ __forceinline__ void glds4(const char* sbase, unsigned voff, unsigned lds_dst) {
    unsigned keep;
    asm volatile("s_mov_b32 %0, m0\n\ts_mov_b32 m0, %3\n\ts_nop 0\n\tglobal_load_lds_dword %1, %2\n\ts_mov_b32 m0, %0" : "=&s"(keep) : "v"(voff), "s"(sbase), "s"(lds_dst) : "memory");
}
namespace pg8 {
constexpr int BM = 256, BK = 64, HALF = 128, HTB = HALF * BK * 2, STAGE_BYTES = 8 * HTB, NXCD = 8, WGM = 8;
__host__ __device__ __forceinline__ int perm32(int rho) { const int n = rho >> 4, i = rho & 15; return 8 * (i >> 2) + 4 * n + (i & 3); }

template <bool F8> __host__ __device__ __forceinline__ int chunk_xor(int r15) { const int rp = (r15 >> 1) & 7; return F8 ? ((rp & 4) | ((rp & 1) << 1) | ((rp >> 1) & 1)) : rp; }
struct Unit { int arow, brow, pn, e, rt, cnt, slot, koff; };
struct Gemm { const void* A; const void* Bt; int lda, ldb, K, wscale; };
typedef int i32x4 __attribute__((ext_vector_type(4)));
typedef int i32x8 __attribute__((ext_vector_type(8)));
__device__ __forceinline__ i32x8 cat8(bf16x8 lo, bf16x8 hi) { return __builtin_shufflevector(__builtin_bit_cast(i32x4, lo), __builtin_bit_cast(i32x4, hi), 0, 1, 2, 3, 4, 5, 6, 7); }

struct DenseSched {
    static constexpr bool GATHER = false;
    int nM, nN, nwg, G, c, kblk = 0;
    __device__ __forceinline__ void init(int M, int N, int G_, int c_) { nM = M / BM; nN = N / BM; nwg = nM * nN; G = G_; c = c_; }
    __device__ __forceinline__ bool next(int i, Unit& u) const {
        const long L = (long)i * G + c; if (L >= nwg) return false;
        int wgid = (int)L; { const int q = nwg / NXCD, r = nwg % NXCD, xcd = wgid % NXCD, off = wgid / NXCD; wgid = (xcd < r ? xcd * (q + 1) : r * (q + 1) + (xcd - r) * q) + off; }
        const int nig = WGM * nN, gid = wgid / nig, fm = gid * WGM, gsz = (nM - fm) < WGM ? (nM - fm) : WGM;
        const int pm = fm + ((wgid % nig) % gsz), pn = (wgid % nig) / gsz;
        u.arow = pm * BM; u.brow = pn * BM; u.pn = pn; u.e = 0; u.rt = pm; u.cnt = BM; u.slot = 0; u.koff = (pn & 1) * kblk; return true;
    }
    __device__ __forceinline__ void a_off(const Unit& u, LAS unsigned char*, int R0, int C0, int lda2, unsigned (&off)[2][2]) const {
#pragma unroll
        for (int h = 0; h < 2; ++h)
#pragma unroll
            for (int i = 0; i < 2; ++i) off[h][i] = (unsigned)((u.arow + 128 * h + 64 * i + R0) * lda2 + C0);
    }
};

struct MoeSched {
    static constexpr bool GATHER = true;
    const LAS int* utab;
    const int* list;
    const float* bias;
    int nunits, nexp_rows, shift;
    __device__ __forceinline__ bool next(int i, Unit& u) const {
        if (i >= nunits) return false;
        const LAS int* p = utab + 4 * i;
        u.e = __builtin_amdgcn_readfirstlane(p[0]); u.rt = __builtin_amdgcn_readfirstlane(p[1]); u.pn = __builtin_amdgcn_readfirstlane(p[2]); u.cnt = __builtin_amdgcn_readfirstlane(p[3]);
        u.arow = 0; u.brow = u.e * nexp_rows + u.pn * BM; u.slot = i % 3; u.koff = 0; return true;
    }
    __device__ __forceinline__ void tab_issue(const Unit& u, unsigned ldsb, int wid, int lane) const {
        if (wid < 4) { int p = u.rt * BM + 64 * wid + lane; p = p < u.cnt ? p : u.cnt - 1;
            glds4((const char*)(list + (size_t)u.e * TKTOT), (unsigned)p * 4u, ldsb + TAB_OFF + u.slot * 1024 + wid * 256); }
        else glds4((const char*)(bias + (size_t)u.e * nexp_rows + u.pn * BM), (unsigned)(64 * (wid - 4) + lane) * 4u, ldsb + TAB_OFF + 3072 + u.slot * 1024 + (wid - 4) * 256);
    }
    __device__ __forceinline__ void a_off(const Unit& u, LAS unsigned char* lds, int R0, int C0, int lda2, unsigned (&off)[2][2]) const {
        const LAS int* ids = (const LAS int*)(lds + TAB_OFF + u.slot * 1024);
#pragma unroll
        for (int h = 0; h < 2; ++h)
#pragma unroll
            for (int i = 0; i < 2; ++i) off[h][i] = (unsigned)((ids[128 * h + 64 * i + R0] >> shift) * lda2 + C0);
    }
};
__device__ __forceinline__ int moe_build_units(LAS int* utab, const volatile LAS int* tstart, const volatile LAS int* cnts, int NP, int G, int c, int tid) {
    const int total = tstart[NE] * NP;
    if (tid < 64) { const int L = tid * G + c;
        if (L < total) { int e = 0;
            for (int q = 0; q < NE - 1; ++q) if (tstart[q + 1] * NP <= L) e = q + 1;
            const int t0 = tstart[e], nte = tstart[e + 1] - t0, idx = L - t0 * NP;
            utab[4 * tid + 0] = e; utab[4 * tid + 1] = idx % nte; utab[4 * tid + 2] = idx / nte; utab[4 * tid + 3] = cnts[e]; } }
    return total > c ? (total - c + G - 1) / G : 0;
}

template <int ACT  , bool HAS_BIAS, bool HAS_SCALE, bool OSC = false, bool OUT8 = false> struct EpiDense {
    static constexpr bool PERM = true;
    bf16_t* O; int ldc; const float* bias; const float* scale; float oscale;
    __device__ __forceinline__ void operator()(const f32x4 (&acc)[2][2][4][2], const Unit& u, int wr, int wc, int fr, int fq) const {
        const int row0 = u.arow + wr * 64 + fr, col0 = u.pn * BM + wc * 32 + 8 * fq;
        f32x4 bv[2][2], sv[2][2];
#pragma unroll
        for (int bj = 0; bj < 2; ++bj)
#pragma unroll
            for (int n = 0; n < 2; ++n) {
                if (HAS_BIAS) bv[bj][n] = *(const f32x4*)(bias + col0 + bj * HALF + 4 * n);
                if (HAS_SCALE) sv[bj][n] = *(const f32x4*)(scale + col0 + bj * HALF + 4 * n);
            }
#pragma unroll
        for (int ai = 0; ai < 2; ++ai)
#pragma unroll
            for (int m = 0; m < 4; ++m) { bf16_t* rowp = O + (size_t)(row0 + ai * HALF + m * 16) * ldc + col0; unsigned char* rowp8 = (unsigned char*)O + (size_t)(row0 + ai * HALF + m * 16) * ldc + col0;
#pragma unroll
                for (int bj = 0; bj < 2; ++bj) { f32x4 v0 = acc[ai][bj][m][0], v1 = acc[ai][bj][m][1];
                    if (OSC) { v0 = v0 * oscale; v1 = v1 * oscale; }
                    if (HAS_BIAS) { v0 = v0 + bv[bj][0]; v1 = v1 + bv[bj][1]; }
                    if (ACT == 1) { const f32x2 a = pk_gelu_tanh((f32x2){v0[0], v0[1]}), b = pk_gelu_tanh((f32x2){v0[2], v0[3]}), c = pk_gelu_tanh((f32x2){v1[0], v1[1]}), d = pk_gelu_tanh((f32x2){v1[2], v1[3]});
                        v0 = (f32x4){a.x, a.y, b.x, b.y}; v1 = (f32x4){c.x, c.y, d.x, d.y}; }
                    if (ACT == 2) { const float nk = -1.4426950408889634f;
                        const f32x2 a = pk_sigmoid_scaled((f32x2){v0[0], v0[1]}, nk), b = pk_sigmoid_scaled((f32x2){v0[2], v0[3]}, nk), c = pk_sigmoid_scaled((f32x2){v1[0], v1[1]}, nk), d = pk_sigmoid_scaled((f32x2){v1[2], v1[3]}, nk);
                        v0 = (f32x4){a.x, a.y, b.x, b.y}; v1 = (f32x4){c.x, c.y, d.x, d.y}; }
                    if (HAS_SCALE) { v0 = v0 * sv[bj][0]; v1 = v1 * sv[bj][1]; }
                    if constexpr (OUT8) { u32x2 w; w.x = pk4_fp8(v0[0], v0[1], v0[2], v0[3]); w.y = pk4_fp8(v1[0], v1[1], v1[2], v1[3]); *(u32x2*)(rowp8 + bj * HALF) = w; }
                    else { u32x4 w; w.x = cvt_pk_bf16(v0[0], v0[1]); w.y = cvt_pk_bf16(v0[2], v0[3]); w.z = cvt_pk_bf16(v1[0], v1[1]); w.w = cvt_pk_bf16(v1[2], v1[3]);
                    *(u32x4*)(rowp + bj * HALF) = w; } } }
    }
};
struct EpiRouter {
    static constexpr bool PERM = false;
    float* LOG;
    __device__ __forceinline__ void operator()(const f32x4 (&acc)[2][2][4][2], const Unit& u, int wr, int wc, int fr, int fq) const {
        if (wc < 2) {
#pragma unroll
            for (int ai = 0; ai < 2; ++ai)
#pragma unroll
                for (int m = 0; m < 4; ++m) { float* rowp = LOG + (size_t)(u.arow + ai * HALF + wr * 64 + m * 16 + fr) * 64 + wc * 32 + 4 * fq;
#pragma unroll
                    for (int n = 0; n < 2; ++n) *(f32x4*)(rowp + 16 * n) = acc[ai][0][m][n]; }
        }
    }
};
template <bool OUT8> struct EpiMoe1 {
    static constexpr bool PERM = false;
    bf16_t* ACT; LAS unsigned char* lds; float oscale;
    __device__ __forceinline__ void operator()(const f32x4 (&acc)[2][2][4][2], const Unit& u, int wr, int wc, int fr, int fq) const {
        const LAS int* ids = (const LAS int*)(lds + TAB_OFF + u.slot * 1024);
        const LAS float* bp = (const LAS float*)(lds + TAB_OFF + 3072 + u.slot * 1024) + wc * 32 + 4 * fq;
        f32x4 bg[2], bl[2];
#pragma unroll
        for (int bj = 0; bj < 2; ++bj) { bg[bj] = *(const LAS f32x4*)(bp + bj * HALF); bl[bj] = *(const LAS f32x4*)(bp + bj * HALF + 16) + 1.0f; }
        const int j0 = u.pn * 128 + wc * 32 + 8 * fq;
#pragma unroll
        for (int ai = 0; ai < 2; ++ai)
#pragma unroll
            for (int m = 0; m < 4; ++m) {
                const int pl = ai * HALF + wr * 64 + m * 16 + fr;
                if (u.rt * BM + pl < u.cnt) {
                    const int flat = ids[pl];
                    float o[8];
#pragma unroll
                    for (int bj = 0; bj < 2; ++bj) { const f32x4 g = acc[ai][bj][m][0] * oscale + bg[bj], l = acc[ai][bj][m][1] * oscale + bl[bj];
#pragma unroll
                        for (int hh = 0; hh < 2; ++hh) {
                            const f32x2 xg = {fminf(g[2 * hh], 7.0f), fminf(g[2 * hh + 1], 7.0f)};
                            const f32x2 xl = {__builtin_amdgcn_fmed3f(l[2 * hh], -6.0f, 8.0f), __builtin_amdgcn_fmed3f(l[2 * hh + 1], -6.0f, 8.0f)};
                            const f32x2 r = pk_sigmoid_scaled(xg, -1.702f * 1.4426950408889634f), oo = (xg * xl) * r;
                            o[bj * 4 + 2 * hh] = oo.x; o[bj * 4 + 2 * hh + 1] = oo.y; } }
                    if constexpr (OUT8) { u32x2 w; w.x = pk4_fp8(o[0], o[1], o[2], o[3]); w.y = pk4_fp8(o[4], o[5], o[6], o[7]);
                        *(u32x2*)((unsigned char*)ACT + (size_t)flat * 1024 + j0) = w; }
                    else { u32x4 w; w.x = cvt_pk_bf16(o[0], o[1]); w.y = cvt_pk_bf16(o[2], o[3]); w.z = cvt_pk_bf16(o[4], o[5]); w.w = cvt_pk_bf16(o[6], o[7]);
                        *(u32x4*)(ACT + (size_t)flat * 1024 + j0) = w; }
                }
            }
    }
};
struct EpiMoe2 {
    static constexpr bool PERM = true;
    bf16_t* YS; LAS unsigned char* lds; float oscale;
    __device__ __forceinline__ void operator()(const f32x4 (&acc)[2][2][4][2], const Unit& u, int wr, int wc, int fr, int fq) const {
        const LAS int* ids = (const LAS int*)(lds + TAB_OFF + u.slot * 1024);
        const LAS float* bp = (const LAS float*)(lds + TAB_OFF + 3072 + u.slot * 1024) + wc * 32 + 8 * fq;
        const int col0 = u.pn * BM + wc * 32 + 8 * fq;
#pragma unroll
        for (int bj = 0; bj < 2; ++bj) {
            const float os = FP8_YS ? 16.0f * oscale : oscale;
            const f32x4 b0 = *(const LAS f32x4*)(bp + bj * HALF) * (FP8_YS ? 16.0f : 1.0f), b1 = *(const LAS f32x4*)(bp + bj * HALF + 4) * (FP8_YS ? 16.0f : 1.0f);
#pragma unroll
            for (int ai = 0; ai < 2; ++ai)
#pragma unroll
                for (int m = 0; m < 4; ++m) {
                    const int pl = ai * HALF + wr * 64 + m * 16 + fr;
                    if (u.rt * BM + pl < u.cnt) {
                        const int flat = ids[pl];
                        const f32x4 v0 = acc[ai][bj][m][0] * os + b0, v1 = acc[ai][bj][m][1] * os + b1;
                        if (FP8_YS) { u32x2 w; w.x = pk4_fp8(v0[0], v0[1], v0[2], v0[3]); w.y = pk4_fp8(v1[0], v1[1], v1[2], v1[3]);
                            *(u32x2*)((unsigned char*)YS + (size_t)flat * 1024 + col0 + bj * HALF) = w; }
                        else { u32x4 w; w.x = cvt_pk_bf16(v0[0], v0[1]); w.y = cvt_pk_bf16(v0[2], v0[3]); w.z = cvt_pk_bf16(v1[0], v1[1]); w.w = cvt_pk_bf16(v1[2], v1[3]);
                            *(u32x4*)(YS + (size_t)flat * 1024 + col0 + bj * HALF) = w; }
                    }
                }
        }
    }
};

template <bool F8, class Epi, class Sched>
__device__ __forceinline__ void gemm_phase(LAS unsigned char* lds, const Gemm g, const Sched& S, const Epi& E, const int wave0) {
    const int tid = (wave0 << 6) | lane_id_asm();
    const int wid = __builtin_amdgcn_readfirstlane(tid >> 6), lane = tid & 63, wr = wid >> 2, wc = wid & 3, fr = lane & 15, fq = lane >> 4;
    constexpr unsigned ESZ = F8 ? 1u : 2u;
    const int nt = (int)((unsigned)g.K * ESZ / 128u);
    int R0, C0;
    R0 = 8 * wid + (lane >> 3); C0 = 16 * ((lane & 7) ^ chunk_xor<F8>(R0 & 15));
    const unsigned lda2 = (unsigned)g.lda * ESZ, ldb2 = (unsigned)g.ldb * ESZ;
    const unsigned voffB = (unsigned)((Epi::PERM ? ((R0 & ~31) + perm32(R0 & 31)) : R0) * (int)ldb2 + C0);
    const unsigned aoffl = (unsigned)(R0 * (int)lda2 + C0);
    const unsigned kstep = 128;
    const size_t hstepB = (size_t)HALF * ldb2;
    const unsigned ldsw = (unsigned)wid * 1024u;
    const int ab = fr * 128 + 16 * ((F8 ? 2 * fq : fq) ^ chunk_xor<F8>(fr));
    const int aoff0 = wr * 8192 + ab, boff0 = wc * 4096 + ab;
    constexpr int KX = F8 ? 16 : 64;
    const char* const Abase = (const char*)g.A;
    const unsigned ldsb = (unsigned)(size_t)lds;
#define PG8_SA(b, h) (((b) * 2 + (h)) * HTB)
#define PG8_SB(b, h) ((4 + (b) * 2 + (h)) * HTB)
#define PG8_GOFF(h, NXT) do { if constexpr (Sched::GATHER) go = *(const LAS u32x2*)(lds + NXT_OFF + ((((NXT) ? ui + 1 : ui) & 1) << 13) + tid * 16 + (h) * 8); } while (0)
#define PG8_STAGE_A(bufoff, h, NXT, kb) do { _Pragma("unroll") for (int _i = 0; _i < 2; ++_i) { \
        if constexpr (Sched::GATHER) glds16(Abase + (kb), _i ? go.y : go.x, ldsb + (bufoff) + ldsw + _i * 8192); \
        else glds16(Abase + ((NXT) ? nxtA : curA) + (size_t)((h) * 128 + _i * 64) * lda2 + (kb), aoffl, ldsb + (bufoff) + ldsw + _i * 8192); } } while (0)
#define PG8_STAGE_B(bufoff, bptr, kb) do { _Pragma("unroll") for (int _i = 0; _i < 2; ++_i) \
        glds16((bptr) + (size_t)(_i * 64) * ldb2 + (kb), voffB, ldsb + (bufoff) + ldsw + _i * 8192); } while (0)
#define PG8_LDA(dst, b, h) do { int _a1 = aoff0 ^ KX; asm volatile("" : "+v"(_a1)); \
        _Pragma("unroll") for (int m = 0; m < 4; ++m) _Pragma("unroll") for (int k = 0; k < 2; ++k) dst[m][k] = *(const LAS bf16x8*)(lds + PG8_SA(b, h) + (k ? _a1 : aoff0) + m * 2048); } while (0)
#define PG8_LDB(dst, b, h) do { int _b1 = boff0 ^ KX; asm volatile("" : "+v"(_b1)); \
        _Pragma("unroll") for (int n = 0; n < 2; ++n) _Pragma("unroll") for (int k = 0; k < 2; ++k) dst[n][k] = *(const LAS bf16x8*)(lds + PG8_SB(b, h) + (k ? _b1 : boff0) + n * 2048); } while (0)
#define PG8_MMA(ai, bj, At, Bt) do { __builtin_amdgcn_s_setprio(1); _Pragma("unroll") for (int m = 0; m < 4; ++m) _Pragma("unroll") for (int n = 0; n < 2; ++n) { \
        if constexpr (F8) acc[ai][bj][m][n] = __builtin_amdgcn_mfma_scale_f32_16x16x128_f8f6f4(cat8(Bt[n][0], Bt[n][1]), cat8(At[m][0], At[m][1]), acc[ai][bj][m][n], 0, 0, 0, 0, 0, 0); \
        else { _Pragma("unroll") for (int k = 0; k < 2; ++k) acc[ai][bj][m][n] = __builtin_amdgcn_mfma_f32_16x16x32_bf16(Bt[n][k], At[m][k], acc[ai][bj][m][n], 0, 0, 0); } } \
        __builtin_amdgcn_s_setprio(0); } while (0)
#define PG8_WAIT_V(n) asm volatile("s_waitcnt vmcnt(" #n ")" ::: "memory")
#define PG8_WAIT_L(n) asm volatile("s_waitcnt lgkmcnt(" #n ")" ::: "memory")
#define PG8_BAR __builtin_amdgcn_s_barrier()
#define PG8_SCHED __builtin_amdgcn_sched_barrier(0)
#define PG8_KITER(k1, b2, NXT, k2, k3) do { \
        PG8_GOFF(1, 0); PG8_LDB(B0, 0, 0); PG8_LDB(B1, 0, 1); PG8_SCHED; PG8_LDA(At, 0, 0); PG8_STAGE_A(PG8_SA(1, 1), 1, 0, (k1)); \
        PG8_WAIT_V(8); PG8_WAIT_L(0); PG8_BAR; PG8_MMA(0, 0, At, B0); PG8_MMA(0, 1, At, B1); PG8_BAR; PG8_SCHED; \
        PG8_GOFF(0, NXT); PG8_LDA(At, 0, 1); PG8_STAGE_B(PG8_SB(0, 0), (b2), (k2)); PG8_STAGE_B(PG8_SB(0, 1), (b2) + hstepB, (k2)); PG8_STAGE_A(PG8_SA(0, 0), 0, NXT, (k2)); \
        PG8_WAIT_V(8); PG8_WAIT_L(0); PG8_BAR; PG8_MMA(1, 0, At, B0); PG8_MMA(1, 1, At, B1); PG8_BAR; PG8_SCHED; \
        PG8_GOFF(1, NXT); PG8_LDB(B0, 1, 0); PG8_LDB(B1, 1, 1); PG8_SCHED; PG8_LDA(At, 1, 0); PG8_STAGE_A(PG8_SA(0, 1), 1, NXT, (k2)); \
        PG8_WAIT_V(8); PG8_WAIT_L(0); PG8_BAR; PG8_MMA(0, 0, At, B0); PG8_MMA(0, 1, At, B1); PG8_BAR; PG8_SCHED; \
        PG8_GOFF(0, NXT); PG8_LDA(At, 1, 1); PG8_STAGE_B(PG8_SB(1, 0), (b2), (k3)); PG8_STAGE_B(PG8_SB(1, 1), (b2) + hstepB, (k3)); PG8_STAGE_A(PG8_SA(1, 0), 0, NXT, (k3)); \
        PG8_WAIT_V(8); PG8_WAIT_L(0); PG8_BAR; PG8_MMA(1, 0, At, B0); PG8_MMA(1, 1, At, B1); PG8_BAR; PG8_SCHED; } while (0)

    Unit cur, nxt; int ui = 0;
    if (!S.next(0, cur)) return;
    unsigned curoff[2][2], nxtoff[2][2];
    size_t curA = 0, nxtA = 0;
    bool has_next = S.next(1, nxt);
#define PG8_NXT_SLOT ((LAS u32x4*)(lds + NXT_OFF) + tid)
    if constexpr (Sched::GATHER) {
        S.tab_issue(cur, ldsb, wid, lane); if (has_next) S.tab_issue(nxt, ldsb, wid, lane);
        asm volatile("s_waitcnt vmcnt(0)" ::: "memory"); __builtin_amdgcn_s_barrier(); asm volatile("" ::: "memory");
        S.a_off(cur, lds, R0, C0, (int)lda2, curoff);
        if (has_next) S.a_off(nxt, lds, R0, C0, (int)lda2, nxtoff);
        else {
#pragma unroll
            for (int h = 0; h < 2; ++h)
#pragma unroll
                for (int i = 0; i < 2; ++i) nxtoff[h][i] = curoff[h][i]; }
        ((LAS u32x4*)(lds + NXT_OFF))[tid] = (u32x4){curoff[0][0], curoff[0][1], curoff[1][0], curoff[1][1]};
        ((LAS u32x4*)(lds + NXT_OFF + 8192))[tid] = (u32x4){nxtoff[0][0], nxtoff[0][1], nxtoff[1][0], nxtoff[1][1]};
    } else { curA = (size_t)cur.arow * lda2 + cur.koff; nxtA = has_next ? (size_t)nxt.arow * lda2 + nxt.koff : curA; }
    f32x4 acc[2][2][4][2];
#pragma unroll
    for (int a = 0; a < 2; ++a)
#pragma unroll
        for (int b = 0; b < 2; ++b)
#pragma unroll
            for (int m = 0; m < 4; ++m)
#pragma unroll
                for (int n = 0; n < 2; ++n) acc[a][b][m][n] = (f32x4){0.f, 0.f, 0.f, 0.f};
    bf16x8 At[4][2], B0[2][2], B1[2][2];
    const char* cB = (const char*)g.Bt + (size_t)cur.brow * ldb2 + cur.koff;
    u32x2 go = {0u, 0u};
    PG8_STAGE_B(PG8_SB(0, 0), cB, 0u); PG8_STAGE_B(PG8_SB(0, 1), cB + hstepB, 0u); PG8_GOFF(0, 0); PG8_STAGE_A(PG8_SA(0, 0), 0, 0, 0u); PG8_GOFF(1, 0); PG8_STAGE_A(PG8_SA(0, 1), 1, 0, 0u);
    if (wr == 1) PG8_BAR;
    PG8_WAIT_V(2); PG8_BAR;
    PG8_GOFF(0, 0); PG8_STAGE_B(PG8_SB(1, 0), cB, kstep); PG8_STAGE_A(PG8_SA(1, 0), 0, 0, kstep); PG8_STAGE_B(PG8_SB(1, 1), cB + hstepB, kstep);
    PG8_WAIT_V(6); PG8_BAR;
    for (;;) {
        const char* nB = has_next ? (const char*)g.Bt + (size_t)nxt.brow * ldb2 + nxt.koff : cB;
        Unit u2; bool has2 = false;
        if constexpr (Sched::GATHER) has2 = has_next && S.next(ui + 2, u2);
#pragma unroll 1
        for (int t = 0; t < nt - 2; t += 2) {
            const unsigned k1 = (unsigned)(t + 1) * kstep, k2 = (unsigned)(t + 2) * kstep, k3 = (unsigned)(t + 3) * kstep;
            if constexpr (Sched::GATHER) { if (t == 2 && has2) S.tab_issue(u2, ldsb, wid, lane); }
            PG8_KITER(k1, cB, 0, k2, k3);
        }
        { const unsigned k1 = (unsigned)(nt - 1) * kstep; PG8_KITER(k1, nB, 1, 0u, kstep); }
#if PIN_ACC
#pragma unroll
        for (int a = 0; a < 2; ++a)
#pragma unroll
            for (int b = 0; b < 2; ++b)
#pragma unroll
                for (int m = 0; m < 4; ++m) asm volatile("" : "+v"(acc[a][b][m][0]), "+v"(acc[a][b][m][1]));
#endif
        if (wr == 0) PG8_BAR;
#ifdef PROBE_VARIANTS
        if (!(kvariant() & 4))
#endif
        { const int l2 = lane_id_asm(); E(acc, cur, wr, wc, l2 & 15, l2 >> 4); }
        if (!has_next) break;
#pragma unroll
        for (int a = 0; a < 2; ++a)
#pragma unroll
            for (int b = 0; b < 2; ++b)
#pragma unroll
                for (int m = 0; m < 4; ++m)
#pragma unroll
                    for (int n = 0; n < 2; ++n) acc[a][b][m][n] = (f32x4){0.f, 0.f, 0.f, 0.f};
        cur = nxt; cB = nB; ++ui; curA = nxtA;
        has_next = S.next(ui + 1, nxt);
        if (has_next) {
            if constexpr (Sched::GATHER) { const int tz = (wave0 << 6) | lane_id_asm(); int R0z, C0z;
                { const int lz = tz & 63; R0z = 8 * wid + (lz >> 3); C0z = 16 * ((lz & 7) ^ chunk_xor<F8>(R0z & 15)); }
                S.a_off(nxt, lds, R0z, C0z, (int)lda2, nxtoff);
                ((LAS u32x4*)(lds + NXT_OFF + (((ui + 1) & 1) << 13)))[tz] = (u32x4){nxtoff[0][0], nxtoff[0][1], nxtoff[1][0], nxtoff[1][1]}; }
            else nxtA = (size_t)nxt.arow * lda2 + nxt.koff;
        } else if constexpr (Sched::GATHER) { const int tz = (wave0 << 6) | lane_id_asm();
            ((LAS u32x4*)(lds + NXT_OFF + (((ui + 1) & 1) << 13)))[tz] = ((const LAS u32x4*)(lds + NXT_OFF + ((ui & 1) << 13)))[tz]; }
        if (wr == 1) PG8_BAR;
    }
    PG8_WAIT_V(0);
    PG8_BAR;
#undef PG8_SA
#undef PG8_SB
#undef PG8_STAGE_A
#undef PG8_GOFF
#undef PG8_STAGE_B
#undef PG8_LDA
#undef PG8_LDB
#undef PG8_MMA
#undef PG8_WAIT_V
#undef PG8_WAIT_L
#undef PG8_BAR
#undef PG8_SCHED
#undef PG8_KITER
#undef PG8_NXT_SLOT
}
}

struct Args { const float* in[32]; float* out; unsigned char* ws; int ph_lo, ph_hi, variant, pad; };
typedef const __attribute__((address_space(4))) unsigned char* kptr_t;
__device__ __forceinline__ const float* kin(int i) { kptr_t p = (kptr_t)__builtin_amdgcn_kernarg_segment_ptr(); asm volatile("" : "+s"(p)); return *(const float* const __attribute__((address_space(4)))*)(p + 8 * i); }
enum { I_X = 0, I_C, I_MODW, I_MODB, I_LNG, I_LNB, I_ABWIN, I_POOLW, I_POOLS, I_CONVW, I_CONVB, I_WA, I_BA, I_WX, I_BX, I_LAM, I_ABWOUT, I_ABBOUT,
       I_SGWIN, I_SGBIN, I_SGLNG, I_SGLNB, I_SGWS, I_SGBS, I_SGWOUT, I_SGBOUT, I_RW, I_RB, I_W1, I_B1, I_W2, I_B2 };

__device__ __forceinline__ int w1_rho(int n) { const int nn = n & 1, j = n >> 1; return ((j >> 7) << 8) | (((j >> 2) & 1) << 7) | (((j >> 5) & 3) << 5) | (nn << 4) | (((j >> 3) & 3) << 2) | (j & 3); }
__device__ __forceinline__ int w1_n_of_rho(int rho) { const int pn = rho >> 8, bj = (rho >> 7) & 1, wc = (rho >> 5) & 3, nn = (rho >> 4) & 1, fq = (rho >> 2) & 3, i = rho & 3; return 2 * (128 * pn + 32 * wc + 8 * fq + 4 * bj + i) + nn; }
template <bool W1MAP>
__device__ __forceinline__ void conv_item(const float* W, int N, bf16_t* WT, int item, int lane) {
    const int nblk = N >> 5, kb = item / nblk, nb = item - kb * nblk;
    const int kg = lane >> 3, nl = lane & 7, k0 = kb * 64 + kg * 8, n0 = nb * 32 + nl * 4;
    f32x4 v[8];
#pragma unroll
    for (int q = 0; q < 8; ++q) v[q] = *(const f32x4*)(W + (size_t)(k0 + q) * N + n0);
#pragma unroll
    for (int i = 0; i < 4; ++i) {
        const int n = n0 + i, row = W1MAP ? w1_rho(n) : n;
        u32x4 o; o.x = pk2(v[0][i], v[1][i]); o.y = pk2(v[2][i], v[3][i]); o.z = pk2(v[4][i], v[5][i]); o.w = pk2(v[6][i], v[7][i]);
        *(u32x4*)(WT + (size_t)row * 1024 + k0) = o;
    }
}

template <bool W1MAP>
__device__ __forceinline__ void conv_item_f8(const float* W, int N, unsigned char* WT8, int item, int lane, float scale) {
    const int nblk = N >> 5, kb = item / nblk, nb = item - kb * nblk;
    const int kg = lane >> 3, nl = lane & 7, k0 = kb * 128 + kg * 16, n0 = nb * 32 + nl * 4;
    f32x4 v[16];
#pragma unroll
    for (int q = 0; q < 16; ++q) v[q] = *(const f32x4*)(W + (size_t)(k0 + q) * N + n0) * scale;
#pragma unroll
    for (int i = 0; i < 4; ++i) {
        const int n = n0 + i, row = W1MAP ? w1_rho(n) : n;
        u32x4 o; o.x = pk4_fp8(v[0][i], v[1][i], v[2][i], v[3][i]); o.y = pk4_fp8(v[4][i], v[5][i], v[6][i], v[7][i]);
        o.z = pk4_fp8(v[8][i], v[9][i], v[10][i], v[11][i]); o.w = pk4_fp8(v[12][i], v[13][i], v[14][i], v[15][i]);
        *(u32x4*)(WT8 + (size_t)row * 1024 + k0) = o;
    }
}

#define IN(k) (lo <= (k) && (k) < hi)
#define SEAM(k) do { if ((k) + 1 < hi) xcd_barrier(bar); } while (0)
#define PH_LOCALS \
    const int tid = (wave0 << 6) | lane_id_asm(); \
    const int lane = tid & 63, wave = wave0; \
    int bx = blockIdx.x; asm volatile("" : "+s"(bx)); \
    const int vcu = (G % 8 == 0) ? (bx % 8) * (G / 8) + bx / 8 : bx; \
    const int gw = vcu * 8 + wave, NGW = G * 8; \
    unsigned char* ws; { kptr_t kp_ = (kptr_t)__builtin_amdgcn_kernarg_segment_ptr(); asm volatile("" : "+s"(kp_)); ws = *(unsigned char* const __attribute__((address_space(4)))*)(kp_ + 264); } \
    float* Xf; { kptr_t kp_ = (kptr_t)__builtin_amdgcn_kernarg_segment_ptr(); asm volatile("" : "+s"(kp_)); Xf = *(float* const __attribute__((address_space(4)))*)(kp_ + 256); } \
    unsigned* const ctl = (unsigned*)(ws + WS_CTL); \
    float* const MOD = (float*)(ws + WS_MOD); bf16_t* const Hb = (bf16_t*)(ws + WS_H); bf16_t* const Zb = (bf16_t*)(ws + WS_Z); bf16_t* const A2b = (bf16_t*)(ws + WS_A2); \
    bf16_t* const RIb = (bf16_t*)(ws + WS_RI); bf16_t* const YMb = (bf16_t*)(ws + WS_YMIX); bf16_t* const Yb = (bf16_t*)(ws + WS_Y); bf16_t* const ACTb = (bf16_t*)(ws + WS_ACT); \
    bf16_t* const YSb = (bf16_t*)(ws + WS_YS); float* const LOGf = (float*)(ws + WS_LOG); float* const TOPG = (float*)(ws + WS_TOPG); int* const LIST = (int*)(ws + WS_LIST); \
    float* const SUMM = (float*)(ws + WS_SUMM); \
    (void)lane; (void)wave; (void)gw; (void)NGW; (void)ctl; (void)MOD; (void)Hb; (void)Zb; (void)A2b; (void)RIb; (void)YMb; (void)Yb; (void)ACTb; (void)YSb; (void)LOGf; (void)TOPG; (void)LIST; (void)SUMM; (void)Xf; (void)vcu


template <int L, int PASS>
__device__ __forceinline__ void scan_phase(const int lo, const int hi, const int G, const XcdBarrier& bar, const int wave0) {
    constexpr int l = L, pass = PASS, P = PH_L0 + PH_PER_LAYER * L, jj = L >> 1; constexpr bool odd = (L & 1) != 0;
            if (PHEN(6) && !odd && IN(P + 3 + pass)) {
            PH_LOCALS;
                for (int it = gw; it < 16 * 32 * 4; it += NGW) {
                    const int b = it >> 7, n = (it >> 2) & 31, cg = it & 3;
                    const int ch = cg * 128 + 2 * lane;
                    float sp[2];
#pragma unroll
                    for (int q = 0; q < 2; ++q) { const float x = -kin(I_LAM)[jj * 512 + ch + q]; sp[q] = 8.0f * 1.4426950408889634f * (fmaxf(x, 0.f) + log1pf(__expf(-fabsf(x)))); }
                    float one = 1.0f; asm volatile("" : "+v"(one));
                    float h0 = 0.f, h1 = 0.f, p0 = one, p1 = one;
                    if (pass == 1) {
#pragma unroll 1
                        for (int m = 0; m < n; ++m) { const f32x4 s = *(const f32x4*)(SUMM + (((size_t)b * 32 + m) * 512 + ch) * 2); h0 = s[0] * h0 + s[1]; h1 = s[2] * h1 + s[3]; }
                    }
                    const size_t row0 = (size_t)b * SEQ + n * 128;
#pragma unroll 4
                    for (int t = 0; t < 128; ++t) {
                        const size_t r = row0 + t;
                        const unsigned rw = *(const unsigned*)(RIb + r * 1024 + ch), iw = *(const unsigned*)(RIb + r * 1024 + 512 + ch), xw = *(const unsigned*)(A2b + r * 1024 + 512 + ch);
                        const float a0 = __builtin_amdgcn_exp2f(-bflo(rw) * sp[0]), a1 = __builtin_amdgcn_exp2f(-bfhi(rw) * sp[1]);
                        const float m0 = __builtin_amdgcn_sqrtf(fmaxf(__builtin_fmaf(-a0, a0, 1.0f), 0.f)), m1 = __builtin_amdgcn_sqrtf(fmaxf(__builtin_fmaf(-a1, a1, 1.0f), 0.f));
                        h0 = a0 * h0 + m0 * (bflo(iw) * bflo(xw)); h1 = a1 * h1 + m1 * (bfhi(iw) * bfhi(xw));
                        if (pass == 0) { p0 *= a0; p1 *= a1; }
                        else { const unsigned gwd = *(const unsigned*)(Zb + r * DINAB + 1024 + ch);
                            if (FP8_OUTP) *(unsigned short*)((unsigned char*)YMb + r * 1024 + 512 + ch) = (unsigned short)pk4_fp8(h0 * gelu_tanh(bflo(gwd)), h1 * gelu_tanh(bfhi(gwd)), 0.f, 0.f);
                            else *(unsigned*)(YMb + r * 1024 + 512 + ch) = pk2(h0 * gelu_tanh(bflo(gwd)), h1 * gelu_tanh(bfhi(gwd))); }
                    }
                    if (pass == 0) *(f32x4*)(SUMM + (((size_t)b * 32 + n) * 512 + ch) * 2) = (f32x4){p0, h0, p1, h1};
                }
                SEAM(P + 3 + pass);
            }
}

template <int L, int SUB>
__device__ __forceinline__ void ln_phase(const int lo, const int hi, const int G, const XcdBarrier& bar, const int wave0) {
    constexpr int l = L, sub = SUB, P = PH_L0 + PH_PER_LAYER * L; constexpr int ph = SUB == 0 ? P + 6 : P + 11;
    constexpr bool XIN_F32 = (L == 0 && SUB == 0), XOUT_F32 = (L == DEPTH - 1 && SUB == 1);
    if (PHEN(8) && IN(ph)) {
        PH_LOCALS;
        const int rows_per = T / NGW, r0 = gw * rows_per, b = r0 / SEQ;
        constexpr int ls = 2 * l + sub, lsn = ls + 1;
        const float* gp = MOD + ((size_t)ls * 16 + b) * 3072 + 2048;
        const float* lgp = kin(I_LNG) + ls * 1024, * lbp = kin(I_LNB) + ls * 1024;
        constexpr bool has_nextmod = lsn < 2 * DEPTH;
        const float* nsh = MOD + ((size_t)(has_nextmod ? lsn : 0) * 16 + b) * 3072, * nsc = nsh + 1024;
        f32x4 gt[4], lg[4], lb[4], sh[4], sc[4];
#pragma unroll
        for (int j = 0; j < 4; ++j) { const int o = 4 * (64 * j + lane); gt[j] = *(const f32x4*)(gp + o) + 1.0f; lg[j] = *(const f32x4*)(lgp + o); lb[j] = *(const f32x4*)(lbp + o);
            sh[j] = *(const f32x4*)(nsh + o); sc[j] = *(const f32x4*)(nsc + o) + 1.0f; }
        const float* xin32 = kin(I_X);
        bf16_t* const Xb = (bf16_t*)(ws + WS_XB);
        constexpr int RPI = 2;
        for (int r = r0; r < r0 + rows_per; r += RPI) {
            f32x4 xf[XIN_F32 ? RPI : 1][4]; u32x2 xb[XIN_F32 ? 1 : RPI][4]; u32x2 yv[sub == 0 ? RPI : 1][4]; u32x2 ys[sub == 0 ? 1 : RPI][4][4]; f32x4 gk[RPI];
#pragma unroll
            for (int q = 0; q < RPI; ++q) {
                if constexpr (XIN_F32) { const f32x4* xr = (const f32x4*)(xin32 + (size_t)(r + q) * D) + lane;
#pragma unroll
                    for (int j = 0; j < 4; ++j) xf[q][j] = xr[64 * j]; }
                else { const u32x2* xr = (const u32x2*)(Xb + (size_t)(r + q) * D) + lane;
#pragma unroll
                    for (int j = 0; j < 4; ++j) xb[q][j] = xr[64 * j]; }
                if constexpr (sub == 0) { const u32x2* yr = (const u32x2*)(Yb + (size_t)(r + q) * D) + lane;
#pragma unroll
                    for (int j = 0; j < 4; ++j) yv[q][j] = yr[64 * j]; }
                else { gk[q] = *(const f32x4*)(TOPG + (size_t)(r + q) * 4);
#pragma unroll
                    for (int k = 0; k < 4; ++k) {
                        if (FP8_YS) { const unsigned* yr = (const unsigned*)((const unsigned char*)YSb + ((size_t)(r + q) * 4 + k) * D) + lane;
#pragma unroll
                            for (int j = 0; j < 4; ++j) ys[q][k][j].x = yr[64 * j]; }
                        else { const u32x2* yr = (const u32x2*)(YSb + ((size_t)(r + q) * 4 + k) * D) + lane;
#pragma unroll
                            for (int j = 0; j < 4; ++j) ys[q][k][j] = yr[64 * j]; } } }
            }
            f32x4 v[RPI][4]; float s[RPI];
#pragma unroll
            for (int q = 0; q < RPI; ++q) {
                s[q] = 0.f;
#pragma unroll
                for (int j = 0; j < 4; ++j) {
                    f32x4 y, x;
                    if constexpr (XIN_F32) x = xf[q][j]; else x = (f32x4){bflo(xb[q][j].x), bfhi(xb[q][j].x), bflo(xb[q][j].y), bfhi(xb[q][j].y)};
                    if constexpr (sub == 0) y = (f32x4){bflo(yv[q][j].x), bfhi(yv[q][j].x), bflo(yv[q][j].y), bfhi(yv[q][j].y)};
                    else { y = (f32x4){0.f, 0.f, 0.f, 0.f};
#pragma unroll
                        for (int k = 0; k < 4; ++k) { const u32x2 w = ys[q][k][j];
                            if (FP8_YS) { const f32x2 lo2 = __builtin_amdgcn_cvt_pk_f32_fp8((int)w.x, false), hi2 = __builtin_amdgcn_cvt_pk_f32_fp8((int)w.x, true);
                                y = y + (f32x4){lo2.x, lo2.y, hi2.x, hi2.y} * (gk[q][k] * 0.0625f); }
                            else y = y + (f32x4){bflo(w.x), bfhi(w.x), bflo(w.y), bfhi(w.y)} * gk[q][k]; } }
                    v[q][j] = x * DN_ALPHA + gt[j] * y;
                    s[q] += (v[q][j][0] + v[q][j][1]) + (v[q][j][2] + v[q][j][3]);
                }
            }
#pragma unroll
            for (int o = 1; o < 64; o <<= 1) {
#pragma unroll
                for (int q = 0; q < RPI; ++q) s[q] += __builtin_bit_cast(float, __builtin_amdgcn_ds_bpermute((lane ^ o) << 2, __builtin_bit_cast(int, s[q])));
            }
            float s2[RPI];
#pragma unroll
            for (int q = 0; q < RPI; ++q) { const float mean = s[q] * (1.0f / D); s2[q] = 0.f;
#pragma unroll
                for (int j = 0; j < 4; ++j) { v[q][j] = v[q][j] - mean; s2[q] += (v[q][j][0] * v[q][j][0] + v[q][j][1] * v[q][j][1]) + (v[q][j][2] * v[q][j][2] + v[q][j][3] * v[q][j][3]); } }
#pragma unroll
            for (int o = 1; o < 64; o <<= 1) {
#pragma unroll
                for (int q = 0; q < RPI; ++q) s2[q] += __builtin_bit_cast(float, __builtin_amdgcn_ds_bpermute((lane ^ o) << 2, __builtin_bit_cast(int, s2[q])));
            }
#pragma unroll
            for (int q = 0; q < RPI; ++q) {
                const float rstd = 1.0f / sqrtf(s2[q] * (1.0f / D) + LN_EPS);
                u32x2* hr = (u32x2*)(Hb + (size_t)(r + q) * D) + lane;
#pragma unroll
                for (int j = 0; j < 4; ++j) { const f32x4 xn = v[q][j] * rstd * lg[j] + lb[j];
                    if (XOUT_F32) ((f32x4*)(Xf + (size_t)(r + q) * D) + lane)[64 * j] = xn;
                    else { u32x2 w; w.x = pk2(xn[0], xn[1]); w.y = pk2(xn[2], xn[3]); ((u32x2*)(Xb + (size_t)(r + q) * D) + lane)[64 * j] = w; }
                    if (has_nextmod) { const f32x4 h = xn * sc[j] + sh[j];
                        if (!(FP8_INP && sub == 1)) { u32x2 w; w.x = pk2(h[0], h[1]); w.y = pk2(h[2], h[3]); hr[64 * j] = w; }
                        if ((FP8_M1 && sub == 0) || (FP8_INP && sub == 1)) ((unsigned*)(ws + WS_H8 + (size_t)(r + q) * D) + lane)[64 * j] = pk4_fp8(h[0], h[1], h[2], h[3]); } }
            }
        }
        if (ph + 1 < NPH) SEAM(ph);
    }
}

template <int L>
__device__ __forceinline__ void layer_body(LAS unsigned char* const lds, volatile LAS unsigned* const LCTL, const int lo, const int hi, const int G, const XcdBarrier& bar, const int wave0) {
    constexpr int l = L;
        const int P = PH_L0 + PH_PER_LAYER * l, jj = l >> 1;
        const bool odd = (l & 1) != 0;
        if (PHEN(2) && IN(P + 0)) {
            PH_LOCALS;
            if (!odd) {
                pg8::DenseSched S; S.init(T, 1536, G, bx);
                if (FP8_INP) { pg8::Gemm g{ws + WS_H8, ws + WS_ABIN + (size_t)jj * 1536 * 1024, 1024, 1024, 1024, 122};
                    pg8::EpiDense<0, false, false, true> E{Zb, 1536, nullptr, nullptr, 1.0f / 32.0f};
                    pg8::gemm_phase<true>(lds, g, S, E, wave0); }
                else { pg8::Gemm g{Hb, (const bf16_t*)(ws + WS_ABIN) + (size_t)jj * 1536 * 1024, 1024, 1024, 1024, 127};
                    pg8::EpiDense<0, false, false> E{Zb, 1536, nullptr, nullptr, 0.f};
                    pg8::gemm_phase<false>(lds, g, S, E, wave0); }
            } else {
                pg8::DenseSched S; S.init(T, 2048, G, bx);
                if (FP8_INP) { pg8::Gemm g{ws + WS_H8, ws + WS_SGIN + (size_t)jj * 2048 * 1024, 1024, 1024, 1024, 122};
                    pg8::EpiDense<1, true, false, true> E{Zb, 2048, kin(I_SGBIN) + jj * 2048, nullptr, 1.0f / 32.0f};
                    pg8::gemm_phase<true>(lds, g, S, E, wave0); }
                else { pg8::Gemm g{Hb, (const bf16_t*)(ws + WS_SGIN) + (size_t)jj * 2048 * 1024, 1024, 1024, 1024, 127};
                    pg8::EpiDense<1, true, false> E{Zb, 2048, kin(I_SGBIN) + jj * 2048, nullptr, 0.f};
                    pg8::gemm_phase<false>(lds, g, S, E, wave0); }
            }
            SEAM(P + 0);
        }
        if (PHEN(3) && !odd && IN(P + 1)) {
            PH_LOCALS;
            const int rows_per = T / NGW, r0 = gw * rows_per;
            const int g4 = lane >> 4, w = 2 << g4;
            float cw[4][8], cb[8];
#pragma unroll
            for (int k = 0; k < 4; ++k)
#pragma unroll
                for (int q = 0; q < 8; ++q) cw[k][q] = kin(I_CONVW)[((size_t)jj * 4 + k) * 512 + 8 * lane + q];
#pragma unroll
            for (int q = 0; q < 8; ++q) cb[q] = kin(I_CONVB)[jj * 512 + 8 * lane + q];
            const int ts0 = r0 & (SEQ - 1);
            u32x4 ring[16], cr[3];
            float sw[8];
#pragma unroll
            for (int q = 0; q < 8; ++q) sw[q] = 0.f;
#pragma unroll
            for (int d = 0; d < 16; ++d) {
                const int k = 15 - d;
                u32x4 v = {0u, 0u, 0u, 0u};
                if (ts0 > d) v = *(const u32x4*)(Zb + (size_t)(r0 - 1 - d) * DINAB + 8 * lane);
                ring[k] = v;
                if (d + 1 < w) { const float f[8] = {bflo(v.x), bfhi(v.x), bflo(v.y), bfhi(v.y), bflo(v.z), bfhi(v.z), bflo(v.w), bfhi(v.w)};
#pragma unroll
                    for (int q = 0; q < 8; ++q) sw[q] += f[q]; }
            }
#pragma unroll
            for (int d = 0; d < 3; ++d) { u32x4 v = {0u, 0u, 0u, 0u}; if (ts0 > d) v = *(const u32x4*)(Zb + (size_t)(r0 - 1 - d) * DINAB + 512 + 8 * lane); cr[2 - d] = v; }
#pragma unroll 1
            for (int rb = 0; rb < rows_per; rb += 16) {
#pragma unroll
                for (int i = 0; i < 16; ++i) {
                    const int r = r0 + rb + i, ts = r & (SEQ - 1);
                    const u32x4 vn = *(const u32x4*)(Zb + (size_t)r * DINAB + 8 * lane), cn = *(const u32x4*)(Zb + (size_t)r * DINAB + 512 + 8 * lane);
                    const u32x4 c2 = ring[(i + 15) & 15], c4 = ring[(i + 13) & 15], c8 = ring[(i + 9) & 15], c16 = ring[(i + 1) & 15];
                    u32x4 vo;
                    vo.x = g4 == 0 ? c2.x : g4 == 1 ? c4.x : g4 == 2 ? c8.x : c16.x; vo.y = g4 == 0 ? c2.y : g4 == 1 ? c4.y : g4 == 2 ? c8.y : c16.y;
                    vo.z = g4 == 0 ? c2.z : g4 == 1 ? c4.z : g4 == 2 ? c8.z : c16.z; vo.w = g4 == 0 ? c2.w : g4 == 1 ? c4.w : g4 == 2 ? c8.w : c16.w;
                    ring[i] = vn;
                    const float fn[8] = {bflo(vn.x), bfhi(vn.x), bflo(vn.y), bfhi(vn.y), bflo(vn.z), bfhi(vn.z), bflo(vn.w), bfhi(vn.w)};
                    const float fo[8] = {bflo(vo.x), bfhi(vo.x), bflo(vo.y), bfhi(vo.y), bflo(vo.z), bfhi(vo.z), bflo(vo.w), bfhi(vo.w)};
                    const int cntw = (ts + 1) < w ? (ts + 1) : w;
                    const float inv = __builtin_amdgcn_rcpf((float)cntw);
                    float pz[8];
#pragma unroll
                    for (int q = 0; q < 8; ++q) { sw[q] += fn[q]; pz[q] = sw[q] * inv - fn[q]; sw[q] -= fo[q]; }
                    u32x4 o; o.x = pk2(pz[0], pz[1]); o.y = pk2(pz[2], pz[3]); o.z = pk2(pz[4], pz[5]); o.w = pk2(pz[6], pz[7]);
                    *(u32x4*)(A2b + (size_t)r * 1024 + 8 * lane) = o;
                    float xc[8];
                    const u32x4 t0 = cr[0], t1 = cr[1], t2 = cr[2];
                    const float f0[8] = {bflo(t0.x), bfhi(t0.x), bflo(t0.y), bfhi(t0.y), bflo(t0.z), bfhi(t0.z), bflo(t0.w), bfhi(t0.w)};
                    const float f1[8] = {bflo(t1.x), bfhi(t1.x), bflo(t1.y), bfhi(t1.y), bflo(t1.z), bfhi(t1.z), bflo(t1.w), bfhi(t1.w)};
                    const float f2[8] = {bflo(t2.x), bfhi(t2.x), bflo(t2.y), bfhi(t2.y), bflo(t2.z), bfhi(t2.z), bflo(t2.w), bfhi(t2.w)};
                    const float f3[8] = {bflo(cn.x), bfhi(cn.x), bflo(cn.y), bfhi(cn.y), bflo(cn.z), bfhi(cn.z), bflo(cn.w), bfhi(cn.w)};
#pragma unroll
                    for (int q = 0; q < 8; ++q) xc[q] = cb[q] + f0[q] * cw[0][q] + f1[q] * cw[1][q] + f2[q] * cw[2][q] + f3[q] * cw[3][q];
                    cr[0] = t1; cr[1] = t2; cr[2] = cn;
                    u32x4 o2; o2.x = pk2(xc[0], xc[1]); o2.y = pk2(xc[2], xc[3]); o2.z = pk2(xc[4], xc[5]); o2.w = pk2(xc[6], xc[7]);
                    *(u32x4*)(A2b + (size_t)r * 1024 + 512 + 8 * lane) = o2;
                }
            }
            SEAM(P + 1);
        }
        if (PHEN(4) && odd && IN(P + 1)) {
            PH_LOCALS;
            LAS float* STAT = (LAS float*)lds;
            LAS unsigned char* WSS = lds + 1024;
            LAS unsigned char* VT = lds + 1024 + 34816;
            const float* lng = kin(I_SGLNG) + jj * 1024, * lnb = kin(I_SGLNB) + jj * 1024;
            const bf16_t* WSMp = (const bf16_t*)(ws + WS_WSM) + (size_t)jj * 8 * 128 * 128;
            const float* bs = kin(I_SGBS) + jj * 8 * 128;
            const int fr = lane & 15, fq = lane >> 4;
            for (int it = vcu; it < T / 128; it += G) {
                const size_t row0 = (size_t)it * 128;
#pragma unroll 1
                for (int rb = 0; rb < 2; ++rb) {
                    u32x4 a8[8], b8[8];
#pragma unroll
                    for (int q = 0; q < 8; ++q) { const bf16_t* vp = Zb + (row0 + wave * 16 + rb * 8 + q) * 2048 + 1024; a8[q] = *(const u32x4*)(vp + 8 * lane); b8[q] = *(const u32x4*)(vp + 512 + 8 * lane); }
                    float sm[8], sq[8];
#pragma unroll
                    for (int q = 0; q < 8; ++q) {
                        const float f[16] = {bflo(a8[q].x), bfhi(a8[q].x), bflo(a8[q].y), bfhi(a8[q].y), bflo(a8[q].z), bfhi(a8[q].z), bflo(a8[q].w), bfhi(a8[q].w),
                                             bflo(b8[q].x), bfhi(b8[q].x), bflo(b8[q].y), bfhi(b8[q].y), bflo(b8[q].z), bfhi(b8[q].z), bflo(b8[q].w), bfhi(b8[q].w)};
                        float s1 = 0.f, s2 = 0.f;
#pragma unroll
                        for (int e = 0; e < 16; ++e) { s1 += f[e]; s2 += f[e] * f[e]; }
                        sm[q] = s1; sq[q] = s2;
                    }
#pragma unroll
                    for (int o = 1; o < 64; o <<= 1) {
#pragma unroll
                        for (int q = 0; q < 8; ++q) { sm[q] += __builtin_bit_cast(float, __builtin_amdgcn_ds_bpermute((lane ^ o) << 2, __builtin_bit_cast(int, sm[q])));
                            sq[q] += __builtin_bit_cast(float, __builtin_amdgcn_ds_bpermute((lane ^ o) << 2, __builtin_bit_cast(int, sq[q]))); }
                    }
                    if (lane < 8) { float m_ = sm[0], q_ = sq[0];
#pragma unroll
                        for (int q = 1; q < 8; ++q) { m_ = lane == q ? sm[q] : m_; q_ = lane == q ? sq[q] : q_; }
                        const float mean = m_ * (1.0f / 1024.0f), var = fmaxf(q_ * (1.0f / 1024.0f) - mean * mean, 0.f);
                        const int r = wave * 16 + rb * 8 + lane; STAT[2 * r] = mean; STAT[2 * r + 1] = 1.0f / sqrtf(var + LN_EPS); }
                }
                __syncthreads();
                u32x4 wv[4], vv[4];
#pragma unroll
                for (int i = 0; i < 4; ++i) { const int q = tid + 512 * i, row = q >> 4, c16 = q & 15;
                    wv[i] = *(const u32x4*)(WSMp + ((size_t)0 * 128 + row) * 128 + c16 * 8);
                    vv[i] = *(const u32x4*)(Zb + (row0 + row) * 2048 + 1024 + 0 * 128 + c16 * 8); }
#pragma unroll 1
                for (int hd = 0; hd < 8; ++hd) {
#pragma unroll
                    for (int i = 0; i < 4; ++i) {
                        const int q = tid + 512 * i, row = q >> 4, c16 = q & 15;
                        *(LAS u32x4*)(WSS + row * 272 + c16 * 16) = wv[i];
                        const u32x4 v4 = vv[i];
                        const float mean = STAT[2 * row], rstd = STAT[2 * row + 1];
                        const float f[8] = {bflo(v4.x), bfhi(v4.x), bflo(v4.y), bfhi(v4.y), bflo(v4.z), bfhi(v4.z), bflo(v4.w), bfhi(v4.w)};
                        const f32x4 g0 = *(const f32x4*)(lng + hd * 128 + c16 * 8), g1 = *(const f32x4*)(lng + hd * 128 + c16 * 8 + 4);
                        const f32x4 b0 = *(const f32x4*)(lnb + hd * 128 + c16 * 8), b1 = *(const f32x4*)(lnb + hd * 128 + c16 * 8 + 4);
                        const float gg[8] = {g0[0], g0[1], g0[2], g0[3], g1[0], g1[1], g1[2], g1[3]}, bb[8] = {b0[0], b0[1], b0[2], b0[3], b1[0], b1[1], b1[2], b1[3]};
#pragma unroll
                        for (int q2 = 0; q2 < 8; ++q2) {
                            const int c = c16 * 8 + q2;
                            const int rho = (c & ~31) | (((c >> 2) & 1) << 4) | (((c >> 3) & 3) << 2) | (c & 3);
                            *(LAS bf16_t*)(VT + rho * 272 + row * 2) = (bf16_t)f2bf((f[q2] - mean) * rstd * gg[q2] + bb[q2]);
                        }
                    }
                    const int hn = hd < 7 ? hd + 1 : 7;
#pragma unroll
                    for (int i = 0; i < 4; ++i) { const int q = tid + 512 * i, row = q >> 4, c16 = q & 15;
                        wv[i] = *(const u32x4*)(WSMp + ((size_t)hn * 128 + row) * 128 + c16 * 8);
                        vv[i] = *(const u32x4*)(Zb + (row0 + row) * 2048 + 1024 + hn * 128 + c16 * 8); }
                    const int t = 16 * wave + fr; const float bst = bs[hd * 128 + t];
                    const size_t rowg = row0 + t;
                    u32x4 uv[4];
#pragma unroll
                    for (int q = 0; q < 4; ++q) uv[q] = *(const u32x4*)(Zb + rowg * 2048 + hd * 128 + 32 * q + 8 * fq);
                    __syncthreads();
                    bf16x8 afr[4];
#pragma unroll
                    for (int ks = 0; ks < 4; ++ks) afr[ks] = *(const LAS bf16x8*)(WSS + (16 * wave + fr) * 272 + (32 * ks + 8 * fq) * 2);
                    f32x4 acc[8];
#pragma unroll
                    for (int tn = 0; tn < 8; ++tn) { acc[tn] = (f32x4){0.f, 0.f, 0.f, 0.f};
#pragma unroll
                        for (int ks = 0; ks < 4; ++ks) { const bf16x8 vfr = *(const LAS bf16x8*)(VT + (16 * tn + fr) * 272 + (32 * ks + 8 * fq) * 2);
                            acc[tn] = __builtin_amdgcn_mfma_f32_16x16x32_bf16(vfr, afr[ks], acc[tn], 0, 0, 0); } }
#pragma unroll
                    for (int q = 0; q < 4; ++q) {
                        const int c0 = hd * 128 + 32 * q + 8 * fq;
                        const u32x4 u4 = uv[q];
                        const f32x4 s0 = acc[2 * q] + bst, s1 = acc[2 * q + 1] + bst;
                        if (FP8_OUTP) { u32x2 o; o.x = pk4_fp8(bflo(u4.x) * s0[0], bfhi(u4.x) * s0[1], bflo(u4.y) * s0[2], bfhi(u4.y) * s0[3]);
                            o.y = pk4_fp8(bflo(u4.z) * s1[0], bfhi(u4.z) * s1[1], bflo(u4.w) * s1[2], bfhi(u4.w) * s1[3]);
                            *(u32x2*)((unsigned char*)YMb + rowg * 1024 + c0) = o; }
                        else { u32x4 o; o.x = pk2(bflo(u4.x) * s0[0], bfhi(u4.x) * s0[1]); o.y = pk2(bflo(u4.y) * s0[2], bfhi(u4.y) * s0[3]);
                        o.z = pk2(bflo(u4.z) * s1[0], bfhi(u4.z) * s1[1]); o.w = pk2(bflo(u4.w) * s1[2], bfhi(u4.w) * s1[3]);
                        *(u32x4*)(YMb + rowg * 1024 + c0) = o; }
                    }
                    __syncthreads();
                }
            }
            SEAM(P + 1);
        }
        if (PHEN(5) && !odd && IN(P + 2)) {
            PH_LOCALS;
            {
                pg8::Gemm g{A2b, (const bf16_t*)(ws + WS_BPOOL) + (size_t)jj * 512 * 512, 1024, 512, 256, 127};
                pg8::DenseSched S; S.init(T, 512, G, bx); S.kblk = 512;
                pg8::EpiDense<0, false, true, false, FP8_OUTP != 0> E{YMb, 1024, nullptr, kin(I_POOLS) + jj * 512, 0.f};
                pg8::gemm_phase<false>(lds, g, S, E, wave0);
            }
            {
                pg8::Gemm g{A2b + 512, (const bf16_t*)(ws + WS_BGATE) + (size_t)jj * 1024 * 512, 1024, 512, 256, 127};
                pg8::DenseSched S; S.init(T, 1024, G, bx); S.kblk = 512;
                pg8::EpiDense<2, true, false> E{RIb, 1024, (const float*)(ws + WS_BIASRI) + jj * 1024, nullptr, 0.f};
                pg8::gemm_phase<false>(lds, g, S, E, wave0);
            }
            SEAM(P + 2);
        }
        scan_phase<L, 0>(lo, hi, G, bar, wave0); scan_phase<L, 1>(lo, hi, G, bar, wave0);
        if (PHEN(7) && IN(P + 5)) {
            PH_LOCALS;
            const float* bo = odd ? kin(I_SGBOUT) + jj * 1024 : kin(I_ABBOUT) + jj * 1024;
            pg8::DenseSched S; S.init(T, 1024, G, bx);
            if (FP8_OUTP) { const unsigned char* wt = odd ? ws + WS_SGOUT + (size_t)jj * 1024 * 1024 : ws + WS_ABOUT + (size_t)jj * 1024 * 1024;
                pg8::Gemm g{YMb, wt, 1024, 1024, 1024, 121};
                pg8::EpiDense<0, true, false, true> E{Yb, 1024, bo, nullptr, 1.0f / 64.0f};
                pg8::gemm_phase<true>(lds, g, S, E, wave0); }
            else { const bf16_t* wt = odd ? (const bf16_t*)(ws + WS_SGOUT) + (size_t)jj * 1024 * 1024 : (const bf16_t*)(ws + WS_ABOUT) + (size_t)jj * 1024 * 1024;
                pg8::Gemm g{YMb, wt, 1024, 1024, 1024, 127};
                pg8::EpiDense<0, true, false> E{Yb, 1024, bo, nullptr, 0.f};
                pg8::gemm_phase<false>(lds, g, S, E, wave0); }
            SEAM(P + 5);
        }
        ln_phase<L, 0>(lo, hi, G, bar, wave0);
            if (PHEN(9) && IN(P + 7)) {
            PH_LOCALS;
                pg8::Gemm g{Hb, (const bf16_t*)(ws + WS_BR) + (size_t)l * 256 * 1024, 1024, 1024, 1024, 127};
                pg8::DenseSched S; S.init(T, 256, G, bx);
                pg8::EpiRouter E{LOGf};
                pg8::gemm_phase<false>(lds, g, S, E, wave0);
                SEAM(P + 7);
            }
            if (PHEN(10) && IN(P + 8)) {
            PH_LOCALS;
                volatile LAS unsigned* hist = LCTL + 96; volatile LAS unsigned* basev = LCTL + 128;
                unsigned* gcnt = ctl + CW_CNT + 64 * l;
                for (int t0 = vcu * 512; t0 < T; t0 += G * 512) {
                    if (tid < 32) hist[tid] = 0u;
                    __syncthreads();
                    const int tok = t0 + tid;
                    float lv[32];
                    { const f32x4* lp = (const f32x4*)(LOGf + (size_t)tok * 64);
#pragma unroll
                      for (int q = 0; q < 8; ++q) { const f32x4 a = lp[q], b2 = lp[8 + q], rb = *(const f32x4*)(kin(I_RB) + l * 32 + 4 * q);
                          lv[4 * q + 0] = a[0] + b2[0] + rb[0]; lv[4 * q + 1] = a[1] + b2[1] + rb[1]; lv[4 * q + 2] = a[2] + b2[2] + rb[2]; lv[4 * q + 3] = a[3] + b2[3] + rb[3]; } }
                    float v0 = -3.0e38f, v1 = -3.0e38f, v2 = -3.0e38f, v3 = -3.0e38f; int i0 = 0, i1 = 0, i2 = 0, i3 = 0;
#pragma unroll
                    for (int e = 0; e < 32; ++e) {
                        const float x = lv[e];
                        if (x > v3) {
                            if (x > v0) { v3 = v2; i3 = i2; v2 = v1; i2 = i1; v1 = v0; i1 = i0; v0 = x; i0 = e; }
                            else if (x > v1) { v3 = v2; i3 = i2; v2 = v1; i2 = i1; v1 = x; i1 = e; }
                            else if (x > v2) { v3 = v2; i3 = i2; v2 = x; i2 = e; }
                            else { v3 = x; i3 = e; }
                        }
                    }
                    const float e1 = __expf(v1 - v0), e2 = __expf(v2 - v0), e3 = __expf(v3 - v0), inv = 1.0f / (1.0f + e1 + e2 + e3);
                    *(f32x4*)(TOPG + (size_t)tok * 4) = (f32x4){inv, e1 * inv, e2 * inv, e3 * inv};
                    LAS unsigned* hp = (LAS unsigned*)hist;
                    const unsigned r0 = __hip_atomic_fetch_add(hp + i0, 1u, __ATOMIC_RELAXED, __HIP_MEMORY_SCOPE_WORKGROUP), r1 = __hip_atomic_fetch_add(hp + i1, 1u, __ATOMIC_RELAXED, __HIP_MEMORY_SCOPE_WORKGROUP),
                                   r2 = __hip_atomic_fetch_add(hp + i2, 1u, __ATOMIC_RELAXED, __HIP_MEMORY_SCOPE_WORKGROUP), r3 = __hip_atomic_fetch_add(hp + i3, 1u, __ATOMIC_RELAXED, __HIP_MEMORY_SCOPE_WORKGROUP);
                    __syncthreads();
                    if (tid < 32) basev[tid] = __hip_atomic_fetch_add(gcnt + tid, hist[tid], __ATOMIC_RELAXED, __HIP_MEMORY_SCOPE_AGENT);
                    __syncthreads();
                    LIST[(size_t)i0 * TKTOT + basev[i0] + r0] = tok * 4 + 0;
                    LIST[(size_t)i1 * TKTOT + basev[i1] + r1] = tok * 4 + 1;
                    LIST[(size_t)i2 * TKTOT + basev[i2] + r2] = tok * 4 + 2;
                    LIST[(size_t)i3 * TKTOT + basev[i3] + r3] = tok * 4 + 3;
                    __syncthreads();
                }
                SEAM(P + 8);
            }
            if (PHEN(11) && IN(P + 9)) {
                PH_LOCALS;
                volatile LAS int* cnts = (volatile LAS int*)(LCTL + 16); volatile LAS int* tstart = (volatile LAS int*)(LCTL + 48);
                if (tid < 32) cnts[tid] = (int)__hip_atomic_load(ctl + CW_CNT + 64 * l + tid, __ATOMIC_RELAXED, __HIP_MEMORY_SCOPE_AGENT);
                __syncthreads();
                if (tid == 0) { int s = 0; for (int e = 0; e < 32; ++e) { tstart[e] = s; s += (cnts[e] + 255) >> 8; } tstart[32] = s; }
                __syncthreads();
                LAS int* const utab = (LAS int*)(lds + UTAB_OFF);
                const int nunits = pg8::moe_build_units(utab, tstart, cnts, 8, G, bx, tid);
                __syncthreads();
                pg8::MoeSched S{(const LAS int*)utab, LIST, (const float*)(ws + WS_B1P) + (size_t)l * 32 * 2048, nunits, 2048, 2};
                pg8::EpiMoe1<FP8_M2 != 0> E{FP8_M2 ? (bf16_t*)(ws + WS_ACT8) : ACTb, lds, FP8_M1 ? 1.0f / 32.0f : 1.0f};
                if (FP8_M1) { pg8::Gemm g{ws + WS_H8, ws + WS_W1T8 + (size_t)l * 32 * 2048 * 1024, 1024, 1024, 1024, 122};
                    pg8::gemm_phase<true>(lds, g, S, E, wave0); }
                else { pg8::Gemm g{Hb, (const bf16_t*)(ws + WS_W1T) + (size_t)l * 32 * 2048 * 1024, 1024, 1024, 1024, 127};
                    pg8::gemm_phase<false>(lds, g, S, E, wave0); }
                SEAM(P + 9);
            }
            if (PHEN(12) && IN(P + 10)) {
                PH_LOCALS;
                volatile LAS int* cnts = (volatile LAS int*)(LCTL + 16); volatile LAS int* tstart = (volatile LAS int*)(LCTL + 48);
                __syncthreads();
                if (tid < 32) cnts[tid] = (int)__hip_atomic_load(ctl + CW_CNT + 64 * l + tid, __ATOMIC_RELAXED, __HIP_MEMORY_SCOPE_AGENT);
                __syncthreads();
                if (tid == 0) { int s = 0; for (int e = 0; e < 32; ++e) { tstart[e] = s; s += (cnts[e] + 255) >> 8; } tstart[32] = s; }
                __syncthreads();
                LAS int* const utab = (LAS int*)(lds + UTAB_OFF);
                const int nunits = pg8::moe_build_units(utab, tstart, cnts, 4, G, bx, tid);
                __syncthreads();
                pg8::MoeSched S{(const LAS int*)utab, LIST, kin(I_B2) + (size_t)l * 32 * 1024, nunits, 1024, 0};
                pg8::EpiMoe2 E{YSb, lds, FP8_M2 ? 1.0f / 64.0f : 1.0f};
                if (FP8_M2) { pg8::Gemm g{ws + WS_ACT8, ws + WS_W2T8 + (size_t)l * 32 * 1024 * 1024, 1024, 1024, 1024, 121};
                    pg8::gemm_phase<true>(lds, g, S, E, wave0); }
                else { pg8::Gemm g{ACTb, (const bf16_t*)(ws + WS_W2T) + (size_t)l * 32 * 1024 * 1024, 1024, 1024, 1024, 127};
                    pg8::gemm_phase<false>(lds, g, S, E, wave0); }
                SEAM(P + 10);
            }
        ln_phase<L, 1>(lo, hi, G, bar, wave0);
}

__global__ void __launch_bounds__(512, 2) fwd_kernel(Args args) {
    extern __shared__ __attribute__((aligned(16))) unsigned char lds_raw[];
    LAS unsigned char* const lds = (LAS unsigned char*)lds_raw;
    volatile LAS unsigned* const LCTL = (volatile LAS unsigned*)(lds + LDSCTL_OFF);
    const int G = gridDim.x;
    int lo, hi; unsigned* ctl0;
    { kptr_t kp = (kptr_t)__builtin_amdgcn_kernarg_segment_ptr(); lo = *(const __attribute__((address_space(4))) int*)(kp + 272); hi = *(const __attribute__((address_space(4))) int*)(kp + 276);
      ctl0 = (unsigned*)(*(unsigned char* const __attribute__((address_space(4)))*)(kp + 264) + WS_CTL); }
    const int wave0 = __builtin_amdgcn_readfirstlane((int)threadIdx.x >> 6);
    for (int u = threadIdx.x; u < (LDS_BYTES - LDSCTL_OFF) / 4; u += 512) LCTL[u] = 0u;
    __syncthreads();
    XcdBarrier bar; bar.bar = ctl0 + CW_BAR; bar.x = 0; bar.st = LCTL; bar.wv = wave0;
    if (hi - lo > 1) bar = xcd_barrier_post(ctl0 + CW_BAR, LCTL, wave0);
    if (PHEN(0) && IN(PH_CONV)) {
            PH_LOCALS;
        {
            LAS float* cact = (LAS float*)lds;
            LAS float* part = (LAS float*)(lds + 65536);
            if (bx < 384) {
                for (int i = tid; i < 16 * 1024; i += 512) { const float c = kin(I_C)[i]; cact[i] = c / (1.0f + __expf(-c)); }
                __syncthreads();
                for (int it = bx; it < 384; it += G) {
                    const int ls = it / 48, col0 = (it % 48) * 64;
                    const int kq = tid >> 6, cl = tid & 63;
                    const float* wp = kin(I_MODW) + (size_t)ls * 1024 * 3072 + col0 + cl;
                    float a[16];
#pragma unroll
                    for (int b = 0; b < 16; ++b) a[b] = 0.f;
#pragma unroll 4
                    for (int k = kq * 128; k < kq * 128 + 128; ++k) {
                        const float w = wp[(size_t)k * 3072];
#pragma unroll
                        for (int b = 0; b < 16; ++b) a[b] += cact[b * 1024 + k] * w;
                    }
#pragma unroll
                    for (int b = 0; b < 16; ++b) part[(kq * 16 + b) * 64 + cl] = a[b];
                    __syncthreads();
                    for (int o = tid; o < 1024; o += 512) {
                        const int b = o >> 6, c2 = o & 63; float s = 0.f;
#pragma unroll
                        for (int q = 0; q < 8; ++q) s += part[(q * 16 + b) * 64 + c2];
                        MOD[((size_t)ls * 16 + b) * 3072 + col0 + c2] = s + kin(I_MODB)[ls * 3072 + col0 + c2];
                    }
                    __syncthreads();
                }
            }
        }
        {
            constexpr int IT_ABIN = 2 * (FP8_INP ? 8 : 16) * 48, IT_ABOUT = 2 * (FP8_OUTP ? 8 : 16) * 32, IT_SGIN = 2 * (FP8_INP ? 8 : 16) * 64, IT_SGOUT = 2 * (FP8_OUTP ? 8 : 16) * 32, IT_W1 = 128 * (FP8_M1 ? 8 : 16) * 64, IT_W2 = 128 * (FP8_M2 ? 8 : 16) * 32;
            constexpr int IT_ALL = IT_ABIN + IT_ABOUT + IT_SGIN + IT_SGOUT + IT_W1 + IT_W2;
            for (int it = gw; it < IT_ALL; it += NGW) {
                int r = it;
                if (r < IT_ABIN) { if (FP8_INP) { const int mat = r / (8 * 48); conv_item_f8<false>(kin(I_ABWIN) + (size_t)mat * 1024 * 1536, 1536, ws + WS_ABIN + (size_t)mat * 1536 * 1024, r % (8 * 48), lane, 32.0f); }
                    else { const int mat = r / (16 * 48); conv_item<false>(kin(I_ABWIN) + (size_t)mat * 1024 * 1536, 1536, (bf16_t*)(ws + WS_ABIN) + (size_t)mat * 1536 * 1024, r % (16 * 48), lane); } continue; } r -= IT_ABIN;
                if (r < IT_ABOUT) { if (FP8_OUTP) { const int mat = r / (8 * 32); conv_item_f8<false>(kin(I_ABWOUT) + (size_t)mat * 1024 * 1024, 1024, ws + WS_ABOUT + (size_t)mat * 1024 * 1024, r % (8 * 32), lane, 64.0f); }
                    else { const int mat = r / (16 * 32); conv_item<false>(kin(I_ABWOUT) + (size_t)mat * 1024 * 1024, 1024, (bf16_t*)(ws + WS_ABOUT) + (size_t)mat * 1024 * 1024, r % (16 * 32), lane); } continue; } r -= IT_ABOUT;
                if (r < IT_SGIN) { if (FP8_INP) { const int mat = r / (8 * 64); conv_item_f8<false>(kin(I_SGWIN) + (size_t)mat * 1024 * 2048, 2048, ws + WS_SGIN + (size_t)mat * 2048 * 1024, r % (8 * 64), lane, 32.0f); }
                    else { const int mat = r / (16 * 64); conv_item<false>(kin(I_SGWIN) + (size_t)mat * 1024 * 2048, 2048, (bf16_t*)(ws + WS_SGIN) + (size_t)mat * 2048 * 1024, r % (16 * 64), lane); } continue; } r -= IT_SGIN;
                if (r < IT_SGOUT) { if (FP8_OUTP) { const int mat = r / (8 * 32); conv_item_f8<false>(kin(I_SGWOUT) + (size_t)mat * 1024 * 1024, 1024, ws + WS_SGOUT + (size_t)mat * 1024 * 1024, r % (8 * 32), lane, 64.0f); }
                    else { const int mat = r / (16 * 32); conv_item<false>(kin(I_SGWOUT) + (size_t)mat * 1024 * 1024, 1024, (bf16_t*)(ws + WS_SGOUT) + (size_t)mat * 1024 * 1024, r % (16 * 32), lane); } continue; } r -= IT_SGOUT;
                if (r < IT_W1) {
                    if (FP8_M1) { const int mat = r / (8 * 64); conv_item_f8<true>(kin(I_W1) + (size_t)mat * 1024 * 2048, 2048, ws + WS_W1T8 + (size_t)mat * 2048 * 1024, r % (8 * 64), lane, 32.0f); }
                    else { const int mat = r / (16 * 64); conv_item<true>(kin(I_W1) + (size_t)mat * 1024 * 2048, 2048, (bf16_t*)(ws + WS_W1T) + (size_t)mat * 2048 * 1024, r % (16 * 64), lane); }
                    continue; } r -= IT_W1;
                if (FP8_M2) { const int mat = r / (8 * 32); conv_item_f8<false>(kin(I_W2) + (size_t)mat * 1024 * 1024, 1024, ws + WS_W2T8 + (size_t)mat * 1024 * 1024, r % (8 * 32), lane, 64.0f); }
                else { const int mat = r / (16 * 32); conv_item<false>(kin(I_W2) + (size_t)mat * 1024 * 1024, 1024, (bf16_t*)(ws + WS_W2T) + (size_t)mat * 1024 * 1024, r % (16 * 32), lane); }
            }
        }
        {
            const int gt = vcu * 512 + tid, NGT = G * 512;
            bf16_t* BR = (bf16_t*)(ws + WS_BR);
            for (int i = gt; i < 4 * 256 * 1024; i += NGT) {
                const int l = i >> 18, n = (i >> 10) & 255, k = i & 1023; unsigned v = 0;
                if (n < 64) { const float w = kin(I_RW)[((size_t)l * 1024 + k) * 32 + (n & 31)]; const unsigned h = f2bf(w); v = h;
                    if (n >= 32) v = f2bf(w - __builtin_bit_cast(float, h << 16)); }
                BR[i] = (bf16_t)v;
            }
            bf16_t* BP = (bf16_t*)(ws + WS_BPOOL);
            for (int i = gt; i < 2 * 512 * 512; i += NGT) {
                const int j = i >> 18, n = (i >> 9) & 511, k = i & 511; unsigned v = 0;
                if ((n >> 7) == (k >> 7)) v = f2bf(kin(I_POOLW)[(((size_t)j * 4 + (n >> 7)) * 128 + (k & 127)) * 128 + (n & 127)]);
                BP[i] = (bf16_t)v;
            }
            bf16_t* BG = (bf16_t*)(ws + WS_BGATE);
            for (int i = gt; i < 2 * 1024 * 512; i += NGT) {
                const int j = i >> 19, n = (i >> 9) & 1023, k = i & 511; unsigned v = 0; const int nn = n & 511;
                if ((nn >> 6) == (k >> 6)) { const float* w = (n < 512) ? kin(I_WA) : kin(I_WX); v = f2bf(w[(((size_t)j * 8 + (nn >> 6)) * 64 + (k & 63)) * 64 + (nn & 63)]); }
                BG[i] = (bf16_t)v;
            }
            bf16_t* WSMp = (bf16_t*)(ws + WS_WSM);
            for (int i = gt; i < 2 * 8 * 128 * 128; i += NGT) {
                const int t = (i >> 7) & 127, s = i & 127; WSMp[i] = (bf16_t)((s <= t) ? f2bf(kin(I_SGWS)[i]) : 0u);
            }
            float* BRI = (float*)(ws + WS_BIASRI);
            for (int i = gt; i < 2 * 1024; i += NGT) { const int j = i >> 10, n = i & 1023; BRI[i] = (n < 512) ? kin(I_BA)[j * 512 + n] : kin(I_BX)[j * 512 + n - 512]; }
            float* B1P = (float*)(ws + WS_B1P);
            for (int i = gt; i < 4 * 32 * 2048; i += NGT) { const int le = i >> 11, rho = i & 2047; B1P[i] = kin(I_B1)[(size_t)le * 2048 + w1_n_of_rho(rho)]; }
        }
        SEAM(PH_CONV);
    }

    if (PHEN(1) && IN(PH_H0)) {
            PH_LOCALS;
        const int rows_per = T / NGW, r0 = gw * rows_per;
        const int b = r0 / SEQ;
        const float* shp = MOD + ((size_t)0 * 16 + b) * 3072, * scp = shp + 1024;
        f32x4 sh[4], sc[4];
#pragma unroll
        for (int j = 0; j < 4; ++j) { sh[j] = *(const f32x4*)(shp + 4 * (64 * j + lane)); sc[j] = *(const f32x4*)(scp + 4 * (64 * j + lane)); }
        for (int r = r0; r < r0 + rows_per; ++r) {
            const f32x4* xr = (const f32x4*)(kin(I_X) + (size_t)r * D) + lane;
            u32x2* hr = (u32x2*)(Hb + (size_t)r * D) + lane;
#pragma unroll
            for (int j = 0; j < 4; ++j) { const f32x4 v = xr[64 * j]; const f32x4 h = v * (sc[j] + 1.0f) + sh[j];
                if (FP8_INP) ((unsigned*)(ws + WS_H8 + (size_t)r * D) + lane)[64 * j] = pk4_fp8(h[0], h[1], h[2], h[3]);
                else { u32x2 w; w.x = pk2(h[0], h[1]); w.y = pk2(h[2], h[3]); hr[64 * j] = w; } }
        }
        SEAM(PH_H0);
    }

    layer_body<0>(lds, LCTL, lo, hi, G, bar, wave0); layer_body<1>(lds, LCTL, lo, hi, G, bar, wave0); layer_body<2>(lds, LCTL, lo, hi, G, bar, wave0); layer_body<3>(lds, LCTL, lo, hi, G, bar, wave0);
}
#undef IN
#undef SEAM

#ifdef DUMP_SPEC
struct DumpSrc { size_t off; int ld; int col0; };
__global__ void dump_kernel(const unsigned char* ws, float* out) {
    const DumpSrc srcs[8] = DUMP_SPEC;
    const size_t i = (size_t)blockIdx.x * blockDim.x + threadIdx.x;
    const int r = (int)(i >> 10), c = (int)(i & 1023), blk = c >> 7, cc = c & 127;
    const DumpSrc d = srcs[blk];
    const bf16_t* p = (const bf16_t*)(ws + d.off);
    out[i] = bf2f(p[(size_t)r * d.ld + d.col0 + cc]);
}
#endif
extern "C" void kernel_launch(void* const* d_in, const int* in_sizes, int n_in, void* d_out, int out_size, void* d_ws, size_t ws_size, hipStream_t stream) {
    static int grid = 0;
    if (grid == 0) {
        if (n_in != 32 || out_size != T * D || ws_size < WS_END) { fprintf(stderr, "kernel_launch: unexpected problem (n_in %d, out %d, ws %zu)\n", n_in, out_size, ws_size); grid = -1; return; }
        int dev = 0, cus = 0, per_cu = 0;
        if (hipGetDevice(&dev) != hipSuccess || hipDeviceGetAttribute(&cus, hipDeviceAttributeMultiprocessorCount, dev) != hipSuccess) { grid = -1; return; }
        if (hipFuncSetAttribute((const void*)fwd_kernel, hipFuncAttributeMaxDynamicSharedMemorySize, LDS_BYTES) != hipSuccess) { fprintf(stderr, "kernel_launch: hipFuncSetAttribute failed\n"); grid = -1; return; }
        if (hipOccupancyMaxActiveBlocksPerMultiprocessor(&per_cu, (const void*)fwd_kernel, 512, LDS_BYTES) != hipSuccess || per_cu < 1) fprintf(stderr, "kernel_launch: occupancy query says %d\n", per_cu);
        (void)hipGetLastError();
        grid = cus;
        if (grid * 8 > T || (T % (grid * 8)) != 0) { fprintf(stderr, "kernel_launch: grid %d does not divide the rows\n", grid); grid = -1; return; }
    }
    if (grid < 0) return;
    (void)hipMemsetAsync((char*)d_ws + WS_CTL, 0, CTL_ZERO_BYTES, stream);
    Args a{};
    for (int i = 0; i < 32; ++i) a.in[i] = (const float*)d_in[i];
    a.out = (float*)d_out; a.ws = (unsigned char*)d_ws;
#if MK_ONE_LAUNCH
    a.ph_lo = 0; a.ph_hi = NPH;
    hipLaunchKernelGGL(fwd_kernel, dim3(grid), dim3(512), LDS_BYTES, stream, a);
#else
#ifndef STOP_PH
#define STOP_PH NPH
#endif
    for (int ph = 0; ph < STOP_PH; ++ph) {
        if (!phase_exists(ph)) continue;
        a.ph_lo = ph; a.ph_hi = ph + 1;
        hipLaunchKernelGGL(fwd_kernel, dim3(grid), dim3(512), LDS_BYTES, stream, a);
#ifdef REP_SLOTS
        { const int slot = ph < PH_L0 ? ph : 2 + (ph - PH_L0) % PH_PER_LAYER; if ((REP_SLOTS >> slot) & 1) {
#ifdef PROBE_VARIANTS
            a.variant = PROBE_VARIANTS;
#endif
            hipLaunchKernelGGL(fwd_kernel, dim3(grid), dim3(512), LDS_BYTES, stream, a); a.variant = 0; } }
#endif
    }
#ifdef DUMP_SPEC
    hipLaunchKernelGGL(dump_kernel, dim3(T * 1024 / 256), dim3(256), 0, stream, (const unsigned char*)d_ws, (float*)d_out);
#endif
#endif
}
```

```cpp
#include <hip/hip_runtime.h>
#include <cstdio>
#include <cstdint>

#ifndef PIN_ACC
#define PIN_ACC 0
#endif
#ifndef FP8_M1
#define FP8_M1 1
#endif
#ifndef FP8_M2
#define FP8_M2 1
#endif
#ifndef FP8_YS
#define FP8_INP 0
#define FP8_OUTP 1
#define ROUTER_X 1
#define FP8_YS 1
#endif
#ifndef MK_ONE_LAUNCH
#define MK_ONE_LAUNCH 1
#endif

#ifndef PHMASK
#define PHMASK 0xFFFFF
#endif
#define PHEN(k) (((PHMASK) >> (k)) & 1)
#define LAS __attribute__((address_space(3)))
#define GAS __attribute__((address_space(1)))
typedef unsigned short bf16_t;
typedef short bf16x8 __attribute__((ext_vector_type(8)));
typedef float f32x4 __attribute__((ext_vector_type(4)));
typedef float f32x2 __attribute__((ext_vector_type(2)));
typedef unsigned u32x4 __attribute__((ext_vector_type(4)));
typedef unsigned u32x2 __attribute__((ext_vector_type(2)));

constexpr int D = 1024, NBATCH = 16, SEQ = 4096, T = NBATCH * SEQ, DEPTH = 4;
constexpr int NE = 32, TOPK = 4, TKTOT = T * TOPK;
constexpr int DPOOL = 512, DREC = 512, DINAB = 1536;
constexpr float LN_EPS = 1e-5f;
constexpr float DN_ALPHA = 1.6817928305074292f;

constexpr size_t MiB = 1ull << 20;
constexpr size_t WS_CTL = 0, CTL_ZERO_BYTES = 1 * MiB;
constexpr size_t WS_MOD = 1 * MiB;
constexpr size_t WS_BR = 3 * MiB;
constexpr size_t WS_BPOOL = 5 * MiB;
constexpr size_t WS_BGATE = 6 * MiB;
constexpr size_t WS_WSM = 8 * MiB;
constexpr size_t WS_BIASRI = 8 * MiB + 512 * 1024;
constexpr size_t WS_B1P = 9 * MiB;
constexpr size_t WS_SUMM = 10 * MiB;
constexpr size_t WS_TOPG = 12 * MiB;
constexpr size_t WS_ABIN = 16 * MiB;
constexpr size_t WS_ABOUT = 22 * MiB;
constexpr size_t WS_SGIN = 26 * MiB;
constexpr size_t WS_SGOUT = 34 * MiB;
constexpr size_t WS_LOG = 40 * MiB;
constexpr size_t WS_LIST = 64 * MiB;
constexpr size_t WS_BRB = 128 * MiB;
constexpr size_t WS_CB = 140 * MiB;
constexpr size_t WS_W1T = 128 * MiB;
constexpr size_t WS_W2T = 640 * MiB;
constexpr size_t WS_H = 896 * MiB;
constexpr size_t WS_Z = 1024 * MiB;
constexpr size_t WS_A2 = 1280 * MiB;
constexpr size_t WS_RI = 1408 * MiB;
constexpr size_t WS_YMIX = 1536 * MiB;
constexpr size_t WS_Y = 1664 * MiB;
constexpr size_t WS_ACT = 1792 * MiB;
constexpr size_t WS_YS = 2304 * MiB;
constexpr size_t WS_W1T8 = 2944 * MiB;
constexpr size_t WS_W2T8 = 3200 * MiB;
constexpr size_t WS_H8 = 3328 * MiB;
constexpr size_t WS_ACT8 = 3392 * MiB;
constexpr size_t WS_XB = 2816 * MiB;
constexpr size_t WS_END = 3648 * MiB;

constexpr int CW_BAR = 4096;
constexpr int CW_CNT = 16384;

constexpr int PH_CONV = 0, PH_H0 = 1, PH_L0 = 2, PH_PER_LAYER = 12, NPH = PH_L0 + PH_PER_LAYER * DEPTH;
__host__ __device__ constexpr bool phase_exists(int ph) {
    if (ph < PH_L0) return true;
    const int l = (ph - PH_L0) / PH_PER_LAYER, s = (ph - PH_L0) % PH_PER_LAYER;
    if ((l & 1) && (s == 2 || s == 3 || s == 4)) return false;
    return true;
}

constexpr int LDS_BYTES = 155648;
constexpr int LDSCTL_OFF = 154624;
constexpr int NXT_OFF = 131072;
constexpr int TAB_OFF = 147456;
constexpr int UTAB_OFF = 153600;

__device__ __forceinline__ unsigned f2bf(float f) { unsigned u = __builtin_bit_cast(unsigned, f); return (u + 0x7fffu + ((u >> 16) & 1u)) >> 16; }
typedef __bf16 bf16v2_t __attribute__((ext_vector_type(2)));
__device__ __forceinline__ unsigned pk2(float lo, float hi) { const f32x2 f = {lo, hi}; return __builtin_bit_cast(unsigned, __builtin_convertvector(f, bf16v2_t)); }
__device__ __forceinline__ float bflo(unsigned w) { return __builtin_bit_cast(float, w << 16); }
__device__ __forceinline__ float bfhi(unsigned w) { return __builtin_bit_cast(float, w & 0xffff0000u); }
__device__ __forceinline__ float bf2f(bf16_t h) { return __builtin_bit_cast(float, ((unsigned)h) << 16); }
__device__ __forceinline__ unsigned cvt_pk_bf16(float lo, float hi) { return pk2(lo, hi); }
__device__ __forceinline__ unsigned pk4_fp8(float a, float b, float c, float d) { int w = 0; w = __builtin_amdgcn_cvt_pk_fp8_f32(a, b, w, false); w = __builtin_amdgcn_cvt_pk_fp8_f32(c, d, w, true); return (unsigned)w; }
__device__ __forceinline__ float fast_sigmoid(float x) { return __builtin_amdgcn_rcpf(1.0f + __builtin_amdgcn_exp2f(-1.4426950408889634f * x)); }
__device__ __forceinline__ float gelu_tanh(float x) { const float u = x * (1.5957691216057308f + 0.07135481627362202f * x * x); return x * fast_sigmoid(u); }
__device__ __forceinline__ f32x2 pk_sigmoid_scaled(f32x2 x, float nk) {
    const f32x2 t = x * nk; f32x2 e; e.x = __builtin_amdgcn_exp2f(t.x); e.y = __builtin_amdgcn_exp2f(t.y);
    const f32x2 d = e + 1.0f; f32x2 r; r.x = __builtin_amdgcn_rcpf(d.x); r.y = __builtin_amdgcn_rcpf(d.y); return r; }
__device__ __forceinline__ f32x2 pk_gelu_tanh(f32x2 x) {
    const f32x2 t = x * ((x * x) * (-0.07135481627362202f * 1.4426950408889634f) + (-1.5957691216057308f * 1.4426950408889634f));
    f32x2 e; e.x = __builtin_amdgcn_exp2f(t.x); e.y = __builtin_amdgcn_exp2f(t.y);
    const f32x2 d = e + 1.0f; f32x2 r; r.x = __builtin_amdgcn_rcpf(d.x); r.y = __builtin_amdgcn_rcpf(d.y); return x * r; }
__device__ __forceinline__ float wave_sum(float v, int lane) {
#pragma unroll
    for (int o = 1; o < 64; o <<= 1) v += __builtin_bit_cast(float, __builtin_amdgcn_ds_bpermute((lane ^ o) << 2, __builtin_bit_cast(int, v)));
    return v;
}

__device__ __forceinline__ int lane_id_asm() { int l; asm volatile("v_mbcnt_lo_u32_b32 %0, -1, 0\n\tv_mbcnt_hi_u32_b32 %0, -1, %0" : "=v"(l)); return l; }
#define XB_TMO      128
#define XB_XCNT(j)  (256  + 64 * (j))
#define XB_XSUB(j)  (1280 + 64 * (j))
#define XB_XGEN(j)  (2304 + 64 * (j))
#define XB_TOP      3328
#define XB_TOPGEN   3392
#define XCD_BAR_WORDS 3456
#define XB_SPIN_CAP (1u << 18)

__device__ __forceinline__ unsigned xb_ld(unsigned* p)              { return __hip_atomic_load(p, __ATOMIC_RELAXED, __HIP_MEMORY_SCOPE_AGENT); }
__device__ __forceinline__ unsigned xb_add(unsigned* p, unsigned v) { return __hip_atomic_fetch_add(p, v, __ATOMIC_RELAXED, __HIP_MEMORY_SCOPE_AGENT); }
__device__ __forceinline__ unsigned xb_xcc_id() { return (unsigned)__builtin_amdgcn_s_getreg((3 << 11) | 20) & 0xFu; }
#define XB_SPIN(cond, bar) do { unsigned _sp = 0; while (cond) { __builtin_amdgcn_s_sleep(1); \
    if ((++_sp & 255u) == 0u) { if (xb_ld(&(bar)[XB_TMO])) break; if (_sp > XB_SPIN_CAP) { atomicAdd(&(bar)[XB_TMO], 1u); break; } } } } while (0)

struct XcdBarrier {
    unsigned* bar; unsigned x; int wv;
    volatile LAS unsigned* st;
};

__device__ __forceinline__ XcdBarrier xcd_barrier_post(unsigned* bar, volatile LAS unsigned* st, int wv) {
    XcdBarrier b; b.bar = bar; b.x = xb_xcc_id(); b.st = st; b.wv = wv;
    if (wv == 0 && lane_id_asm() == 0) (void)xb_add(&bar[XB_XCNT(b.x)], 1u);
    return b;
}
__device__ __forceinline__ void xcd_barrier_complete(unsigned* bar, unsigned x, unsigned& nloc, unsigned& nx) {
    const unsigned G = gridDim.x * gridDim.y * gridDim.z;
    unsigned sum, cnt, mine, sp = 0u;
    for (;;) {
        sum = 0u; cnt = 0u; mine = 0u;
#pragma unroll
        for (unsigned j = 0; j < 16; ++j) { const unsigned c = xb_ld(&bar[XB_XCNT(j)]); sum += c; cnt += (c > 0u) ? 1u : 0u; mine = (j == x) ? c : mine; }
        if (sum == G) break;
        __builtin_amdgcn_s_sleep(1);
        if ((++sp & 255u) == 0u) { if (xb_ld(&bar[XB_TMO])) break; if (sp > XB_SPIN_CAP) { atomicAdd(&bar[XB_TMO], 1u); break; } }
    }
    nloc = mine > 0u ? mine : 1u; nx = cnt > 0u ? cnt : 1u;
}

__device__ __forceinline__ void xcd_barrier(const XcdBarrier& b) {
    asm volatile("s_waitcnt vmcnt(0)" ::: "memory");
    __syncthreads();
    if (b.wv == 0 && lane_id_asm() == 0) {
        unsigned* bar = b.bar;
        __builtin_amdgcn_s_waitcnt(0);
        unsigned nloc = b.st[0], nx = b.st[1];
        if (nloc == 0u) { xcd_barrier_complete(bar, b.x, nloc, nx); b.st[0] = nloc; b.st[1] = nx; }
        const unsigned old = xb_add(&bar[XB_XSUB(b.x)], 1u);
        const unsigned gen = old / nloc;
        if (old + 1u == (gen + 1u) * nloc) {
            __builtin_amdgcn_fence(__ATOMIC_RELEASE, "agent");
            asm volatile("s_waitcnt vmcnt(0)" ::: "memory");
            const unsigned og = xb_add(&bar[XB_TOP], 1u);
            const unsigned tg = og / nx;
            if (og + 1u == (tg + 1u) * nx) xb_add(&bar[XB_TOPGEN], 1u);
            else XB_SPIN(xb_ld(&bar[XB_TOPGEN]) == tg, bar);
            __builtin_amdgcn_fence(__ATOMIC_ACQUIRE, "agent");
            xb_add(&bar[XB_XGEN(b.x)], 1u);
            asm volatile("s_waitcnt vmcnt(0)" ::: "memory");
        } else {
            XB_SPIN(xb_ld(&bar[XB_XGEN(b.x)]) == gen, bar);
            __builtin_amdgcn_fence(__ATOMIC_ACQUIRE, "agent");
            asm volatile("s_waitcnt vmcnt(0)" ::: "memory");
        }
    }
    __syncthreads();
}

#ifdef PROBE_VARIANTS
__device__ __forceinline__ int kvariant() { return *(const __attribute__((address_space(4))) int*)((const __attribute__((address_space(4))) unsigned char*)__builtin_amdgcn_kernarg_segment_ptr() + 280); }
#endif
__device__ __forceinline__ void glds16(const char* sbase, unsigned voff, unsigned lds_dst) {
    unsigned keep;
    asm volatile("s_mov_b32 %0, m0\n\ts_mov_b32 m0, %3\n\ts_nop 0\n\tglobal_load_lds_dwordx4 %1, %2\n\ts_mov_b32 m0, %0" : "=&s"(keep) : "v"(voff), "s"(sbase), "s"(lds_dst) : "memory");
}
__device__ __forceinline__ void glds4(const char* sbase, unsigned voff, unsigned lds_dst) {
    unsigned keep;
    asm volatile("s_mov_b32 %0, m0\n\ts_mov_b32 m0, %3\n\ts_nop 0\n\tglobal_load_lds_dword %1, %2\n\ts_mov_b32 m0, %0" : "=&s"(keep) : "v"(voff), "s"(sbase), "s"(lds_dst) : "memory");
}
namespace pg8 {
constexpr int BM = 256, BK = 64, HALF = 128, HTB = HALF * BK * 2, STAGE_BYTES = 8 * HTB, NXCD = 8, WGM = 8;
__host__ __device__ __forceinline__ int perm32(int rho) { const int n = rho >> 4, i = rho & 15; return 8 * (i >> 2) + 4 * n + (i & 3); }

template <bool F8> __host__ __device__ __forceinline__ int chunk_xor(int r15) { const int rp = (r15 >> 1) & 7; return F8 ? ((rp & 4) | ((rp & 1) << 1) | ((rp >> 1) & 1)) : rp; }
struct Unit { int arow, brow, pn, e, rt, cnt, slot, koff; };
struct Gemm { const void* A; const void* Bt; int lda, ldb, K, wscale; };
typedef int i32x4 __attribute__((ext_vector_type(4)));
typedef int i32x8 __attribute__((ext_vector_type(8)));
__device__ __forceinline__ i32x8 cat8(bf16x8 lo, bf16x8 hi) { return __builtin_shufflevector(__builtin_bit_cast(i32x4, lo), __builtin_bit_cast(i32x4, hi), 0, 1, 2, 3, 4, 5, 6, 7); }

struct DenseSched {
    static constexpr bool GATHER = false;
    int nM, nN, nwg, G, c, kblk = 0, bb = 0;
    __device__ __forceinline__ void init(int M, int N, int G_, int c_) { nM = M / BM; nN = N / BM; nwg = nM * nN; G = G_; c = c_; }
    __device__ __forceinline__ bool next(int i, Unit& u) const {
        const long L = (long)i * G + c; if (L >= nwg) return false;
        int wgid = (int)L; { const int q = nwg / NXCD, r = nwg % NXCD, xcd = wgid % NXCD, off = wgid / NXCD; wgid = (xcd < r ? xcd * (q + 1) : r * (q + 1) + (xcd - r) * q) + off; }
        const int nig = WGM * nN, gid = wgid / nig, fm = gid * WGM, gsz = (nM - fm) < WGM ? (nM - fm) : WGM;
        const int pm = fm + ((wgid % nig) % gsz), pn = (wgid % nig) / gsz;
        u.arow = pm * BM; u.brow = pn * BM; u.pn = pn; u.e = 0; u.rt = pm; u.cnt = BM; u.slot = 0; u.koff = (pn & 1) * kblk; u.brow += ((pm * BM) >> 12) * bb; return true;
    }
    __device__ __forceinline__ void a_off(const Unit& u, LAS unsigned char*, int R0, int C0, int lda2, unsigned (&off)[2][2]) const {
#pragma unroll
        for (int h = 0; h < 2; ++h)
#pragma unroll
            for (int i = 0; i < 2; ++i) off[h][i] = (unsigned)((u.arow + 128 * h + 64 * i + R0) * lda2 + C0);
    }
};

struct MoeSched {
    static constexpr bool GATHER = true;
    const LAS int* utab;
    const int* list;
    const float* bias;
    int nunits, nexp_rows, shift;
    __device__ __forceinline__ bool next(int i, Unit& u) const {
        if (i >= nunits) return false;
        const LAS int* p = utab + 4 * i;
        u.e = __builtin_amdgcn_readfirstlane(p[0]); u.rt = __builtin_amdgcn_readfirstlane(p[1]); u.pn = __builtin_amdgcn_readfirstlane(p[2]); u.cnt = __builtin_amdgcn_readfirstlane(p[3]);
        u.arow = 0; u.brow = u.e * nexp_rows + u.pn * BM; u.slot = i % 3; u.koff = 0; return true;
    }
    __device__ __forceinline__ void tab_issue(const Unit& u, unsigned ldsb, int wid, int lane) const {
        if (wid < 4) { int p = u.rt * BM + 64 * wid + lane; p = p < u.cnt ? p : u.cnt - 1;
            glds4((const char*)(list + (size_t)u.e * TKTOT), (unsigned)p * 4u, ldsb + TAB_OFF + u.slot * 1024 + wid * 256); }
        else glds4((const char*)(bias + (size_t)u.e * nexp_rows + u.pn * BM), (unsigned)(64 * (wid - 4) + lane) * 4u, ldsb + TAB_OFF + 3072 + u.slot * 1024 + (wid - 4) * 256);
    }
    __device__ __forceinline__ void a_off(const Unit& u, LAS unsigned char* lds, int R0, int C0, int lda2, unsigned (&off)[2][2]) const {
        const LAS int* ids = (const LAS int*)(lds + TAB_OFF + u.slot * 1024);
#pragma unroll
        for (int h = 0; h < 2; ++h)
#pragma unroll
            for (int i = 0; i < 2; ++i) off[h][i] = (unsigned)((ids[128 * h + 64 * i + R0] >> shift) * lda2 + C0);
    }
};
__device__ __forceinline__ int moe_build_units(LAS int* utab, const volatile LAS int* tstart, const volatile LAS int* cnts, int NP, int G, int c, int tid) {
    const int total = tstart[NE] * NP;
    if (tid < 64) { const int L = tid * G + c;
        if (L < total) { int e = 0;
            for (int q = 0; q < NE - 1; ++q) if (tstart[q + 1] * NP <= L) e = q + 1;
            const int t0 = tstart[e], nte = tstart[e + 1] - t0, idx = L - t0 * NP;
            utab[4 * tid + 0] = e; utab[4 * tid + 1] = idx % nte; utab[4 * tid + 2] = idx / nte; utab[4 * tid + 3] = cnts[e]; } }
    return total > c ? (total - c + G - 1) / G : 0;
}

template <int ACT  , bool HAS_BIAS, bool HAS_SCALE, bool OSC = false, bool OUT8 = false> struct EpiDense {
    static constexpr bool PERM = true;
    bf16_t* O; int ldc; const float* bias; const float* scale; float oscale;
    __device__ __forceinline__ void operator()(const f32x4 (&acc)[2][2][4][2], const Unit& u, int wr, int wc, int fr, int fq) const {
        const int row0 = u.arow + wr * 64 + fr, col0 = u.pn * BM + wc * 32 + 8 * fq;
        f32x4 bv[2][2], sv[2][2];
#pragma unroll
        for (int bj = 0; bj < 2; ++bj)
#pragma unroll
            for (int n = 0; n < 2; ++n) {
                if (HAS_BIAS) bv[bj][n] = *(const f32x4*)(bias + col0 + bj * HALF + 4 * n);
                if (HAS_SCALE) sv[bj][n] = *(const f32x4*)(scale + col0 + bj * HALF + 4 * n);
            }
#pragma unroll
        for (int ai = 0; ai < 2; ++ai)
#pragma unroll
            for (int m = 0; m < 4; ++m) { bf16_t* rowp = O + (size_t)(row0 + ai * HALF + m * 16) * ldc + col0; unsigned char* rowp8 = (unsigned char*)O + (size_t)(row0 + ai * HALF + m * 16) * ldc + col0;
#pragma unroll
                for (int bj = 0; bj < 2; ++bj) { f32x4 v0 = acc[ai][bj][m][0], v1 = acc[ai][bj][m][1];
                    if (OSC) { v0 = v0 * oscale; v1 = v1 * oscale; }
                    if (HAS_BIAS) { v0 = v0 + bv[bj][0]; v1 = v1 + bv[bj][1]; }
                    if (ACT == 1) { const f32x2 a = pk_gelu_tanh((f32x2){v0[0], v0[1]}), b = pk_gelu_tanh((f32x2){v0[2], v0[3]}), c = pk_gelu_tanh((f32x2){v1[0], v1[1]}), d = pk_gelu_tanh((f32x2){v1[2], v1[3]});
                        v0 = (f32x4){a.x, a.y, b.x, b.y}; v1 = (f32x4){c.x, c.y, d.x, d.y}; }
                    if (ACT == 2) { const float nk = -1.4426950408889634f;
                        const f32x2 a = pk_sigmoid_scaled((f32x2){v0[0], v0[1]}, nk), b = pk_sigmoid_scaled((f32x2){v0[2], v0[3]}, nk), c = pk_sigmoid_scaled((f32x2){v1[0], v1[1]}, nk), d = pk_sigmoid_scaled((f32x2){v1[2], v1[3]}, nk);
                        v0 = (f32x4){a.x, a.y, b.x, b.y}; v1 = (f32x4){c.x, c.y, d.x, d.y}; }
                    if (HAS_SCALE) { v0 = v0 * sv[bj][0]; v1 = v1 * sv[bj][1]; }
                    if constexpr (OUT8) { u32x2 w; w.x = pk4_fp8(v0[0], v0[1], v0[2], v0[3]); w.y = pk4_fp8(v1[0], v1[1], v1[2], v1[3]); *(u32x2*)(rowp8 + bj * HALF) = w; }
                    else { u32x4 w; w.x = cvt_pk_bf16(v0[0], v0[1]); w.y = cvt_pk_bf16(v0[2], v0[3]); w.z = cvt_pk_bf16(v1[0], v1[1]); w.w = cvt_pk_bf16(v1[2], v1[3]);
                    *(u32x4*)(rowp + bj * HALF) = w; } } }
    }
};
struct EpiRouter {
    static constexpr bool PERM = false;
    float* LOG;
    __device__ __forceinline__ void operator()(const f32x4 (&acc)[2][2][4][2], const Unit& u, int wr, int wc, int fr, int fq) const {
        if (wc < 2) {
#pragma unroll
            for (int ai = 0; ai < 2; ++ai)
#pragma unroll
                for (int m = 0; m < 4; ++m) { float* rowp = LOG + (size_t)(u.arow + ai * HALF + wr * 64 + m * 16 + fr) * 64 + wc * 32 + 4 * fq;
#pragma unroll
                    for (int n = 0; n < 2; ++n) *(f32x4*)(rowp + 16 * n) = acc[ai][0][m][n]; }
        }
    }
};
template <bool OUT8> struct EpiMoe1 {
    static constexpr bool PERM = false;
    bf16_t* ACT; LAS unsigned char* lds; float oscale;
    __device__ __forceinline__ void operator()(const f32x4 (&acc)[2][2][4][2], const Unit& u, int wr, int wc, int fr, int fq) const {
        const LAS int* ids = (const LAS int*)(lds + TAB_OFF + u.slot * 1024);
        const LAS float* bp = (const LAS float*)(lds + TAB_OFF + 3072 + u.slot * 1024) + wc * 32 + 4 * fq;
        f32x4 bg[2], bl[2];
#pragma unroll
        for (int bj = 0; bj < 2; ++bj) { bg[bj] = *(const LAS f32x4*)(bp + bj * HALF); bl[bj] = *(const LAS f32x4*)(bp + bj * HALF + 16) + 1.0f; }
        const int j0 = u.pn * 128 + wc * 32 + 8 * fq;
#pragma unroll
        for (int ai = 0; ai < 2; ++ai)
#pragma unroll
            for (int m = 0; m < 4; ++m) {
                const int pl = ai * HALF + wr * 64 + m * 16 + fr;
                if (u.rt * BM + pl < u.cnt) {
                    const int flat = ids[pl];
                    float o[8];
#pragma unroll
                    for (int bj = 0; bj < 2; ++bj) { const f32x4 g = acc[ai][bj][m][0] * oscale + bg[bj], l = acc[ai][bj][m][1] * oscale + bl[bj];
#pragma unroll
                        for (int hh = 0; hh < 2; ++hh) {
                            const f32x2 xg = {fminf(g[2 * hh], 7.0f), fminf(g[2 * hh + 1], 7.0f)};
                            const f32x2 xl = {__builtin_amdgcn_fmed3f(l[2 * hh], -6.0f, 8.0f), __builtin_amdgcn_fmed3f(l[2 * hh + 1], -6.0f, 8.0f)};
                            const f32x2 r = pk_sigmoid_scaled(xg, -1.702f * 1.4426950408889634f), oo = (xg * xl) * r;
                            o[bj * 4 + 2 * hh] = oo.x; o[bj * 4 + 2 * hh + 1] = oo.y; } }
                    if constexpr (OUT8) { u32x2 w; w.x = pk4_fp8(o[0], o[1], o[2], o[3]); w.y = pk4_fp8(o[4], o[5], o[6], o[7]);
                        *(u32x2*)((unsigned char*)ACT + (size_t)flat * 1024 + j0) = w; }
                    else { u32x4 w; w.x = cvt_pk_bf16(o[0], o[1]); w.y = cvt_pk_bf16(o[2], o[3]); w.z = cvt_pk_bf16(o[4], o[5]); w.w = cvt_pk_bf16(o[6], o[7]);
                        *(u32x4*)(ACT + (size_t)flat * 1024 + j0) = w; }
                }
            }
    }
};
struct EpiMoe2 {
    static constexpr bool PERM = true;
    bf16_t* YS; LAS unsigned char* lds; float oscale;
    __device__ __forceinline__ void operator()(const f32x4 (&acc)[2][2][4][2], const Unit& u, int wr, int wc, int fr, int fq) const {
        const LAS int* ids = (const LAS int*)(lds + TAB_OFF + u.slot * 1024);
        const LAS float* bp = (const LAS float*)(lds + TAB_OFF + 3072 + u.slot * 1024) + wc * 32 + 8 * fq;
        const int col0 = u.pn * BM + wc * 32 + 8 * fq;
#pragma unroll
        for (int bj = 0; bj < 2; ++bj) {
            const float os = FP8_YS ? 16.0f * oscale : oscale;
            const f32x4 b0 = *(const LAS f32x4*)(bp + bj * HALF) * (FP8_YS ? 16.0f : 1.0f), b1 = *(const LAS f32x4*)(bp + bj * HALF + 4) * (FP8_YS ? 16.0f : 1.0f);
#pragma unroll
            for (int ai = 0; ai < 2; ++ai)
#pragma unroll
                for (int m = 0; m < 4; ++m) {
                    const int pl = ai * HALF + wr * 64 + m * 16 + fr;
                    if (u.rt * BM + pl < u.cnt) {
                        const int flat = ids[pl];
                        const f32x4 v0 = acc[ai][bj][m][0] * os + b0, v1 = acc[ai][bj][m][1] * os + b1;
                        if (FP8_YS) { u32x2 w; w.x = pk4_fp8(v0[0], v0[1], v0[2], v0[3]); w.y = pk4_fp8(v1[0], v1[1], v1[2], v1[3]);
                            *(u32x2*)((unsigned char*)YS + (size_t)flat * 1024 + col0 + bj * HALF) = w; }
                        else { u32x4 w; w.x = cvt_pk_bf16(v0[0], v0[1]); w.y = cvt_pk_bf16(v0[2], v0[3]); w.z = cvt_pk_bf16(v1[0], v1[1]); w.w = cvt_pk_bf16(v1[2], v1[3]);
                            *(u32x4*)(YS + (size_t)flat * 1024 + col0 + bj * HALF) = w; }
                    }
                }
        }
    }
};

template <bool F8, class Epi, class Sched>
__device__ __forceinline__ void gemm_phase(LAS unsigned char* lds, const Gemm g, const Sched& S, const Epi& E, const int wave0) {
    const int tid = (wave0 << 6) | lane_id_asm();
    const int wid = __builtin_amdgcn_readfirstlane(tid >> 6), lane = tid & 63, wr = wid >> 2, wc = wid & 3, fr = lane & 15, fq = lane >> 4;
    constexpr unsigned ESZ = F8 ? 1u : 2u;
    const int nt = (int)((unsigned)g.K * ESZ / 128u);
    int R0, C0;
    R0 = 8 * wid + (lane >> 3); C0 = 16 * ((lane & 7) ^ chunk_xor<F8>(R0 & 15));
    const unsigned lda2 = (unsigned)g.lda * ESZ, ldb2 = (unsigned)g.ldb * ESZ;
    const unsigned voffB = (unsigned)((Epi::PERM ? ((R0 & ~31) + perm32(R0 & 31)) : R0) * (int)ldb2 + C0);
    const unsigned aoffl = (unsigned)(R0 * (int)lda2 + C0);
    const unsigned kstep = 128;
    const size_t hstepB = (size_t)HALF * ldb2;
    const unsigned ldsw = (unsigned)wid * 1024u;
    const int ab = fr * 128 + 16 * ((F8 ? 2 * fq : fq) ^ chunk_xor<F8>(fr));
    const int aoff0 = wr * 8192 + ab, boff0 = wc * 4096 + ab;
    constexpr int KX = F8 ? 16 : 64;
    const char* const Abase = (const char*)g.A;
    const unsigned ldsb = (unsigned)(size_t)lds;
#define PG8_SA(b, h) (((b) * 2 + (h)) * HTB)
#define PG8_SB(b, h) ((4 + (b) * 2 + (h)) * HTB)
#define PG8_GOFF(h, NXT) do { if constexpr (Sched::GATHER) go = *(const LAS u32x2*)(lds + NXT_OFF + ((((NXT) ? ui + 1 : ui) & 1) << 13) + tid * 16 + (h) * 8); } while (0)
#define PG8_STAGE_A(bufoff, h, NXT, kb) do { _Pragma("unroll") for (int _i = 0; _i < 2; ++_i) { \
        if constexpr (Sched::GATHER) glds16(Abase + (kb), _i ? go.y : go.x, ldsb + (bufoff) + ldsw + _i * 8192); \
        else glds16(Abase + ((NXT) ? nxtA : curA) + (size_t)((h) * 128 + _i * 64) * lda2 + (kb), aoffl, ldsb + (bufoff) + ldsw + _i * 8192); } } while (0)
#define PG8_STAGE_B(bufoff, bptr, kb) do { _Pragma("unroll") for (int _i = 0; _i < 2; ++_i) \
        glds16((bptr) + (size_t)(_i * 64) * ldb2 + (kb), voffB, ldsb + (bufoff) + ldsw + _i * 8192); } while (0)
#define PG8_LDA(dst, b, h) do { int _a1 = aoff0 ^ KX; asm volatile("" : "+v"(_a1)); \
        _Pragma("unroll") for (int m = 0; m < 4; ++m) _Pragma("unroll") for (int k = 0; k < 2; ++k) dst[m][k] = *(const LAS bf16x8*)(lds + PG8_SA(b, h) + (k ? _a1 : aoff0) + m * 2048); } while (0)
#define PG8_LDB(dst, b, h) do { int _b1 = boff0 ^ KX; asm volatile("" : "+v"(_b1)); \
        _Pragma("unroll") for (int n = 0; n < 2; ++n) _Pragma("unroll") for (int k = 0; k < 2; ++k) dst[n][k] = *(const LAS bf16x8*)(lds + PG8_SB(b, h) + (k ? _b1 : boff0) + n * 2048); } while (0)
#define PG8_MMA(ai, bj, At, Bt) do { __builtin_amdgcn_s_setprio(1); _Pragma("unroll") for (int m = 0; m < 4; ++m) _Pragma("unroll") for (int n = 0; n < 2; ++n) { \
        if constexpr (F8) acc[ai][bj][m][n] = __builtin_amdgcn_mfma_scale_f32_16x16x128_f8f6f4(cat8(Bt[n][0], Bt[n][1]), cat8(At[m][0], At[m][1]), acc[ai][bj][m][n], 0, 0, 0, 0, 0, 0); \
        else { _Pragma("unroll") for (int k = 0; k < 2; ++k) acc[ai][bj][m][n] = __builtin_amdgcn_mfma_f32_16x16x32_bf16(Bt[n][k], At[m][k], acc[ai][bj][m][n], 0, 0, 0); } } \
        __builtin_amdgcn_s_setprio(0); } while (0)
#define PG8_WAIT_V(n) asm volatile("s_waitcnt vmcnt(" #n ")" ::: "memory")
#define PG8_WAIT_L(n) asm volatile("s_waitcnt lgkmcnt(" #n ")" ::: "memory")
#define PG8_BAR __builtin_amdgcn_s_barrier()
#define PG8_SCHED __builtin_amdgcn_sched_barrier(0)
#define PG8_KITER(k1, b2, NXT, k2, k3) do { \
        PG8_GOFF(1, 0); PG8_LDB(B0, 0, 0); PG8_LDB(B1, 0, 1); PG8_SCHED; PG8_LDA(At, 0, 0); PG8_STAGE_A(PG8_SA(1, 1), 1, 0, (k1)); \
        PG8_WAIT_V(8); PG8_WAIT_L(0); PG8_BAR; PG8_MMA(0, 0, At, B0); PG8_MMA(0, 1, At, B1); PG8_BAR; PG8_SCHED; \
        PG8_GOFF(0, NXT); PG8_LDA(At, 0, 1); PG8_STAGE_B(PG8_SB(0, 0), (b2), (k2)); PG8_STAGE_B(PG8_SB(0, 1), (b2) + hstepB, (k2)); PG8_STAGE_A(PG8_SA(0, 0), 0, NXT, (k2)); \
        PG8_WAIT_V(8); PG8_WAIT_L(0); PG8_BAR; PG8_MMA(1, 0, At, B0); PG8_MMA(1, 1, At, B1); PG8_BAR; PG8_SCHED; \
        PG8_GOFF(1, NXT); PG8_LDB(B0, 1, 0); PG8_LDB(B1, 1, 1); PG8_SCHED; PG8_LDA(At, 1, 0); PG8_STAGE_A(PG8_SA(0, 1), 1, NXT, (k2)); \
        PG8_WAIT_V(8); PG8_WAIT_L(0); PG8_BAR; PG8_MMA(0, 0, At, B0); PG8_MMA(0, 1, At, B1); PG8_BAR; PG8_SCHED; \
        PG8_GOFF(0, NXT); PG8_LDA(At, 1, 1); PG8_STAGE_B(PG8_SB(1, 0), (b2), (k3)); PG8_STAGE_B(PG8_SB(1, 1), (b2) + hstepB, (k3)); PG8_STAGE_A(PG8_SA(1, 0), 0, NXT, (k3)); \
        PG8_WAIT_V(8); PG8_WAIT_L(0); PG8_BAR; PG8_MMA(1, 0, At, B0); PG8_MMA(1, 1, At, B1); PG8_BAR; PG8_SCHED; } while (0)

    Unit cur, nxt; int ui = 0;
    if (!S.next(0, cur)) return;
    unsigned curoff[2][2], nxtoff[2][2];
    size_t curA = 0, nxtA = 0;
    bool has_next = S.next(1, nxt);
#define PG8_NXT_SLOT ((LAS u32x4*)(lds + NXT_OFF) + tid)
    if constexpr (Sched::GATHER) {
        S.tab_issue(cur, ldsb, wid, lane); if (has_next) S.tab_issue(nxt, ldsb, wid, lane);
        asm volatile("s_waitcnt vmcnt(0)" ::: "memory"); __builtin_amdgcn_s_barrier(); asm volatile("" ::: "memory");
        S.a_off(cur, lds, R0, C0, (int)lda2, curoff);
        if (has_next) S.a_off(nxt, lds, R0, C0, (int)lda2, nxtoff);
        else {
#pragma unroll
            for (int h = 0; h < 2; ++h)
#pragma unroll
                for (int i = 0; i < 2; ++i) nxtoff[h][i] = curoff[h][i]; }
        ((LAS u32x4*)(lds + NXT_OFF))[tid] = (u32x4){curoff[0][0], curoff[0][1], curoff[1][0], curoff[1][1]};
        ((LAS u32x4*)(lds + NXT_OFF + 8192))[tid] = (u32x4){nxtoff[0][0], nxtoff[0][1], nxtoff[1][0], nxtoff[1][1]};
    } else { curA = (size_t)cur.arow * lda2 + cur.koff; nxtA = has_next ? (size_t)nxt.arow * lda2 + nxt.koff : curA; }
    f32x4 acc[2][2][4][2];
#pragma unroll
    for (int a = 0; a < 2; ++a)
#pragma unroll
        for (int b = 0; b < 2; ++b)
#pragma unroll
            for (int m = 0; m < 4; ++m)
#pragma unroll
                for (int n = 0; n < 2; ++n) acc[a][b][m][n] = (f32x4){0.f, 0.f, 0.f, 0.f};
    bf16x8 At[4][2], B0[2][2], B1[2][2];
    const char* cB = (const char*)g.Bt + (size_t)cur.brow * ldb2 + cur.koff;
    u32x2 go = {0u, 0u};
    PG8_STAGE_B(PG8_SB(0, 0), cB, 0u); PG8_STAGE_B(PG8_SB(0, 1), cB + hstepB, 0u); PG8_GOFF(0, 0); PG8_STAGE_A(PG8_SA(0, 0), 0, 0, 0u); PG8_GOFF(1, 0); PG8_STAGE_A(PG8_SA(0, 1), 1, 0, 0u);
    if (wr == 1) PG8_BAR;
    PG8_WAIT_V(2); PG8_BAR;
    PG8_GOFF(0, 0); PG8_STAGE_B(PG8_SB(1, 0), cB, kstep); PG8_STAGE_A(PG8_SA(1, 0), 0, 0, kstep); PG8_STAGE_B(PG8_SB(1, 1), cB + hstepB, kstep);
    PG8_WAIT_V(6); PG8_BAR;
    for (;;) {
        const char* nB = has_next ? (const char*)g.Bt + (size_t)nxt.brow * ldb2 + nxt.koff : cB;
        Unit u2; bool has2 = false;
        if constexpr (Sched::GATHER) has2 = has_next && S.next(ui + 2, u2);
#pragma unroll 1
        for (int t = 0; t < nt - 2; t += 2) {
            const unsigned k1 = (unsigned)(t + 1) * kstep, k2 = (unsigned)(t + 2) * kstep, k3 = (unsigned)(t + 3) * kstep;
            if constexpr (Sched::GATHER) { if (t == 2 && has2) S.tab_issue(u2, ldsb, wid, lane); }
            PG8_KITER(k1, cB, 0, k2, k3);
        }
        { const unsigned k1 = (unsigned)(nt - 1) * kstep; PG8_KITER(k1, nB, 1, 0u, kstep); }
#if PIN_ACC
#pragma unroll
        for (int a = 0; a < 2; ++a)
#pragma unroll
            for (int b = 0; b < 2; ++b)
#pragma unroll
                for (int m = 0; m < 4; ++m) asm volatile("" : "+v"(acc[a][b][m][0]), "+v"(acc[a][b][m][1]));
#endif
        if (wr == 0) PG8_BAR;
#ifdef PROBE_VARIANTS
        if (!(kvariant() & 4))
#endif
        { const int l2 = lane_id_asm(); E(acc, cur, wr, wc, l2 & 15, l2 >> 4); }
        if (!has_next) break;
#pragma unroll
        for (int a = 0; a < 2; ++a)
#pragma unroll
            for (int b = 0; b < 2; ++b)
#pragma unroll
                for (int m = 0; m < 4; ++m)
#pragma unroll
                    for (int n = 0; n < 2; ++n) acc[a][b][m][n] = (f32x4){0.f, 0.f, 0.f, 0.f};
        cur = nxt; cB = nB; ++ui; curA = nxtA;
        has_next = S.next(ui + 1, nxt);
        if (has_next) {
            if constexpr (Sched::GATHER) { const int tz = (wave0 << 6) | lane_id_asm(); int R0z, C0z;
                { const int lz = tz & 63; R0z = 8 * wid + (lz >> 3); C0z = 16 * ((lz & 7) ^ chunk_xor<F8>(R0z & 15)); }
                S.a_off(nxt, lds, R0z, C0z, (int)lda2, nxtoff);
                ((LAS u32x4*)(lds + NXT_OFF + (((ui + 1) & 1) << 13)))[tz] = (u32x4){nxtoff[0][0], nxtoff[0][1], nxtoff[1][0], nxtoff[1][1]}; }
            else nxtA = (size_t)nxt.arow * lda2 + nxt.koff;
        } else if constexpr (Sched::GATHER) { const int tz = (wave0 << 6) | lane_id_asm();
            ((LAS u32x4*)(lds + NXT_OFF + (((ui + 1) & 1) << 13)))[tz] = ((const LAS u32x4*)(lds + NXT_OFF + ((ui & 1) << 13)))[tz]; }
        if (wr == 1) PG8_BAR;
    }
    PG8_WAIT_V(0);
    PG8_BAR;
#undef PG8_SA
#undef PG8_SB
#undef PG8_STAGE_A
#undef PG8_GOFF
#undef PG8_STAGE_B
#undef PG8_LDA
#undef PG8_LDB
#undef PG8_MMA
#undef PG8_WAIT_V
#undef PG8_WAIT_L
#undef PG8_BAR
#undef PG8_SCHED
#undef PG8_KITER
#undef PG8_NXT_SLOT
}
}

struct Args { const float* in[32]; float* out; unsigned char* ws; int ph_lo, ph_hi, variant, pad; };
typedef const __attribute__((address_space(4))) unsigned char* kptr_t;
__device__ __forceinline__ const float* kin(int i) { kptr_t p = (kptr_t)__builtin_amdgcn_kernarg_segment_ptr(); asm volatile("" : "+s"(p)); return *(const float* const __attribute__((address_space(4)))*)(p + 8 * i); }
enum { I_X = 0, I_C, I_MODW, I_MODB, I_LNG, I_LNB, I_ABWIN, I_POOLW, I_POOLS, I_CONVW, I_CONVB, I_WA, I_BA, I_WX, I_BX, I_LAM, I_ABWOUT, I_ABBOUT,
       I_SGWIN, I_SGBIN, I_SGLNG, I_SGLNB, I_SGWS, I_SGBS, I_SGWOUT, I_SGBOUT, I_RW, I_RB, I_W1, I_B1, I_W2, I_B2 };

__device__ __forceinline__ int w1_rho(int n) { const int nn = n & 1, j = n >> 1; return ((j >> 7) << 8) | (((j >> 2) & 1) << 7) | (((j >> 5) & 3) << 5) | (nn << 4) | (((j >> 3) & 3) << 2) | (j & 3); }
__device__ __forceinline__ int w1_n_of_rho(int rho) { const int pn = rho >> 8, bj = (rho >> 7) & 1, wc = (rho >> 5) & 3, nn = (rho >> 4) & 1, fq = (rho >> 2) & 3, i = rho & 3; return 2 * (128 * pn + 32 * wc + 8 * fq + 4 * bj + i) + nn; }
template <bool W1MAP>
__device__ __forceinline__ void conv_item(const float* W, int N, bf16_t* WT, int item, int lane) {
    const int nblk = N >> 5, kb = item / nblk, nb = item - kb * nblk;
    const int kg = lane >> 3, nl = lane & 7, k0 = kb * 64 + kg * 8, n0 = nb * 32 + nl * 4;
    f32x4 v[8];
#pragma unroll
    for (int q = 0; q < 8; ++q) v[q] = *(const f32x4*)(W + (size_t)(k0 + q) * N + n0);
#pragma unroll
    for (int i = 0; i < 4; ++i) {
        const int n = n0 + i, row = W1MAP ? w1_rho(n) : n;
        u32x4 o; o.x = pk2(v[0][i], v[1][i]); o.y = pk2(v[2][i], v[3][i]); o.z = pk2(v[4][i], v[5][i]); o.w = pk2(v[6][i], v[7][i]);
        *(u32x4*)(WT + (size_t)row * 1024 + k0) = o;
    }
}

template <bool W1MAP>
__device__ __forceinline__ void conv_item_f8(const float* W, int N, unsigned char* WT8, int item, int lane, float scale) {
    const int nblk = N >> 5, kb = item / nblk, nb = item - kb * nblk;
    const int kg = lane >> 3, nl = lane & 7, k0 = kb * 128 + kg * 16, n0 = nb * 32 + nl * 4;
    f32x4 v[16];
#pragma unroll
    for (int q = 0; q < 16; ++q) v[q] = *(const f32x4*)(W + (size_t)(k0 + q) * N + n0) * scale;
#pragma unroll
    for (int i = 0; i < 4; ++i) {
        const int n = n0 + i, row = W1MAP ? w1_rho(n) : n;
        u32x4 o; o.x = pk4_fp8(v[0][i], v[1][i], v[2][i], v[3][i]); o.y = pk4_fp8(v[4][i], v[5][i], v[6][i], v[7][i]);
        o.z = pk4_fp8(v[8][i], v[9][i], v[10][i], v[11][i]); o.w = pk4_fp8(v[12][i], v[13][i], v[14][i], v[15][i]);
        *(u32x4*)(WT8 + (size_t)row * 1024 + k0) = o;
    }
}

#define IN(k) (lo <= (k) && (k) < hi)
#define SEAM(k) do { if ((k) + 1 < hi) xcd_barrier(bar); } while (0)
#define PH_LOCALS \
    const int tid = (wave0 << 6) | lane_id_asm(); \
    const int lane = tid & 63, wave = wave0; \
    int bx = blockIdx.x; asm volatile("" : "+s"(bx)); \
    const int vcu = (G % 8 == 0) ? (bx % 8) * (G / 8) + bx / 8 : bx; \
    const int gw = vcu * 8 + wave, NGW = G * 8; \
    unsigned char* ws; { kptr_t kp_ = (kptr_t)__builtin_amdgcn_kernarg_segment_ptr(); asm volatile("" : "+s"(kp_)); ws = *(unsigned char* const __attribute__((address_space(4)))*)(kp_ + 264); } \
    float* Xf; { kptr_t kp_ = (kptr_t)__builtin_amdgcn_kernarg_segment_ptr(); asm volatile("" : "+s"(kp_)); Xf = *(float* const __attribute__((address_space(4)))*)(kp_ + 256); } \
    unsigned* const ctl = (unsigned*)(ws + WS_CTL); \
    float* const MOD = (float*)(ws + WS_MOD); bf16_t* const Hb = (bf16_t*)(ws + WS_H); bf16_t* const Zb = (bf16_t*)(ws + WS_Z); bf16_t* const A2b = (bf16_t*)(ws + WS_A2); \
    bf16_t* const RIb = (bf16_t*)(ws + WS_RI); bf16_t* const YMb = (bf16_t*)(ws + WS_YMIX); bf16_t* const Yb = (bf16_t*)(ws + WS_Y); bf16_t* const ACTb = (bf16_t*)(ws + WS_ACT); \
    bf16_t* const YSb = (bf16_t*)(ws + WS_YS); float* const LOGf = (float*)(ws + WS_LOG); float* const TOPG = (float*)(ws + WS_TOPG); int* const LIST = (int*)(ws + WS_LIST); \
    float* const SUMM = (float*)(ws + WS_SUMM); \
    (void)lane; (void)wave; (void)gw; (void)NGW; (void)ctl; (void)MOD; (void)Hb; (void)Zb; (void)A2b; (void)RIb; (void)YMb; (void)Yb; (void)ACTb; (void)YSb; (void)LOGf; (void)TOPG; (void)LIST; (void)SUMM; (void)Xf; (void)vcu


template <int L, int PASS>
__device__ __forceinline__ void scan_phase(const int lo, const int hi, const int G, const XcdBarrier& bar, const int wave0) {
    constexpr int l = L, pass = PASS, P = PH_L0 + PH_PER_LAYER * L, jj = L >> 1; constexpr bool odd = (L & 1) != 0;
            if (PHEN(6) && !odd && IN(P + 3 + pass)) {
            PH_LOCALS;
                for (int it = gw; it < 16 * 32 * 4; it += NGW) {
                    const int b = it >> 7, n = (it >> 2) & 31, cg = it & 3;
                    const int ch = cg * 128 + 2 * lane;
                    float sp[2];
#pragma unroll
                    for (int q = 0; q < 2; ++q) { const float x = -kin(I_LAM)[jj * 512 + ch + q]; sp[q] = 8.0f * 1.4426950408889634f * (fmaxf(x, 0.f) + log1pf(__expf(-fabsf(x)))); }
                    float one = 1.0f; asm volatile("" : "+v"(one));
                    float h0 = 0.f, h1 = 0.f, p0 = one, p1 = one;
                    if (pass == 1) {
#pragma unroll 1
                        for (int m = 0; m < n; ++m) { const f32x4 s = *(const f32x4*)(SUMM + (((size_t)b * 32 + m) * 512 + ch) * 2); h0 = s[0] * h0 + s[1]; h1 = s[2] * h1 + s[3]; }
                    }
                    const size_t row0 = (size_t)b * SEQ + n * 128;
#pragma unroll 4
                    for (int t = 0; t < 128; ++t) {
                        const size_t r = row0 + t;
                        const unsigned rw = *(const unsigned*)(RIb + r * 1024 + ch), iw = *(const unsigned*)(RIb + r * 1024 + 512 + ch), xw = *(const unsigned*)(A2b + r * 1024 + 512 + ch);
                        const float a0 = __builtin_amdgcn_exp2f(-bflo(rw) * sp[0]), a1 = __builtin_amdgcn_exp2f(-bfhi(rw) * sp[1]);
                        const float m0 = __builtin_amdgcn_sqrtf(fmaxf(__builtin_fmaf(-a0, a0, 1.0f), 0.f)), m1 = __builtin_amdgcn_sqrtf(fmaxf(__builtin_fmaf(-a1, a1, 1.0f), 0.f));
                        h0 = a0 * h0 + m0 * (bflo(iw) * bflo(xw)); h1 = a1 * h1 + m1 * (bfhi(iw) * bfhi(xw));
                        if (pass == 0) { p0 *= a0; p1 *= a1; }
                        else { const unsigned gwd = *(const unsigned*)(Zb + r * DINAB + 1024 + ch);
                            if (FP8_OUTP) *(unsigned short*)((unsigned char*)YMb + r * 1024 + 512 + ch) = (unsigned short)pk4_fp8(h0 * gelu_tanh(bflo(gwd)), h1 * gelu_tanh(bfhi(gwd)), 0.f, 0.f);
                            else *(unsigned*)(YMb + r * 1024 + 512 + ch) = pk2(h0 * gelu_tanh(bflo(gwd)), h1 * gelu_tanh(bfhi(gwd))); }
                    }
                    if (pass == 0) *(f32x4*)(SUMM + (((size_t)b * 32 + n) * 512 + ch) * 2) = (f32x4){p0, h0, p1, h1};
                }
                SEAM(P + 3 + pass);
            }
}

template <int L, int SUB>
__device__ __forceinline__ void ln_phase(const int lo, const int hi, const int G, const XcdBarrier& bar, const int wave0) {
    constexpr int l = L, sub = SUB, P = PH_L0 + PH_PER_LAYER * L; constexpr int ph = SUB == 0 ? P + 6 : P + 11;
    constexpr bool XIN_F32 = (L == 0 && SUB == 0), XOUT_F32 = (L == DEPTH - 1 && SUB == 1);
    if (PHEN(8) && IN(ph)) {
        PH_LOCALS;
        const int rows_per = T / NGW, r0 = gw * rows_per, b = r0 / SEQ;
        constexpr int ls = 2 * l + sub, lsn = ls + 1;
        const float* gp = MOD + ((size_t)ls * 16 + b) * 3072 + 2048;
        const float* lgp = kin(I_LNG) + ls * 1024, * lbp = kin(I_LNB) + ls * 1024;
        constexpr bool has_nextmod = lsn < 2 * DEPTH;
        const float* nsh = MOD + ((size_t)(has_nextmod ? lsn : 0) * 16 + b) * 3072, * nsc = nsh + 1024;
        f32x4 gt[4], lg[4], lb[4], sh[4], sc[4];
#pragma unroll
        for (int j = 0; j < 4; ++j) { const int o = 4 * (64 * j + lane); gt[j] = *(const f32x4*)(gp + o) + 1.0f; lg[j] = *(const f32x4*)(lgp + o); lb[j] = *(const f32x4*)(lbp + o);
            sh[j] = *(const f32x4*)(nsh + o); sc[j] = *(const f32x4*)(nsc + o) + 1.0f; }
        const float* xin32 = kin(I_X);
        bf16_t* const Xb = (bf16_t*)(ws + WS_XB);
        constexpr int RPI = 2;
        for (int r = r0; r < r0 + rows_per; r += RPI) {
            f32x4 xf[XIN_F32 ? RPI : 1][4]; u32x2 xb[XIN_F32 ? 1 : RPI][4]; u32x2 yv[sub == 0 ? RPI : 1][4]; u32x2 ys[sub == 0 ? 1 : RPI][4][4]; f32x4 gk[RPI];
#pragma unroll
            for (int q = 0; q < RPI; ++q) {
                if constexpr (XIN_F32) { const f32x4* xr = (const f32x4*)(xin32 + (size_t)(r + q) * D) + lane;
#pragma unroll
                    for (int j = 0; j < 4; ++j) xf[q][j] = xr[64 * j]; }
                else { const u32x2* xr = (const u32x2*)(Xb + (size_t)(r + q) * D) + lane;
#pragma unroll
                    for (int j = 0; j < 4; ++j) xb[q][j] = xr[64 * j]; }
                if constexpr (sub == 0) { const u32x2* yr = (const u32x2*)(Yb + (size_t)(r + q) * D) + lane;
#pragma unroll
                    for (int j = 0; j < 4; ++j) yv[q][j] = yr[64 * j]; }
                else { gk[q] = *(const f32x4*)(TOPG + (size_t)(r + q) * 4);
#pragma unroll
                    for (int k = 0; k < 4; ++k) {
                        if (FP8_YS) { const unsigned* yr = (const unsigned*)((const unsigned char*)YSb + ((size_t)(r + q) * 4 + k) * D) + lane;
#pragma unroll
                            for (int j = 0; j < 4; ++j) ys[q][k][j].x = yr[64 * j]; }
                        else { const u32x2* yr = (const u32x2*)(YSb + ((size_t)(r + q) * 4 + k) * D) + lane;
#pragma unroll
                            for (int j = 0; j < 4; ++j) ys[q][k][j] = yr[64 * j]; } } }
            }
            f32x4 v[RPI][4]; float s[RPI];
#pragma unroll
            for (int q = 0; q < RPI; ++q) {
                s[q] = 0.f;
#pragma unroll
                for (int j = 0; j < 4; ++j) {
                    f32x4 y, x;
                    if constexpr (XIN_F32) x = xf[q][j]; else x = (f32x4){bflo(xb[q][j].x), bfhi(xb[q][j].x), bflo(xb[q][j].y), bfhi(xb[q][j].y)};
                    if constexpr (sub == 0) y = (f32x4){bflo(yv[q][j].x), bfhi(yv[q][j].x), bflo(yv[q][j].y), bfhi(yv[q][j].y)};
                    else { y = (f32x4){0.f, 0.f, 0.f, 0.f};
#pragma unroll
                        for (int k = 0; k < 4; ++k) { const u32x2 w = ys[q][k][j];
                            if (FP8_YS) { const f32x2 lo2 = __builtin_amdgcn_cvt_pk_f32_fp8((int)w.x, false), hi2 = __builtin_amdgcn_cvt_pk_f32_fp8((int)w.x, true);
                                y = y + (f32x4){lo2.x, lo2.y, hi2.x, hi2.y} * (gk[q][k] * 0.0625f); }
                            else y = y + (f32x4){bflo(w.x), bfhi(w.x), bflo(w.y), bfhi(w.y)} * gk[q][k]; } }
                    v[q][j] = x * DN_ALPHA + gt[j] * y;
                    s[q] += (v[q][j][0] + v[q][j][1]) + (v[q][j][2] + v[q][j][3]);
                }
            }
#pragma unroll
            for (int o = 1; o < 64; o <<= 1) {
#pragma unroll
                for (int q = 0; q < RPI; ++q) s[q] += __builtin_bit_cast(float, __builtin_amdgcn_ds_bpermute((lane ^ o) << 2, __builtin_bit_cast(int, s[q])));
            }
            float s2[RPI];
#pragma unroll
            for (int q = 0; q < RPI; ++q) { const float mean = s[q] * (1.0f / D); s2[q] = 0.f;
#pragma unroll
                for (int j = 0; j < 4; ++j) { v[q][j] = v[q][j] - mean; s2[q] += (v[q][j][0] * v[q][j][0] + v[q][j][1] * v[q][j][1]) + (v[q][j][2] * v[q][j][2] + v[q][j][3] * v[q][j][3]); } }
#pragma unroll
            for (int o = 1; o < 64; o <<= 1) {
#pragma unroll
                for (int q = 0; q < RPI; ++q) s2[q] += __builtin_bit_cast(float, __builtin_amdgcn_ds_bpermute((lane ^ o) << 2, __builtin_bit_cast(int, s2[q])));
            }
#pragma unroll
            for (int q = 0; q < RPI; ++q) {
                const float rstd = 1.0f / sqrtf(s2[q] * (1.0f / D) + LN_EPS);
                u32x2* hr = (u32x2*)(Hb + (size_t)(r + q) * D) + lane;
#pragma unroll
                for (int j = 0; j < 4; ++j) { const f32x4 xn = v[q][j] * rstd * lg[j] + lb[j];
                    if (XOUT_F32) ((f32x4*)(Xf + (size_t)(r + q) * D) + lane)[64 * j] = xn;
                    else { u32x2 w; w.x = pk2(xn[0], xn[1]); w.y = pk2(xn[2], xn[3]); ((u32x2*)(Xb + (size_t)(r + q) * D) + lane)[64 * j] = w; }
                    if (has_nextmod) { const f32x4 h = xn * sc[j] + sh[j];
                        if (!(FP8_INP && sub == 1) && !(ROUTER_X && sub == 0)) { u32x2 w; w.x = pk2(h[0], h[1]); w.y = pk2(h[2], h[3]); hr[64 * j] = w; }
                        if ((FP8_M1 && sub == 0) || (FP8_INP && sub == 1)) ((unsigned*)(ws + WS_H8 + (size_t)(r + q) * D) + lane)[64 * j] = pk4_fp8(h[0], h[1], h[2], h[3]); } }
            }
        }
        if (ph + 1 < NPH) SEAM(ph);
    }
}

template <int L>
__device__ __forceinline__ void layer_body(LAS unsigned char* const lds, volatile LAS unsigned* const LCTL, const int lo, const int hi, const int G, const XcdBarrier& bar, const int wave0) {
    constexpr int l = L;
        const int P = PH_L0 + PH_PER_LAYER * l, jj = l >> 1;
        const bool odd = (l & 1) != 0;
        if (PHEN(2) && IN(P + 0)) {
            PH_LOCALS;
            if (!odd) {
                pg8::DenseSched S; S.init(T, 1536, G, bx);
                if (FP8_INP) { pg8::Gemm g{ws + WS_H8, ws + WS_ABIN + (size_t)jj * 1536 * 1024, 1024, 1024, 1024, 122};
                    pg8::EpiDense<0, false, false, true> E{Zb, 1536, nullptr, nullptr, 1.0f / 32.0f};
                    pg8::gemm_phase<true>(lds, g, S, E, wave0); }
                else { pg8::Gemm g{Hb, (const bf16_t*)(ws + WS_ABIN) + (size_t)jj * 1536 * 1024, 1024, 1024, 1024, 127};
                    pg8::EpiDense<0, false, false> E{Zb, 1536, nullptr, nullptr, 0.f};
                    pg8::gemm_phase<false>(lds, g, S, E, wave0); }
            } else {
                pg8::DenseSched S; S.init(T, 2048, G, bx);
                if (FP8_INP) { pg8::Gemm g{ws + WS_H8, ws + WS_SGIN + (size_t)jj * 2048 * 1024, 1024, 1024, 1024, 122};
                    pg8::EpiDense<1, true, false, true> E{Zb, 2048, kin(I_SGBIN) + jj * 2048, nullptr, 1.0f / 32.0f};
                    pg8::gemm_phase<true>(lds, g, S, E, wave0); }
                else { pg8::Gemm g{Hb, (const bf16_t*)(ws + WS_SGIN) + (size_t)jj * 2048 * 1024, 1024, 1024, 1024, 127};
                    pg8::EpiDense<1, true, false> E{Zb, 2048, kin(I_SGBIN) + jj * 2048, nullptr, 0.f};
                    pg8::gemm_phase<false>(lds, g, S, E, wave0); }
            }
            SEAM(P + 0);
        }
        if (PHEN(3) && !odd && IN(P + 1)) {
            PH_LOCALS;
            const int rows_per = T / NGW, r0 = gw * rows_per;
            const int g4 = lane >> 4, w = 2 << g4;
            float cw[4][8], cb[8];
#pragma unroll
            for (int k = 0; k < 4; ++k)
#pragma unroll
                for (int q = 0; q < 8; ++q) cw[k][q] = kin(I_CONVW)[((size_t)jj * 4 + k) * 512 + 8 * lane + q];
#pragma unroll
            for (int q = 0; q < 8; ++q) cb[q] = kin(I_CONVB)[jj * 512 + 8 * lane + q];
            const int ts0 = r0 & (SEQ - 1);
            u32x4 ring[16], cr[3];
            float sw[8];
#pragma unroll
            for (int q = 0; q < 8; ++q) sw[q] = 0.f;
#pragma unroll
            for (int d = 0; d < 16; ++d) {
                const int k = 15 - d;
                u32x4 v = {0u, 0u, 0u, 0u};
                if (ts0 > d) v = *(const u32x4*)(Zb + (size_t)(r0 - 1 - d) * DINAB + 8 * lane);
                ring[k] = v;
                if (d + 1 < w) { const float f[8] = {bflo(v.x), bfhi(v.x), bflo(v.y), bfhi(v.y), bflo(v.z), bfhi(v.z), bflo(v.w), bfhi(v.w)};
#pragma unroll
                    for (int q = 0; q < 8; ++q) sw[q] += f[q]; }
            }
#pragma unroll
            for (int d = 0; d < 3; ++d) { u32x4 v = {0u, 0u, 0u, 0u}; if (ts0 > d) v = *(const u32x4*)(Zb + (size_t)(r0 - 1 - d) * DINAB + 512 + 8 * lane); cr[2 - d] = v; }
#pragma unroll 1
            for (int rb = 0; rb < rows_per; rb += 16) {
#pragma unroll
                for (int i = 0; i < 16; ++i) {
                    const int r = r0 + rb + i, ts = r & (SEQ - 1);
                    const u32x4 vn = *(const u32x4*)(Zb + (size_t)r * DINAB + 8 * lane), cn = *(const u32x4*)(Zb + (size_t)r * DINAB + 512 + 8 * lane);
                    const u32x4 c2 = ring[(i + 15) & 15], c4 = ring[(i + 13) & 15], c8 = ring[(i + 9) & 15], c16 = ring[(i + 1) & 15];
                    u32x4 vo;
                    vo.x = g4 == 0 ? c2.x : g4 == 1 ? c4.x : g4 == 2 ? c8.x : c16.x; vo.y = g4 == 0 ? c2.y : g4 == 1 ? c4.y : g4 == 2 ? c8.y : c16.y;
                    vo.z = g4 == 0 ? c2.z : g4 == 1 ? c4.z : g4 == 2 ? c8.z : c16.z; vo.w = g4 == 0 ? c2.w : g4 == 1 ? c4.w : g4 == 2 ? c8.w : c16.w;
                    ring[i] = vn;
                    const float fn[8] = {bflo(vn.x), bfhi(vn.x), bflo(vn.y), bfhi(vn.y), bflo(vn.z), bfhi(vn.z), bflo(vn.w), bfhi(vn.w)};
                    const float fo[8] = {bflo(vo.x), bfhi(vo.x), bflo(vo.y), bfhi(vo.y), bflo(vo.z), bfhi(vo.z), bflo(vo.w), bfhi(vo.w)};
                    const int cntw = (ts + 1) < w ? (ts + 1) : w;
                    const float inv = __builtin_amdgcn_rcpf((float)cntw);
                    float pz[8];
#pragma unroll
                    for (int q = 0; q < 8; ++q) { sw[q] += fn[q]; pz[q] = sw[q] * inv - fn[q]; sw[q] -= fo[q]; }
                    u32x4 o; o.x = pk2(pz[0], pz[1]); o.y = pk2(pz[2], pz[3]); o.z = pk2(pz[4], pz[5]); o.w = pk2(pz[6], pz[7]);
                    *(u32x4*)(A2b + (size_t)r * 1024 + 8 * lane) = o;
                    float xc[8];
                    const u32x4 t0 = cr[0], t1 = cr[1], t2 = cr[2];
                    const float f0[8] = {bflo(t0.x), bfhi(t0.x), bflo(t0.y), bfhi(t0.y), bflo(t0.z), bfhi(t0.z), bflo(t0.w), bfhi(t0.w)};
                    const float f1[8] = {bflo(t1.x), bfhi(t1.x), bflo(t1.y), bfhi(t1.y), bflo(t1.z), bfhi(t1.z), bflo(t1.w), bfhi(t1.w)};
                    const float f2[8] = {bflo(t2.x), bfhi(t2.x), bflo(t2.y), bfhi(t2.y), bflo(t2.z), bfhi(t2.z), bflo(t2.w), bfhi(t2.w)};
                    const float f3[8] = {bflo(cn.x), bfhi(cn.x), bflo(cn.y), bfhi(cn.y), bflo(cn.z), bfhi(cn.z), bflo(cn.w), bfhi(cn.w)};
#pragma unroll
                    for (int q = 0; q < 8; ++q) xc[q] = cb[q] + f0[q] * cw[0][q] + f1[q] * cw[1][q] + f2[q] * cw[2][q] + f3[q] * cw[3][q];
                    cr[0] = t1; cr[1] = t2; cr[2] = cn;
                    u32x4 o2; o2.x = pk2(xc[0], xc[1]); o2.y = pk2(xc[2], xc[3]); o2.z = pk2(xc[4], xc[5]); o2.w = pk2(xc[6], xc[7]);
                    *(u32x4*)(A2b + (size_t)r * 1024 + 512 + 8 * lane) = o2;
                }
            }
            SEAM(P + 1);
        }
        if (PHEN(4) && odd && IN(P + 1)) {
            PH_LOCALS;
            LAS float* STAT = (LAS float*)lds;
            LAS unsigned char* WSS = lds + 1024;
            LAS unsigned char* VT = lds + 1024 + 34816;
            const float* lng = kin(I_SGLNG) + jj * 1024, * lnb = kin(I_SGLNB) + jj * 1024;
            const bf16_t* WSMp = (const bf16_t*)(ws + WS_WSM) + (size_t)jj * 8 * 128 * 128;
            const float* bs = kin(I_SGBS) + jj * 8 * 128;
            const int fr = lane & 15, fq = lane >> 4;
            for (int it = vcu; it < T / 128; it += G) {
                const size_t row0 = (size_t)it * 128;
#pragma unroll 1
                for (int rb = 0; rb < 2; ++rb) {
                    u32x4 a8[8], b8[8];
#pragma unroll
                    for (int q = 0; q < 8; ++q) { const bf16_t* vp = Zb + (row0 + wave * 16 + rb * 8 + q) * 2048 + 1024; a8[q] = *(const u32x4*)(vp + 8 * lane); b8[q] = *(const u32x4*)(vp + 512 + 8 * lane); }
                    float sm[8], sq[8];
#pragma unroll
                    for (int q = 0; q < 8; ++q) {
                        const float f[16] = {bflo(a8[q].x), bfhi(a8[q].x), bflo(a8[q].y), bfhi(a8[q].y), bflo(a8[q].z), bfhi(a8[q].z), bflo(a8[q].w), bfhi(a8[q].w),
                                             bflo(b8[q].x), bfhi(b8[q].x), bflo(b8[q].y), bfhi(b8[q].y), bflo(b8[q].z), bfhi(b8[q].z), bflo(b8[q].w), bfhi(b8[q].w)};
                        float s1 = 0.f, s2 = 0.f;
#pragma unroll
                        for (int e = 0; e < 16; ++e) { s1 += f[e]; s2 += f[e] * f[e]; }
                        sm[q] = s1; sq[q] = s2;
                    }
#pragma unroll
                    for (int o = 1; o < 64; o <<= 1) {
#pragma unroll
                        for (int q = 0; q < 8; ++q) { sm[q] += __builtin_bit_cast(float, __builtin_amdgcn_ds_bpermute((lane ^ o) << 2, __builtin_bit_cast(int, sm[q])));
                            sq[q] += __builtin_bit_cast(float, __builtin_amdgcn_ds_bpermute((lane ^ o) << 2, __builtin_bit_cast(int, sq[q]))); }
                    }
                    if (lane < 8) { float m_ = sm[0], q_ = sq[0];
#pragma unroll
                        for (int q = 1; q < 8; ++q) { m_ = lane == q ? sm[q] : m_; q_ = lane == q ? sq[q] : q_; }
                        const float mean = m_ * (1.0f / 1024.0f), var = fmaxf(q_ * (1.0f / 1024.0f) - mean * mean, 0.f);
                        const int r = wave * 16 + rb * 8 + lane; STAT[2 * r] = mean; STAT[2 * r + 1] = 1.0f / sqrtf(var + LN_EPS); }
                }
                __syncthreads();
                u32x4 wv[4], vv[4];
#pragma unroll
                for (int i = 0; i < 4; ++i) { const int q = tid + 512 * i, row = q >> 4, c16 = q & 15;
                    wv[i] = *(const u32x4*)(WSMp + ((size_t)0 * 128 + row) * 128 + c16 * 8);
                    vv[i] = *(const u32x4*)(Zb + (row0 + row) * 2048 + 1024 + 0 * 128 + c16 * 8); }
#pragma unroll 1
                for (int hd = 0; hd < 8; ++hd) {
#pragma unroll
                    for (int i = 0; i < 4; ++i) {
                        const int q = tid + 512 * i, row = q >> 4, c16 = q & 15;
                        *(LAS u32x4*)(WSS + row * 272 + c16 * 16) = wv[i];
                        const u32x4 v4 = vv[i];
                        const float mean = STAT[2 * row], rstd = STAT[2 * row + 1];
                        const float f[8] = {bflo(v4.x), bfhi(v4.x), bflo(v4.y), bfhi(v4.y), bflo(v4.z), bfhi(v4.z), bflo(v4.w), bfhi(v4.w)};
                        const f32x4 g0 = *(const f32x4*)(lng + hd * 128 + c16 * 8), g1 = *(const f32x4*)(lng + hd * 128 + c16 * 8 + 4);
                        const f32x4 b0 = *(const f32x4*)(lnb + hd * 128 + c16 * 8), b1 = *(const f32x4*)(lnb + hd * 128 + c16 * 8 + 4);
                        const float gg[8] = {g0[0], g0[1], g0[2], g0[3], g1[0], g1[1], g1[2], g1[3]}, bb[8] = {b0[0], b0[1], b0[2], b0[3], b1[0], b1[1], b1[2], b1[3]};
#pragma unroll
                        for (int q2 = 0; q2 < 8; ++q2) {
                            const int c = c16 * 8 + q2;
                            const int rho = (c & ~31) | (((c >> 2) & 1) << 4) | (((c >> 3) & 3) << 2) | (c & 3);
                            *(LAS bf16_t*)(VT + rho * 272 + row * 2) = (bf16_t)f2bf((f[q2] - mean) * rstd * gg[q2] + bb[q2]);
                        }
                    }
                    const int hn = hd < 7 ? hd + 1 : 7;
#pragma unroll
                    for (int i = 0; i < 4; ++i) { const int q = tid + 512 * i, row = q >> 4, c16 = q & 15;
                        wv[i] = *(const u32x4*)(WSMp + ((size_t)hn * 128 + row) * 128 + c16 * 8);
                        vv[i] = *(const u32x4*)(Zb + (row0 + row) * 2048 + 1024 + hn * 128 + c16 * 8); }
                    const int t = 16 * wave + fr; const float bst = bs[hd * 128 + t];
                    const size_t rowg = row0 + t;
                    u32x4 uv[4];
#pragma unroll
                    for (int q = 0; q < 4; ++q) uv[q] = *(const u32x4*)(Zb + rowg * 2048 + hd * 128 + 32 * q + 8 * fq);
                    __syncthreads();
                    bf16x8 afr[4];
#pragma unroll
                    for (int ks = 0; ks < 4; ++ks) afr[ks] = *(const LAS bf16x8*)(WSS + (16 * wave + fr) * 272 + (32 * ks + 8 * fq) * 2);
                    f32x4 acc[8];
#pragma unroll
                    for (int tn = 0; tn < 8; ++tn) { acc[tn] = (f32x4){0.f, 0.f, 0.f, 0.f};
#pragma unroll
                        for (int ks = 0; ks < 4; ++ks) { const bf16x8 vfr = *(const LAS bf16x8*)(VT + (16 * tn + fr) * 272 + (32 * ks + 8 * fq) * 2);
                            acc[tn] = __builtin_amdgcn_mfma_f32_16x16x32_bf16(vfr, afr[ks], acc[tn], 0, 0, 0); } }
#pragma unroll
                    for (int q = 0; q < 4; ++q) {
                        const int c0 = hd * 128 + 32 * q + 8 * fq;
                        const u32x4 u4 = uv[q];
                        const f32x4 s0 = acc[2 * q] + bst, s1 = acc[2 * q + 1] + bst;
                        if (FP8_OUTP) { u32x2 o; o.x = pk4_fp8(bflo(u4.x) * s0[0], bfhi(u4.x) * s0[1], bflo(u4.y) * s0[2], bfhi(u4.y) * s0[3]);
                            o.y = pk4_fp8(bflo(u4.z) * s1[0], bfhi(u4.z) * s1[1], bflo(u4.w) * s1[2], bfhi(u4.w) * s1[3]);
                            *(u32x2*)((unsigned char*)YMb + rowg * 1024 + c0) = o; }
                        else { u32x4 o; o.x = pk2(bflo(u4.x) * s0[0], bfhi(u4.x) * s0[1]); o.y = pk2(bflo(u4.y) * s0[2], bfhi(u4.y) * s0[3]);
                        o.z = pk2(bflo(u4.z) * s1[0], bfhi(u4.z) * s1[1]); o.w = pk2(bflo(u4.w) * s1[2], bfhi(u4.w) * s1[3]);
                        *(u32x4*)(YMb + rowg * 1024 + c0) = o; }
                    }
                    __syncthreads();
                }
            }
            SEAM(P + 1);
        }
        if (PHEN(5) && !odd && IN(P + 2)) {
            PH_LOCALS;
            {
                pg8::Gemm g{A2b, (const bf16_t*)(ws + WS_BPOOL) + (size_t)jj * 512 * 512, 1024, 512, 256, 127};
                pg8::DenseSched S; S.init(T, 512, G, bx); S.kblk = 512;
                pg8::EpiDense<0, false, true, false, FP8_OUTP != 0> E{YMb, 1024, nullptr, kin(I_POOLS) + jj * 512, 0.f};
                pg8::gemm_phase<false>(lds, g, S, E, wave0);
            }
            {
                pg8::Gemm g{A2b + 512, (const bf16_t*)(ws + WS_BGATE) + (size_t)jj * 1024 * 512, 1024, 512, 256, 127};
                pg8::DenseSched S; S.init(T, 1024, G, bx); S.kblk = 512;
                pg8::EpiDense<2, true, false> E{RIb, 1024, (const float*)(ws + WS_BIASRI) + jj * 1024, nullptr, 0.f};
                pg8::gemm_phase<false>(lds, g, S, E, wave0);
            }
            SEAM(P + 2);
        }
        scan_phase<L, 0>(lo, hi, G, bar, wave0); scan_phase<L, 1>(lo, hi, G, bar, wave0);
        if (PHEN(7) && IN(P + 5)) {
            PH_LOCALS;
            const float* bo = odd ? kin(I_SGBOUT) + jj * 1024 : kin(I_ABBOUT) + jj * 1024;
            pg8::DenseSched S; S.init(T, 1024, G, bx);
            if (FP8_OUTP) { const unsigned char* wt = odd ? ws + WS_SGOUT + (size_t)jj * 1024 * 1024 : ws + WS_ABOUT + (size_t)jj * 1024 * 1024;
                pg8::Gemm g{YMb, wt, 1024, 1024, 1024, 121};
                pg8::EpiDense<0, true, false, true> E{Yb, 1024, bo, nullptr, 1.0f / 64.0f};
                pg8::gemm_phase<true>(lds, g, S, E, wave0); }
            else { const bf16_t* wt = odd ? (const bf16_t*)(ws + WS_SGOUT) + (size_t)jj * 1024 * 1024 : (const bf16_t*)(ws + WS_ABOUT) + (size_t)jj * 1024 * 1024;
                pg8::Gemm g{YMb, wt, 1024, 1024, 1024, 127};
                pg8::EpiDense<0, true, false> E{Yb, 1024, bo, nullptr, 0.f};
                pg8::gemm_phase<false>(lds, g, S, E, wave0); }
            SEAM(P + 5);
        }
        ln_phase<L, 0>(lo, hi, G, bar, wave0);
            if (PHEN(9) && IN(P + 7)) {
            PH_LOCALS;
                pg8::Gemm g{ROUTER_X ? (const bf16_t*)(ws + WS_XB) : Hb, ROUTER_X ? (const bf16_t*)(ws + WS_BRB) + (size_t)l * 16 * 64 * 1024 : (const bf16_t*)(ws + WS_BR) + (size_t)l * 256 * 1024, 1024, 1024, 1024, 127};
                pg8::DenseSched S; S.init(T, 256, G, bx); if (ROUTER_X) S.bb = 64;
                pg8::EpiRouter E{LOGf};
                pg8::gemm_phase<false>(lds, g, S, E, wave0);
                SEAM(P + 7);
            }
            if (PHEN(10) && IN(P + 8)) {
            PH_LOCALS;
                volatile LAS unsigned* hist = LCTL + 96; volatile LAS unsigned* basev = LCTL + 128;
                unsigned* gcnt = ctl + CW_CNT + 64 * l;
                for (int t0 = vcu * 512; t0 < T; t0 += G * 512) {
                    if (tid < 32) hist[tid] = 0u;
                    __syncthreads();
                    const int tok = t0 + tid;
                    float lv[32];
                    { const f32x4* lp = (const f32x4*)(LOGf + (size_t)tok * 64);
#pragma unroll
                      for (int q = 0; q < 8; ++q) { const f32x4 a = lp[q], b2 = lp[8 + q], rb = ROUTER_X ? *(const f32x4*)((const float*)(ws + WS_CB) + (l * 16 + (t0 >> 12)) * 32 + 4 * q) : *(const f32x4*)(kin(I_RB) + l * 32 + 4 * q);
                          lv[4 * q + 0] = a[0] + b2[0] + rb[0]; lv[4 * q + 1] = a[1] + b2[1] + rb[1]; lv[4 * q + 2] = a[2] + b2[2] + rb[2]; lv[4 * q + 3] = a[3] + b2[3] + rb[3]; } }
                    float v0 = -3.0e38f, v1 = -3.0e38f, v2 = -3.0e38f, v3 = -3.0e38f; int i0 = 0, i1 = 0, i2 = 0, i3 = 0;
#pragma unroll
                    for (int e = 0; e < 32; ++e) {
                        const float x = lv[e];
                        if (x > v3) {
                            if (x > v0) { v3 = v2; i3 = i2; v2 = v1; i2 = i1; v1 = v0; i1 = i0; v0 = x; i0 = e; }
                            else if (x > v1) { v3 = v2; i3 = i2; v2 = v1; i2 = i1; v1 = x; i1 = e; }
                            else if (x > v2) { v3 = v2; i3 = i2; v2 = x; i2 = e; }
                            else { v3 = x; i3 = e; }
                        }
                    }
                    const float e1 = __expf(v1 - v0), e2 = __expf(v2 - v0), e3 = __expf(v3 - v0), inv = 1.0f / (1.0f + e1 + e2 + e3);
                    *(f32x4*)(TOPG + (size_t)tok * 4) = (f32x4){inv, e1 * inv, e2 * inv, e3 * inv};
                    LAS unsigned* hp = (LAS unsigned*)hist;
                    const unsigned r0 = __hip_atomic_fetch_add(hp + i0, 1u, __ATOMIC_RELAXED, __HIP_MEMORY_SCOPE_WORKGROUP), r1 = __hip_atomic_fetch_add(hp + i1, 1u, __ATOMIC_RELAXED, __HIP_MEMORY_SCOPE_WORKGROUP),
                                   r2 = __hip_atomic_fetch_add(hp + i2, 1u, __ATOMIC_RELAXED, __HIP_MEMORY_SCOPE_WORKGROUP), r3 = __hip_atomic_fetch_add(hp + i3, 1u, __ATOMIC_RELAXED, __HIP_MEMORY_SCOPE_WORKGROUP);
                    __syncthreads();
                    if (tid < 32) basev[tid] = __hip_atomic_fetch_add(gcnt + tid, hist[tid], __ATOMIC_RELAXED, __HIP_MEMORY_SCOPE_AGENT);
                    __syncthreads();
                    LIST[(size_t)i0 * TKTOT + basev[i0] + r0] = tok * 4 + 0;
                    LIST[(size_t)i1 * TKTOT + basev[i1] + r1] = tok * 4 + 1;
                    LIST[(size_t)i2 * TKTOT + basev[i2] + r2] = tok * 4 + 2;
                    LIST[(size_t)i3 * TKTOT + basev[i3] + r3] = tok * 4 + 3;
                    __syncthreads();
                }
                SEAM(P + 8);
            }
            if (PHEN(11) && IN(P + 9)) {
                PH_LOCALS;
                volatile LAS int* cnts = (volatile LAS int*)(LCTL + 16); volatile LAS int* tstart = (volatile LAS int*)(LCTL + 48);
                if (tid < 32) cnts[tid] = (int)__hip_atomic_load(ctl + CW_CNT + 64 * l + tid, __ATOMIC_RELAXED, __HIP_MEMORY_SCOPE_AGENT);
                __syncthreads();
                if (tid == 0) { int s = 0; for (int e = 0; e < 32; ++e) { tstart[e] = s; s += (cnts[e] + 255) >> 8; } tstart[32] = s; }
                __syncthreads();
                LAS int* const utab = (LAS int*)(lds + UTAB_OFF);
                const int nunits = pg8::moe_build_units(utab, tstart, cnts, 8, G, bx, tid);
                __syncthreads();
                pg8::MoeSched S{(const LAS int*)utab, LIST, (const float*)(ws + WS_B1P) + (size_t)l * 32 * 2048, nunits, 2048, 2};
                pg8::EpiMoe1<FP8_M2 != 0> E{FP8_M2 ? (bf16_t*)(ws + WS_ACT8) : ACTb, lds, FP8_M1 ? 1.0f / 32.0f : 1.0f};
                if (FP8_M1) { pg8::Gemm g{ws + WS_H8, ws + WS_W1T8 + (size_t)l * 32 * 2048 * 1024, 1024, 1024, 1024, 122};
                    pg8::gemm_phase<true>(lds, g, S, E, wave0); }
                else { pg8::Gemm g{Hb, (const bf16_t*)(ws + WS_W1T) + (size_t)l * 32 * 2048 * 1024, 1024, 1024, 1024, 127};
                    pg8::gemm_phase<false>(lds, g, S, E, wave0); }
                SEAM(P + 9);
            }
            if (PHEN(12) && IN(P + 10)) {
                PH_LOCALS;
                volatile LAS int* cnts = (volatile LAS int*)(LCTL + 16); volatile LAS int* tstart = (volatile LAS int*)(LCTL + 48);
                __syncthreads();
                if (tid < 32) cnts[tid] = (int)__hip_atomic_load(ctl + CW_CNT + 64 * l + tid, __ATOMIC_RELAXED, __HIP_MEMORY_SCOPE_AGENT);
                __syncthreads();
                if (tid == 0) { int s = 0; for (int e = 0; e < 32; ++e) { tstart[e] = s; s += (cnts[e] + 255) >> 8; } tstart[32] = s; }
                __syncthreads();
                LAS int* const utab = (LAS int*)(lds + UTAB_OFF);
                const int nunits = pg8::moe_build_units(utab, tstart, cnts, 4, G, bx, tid);
                __syncthreads();
                pg8::MoeSched S{(const LAS int*)utab, LIST, kin(I_B2) + (size_t)l * 32 * 1024, nunits, 1024, 0};
                pg8::EpiMoe2 E{YSb, lds, FP8_M2 ? 1.0f / 64.0f : 1.0f};
                if (FP8_M2) { pg8::Gemm g{ws + WS_ACT8, ws + WS_W2T8 + (size_t)l * 32 * 1024 * 1024, 1024, 1024, 1024, 121};
                    pg8::gemm_phase<true>(lds, g, S, E, wave0); }
                else { pg8::Gemm g{ACTb, (const bf16_t*)(ws + WS_W2T) + (size_t)l * 32 * 1024 * 1024, 1024, 1024, 1024, 127};
                    pg8::gemm_phase<false>(lds, g, S, E, wave0); }
                SEAM(P + 10);
            }
        ln_phase<L, 1>(lo, hi, G, bar, wave0);
}

__global__ void __launch_bounds__(512, 2) fwd_kernel(Args args) {
    extern __shared__ __attribute__((aligned(16))) unsigned char lds_raw[];
    LAS unsigned char* const lds = (LAS unsigned char*)lds_raw;
    volatile LAS unsigned* const LCTL = (volatile LAS unsigned*)(lds + LDSCTL_OFF);
    const int G = gridDim.x;
    int lo, hi; unsigned* ctl0;
    { kptr_t kp = (kptr_t)__builtin_amdgcn_kernarg_segment_ptr(); lo = *(const __attribute__((address_space(4))) int*)(kp + 272); hi = *(const __attribute__((address_space(4))) int*)(kp + 276);
      ctl0 = (unsigned*)(*(unsigned char* const __attribute__((address_space(4)))*)(kp + 264) + WS_CTL); }
    const int wave0 = __builtin_amdgcn_readfirstlane((int)threadIdx.x >> 6);
    for (int u = threadIdx.x; u < (LDS_BYTES - LDSCTL_OFF) / 4; u += 512) LCTL[u] = 0u;
    __syncthreads();
    XcdBarrier bar; bar.bar = ctl0 + CW_BAR; bar.x = 0; bar.st = LCTL; bar.wv = wave0;
    if (hi - lo > 1) bar = xcd_barrier_post(ctl0 + CW_BAR, LCTL, wave0);
    if (PHEN(0) && IN(PH_CONV)) {
            PH_LOCALS;
        {
            LAS float* cact = (LAS float*)lds;
            LAS float* part = (LAS float*)(lds + 65536);
            if (bx < 384) {
                for (int i = tid; i < 16 * 1024; i += 512) { const float c = kin(I_C)[i]; cact[i] = c / (1.0f + __expf(-c)); }
                __syncthreads();
                for (int it = bx; it < 384; it += G) {
                    const int ls = it / 48, col0 = (it % 48) * 64;
                    const int kq = tid >> 6, cl = tid & 63;
                    const float* wp = kin(I_MODW) + (size_t)ls * 1024 * 3072 + col0 + cl;
                    float a[16];
#pragma unroll
                    for (int b = 0; b < 16; ++b) a[b] = 0.f;
#pragma unroll 4
                    for (int k = kq * 128; k < kq * 128 + 128; ++k) {
                        const float w = wp[(size_t)k * 3072];
#pragma unroll
                        for (int b = 0; b < 16; ++b) a[b] += cact[b * 1024 + k] * w;
                    }
#pragma unroll
                    for (int b = 0; b < 16; ++b) part[(kq * 16 + b) * 64 + cl] = a[b];
                    __syncthreads();
                    for (int o = tid; o < 1024; o += 512) {
                        const int b = o >> 6, c2 = o & 63; float s = 0.f;
#pragma unroll
                        for (int q = 0; q < 8; ++q) s += part[(q * 16 + b) * 64 + c2];
                        MOD[((size_t)ls * 16 + b) * 3072 + col0 + c2] = s + kin(I_MODB)[ls * 3072 + col0 + c2];
                    }
                    __syncthreads();
                }
            }
        }
        {
            constexpr int IT_ABIN = 2 * (FP8_INP ? 8 : 16) * 48, IT_ABOUT = 2 * (FP8_OUTP ? 8 : 16) * 32, IT_SGIN = 2 * (FP8_INP ? 8 : 16) * 64, IT_SGOUT = 2 * (FP8_OUTP ? 8 : 16) * 32, IT_W1 = 128 * (FP8_M1 ? 8 : 16) * 64, IT_W2 = 128 * (FP8_M2 ? 8 : 16) * 32;
            constexpr int IT_ALL = IT_ABIN + IT_ABOUT + IT_SGIN + IT_SGOUT + IT_W1 + IT_W2;
            for (int it = gw; it < IT_ALL; it += NGW) {
                int r = it;
                if (r < IT_ABIN) { if (FP8_INP) { const int mat = r / (8 * 48); conv_item_f8<false>(kin(I_ABWIN) + (size_t)mat * 1024 * 1536, 1536, ws + WS_ABIN + (size_t)mat * 1536 * 1024, r % (8 * 48), lane, 32.0f); }
                    else { const int mat = r / (16 * 48); conv_item<false>(kin(I_ABWIN) + (size_t)mat * 1024 * 1536, 1536, (bf16_t*)(ws + WS_ABIN) + (size_t)mat * 1536 * 1024, r % (16 * 48), lane); } continue; } r -= IT_ABIN;
                if (r < IT_ABOUT) { if (FP8_OUTP) { const int mat = r / (8 * 32); conv_item_f8<false>(kin(I_ABWOUT) + (size_t)mat * 1024 * 1024, 1024, ws + WS_ABOUT + (size_t)mat * 1024 * 1024, r % (8 * 32), lane, 64.0f); }
                    else { const int mat = r / (16 * 32); conv_item<false>(kin(I_ABWOUT) + (size_t)mat * 1024 * 1024, 1024, (bf16_t*)(ws + WS_ABOUT) + (size_t)mat * 1024 * 1024, r % (16 * 32), lane); } continue; } r -= IT_ABOUT;
                if (r < IT_SGIN) { if (FP8_INP) { const int mat = r / (8 * 64); conv_item_f8<false>(kin(I_SGWIN) + (size_t)mat * 1024 * 2048, 2048, ws + WS_SGIN + (size_t)mat * 2048 * 1024, r % (8 * 64), lane, 32.0f); }
                    else { const int mat = r / (16 * 64); conv_item<false>(kin(I_SGWIN) + (size_t)mat * 1024 * 2048, 2048, (bf16_t*)(ws + WS_SGIN) + (size_t)mat * 2048 * 1024, r % (16 * 64), lane); } continue; } r -= IT_SGIN;
                if (r < IT_SGOUT) { if (FP8_OUTP) { const int mat = r / (8 * 32); conv_item_f8<false>(kin(I_SGWOUT) + (size_t)mat * 1024 * 1024, 1024, ws + WS_SGOUT + (size_t)mat * 1024 * 1024, r % (8 * 32), lane, 64.0f); }
                    else { const int mat = r / (16 * 32); conv_item<false>(kin(I_SGWOUT) + (size_t)mat * 1024 * 1024, 1024, (bf16_t*)(ws + WS_SGOUT) + (size_t)mat * 1024 * 1024, r % (16 * 32), lane); } continue; } r -= IT_SGOUT;
                if (r < IT_W1) {
                    if (FP8_M1) { const int mat = r / (8 * 64); conv_item_f8<true>(kin(I_W1) + (size_t)mat * 1024 * 2048, 2048, ws + WS_W1T8 + (size_t)mat * 2048 * 1024, r % (8 * 64), lane, 32.0f); }
                    else { const int mat = r / (16 * 64); conv_item<true>(kin(I_W1) + (size_t)mat * 1024 * 2048, 2048, (bf16_t*)(ws + WS_W1T) + (size_t)mat * 2048 * 1024, r % (16 * 64), lane); }
                    continue; } r -= IT_W1;
                if (FP8_M2) { const int mat = r / (8 * 32); conv_item_f8<false>(kin(I_W2) + (size_t)mat * 1024 * 1024, 1024, ws + WS_W2T8 + (size_t)mat * 1024 * 1024, r % (8 * 32), lane, 64.0f); }
                else { const int mat = r / (16 * 32); conv_item<false>(kin(I_W2) + (size_t)mat * 1024 * 1024, 1024, (bf16_t*)(ws + WS_W2T) + (size_t)mat * 1024 * 1024, r % (16 * 32), lane); }
            }
        }
        {
            const int gt = vcu * 512 + tid, NGT = G * 512;
            bf16_t* BR = (bf16_t*)(ws + WS_BR);
            if (!ROUTER_X) for (int i = gt; i < 4 * 256 * 1024; i += NGT) {
                const int l = i >> 18, n = (i >> 10) & 255, k = i & 1023; unsigned v = 0;
                if (n < 64) { const float w = kin(I_RW)[((size_t)l * 1024 + k) * 32 + (n & 31)]; const unsigned h = f2bf(w); v = h;
                    if (n >= 32) v = f2bf(w - __builtin_bit_cast(float, h << 16)); }
                BR[i] = (bf16_t)v;
            }
            bf16_t* BP = (bf16_t*)(ws + WS_BPOOL);
            for (int i = gt; i < 2 * 512 * 512; i += NGT) {
                const int j = i >> 18, n = (i >> 9) & 511, k = i & 511; unsigned v = 0;
                if ((n >> 7) == (k >> 7)) v = f2bf(kin(I_POOLW)[(((size_t)j * 4 + (n >> 7)) * 128 + (k & 127)) * 128 + (n & 127)]);
                BP[i] = (bf16_t)v;
            }
            bf16_t* BG = (bf16_t*)(ws + WS_BGATE);
            for (int i = gt; i < 2 * 1024 * 512; i += NGT) {
                const int j = i >> 19, n = (i >> 9) & 1023, k = i & 511; unsigned v = 0; const int nn = n & 511;
                if ((nn >> 6) == (k >> 6)) { const float* w = (n < 512) ? kin(I_WA) : kin(I_WX); v = f2bf(w[(((size_t)j * 8 + (nn >> 6)) * 64 + (k & 63)) * 64 + (nn & 63)]); }
                BG[i] = (bf16_t)v;
            }
            bf16_t* WSMp = (bf16_t*)(ws + WS_WSM);
            for (int i = gt; i < 2 * 8 * 128 * 128; i += NGT) {
                const int t = (i >> 7) & 127, s = i & 127; WSMp[i] = (bf16_t)((s <= t) ? f2bf(kin(I_SGWS)[i]) : 0u);
            }
            float* BRI = (float*)(ws + WS_BIASRI);
            for (int i = gt; i < 2 * 1024; i += NGT) { const int j = i >> 10, n = i & 1023; BRI[i] = (n < 512) ? kin(I_BA)[j * 512 + n] : kin(I_BX)[j * 512 + n - 512]; }
            float* B1P = (float*)(ws + WS_B1P);
            for (int i = gt; i < 4 * 32 * 2048; i += NGT) { const int le = i >> 11, rho = i & 2047; B1P[i] = kin(I_B1)[(size_t)le * 2048 + w1_n_of_rho(rho)]; }
        }
        SEAM(PH_CONV);
    }

    if (PHEN(1) && IN(PH_H0)) {
            PH_LOCALS;
        const int rows_per = T / NGW, r0 = gw * rows_per;
        const int b = r0 / SEQ;
        const float* shp = MOD + ((size_t)0 * 16 + b) * 3072, * scp = shp + 1024;
        f32x4 sh[4], sc[4];
#pragma unroll
        for (int j = 0; j < 4; ++j) { sh[j] = *(const f32x4*)(shp + 4 * (64 * j + lane)); sc[j] = *(const f32x4*)(scp + 4 * (64 * j + lane)); }
        for (int r = r0; r < r0 + rows_per; ++r) {
            const f32x4* xr = (const f32x4*)(kin(I_X) + (size_t)r * D) + lane;
            u32x2* hr = (u32x2*)(Hb + (size_t)r * D) + lane;
#pragma unroll
            for (int j = 0; j < 4; ++j) { const f32x4 v = xr[64 * j]; const f32x4 h = v * (sc[j] + 1.0f) + sh[j];
                if (FP8_INP) ((unsigned*)(ws + WS_H8 + (size_t)r * D) + lane)[64 * j] = pk4_fp8(h[0], h[1], h[2], h[3]);
                else { u32x2 w; w.x = pk2(h[0], h[1]); w.y = pk2(h[2], h[3]); hr[64 * j] = w; } }
        }
        if (ROUTER_X) {
            bf16_t* BRB = (bf16_t*)(ws + WS_BRB);
            const float* rwp = kin(I_RW);
            for (int i = vcu * 512 + tid; i < 4 * 32 * 1024; i += G * 512) {
                const int l = i >> 15, e = (i >> 10) & 31, k = i & 1023;
                const float w = rwp[((size_t)l * 1024 + k) * 32 + e];
#pragma unroll 4
                for (int bq = 0; bq < 16; ++bq) {
                    const float wm = w * (1.0f + MOD[((size_t)(2 * l + 1) * 16 + bq) * 3072 + 1024 + k]);
                    const unsigned h = f2bf(wm), lo2 = f2bf(wm - __builtin_bit_cast(float, h << 16));
                    bf16_t* o = BRB + (((size_t)l * 16 + bq) * 64 + e) * 1024 + k; o[0] = (bf16_t)h; o[32 * 1024] = (bf16_t)lo2; }
            }
            for (int i = vcu * 512 + tid; i < 192 * 1024 / 2; i += G * 512) ((unsigned*)(BRB + (size_t)4 * 16 * 64 * 1024))[i] = 0u;
            const int it = vcu + G * wave;
            if (it < 512) {
                const int l = it >> 7, bq = (it >> 3) & 15, eq = it & 7;
                const float* shq = MOD + ((size_t)(2 * l + 1) * 16 + bq) * 3072;
                const f32x4* rw4 = (const f32x4*)(kin(I_RW) + (size_t)l * 1024 * 32) + eq;
                float sa[4] = {0.f, 0.f, 0.f, 0.f};
#pragma unroll
                for (int i2 = 0; i2 < 16; ++i2) { const int k = lane + 64 * i2; const f32x4 wv4 = rw4[(size_t)k * 8]; const float sk = shq[k]; sa[0] += wv4[0] * sk; sa[1] += wv4[1] * sk; sa[2] += wv4[2] * sk; sa[3] += wv4[3] * sk; }
#pragma unroll
                for (int o = 1; o < 64; o <<= 1) {
#pragma unroll
                    for (int c4 = 0; c4 < 4; ++c4) sa[c4] += __builtin_bit_cast(float, __builtin_amdgcn_ds_bpermute((lane ^ o) << 2, __builtin_bit_cast(int, sa[c4])));
                }
                const f32x4 rb4 = *(const f32x4*)(kin(I_RB) + l * 32 + 4 * eq);
                *(f32x4*)((float*)(ws + WS_CB) + (l * 16 + bq) * 32 + 4 * eq) = (f32x4){sa[0] + rb4[0], sa[1] + rb4[1], sa[2] + rb4[2], sa[3] + rb4[3]};
            }
        }
        SEAM(PH_H0);
    }

    layer_body<0>(lds, LCTL, lo, hi, G, bar, wave0); layer_body<1>(lds, LCTL, lo, hi, G, bar, wave0); layer_body<2>(lds, LCTL, lo, hi, G, bar, wave0); layer_body<3>(lds, LCTL, lo, hi, G, bar, wave0);
}
#undef IN
#undef SEAM

#ifdef DUMP_SPEC
struct DumpSrc { size_t off; int ld; int col0; };
__global__ void dump_kernel(const unsigned char* ws, float* out) {
    const DumpSrc srcs[8] = DUMP_SPEC;
    const size_t i = (size_t)blockIdx.x * blockDim.x + threadIdx.x;
    const int r = (int)(i >> 10), c = (int)(i & 1023), blk = c >> 7, cc = c & 127;
    const DumpSrc d = srcs[blk];
    const bf16_t* p = (const bf16_t*)(ws + d.off);
    out[i] = bf2f(p[(size_t)r * d.ld + d.col0 + cc]);
}
#endif
extern "C" void kernel_launch(void* const* d_in, const int* in_sizes, int n_in, void* d_out, int out_size, void* d_ws, size_t ws_size, hipStream_t stream) {
    static int grid = 0;
    if (grid == 0) {
        if (n_in != 32 || out_size != T * D || ws_size < WS_END) { fprintf(stderr, "kernel_launch: unexpected problem (n_in %d, out %d, ws %zu)\n", n_in, out_size, ws_size); grid = -1; return; }
        int dev = 0, cus = 0, per_cu = 0;
        if (hipGetDevice(&dev) != hipSuccess || hipDeviceGetAttribute(&cus, hipDeviceAttributeMultiprocessorCount, dev) != hipSuccess) { grid = -1; return; }
        if (hipFuncSetAttribute((const void*)fwd_kernel, hipFuncAttributeMaxDynamicSharedMemorySize, LDS_BYTES) != hipSuccess) { fprintf(stderr, "kernel_launch: hipFuncSetAttribute failed\n"); grid = -1; return; }
        if (hipOccupancyMaxActiveBlocksPerMultiprocessor(&per_cu, (const void*)fwd_kernel, 512, LDS_BYTES) != hipSuccess || per_cu < 1) fprintf(stderr, "kernel_launch: occupancy query says %d\n", per_cu);
        (void)hipGetLastError();
        grid = cus;
        if (grid * 8 > T || (T % (grid * 8)) != 0) { fprintf(stderr, "kernel_launch: grid %d does not divide the rows\n", grid); grid = -1; return; }
    }
    if (grid < 0) return;
    (void)hipMemsetAsync((char*)d_ws + WS_CTL, 0, CTL_ZERO_BYTES, stream);
    Args a{};
    for (int i = 0; i < 32; ++i) a.in[i] = (const float*)d_in[i];
    a.out = (float*)d_out; a.ws = (unsigned char*)d_ws;
#if MK_ONE_LAUNCH
    a.ph_lo = 0; a.ph_hi = NPH;
    hipLaunchKernelGGL(fwd_kernel, dim3(grid), dim3(512), LDS_BYTES, stream, a);
#else
#ifndef STOP_PH
#define STOP_PH NPH
#endif
    for (int ph = 0; ph < STOP_PH; ++ph) {
        if (!phase_exists(ph)) continue;
        a.ph_lo = ph; a.ph_hi = ph + 1;
        hipLaunchKernelGGL(fwd_kernel, dim3(grid), dim3(512), LDS_BYTES, stream, a);
#ifdef REP_SLOTS
        { const int slot = ph < PH_L0 ? ph : 2 + (ph - PH_L0) % PH_PER_LAYER; if ((REP_SLOTS >> slot) & 1) {
#ifdef PROBE_VARIANTS
            a.variant = PROBE_VARIANTS;
#endif
            hipLaunchKernelGGL(fwd_kernel, dim3(grid), dim3(512), LDS_BYTES, stream, a); a.variant = 0; } }
#endif
    }
#ifdef DUMP_SPEC
    hipLaunchKernelGGL(dump_kernel, dim3(T * 1024 / 256), dim3(256), 0, stream, (const unsigned char*)d_ws, (float*)d_out);
#endif
#endif
}
```

```cpp
#include <hip/hip_runtime.h>
#include <cstdio>
#include <cstdint>

#ifndef PIN_ACC
#define PIN_ACC 0
#endif
#ifndef FP8_M1
#define FP8_M1 1
#endif
#ifndef FP8_M2
#define FP8_M2 1
#endif
#ifndef FP8_YS
#define FP8_INP 0
#define FP8_OUTP 1
#define WIDE_EPI 1
#define ROUTER_X 1
#define FP8_YS 1
#endif
#ifndef MK_ONE_LAUNCH
#define MK_ONE_LAUNCH 1
#endif

#ifndef PHMASK
#define PHMASK 0xFFFFF
#endif
#define PHEN(k) (((PHMASK) >> (k)) & 1)
#define LAS __attribute__((address_space(3)))
#define GAS __attribute__((address_space(1)))
typedef unsigned short bf16_t;
typedef short bf16x8 __attribute__((ext_vector_type(8)));
typedef float f32x4 __attribute__((ext_vector_type(4)));
typedef float f32x2 __attribute__((ext_vector_type(2)));
typedef unsigned u32x4 __attribute__((ext_vector_type(4)));
typedef unsigned u32x2 __attribute__((ext_vector_type(2)));

constexpr int D = 1024, NBATCH = 16, SEQ = 4096, T = NBATCH * SEQ, DEPTH = 4;
constexpr int NE = 32, TOPK = 4, TKTOT = T * TOPK;
constexpr int DPOOL = 512, DREC = 512, DINAB = 1536;
constexpr float LN_EPS = 1e-5f;
constexpr float DN_ALPHA = 1.6817928305074292f;

constexpr size_t MiB = 1ull << 20;
constexpr size_t WS_CTL = 0, CTL_ZERO_BYTES = 1 * MiB;
constexpr size_t WS_MOD = 1 * MiB;
constexpr size_t WS_BR = 3 * MiB;
constexpr size_t WS_BPOOL = 5 * MiB;
constexpr size_t WS_BGATE = 6 * MiB;
constexpr size_t WS_WSM = 8 * MiB;
constexpr size_t WS_BIASRI = 8 * MiB + 512 * 1024;
constexpr size_t WS_B1P = 9 * MiB;
constexpr size_t WS_SUMM = 10 * MiB;
constexpr size_t WS_TOPG = 12 * MiB;
constexpr size_t WS_ABIN = 16 * MiB;
constexpr size_t WS_ABOUT = 22 * MiB;
constexpr size_t WS_SGIN = 26 * MiB;
constexpr size_t WS_SGOUT = 34 * MiB;
constexpr size_t WS_LOG = 40 * MiB;
constexpr size_t WS_LIST = 64 * MiB;
constexpr size_t WS_BRB = 128 * MiB;
constexpr size_t WS_CB = 140 * MiB;
constexpr size_t WS_W1T = 128 * MiB;
constexpr size_t WS_W2T = 640 * MiB;
constexpr size_t WS_H = 896 * MiB;
constexpr size_t WS_Z = 1024 * MiB;
constexpr size_t WS_A2 = 1280 * MiB;
constexpr size_t WS_RI = 1408 * MiB;
constexpr size_t WS_YMIX = 1536 * MiB;
constexpr size_t WS_Y = 1664 * MiB;
constexpr size_t WS_ACT = 1792 * MiB;
constexpr size_t WS_YS = 2304 * MiB;
constexpr size_t WS_W1T8 = 2944 * MiB;
constexpr size_t WS_W2T8 = 3200 * MiB;
constexpr size_t WS_H8 = 3328 * MiB;
constexpr size_t WS_ACT8 = 3392 * MiB;
constexpr size_t WS_XB = 2816 * MiB;
constexpr size_t WS_END = 3648 * MiB;

constexpr int CW_BAR = 4096;
constexpr int CW_CNT = 16384;

constexpr int PH_CONV = 0, PH_H0 = 1, PH_L0 = 2, PH_PER_LAYER = 12, NPH = PH_L0 + PH_PER_LAYER * DEPTH;
__host__ __device__ constexpr bool phase_exists(int ph) {
    if (ph < PH_L0) return true;
    const int l = (ph - PH_L0) / PH_PER_LAYER, s = (ph - PH_L0) % PH_PER_LAYER;
    if ((l & 1) && (s == 2 || s == 3 || s == 4)) return false;
    return true;
}

constexpr int LDS_BYTES = 155648;
constexpr int LDSCTL_OFF = 154624;
constexpr int NXT_OFF = 131072;
constexpr int TAB_OFF = 147456;
constexpr int UTAB_OFF = 153600;

__device__ __forceinline__ unsigned f2bf(float f) { unsigned u = __builtin_bit_cast(unsigned, f); return (u + 0x7fffu + ((u >> 16) & 1u)) >> 16; }
typedef __bf16 bf16v2_t __attribute__((ext_vector_type(2)));
__device__ __forceinline__ unsigned pk2(float lo, float hi) { const f32x2 f = {lo, hi}; return __builtin_bit_cast(unsigned, __builtin_convertvector(f, bf16v2_t)); }
__device__ __forceinline__ float bflo(unsigned w) { return __builtin_bit_cast(float, w << 16); }
__device__ __forceinline__ float bfhi(unsigned w) { return __builtin_bit_cast(float, w & 0xffff0000u); }
__device__ __forceinline__ float bf2f(bf16_t h) { return __builtin_bit_cast(float, ((unsigned)h) << 16); }
__device__ __forceinline__ unsigned cvt_pk_bf16(float lo, float hi) { return pk2(lo, hi); }
__device__ __forceinline__ unsigned pk4_fp8(float a, float b, float c, float d) { int w = 0; w = __builtin_amdgcn_cvt_pk_fp8_f32(a, b, w, false); w = __builtin_amdgcn_cvt_pk_fp8_f32(c, d, w, true); return (unsigned)w; }
__device__ __forceinline__ float fast_sigmoid(float x) { return __builtin_amdgcn_rcpf(1.0f + __builtin_amdgcn_exp2f(-1.4426950408889634f * x)); }
__device__ __forceinline__ float gelu_tanh(float x) { const float u = x * (1.5957691216057308f + 0.07135481627362202f * x * x); return x * fast_sigmoid(u); }
__device__ __forceinline__ f32x2 pk_sigmoid_scaled(f32x2 x, float nk) {
    const f32x2 t = x * nk; f32x2 e; e.x = __builtin_amdgcn_exp2f(t.x); e.y = __builtin_amdgcn_exp2f(t.y);
    const f32x2 d = e + 1.0f; f32x2 r; r.x = __builtin_amdgcn_rcpf(d.x); r.y = __builtin_amdgcn_rcpf(d.y); return r; }
__device__ __forceinline__ f32x2 pk_gelu_tanh(f32x2 x) {
    const f32x2 t = x * ((x * x) * (-0.07135481627362202f * 1.4426950408889634f) + (-1.5957691216057308f * 1.4426950408889634f));
    f32x2 e; e.x = __builtin_amdgcn_exp2f(t.x); e.y = __builtin_amdgcn_exp2f(t.y);
    const f32x2 d = e + 1.0f; f32x2 r; r.x = __builtin_amdgcn_rcpf(d.x); r.y = __builtin_amdgcn_rcpf(d.y); return x * r; }
__device__ __forceinline__ float wave_sum(float v, int lane) {
#pragma unroll
    for (int o = 1; o < 64; o <<= 1) v += __builtin_bit_cast(float, __builtin_amdgcn_ds_bpermute((lane ^ o) << 2, __builtin_bit_cast(int, v)));
    return v;
}

__device__ __forceinline__ int lane_id_asm() { int l; asm volatile("v_mbcnt_lo_u32_b32 %0, -1, 0\n\tv_mbcnt_hi_u32_b32 %0, -1, %0" : "=v"(l)); return l; }
#define XB_TMO      128
#define XB_XCNT(j)  (256  + 64 * (j))
#define XB_XSUB(j)  (1280 + 64 * (j))
#define XB_XGEN(j)  (2304 + 64 * (j))
#define XB_TOP      3328
#define XB_TOPGEN   3392
#define XCD_BAR_WORDS 3456
#define XB_SPIN_CAP (1u << 18)

__device__ __forceinline__ unsigned xb_ld(unsigned* p)              { return __hip_atomic_load(p, __ATOMIC_RELAXED, __HIP_MEMORY_SCOPE_AGENT); }
__device__ __forceinline__ unsigned xb_add(unsigned* p, unsigned v) { return __hip_atomic_fetch_add(p, v, __ATOMIC_RELAXED, __HIP_MEMORY_SCOPE_AGENT); }
__device__ __forceinline__ unsigned xb_xcc_id() { return (unsigned)__builtin_amdgcn_s_getreg((3 << 11) | 20) & 0xFu; }
#define XB_SPIN(cond, bar) do { unsigned _sp = 0; while (cond) { __builtin_amdgcn_s_sleep(1); \
    if ((++_sp & 255u) == 0u) { if (xb_ld(&(bar)[XB_TMO])) break; if (_sp > XB_SPIN_CAP) { atomicAdd(&(bar)[XB_TMO], 1u); break; } } } } while (0)

struct XcdBarrier {
    unsigned* bar; unsigned x; int wv;
    volatile LAS unsigned* st;
};

__device__ __forceinline__ XcdBarrier xcd_barrier_post(unsigned* bar, volatile LAS unsigned* st, int wv) {
    XcdBarrier b; b.bar = bar; b.x = xb_xcc_id(); b.st = st; b.wv = wv;
    if (wv == 0 && lane_id_asm() == 0) (void)xb_add(&bar[XB_XCNT(b.x)], 1u);
    return b;
}
__device__ __forceinline__ void xcd_barrier_complete(unsigned* bar, unsigned x, unsigned& nloc, unsigned& nx) {
    const unsigned G = gridDim.x * gridDim.y * gridDim.z;
    unsigned sum, cnt, mine, sp = 0u;
    for (;;) {
        sum = 0u; cnt = 0u; mine = 0u;
#pragma unroll
        for (unsigned j = 0; j < 16; ++j) { const unsigned c = xb_ld(&bar[XB_XCNT(j)]); sum += c; cnt += (c > 0u) ? 1u : 0u; mine = (j == x) ? c : mine; }
        if (sum == G) break;
        __builtin_amdgcn_s_sleep(1);
        if ((++sp & 255u) == 0u) { if (xb_ld(&bar[XB_TMO])) break; if (sp > XB_SPIN_CAP) { atomicAdd(&bar[XB_TMO], 1u); break; } }
    }
    nloc = mine > 0u ? mine : 1u; nx = cnt > 0u ? cnt : 1u;
}

__device__ __forceinline__ void xcd_barrier(const XcdBarrier& b) {
    asm volatile("s_waitcnt vmcnt(0)" ::: "memory");
    __syncthreads();
    if (b.wv == 0 && lane_id_asm() == 0) {
        unsigned* bar = b.bar;
        __builtin_amdgcn_s_waitcnt(0);
        unsigned nloc = b.st[0], nx = b.st[1];
        if (nloc == 0u) { xcd_barrier_complete(bar, b.x, nloc, nx); b.st[0] = nloc; b.st[1] = nx; }
        const unsigned old = xb_add(&bar[XB_XSUB(b.x)], 1u);
        const unsigned gen = old / nloc;
        if (old + 1u == (gen + 1u) * nloc) {
            __builtin_amdgcn_fence(__ATOMIC_RELEASE, "agent");
            asm volatile("s_waitcnt vmcnt(0)" ::: "memory");
            const unsigned og = xb_add(&bar[XB_TOP], 1u);
            const unsigned tg = og / nx;
            if (og + 1u == (tg + 1u) * nx) xb_add(&bar[XB_TOPGEN], 1u);
            else XB_SPIN(xb_ld(&bar[XB_TOPGEN]) == tg, bar);
            __builtin_amdgcn_fence(__ATOMIC_ACQUIRE, "agent");
            xb_add(&bar[XB_XGEN(b.x)], 1u);
            asm volatile("s_waitcnt vmcnt(0)" ::: "memory");
        } else {
            XB_SPIN(xb_ld(&bar[XB_XGEN(b.x)]) == gen, bar);
            __builtin_amdgcn_fence(__ATOMIC_ACQUIRE, "agent");
            asm volatile("s_waitcnt vmcnt(0)" ::: "memory");
        }
    }
    __syncthreads();
}

#ifdef PROBE_VARIANTS
__device__ __forceinline__ int kvariant() { return *(const __attribute__((address_space(4))) int*)((const __attribute__((address_space(4))) unsigned char*)__builtin_amdgcn_kernarg_segment_ptr() + 280); }
#endif
__device__ __forceinline__ void glds16(const char* sbase, unsigned voff, unsigned lds_dst) {
    unsigned keep;
    asm volatile("s_mov_b32 %0, m0\n\ts_mov_b32 m0, %3\n\ts_nop 0\n\tglobal_load_lds_dwordx4 %1, %2\n\ts_mov_b32 m0, %0" : "=&s"(keep) : "v"(voff), "s"(sbase), "s"(lds_dst) : "memory");
}
__device__ __forceinline__ void glds4(const char* sbase, unsigned voff, unsigned lds_dst) {
    unsigned keep;
    asm volatile("s_mov_b32 %0, m0\n\ts_mov_b32 m0, %3\n\ts_nop 0\n\tglobal_load_lds_dword %1, %2\n\ts_mov_b32 m0, %0" : "=&s"(keep) : "v"(voff), "s"(sbase), "s"(lds_dst) : "memory");
}
namespace pg8 {
constexpr int BM = 256, BK = 64, HALF = 128, HTB = HALF * BK * 2, STAGE_BYTES = 8 * HTB, NXCD = 8, WGM = 8;
__host__ __device__ __forceinline__ int perm32(int rho) { const int n = rho >> 4, i = rho & 15; return 8 * (i >> 2) + 4 * n + (i & 3); }

template <bool F8> __host__ __device__ __forceinline__ int chunk_xor(int r15) { const int rp = (r15 >> 1) & 7; return F8 ? ((rp & 4) | ((rp & 1) << 1) | ((rp >> 1) & 1)) : rp; }
struct Unit { int arow, brow, pn, e, rt, cnt, slot, koff; };
struct Gemm { const void* A; const void* Bt; int lda, ldb, K, wscale; };
typedef int i32x4 __attribute__((ext_vector_type(4)));
typedef int i32x8 __attribute__((ext_vector_type(8)));
__device__ __forceinline__ i32x8 cat8(bf16x8 lo, bf16x8 hi) { return __builtin_shufflevector(__builtin_bit_cast(i32x4, lo), __builtin_bit_cast(i32x4, hi), 0, 1, 2, 3, 4, 5, 6, 7); }

struct DenseSched {
    static constexpr bool GATHER = false;
    int nM, nN, nwg, G, c, kblk = 0, bb = 0;
    __device__ __forceinline__ void init(int M, int N, int G_, int c_) { nM = M / BM; nN = N / BM; nwg = nM * nN; G = G_; c = c_; }
    __device__ __forceinline__ bool next(int i, Unit& u) const {
        const long L = (long)i * G + c; if (L >= nwg) return false;
        int wgid = (int)L; { const int q = nwg / NXCD, r = nwg % NXCD, xcd = wgid % NXCD, off = wgid / NXCD; wgid = (xcd < r ? xcd * (q + 1) : r * (q + 1) + (xcd - r) * q) + off; }
        const int nig = WGM * nN, gid = wgid / nig, fm = gid * WGM, gsz = (nM - fm) < WGM ? (nM - fm) : WGM;
        const int pm = fm + ((wgid % nig) % gsz), pn = (wgid % nig) / gsz;
        u.arow = pm * BM; u.brow = pn * BM; u.pn = pn; u.e = 0; u.rt = pm; u.cnt = BM; u.slot = 0; u.koff = (pn & 1) * kblk; u.brow += ((pm * BM) >> 12) * bb; return true;
    }
    __device__ __forceinline__ void a_off(const Unit& u, LAS unsigned char*, int R0, int C0, int lda2, unsigned (&off)[2][2]) const {
#pragma unroll
        for (int h = 0; h < 2; ++h)
#pragma unroll
            for (int i = 0; i < 2; ++i) off[h][i] = (unsigned)((u.arow + 128 * h + 64 * i + R0) * lda2 + C0);
    }
};

struct MoeSched {
    static constexpr bool GATHER = true;
    const LAS int* utab;
    const int* list;
    const float* bias;
    int nunits, nexp_rows, shift;
    __device__ __forceinline__ bool next(int i, Unit& u) const {
        if (i >= nunits) return false;
        const LAS int* p = utab + 4 * i;
        u.e = __builtin_amdgcn_readfirstlane(p[0]); u.rt = __builtin_amdgcn_readfirstlane(p[1]); u.pn = __builtin_amdgcn_readfirstlane(p[2]); u.cnt = __builtin_amdgcn_readfirstlane(p[3]);
        u.arow = 0; u.brow = u.e * nexp_rows + u.pn * BM; u.slot = i % 3; u.koff = 0; return true;
    }
    __device__ __forceinline__ void tab_issue(const Unit& u, unsigned ldsb, int wid, int lane) const {
        if (wid < 4) { int p = u.rt * BM + 64 * wid + lane; p = p < u.cnt ? p : u.cnt - 1;
            glds4((const char*)(list + (size_t)u.e * TKTOT), (unsigned)p * 4u, ldsb + TAB_OFF + u.slot * 1024 + wid * 256); }
        else glds4((const char*)(bias + (size_t)u.e * nexp_rows + u.pn * BM), (unsigned)(64 * (wid - 4) + lane) * 4u, ldsb + TAB_OFF + 3072 + u.slot * 1024 + (wid - 4) * 256);
    }
    __device__ __forceinline__ void a_off(const Unit& u, LAS unsigned char* lds, int R0, int C0, int lda2, unsigned (&off)[2][2]) const {
        const LAS int* ids = (const LAS int*)(lds + TAB_OFF + u.slot * 1024);
#pragma unroll
        for (int h = 0; h < 2; ++h)
#pragma unroll
            for (int i = 0; i < 2; ++i) off[h][i] = (unsigned)((ids[128 * h + 64 * i + R0] >> shift) * lda2 + C0);
    }
};
__device__ __forceinline__ int moe_build_units(LAS int* utab, const volatile LAS int* tstart, const volatile LAS int* cnts, int NP, int G, int c, int tid) {
    const int total = tstart[NE] * NP;
    if (tid < 64) { const int L = tid * G + c;
        if (L < total) { int e = 0;
            for (int q = 0; q < NE - 1; ++q) if (tstart[q + 1] * NP <= L) e = q + 1;
            const int t0 = tstart[e], nte = tstart[e + 1] - t0, idx = L - t0 * NP;
            utab[4 * tid + 0] = e; utab[4 * tid + 1] = idx % nte; utab[4 * tid + 2] = idx / nte; utab[4 * tid + 3] = cnts[e]; } }
    return total > c ? (total - c + G - 1) / G : 0;
}

template <int ACT  , bool HAS_BIAS, bool HAS_SCALE, bool OSC = false, bool OUT8 = false> struct EpiDense {
    static constexpr int PERM = WIDE_EPI ? 2 : 1;
    bf16_t* O; int ldc; const float* bias; const float* scale; float oscale;
    __device__ __forceinline__ void operator()(const f32x4 (&acc)[2][2][4][2], const Unit& u, int wr, int wc, int fr, int fq) const {
        const int row0 = u.arow + wr * 64 + fr, col0 = PERM == 2 ? u.pn * BM + wc * 64 + 16 * fq : u.pn * BM + wc * 32 + 8 * fq;
        constexpr int BJS = PERM == 2 ? 8 : HALF;
        f32x4 bv[2][2], sv[2][2];
#pragma unroll
        for (int bj = 0; bj < 2; ++bj)
#pragma unroll
            for (int n = 0; n < 2; ++n) {
                if (HAS_BIAS) bv[bj][n] = *(const f32x4*)(bias + col0 + bj * BJS + 4 * n);
                if (HAS_SCALE) sv[bj][n] = *(const f32x4*)(scale + col0 + bj * BJS + 4 * n);
            }
#pragma unroll
        for (int ai = 0; ai < 2; ++ai)
#pragma unroll
            for (int m = 0; m < 4; ++m) { bf16_t* rowp = O + (size_t)(row0 + ai * HALF + m * 16) * ldc + col0; unsigned char* rowp8 = (unsigned char*)O + (size_t)(row0 + ai * HALF + m * 16) * ldc + col0;
                u32x4 w8;
#pragma unroll
                for (int bj = 0; bj < 2; ++bj) { f32x4 v0 = acc[ai][bj][m][0], v1 = acc[ai][bj][m][1];
                    if (OSC) { v0 = v0 * oscale; v1 = v1 * oscale; }
                    if (HAS_BIAS) { v0 = v0 + bv[bj][0]; v1 = v1 + bv[bj][1]; }
                    if (ACT == 1) { const f32x2 a = pk_gelu_tanh((f32x2){v0[0], v0[1]}), b = pk_gelu_tanh((f32x2){v0[2], v0[3]}), c = pk_gelu_tanh((f32x2){v1[0], v1[1]}), d = pk_gelu_tanh((f32x2){v1[2], v1[3]});
                        v0 = (f32x4){a.x, a.y, b.x, b.y}; v1 = (f32x4){c.x, c.y, d.x, d.y}; }
                    if (ACT == 2) { const float nk = -1.4426950408889634f;
                        const f32x2 a = pk_sigmoid_scaled((f32x2){v0[0], v0[1]}, nk), b = pk_sigmoid_scaled((f32x2){v0[2], v0[3]}, nk), c = pk_sigmoid_scaled((f32x2){v1[0], v1[1]}, nk), d = pk_sigmoid_scaled((f32x2){v1[2], v1[3]}, nk);
                        v0 = (f32x4){a.x, a.y, b.x, b.y}; v1 = (f32x4){c.x, c.y, d.x, d.y}; }
                    if (HAS_SCALE) { v0 = v0 * sv[bj][0]; v1 = v1 * sv[bj][1]; }
                    if constexpr (OUT8) { const unsigned p0 = pk4_fp8(v0[0], v0[1], v0[2], v0[3]), p1 = pk4_fp8(v1[0], v1[1], v1[2], v1[3]);
                        if constexpr (PERM == 2) { if (bj == 0) { w8.x = p0; w8.y = p1; } else { w8.z = p0; w8.w = p1; *(u32x4*)rowp8 = w8; } }
                        else { u32x2 w; w.x = p0; w.y = p1; *(u32x2*)(rowp8 + bj * HALF) = w; } }
                    else { u32x4 w; w.x = cvt_pk_bf16(v0[0], v0[1]); w.y = cvt_pk_bf16(v0[2], v0[3]); w.z = cvt_pk_bf16(v1[0], v1[1]); w.w = cvt_pk_bf16(v1[2], v1[3]);
                    *(u32x4*)(rowp + bj * BJS) = w; } } }
    }
};
struct EpiRouter {
    static constexpr int PERM = 0;
    float* LOG;
    __device__ __forceinline__ void operator()(const f32x4 (&acc)[2][2][4][2], const Unit& u, int wr, int wc, int fr, int fq) const {
        if (wc < 2) {
#pragma unroll
            for (int ai = 0; ai < 2; ++ai)
#pragma unroll
                for (int m = 0; m < 4; ++m) { float* rowp = LOG + (size_t)(u.arow + ai * HALF + wr * 64 + m * 16 + fr) * 64 + wc * 32 + 4 * fq;
#pragma unroll
                    for (int n = 0; n < 2; ++n) *(f32x4*)(rowp + 16 * n) = acc[ai][0][m][n]; }
        }
    }
};
template <bool OUT8> struct EpiMoe1 {
    static constexpr int PERM = 0;
    bf16_t* ACT; LAS unsigned char* lds; float oscale;
    __device__ __forceinline__ void operator()(const f32x4 (&acc)[2][2][4][2], const Unit& u, int wr, int wc, int fr, int fq) const {
        const LAS int* ids = (const LAS int*)(lds + TAB_OFF + u.slot * 1024);
        const LAS float* bp = (const LAS float*)(lds + TAB_OFF + 3072 + u.slot * 1024) + wc * 32 + 4 * fq;
        f32x4 bg[2], bl[2];
#pragma unroll
        for (int bj = 0; bj < 2; ++bj) { bg[bj] = *(const LAS f32x4*)(bp + bj * HALF); bl[bj] = *(const LAS f32x4*)(bp + bj * HALF + 16) + 1.0f; }
        const int j0 = u.pn * 128 + wc * 32 + 8 * fq;
#pragma unroll
        for (int ai = 0; ai < 2; ++ai)
#pragma unroll
            for (int m = 0; m < 4; ++m) {
                const int pl = ai * HALF + wr * 64 + m * 16 + fr;
                if (u.rt * BM + pl < u.cnt) {
                    const int flat = ids[pl];
                    float o[8];
#pragma unroll
                    for (int bj = 0; bj < 2; ++bj) { const f32x4 g = acc[ai][bj][m][0] * oscale + bg[bj], l = acc[ai][bj][m][1] * oscale + bl[bj];
#pragma unroll
                        for (int hh = 0; hh < 2; ++hh) {
                            const f32x2 xg = {fminf(g[2 * hh], 7.0f), fminf(g[2 * hh + 1], 7.0f)};
                            const f32x2 xl = {__builtin_amdgcn_fmed3f(l[2 * hh], -6.0f, 8.0f), __builtin_amdgcn_fmed3f(l[2 * hh + 1], -6.0f, 8.0f)};
                            const f32x2 r = pk_sigmoid_scaled(xg, -1.702f * 1.4426950408889634f), oo = (xg * xl) * r;
                            o[bj * 4 + 2 * hh] = oo.x; o[bj * 4 + 2 * hh + 1] = oo.y; } }
                    if constexpr (OUT8) { u32x2 w; w.x = pk4_fp8(o[0], o[1], o[2], o[3]); w.y = pk4_fp8(o[4], o[5], o[6], o[7]);
                        *(u32x2*)((unsigned char*)ACT + (size_t)flat * 1024 + j0) = w; }
                    else { u32x4 w; w.x = cvt_pk_bf16(o[0], o[1]); w.y = cvt_pk_bf16(o[2], o[3]); w.z = cvt_pk_bf16(o[4], o[5]); w.w = cvt_pk_bf16(o[6], o[7]);
                        *(u32x4*)(ACT + (size_t)flat * 1024 + j0) = w; }
                }
            }
    }
};
struct EpiMoe2 {
    static constexpr int PERM = (WIDE_EPI && FP8_YS) ? 2 : 1;
    bf16_t* YS; LAS unsigned char* lds; float oscale;
    __device__ __forceinline__ void operator()(const f32x4 (&acc)[2][2][4][2], const Unit& u, int wr, int wc, int fr, int fq) const {
        const LAS int* ids = (const LAS int*)(lds + TAB_OFF + u.slot * 1024);
        if constexpr (PERM == 2) {
            const LAS float* bp = (const LAS float*)(lds + TAB_OFF + 3072 + u.slot * 1024) + wc * 64 + 16 * fq;
            const int col0 = u.pn * BM + wc * 64 + 16 * fq;
            const float os = 16.0f * oscale;
#pragma unroll
            for (int ai = 0; ai < 2; ++ai) {
                const f32x4 b00 = *(const LAS f32x4*)(bp) * 16.0f, b01 = *(const LAS f32x4*)(bp + 4) * 16.0f, b10 = *(const LAS f32x4*)(bp + 8) * 16.0f, b11 = *(const LAS f32x4*)(bp + 12) * 16.0f;
#pragma unroll
                for (int m = 0; m < 4; ++m) {
                    const int pl = ai * HALF + wr * 64 + m * 16 + fr;
                    if (u.rt * BM + pl < u.cnt) {
                        const int flat = ids[pl];
                        const f32x4 v00 = acc[ai][0][m][0] * os + b00, v01 = acc[ai][0][m][1] * os + b01, v10 = acc[ai][1][m][0] * os + b10, v11 = acc[ai][1][m][1] * os + b11;
                        u32x4 w; w.x = pk4_fp8(v00[0], v00[1], v00[2], v00[3]); w.y = pk4_fp8(v01[0], v01[1], v01[2], v01[3]); w.z = pk4_fp8(v10[0], v10[1], v10[2], v10[3]); w.w = pk4_fp8(v11[0], v11[1], v11[2], v11[3]);
                        *(u32x4*)((unsigned char*)YS + (size_t)flat * 1024 + col0) = w;
                    }
                }
            }
        } else {
        const LAS float* bp = (const LAS float*)(lds + TAB_OFF + 3072 + u.slot * 1024) + wc * 32 + 8 * fq;
        const int col0 = u.pn * BM + wc * 32 + 8 * fq;
#pragma unroll
        for (int bj = 0; bj < 2; ++bj) {
            const float os = FP8_YS ? 16.0f * oscale : oscale;
            const f32x4 b0 = *(const LAS f32x4*)(bp + bj * HALF) * (FP8_YS ? 16.0f : 1.0f), b1 = *(const LAS f32x4*)(bp + bj * HALF + 4) * (FP8_YS ? 16.0f : 1.0f);
#pragma unroll
            for (int ai = 0; ai < 2; ++ai)
#pragma unroll
                for (int m = 0; m < 4; ++m) {
                    const int pl = ai * HALF + wr * 64 + m * 16 + fr;
                    if (u.rt * BM + pl < u.cnt) {
                        const int flat = ids[pl];
                        const f32x4 v0 = acc[ai][bj][m][0] * os + b0, v1 = acc[ai][bj][m][1] * os + b1;
                        if (FP8_YS) { u32x2 w; w.x = pk4_fp8(v0[0], v0[1], v0[2], v0[3]); w.y = pk4_fp8(v1[0], v1[1], v1[2], v1[3]);
                            *(u32x2*)((unsigned char*)YS + (size_t)flat * 1024 + col0 + bj * HALF) = w; }
                        else { u32x4 w; w.x = cvt_pk_bf16(v0[0], v0[1]); w.y = cvt_pk_bf16(v0[2], v0[3]); w.z = cvt_pk_bf16(v1[0], v1[1]); w.w = cvt_pk_bf16(v1[2], v1[3]);
                            *(u32x4*)(YS + (size_t)flat * 1024 + col0 + bj * HALF) = w; }
                    }
                }
        }
        }
    }
};

template <bool F8, class Epi, class Sched>
__device__ __forceinline__ void gemm_phase(LAS unsigned char* lds, const Gemm g, const Sched& S, const Epi& E, const int wave0) {
    const int tid = (wave0 << 6) | lane_id_asm();
    const int wid = __builtin_amdgcn_readfirstlane(tid >> 6), lane = tid & 63, wr = wid >> 2, wc = wid & 3, fr = lane & 15, fq = lane >> 4;
    constexpr unsigned ESZ = F8 ? 1u : 2u;
    const int nt = (int)((unsigned)g.K * ESZ / 128u);
    int R0, C0;
    R0 = 8 * wid + (lane >> 3); C0 = 16 * ((lane & 7) ^ chunk_xor<F8>(R0 & 15));
    const unsigned lda2 = (unsigned)g.lda * ESZ, ldb2 = (unsigned)g.ldb * ESZ;
    const unsigned voffB = (unsigned)((Epi::PERM == 2 ? (64 * (R0 >> 5) + 16 * ((R0 >> 2) & 3) + 4 * ((R0 >> 4) & 1) + (R0 & 3)) : Epi::PERM == 1 ? ((R0 & ~31) + perm32(R0 & 31)) : R0) * (int)ldb2 + C0);
    constexpr int PIECE_B = Epi::PERM == 2 ? 128 : 64;
    const unsigned aoffl = (unsigned)(R0 * (int)lda2 + C0);
    const unsigned kstep = 128;
    const size_t hstepB = (size_t)(Epi::PERM == 2 ? 8 : HALF) * ldb2;
    const unsigned ldsw = (unsigned)wid * 1024u;
    const int ab = fr * 128 + 16 * ((F8 ? 2 * fq : fq) ^ chunk_xor<F8>(fr));
    const int aoff0 = wr * 8192 + ab, boff0 = wc * 4096 + ab;
    constexpr int KX = F8 ? 16 : 64;
    const char* const Abase = (const char*)g.A;
    const unsigned ldsb = (unsigned)(size_t)lds;
#define PG8_SA(b, h) (((b) * 2 + (h)) * HTB)
#define PG8_SB(b, h) ((4 + (b) * 2 + (h)) * HTB)
#define PG8_GOFF(h, NXT) do { if constexpr (Sched::GATHER) go = *(const LAS u32x2*)(lds + NXT_OFF + ((((NXT) ? ui + 1 : ui) & 1) << 13) + tid * 16 + (h) * 8); } while (0)
#define PG8_STAGE_A(bufoff, h, NXT, kb) do { _Pragma("unroll") for (int _i = 0; _i < 2; ++_i) { \
        if constexpr (Sched::GATHER) glds16(Abase + (kb), _i ? go.y : go.x, ldsb + (bufoff) + ldsw + _i * 8192); \
        else glds16(Abase + ((NXT) ? nxtA : curA) + (size_t)((h) * 128 + _i * 64) * lda2 + (kb), aoffl, ldsb + (bufoff) + ldsw + _i * 8192); } } while (0)
#define PG8_STAGE_B(bufoff, bptr, kb) do { _Pragma("unroll") for (int _i = 0; _i < 2; ++_i) \
        glds16((bptr) + (size_t)(_i * PIECE_B) * ldb2 + (kb), voffB, ldsb + (bufoff) + ldsw + _i * 8192); } while (0)
#define PG8_LDA(dst, b, h) do { int _a1 = aoff0 ^ KX; asm volatile("" : "+v"(_a1)); \
        _Pragma("unroll") for (int m = 0; m < 4; ++m) _Pragma("unroll") for (int k = 0; k < 2; ++k) dst[m][k] = *(const LAS bf16x8*)(lds + PG8_SA(b, h) + (k ? _a1 : aoff0) + m * 2048); } while (0)
#define PG8_LDB(dst, b, h) do { int _b1 = boff0 ^ KX; asm volatile("" : "+v"(_b1)); \
        _Pragma("unroll") for (int n = 0; n < 2; ++n) _Pragma("unroll") for (int k = 0; k < 2; ++k) dst[n][k] = *(const LAS bf16x8*)(lds + PG8_SB(b, h) + (k ? _b1 : boff0) + n * 2048); } while (0)
#define PG8_MMA(ai, bj, At, Bt) do { __builtin_amdgcn_s_setprio(1); _Pragma("unroll") for (int m = 0; m < 4; ++m) _Pragma("unroll") for (int n = 0; n < 2; ++n) { \
        if constexpr (F8) acc[ai][bj][m][n] = __builtin_amdgcn_mfma_scale_f32_16x16x128_f8f6f4(cat8(Bt[n][0], Bt[n][1]), cat8(At[m][0], At[m][1]), acc[ai][bj][m][n], 0, 0, 0, 0, 0, 0); \
        else { _Pragma("unroll") for (int k = 0; k < 2; ++k) acc[ai][bj][m][n] = __builtin_amdgcn_mfma_f32_16x16x32_bf16(Bt[n][k], At[m][k], acc[ai][bj][m][n], 0, 0, 0); } } \
        __builtin_amdgcn_s_setprio(0); } while (0)
#define PG8_WAIT_V(n) asm volatile("s_waitcnt vmcnt(" #n ")" ::: "memory")
#define PG8_WAIT_L(n) asm volatile("s_waitcnt lgkmcnt(" #n ")" ::: "memory")
#define PG8_BAR __builtin_amdgcn_s_barrier()
#define PG8_SCHED __builtin_amdgcn_sched_barrier(0)
#define PG8_KITER(k1, b2, NXT, k2, k3) do { \
        PG8_GOFF(1, 0); PG8_LDB(B0, 0, 0); PG8_LDB(B1, 0, 1); PG8_SCHED; PG8_LDA(At, 0, 0); PG8_STAGE_A(PG8_SA(1, 1), 1, 0, (k1)); \
        PG8_WAIT_V(8); PG8_WAIT_L(0); PG8_BAR; PG8_MMA(0, 0, At, B0); PG8_MMA(0, 1, At, B1); PG8_BAR; PG8_SCHED; \
        PG8_GOFF(0, NXT); PG8_LDA(At, 0, 1); PG8_STAGE_B(PG8_SB(0, 0), (b2), (k2)); PG8_STAGE_B(PG8_SB(0, 1), (b2) + hstepB, (k2)); PG8_STAGE_A(PG8_SA(0, 0), 0, NXT, (k2)); \
        PG8_WAIT_V(8); PG8_WAIT_L(0); PG8_BAR; PG8_MMA(1, 0, At, B0); PG8_MMA(1, 1, At, B1); PG8_BAR; PG8_SCHED; \
        PG8_GOFF(1, NXT); PG8_LDB(B0, 1, 0); PG8_LDB(B1, 1, 1); PG8_SCHED; PG8_LDA(At, 1, 0); PG8_STAGE_A(PG8_SA(0, 1), 1, NXT, (k2)); \
        PG8_WAIT_V(8); PG8_WAIT_L(0); PG8_BAR; PG8_MMA(0, 0, At, B0); PG8_MMA(0, 1, At, B1); PG8_BAR; PG8_SCHED; \
        PG8_GOFF(0, NXT); PG8_LDA(At, 1, 1); PG8_STAGE_B(PG8_SB(1, 0), (b2), (k3)); PG8_STAGE_B(PG8_SB(1, 1), (b2) + hstepB, (k3)); PG8_STAGE_A(PG8_SA(1, 0), 0, NXT, (k3)); \
        PG8_WAIT_V(8); PG8_WAIT_L(0); PG8_BAR; PG8_MMA(1, 0, At, B0); PG8_MMA(1, 1, At, B1); PG8_BAR; PG8_SCHED; } while (0)

    Unit cur, nxt; int ui = 0;
    if (!S.next(0, cur)) return;
    unsigned curoff[2][2], nxtoff[2][2];
    size_t curA = 0, nxtA = 0;
    bool has_next = S.next(1, nxt);
#define PG8_NXT_SLOT ((LAS u32x4*)(lds + NXT_OFF) + tid)
    if constexpr (Sched::GATHER) {
        S.tab_issue(cur, ldsb, wid, lane); if (has_next) S.tab_issue(nxt, ldsb, wid, lane);
        asm volatile("s_waitcnt vmcnt(0)" ::: "memory"); __builtin_amdgcn_s_barrier(); asm volatile("" ::: "memory");
        S.a_off(cur, lds, R0, C0, (int)lda2, curoff);
        if (has_next) S.a_off(nxt, lds, R0, C0, (int)lda2, nxtoff);
        else {
#pragma unroll
            for (int h = 0; h < 2; ++h)
#pragma unroll
                for (int i = 0; i < 2; ++i) nxtoff[h][i] = curoff[h][i]; }
        ((LAS u32x4*)(lds + NXT_OFF))[tid] = (u32x4){curoff[0][0], curoff[0][1], curoff[1][0], curoff[1][1]};
        ((LAS u32x4*)(lds + NXT_OFF + 8192))[tid] = (u32x4){nxtoff[0][0], nxtoff[0][1], nxtoff[1][0], nxtoff[1][1]};
    } else { curA = (size_t)cur.arow * lda2 + cur.koff; nxtA = has_next ? (size_t)nxt.arow * lda2 + nxt.koff : curA; }
    f32x4 acc[2][2][4][2];
#pragma unroll
    for (int a = 0; a < 2; ++a)
#pragma unroll
        for (int b = 0; b < 2; ++b)
#pragma unroll
            for (int m = 0; m < 4; ++m)
#pragma unroll
                for (int n = 0; n < 2; ++n) acc[a][b][m][n] = (f32x4){0.f, 0.f, 0.f, 0.f};
    bf16x8 At[4][2], B0[2][2], B1[2][2];
    const char* cB = (const char*)g.Bt + (size_t)cur.brow * ldb2 + cur.koff;
    u32x2 go = {0u, 0u};
    PG8_STAGE_B(PG8_SB(0, 0), cB, 0u); PG8_STAGE_B(PG8_SB(0, 1), cB + hstepB, 0u); PG8_GOFF(0, 0); PG8_STAGE_A(PG8_SA(0, 0), 0, 0, 0u); PG8_GOFF(1, 0); PG8_STAGE_A(PG8_SA(0, 1), 1, 0, 0u);
    if (wr == 1) PG8_BAR;
    PG8_WAIT_V(2); PG8_BAR;
    PG8_GOFF(0, 0); PG8_STAGE_B(PG8_SB(1, 0), cB, kstep); PG8_STAGE_A(PG8_SA(1, 0), 0, 0, kstep); PG8_STAGE_B(PG8_SB(1, 1), cB + hstepB, kstep);
    PG8_WAIT_V(6); PG8_BAR;
    for (;;) {
        const char* nB = has_next ? (const char*)g.Bt + (size_t)nxt.brow * ldb2 + nxt.koff : cB;
        Unit u2; bool has2 = false;
        if constexpr (Sched::GATHER) has2 = has_next && S.next(ui + 2, u2);
#pragma unroll 1
        for (int t = 0; t < nt - 2; t += 2) {
            const unsigned k1 = (unsigned)(t + 1) * kstep, k2 = (unsigned)(t + 2) * kstep, k3 = (unsigned)(t + 3) * kstep;
            if constexpr (Sched::GATHER) { if (t == 2 && has2) S.tab_issue(u2, ldsb, wid, lane); }
            PG8_KITER(k1, cB, 0, k2, k3);
        }
        { const unsigned k1 = (unsigned)(nt - 1) * kstep; PG8_KITER(k1, nB, 1, 0u, kstep); }
#if PIN_ACC
#pragma unroll
        for (int a = 0; a < 2; ++a)
#pragma unroll
            for (int b = 0; b < 2; ++b)
#pragma unroll
                for (int m = 0; m < 4; ++m) asm volatile("" : "+v"(acc[a][b][m][0]), "+v"(acc[a][b][m][1]));
#endif
        if (wr == 0) PG8_BAR;
#ifdef PROBE_VARIANTS
        if (!(kvariant() & 4))
#endif
        { const int l2 = lane_id_asm(); E(acc, cur, wr, wc, l2 & 15, l2 >> 4); }
        if (!has_next) break;
#pragma unroll
        for (int a = 0; a < 2; ++a)
#pragma unroll
            for (int b = 0; b < 2; ++b)
#pragma unroll
                for (int m = 0; m < 4; ++m)
#pragma unroll
                    for (int n = 0; n < 2; ++n) acc[a][b][m][n] = (f32x4){0.f, 0.f, 0.f, 0.f};
        cur = nxt; cB = nB; ++ui; curA = nxtA;
        has_next = S.next(ui + 1, nxt);
        if (has_next) {
            if constexpr (Sched::GATHER) { const int tz = (wave0 << 6) | lane_id_asm(); int R0z, C0z;
                { const int lz = tz & 63; R0z = 8 * wid + (lz >> 3); C0z = 16 * ((lz & 7) ^ chunk_xor<F8>(R0z & 15)); }
                S.a_off(nxt, lds, R0z, C0z, (int)lda2, nxtoff);
                ((LAS u32x4*)(lds + NXT_OFF + (((ui + 1) & 1) << 13)))[tz] = (u32x4){nxtoff[0][0], nxtoff[0][1], nxtoff[1][0], nxtoff[1][1]}; }
            else nxtA = (size_t)nxt.arow * lda2 + nxt.koff;
        } else if constexpr (Sched::GATHER) { const int tz = (wave0 << 6) | lane_id_asm();
            ((LAS u32x4*)(lds + NXT_OFF + (((ui + 1) & 1) << 13)))[tz] = ((const LAS u32x4*)(lds + NXT_OFF + ((ui & 1) << 13)))[tz]; }
        if (wr == 1) PG8_BAR;
    }
    PG8_WAIT_V(0);
    PG8_BAR;
#undef PG8_SA
#undef PG8_SB
#undef PG8_STAGE_A
#undef PG8_GOFF
#undef PG8_STAGE_B
#undef PG8_LDA
#undef PG8_LDB
#undef PG8_MMA
#undef PG8_WAIT_V
#undef PG8_WAIT_L
#undef PG8_BAR
#undef PG8_SCHED
#undef PG8_KITER
#undef PG8_NXT_SLOT
}
}

struct Args { const float* in[32]; float* out; unsigned char* ws; int ph_lo, ph_hi, variant, pad; };
typedef const __attribute__((address_space(4))) unsigned char* kptr_t;
__device__ __forceinline__ const float* kin(int i) { kptr_t p = (kptr_t)__builtin_amdgcn_kernarg_segment_ptr(); asm volatile("" : "+s"(p)); return *(const float* const __attribute__((address_space(4)))*)(p + 8 * i); }
enum { I_X = 0, I_C, I_MODW, I_MODB, I_LNG, I_LNB, I_ABWIN, I_POOLW, I_POOLS, I_CONVW, I_CONVB, I_WA, I_BA, I_WX, I_BX, I_LAM, I_ABWOUT, I_ABBOUT,
       I_SGWIN, I_SGBIN, I_SGLNG, I_SGLNB, I_SGWS, I_SGBS, I_SGWOUT, I_SGBOUT, I_RW, I_RB, I_W1, I_B1, I_W2, I_B2 };

__device__ __forceinline__ int w1_rho(int n) { const int nn = n & 1, j = n >> 1; return ((j >> 7) << 8) | (((j >> 2) & 1) << 7) | (((j >> 5) & 3) << 5) | (nn << 4) | (((j >> 3) & 3) << 2) | (j & 3); }
__device__ __forceinline__ int w1_n_of_rho(int rho) { const int pn = rho >> 8, bj = (rho >> 7) & 1, wc = (rho >> 5) & 3, nn = (rho >> 4) & 1, fq = (rho >> 2) & 3, i = rho & 3; return 2 * (128 * pn + 32 * wc + 8 * fq + 4 * bj + i) + nn; }
template <bool W1MAP>
__device__ __forceinline__ void conv_item(const float* W, int N, bf16_t* WT, int item, int lane) {
    const int nblk = N >> 5, kb = item / nblk, nb = item - kb * nblk;
    const int kg = lane >> 3, nl = lane & 7, k0 = kb * 64 + kg * 8, n0 = nb * 32 + nl * 4;
    f32x4 v[8];
#pragma unroll
    for (int q = 0; q < 8; ++q) v[q] = *(const f32x4*)(W + (size_t)(k0 + q) * N + n0);
#pragma unroll
    for (int i = 0; i < 4; ++i) {
        const int n = n0 + i, row = W1MAP ? w1_rho(n) : n;
        u32x4 o; o.x = pk2(v[0][i], v[1][i]); o.y = pk2(v[2][i], v[3][i]); o.z = pk2(v[4][i], v[5][i]); o.w = pk2(v[6][i], v[7][i]);
        *(u32x4*)(WT + (size_t)row * 1024 + k0) = o;
    }
}

template <bool W1MAP>
__device__ __forceinline__ void conv_item_f8(const float* W, int N, unsigned char* WT8, int item, int lane, float scale) {
    const int nblk = N >> 5, kb = item / nblk, nb = item - kb * nblk;
    const int kg = lane >> 3, nl = lane & 7, k0 = kb * 128 + kg * 16, n0 = nb * 32 + nl * 4;
    f32x4 v[16];
#pragma unroll
    for (int q = 0; q < 16; ++q) v[q] = *(const f32x4*)(W + (size_t)(k0 + q) * N + n0) * scale;
#pragma unroll
    for (int i = 0; i < 4; ++i) {
        const int n = n0 + i, row = W1MAP ? w1_rho(n) : n;
        u32x4 o; o.x = pk4_fp8(v[0][i], v[1][i], v[2][i], v[3][i]); o.y = pk4_fp8(v[4][i], v[5][i], v[6][i], v[7][i]);
        o.z = pk4_fp8(v[8][i], v[9][i], v[10][i], v[11][i]); o.w = pk4_fp8(v[12][i], v[13][i], v[14][i], v[15][i]);
        *(u32x4*)(WT8 + (size_t)row * 1024 + k0) = o;
    }
}

#define IN(k) (lo <= (k) && (k) < hi)
#define SEAM(k) do { if ((k) + 1 < hi) xcd_barrier(bar); } while (0)
#define PH_LOCALS \
    const int tid = (wave0 << 6) | lane_id_asm(); \
    const int lane = tid & 63, wave = wave0; \
    int bx = blockIdx.x; asm volatile("" : "+s"(bx)); \
    const int vcu = (G % 8 == 0) ? (bx % 8) * (G / 8) + bx / 8 : bx; \
    const int gw = vcu * 8 + wave, NGW = G * 8; \
    unsigned char* ws; { kptr_t kp_ = (kptr_t)__builtin_amdgcn_kernarg_segment_ptr(); asm volatile("" : "+s"(kp_)); ws = *(unsigned char* const __attribute__((address_space(4)))*)(kp_ + 264); } \
    float* Xf; { kptr_t kp_ = (kptr_t)__builtin_amdgcn_kernarg_segment_ptr(); asm volatile("" : "+s"(kp_)); Xf = *(float* const __attribute__((address_space(4)))*)(kp_ + 256); } \
    unsigned* const ctl = (unsigned*)(ws + WS_CTL); \
    float* const MOD = (float*)(ws + WS_MOD); bf16_t* const Hb = (bf16_t*)(ws + WS_H); bf16_t* const Zb = (bf16_t*)(ws + WS_Z); bf16_t* const A2b = (bf16_t*)(ws + WS_A2); \
    bf16_t* const RIb = (bf16_t*)(ws + WS_RI); bf16_t* const YMb = (bf16_t*)(ws + WS_YMIX); bf16_t* const Yb = (bf16_t*)(ws + WS_Y); bf16_t* const ACTb = (bf16_t*)(ws + WS_ACT); \
    bf16_t* const YSb = (bf16_t*)(ws + WS_YS); float* const LOGf = (float*)(ws + WS_LOG); float* const TOPG = (float*)(ws + WS_TOPG); int* const LIST = (int*)(ws + WS_LIST); \
    float* const SUMM = (float*)(ws + WS_SUMM); \
    (void)lane; (void)wave; (void)gw; (void)NGW; (void)ctl; (void)MOD; (void)Hb; (void)Zb; (void)A2b; (void)RIb; (void)YMb; (void)Yb; (void)ACTb; (void)YSb; (void)LOGf; (void)TOPG; (void)LIST; (void)SUMM; (void)Xf; (void)vcu


template <int L, int PASS>
__device__ __forceinline__ void scan_phase(const int lo, const int hi, const int G, const XcdBarrier& bar, const int wave0) {
    constexpr int l = L, pass = PASS, P = PH_L0 + PH_PER_LAYER * L, jj = L >> 1; constexpr bool odd = (L & 1) != 0;
            if (PHEN(6) && !odd && IN(P + 3 + pass)) {
            PH_LOCALS;
                for (int it = gw; it < 16 * 32 * 4; it += NGW) {
                    const int b = it >> 7, n = (it >> 2) & 31, cg = it & 3;
                    const int ch = cg * 128 + 2 * lane;
                    float sp[2];
#pragma unroll
                    for (int q = 0; q < 2; ++q) { const float x = -kin(I_LAM)[jj * 512 + ch + q]; sp[q] = 8.0f * 1.4426950408889634f * (fmaxf(x, 0.f) + log1pf(__expf(-fabsf(x)))); }
                    float one = 1.0f; asm volatile("" : "+v"(one));
                    float h0 = 0.f, h1 = 0.f, p0 = one, p1 = one;
                    if (pass == 1) {
#pragma unroll 1
                        for (int m = 0; m < n; ++m) { const f32x4 s = *(const f32x4*)(SUMM + (((size_t)b * 32 + m) * 512 + ch) * 2); h0 = s[0] * h0 + s[1]; h1 = s[2] * h1 + s[3]; }
                    }
                    const size_t row0 = (size_t)b * SEQ + n * 128;
#pragma unroll 4
                    for (int t = 0; t < 128; ++t) {
                        const size_t r = row0 + t;
                        const unsigned rw = *(const unsigned*)(RIb + r * 1024 + ch), iw = *(const unsigned*)(RIb + r * 1024 + 512 + ch), xw = *(const unsigned*)(A2b + r * 1024 + 512 + ch);
                        const float a0 = __builtin_amdgcn_exp2f(-bflo(rw) * sp[0]), a1 = __builtin_amdgcn_exp2f(-bfhi(rw) * sp[1]);
                        const float m0 = __builtin_amdgcn_sqrtf(fmaxf(__builtin_fmaf(-a0, a0, 1.0f), 0.f)), m1 = __builtin_amdgcn_sqrtf(fmaxf(__builtin_fmaf(-a1, a1, 1.0f), 0.f));
                        h0 = a0 * h0 + m0 * (bflo(iw) * bflo(xw)); h1 = a1 * h1 + m1 * (bfhi(iw) * bfhi(xw));
                        if (pass == 0) { p0 *= a0; p1 *= a1; }
                        else { const unsigned gwd = *(const unsigned*)(Zb + r * DINAB + 1024 + ch);
                            if (FP8_OUTP) *(unsigned short*)((unsigned char*)YMb + r * 1024 + 512 + ch) = (unsigned short)pk4_fp8(h0 * gelu_tanh(bflo(gwd)), h1 * gelu_tanh(bfhi(gwd)), 0.f, 0.f);
                            else *(unsigned*)(YMb + r * 1024 + 512 + ch) = pk2(h0 * gelu_tanh(bflo(gwd)), h1 * gelu_tanh(bfhi(gwd))); }
                    }
                    if (pass == 0) *(f32x4*)(SUMM + (((size_t)b * 32 + n) * 512 + ch) * 2) = (f32x4){p0, h0, p1, h1};
                }
                SEAM(P + 3 + pass);
            }
}

template <int L, int SUB>
__device__ __forceinline__ void ln_phase(const int lo, const int hi, const int G, const XcdBarrier& bar, const int wave0) {
    constexpr int l = L, sub = SUB, P = PH_L0 + PH_PER_LAYER * L; constexpr int ph = SUB == 0 ? P + 6 : P + 11;
    constexpr bool XIN_F32 = (L == 0 && SUB == 0), XOUT_F32 = (L == DEPTH - 1 && SUB == 1);
    if (PHEN(8) && IN(ph)) {
        PH_LOCALS;
        const int rows_per = T / NGW, r0 = gw * rows_per, b = r0 / SEQ;
        constexpr int ls = 2 * l + sub, lsn = ls + 1;
        const float* gp = MOD + ((size_t)ls * 16 + b) * 3072 + 2048;
        const float* lgp = kin(I_LNG) + ls * 1024, * lbp = kin(I_LNB) + ls * 1024;
        constexpr bool has_nextmod = lsn < 2 * DEPTH;
        const float* nsh = MOD + ((size_t)(has_nextmod ? lsn : 0) * 16 + b) * 3072, * nsc = nsh + 1024;
        f32x4 gt[4], lg[4], lb[4], sh[4], sc[4];
#pragma unroll
        for (int j = 0; j < 4; ++j) { const int o = 4 * (64 * j + lane); gt[j] = *(const f32x4*)(gp + o) + 1.0f; lg[j] = *(const f32x4*)(lgp + o); lb[j] = *(const f32x4*)(lbp + o);
            sh[j] = *(const f32x4*)(nsh + o); sc[j] = *(const f32x4*)(nsc + o) + 1.0f; }
        const float* xin32 = kin(I_X);
        bf16_t* const Xb = (bf16_t*)(ws + WS_XB);
        constexpr int RPI = 2;
        for (int r = r0; r < r0 + rows_per; r += RPI) {
            f32x4 xf[XIN_F32 ? RPI : 1][4]; u32x2 xb[XIN_F32 ? 1 : RPI][4]; u32x2 yv[sub == 0 ? RPI : 1][4]; u32x2 ys[sub == 0 ? 1 : RPI][4][4]; f32x4 gk[RPI];
#pragma unroll
            for (int q = 0; q < RPI; ++q) {
                if constexpr (XIN_F32) { const f32x4* xr = (const f32x4*)(xin32 + (size_t)(r + q) * D) + lane;
#pragma unroll
                    for (int j = 0; j < 4; ++j) xf[q][j] = xr[64 * j]; }
                else { const u32x2* xr = (const u32x2*)(Xb + (size_t)(r + q) * D) + lane;
#pragma unroll
                    for (int j = 0; j < 4; ++j) xb[q][j] = xr[64 * j]; }
                if constexpr (sub == 0) { const u32x2* yr = (const u32x2*)(Yb + (size_t)(r + q) * D) + lane;
#pragma unroll
                    for (int j = 0; j < 4; ++j) yv[q][j] = yr[64 * j]; }
                else { gk[q] = *(const f32x4*)(TOPG + (size_t)(r + q) * 4);
#pragma unroll
                    for (int k = 0; k < 4; ++k) {
                        if (FP8_YS) { const unsigned* yr = (const unsigned*)((const unsigned char*)YSb + ((size_t)(r + q) * 4 + k) * D) + lane;
#pragma unroll
                            for (int j = 0; j < 4; ++j) ys[q][k][j].x = yr[64 * j]; }
                        else { const u32x2* yr = (const u32x2*)(YSb + ((size_t)(r + q) * 4 + k) * D) + lane;
#pragma unroll
                            for (int j = 0; j < 4; ++j) ys[q][k][j] = yr[64 * j]; } } }
            }
            f32x4 v[RPI][4]; float s[RPI];
#pragma unroll
            for (int q = 0; q < RPI; ++q) {
                s[q] = 0.f;
#pragma unroll
                for (int j = 0; j < 4; ++j) {
                    f32x4 y, x;
                    if constexpr (XIN_F32) x = xf[q][j]; else x = (f32x4){bflo(xb[q][j].x), bfhi(xb[q][j].x), bflo(xb[q][j].y), bfhi(xb[q][j].y)};
                    if constexpr (sub == 0) y = (f32x4){bflo(yv[q][j].x), bfhi(yv[q][j].x), bflo(yv[q][j].y), bfhi(yv[q][j].y)};
                    else { y = (f32x4){0.f, 0.f, 0.f, 0.f};
#pragma unroll
                        for (int k = 0; k < 4; ++k) { const u32x2 w = ys[q][k][j];
                            if (FP8_YS) { const f32x2 lo2 = __builtin_amdgcn_cvt_pk_f32_fp8((int)w.x, false), hi2 = __builtin_amdgcn_cvt_pk_f32_fp8((int)w.x, true);
                                y = y + (f32x4){lo2.x, lo2.y, hi2.x, hi2.y} * (gk[q][k] * 0.0625f); }
                            else y = y + (f32x4){bflo(w.x), bfhi(w.x), bflo(w.y), bfhi(w.y)} * gk[q][k]; } }
                    v[q][j] = x * DN_ALPHA + gt[j] * y;
                    s[q] += (v[q][j][0] + v[q][j][1]) + (v[q][j][2] + v[q][j][3]);
                }
            }
#pragma unroll
            for (int o = 1; o < 64; o <<= 1) {
#pragma unroll
                for (int q = 0; q < RPI; ++q) s[q] += __builtin_bit_cast(float, __builtin_amdgcn_ds_bpermute((lane ^ o) << 2, __builtin_bit_cast(int, s[q])));
            }
            float s2[RPI];
#pragma unroll
            for (int q = 0; q < RPI; ++q) { const float mean = s[q] * (1.0f / D); s2[q] = 0.f;
#pragma unroll
                for (int j = 0; j < 4; ++j) { v[q][j] = v[q][j] - mean; s2[q] += (v[q][j][0] * v[q][j][0] + v[q][j][1] * v[q][j][1]) + (v[q][j][2] * v[q][j][2] + v[q][j][3] * v[q][j][3]); } }
#pragma unroll
            for (int o = 1; o < 64; o <<= 1) {
#pragma unroll
                for (int q = 0; q < RPI; ++q) s2[q] += __builtin_bit_cast(float, __builtin_amdgcn_ds_bpermute((lane ^ o) << 2, __builtin_bit_cast(int, s2[q])));
            }
#pragma unroll
            for (int q = 0; q < RPI; ++q) {
                const float rstd = 1.0f / sqrtf(s2[q] * (1.0f / D) + LN_EPS);
                u32x2* hr = (u32x2*)(Hb + (size_t)(r + q) * D) + lane;
#pragma unroll
                for (int j = 0; j < 4; ++j) { const f32x4 xn = v[q][j] * rstd * lg[j] + lb[j];
                    if (XOUT_F32) ((f32x4*)(Xf + (size_t)(r + q) * D) + lane)[64 * j] = xn;
                    else { u32x2 w; w.x = pk2(xn[0], xn[1]); w.y = pk2(xn[2], xn[3]); ((u32x2*)(Xb + (size_t)(r + q) * D) + lane)[64 * j] = w; }
                    if (has_nextmod) { const f32x4 h = xn * sc[j] + sh[j];
                        if (!(FP8_INP && sub == 1) && !(ROUTER_X && sub == 0)) { u32x2 w; w.x = pk2(h[0], h[1]); w.y = pk2(h[2], h[3]); hr[64 * j] = w; }
                        if ((FP8_M1 && sub == 0) || (FP8_INP && sub == 1)) ((unsigned*)(ws + WS_H8 + (size_t)(r + q) * D) + lane)[64 * j] = pk4_fp8(h[0], h[1], h[2], h[3]); } }
            }
        }
        if (ph + 1 < NPH) SEAM(ph);
    }
}

template <int L>
__device__ __forceinline__ void layer_body(LAS unsigned char* const lds, volatile LAS unsigned* const LCTL, const int lo, const int hi, const int G, const XcdBarrier& bar, const int wave0) {
    constexpr int l = L;
        const int P = PH_L0 + PH_PER_LAYER * l, jj = l >> 1;
        const bool odd = (l & 1) != 0;
        if (PHEN(2) && IN(P + 0)) {
            PH_LOCALS;
            if (!odd) {
                pg8::DenseSched S; S.init(T, 1536, G, bx);
                if (FP8_INP) { pg8::Gemm g{ws + WS_H8, ws + WS_ABIN + (size_t)jj * 1536 * 1024, 1024, 1024, 1024, 122};
                    pg8::EpiDense<0, false, false, true> E{Zb, 1536, nullptr, nullptr, 1.0f / 32.0f};
                    pg8::gemm_phase<true>(lds, g, S, E, wave0); }
                else { pg8::Gemm g{Hb, (const bf16_t*)(ws + WS_ABIN) + (size_t)jj * 1536 * 1024, 1024, 1024, 1024, 127};
                    pg8::EpiDense<0, false, false> E{Zb, 1536, nullptr, nullptr, 0.f};
                    pg8::gemm_phase<false>(lds, g, S, E, wave0); }
            } else {
                pg8::DenseSched S; S.init(T, 2048, G, bx);
                if (FP8_INP) { pg8::Gemm g{ws + WS_H8, ws + WS_SGIN + (size_t)jj * 2048 * 1024, 1024, 1024, 1024, 122};
                    pg8::EpiDense<1, true, false, true> E{Zb, 2048, kin(I_SGBIN) + jj * 2048, nullptr, 1.0f / 32.0f};
                    pg8::gemm_phase<true>(lds, g, S, E, wave0); }
                else { pg8::Gemm g{Hb, (const bf16_t*)(ws + WS_SGIN) + (size_t)jj * 2048 * 1024, 1024, 1024, 1024, 127};
                    pg8::EpiDense<1, true, false> E{Zb, 2048, kin(I_SGBIN) + jj * 2048, nullptr, 0.f};
                    pg8::gemm_phase<false>(lds, g, S, E, wave0); }
            }
            SEAM(P + 0);
        }
        if (PHEN(3) && !odd && IN(P + 1)) {
            PH_LOCALS;
            const int rows_per = T / NGW, r0 = gw * rows_per;
            const int g4 = lane >> 4, w = 2 << g4;
            float cw[4][8], cb[8];
#pragma unroll
            for (int k = 0; k < 4; ++k)
#pragma unroll
                for (int q = 0; q < 8; ++q) cw[k][q] = kin(I_CONVW)[((size_t)jj * 4 + k) * 512 + 8 * lane + q];
#pragma unroll
            for (int q = 0; q < 8; ++q) cb[q] = kin(I_CONVB)[jj * 512 + 8 * lane + q];
            const int ts0 = r0 & (SEQ - 1);
            u32x4 ring[16], cr[3];
            float sw[8];
#pragma unroll
            for (int q = 0; q < 8; ++q) sw[q] = 0.f;
#pragma unroll
            for (int d = 0; d < 16; ++d) {
                const int k = 15 - d;
                u32x4 v = {0u, 0u, 0u, 0u};
                if (ts0 > d) v = *(const u32x4*)(Zb + (size_t)(r0 - 1 - d) * DINAB + 8 * lane);
                ring[k] = v;
                if (d + 1 < w) { const float f[8] = {bflo(v.x), bfhi(v.x), bflo(v.y), bfhi(v.y), bflo(v.z), bfhi(v.z), bflo(v.w), bfhi(v.w)};
#pragma unroll
                    for (int q = 0; q < 8; ++q) sw[q] += f[q]; }
            }
#pragma unroll
            for (int d = 0; d < 3; ++d) { u32x4 v = {0u, 0u, 0u, 0u}; if (ts0 > d) v = *(const u32x4*)(Zb + (size_t)(r0 - 1 - d) * DINAB + 512 + 8 * lane); cr[2 - d] = v; }
#pragma unroll 1
            for (int rb = 0; rb < rows_per; rb += 16) {
#pragma unroll
                for (int i = 0; i < 16; ++i) {
                    const int r = r0 + rb + i, ts = r & (SEQ - 1);
                    const u32x4 vn = *(const u32x4*)(Zb + (size_t)r * DINAB + 8 * lane), cn = *(const u32x4*)(Zb + (size_t)r * DINAB + 512 + 8 * lane);
                    const u32x4 c2 = ring[(i + 15) & 15], c4 = ring[(i + 13) & 15], c8 = ring[(i + 9) & 15], c16 = ring[(i + 1) & 15];
                    u32x4 vo;
                    vo.x = g4 == 0 ? c2.x : g4 == 1 ? c4.x : g4 == 2 ? c8.x : c16.x; vo.y = g4 == 0 ? c2.y : g4 == 1 ? c4.y : g4 == 2 ? c8.y : c16.y;
                    vo.z = g4 == 0 ? c2.z : g4 == 1 ? c4.z : g4 == 2 ? c8.z : c16.z; vo.w = g4 == 0 ? c2.w : g4 == 1 ? c4.w : g4 == 2 ? c8.w : c16.w;
                    ring[i] = vn;
                    const float fn[8] = {bflo(vn.x), bfhi(vn.x), bflo(vn.y), bfhi(vn.y), bflo(vn.z), bfhi(vn.z), bflo(vn.w), bfhi(vn.w)};
                    const float fo[8] = {bflo(vo.x), bfhi(vo.x), bflo(vo.y), bfhi(vo.y), bflo(vo.z), bfhi(vo.z), bflo(vo.w), bfhi(vo.w)};
                    const int cntw = (ts + 1) < w ? (ts + 1) : w;
                    const float inv = __builtin_amdgcn_rcpf((float)cntw);
                    float pz[8];
#pragma unroll
                    for (int q = 0; q < 8; ++q) { sw[q] += fn[q]; pz[q] = sw[q] * inv - fn[q]; sw[q] -= fo[q]; }
                    u32x4 o; o.x = pk2(pz[0], pz[1]); o.y = pk2(pz[2], pz[3]); o.z = pk2(pz[4], pz[5]); o.w = pk2(pz[6], pz[7]);
                    *(u32x4*)(A2b + (size_t)r * 1024 + 8 * lane) = o;
                    float xc[8];
                    const u32x4 t0 = cr[0], t1 = cr[1], t2 = cr[2];
                    const float f0[8] = {bflo(t0.x), bfhi(t0.x), bflo(t0.y), bfhi(t0.y), bflo(t0.z), bfhi(t0.z), bflo(t0.w), bfhi(t0.w)};
                    const float f1[8] = {bflo(t1.x), bfhi(t1.x), bflo(t1.y), bfhi(t1.y), bflo(t1.z), bfhi(t1.z), bflo(t1.w), bfhi(t1.w)};
                    const float f2[8] = {bflo(t2.x), bfhi(t2.x), bflo(t2.y), bfhi(t2.y), bflo(t2.z), bfhi(t2.z), bflo(t2.w), bfhi(t2.w)};
                    const float f3[8] = {bflo(cn.x), bfhi(cn.x), bflo(cn.y), bfhi(cn.y), bflo(cn.z), bfhi(cn.z), bflo(cn.w), bfhi(cn.w)};
#pragma unroll
                    for (int q = 0; q < 8; ++q) xc[q] = cb[q] + f0[q] * cw[0][q] + f1[q] * cw[1][q] + f2[q] * cw[2][q] + f3[q] * cw[3][q];
                    cr[0] = t1; cr[1] = t2; cr[2] = cn;
                    u32x4 o2; o2.x = pk2(xc[0], xc[1]); o2.y = pk2(xc[2], xc[3]); o2.z = pk2(xc[4], xc[5]); o2.w = pk2(xc[6], xc[7]);
                    *(u32x4*)(A2b + (size_t)r * 1024 + 512 + 8 * lane) = o2;
                }
            }
            SEAM(P + 1);
        }
        if (PHEN(4) && odd && IN(P + 1)) {
            PH_LOCALS;
            LAS float* STAT = (LAS float*)lds;
            LAS unsigned char* WSS = lds + 1024;
            LAS unsigned char* VT = lds + 1024 + 34816;
            const float* lng = kin(I_SGLNG) + jj * 1024, * lnb = kin(I_SGLNB) + jj * 1024;
            const bf16_t* WSMp = (const bf16_t*)(ws + WS_WSM) + (size_t)jj * 8 * 128 * 128;
            const float* bs = kin(I_SGBS) + jj * 8 * 128;
            const int fr = lane & 15, fq = lane >> 4;
            for (int it = vcu; it < T / 128; it += G) {
                const size_t row0 = (size_t)it * 128;
#pragma unroll 1
                for (int rb = 0; rb < 2; ++rb) {
                    u32x4 a8[8], b8[8];
#pragma unroll
                    for (int q = 0; q < 8; ++q) { const bf16_t* vp = Zb + (row0 + wave * 16 + rb * 8 + q) * 2048 + 1024; a8[q] = *(const u32x4*)(vp + 8 * lane); b8[q] = *(const u32x4*)(vp + 512 + 8 * lane); }
                    float sm[8], sq[8];
#pragma unroll
                    for (int q = 0; q < 8; ++q) {
                        const float f[16] = {bflo(a8[q].x), bfhi(a8[q].x), bflo(a8[q].y), bfhi(a8[q].y), bflo(a8[q].z), bfhi(a8[q].z), bflo(a8[q].w), bfhi(a8[q].w),
                                             bflo(b8[q].x), bfhi(b8[q].x), bflo(b8[q].y), bfhi(b8[q].y), bflo(b8[q].z), bfhi(b8[q].z), bflo(b8[q].w), bfhi(b8[q].w)};
                        float s1 = 0.f, s2 = 0.f;
#pragma unroll
                        for (int e = 0; e < 16; ++e) { s1 += f[e]; s2 += f[e] * f[e]; }
                        sm[q] = s1; sq[q] = s2;
                    }
#pragma unroll
                    for (int o = 1; o < 64; o <<= 1) {
#pragma unroll
                        for (int q = 0; q < 8; ++q) { sm[q] += __builtin_bit_cast(float, __builtin_amdgcn_ds_bpermute((lane ^ o) << 2, __builtin_bit_cast(int, sm[q])));
                            sq[q] += __builtin_bit_cast(float, __builtin_amdgcn_ds_bpermute((lane ^ o) << 2, __builtin_bit_cast(int, sq[q]))); }
                    }
                    if (lane < 8) { float m_ = sm[0], q_ = sq[0];
#pragma unroll
                        for (int q = 1; q < 8; ++q) { m_ = lane == q ? sm[q] : m_; q_ = lane == q ? sq[q] : q_; }
                        const float mean = m_ * (1.0f / 1024.0f), var = fmaxf(q_ * (1.0f / 1024.0f) - mean * mean, 0.f);
                        const int r = wave * 16 + rb * 8 + lane; STAT[2 * r] = mean; STAT[2 * r + 1] = 1.0f / sqrtf(var + LN_EPS); }
                }
                __syncthreads();
                u32x4 wv[4], vv[4];
#pragma unroll
                for (int i = 0; i < 4; ++i) { const int q = tid + 512 * i, row = q >> 4, c16 = q & 15;
                    wv[i] = *(const u32x4*)(WSMp + ((size_t)0 * 128 + row) * 128 + c16 * 8);
                    vv[i] = *(const u32x4*)(Zb + (row0 + row) * 2048 + 1024 + 0 * 128 + c16 * 8); }
#pragma unroll 1
                for (int hd = 0; hd < 8; ++hd) {
#pragma unroll
                    for (int i = 0; i < 4; ++i) {
                        const int q = tid + 512 * i, row = q >> 4, c16 = q & 15;
                        *(LAS u32x4*)(WSS + row * 272 + c16 * 16) = wv[i];
                        const u32x4 v4 = vv[i];
                        const float mean = STAT[2 * row], rstd = STAT[2 * row + 1];
                        const float f[8] = {bflo(v4.x), bfhi(v4.x), bflo(v4.y), bfhi(v4.y), bflo(v4.z), bfhi(v4.z), bflo(v4.w), bfhi(v4.w)};
                        const f32x4 g0 = *(const f32x4*)(lng + hd * 128 + c16 * 8), g1 = *(const f32x4*)(lng + hd * 128 + c16 * 8 + 4);
                        const f32x4 b0 = *(const f32x4*)(lnb + hd * 128 + c16 * 8), b1 = *(const f32x4*)(lnb + hd * 128 + c16 * 8 + 4);
                        const float gg[8] = {g0[0], g0[1], g0[2], g0[3], g1[0], g1[1], g1[2], g1[3]}, bb[8] = {b0[0], b0[1], b0[2], b0[3], b1[0], b1[1], b1[2], b1[3]};
#pragma unroll
                        for (int q2 = 0; q2 < 8; ++q2) {
                            const int c = c16 * 8 + q2;
                            const int rho = (c & ~31) | (((c >> 2) & 1) << 4) | (((c >> 3) & 3) << 2) | (c & 3);
                            *(LAS bf16_t*)(VT + rho * 272 + row * 2) = (bf16_t)f2bf((f[q2] - mean) * rstd * gg[q2] + bb[q2]);
                        }
                    }
                    const int hn = hd < 7 ? hd + 1 : 7;
#pragma unroll
                    for (int i = 0; i < 4; ++i) { const int q = tid + 512 * i, row = q >> 4, c16 = q & 15;
                        wv[i] = *(const u32x4*)(WSMp + ((size_t)hn * 128 + row) * 128 + c16 * 8);
                        vv[i] = *(const u32x4*)(Zb + (row0 + row) * 2048 + 1024 + hn * 128 + c16 * 8); }
                    const int t = 16 * wave + fr; const float bst = bs[hd * 128 + t];
                    const size_t rowg = row0 + t;
                    u32x4 uv[4];
#pragma unroll
                    for (int q = 0; q < 4; ++q) uv[q] = *(const u32x4*)(Zb + rowg * 2048 + hd * 128 + 32 * q + 8 * fq);
                    __syncthreads();
                    bf16x8 afr[4];
#pragma unroll
                    for (int ks = 0; ks < 4; ++ks) afr[ks] = *(const LAS bf16x8*)(WSS + (16 * wave + fr) * 272 + (32 * ks + 8 * fq) * 2);
                    f32x4 acc[8];
#pragma unroll
                    for (int tn = 0; tn < 8; ++tn) { acc[tn] = (f32x4){0.f, 0.f, 0.f, 0.f};
#pragma unroll
                        for (int ks = 0; ks < 4; ++ks) { const bf16x8 vfr = *(const LAS bf16x8*)(VT + (16 * tn + fr) * 272 + (32 * ks + 8 * fq) * 2);
                            acc[tn] = __builtin_amdgcn_mfma_f32_16x16x32_bf16(vfr, afr[ks], acc[tn], 0, 0, 0); } }
#pragma unroll
                    for (int q = 0; q < 4; ++q) {
                        const int c0 = hd * 128 + 32 * q + 8 * fq;
                        const u32x4 u4 = uv[q];
                        const f32x4 s0 = acc[2 * q] + bst, s1 = acc[2 * q + 1] + bst;
                        if (FP8_OUTP) { u32x2 o; o.x = pk4_fp8(bflo(u4.x) * s0[0], bfhi(u4.x) * s0[1], bflo(u4.y) * s0[2], bfhi(u4.y) * s0[3]);
                            o.y = pk4_fp8(bflo(u4.z) * s1[0], bfhi(u4.z) * s1[1], bflo(u4.w) * s1[2], bfhi(u4.w) * s1[3]);
                            *(u32x2*)((unsigned char*)YMb + rowg * 1024 + c0) = o; }
                        else { u32x4 o; o.x = pk2(bflo(u4.x) * s0[0], bfhi(u4.x) * s0[1]); o.y = pk2(bflo(u4.y) * s0[2], bfhi(u4.y) * s0[3]);
                        o.z = pk2(bflo(u4.z) * s1[0], bfhi(u4.z) * s1[1]); o.w = pk2(bflo(u4.w) * s1[2], bfhi(u4.w) * s1[3]);
                        *(u32x4*)(YMb + rowg * 1024 + c0) = o; }
                    }
                    __syncthreads();
                }
            }
            SEAM(P + 1);
        }
        if (PHEN(5) && !odd && IN(P + 2)) {
            PH_LOCALS;
            {
                pg8::Gemm g{A2b, (const bf16_t*)(ws + WS_BPOOL) + (size_t)jj * 512 * 512, 1024, 512, 256, 127};
                pg8::DenseSched S; S.init(T, 512, G, bx); S.kblk = 512;
                pg8::EpiDense<0, false, true, false, FP8_OUTP != 0> E{YMb, 1024, nullptr, kin(I_POOLS) + jj * 512, 0.f};
                pg8::gemm_phase<false>(lds, g, S, E, wave0);
            }
            {
                pg8::Gemm g{A2b + 512, (const bf16_t*)(ws + WS_BGATE) + (size_t)jj * 1024 * 512, 1024, 512, 256, 127};
                pg8::DenseSched S; S.init(T, 1024, G, bx); S.kblk = 512;
                pg8::EpiDense<2, true, false> E{RIb, 1024, (const float*)(ws + WS_BIASRI) + jj * 1024, nullptr, 0.f};
                pg8::gemm_phase<false>(lds, g, S, E, wave0);
            }
            SEAM(P + 2);
        }
        scan_phase<L, 0>(lo, hi, G, bar, wave0); scan_phase<L, 1>(lo, hi, G, bar, wave0);
        if (PHEN(7) && IN(P + 5)) {
            PH_LOCALS;
            const float* bo = odd ? kin(I_SGBOUT) + jj * 1024 : kin(I_ABBOUT) + jj * 1024;
            pg8::DenseSched S; S.init(T, 1024, G, bx);
            if (FP8_OUTP) { const unsigned char* wt = odd ? ws + WS_SGOUT + (size_t)jj * 1024 * 1024 : ws + WS_ABOUT + (size_t)jj * 1024 * 1024;
                pg8::Gemm g{YMb, wt, 1024, 1024, 1024, 121};
                pg8::EpiDense<0, true, false, true> E{Yb, 1024, bo, nullptr, 1.0f / 64.0f};
                pg8::gemm_phase<true>(lds, g, S, E, wave0); }
            else { const bf16_t* wt = odd ? (const bf16_t*)(ws + WS_SGOUT) + (size_t)jj * 1024 * 1024 : (const bf16_t*)(ws + WS_ABOUT) + (size_t)jj * 1024 * 1024;
                pg8::Gemm g{YMb, wt, 1024, 1024, 1024, 127};
                pg8::EpiDense<0, true, false> E{Yb, 1024, bo, nullptr, 0.f};
                pg8::gemm_phase<false>(lds, g, S, E, wave0); }
            SEAM(P + 5);
        }
        ln_phase<L, 0>(lo, hi, G, bar, wave0);
            if (PHEN(9) && IN(P + 7)) {
            PH_LOCALS;
                pg8::Gemm g{ROUTER_X ? (const bf16_t*)(ws + WS_XB) : Hb, ROUTER_X ? (const bf16_t*)(ws + WS_BRB) + (size_t)l * 16 * 64 * 1024 : (const bf16_t*)(ws + WS_BR) + (size_t)l * 256 * 1024, 1024, 1024, 1024, 127};
                pg8::DenseSched S; S.init(T, 256, G, bx); if (ROUTER_X) S.bb = 64;
                pg8::EpiRouter E{LOGf};
                pg8::gemm_phase<false>(lds, g, S, E, wave0);
                SEAM(P + 7);
            }
            if (PHEN(10) && IN(P + 8)) {
            PH_LOCALS;
                volatile LAS unsigned* hist = LCTL + 96; volatile LAS unsigned* basev = LCTL + 128;
                unsigned* gcnt = ctl + CW_CNT + 64 * l;
                for (int t0 = vcu * 512; t0 < T; t0 += G * 512) {
                    if (tid < 32) hist[tid] = 0u;
                    __syncthreads();
                    const int tok = t0 + tid;
                    float lv[32];
                    { const f32x4* lp = (const f32x4*)(LOGf + (size_t)tok * 64);
#pragma unroll
                      for (int q = 0; q < 8; ++q) { const f32x4 a = lp[q], b2 = lp[8 + q], rb = ROUTER_X ? *(const f32x4*)((const float*)(ws + WS_CB) + (l * 16 + (t0 >> 12)) * 32 + 4 * q) : *(const f32x4*)(kin(I_RB) + l * 32 + 4 * q);
                          lv[4 * q + 0] = a[0] + b2[0] + rb[0]; lv[4 * q + 1] = a[1] + b2[1] + rb[1]; lv[4 * q + 2] = a[2] + b2[2] + rb[2]; lv[4 * q + 3] = a[3] + b2[3] + rb[3]; } }
                    float v0 = -3.0e38f, v1 = -3.0e38f, v2 = -3.0e38f, v3 = -3.0e38f; int i0 = 0, i1 = 0, i2 = 0, i3 = 0;
#pragma unroll
                    for (int e = 0; e < 32; ++e) {
                        const float x = lv[e];
                        if (x > v3) {
                            if (x > v0) { v3 = v2; i3 = i2; v2 = v1; i2 = i1; v1 = v0; i1 = i0; v0 = x; i0 = e; }
                            else if (x > v1) { v3 = v2; i3 = i2; v2 = v1; i2 = i1; v1 = x; i1 = e; }
                            else if (x > v2) { v3 = v2; i3 = i2; v2 = x; i2 = e; }
                            else { v3 = x; i3 = e; }
                        }
                    }
                    const float e1 = __expf(v1 - v0), e2 = __expf(v2 - v0), e3 = __expf(v3 - v0), inv = 1.0f / (1.0f + e1 + e2 + e3);
                    *(f32x4*)(TOPG + (size_t)tok * 4) = (f32x4){inv, e1 * inv, e2 * inv, e3 * inv};
                    LAS unsigned* hp = (LAS unsigned*)hist;
                    const unsigned r0 = __hip_atomic_fetch_add(hp + i0, 1u, __ATOMIC_RELAXED, __HIP_MEMORY_SCOPE_WORKGROUP), r1 = __hip_atomic_fetch_add(hp + i1, 1u, __ATOMIC_RELAXED, __HIP_MEMORY_SCOPE_WORKGROUP),
                                   r2 = __hip_atomic_fetch_add(hp + i2, 1u, __ATOMIC_RELAXED, __HIP_MEMORY_SCOPE_WORKGROUP), r3 = __hip_atomic_fetch_add(hp + i3, 1u, __ATOMIC_RELAXED, __HIP_MEMORY_SCOPE_WORKGROUP);
                    __syncthreads();
                    if (tid < 32) basev[tid] = __hip_atomic_fetch_add(gcnt + tid, hist[tid], __ATOMIC_RELAXED, __HIP_MEMORY_SCOPE_AGENT);
                    __syncthreads();
                    LIST[(size_t)i0 * TKTOT + basev[i0] + r0] = tok * 4 + 0;
                    LIST[(size_t)i1 * TKTOT + basev[i1] + r1] = tok * 4 + 1;
                    LIST[(size_t)i2 * TKTOT + basev[i2] + r2] = tok * 4 + 2;
                    LIST[(size_t)i3 * TKTOT + basev[i3] + r3] = tok * 4 + 3;
                    __syncthreads();
                }
                SEAM(P + 8);
            }
            if (PHEN(11) && IN(P + 9)) {
                PH_LOCALS;
                volatile LAS int* cnts = (volatile LAS int*)(LCTL + 16); volatile LAS int* tstart = (volatile LAS int*)(LCTL + 48);
                if (tid < 32) cnts[tid] = (int)__hip_atomic_load(ctl + CW_CNT + 64 * l + tid, __ATOMIC_RELAXED, __HIP_MEMORY_SCOPE_AGENT);
                __syncthreads();
                if (tid == 0) { int s = 0; for (int e = 0; e < 32; ++e) { tstart[e] = s; s += (cnts[e] + 255) >> 8; } tstart[32] = s; }
                __syncthreads();
                LAS int* const utab = (LAS int*)(lds + UTAB_OFF);
                const int nunits = pg8::moe_build_units(utab, tstart, cnts, 8, G, bx, tid);
                __syncthreads();
                pg8::MoeSched S{(const LAS int*)utab, LIST, (const float*)(ws + WS_B1P) + (size_t)l * 32 * 2048, nunits, 2048, 2};
                pg8::EpiMoe1<FP8_M2 != 0> E{FP8_M2 ? (bf16_t*)(ws + WS_ACT8) : ACTb, lds, FP8_M1 ? 1.0f / 32.0f : 1.0f};
                if (FP8_M1) { pg8::Gemm g{ws + WS_H8, ws + WS_W1T8 + (size_t)l * 32 * 2048 * 1024, 1024, 1024, 1024, 122};
                    pg8::gemm_phase<true>(lds, g, S, E, wave0); }
                else { pg8::Gemm g{Hb, (const bf16_t*)(ws + WS_W1T) + (size_t)l * 32 * 2048 * 1024, 1024, 1024, 1024, 127};
                    pg8::gemm_phase<false>(lds, g, S, E, wave0); }
                SEAM(P + 9);
            }
            if (PHEN(12) && IN(P + 10)) {
                PH_LOCALS;
                volatile LAS int* cnts = (volatile LAS int*)(LCTL + 16); volatile LAS int* tstart = (volatile LAS int*)(LCTL + 48);
                __syncthreads();
                if (tid < 32) cnts[tid] = (int)__hip_atomic_load(ctl + CW_CNT + 64 * l + tid, __ATOMIC_RELAXED, __HIP_MEMORY_SCOPE_AGENT);
                __syncthreads();
                if (tid == 0) { int s = 0; for (int e = 0; e < 32; ++e) { tstart[e] = s; s += (cnts[e] + 255) >> 8; } tstart[32] = s; }
                __syncthreads();
                LAS int* const utab = (LAS int*)(lds + UTAB_OFF);
                const int nunits = pg8::moe_build_units(utab, tstart, cnts, 4, G, bx, tid);
                __syncthreads();
                pg8::MoeSched S{(const LAS int*)utab, LIST, kin(I_B2) + (size_t)l * 32 * 1024, nunits, 1024, 0};
                pg8::EpiMoe2 E{YSb, lds, FP8_M2 ? 1.0f / 64.0f : 1.0f};
                if (FP8_M2) { pg8::Gemm g{ws + WS_ACT8, ws + WS_W2T8 + (size_t)l * 32 * 1024 * 1024, 1024, 1024, 1024, 121};
                    pg8::gemm_phase<true>(lds, g, S, E, wave0); }
                else { pg8::Gemm g{ACTb, (const bf16_t*)(ws + WS_W2T) + (size_t)l * 32 * 1024 * 1024, 1024, 1024, 1024, 127};
                    pg8::gemm_phase<false>(lds, g, S, E, wave0); }
                SEAM(P + 10);
            }
        ln_phase<L, 1>(lo, hi, G, bar, wave0);
}

__global__ void __launch_bounds__(512, 2) fwd_kernel(Args args) {
    extern __shared__ __attribute__((aligned(16))) unsigned char lds_raw[];
    LAS unsigned char* const lds = (LAS unsigned char*)lds_raw;
    volatile LAS unsigned* const LCTL = (volatile LAS unsigned*)(lds + LDSCTL_OFF);
    const int G = gridDim.x;
    int lo, hi; unsigned* ctl0;
    { kptr_t kp = (kptr_t)__builtin_amdgcn_kernarg_segment_ptr(); lo = *(const __attribute__((address_space(4))) int*)(kp + 272); hi = *(const __attribute__((address_space(4))) int*)(kp + 276);
      ctl0 = (unsigned*)(*(unsigned char* const __attribute__((address_space(4)))*)(kp + 264) + WS_CTL); }
    const int wave0 = __builtin_amdgcn_readfirstlane((int)threadIdx.x >> 6);
    for (int u = threadIdx.x; u < (LDS_BYTES - LDSCTL_OFF) / 4; u += 512) LCTL[u] = 0u;
    __syncthreads();
    XcdBarrier bar; bar.bar = ctl0 + CW_BAR; bar.x = 0; bar.st = LCTL; bar.wv = wave0;
    if (hi - lo > 1) bar = xcd_barrier_post(ctl0 + CW_BAR, LCTL, wave0);
    if (PHEN(0) && IN(PH_CONV)) {
            PH_LOCALS;
        {
            LAS float* cact = (LAS float*)lds;
            LAS float* part = (LAS float*)(lds + 65536);
            if (bx < 384) {
                for (int i = tid; i < 16 * 1024; i += 512) { const float c = kin(I_C)[i]; cact[i] = c / (1.0f + __expf(-c)); }
                __syncthreads();
                for (int it = bx; it < 384; it += G) {
                    const int ls = it / 48, col0 = (it % 48) * 64;
                    const int kq = tid >> 6, cl = tid & 63;
                    const float* wp = kin(I_MODW) + (size_t)ls * 1024 * 3072 + col0 + cl;
                    float a[16];
#pragma unroll
                    for (int b = 0; b < 16; ++b) a[b] = 0.f;
#pragma unroll 4
                    for (int k = kq * 128; k < kq * 128 + 128; ++k) {
                        const float w = wp[(size_t)k * 3072];
#pragma unroll
                        for (int b = 0; b < 16; ++b) a[b] += cact[b * 1024 + k] * w;
                    }
#pragma unroll
                    for (int b = 0; b < 16; ++b) part[(kq * 16 + b) * 64 + cl] = a[b];
                    __syncthreads();
                    for (int o = tid; o < 1024; o += 512) {
                        const int b = o >> 6, c2 = o & 63; float s = 0.f;
#pragma unroll
                        for (int q = 0; q < 8; ++q) s += part[(q * 16 + b) * 64 + c2];
                        MOD[((size_t)ls * 16 + b) * 3072 + col0 + c2] = s + kin(I_MODB)[ls * 3072 + col0 + c2];
                    }
                    __syncthreads();
                }
            }
        }
        {
            constexpr int IT_ABIN = 2 * (FP8_INP ? 8 : 16) * 48, IT_ABOUT = 2 * (FP8_OUTP ? 8 : 16) * 32, IT_SGIN = 2 * (FP8_INP ? 8 : 16) * 64, IT_SGOUT = 2 * (FP8_OUTP ? 8 : 16) * 32, IT_W1 = 128 * (FP8_M1 ? 8 : 16) * 64, IT_W2 = 128 * (FP8_M2 ? 8 : 16) * 32;
            constexpr int IT_ALL = IT_ABIN + IT_ABOUT + IT_SGIN + IT_SGOUT + IT_W1 + IT_W2;
            for (int it = gw; it < IT_ALL; it += NGW) {
                int r = it;
                if (r < IT_ABIN) { if (FP8_INP) { const int mat = r / (8 * 48); conv_item_f8<false>(kin(I_ABWIN) + (size_t)mat * 1024 * 1536, 1536, ws + WS_ABIN + (size_t)mat * 1536 * 1024, r % (8 * 48), lane, 32.0f); }
                    else { const int mat = r / (16 * 48); conv_item<false>(kin(I_ABWIN) + (size_t)mat * 1024 * 1536, 1536, (bf16_t*)(ws + WS_ABIN) + (size_t)mat * 1536 * 1024, r % (16 * 48), lane); } continue; } r -= IT_ABIN;
                if (r < IT_ABOUT) { if (FP8_OUTP) { const int mat = r / (8 * 32); conv_item_f8<false>(kin(I_ABWOUT) + (size_t)mat * 1024 * 1024, 1024, ws + WS_ABOUT + (size_t)mat * 1024 * 1024, r % (8 * 32), lane, 64.0f); }
                    else { const int mat = r / (16 * 32); conv_item<false>(kin(I_ABWOUT) + (size_t)mat * 1024 * 1024, 1024, (bf16_t*)(ws + WS_ABOUT) + (size_t)mat * 1024 * 1024, r % (16 * 32), lane); } continue; } r -= IT_ABOUT;
                if (r < IT_SGIN) { if (FP8_INP) { const int mat = r / (8 * 64); conv_item_f8<false>(kin(I_SGWIN) + (size_t)mat * 1024 * 2048, 2048, ws + WS_SGIN + (size_t)mat * 2048 * 1024, r % (8 * 64), lane, 32.0f); }
                    else { const int mat = r / (16 * 64); conv_item<false>(kin(I_SGWIN) + (size_t)mat * 1024 * 2048, 2048, (bf16_t*)(ws + WS_SGIN) + (size_t)mat * 2048 * 1024, r % (16 * 64), lane); } continue; } r -= IT_SGIN;
                if (r < IT_SGOUT) { if (FP8_OUTP) { const int mat = r / (8 * 32); conv_item_f8<false>(kin(I_SGWOUT) + (size_t)mat * 1024 * 1024, 1024, ws + WS_SGOUT + (size_t)mat * 1024 * 1024, r % (8 * 32), lane, 64.0f); }
                    else { const int mat = r / (16 * 32); conv_item<false>(kin(I_SGWOUT) + (size_t)mat * 1024 * 1024, 1024, (bf16_t*)(ws + WS_SGOUT) + (size_t)mat * 1024 * 1024, r % (16 * 32), lane); } continue; } r -= IT_SGOUT;
                if (r < IT_W1) {
                    if (FP8_M1) { const int mat = r / (8 * 64); conv_item_f8<true>(kin(I_W1) + (size_t)mat * 1024 * 2048, 2048, ws + WS_W1T8 + (size_t)mat * 2048 * 1024, r % (8 * 64), lane, 32.0f); }
                    else { const int mat = r / (16 * 64); conv_item<true>(kin(I_W1) + (size_t)mat * 1024 * 2048, 2048, (bf16_t*)(ws + WS_W1T) + (size_t)mat * 2048 * 1024, r % (16 * 64), lane); }
                    continue; } r -= IT_W1;
                if (FP8_M2) { const int mat = r / (8 * 32); conv_item_f8<false>(kin(I_W2) + (size_t)mat * 1024 * 1024, 1024, ws + WS_W2T8 + (size_t)mat * 1024 * 1024, r % (8 * 32), lane, 64.0f); }
                else { const int mat = r / (16 * 32); conv_item<false>(kin(I_W2) + (size_t)mat * 1024 * 1024, 1024, (bf16_t*)(ws + WS_W2T) + (size_t)mat * 1024 * 1024, r % (16 * 32), lane); }
            }
        }
        {
            const int gt = vcu * 512 + tid, NGT = G * 512;
            bf16_t* BR = (bf16_t*)(ws + WS_BR);
            if (!ROUTER_X) for (int i = gt; i < 4 * 256 * 1024; i += NGT) {
                const int l = i >> 18, n = (i >> 10) & 255, k = i & 1023; unsigned v = 0;
                if (n < 64) { const float w = kin(I_RW)[((size_t)l * 1024 + k) * 32 + (n & 31)]; const unsigned h = f2bf(w); v = h;
                    if (n >= 32) v = f2bf(w - __builtin_bit_cast(float, h << 16)); }
                BR[i] = (bf16_t)v;
            }
            bf16_t* BP = (bf16_t*)(ws + WS_BPOOL);
            for (int i = gt; i < 2 * 512 * 512; i += NGT) {
                const int j = i >> 18, n = (i >> 9) & 511, k = i & 511; unsigned v = 0;
                if ((n >> 7) == (k >> 7)) v = f2bf(kin(I_POOLW)[(((size_t)j * 4 + (n >> 7)) * 128 + (k & 127)) * 128 + (n & 127)]);
                BP[i] = (bf16_t)v;
            }
            bf16_t* BG = (bf16_t*)(ws + WS_BGATE);
            for (int i = gt; i < 2 * 1024 * 512; i += NGT) {
                const int j = i >> 19, n = (i >> 9) & 1023, k = i & 511; unsigned v = 0; const int nn = n & 511;
                if ((nn >> 6) == (k >> 6)) { const float* w = (n < 512) ? kin(I_WA) : kin(I_WX); v = f2bf(w[(((size_t)j * 8 + (nn >> 6)) * 64 + (k & 63)) * 64 + (nn & 63)]); }
                BG[i] = (bf16_t)v;
            }
            bf16_t* WSMp = (bf16_t*)(ws + WS_WSM);
            for (int i = gt; i < 2 * 8 * 128 * 128; i += NGT) {
                const int t = (i >> 7) & 127, s = i & 127; WSMp[i] = (bf16_t)((s <= t) ? f2bf(kin(I_SGWS)[i]) : 0u);
            }
            float* BRI = (float*)(ws + WS_BIASRI);
            for (int i = gt; i < 2 * 1024; i += NGT) { const int j = i >> 10, n = i & 1023; BRI[i] = (n < 512) ? kin(I_BA)[j * 512 + n] : kin(I_BX)[j * 512 + n - 512]; }
            float* B1P = (float*)(ws + WS_B1P);
            for (int i = gt; i < 4 * 32 * 2048; i += NGT) { const int le = i >> 11, rho = i & 2047; B1P[i] = kin(I_B1)[(size_t)le * 2048 + w1_n_of_rho(rho)]; }
        }
        SEAM(PH_CONV);
    }

    if (PHEN(1) && IN(PH_H0)) {
            PH_LOCALS;
        const int rows_per = T / NGW, r0 = gw * rows_per;
        const int b = r0 / SEQ;
        const float* shp = MOD + ((size_t)0 * 16 + b) * 3072, * scp = shp + 1024;
        f32x4 sh[4], sc[4];
#pragma unroll
        for (int j = 0; j < 4; ++j) { sh[j] = *(const f32x4*)(shp + 4 * (64 * j + lane)); sc[j] = *(const f32x4*)(scp + 4 * (64 * j + lane)); }
        for (int r = r0; r < r0 + rows_per; ++r) {
            const f32x4* xr = (const f32x4*)(kin(I_X) + (size_t)r * D) + lane;
            u32x2* hr = (u32x2*)(Hb + (size_t)r * D) + lane;
#pragma unroll
            for (int j = 0; j < 4; ++j) { const f32x4 v = xr[64 * j]; const f32x4 h = v * (sc[j] + 1.0f) + sh[j];
                if (FP8_INP) ((unsigned*)(ws + WS_H8 + (size_t)r * D) + lane)[64 * j] = pk4_fp8(h[0], h[1], h[2], h[3]);
                else { u32x2 w; w.x = pk2(h[0], h[1]); w.y = pk2(h[2], h[3]); hr[64 * j] = w; } }
        }
        if (ROUTER_X) {
            bf16_t* BRB = (bf16_t*)(ws + WS_BRB);
            const float* rwp = kin(I_RW);
            for (int i = vcu * 512 + tid; i < 4 * 32 * 1024; i += G * 512) {
                const int l = i >> 15, e = (i >> 10) & 31, k = i & 1023;
                const float w = rwp[((size_t)l * 1024 + k) * 32 + e];
#pragma unroll 4
                for (int bq = 0; bq < 16; ++bq) {
                    const float wm = w * (1.0f + MOD[((size_t)(2 * l + 1) * 16 + bq) * 3072 + 1024 + k]);
                    const unsigned h = f2bf(wm), lo2 = f2bf(wm - __builtin_bit_cast(float, h << 16));
                    bf16_t* o = BRB + (((size_t)l * 16 + bq) * 64 + e) * 1024 + k; o[0] = (bf16_t)h; o[32 * 1024] = (bf16_t)lo2; }
            }
            for (int i = vcu * 512 + tid; i < 192 * 1024 / 2; i += G * 512) ((unsigned*)(BRB + (size_t)4 * 16 * 64 * 1024))[i] = 0u;
            const int it = vcu + G * wave;
            if (it < 512) {
                const int l = it >> 7, bq = (it >> 3) & 15, eq = it & 7;
                const float* shq = MOD + ((size_t)(2 * l + 1) * 16 + bq) * 3072;
                const f32x4* rw4 = (const f32x4*)(kin(I_RW) + (size_t)l * 1024 * 32) + eq;
                float sa[4] = {0.f, 0.f, 0.f, 0.f};
#pragma unroll
                for (int i2 = 0; i2 < 16; ++i2) { const int k = lane + 64 * i2; const f32x4 wv4 = rw4[(size_t)k * 8]; const float sk = shq[k]; sa[0] += wv4[0] * sk; sa[1] += wv4[1] * sk; sa[2] += wv4[2] * sk; sa[3] += wv4[3] * sk; }
#pragma unroll
                for (int o = 1; o < 64; o <<= 1) {
#pragma unroll
                    for (int c4 = 0; c4 < 4; ++c4) sa[c4] += __builtin_bit_cast(float, __builtin_amdgcn_ds_bpermute((lane ^ o) << 2, __builtin_bit_cast(int, sa[c4])));
                }
                const f32x4 rb4 = *(const f32x4*)(kin(I_RB) + l * 32 + 4 * eq);
                *(f32x4*)((float*)(ws + WS_CB) + (l * 16 + bq) * 32 + 4 * eq) = (f32x4){sa[0] + rb4[0], sa[1] + rb4[1], sa[2] + rb4[2], sa[3] + rb4[3]};
            }
        }
        SEAM(PH_H0);
    }

    layer_body<0>(lds, LCTL, lo, hi, G, bar, wave0); layer_body<1>(lds, LCTL, lo, hi, G, bar, wave0); layer_body<2>(lds, LCTL, lo, hi, G, bar, wave0); layer_body<3>(lds, LCTL, lo, hi, G, bar, wave0);
}
#undef IN
#undef SEAM

#ifdef DUMP_SPEC
struct DumpSrc { size_t off; int ld; int col0; };
__global__ void dump_kernel(const unsigned char* ws, float* out) {
    const DumpSrc srcs[8] = DUMP_SPEC;
    const size_t i = (size_t)blockIdx.x * blockDim.x + threadIdx.x;
    const int r = (int)(i >> 10), c = (int)(i & 1023), blk = c >> 7, cc = c & 127;
    const DumpSrc d = srcs[blk];
    const bf16_t* p = (const bf16_t*)(ws + d.off);
    out[i] = bf2f(p[(size_t)r * d.ld + d.col0 + cc]);
}
#endif
extern "C" void kernel_launch(void* const* d_in, const int* in_sizes, int n_in, void* d_out, int out_size, void* d_ws, size_t ws_size, hipStream_t stream) {
    static int grid = 0;
    if (grid == 0) {
        if (n_in != 32 || out_size != T * D || ws_size < WS_END) { fprintf(stderr, "kernel_launch: unexpected problem (n_in %d, out %d, ws %zu)\n", n_in, out_size, ws_size); grid = -1; return; }
        int dev = 0, cus = 0, per_cu = 0;
        if (hipGetDevice(&dev) != hipSuccess || hipDeviceGetAttribute(&cus, hipDeviceAttributeMultiprocessorCount, dev) != hipSuccess) { grid = -1; return; }
        if (hipFuncSetAttribute((const void*)fwd_kernel, hipFuncAttributeMaxDynamicSharedMemorySize, LDS_BYTES) != hipSuccess) { fprintf(stderr, "kernel_launch: hipFuncSetAttribute failed\n"); grid = -1; return; }
        if (hipOccupancyMaxActiveBlocksPerMultiprocessor(&per_cu, (const void*)fwd_kernel, 512, LDS_BYTES) != hipSuccess || per_cu < 1) fprintf(stderr, "kernel_launch: occupancy query says %d\n", per_cu);
        (void)hipGetLastError();
        grid = cus;
        if (grid * 8 > T || (T % (grid * 8)) != 0) { fprintf(stderr, "kernel_launch: grid %d does not divide the rows\n", grid); grid = -1; return; }
    }
    if (grid < 0) return;
    (void)hipMemsetAsync((char*)d_ws + WS_CTL, 0, CTL_ZERO_BYTES, stream);
    Args a{};
    for (int i = 0; i < 32; ++i) a.in[i] = (const float*)d_in[i];
    a.out = (float*)d_out; a.ws = (unsigned char*)d_ws;
#if MK_ONE_LAUNCH
    a.ph_lo = 0; a.ph_hi = NPH;
    hipLaunchKernelGGL(fwd_kernel, dim3(grid), dim3(512), LDS_BYTES, stream, a);
#else
#ifndef STOP_PH
#define STOP_PH NPH
#endif
    for (int ph = 0; ph < STOP_PH; ++ph) {
        if (!phase_exists(ph)) continue;
        a.ph_lo = ph; a.ph_hi = ph + 1;
        hipLaunchKernelGGL(fwd_kernel, dim3(grid), dim3(512), LDS_BYTES, stream, a);
#ifdef REP_SLOTS
        { const int slot = ph < PH_L0 ? ph : 2 + (ph - PH_L0) % PH_PER_LAYER; if ((REP_SLOTS >> slot) & 1) {
#ifdef PROBE_VARIANTS
            a.variant = PROBE_VARIANTS;
#endif
            hipLaunchKernelGGL(fwd_kernel, dim3(grid), dim3(512), LDS_BYTES, stream, a); a.variant = 0; } }
#endif
    }
#ifdef DUMP_SPEC
    hipLaunchKernelGGL(dump_kernel, dim3(T * 1024 / 256), dim3(256), 0, stream, (const unsigned char*)d_ws, (float*)d_out);
#endif
#endif
}
```

```cpp
#include <hip/hip_runtime.h>
#include <cstdio>
#include <cstdint>

#ifndef PIN_ACC
#define PIN_ACC 0
#endif
#ifndef FP8_M1
#define FP8_M1 1
#endif
#ifndef FP8_M2
#define FP8_M2 1
#endif
#ifndef FP8_YS
#define FP8_INP 0
#define FP8_OUTP 1
#define WIDE_EPI 1
#define FUSE_LOCAL 1
#define ROUTER_X 1
#define FP8_YS 1
#endif
#ifndef MK_ONE_LAUNCH
#define MK_ONE_LAUNCH 1
#endif

#ifndef PHMASK
#define PHMASK 0xFFFFF
#endif
#define PHEN(k) (((PHMASK) >> (k)) & 1)
#define LAS __attribute__((address_space(3)))
#define GAS __attribute__((address_space(1)))
typedef unsigned short bf16_t;
typedef short bf16x8 __attribute__((ext_vector_type(8)));
typedef float f32x4 __attribute__((ext_vector_type(4)));
typedef float f32x2 __attribute__((ext_vector_type(2)));
typedef unsigned u32x4 __attribute__((ext_vector_type(4)));
typedef unsigned u32x2 __attribute__((ext_vector_type(2)));

constexpr int D = 1024, NBATCH = 16, SEQ = 4096, T = NBATCH * SEQ, DEPTH = 4;
constexpr int NE = 32, TOPK = 4, TKTOT = T * TOPK;
constexpr int DPOOL = 512, DREC = 512, DINAB = 1536;
constexpr float LN_EPS = 1e-5f;
constexpr float DN_ALPHA = 1.6817928305074292f;

constexpr size_t MiB = 1ull << 20;
constexpr size_t WS_CTL = 0, CTL_ZERO_BYTES = 1 * MiB;
constexpr size_t WS_MOD = 1 * MiB;
constexpr size_t WS_BR = 3 * MiB;
constexpr size_t WS_BPOOL = 5 * MiB;
constexpr size_t WS_BGATE = 6 * MiB;
constexpr size_t WS_WSM = 8 * MiB;
constexpr size_t WS_BIASRI = 8 * MiB + 512 * 1024;
constexpr size_t WS_B1P = 9 * MiB;
constexpr size_t WS_SUMM = 10 * MiB;
constexpr size_t WS_TOPG = 12 * MiB;
constexpr size_t WS_ABIN = 16 * MiB;
constexpr size_t WS_ABOUT = 22 * MiB;
constexpr size_t WS_SGIN = 26 * MiB;
constexpr size_t WS_SGOUT = 34 * MiB;
constexpr size_t WS_LOG = 40 * MiB;
constexpr size_t WS_LIST = 64 * MiB;
constexpr size_t WS_BRB = 128 * MiB;
constexpr size_t WS_CB = 140 * MiB;
constexpr size_t WS_W1T = 128 * MiB;
constexpr size_t WS_W2T = 640 * MiB;
constexpr size_t WS_H = 896 * MiB;
constexpr size_t WS_Z = 1024 * MiB;
constexpr size_t WS_A2 = 1280 * MiB;
constexpr size_t WS_RI = 1408 * MiB;
constexpr size_t WS_YMIX = 1536 * MiB;
constexpr size_t WS_Y = 1664 * MiB;
constexpr size_t WS_ACT = 1792 * MiB;
constexpr size_t WS_YS = 2304 * MiB;
constexpr size_t WS_W1T8 = 2944 * MiB;
constexpr size_t WS_W2T8 = 3200 * MiB;
constexpr size_t WS_H8 = 3328 * MiB;
constexpr size_t WS_ACT8 = 3392 * MiB;
constexpr size_t WS_XB = 2816 * MiB;
constexpr size_t WS_END = 3648 * MiB;

constexpr int CW_BAR = 4096;
constexpr int CW_CNT = 16384;

constexpr int PH_CONV = 0, PH_H0 = 1, PH_L0 = 2, PH_PER_LAYER = 12, NPH = PH_L0 + PH_PER_LAYER * DEPTH;
__host__ __device__ constexpr bool phase_exists(int ph) {
    if (ph < PH_L0) return true;
    const int l = (ph - PH_L0) / PH_PER_LAYER, s = (ph - PH_L0) % PH_PER_LAYER;
    if ((l & 1) && (s == 2 || s == 3 || s == 4)) return false;
    return true;
}

constexpr int LDS_BYTES = 155648;
constexpr int LDSCTL_OFF = 154624;
constexpr int NXT_OFF = 131072;
constexpr int TAB_OFF = 147456;
constexpr int UTAB_OFF = 153600;

__device__ __forceinline__ unsigned f2bf(float f) { unsigned u = __builtin_bit_cast(unsigned, f); return (u + 0x7fffu + ((u >> 16) & 1u)) >> 16; }
typedef __bf16 bf16v2_t __attribute__((ext_vector_type(2)));
__device__ __forceinline__ unsigned pk2(float lo, float hi) { const f32x2 f = {lo, hi}; return __builtin_bit_cast(unsigned, __builtin_convertvector(f, bf16v2_t)); }
__device__ __forceinline__ float bflo(unsigned w) { return __builtin_bit_cast(float, w << 16); }
__device__ __forceinline__ float bfhi(unsigned w) { return __builtin_bit_cast(float, w & 0xffff0000u); }
__device__ __forceinline__ float bf2f(bf16_t h) { return __builtin_bit_cast(float, ((unsigned)h) << 16); }
__device__ __forceinline__ unsigned cvt_pk_bf16(float lo, float hi) { return pk2(lo, hi); }
__device__ __forceinline__ unsigned pk4_fp8(float a, float b, float c, float d) { int w = 0; w = __builtin_amdgcn_cvt_pk_fp8_f32(a, b, w, false); w = __builtin_amdgcn_cvt_pk_fp8_f32(c, d, w, true); return (unsigned)w; }
__device__ __forceinline__ float fast_sigmoid(float x) { return __builtin_amdgcn_rcpf(1.0f + __builtin_amdgcn_exp2f(-1.4426950408889634f * x)); }
__device__ __forceinline__ float gelu_tanh(float x) { const float u = x * (1.5957691216057308f + 0.07135481627362202f * x * x); return x * fast_sigmoid(u); }
__device__ __forceinline__ f32x2 pk_sigmoid_scaled(f32x2 x, float nk) {
    const f32x2 t = x * nk; f32x2 e; e.x = __builtin_amdgcn_exp2f(t.x); e.y = __builtin_amdgcn_exp2f(t.y);
    const f32x2 d = e + 1.0f; f32x2 r; r.x = __builtin_amdgcn_rcpf(d.x); r.y = __builtin_amdgcn_rcpf(d.y); return r; }
__device__ __forceinline__ f32x2 pk_gelu_tanh(f32x2 x) {
    const f32x2 t = x * ((x * x) * (-0.07135481627362202f * 1.4426950408889634f) + (-1.5957691216057308f * 1.4426950408889634f));
    f32x2 e; e.x = __builtin_amdgcn_exp2f(t.x); e.y = __builtin_amdgcn_exp2f(t.y);
    const f32x2 d = e + 1.0f; f32x2 r; r.x = __builtin_amdgcn_rcpf(d.x); r.y = __builtin_amdgcn_rcpf(d.y); return x * r; }
__device__ __forceinline__ float wave_sum(float v, int lane) {
#pragma unroll
    for (int o = 1; o < 64; o <<= 1) v += __builtin_bit_cast(float, __builtin_amdgcn_ds_bpermute((lane ^ o) << 2, __builtin_bit_cast(int, v)));
    return v;
}

__device__ __forceinline__ int lane_id_asm() { int l; asm volatile("v_mbcnt_lo_u32_b32 %0, -1, 0\n\tv_mbcnt_hi_u32_b32 %0, -1, %0" : "=v"(l)); return l; }
#define XB_TMO      128
#define XB_XCNT(j)  (256  + 64 * (j))
#define XB_XSUB(j)  (1280 + 64 * (j))
#define XB_XGEN(j)  (2304 + 64 * (j))
#define XB_TOP      3328
#define XB_TOPGEN   3392
#define XCD_BAR_WORDS 3456
#define XB_SPIN_CAP (1u << 18)

__device__ __forceinline__ unsigned xb_ld(unsigned* p)              { return __hip_atomic_load(p, __ATOMIC_RELAXED, __HIP_MEMORY_SCOPE_AGENT); }
__device__ __forceinline__ unsigned xb_add(unsigned* p, unsigned v) { return __hip_atomic_fetch_add(p, v, __ATOMIC_RELAXED, __HIP_MEMORY_SCOPE_AGENT); }
__device__ __forceinline__ unsigned xb_xcc_id() { return (unsigned)__builtin_amdgcn_s_getreg((3 << 11) | 20) & 0xFu; }
#define XB_SPIN(cond, bar) do { unsigned _sp = 0; while (cond) { __builtin_amdgcn_s_sleep(1); \
    if ((++_sp & 255u) == 0u) { if (xb_ld(&(bar)[XB_TMO])) break; if (_sp > XB_SPIN_CAP) { atomicAdd(&(bar)[XB_TMO], 1u); break; } } } } while (0)

struct XcdBarrier {
    unsigned* bar; unsigned x; int wv;
    volatile LAS unsigned* st;
};

__device__ __forceinline__ XcdBarrier xcd_barrier_post(unsigned* bar, volatile LAS unsigned* st, int wv) {
    XcdBarrier b; b.bar = bar; b.x = xb_xcc_id(); b.st = st; b.wv = wv;
    if (wv == 0 && lane_id_asm() == 0) (void)xb_add(&bar[XB_XCNT(b.x)], 1u);
    return b;
}
__device__ __forceinline__ void xcd_barrier_complete(unsigned* bar, unsigned x, unsigned& nloc, unsigned& nx) {
    const unsigned G = gridDim.x * gridDim.y * gridDim.z;
    unsigned sum, cnt, mine, sp = 0u;
    for (;;) {
        sum = 0u; cnt = 0u; mine = 0u;
#pragma unroll
        for (unsigned j = 0; j < 16; ++j) { const unsigned c = xb_ld(&bar[XB_XCNT(j)]); sum += c; cnt += (c > 0u) ? 1u : 0u; mine = (j == x) ? c : mine; }
        if (sum == G) break;
        __builtin_amdgcn_s_sleep(1);
        if ((++sp & 255u) == 0u) { if (xb_ld(&bar[XB_TMO])) break; if (sp > XB_SPIN_CAP) { atomicAdd(&bar[XB_TMO], 1u); break; } }
    }
    nloc = mine > 0u ? mine : 1u; nx = cnt > 0u ? cnt : 1u;
}

__device__ __forceinline__ void xcd_barrier(const XcdBarrier& b) {
    asm volatile("s_waitcnt vmcnt(0)" ::: "memory");
    __syncthreads();
    if (b.wv == 0 && lane_id_asm() == 0) {
        unsigned* bar = b.bar;
        __builtin_amdgcn_s_waitcnt(0);
        unsigned nloc = b.st[0], nx = b.st[1];
        if (nloc == 0u) { xcd_barrier_complete(bar, b.x, nloc, nx); b.st[0] = nloc; b.st[1] = nx; }
        const unsigned old = xb_add(&bar[XB_XSUB(b.x)], 1u);
        const unsigned gen = old / nloc;
        if (old + 1u == (gen + 1u) * nloc) {
            __builtin_amdgcn_fence(__ATOMIC_RELEASE, "agent");
            asm volatile("s_waitcnt vmcnt(0)" ::: "memory");
            const unsigned og = xb_add(&bar[XB_TOP], 1u);
            const unsigned tg = og / nx;
            if (og + 1u == (tg + 1u) * nx) xb_add(&bar[XB_TOPGEN], 1u);
            else XB_SPIN(xb_ld(&bar[XB_TOPGEN]) == tg, bar);
            __builtin_amdgcn_fence(__ATOMIC_ACQUIRE, "agent");
            xb_add(&bar[XB_XGEN(b.x)], 1u);
            asm volatile("s_waitcnt vmcnt(0)" ::: "memory");
        } else {
            XB_SPIN(xb_ld(&bar[XB_XGEN(b.x)]) == gen, bar);
            __builtin_amdgcn_fence(__ATOMIC_ACQUIRE, "agent");
            asm volatile("s_waitcnt vmcnt(0)" ::: "memory");
        }
    }
    __syncthreads();
}

#ifdef PROBE_VARIANTS
__device__ __forceinline__ int kvariant() { return *(const __attribute__((address_space(4))) int*)((const __attribute__((address_space(4))) unsigned char*)__builtin_amdgcn_kernarg_segment_ptr() + 280); }
#endif
__device__ __forceinline__ void glds16(const char* sbase, unsigned voff, unsigned lds_dst) {
    unsigned keep;
    asm volatile("s_mov_b32 %0, m0\n\ts_mov_b32 m0, %3\n\ts_nop 0\n\tglobal_load_lds_dwordx4 %1, %2\n\ts_mov_b32 m0, %0" : "=&s"(keep) : "v"(voff), "s"(sbase), "s"(lds_dst) : "memory");
}
__device__ __forceinline__ void glds4(const char* sbase, unsigned voff, unsigned lds_dst) {
    unsigned keep;
    asm volatile("s_mov_b32 %0, m0\n\ts_mov_b32 m0, %3\n\ts_nop 0\n\tglobal_load_lds_dword %1, %2\n\ts_mov_b32 m0, %0" : "=&s"(keep) : "v"(voff), "s"(sbase), "s"(lds_dst) : "memory");
}
namespace pg8 {
constexpr int BM = 256, BK = 64, HALF = 128, HTB = HALF * BK * 2, STAGE_BYTES = 8 * HTB, NXCD = 8, WGM = 8;
__host__ __device__ __forceinline__ int perm32(int rho) { const int n = rho >> 4, i = rho & 15; return 8 * (i >> 2) + 4 * n + (i & 3); }

template <bool F8> __host__ __device__ __forceinline__ int chunk_xor(int r15) { const int rp = (r15 >> 1) & 7; return F8 ? ((rp & 4) | ((rp & 1) << 1) | ((rp >> 1) & 1)) : rp; }
struct Unit { int arow, brow, pn, e, rt, cnt, slot, koff; };
struct Gemm { const void* A; const void* Bt; int lda, ldb, K, wscale; };
typedef int i32x4 __attribute__((ext_vector_type(4)));
typedef int i32x8 __attribute__((ext_vector_type(8)));
__device__ __forceinline__ i32x8 cat8(bf16x8 lo, bf16x8 hi) { return __builtin_shufflevector(__builtin_bit_cast(i32x4, lo), __builtin_bit_cast(i32x4, hi), 0, 1, 2, 3, 4, 5, 6, 7); }

struct DenseSched {
    static constexpr bool GATHER = false;
    int nM, nN, nwg, G, c, kblk = 0, bb = 0, rowm = 0;
    __device__ __forceinline__ void init(int M, int N, int G_, int c_) { nM = M / BM; nN = N / BM; nwg = nM * nN; G = G_; c = c_; }
    __device__ __forceinline__ bool next(int i, Unit& u) const {
        int pm, pn;
        if (rowm) { if (i >= nN) return false; pm = (c % NXCD) * (G / NXCD) + c / NXCD; pn = i; }
        else {
        const long L = (long)i * G + c; if (L >= nwg) return false;
        int wgid = (int)L; { const int q = nwg / NXCD, r = nwg % NXCD, xcd = wgid % NXCD, off = wgid / NXCD; wgid = (xcd < r ? xcd * (q + 1) : r * (q + 1) + (xcd - r) * q) + off; }
        const int nig = WGM * nN, gid = wgid / nig, fm = gid * WGM, gsz = (nM - fm) < WGM ? (nM - fm) : WGM;
        pm = fm + ((wgid % nig) % gsz); pn = (wgid % nig) / gsz; }
        u.arow = pm * BM; u.brow = pn * BM; u.pn = pn; u.e = 0; u.rt = pm; u.cnt = BM; u.slot = 0; u.koff = (pn & 1) * kblk; u.brow += ((pm * BM) >> 12) * bb; return true;
    }
    __device__ __forceinline__ void a_off(const Unit& u, LAS unsigned char*, int R0, int C0, int lda2, unsigned (&off)[2][2]) const {
#pragma unroll
        for (int h = 0; h < 2; ++h)
#pragma unroll
            for (int i = 0; i < 2; ++i) off[h][i] = (unsigned)((u.arow + 128 * h + 64 * i + R0) * lda2 + C0);
    }
};

struct MoeSched {
    static constexpr bool GATHER = true;
    const LAS int* utab;
    const int* list;
    const float* bias;
    int nunits, nexp_rows, shift;
    __device__ __forceinline__ bool next(int i, Unit& u) const {
        if (i >= nunits) return false;
        const LAS int* p = utab + 4 * i;
        u.e = __builtin_amdgcn_readfirstlane(p[0]); u.rt = __builtin_amdgcn_readfirstlane(p[1]); u.pn = __builtin_amdgcn_readfirstlane(p[2]); u.cnt = __builtin_amdgcn_readfirstlane(p[3]);
        u.arow = 0; u.brow = u.e * nexp_rows + u.pn * BM; u.slot = i % 3; u.koff = 0; return true;
    }
    __device__ __forceinline__ void tab_issue(const Unit& u, unsigned ldsb, int wid, int lane) const {
        if (wid < 4) { int p = u.rt * BM + 64 * wid + lane; p = p < u.cnt ? p : u.cnt - 1;
            glds4((const char*)(list + (size_t)u.e * TKTOT), (unsigned)p * 4u, ldsb + TAB_OFF + u.slot * 1024 + wid * 256); }
        else glds4((const char*)(bias + (size_t)u.e * nexp_rows + u.pn * BM), (unsigned)(64 * (wid - 4) + lane) * 4u, ldsb + TAB_OFF + 3072 + u.slot * 1024 + (wid - 4) * 256);
    }
    __device__ __forceinline__ void a_off(const Unit& u, LAS unsigned char* lds, int R0, int C0, int lda2, unsigned (&off)[2][2]) const {
        const LAS int* ids = (const LAS int*)(lds + TAB_OFF + u.slot * 1024);
#pragma unroll
        for (int h = 0; h < 2; ++h)
#pragma unroll
            for (int i = 0; i < 2; ++i) off[h][i] = (unsigned)((ids[128 * h + 64 * i + R0] >> shift) * lda2 + C0);
    }
};
__device__ __forceinline__ int moe_build_units(LAS int* utab, const volatile LAS int* tstart, const volatile LAS int* cnts, int NP, int G, int c, int tid) {
    const int total = tstart[NE] * NP;
    if (tid < 64) { const int L = tid * G + c;
        if (L < total) { int e = 0;
            for (int q = 0; q < NE - 1; ++q) if (tstart[q + 1] * NP <= L) e = q + 1;
            const int t0 = tstart[e], nte = tstart[e + 1] - t0, idx = L - t0 * NP;
            utab[4 * tid + 0] = e; utab[4 * tid + 1] = idx % nte; utab[4 * tid + 2] = idx / nte; utab[4 * tid + 3] = cnts[e]; } }
    return total > c ? (total - c + G - 1) / G : 0;
}

template <int ACT  , bool HAS_BIAS, bool HAS_SCALE, bool OSC = false, bool OUT8 = false> struct EpiDense {
    static constexpr int PERM = WIDE_EPI ? 2 : 1;
    bf16_t* O; int ldc; const float* bias; const float* scale; float oscale;
    __device__ __forceinline__ void operator()(const f32x4 (&acc)[2][2][4][2], const Unit& u, int wr, int wc, int fr, int fq) const {
        const int row0 = u.arow + wr * 64 + fr, col0 = PERM == 2 ? u.pn * BM + wc * 64 + 16 * fq : u.pn * BM + wc * 32 + 8 * fq;
        constexpr int BJS = PERM == 2 ? 8 : HALF;
        f32x4 bv[2][2], sv[2][2];
#pragma unroll
        for (int bj = 0; bj < 2; ++bj)
#pragma unroll
            for (int n = 0; n < 2; ++n) {
                if (HAS_BIAS) bv[bj][n] = *(const f32x4*)(bias + col0 + bj * BJS + 4 * n);
                if (HAS_SCALE) sv[bj][n] = *(const f32x4*)(scale + col0 + bj * BJS + 4 * n);
            }
#pragma unroll
        for (int ai = 0; ai < 2; ++ai)
#pragma unroll
            for (int m = 0; m < 4; ++m) { bf16_t* rowp = O + (size_t)(row0 + ai * HALF + m * 16) * ldc + col0; unsigned char* rowp8 = (unsigned char*)O + (size_t)(row0 + ai * HALF + m * 16) * ldc + col0;
                u32x4 w8;
#pragma unroll
                for (int bj = 0; bj < 2; ++bj) { f32x4 v0 = acc[ai][bj][m][0], v1 = acc[ai][bj][m][1];
                    if (OSC) { v0 = v0 * oscale; v1 = v1 * oscale; }
                    if (HAS_BIAS) { v0 = v0 + bv[bj][0]; v1 = v1 + bv[bj][1]; }
                    if (ACT == 1) { const f32x2 a = pk_gelu_tanh((f32x2){v0[0], v0[1]}), b = pk_gelu_tanh((f32x2){v0[2], v0[3]}), c = pk_gelu_tanh((f32x2){v1[0], v1[1]}), d = pk_gelu_tanh((f32x2){v1[2], v1[3]});
                        v0 = (f32x4){a.x, a.y, b.x, b.y}; v1 = (f32x4){c.x, c.y, d.x, d.y}; }
                    if (ACT == 2) { const float nk = -1.4426950408889634f;
                        const f32x2 a = pk_sigmoid_scaled((f32x2){v0[0], v0[1]}, nk), b = pk_sigmoid_scaled((f32x2){v0[2], v0[3]}, nk), c = pk_sigmoid_scaled((f32x2){v1[0], v1[1]}, nk), d = pk_sigmoid_scaled((f32x2){v1[2], v1[3]}, nk);
                        v0 = (f32x4){a.x, a.y, b.x, b.y}; v1 = (f32x4){c.x, c.y, d.x, d.y}; }
                    if (HAS_SCALE) { v0 = v0 * sv[bj][0]; v1 = v1 * sv[bj][1]; }
                    if constexpr (OUT8) { const unsigned p0 = pk4_fp8(v0[0], v0[1], v0[2], v0[3]), p1 = pk4_fp8(v1[0], v1[1], v1[2], v1[3]);
                        if constexpr (PERM == 2) { if (bj == 0) { w8.x = p0; w8.y = p1; } else { w8.z = p0; w8.w = p1; *(u32x4*)rowp8 = w8; } }
                        else { u32x2 w; w.x = p0; w.y = p1; *(u32x2*)(rowp8 + bj * HALF) = w; } }
                    else { u32x4 w; w.x = cvt_pk_bf16(v0[0], v0[1]); w.y = cvt_pk_bf16(v0[2], v0[3]); w.z = cvt_pk_bf16(v1[0], v1[1]); w.w = cvt_pk_bf16(v1[2], v1[3]);
                    *(u32x4*)(rowp + bj * BJS) = w; } } }
    }
};
struct EpiRouter {
    static constexpr int PERM = 0;
    float* LOG;
    __device__ __forceinline__ void operator()(const f32x4 (&acc)[2][2][4][2], const Unit& u, int wr, int wc, int fr, int fq) const {
        if (wc < 2) {
#pragma unroll
            for (int ai = 0; ai < 2; ++ai)
#pragma unroll
                for (int m = 0; m < 4; ++m) { float* rowp = LOG + (size_t)(u.arow + ai * HALF + wr * 64 + m * 16 + fr) * 64 + wc * 32 + 4 * fq;
#pragma unroll
                    for (int n = 0; n < 2; ++n) *(f32x4*)(rowp + 16 * n) = acc[ai][0][m][n]; }
        }
    }
};
template <bool OUT8> struct EpiMoe1 {
    static constexpr int PERM = 0;
    bf16_t* ACT; LAS unsigned char* lds; float oscale;
    __device__ __forceinline__ void operator()(const f32x4 (&acc)[2][2][4][2], const Unit& u, int wr, int wc, int fr, int fq) const {
        const LAS int* ids = (const LAS int*)(lds + TAB_OFF + u.slot * 1024);
        const LAS float* bp = (const LAS float*)(lds + TAB_OFF + 3072 + u.slot * 1024) + wc * 32 + 4 * fq;
        f32x4 bg[2], bl[2];
#pragma unroll
        for (int bj = 0; bj < 2; ++bj) { bg[bj] = *(const LAS f32x4*)(bp + bj * HALF); bl[bj] = *(const LAS f32x4*)(bp + bj * HALF + 16) + 1.0f; }
        const int j0 = u.pn * 128 + wc * 32 + 8 * fq;
#pragma unroll
        for (int ai = 0; ai < 2; ++ai)
#pragma unroll
            for (int m = 0; m < 4; ++m) {
                const int pl = ai * HALF + wr * 64 + m * 16 + fr;
                if (u.rt * BM + pl < u.cnt) {
                    const int flat = ids[pl];
                    float o[8];
#pragma unroll
                    for (int bj = 0; bj < 2; ++bj) { const f32x4 g = acc[ai][bj][m][0] * oscale + bg[bj], l = acc[ai][bj][m][1] * oscale + bl[bj];
#pragma unroll
                        for (int hh = 0; hh < 2; ++hh) {
                            const f32x2 xg = {fminf(g[2 * hh], 7.0f), fminf(g[2 * hh + 1], 7.0f)};
                            const f32x2 xl = {__builtin_amdgcn_fmed3f(l[2 * hh], -6.0f, 8.0f), __builtin_amdgcn_fmed3f(l[2 * hh + 1], -6.0f, 8.0f)};
                            const f32x2 r = pk_sigmoid_scaled(xg, -1.702f * 1.4426950408889634f), oo = (xg * xl) * r;
                            o[bj * 4 + 2 * hh] = oo.x; o[bj * 4 + 2 * hh + 1] = oo.y; } }
                    if constexpr (OUT8) { u32x2 w; w.x = pk4_fp8(o[0], o[1], o[2], o[3]); w.y = pk4_fp8(o[4], o[5], o[6], o[7]);
                        *(u32x2*)((unsigned char*)ACT + (size_t)flat * 1024 + j0) = w; }
                    else { u32x4 w; w.x = cvt_pk_bf16(o[0], o[1]); w.y = cvt_pk_bf16(o[2], o[3]); w.z = cvt_pk_bf16(o[4], o[5]); w.w = cvt_pk_bf16(o[6], o[7]);
                        *(u32x4*)(ACT + (size_t)flat * 1024 + j0) = w; }
                }
            }
    }
};
struct EpiMoe2 {
    static constexpr int PERM = (WIDE_EPI && FP8_YS) ? 2 : 1;
    bf16_t* YS; LAS unsigned char* lds; float oscale;
    __device__ __forceinline__ void operator()(const f32x4 (&acc)[2][2][4][2], const Unit& u, int wr, int wc, int fr, int fq) const {
        const LAS int* ids = (const LAS int*)(lds + TAB_OFF + u.slot * 1024);
        if constexpr (PERM == 2) {
            const LAS float* bp = (const LAS float*)(lds + TAB_OFF + 3072 + u.slot * 1024) + wc * 64 + 16 * fq;
            const int col0 = u.pn * BM + wc * 64 + 16 * fq;
            const float os = 16.0f * oscale;
#pragma unroll
            for (int ai = 0; ai < 2; ++ai) {
                const f32x4 b00 = *(const LAS f32x4*)(bp) * 16.0f, b01 = *(const LAS f32x4*)(bp + 4) * 16.0f, b10 = *(const LAS f32x4*)(bp + 8) * 16.0f, b11 = *(const LAS f32x4*)(bp + 12) * 16.0f;
#pragma unroll
                for (int m = 0; m < 4; ++m) {
                    const int pl = ai * HALF + wr * 64 + m * 16 + fr;
                    if (u.rt * BM + pl < u.cnt) {
                        const int flat = ids[pl];
                        const f32x4 v00 = acc[ai][0][m][0] * os + b00, v01 = acc[ai][0][m][1] * os + b01, v10 = acc[ai][1][m][0] * os + b10, v11 = acc[ai][1][m][1] * os + b11;
                        u32x4 w; w.x = pk4_fp8(v00[0], v00[1], v00[2], v00[3]); w.y = pk4_fp8(v01[0], v01[1], v01[2], v01[3]); w.z = pk4_fp8(v10[0], v10[1], v10[2], v10[3]); w.w = pk4_fp8(v11[0], v11[1], v11[2], v11[3]);
                        *(u32x4*)((unsigned char*)YS + (size_t)flat * 1024 + col0) = w;
                    }
                }
            }
        } else {
        const LAS float* bp = (const LAS float*)(lds + TAB_OFF + 3072 + u.slot * 1024) + wc * 32 + 8 * fq;
        const int col0 = u.pn * BM + wc * 32 + 8 * fq;
#pragma unroll
        for (int bj = 0; bj < 2; ++bj) {
            const float os = FP8_YS ? 16.0f * oscale : oscale;
            const f32x4 b0 = *(const LAS f32x4*)(bp + bj * HALF) * (FP8_YS ? 16.0f : 1.0f), b1 = *(const LAS f32x4*)(bp + bj * HALF + 4) * (FP8_YS ? 16.0f : 1.0f);
#pragma unroll
            for (int ai = 0; ai < 2; ++ai)
#pragma unroll
                for (int m = 0; m < 4; ++m) {
                    const int pl = ai * HALF + wr * 64 + m * 16 + fr;
                    if (u.rt * BM + pl < u.cnt) {
                        const int flat = ids[pl];
                        const f32x4 v0 = acc[ai][bj][m][0] * os + b0, v1 = acc[ai][bj][m][1] * os + b1;
                        if (FP8_YS) { u32x2 w; w.x = pk4_fp8(v0[0], v0[1], v0[2], v0[3]); w.y = pk4_fp8(v1[0], v1[1], v1[2], v1[3]);
                            *(u32x2*)((unsigned char*)YS + (size_t)flat * 1024 + col0 + bj * HALF) = w; }
                        else { u32x4 w; w.x = cvt_pk_bf16(v0[0], v0[1]); w.y = cvt_pk_bf16(v0[2], v0[3]); w.z = cvt_pk_bf16(v1[0], v1[1]); w.w = cvt_pk_bf16(v1[2], v1[3]);
                            *(u32x4*)(YS + (size_t)flat * 1024 + col0 + bj * HALF) = w; }
                    }
                }
        }
        }
    }
};

template <bool F8, class Epi, class Sched>
__device__ __forceinline__ void gemm_phase(LAS unsigned char* lds, const Gemm g, const Sched& S, const Epi& E, const int wave0) {
    const int tid = (wave0 << 6) | lane_id_asm();
    const int wid = __builtin_amdgcn_readfirstlane(tid >> 6), lane = tid & 63, wr = wid >> 2, wc = wid & 3, fr = lane & 15, fq = lane >> 4;
    constexpr unsigned ESZ = F8 ? 1u : 2u;
    const int nt = (int)((unsigned)g.K * ESZ / 128u);
    int R0, C0;
    R0 = 8 * wid + (lane >> 3); C0 = 16 * ((lane & 7) ^ chunk_xor<F8>(R0 & 15));
    const unsigned lda2 = (unsigned)g.lda * ESZ, ldb2 = (unsigned)g.ldb * ESZ;
    const unsigned voffB = (unsigned)((Epi::PERM == 2 ? (64 * (R0 >> 5) + 16 * ((R0 >> 2) & 3) + 4 * ((R0 >> 4) & 1) + (R0 & 3)) : Epi::PERM == 1 ? ((R0 & ~31) + perm32(R0 & 31)) : R0) * (int)ldb2 + C0);
    constexpr int PIECE_B = Epi::PERM == 2 ? 128 : 64;
    const unsigned aoffl = (unsigned)(R0 * (int)lda2 + C0);
    const unsigned kstep = 128;
    const size_t hstepB = (size_t)(Epi::PERM == 2 ? 8 : HALF) * ldb2;
    const unsigned ldsw = (unsigned)wid * 1024u;
    const int ab = fr * 128 + 16 * ((F8 ? 2 * fq : fq) ^ chunk_xor<F8>(fr));
    const int aoff0 = wr * 8192 + ab, boff0 = wc * 4096 + ab;
    constexpr int KX = F8 ? 16 : 64;
    const char* const Abase = (const char*)g.A;
    const unsigned ldsb = (unsigned)(size_t)lds;
#define PG8_SA(b, h) (((b) * 2 + (h)) * HTB)
#define PG8_SB(b, h) ((4 + (b) * 2 + (h)) * HTB)
#define PG8_GOFF(h, NXT) do { if constexpr (Sched::GATHER) go = *(const LAS u32x2*)(lds + NXT_OFF + ((((NXT) ? ui + 1 : ui) & 1) << 13) + tid * 16 + (h) * 8); } while (0)
#define PG8_STAGE_A(bufoff, h, NXT, kb) do { _Pragma("unroll") for (int _i = 0; _i < 2; ++_i) { \
        if constexpr (Sched::GATHER) glds16(Abase + (kb), _i ? go.y : go.x, ldsb + (bufoff) + ldsw + _i * 8192); \
        else glds16(Abase + ((NXT) ? nxtA : curA) + (size_t)((h) * 128 + _i * 64) * lda2 + (kb), aoffl, ldsb + (bufoff) + ldsw + _i * 8192); } } while (0)
#define PG8_STAGE_B(bufoff, bptr, kb) do { _Pragma("unroll") for (int _i = 0; _i < 2; ++_i) \
        glds16((bptr) + (size_t)(_i * PIECE_B) * ldb2 + (kb), voffB, ldsb + (bufoff) + ldsw + _i * 8192); } while (0)
#define PG8_LDA(dst, b, h) do { int _a1 = aoff0 ^ KX; asm volatile("" : "+v"(_a1)); \
        _Pragma("unroll") for (int m = 0; m < 4; ++m) _Pragma("unroll") for (int k = 0; k < 2; ++k) dst[m][k] = *(const LAS bf16x8*)(lds + PG8_SA(b, h) + (k ? _a1 : aoff0) + m * 2048); } while (0)
#define PG8_LDB(dst, b, h) do { int _b1 = boff0 ^ KX; asm volatile("" : "+v"(_b1)); \
        _Pragma("unroll") for (int n = 0; n < 2; ++n) _Pragma("unroll") for (int k = 0; k < 2; ++k) dst[n][k] = *(const LAS bf16x8*)(lds + PG8_SB(b, h) + (k ? _b1 : boff0) + n * 2048); } while (0)
#define PG8_MMA(ai, bj, At, Bt) do { __builtin_amdgcn_s_setprio(1); _Pragma("unroll") for (int m = 0; m < 4; ++m) _Pragma("unroll") for (int n = 0; n < 2; ++n) { \
        if constexpr (F8) acc[ai][bj][m][n] = __builtin_amdgcn_mfma_scale_f32_16x16x128_f8f6f4(cat8(Bt[n][0], Bt[n][1]), cat8(At[m][0], At[m][1]), acc[ai][bj][m][n], 0, 0, 0, 0, 0, 0); \
        else { _Pragma("unroll") for (int k = 0; k < 2; ++k) acc[ai][bj][m][n] = __builtin_amdgcn_mfma_f32_16x16x32_bf16(Bt[n][k], At[m][k], acc[ai][bj][m][n], 0, 0, 0); } } \
        __builtin_amdgcn_s_setprio(0); } while (0)
#define PG8_WAIT_V(n) asm volatile("s_waitcnt vmcnt(" #n ")" ::: "memory")
#define PG8_WAIT_L(n) asm volatile("s_waitcnt lgkmcnt(" #n ")" ::: "memory")
#define PG8_BAR __builtin_amdgcn_s_barrier()
#define PG8_SCHED __builtin_amdgcn_sched_barrier(0)
#define PG8_KITER(k1, b2, NXT, k2, k3) do { \
        PG8_GOFF(1, 0); PG8_LDB(B0, 0, 0); PG8_LDB(B1, 0, 1); PG8_SCHED; PG8_LDA(At, 0, 0); PG8_STAGE_A(PG8_SA(1, 1), 1, 0, (k1)); \
        PG8_WAIT_V(8); PG8_WAIT_L(0); PG8_BAR; PG8_MMA(0, 0, At, B0); PG8_MMA(0, 1, At, B1); PG8_BAR; PG8_SCHED; \
        PG8_GOFF(0, NXT); PG8_LDA(At, 0, 1); PG8_STAGE_B(PG8_SB(0, 0), (b2), (k2)); PG8_STAGE_B(PG8_SB(0, 1), (b2) + hstepB, (k2)); PG8_STAGE_A(PG8_SA(0, 0), 0, NXT, (k2)); \
        PG8_WAIT_V(8); PG8_WAIT_L(0); PG8_BAR; PG8_MMA(1, 0, At, B0); PG8_MMA(1, 1, At, B1); PG8_BAR; PG8_SCHED; \
        PG8_GOFF(1, NXT); PG8_LDB(B0, 1, 0); PG8_LDB(B1, 1, 1); PG8_SCHED; PG8_LDA(At, 1, 0); PG8_STAGE_A(PG8_SA(0, 1), 1, NXT, (k2)); \
        PG8_WAIT_V(8); PG8_WAIT_L(0); PG8_BAR; PG8_MMA(0, 0, At, B0); PG8_MMA(0, 1, At, B1); PG8_BAR; PG8_SCHED; \
        PG8_GOFF(0, NXT); PG8_LDA(At, 1, 1); PG8_STAGE_B(PG8_SB(1, 0), (b2), (k3)); PG8_STAGE_B(PG8_SB(1, 1), (b2) + hstepB, (k3)); PG8_STAGE_A(PG8_SA(1, 0), 0, NXT, (k3)); \
        PG8_WAIT_V(8); PG8_WAIT_L(0); PG8_BAR; PG8_MMA(1, 0, At, B0); PG8_MMA(1, 1, At, B1); PG8_BAR; PG8_SCHED; } while (0)

    Unit cur, nxt; int ui = 0;
    if (!S.next(0, cur)) return;
    unsigned curoff[2][2], nxtoff[2][2];
    size_t curA = 0, nxtA = 0;
    bool has_next = S.next(1, nxt);
#define PG8_NXT_SLOT ((LAS u32x4*)(lds + NXT_OFF) + tid)
    if constexpr (Sched::GATHER) {
        S.tab_issue(cur, ldsb, wid, lane); if (has_next) S.tab_issue(nxt, ldsb, wid, lane);
        asm volatile("s_waitcnt vmcnt(0)" ::: "memory"); __builtin_amdgcn_s_barrier(); asm volatile("" ::: "memory");
        S.a_off(cur, lds, R0, C0, (int)lda2, curoff);
        if (has_next) S.a_off(nxt, lds, R0, C0, (int)lda2, nxtoff);
        else {
#pragma unroll
            for (int h = 0; h < 2; ++h)
#pragma unroll
                for (int i = 0; i < 2; ++i) nxtoff[h][i] = curoff[h][i]; }
        ((LAS u32x4*)(lds + NXT_OFF))[tid] = (u32x4){curoff[0][0], curoff[0][1], curoff[1][0], curoff[1][1]};
        ((LAS u32x4*)(lds + NXT_OFF + 8192))[tid] = (u32x4){nxtoff[0][0], nxtoff[0][1], nxtoff[1][0], nxtoff[1][1]};
    } else { curA = (size_t)cur.arow * lda2 + cur.koff; nxtA = has_next ? (size_t)nxt.arow * lda2 + nxt.koff : curA; }
    f32x4 acc[2][2][4][2];
#pragma unroll
    for (int a = 0; a < 2; ++a)
#pragma unroll
        for (int b = 0; b < 2; ++b)
#pragma unroll
            for (int m = 0; m < 4; ++m)
#pragma unroll
                for (int n = 0; n < 2; ++n) acc[a][b][m][n] = (f32x4){0.f, 0.f, 0.f, 0.f};
    bf16x8 At[4][2], B0[2][2], B1[2][2];
    const char* cB = (const char*)g.Bt + (size_t)cur.brow * ldb2 + cur.koff;
    u32x2 go = {0u, 0u};
    PG8_STAGE_B(PG8_SB(0, 0), cB, 0u); PG8_STAGE_B(PG8_SB(0, 1), cB + hstepB, 0u); PG8_GOFF(0, 0); PG8_STAGE_A(PG8_SA(0, 0), 0, 0, 0u); PG8_GOFF(1, 0); PG8_STAGE_A(PG8_SA(0, 1), 1, 0, 0u);
    if (wr == 1) PG8_BAR;
    PG8_WAIT_V(2); PG8_BAR;
    PG8_GOFF(0, 0); PG8_STAGE_B(PG8_SB(1, 0), cB, kstep); PG8_STAGE_A(PG8_SA(1, 0), 0, 0, kstep); PG8_STAGE_B(PG8_SB(1, 1), cB + hstepB, kstep);
    PG8_WAIT_V(6); PG8_BAR;
    for (;;) {
        const char* nB = has_next ? (const char*)g.Bt + (size_t)nxt.brow * ldb2 + nxt.koff : cB;
        Unit u2; bool has2 = false;
        if constexpr (Sched::GATHER) has2 = has_next && S.next(ui + 2, u2);
#pragma unroll 1
        for (int t = 0; t < nt - 2; t += 2) {
            const unsigned k1 = (unsigned)(t + 1) * kstep, k2 = (unsigned)(t + 2) * kstep, k3 = (unsigned)(t + 3) * kstep;
            if constexpr (Sched::GATHER) { if (t == 2 && has2) S.tab_issue(u2, ldsb, wid, lane); }
            PG8_KITER(k1, cB, 0, k2, k3);
        }
        { const unsigned k1 = (unsigned)(nt - 1) * kstep; PG8_KITER(k1, nB, 1, 0u, kstep); }
#if PIN_ACC
#pragma unroll
        for (int a = 0; a < 2; ++a)
#pragma unroll
            for (int b = 0; b < 2; ++b)
#pragma unroll
                for (int m = 0; m < 4; ++m) asm volatile("" : "+v"(acc[a][b][m][0]), "+v"(acc[a][b][m][1]));
#endif
        if (wr == 0) PG8_BAR;
#ifdef PROBE_VARIANTS
        if (!(kvariant() & 4))
#endif
        { const int l2 = lane_id_asm(); E(acc, cur, wr, wc, l2 & 15, l2 >> 4); }
        if (!has_next) break;
#pragma unroll
        for (int a = 0; a < 2; ++a)
#pragma unroll
            for (int b = 0; b < 2; ++b)
#pragma unroll
                for (int m = 0; m < 4; ++m)
#pragma unroll
                    for (int n = 0; n < 2; ++n) acc[a][b][m][n] = (f32x4){0.f, 0.f, 0.f, 0.f};
        cur = nxt; cB = nB; ++ui; curA = nxtA;
        has_next = S.next(ui + 1, nxt);
        if (has_next) {
            if constexpr (Sched::GATHER) { const int tz = (wave0 << 6) | lane_id_asm(); int R0z, C0z;
                { const int lz = tz & 63; R0z = 8 * wid + (lz >> 3); C0z = 16 * ((lz & 7) ^ chunk_xor<F8>(R0z & 15)); }
                S.a_off(nxt, lds, R0z, C0z, (int)lda2, nxtoff);
                ((LAS u32x4*)(lds + NXT_OFF + (((ui + 1) & 1) << 13)))[tz] = (u32x4){nxtoff[0][0], nxtoff[0][1], nxtoff[1][0], nxtoff[1][1]}; }
            else nxtA = (size_t)nxt.arow * lda2 + nxt.koff;
        } else if constexpr (Sched::GATHER) { const int tz = (wave0 << 6) | lane_id_asm();
            ((LAS u32x4*)(lds + NXT_OFF + (((ui + 1) & 1) << 13)))[tz] = ((const LAS u32x4*)(lds + NXT_OFF + ((ui & 1) << 13)))[tz]; }
        if (wr == 1) PG8_BAR;
    }
    PG8_WAIT_V(0);
    PG8_BAR;
#undef PG8_SA
#undef PG8_SB
#undef PG8_STAGE_A
#undef PG8_GOFF
#undef PG8_STAGE_B
#undef PG8_LDA
#undef PG8_LDB
#undef PG8_MMA
#undef PG8_WAIT_V
#undef PG8_WAIT_L
#undef PG8_BAR
#undef PG8_SCHED
#undef PG8_KITER
#undef PG8_NXT_SLOT
}
}

struct Args { const float* in[32]; float* out; unsigned char* ws; int ph_lo, ph_hi, variant, pad; };
typedef const __attribute__((address_space(4))) unsigned char* kptr_t;
__device__ __forceinline__ const float* kin(int i) { kptr_t p = (kptr_t)__builtin_amdgcn_kernarg_segment_ptr(); asm volatile("" : "+s"(p)); return *(const float* const __attribute__((address_space(4)))*)(p + 8 * i); }
enum { I_X = 0, I_C, I_MODW, I_MODB, I_LNG, I_LNB, I_ABWIN, I_POOLW, I_POOLS, I_CONVW, I_CONVB, I_WA, I_BA, I_WX, I_BX, I_LAM, I_ABWOUT, I_ABBOUT,
       I_SGWIN, I_SGBIN, I_SGLNG, I_SGLNB, I_SGWS, I_SGBS, I_SGWOUT, I_SGBOUT, I_RW, I_RB, I_W1, I_B1, I_W2, I_B2 };

__device__ __forceinline__ int w1_rho(int n) { const int nn = n & 1, j = n >> 1; return ((j >> 7) << 8) | (((j >> 2) & 1) << 7) | (((j >> 5) & 3) << 5) | (nn << 4) | (((j >> 3) & 3) << 2) | (j & 3); }
__device__ __forceinline__ int w1_n_of_rho(int rho) { const int pn = rho >> 8, bj = (rho >> 7) & 1, wc = (rho >> 5) & 3, nn = (rho >> 4) & 1, fq = (rho >> 2) & 3, i = rho & 3; return 2 * (128 * pn + 32 * wc + 8 * fq + 4 * bj + i) + nn; }
template <bool W1MAP>
__device__ __forceinline__ void conv_item(const float* W, int N, bf16_t* WT, int item, int lane) {
    const int nblk = N >> 5, kb = item / nblk, nb = item - kb * nblk;
    const int kg = lane >> 3, nl = lane & 7, k0 = kb * 64 + kg * 8, n0 = nb * 32 + nl * 4;
    f32x4 v[8];
#pragma unroll
    for (int q = 0; q < 8; ++q) v[q] = *(const f32x4*)(W + (size_t)(k0 + q) * N + n0);
#pragma unroll
    for (int i = 0; i < 4; ++i) {
        const int n = n0 + i, row = W1MAP ? w1_rho(n) : n;
        u32x4 o; o.x = pk2(v[0][i], v[1][i]); o.y = pk2(v[2][i], v[3][i]); o.z = pk2(v[4][i], v[5][i]); o.w = pk2(v[6][i], v[7][i]);
        *(u32x4*)(WT + (size_t)row * 1024 + k0) = o;
    }
}

template <bool W1MAP>
__device__ __forceinline__ void conv_item_f8(const float* W, int N, unsigned char* WT8, int item, int lane, float scale) {
    const int nblk = N >> 5, kb = item / nblk, nb = item - kb * nblk;
    const int kg = lane >> 3, nl = lane & 7, k0 = kb * 128 + kg * 16, n0 = nb * 32 + nl * 4;
    f32x4 v[16];
#pragma unroll
    for (int q = 0; q < 16; ++q) v[q] = *(const f32x4*)(W + (size_t)(k0 + q) * N + n0) * scale;
#pragma unroll
    for (int i = 0; i < 4; ++i) {
        const int n = n0 + i, row = W1MAP ? w1_rho(n) : n;
        u32x4 o; o.x = pk4_fp8(v[0][i], v[1][i], v[2][i], v[3][i]); o.y = pk4_fp8(v[4][i], v[5][i], v[6][i], v[7][i]);
        o.z = pk4_fp8(v[8][i], v[9][i], v[10][i], v[11][i]); o.w = pk4_fp8(v[12][i], v[13][i], v[14][i], v[15][i]);
        *(u32x4*)(WT8 + (size_t)row * 1024 + k0) = o;
    }
}

#define IN(k) (lo <= (k) && (k) < hi)
#define SEAM(k) do { if ((k) + 1 < hi) xcd_barrier(bar); } while (0)
#define LSEAM(k) do { if ((k) + 1 < hi) { if (FUSE_LOCAL && G == 256) { __builtin_amdgcn_fence(__ATOMIC_RELEASE, "workgroup"); __syncthreads(); __builtin_amdgcn_fence(__ATOMIC_ACQUIRE, "workgroup"); } else xcd_barrier(bar); } } while (0)
#define PH_LOCALS \
    const int tid = (wave0 << 6) | lane_id_asm(); \
    const int lane = tid & 63, wave = wave0; \
    int bx = blockIdx.x; asm volatile("" : "+s"(bx)); \
    const int vcu = (G % 8 == 0) ? (bx % 8) * (G / 8) + bx / 8 : bx; \
    const int gw = vcu * 8 + wave, NGW = G * 8; \
    unsigned char* ws; { kptr_t kp_ = (kptr_t)__builtin_amdgcn_kernarg_segment_ptr(); asm volatile("" : "+s"(kp_)); ws = *(unsigned char* const __attribute__((address_space(4)))*)(kp_ + 264); } \
    float* Xf; { kptr_t kp_ = (kptr_t)__builtin_amdgcn_kernarg_segment_ptr(); asm volatile("" : "+s"(kp_)); Xf = *(float* const __attribute__((address_space(4)))*)(kp_ + 256); } \
    unsigned* const ctl = (unsigned*)(ws + WS_CTL); \
    float* const MOD = (float*)(ws + WS_MOD); bf16_t* const Hb = (bf16_t*)(ws + WS_H); bf16_t* const Zb = (bf16_t*)(ws + WS_Z); bf16_t* const A2b = (bf16_t*)(ws + WS_A2); \
    bf16_t* const RIb = (bf16_t*)(ws + WS_RI); bf16_t* const YMb = (bf16_t*)(ws + WS_YMIX); bf16_t* const Yb = (bf16_t*)(ws + WS_Y); bf16_t* const ACTb = (bf16_t*)(ws + WS_ACT); \
    bf16_t* const YSb = (bf16_t*)(ws + WS_YS); float* const LOGf = (float*)(ws + WS_LOG); float* const TOPG = (float*)(ws + WS_TOPG); int* const LIST = (int*)(ws + WS_LIST); \
    float* const SUMM = (float*)(ws + WS_SUMM); \
    (void)lane; (void)wave; (void)gw; (void)NGW; (void)ctl; (void)MOD; (void)Hb; (void)Zb; (void)A2b; (void)RIb; (void)YMb; (void)Yb; (void)ACTb; (void)YSb; (void)LOGf; (void)TOPG; (void)LIST; (void)SUMM; (void)Xf; (void)vcu


template <int L, int PASS>
__device__ __forceinline__ void scan_phase(const int lo, const int hi, const int G, const XcdBarrier& bar, const int wave0) {
    constexpr int l = L, pass = PASS, P = PH_L0 + PH_PER_LAYER * L, jj = L >> 1; constexpr bool odd = (L & 1) != 0;
            if (PHEN(6) && !odd && IN(P + 3 + pass)) {
            PH_LOCALS;
                for (int it = gw; it < 16 * 32 * 4; it += NGW) {
                    const int b = it >> 7, n = (it >> 2) & 31, cg = it & 3;
                    const int ch = cg * 128 + 2 * lane;
                    float sp[2];
#pragma unroll
                    for (int q = 0; q < 2; ++q) { const float x = -kin(I_LAM)[jj * 512 + ch + q]; sp[q] = 8.0f * 1.4426950408889634f * (fmaxf(x, 0.f) + log1pf(__expf(-fabsf(x)))); }
                    float one = 1.0f; asm volatile("" : "+v"(one));
                    float h0 = 0.f, h1 = 0.f, p0 = one, p1 = one;
                    if (pass == 1) {
#pragma unroll 1
                        for (int m = 0; m < n; ++m) { const f32x4 s = *(const f32x4*)(SUMM + (((size_t)b * 32 + m) * 512 + ch) * 2); h0 = s[0] * h0 + s[1]; h1 = s[2] * h1 + s[3]; }
                    }
                    const size_t row0 = (size_t)b * SEQ + n * 128;
#pragma unroll 4
                    for (int t = 0; t < 128; ++t) {
                        const size_t r = row0 + t;
                        const unsigned rw = *(const unsigned*)(RIb + r * 1024 + ch), iw = *(const unsigned*)(RIb + r * 1024 + 512 + ch), xw = *(const unsigned*)(A2b + r * 1024 + 512 + ch);
                        const float a0 = __builtin_amdgcn_exp2f(-bflo(rw) * sp[0]), a1 = __builtin_amdgcn_exp2f(-bfhi(rw) * sp[1]);
                        const float m0 = __builtin_amdgcn_sqrtf(fmaxf(__builtin_fmaf(-a0, a0, 1.0f), 0.f)), m1 = __builtin_amdgcn_sqrtf(fmaxf(__builtin_fmaf(-a1, a1, 1.0f), 0.f));
                        h0 = a0 * h0 + m0 * (bflo(iw) * bflo(xw)); h1 = a1 * h1 + m1 * (bfhi(iw) * bfhi(xw));
                        if (pass == 0) { p0 *= a0; p1 *= a1; }
                        else { const unsigned gwd = *(const unsigned*)(Zb + r * DINAB + 1024 + ch);
                            if (FP8_OUTP) *(unsigned short*)((unsigned char*)YMb + r * 1024 + 512 + ch) = (unsigned short)pk4_fp8(h0 * gelu_tanh(bflo(gwd)), h1 * gelu_tanh(bfhi(gwd)), 0.f, 0.f);
                            else *(unsigned*)(YMb + r * 1024 + 512 + ch) = pk2(h0 * gelu_tanh(bflo(gwd)), h1 * gelu_tanh(bfhi(gwd))); }
                    }
                    if (pass == 0) *(f32x4*)(SUMM + (((size_t)b * 32 + n) * 512 + ch) * 2) = (f32x4){p0, h0, p1, h1};
                }
                SEAM(P + 3 + pass);
            }
}

template <int L, int SUB>
__device__ __forceinline__ void ln_phase(const int lo, const int hi, const int G, const XcdBarrier& bar, const int wave0) {
    constexpr int l = L, sub = SUB, P = PH_L0 + PH_PER_LAYER * L; constexpr int ph = SUB == 0 ? P + 6 : P + 11;
    constexpr bool XIN_F32 = (L == 0 && SUB == 0), XOUT_F32 = (L == DEPTH - 1 && SUB == 1);
    if (PHEN(8) && IN(ph)) {
        PH_LOCALS;
        const int rows_per = T / NGW, r0 = gw * rows_per, b = r0 / SEQ;
        constexpr int ls = 2 * l + sub, lsn = ls + 1;
        const float* gp = MOD + ((size_t)ls * 16 + b) * 3072 + 2048;
        const float* lgp = kin(I_LNG) + ls * 1024, * lbp = kin(I_LNB) + ls * 1024;
        constexpr bool has_nextmod = lsn < 2 * DEPTH;
        const float* nsh = MOD + ((size_t)(has_nextmod ? lsn : 0) * 16 + b) * 3072, * nsc = nsh + 1024;
        f32x4 gt[4], lg[4], lb[4], sh[4], sc[4];
#pragma unroll
        for (int j = 0; j < 4; ++j) { const int o = 4 * (64 * j + lane); gt[j] = *(const f32x4*)(gp + o) + 1.0f; lg[j] = *(const f32x4*)(lgp + o); lb[j] = *(const f32x4*)(lbp + o);
            sh[j] = *(const f32x4*)(nsh + o); sc[j] = *(const f32x4*)(nsc + o) + 1.0f; }
        const float* xin32 = kin(I_X);
        bf16_t* const Xb = (bf16_t*)(ws + WS_XB);
        constexpr int RPI = 2;
        for (int r = r0; r < r0 + rows_per; r += RPI) {
            f32x4 xf[XIN_F32 ? RPI : 1][4]; u32x2 xb[XIN_F32 ? 1 : RPI][4]; u32x2 yv[sub == 0 ? RPI : 1][4]; u32x2 ys[sub == 0 ? 1 : RPI][4][4]; f32x4 gk[RPI];
#pragma unroll
            for (int q = 0; q < RPI; ++q) {
                if constexpr (XIN_F32) { const f32x4* xr = (const f32x4*)(xin32 + (size_t)(r + q) * D) + lane;
#pragma unroll
                    for (int j = 0; j < 4; ++j) xf[q][j] = xr[64 * j]; }
                else { const u32x2* xr = (const u32x2*)(Xb + (size_t)(r + q) * D) + lane;
#pragma unroll
                    for (int j = 0; j < 4; ++j) xb[q][j] = xr[64 * j]; }
                if constexpr (sub == 0) { const u32x2* yr = (const u32x2*)(Yb + (size_t)(r + q) * D) + lane;
#pragma unroll
                    for (int j = 0; j < 4; ++j) yv[q][j] = yr[64 * j]; }
                else { gk[q] = *(const f32x4*)(TOPG + (size_t)(r + q) * 4);
#pragma unroll
                    for (int k = 0; k < 4; ++k) {
                        if (FP8_YS) { const unsigned* yr = (const unsigned*)((const unsigned char*)YSb + ((size_t)(r + q) * 4 + k) * D) + lane;
#pragma unroll
                            for (int j = 0; j < 4; ++j) ys[q][k][j].x = yr[64 * j]; }
                        else { const u32x2* yr = (const u32x2*)(YSb + ((size_t)(r + q) * 4 + k) * D) + lane;
#pragma unroll
                            for (int j = 0; j < 4; ++j) ys[q][k][j] = yr[64 * j]; } } }
            }
            f32x4 v[RPI][4]; float s[RPI];
#pragma unroll
            for (int q = 0; q < RPI; ++q) {
                s[q] = 0.f;
#pragma unroll
                for (int j = 0; j < 4; ++j) {
                    f32x4 y, x;
                    if constexpr (XIN_F32) x = xf[q][j]; else x = (f32x4){bflo(xb[q][j].x), bfhi(xb[q][j].x), bflo(xb[q][j].y), bfhi(xb[q][j].y)};
                    if constexpr (sub == 0) y = (f32x4){bflo(yv[q][j].x), bfhi(yv[q][j].x), bflo(yv[q][j].y), bfhi(yv[q][j].y)};
                    else { y = (f32x4){0.f, 0.f, 0.f, 0.f};
#pragma unroll
                        for (int k = 0; k < 4; ++k) { const u32x2 w = ys[q][k][j];
                            if (FP8_YS) { const f32x2 lo2 = __builtin_amdgcn_cvt_pk_f32_fp8((int)w.x, false), hi2 = __builtin_amdgcn_cvt_pk_f32_fp8((int)w.x, true);
                                y = y + (f32x4){lo2.x, lo2.y, hi2.x, hi2.y} * (gk[q][k] * 0.0625f); }
                            else y = y + (f32x4){bflo(w.x), bfhi(w.x), bflo(w.y), bfhi(w.y)} * gk[q][k]; } }
                    v[q][j] = x * DN_ALPHA + gt[j] * y;
                    s[q] += (v[q][j][0] + v[q][j][1]) + (v[q][j][2] + v[q][j][3]);
                }
            }
#pragma unroll
            for (int o = 1; o < 64; o <<= 1) {
#pragma unroll
                for (int q = 0; q < RPI; ++q) s[q] += __builtin_bit_cast(float, __builtin_amdgcn_ds_bpermute((lane ^ o) << 2, __builtin_bit_cast(int, s[q])));
            }
            float s2[RPI];
#pragma unroll
            for (int q = 0; q < RPI; ++q) { const float mean = s[q] * (1.0f / D); s2[q] = 0.f;
#pragma unroll
                for (int j = 0; j < 4; ++j) { v[q][j] = v[q][j] - mean; s2[q] += (v[q][j][0] * v[q][j][0] + v[q][j][1] * v[q][j][1]) + (v[q][j][2] * v[q][j][2] + v[q][j][3] * v[q][j][3]); } }
#pragma unroll
            for (int o = 1; o < 64; o <<= 1) {
#pragma unroll
                for (int q = 0; q < RPI; ++q) s2[q] += __builtin_bit_cast(float, __builtin_amdgcn_ds_bpermute((lane ^ o) << 2, __builtin_bit_cast(int, s2[q])));
            }
#pragma unroll
            for (int q = 0; q < RPI; ++q) {
                const float rstd = 1.0f / sqrtf(s2[q] * (1.0f / D) + LN_EPS);
                u32x2* hr = (u32x2*)(Hb + (size_t)(r + q) * D) + lane;
#pragma unroll
                for (int j = 0; j < 4; ++j) { const f32x4 xn = v[q][j] * rstd * lg[j] + lb[j];
                    if (XOUT_F32) ((f32x4*)(Xf + (size_t)(r + q) * D) + lane)[64 * j] = xn;
                    else { u32x2 w; w.x = pk2(xn[0], xn[1]); w.y = pk2(xn[2], xn[3]); ((u32x2*)(Xb + (size_t)(r + q) * D) + lane)[64 * j] = w; }
                    if (has_nextmod) { const f32x4 h = xn * sc[j] + sh[j];
                        if (!(FP8_INP && sub == 1) && !(ROUTER_X && sub == 0)) { u32x2 w; w.x = pk2(h[0], h[1]); w.y = pk2(h[2], h[3]); hr[64 * j] = w; }
                        if ((FP8_M1 && sub == 0) || (FP8_INP && sub == 1)) ((unsigned*)(ws + WS_H8 + (size_t)(r + q) * D) + lane)[64 * j] = pk4_fp8(h[0], h[1], h[2], h[3]); } }
            }
        }
        if (ph + 1 < NPH) { if (sub == 0) LSEAM(ph); else SEAM(ph); }
    }
}

template <int L>
__device__ __forceinline__ void layer_body(LAS unsigned char* const lds, volatile LAS unsigned* const LCTL, const int lo, const int hi, const int G, const XcdBarrier& bar, const int wave0) {
    constexpr int l = L;
        const int P = PH_L0 + PH_PER_LAYER * l, jj = l >> 1;
        const bool odd = (l & 1) != 0;
        if (PHEN(2) && IN(P + 0)) {
            PH_LOCALS;
            if (!odd) {
                pg8::DenseSched S; S.init(T, 1536, G, bx);
                if (FP8_INP) { pg8::Gemm g{ws + WS_H8, ws + WS_ABIN + (size_t)jj * 1536 * 1024, 1024, 1024, 1024, 122};
                    pg8::EpiDense<0, false, false, true> E{Zb, 1536, nullptr, nullptr, 1.0f / 32.0f};
                    pg8::gemm_phase<true>(lds, g, S, E, wave0); }
                else { pg8::Gemm g{Hb, (const bf16_t*)(ws + WS_ABIN) + (size_t)jj * 1536 * 1024, 1024, 1024, 1024, 127};
                    pg8::EpiDense<0, false, false> E{Zb, 1536, nullptr, nullptr, 0.f};
                    pg8::gemm_phase<false>(lds, g, S, E, wave0); }
            } else {
                pg8::DenseSched S; S.init(T, 2048, G, bx);
                if (FP8_INP) { pg8::Gemm g{ws + WS_H8, ws + WS_SGIN + (size_t)jj * 2048 * 1024, 1024, 1024, 1024, 122};
                    pg8::EpiDense<1, true, false, true> E{Zb, 2048, kin(I_SGBIN) + jj * 2048, nullptr, 1.0f / 32.0f};
                    pg8::gemm_phase<true>(lds, g, S, E, wave0); }
                else { pg8::Gemm g{Hb, (const bf16_t*)(ws + WS_SGIN) + (size_t)jj * 2048 * 1024, 1024, 1024, 1024, 127};
                    pg8::EpiDense<1, true, false> E{Zb, 2048, kin(I_SGBIN) + jj * 2048, nullptr, 0.f};
                    pg8::gemm_phase<false>(lds, g, S, E, wave0); }
            }
            SEAM(P + 0);
        }
        if (PHEN(3) && !odd && IN(P + 1)) {
            PH_LOCALS;
            const int rows_per = T / NGW, r0 = gw * rows_per;
            const int g4 = lane >> 4, w = 2 << g4;
            float cw[4][8], cb[8];
#pragma unroll
            for (int k = 0; k < 4; ++k)
#pragma unroll
                for (int q = 0; q < 8; ++q) cw[k][q] = kin(I_CONVW)[((size_t)jj * 4 + k) * 512 + 8 * lane + q];
#pragma unroll
            for (int q = 0; q < 8; ++q) cb[q] = kin(I_CONVB)[jj * 512 + 8 * lane + q];
            const int ts0 = r0 & (SEQ - 1);
            u32x4 ring[16], cr[3];
            float sw[8];
#pragma unroll
            for (int q = 0; q < 8; ++q) sw[q] = 0.f;
#pragma unroll
            for (int d = 0; d < 16; ++d) {
                const int k = 15 - d;
                u32x4 v = {0u, 0u, 0u, 0u};
                if (ts0 > d) v = *(const u32x4*)(Zb + (size_t)(r0 - 1 - d) * DINAB + 8 * lane);
                ring[k] = v;
                if (d + 1 < w) { const float f[8] = {bflo(v.x), bfhi(v.x), bflo(v.y), bfhi(v.y), bflo(v.z), bfhi(v.z), bflo(v.w), bfhi(v.w)};
#pragma unroll
                    for (int q = 0; q < 8; ++q) sw[q] += f[q]; }
            }
#pragma unroll
            for (int d = 0; d < 3; ++d) { u32x4 v = {0u, 0u, 0u, 0u}; if (ts0 > d) v = *(const u32x4*)(Zb + (size_t)(r0 - 1 - d) * DINAB + 512 + 8 * lane); cr[2 - d] = v; }
#pragma unroll 1
            for (int rb = 0; rb < rows_per; rb += 16) {
#pragma unroll
                for (int i = 0; i < 16; ++i) {
                    const int r = r0 + rb + i, ts = r & (SEQ - 1);
                    const u32x4 vn = *(const u32x4*)(Zb + (size_t)r * DINAB + 8 * lane), cn = *(const u32x4*)(Zb + (size_t)r * DINAB + 512 + 8 * lane);
                    const u32x4 c2 = ring[(i + 15) & 15], c4 = ring[(i + 13) & 15], c8 = ring[(i + 9) & 15], c16 = ring[(i + 1) & 15];
                    u32x4 vo;
                    vo.x = g4 == 0 ? c2.x : g4 == 1 ? c4.x : g4 == 2 ? c8.x : c16.x; vo.y = g4 == 0 ? c2.y : g4 == 1 ? c4.y : g4 == 2 ? c8.y : c16.y;
                    vo.z = g4 == 0 ? c2.z : g4 == 1 ? c4.z : g4 == 2 ? c8.z : c16.z; vo.w = g4 == 0 ? c2.w : g4 == 1 ? c4.w : g4 == 2 ? c8.w : c16.w;
                    ring[i] = vn;
                    const float fn[8] = {bflo(vn.x), bfhi(vn.x), bflo(vn.y), bfhi(vn.y), bflo(vn.z), bfhi(vn.z), bflo(vn.w), bfhi(vn.w)};
                    const float fo[8] = {bflo(vo.x), bfhi(vo.x), bflo(vo.y), bfhi(vo.y), bflo(vo.z), bfhi(vo.z), bflo(vo.w), bfhi(vo.w)};
                    const int cntw = (ts + 1) < w ? (ts + 1) : w;
                    const float inv = __builtin_amdgcn_rcpf((float)cntw);
                    float pz[8];
#pragma unroll
                    for (int q = 0; q < 8; ++q) { sw[q] += fn[q]; pz[q] = sw[q] * inv - fn[q]; sw[q] -= fo[q]; }
                    u32x4 o; o.x = pk2(pz[0], pz[1]); o.y = pk2(pz[2], pz[3]); o.z = pk2(pz[4], pz[5]); o.w = pk2(pz[6], pz[7]);
                    *(u32x4*)(A2b + (size_t)r * 1024 + 8 * lane) = o;
                    float xc[8];
                    const u32x4 t0 = cr[0], t1 = cr[1], t2 = cr[2];
                    const float f0[8] = {bflo(t0.x), bfhi(t0.x), bflo(t0.y), bfhi(t0.y), bflo(t0.z), bfhi(t0.z), bflo(t0.w), bfhi(t0.w)};
                    const float f1[8] = {bflo(t1.x), bfhi(t1.x), bflo(t1.y), bfhi(t1.y), bflo(t1.z), bfhi(t1.z), bflo(t1.w), bfhi(t1.w)};
                    const float f2[8] = {bflo(t2.x), bfhi(t2.x), bflo(t2.y), bfhi(t2.y), bflo(t2.z), bfhi(t2.z), bflo(t2.w), bfhi(t2.w)};
                    const float f3[8] = {bflo(cn.x), bfhi(cn.x), bflo(cn.y), bfhi(cn.y), bflo(cn.z), bfhi(cn.z), bflo(cn.w), bfhi(cn.w)};
#pragma unroll
                    for (int q = 0; q < 8; ++q) xc[q] = cb[q] + f0[q] * cw[0][q] + f1[q] * cw[1][q] + f2[q] * cw[2][q] + f3[q] * cw[3][q];
                    cr[0] = t1; cr[1] = t2; cr[2] = cn;
                    u32x4 o2; o2.x = pk2(xc[0], xc[1]); o2.y = pk2(xc[2], xc[3]); o2.z = pk2(xc[4], xc[5]); o2.w = pk2(xc[6], xc[7]);
                    *(u32x4*)(A2b + (size_t)r * 1024 + 512 + 8 * lane) = o2;
                }
            }
            LSEAM(P + 1);
        }
        if (PHEN(4) && odd && IN(P + 1)) {
            PH_LOCALS;
            LAS float* STAT = (LAS float*)lds;
            LAS unsigned char* WSS = lds + 1024;
            LAS unsigned char* VT = lds + 1024 + 34816;
            const float* lng = kin(I_SGLNG) + jj * 1024, * lnb = kin(I_SGLNB) + jj * 1024;
            const bf16_t* WSMp = (const bf16_t*)(ws + WS_WSM) + (size_t)jj * 8 * 128 * 128;
            const float* bs = kin(I_SGBS) + jj * 8 * 128;
            const int fr = lane & 15, fq = lane >> 4;
            for (int it = vcu; it < T / 128; it += G) {
                const size_t row0 = (size_t)it * 128;
#pragma unroll 1
                for (int rb = 0; rb < 2; ++rb) {
                    u32x4 a8[8], b8[8];
#pragma unroll
                    for (int q = 0; q < 8; ++q) { const bf16_t* vp = Zb + (row0 + wave * 16 + rb * 8 + q) * 2048 + 1024; a8[q] = *(const u32x4*)(vp + 8 * lane); b8[q] = *(const u32x4*)(vp + 512 + 8 * lane); }
                    float sm[8], sq[8];
#pragma unroll
                    for (int q = 0; q < 8; ++q) {
                        const float f[16] = {bflo(a8[q].x), bfhi(a8[q].x), bflo(a8[q].y), bfhi(a8[q].y), bflo(a8[q].z), bfhi(a8[q].z), bflo(a8[q].w), bfhi(a8[q].w),
                                             bflo(b8[q].x), bfhi(b8[q].x), bflo(b8[q].y), bfhi(b8[q].y), bflo(b8[q].z), bfhi(b8[q].z), bflo(b8[q].w), bfhi(b8[q].w)};
                        float s1 = 0.f, s2 = 0.f;
#pragma unroll
                        for (int e = 0; e < 16; ++e) { s1 += f[e]; s2 += f[e] * f[e]; }
                        sm[q] = s1; sq[q] = s2;
                    }
#pragma unroll
                    for (int o = 1; o < 64; o <<= 1) {
#pragma unroll
                        for (int q = 0; q < 8; ++q) { sm[q] += __builtin_bit_cast(float, __builtin_amdgcn_ds_bpermute((lane ^ o) << 2, __builtin_bit_cast(int, sm[q])));
                            sq[q] += __builtin_bit_cast(float, __builtin_amdgcn_ds_bpermute((lane ^ o) << 2, __builtin_bit_cast(int, sq[q]))); }
                    }
                    if (lane < 8) { float m_ = sm[0], q_ = sq[0];
#pragma unroll
                        for (int q = 1; q < 8; ++q) { m_ = lane == q ? sm[q] : m_; q_ = lane == q ? sq[q] : q_; }
                        const float mean = m_ * (1.0f / 1024.0f), var = fmaxf(q_ * (1.0f / 1024.0f) - mean * mean, 0.f);
                        const int r = wave * 16 + rb * 8 + lane; STAT[2 * r] = mean; STAT[2 * r + 1] = 1.0f / sqrtf(var + LN_EPS); }
                }
                __syncthreads();
                u32x4 wv[4], vv[4];
#pragma unroll
                for (int i = 0; i < 4; ++i) { const int q = tid + 512 * i, row = q >> 4, c16 = q & 15;
                    wv[i] = *(const u32x4*)(WSMp + ((size_t)0 * 128 + row) * 128 + c16 * 8);
                    vv[i] = *(const u32x4*)(Zb + (row0 + row) * 2048 + 1024 + 0 * 128 + c16 * 8); }
#pragma unroll 1
                for (int hd = 0; hd < 8; ++hd) {
#pragma unroll
                    for (int i = 0; i < 4; ++i) {
                        const int q = tid + 512 * i, row = q >> 4, c16 = q & 15;
                        *(LAS u32x4*)(WSS + row * 272 + c16 * 16) = wv[i];
                        const u32x4 v4 = vv[i];
                        const float mean = STAT[2 * row], rstd = STAT[2 * row + 1];
                        const float f[8] = {bflo(v4.x), bfhi(v4.x), bflo(v4.y), bfhi(v4.y), bflo(v4.z), bfhi(v4.z), bflo(v4.w), bfhi(v4.w)};
                        const f32x4 g0 = *(const f32x4*)(lng + hd * 128 + c16 * 8), g1 = *(const f32x4*)(lng + hd * 128 + c16 * 8 + 4);
                        const f32x4 b0 = *(const f32x4*)(lnb + hd * 128 + c16 * 8), b1 = *(const f32x4*)(lnb + hd * 128 + c16 * 8 + 4);
                        const float gg[8] = {g0[0], g0[1], g0[2], g0[3], g1[0], g1[1], g1[2], g1[3]}, bb[8] = {b0[0], b0[1], b0[2], b0[3], b1[0], b1[1], b1[2], b1[3]};
#pragma unroll
                        for (int q2 = 0; q2 < 8; ++q2) {
                            const int c = c16 * 8 + q2;
                            const int rho = (c & ~31) | (((c >> 2) & 1) << 4) | (((c >> 3) & 3) << 2) | (c & 3);
                            *(LAS bf16_t*)(VT + rho * 272 + row * 2) = (bf16_t)f2bf((f[q2] - mean) * rstd * gg[q2] + bb[q2]);
                        }
                    }
                    const int hn = hd < 7 ? hd + 1 : 7;
#pragma unroll
                    for (int i = 0; i < 4; ++i) { const int q = tid + 512 * i, row = q >> 4, c16 = q & 15;
                        wv[i] = *(const u32x4*)(WSMp + ((size_t)hn * 128 + row) * 128 + c16 * 8);
                        vv[i] = *(const u32x4*)(Zb + (row0 + row) * 2048 + 1024 + hn * 128 + c16 * 8); }
                    const int t = 16 * wave + fr; const float bst = bs[hd * 128 + t];
                    const size_t rowg = row0 + t;
                    u32x4 uv[4];
#pragma unroll
                    for (int q = 0; q < 4; ++q) uv[q] = *(const u32x4*)(Zb + rowg * 2048 + hd * 128 + 32 * q + 8 * fq);
                    __syncthreads();
                    bf16x8 afr[4];
#pragma unroll
                    for (int ks = 0; ks < 4; ++ks) afr[ks] = *(const LAS bf16x8*)(WSS + (16 * wave + fr) * 272 + (32 * ks + 8 * fq) * 2);
                    f32x4 acc[8];
#pragma unroll
                    for (int tn = 0; tn < 8; ++tn) { acc[tn] = (f32x4){0.f, 0.f, 0.f, 0.f};
#pragma unroll
                        for (int ks = 0; ks < 4; ++ks) { const bf16x8 vfr = *(const LAS bf16x8*)(VT + (16 * tn + fr) * 272 + (32 * ks + 8 * fq) * 2);
                            acc[tn] = __builtin_amdgcn_mfma_f32_16x16x32_bf16(vfr, afr[ks], acc[tn], 0, 0, 0); } }
#pragma unroll
                    for (int q = 0; q < 4; ++q) {
                        const int c0 = hd * 128 + 32 * q + 8 * fq;
                        const u32x4 u4 = uv[q];
                        const f32x4 s0 = acc[2 * q] + bst, s1 = acc[2 * q + 1] + bst;
                        if (FP8_OUTP) { u32x2 o; o.x = pk4_fp8(bflo(u4.x) * s0[0], bfhi(u4.x) * s0[1], bflo(u4.y) * s0[2], bfhi(u4.y) * s0[3]);
                            o.y = pk4_fp8(bflo(u4.z) * s1[0], bfhi(u4.z) * s1[1], bflo(u4.w) * s1[2], bfhi(u4.w) * s1[3]);
                            *(u32x2*)((unsigned char*)YMb + rowg * 1024 + c0) = o; }
                        else { u32x4 o; o.x = pk2(bflo(u4.x) * s0[0], bfhi(u4.x) * s0[1]); o.y = pk2(bflo(u4.y) * s0[2], bfhi(u4.y) * s0[3]);
                        o.z = pk2(bflo(u4.z) * s1[0], bfhi(u4.z) * s1[1]); o.w = pk2(bflo(u4.w) * s1[2], bfhi(u4.w) * s1[3]);
                        *(u32x4*)(YMb + rowg * 1024 + c0) = o; }
                    }
                    __syncthreads();
                }
            }
            SEAM(P + 1);
        }
        if (PHEN(5) && !odd && IN(P + 2)) {
            PH_LOCALS;
            {
                pg8::Gemm g{A2b, (const bf16_t*)(ws + WS_BPOOL) + (size_t)jj * 512 * 512, 1024, 512, 256, 127};
                pg8::DenseSched S; S.init(T, 512, G, bx); S.kblk = 512; S.rowm = (FUSE_LOCAL && G == 256) ? 1 : 0;
                pg8::EpiDense<0, false, true, false, FP8_OUTP != 0> E{YMb, 1024, nullptr, kin(I_POOLS) + jj * 512, 0.f};
                pg8::gemm_phase<false>(lds, g, S, E, wave0);
            }
            {
                pg8::Gemm g{A2b + 512, (const bf16_t*)(ws + WS_BGATE) + (size_t)jj * 1024 * 512, 1024, 512, 256, 127};
                pg8::DenseSched S; S.init(T, 1024, G, bx); S.kblk = 512; S.rowm = (FUSE_LOCAL && G == 256) ? 1 : 0;
                pg8::EpiDense<2, true, false> E{RIb, 1024, (const float*)(ws + WS_BIASRI) + jj * 1024, nullptr, 0.f};
                pg8::gemm_phase<false>(lds, g, S, E, wave0);
            }
            SEAM(P + 2);
        }
        scan_phase<L, 0>(lo, hi, G, bar, wave0); scan_phase<L, 1>(lo, hi, G, bar, wave0);
        if (PHEN(7) && IN(P + 5)) {
            PH_LOCALS;
            const float* bo = odd ? kin(I_SGBOUT) + jj * 1024 : kin(I_ABBOUT) + jj * 1024;
            pg8::DenseSched S; S.init(T, 1024, G, bx);
            if (FP8_OUTP) { const unsigned char* wt = odd ? ws + WS_SGOUT + (size_t)jj * 1024 * 1024 : ws + WS_ABOUT + (size_t)jj * 1024 * 1024;
                pg8::Gemm g{YMb, wt, 1024, 1024, 1024, 121};
                pg8::EpiDense<0, true, false, true> E{Yb, 1024, bo, nullptr, 1.0f / 64.0f};
                pg8::gemm_phase<true>(lds, g, S, E, wave0); }
            else { const bf16_t* wt = odd ? (const bf16_t*)(ws + WS_SGOUT) + (size_t)jj * 1024 * 1024 : (const bf16_t*)(ws + WS_ABOUT) + (size_t)jj * 1024 * 1024;
                pg8::Gemm g{YMb, wt, 1024, 1024, 1024, 127};
                pg8::EpiDense<0, true, false> E{Yb, 1024, bo, nullptr, 0.f};
                pg8::gemm_phase<false>(lds, g, S, E, wave0); }
            SEAM(P + 5);
        }
        ln_phase<L, 0>(lo, hi, G, bar, wave0);
            if (PHEN(9) && IN(P + 7)) {
            PH_LOCALS;
                pg8::Gemm g{ROUTER_X ? (const bf16_t*)(ws + WS_XB) : Hb, ROUTER_X ? (const bf16_t*)(ws + WS_BRB) + (size_t)l * 16 * 64 * 1024 : (const bf16_t*)(ws + WS_BR) + (size_t)l * 256 * 1024, 1024, 1024, 1024, 127};
                pg8::DenseSched S; S.init(T, 256, G, bx); if (ROUTER_X) S.bb = 64;
                pg8::EpiRouter E{LOGf};
                pg8::gemm_phase<false>(lds, g, S, E, wave0);
                LSEAM(P + 7);
            }
            if (PHEN(10) && IN(P + 8)) {
            PH_LOCALS;
                volatile LAS unsigned* hist = LCTL + 96; volatile LAS unsigned* basev = LCTL + 128;
                unsigned* gcnt = ctl + CW_CNT + 64 * l;
                const int TPB = (FUSE_LOCAL && G == 256) ? 256 : 512;
                for (int t0 = vcu * TPB; t0 < T; t0 += G * TPB) {
                    if (tid < 32) hist[tid] = 0u;
                    __syncthreads();
                    const bool act = tid < TPB;
                    const int tok = t0 + (act ? tid : 0);
                    float lv[32];
                    { const f32x4* lp = (const f32x4*)(LOGf + (size_t)tok * 64);
#pragma unroll
                      for (int q = 0; q < 8; ++q) { const f32x4 a = lp[q], b2 = lp[8 + q], rb = ROUTER_X ? *(const f32x4*)((const float*)(ws + WS_CB) + (l * 16 + (t0 >> 12)) * 32 + 4 * q) : *(const f32x4*)(kin(I_RB) + l * 32 + 4 * q);
                          lv[4 * q + 0] = a[0] + b2[0] + rb[0]; lv[4 * q + 1] = a[1] + b2[1] + rb[1]; lv[4 * q + 2] = a[2] + b2[2] + rb[2]; lv[4 * q + 3] = a[3] + b2[3] + rb[3]; } }
                    float v0 = -3.0e38f, v1 = -3.0e38f, v2 = -3.0e38f, v3 = -3.0e38f; int i0 = 0, i1 = 0, i2 = 0, i3 = 0;
#pragma unroll
                    for (int e = 0; e < 32; ++e) {
                        const float x = lv[e];
                        if (x > v3) {
                            if (x > v0) { v3 = v2; i3 = i2; v2 = v1; i2 = i1; v1 = v0; i1 = i0; v0 = x; i0 = e; }
                            else if (x > v1) { v3 = v2; i3 = i2; v2 = v1; i2 = i1; v1 = x; i1 = e; }
                            else if (x > v2) { v3 = v2; i3 = i2; v2 = x; i2 = e; }
                            else { v3 = x; i3 = e; }
                        }
                    }
                    const float e1 = __expf(v1 - v0), e2 = __expf(v2 - v0), e3 = __expf(v3 - v0), inv = 1.0f / (1.0f + e1 + e2 + e3);
                    if (act) *(f32x4*)(TOPG + (size_t)tok * 4) = (f32x4){inv, e1 * inv, e2 * inv, e3 * inv};
                    LAS unsigned* hp = (LAS unsigned*)hist;
                    unsigned r0 = 0u, r1 = 0u, r2 = 0u, r3 = 0u;
                    if (act) { r0 = __hip_atomic_fetch_add(hp + i0, 1u, __ATOMIC_RELAXED, __HIP_MEMORY_SCOPE_WORKGROUP); r1 = __hip_atomic_fetch_add(hp + i1, 1u, __ATOMIC_RELAXED, __HIP_MEMORY_SCOPE_WORKGROUP);
                        r2 = __hip_atomic_fetch_add(hp + i2, 1u, __ATOMIC_RELAXED, __HIP_MEMORY_SCOPE_WORKGROUP); r3 = __hip_atomic_fetch_add(hp + i3, 1u, __ATOMIC_RELAXED, __HIP_MEMORY_SCOPE_WORKGROUP); }
                    __syncthreads();
                    if (tid < 32) basev[tid] = __hip_atomic_fetch_add(gcnt + tid, hist[tid], __ATOMIC_RELAXED, __HIP_MEMORY_SCOPE_AGENT);
                    __syncthreads();
                    if (act) {
                    LIST[(size_t)i0 * TKTOT + basev[i0] + r0] = tok * 4 + 0;
                    LIST[(size_t)i1 * TKTOT + basev[i1] + r1] = tok * 4 + 1;
                    LIST[(size_t)i2 * TKTOT + basev[i2] + r2] = tok * 4 + 2;
                    LIST[(size_t)i3 * TKTOT + basev[i3] + r3] = tok * 4 + 3; }
                    __syncthreads();
                }
                SEAM(P + 8);
            }
            if (PHEN(11) && IN(P + 9)) {
                PH_LOCALS;
                volatile LAS int* cnts = (volatile LAS int*)(LCTL + 16); volatile LAS int* tstart = (volatile LAS int*)(LCTL + 48);
                if (tid < 32) cnts[tid] = (int)__hip_atomic_load(ctl + CW_CNT + 64 * l + tid, __ATOMIC_RELAXED, __HIP_MEMORY_SCOPE_AGENT);
                __syncthreads();
                if (tid == 0) { int s = 0; for (int e = 0; e < 32; ++e) { tstart[e] = s; s += (cnts[e] + 255) >> 8; } tstart[32] = s; }
                __syncthreads();
                LAS int* const utab = (LAS int*)(lds + UTAB_OFF);
                const int nunits = pg8::moe_build_units(utab, tstart, cnts, 8, G, bx, tid);
                __syncthreads();
                pg8::MoeSched S{(const LAS int*)utab, LIST, (const float*)(ws + WS_B1P) + (size_t)l * 32 * 2048, nunits, 2048, 2};
                pg8::EpiMoe1<FP8_M2 != 0> E{FP8_M2 ? (bf16_t*)(ws + WS_ACT8) : ACTb, lds, FP8_M1 ? 1.0f / 32.0f : 1.0f};
                if (FP8_M1) { pg8::Gemm g{ws + WS_H8, ws + WS_W1T8 + (size_t)l * 32 * 2048 * 1024, 1024, 1024, 1024, 122};
                    pg8::gemm_phase<true>(lds, g, S, E, wave0); }
                else { pg8::Gemm g{Hb, (const bf16_t*)(ws + WS_W1T) + (size_t)l * 32 * 2048 * 1024, 1024, 1024, 1024, 127};
                    pg8::gemm_phase<false>(lds, g, S, E, wave0); }
                SEAM(P + 9);
            }
            if (PHEN(12) && IN(P + 10)) {
                PH_LOCALS;
                volatile LAS int* cnts = (volatile LAS int*)(LCTL + 16); volatile LAS int* tstart = (volatile LAS int*)(LCTL + 48);
                __syncthreads();
                if (tid < 32) cnts[tid] = (int)__hip_atomic_load(ctl + CW_CNT + 64 * l + tid, __ATOMIC_RELAXED, __HIP_MEMORY_SCOPE_AGENT);
                __syncthreads();
                if (tid == 0) { int s = 0; for (int e = 0; e < 32; ++e) { tstart[e] = s; s += (cnts[e] + 255) >> 8; } tstart[32] = s; }
                __syncthreads();
                LAS int* const utab = (LAS int*)(lds + UTAB_OFF);
                const int nunits = pg8::moe_build_units(utab, tstart, cnts, 4, G, bx, tid);
                __syncthreads();
                pg8::MoeSched S{(const LAS int*)utab, LIST, kin(I_B2) + (size_t)l * 32 * 1024, nunits, 1024, 0};
                pg8::EpiMoe2 E{YSb, lds, FP8_M2 ? 1.0f / 64.0f : 1.0f};
                if (FP8_M2) { pg8::Gemm g{ws + WS_ACT8, ws + WS_W2T8 + (size_t)l * 32 * 1024 * 1024, 1024, 1024, 1024, 121};
                    pg8::gemm_phase<true>(lds, g, S, E, wave0); }
                else { pg8::Gemm g{ACTb, (const bf16_t*)(ws + WS_W2T) + (size_t)l * 32 * 1024 * 1024, 1024, 1024, 1024, 127};
                    pg8::gemm_phase<false>(lds, g, S, E, wave0); }
                SEAM(P + 10);
            }
        ln_phase<L, 1>(lo, hi, G, bar, wave0);
}

__global__ void __launch_bounds__(512, 2) fwd_kernel(Args args) {
    extern __shared__ __attribute__((aligned(16))) unsigned char lds_raw[];
    LAS unsigned char* const lds = (LAS unsigned char*)lds_raw;
    volatile LAS unsigned* const LCTL = (volatile LAS unsigned*)(lds + LDSCTL_OFF);
    const int G = gridDim.x;
    int lo, hi; unsigned* ctl0;
    { kptr_t kp = (kptr_t)__builtin_amdgcn_kernarg_segment_ptr(); lo = *(const __attribute__((address_space(4))) int*)(kp + 272); hi = *(const __attribute__((address_space(4))) int*)(kp + 276);
      ctl0 = (unsigned*)(*(unsigned char* const __attribute__((address_space(4)))*)(kp + 264) + WS_CTL); }
    const int wave0 = __builtin_amdgcn_readfirstlane((int)threadIdx.x >> 6);
    for (int u = threadIdx.x; u < (LDS_BYTES - LDSCTL_OFF) / 4; u += 512) LCTL[u] = 0u;
    __syncthreads();
    XcdBarrier bar; bar.bar = ctl0 + CW_BAR; bar.x = 0; bar.st = LCTL; bar.wv = wave0;
    if (hi - lo > 1) bar = xcd_barrier_post(ctl0 + CW_BAR, LCTL, wave0);
    if (PHEN(0) && IN(PH_CONV)) {
            PH_LOCALS;
        {
            LAS float* cact = (LAS float*)lds;
            LAS float* part = (LAS float*)(lds + 65536);
            if (bx < 384) {
                for (int i = tid; i < 16 * 1024; i += 512) { const float c = kin(I_C)[i]; cact[i] = c / (1.0f + __expf(-c)); }
                __syncthreads();
                for (int it = bx; it < 384; it += G) {
                    const int ls = it / 48, col0 = (it % 48) * 64;
                    const int kq = tid >> 6, cl = tid & 63;
                    const float* wp = kin(I_MODW) + (size_t)ls * 1024 * 3072 + col0 + cl;
                    float a[16];
#pragma unroll
                    for (int b = 0; b < 16; ++b) a[b] = 0.f;
#pragma unroll 4
                    for (int k = kq * 128; k < kq * 128 + 128; ++k) {
                        const float w = wp[(size_t)k * 3072];
#pragma unroll
                        for (int b = 0; b < 16; ++b) a[b] += cact[b * 1024 + k] * w;
                    }
#pragma unroll
                    for (int b = 0; b < 16; ++b) part[(kq * 16 + b) * 64 + cl] = a[b];
                    __syncthreads();
                    for (int o = tid; o < 1024; o += 512) {
                        const int b = o >> 6, c2 = o & 63; float s = 0.f;
#pragma unroll
                        for (int q = 0; q < 8; ++q) s += part[(q * 16 + b) * 64 + c2];
                        MOD[((size_t)ls * 16 + b) * 3072 + col0 + c2] = s + kin(I_MODB)[ls * 3072 + col0 + c2];
                    }
                    __syncthreads();
                }
            }
        }
        {
            constexpr int IT_ABIN = 2 * (FP8_INP ? 8 : 16) * 48, IT_ABOUT = 2 * (FP8_OUTP ? 8 : 16) * 32, IT_SGIN = 2 * (FP8_INP ? 8 : 16) * 64, IT_SGOUT = 2 * (FP8_OUTP ? 8 : 16) * 32, IT_W1 = 128 * (FP8_M1 ? 8 : 16) * 64, IT_W2 = 128 * (FP8_M2 ? 8 : 16) * 32;
            constexpr int IT_ALL = IT_ABIN + IT_ABOUT + IT_SGIN + IT_SGOUT + IT_W1 + IT_W2;
            for (int it = gw; it < IT_ALL; it += NGW) {
                int r = it;
                if (r < IT_ABIN) { if (FP8_INP) { const int mat = r / (8 * 48); conv_item_f8<false>(kin(I_ABWIN) + (size_t)mat * 1024 * 1536, 1536, ws + WS_ABIN + (size_t)mat * 1536 * 1024, r % (8 * 48), lane, 32.0f); }
                    else { const int mat = r / (16 * 48); conv_item<false>(kin(I_ABWIN) + (size_t)mat * 1024 * 1536, 1536, (bf16_t*)(ws + WS_ABIN) + (size_t)mat * 1536 * 1024, r % (16 * 48), lane); } continue; } r -= IT_ABIN;
                if (r < IT_ABOUT) { if (FP8_OUTP) { const int mat = r / (8 * 32); conv_item_f8<false>(kin(I_ABWOUT) + (size_t)mat * 1024 * 1024, 1024, ws + WS_ABOUT + (size_t)mat * 1024 * 1024, r % (8 * 32), lane, 64.0f); }
                    else { const int mat = r / (16 * 32); conv_item<false>(kin(I_ABWOUT) + (size_t)mat * 1024 * 1024, 1024, (bf16_t*)(ws + WS_ABOUT) + (size_t)mat * 1024 * 1024, r % (16 * 32), lane); } continue; } r -= IT_ABOUT;
                if (r < IT_SGIN) { if (FP8_INP) { const int mat = r / (8 * 64); conv_item_f8<false>(kin(I_SGWIN) + (size_t)mat * 1024 * 2048, 2048, ws + WS_SGIN + (size_t)mat * 2048 * 1024, r % (8 * 64), lane, 32.0f); }
                    else { const int mat = r / (16 * 64); conv_item<false>(kin(I_SGWIN) + (size_t)mat * 1024 * 2048, 2048, (bf16_t*)(ws + WS_SGIN) + (size_t)mat * 2048 * 1024, r % (16 * 64), lane); } continue; } r -= IT_SGIN;
                if (r < IT_SGOUT) { if (FP8_OUTP) { const int mat = r / (8 * 32); conv_item_f8<false>(kin(I_SGWOUT) + (size_t)mat * 1024 * 1024, 1024, ws + WS_SGOUT + (size_t)mat * 1024 * 1024, r % (8 * 32), lane, 64.0f); }
                    else { const int mat = r / (16 * 32); conv_item<false>(kin(I_SGWOUT) + (size_t)mat * 1024 * 1024, 1024, (bf16_t*)(ws + WS_SGOUT) + (size_t)mat * 1024 * 1024, r % (16 * 32), lane); } continue; } r -= IT_SGOUT;
                if (r < IT_W1) {
                    if (FP8_M1) { const int mat = r / (8 * 64); conv_item_f8<true>(kin(I_W1) + (size_t)mat * 1024 * 2048, 2048, ws + WS_W1T8 + (size_t)mat * 2048 * 1024, r % (8 * 64), lane, 32.0f); }
                    else { const int mat = r / (16 * 64); conv_item<true>(kin(I_W1) + (size_t)mat * 1024 * 2048, 2048, (bf16_t*)(ws + WS_W1T) + (size_t)mat * 2048 * 1024, r % (16 * 64), lane); }
                    continue; } r -= IT_W1;
                if (FP8_M2) { const int mat = r / (8 * 32); conv_item_f8<false>(kin(I_W2) + (size_t)mat * 1024 * 1024, 1024, ws + WS_W2T8 + (size_t)mat * 1024 * 1024, r % (8 * 32), lane, 64.0f); }
                else { const int mat = r / (16 * 32); conv_item<false>(kin(I_W2) + (size_t)mat * 1024 * 1024, 1024, (bf16_t*)(ws + WS_W2T) + (size_t)mat * 1024 * 1024, r % (16 * 32), lane); }
            }
        }
        {
            const int gt = vcu * 512 + tid, NGT = G * 512;
            bf16_t* BR = (bf16_t*)(ws + WS_BR);
            if (!ROUTER_X) for (int i = gt; i < 4 * 256 * 1024; i += NGT) {
                const int l = i >> 18, n = (i >> 10) & 255, k = i & 1023; unsigned v = 0;
                if (n < 64) { const float w = kin(I_RW)[((size_t)l * 1024 + k) * 32 + (n & 31)]; const unsigned h = f2bf(w); v = h;
                    if (n >= 32) v = f2bf(w - __builtin_bit_cast(float, h << 16)); }
                BR[i] = (bf16_t)v;
            }
            bf16_t* BP = (bf16_t*)(ws + WS_BPOOL);
            for (int i = gt; i < 2 * 512 * 512; i += NGT) {
                const int j = i >> 18, n = (i >> 9) & 511, k = i & 511; unsigned v = 0;
                if ((n >> 7) == (k >> 7)) v = f2bf(kin(I_POOLW)[(((size_t)j * 4 + (n >> 7)) * 128 + (k & 127)) * 128 + (n & 127)]);
                BP[i] = (bf16_t)v;
            }
            bf16_t* BG = (bf16_t*)(ws + WS_BGATE);
            for (int i = gt; i < 2 * 1024 * 512; i += NGT) {
                const int j = i >> 19, n = (i >> 9) & 1023, k = i & 511; unsigned v = 0; const int nn = n & 511;
                if ((nn >> 6) == (k >> 6)) { const float* w = (n < 512) ? kin(I_WA) : kin(I_WX); v = f2bf(w[(((size_t)j * 8 + (nn >> 6)) * 64 + (k & 63)) * 64 + (nn & 63)]); }
                BG[i] = (bf16_t)v;
            }
            bf16_t* WSMp = (bf16_t*)(ws + WS_WSM);
            for (int i = gt; i < 2 * 8 * 128 * 128; i += NGT) {
                const int t = (i >> 7) & 127, s = i & 127; WSMp[i] = (bf16_t)((s <= t) ? f2bf(kin(I_SGWS)[i]) : 0u);
            }
            float* BRI = (float*)(ws + WS_BIASRI);
            for (int i = gt; i < 2 * 1024; i += NGT) { const int j = i >> 10, n = i & 1023; BRI[i] = (n < 512) ? kin(I_BA)[j * 512 + n] : kin(I_BX)[j * 512 + n - 512]; }
            float* B1P = (float*)(ws + WS_B1P);
            for (int i = gt; i < 4 * 32 * 2048; i += NGT) { const int le = i >> 11, rho = i & 2047; B1P[i] = kin(I_B1)[(size_t)le * 2048 + w1_n_of_rho(rho)]; }
        }
        SEAM(PH_CONV);
    }

    if (PHEN(1) && IN(PH_H0)) {
            PH_LOCALS;
        const int rows_per = T / NGW, r0 = gw * rows_per;
        const int b = r0 / SEQ;
        const float* shp = MOD + ((size_t)0 * 16 + b) * 3072, * scp = shp + 1024;
        f32x4 sh[4], sc[4];
#pragma unroll
        for (int j = 0; j < 4; ++j) { sh[j] = *(const f32x4*)(shp + 4 * (64 * j + lane)); sc[j] = *(const f32x4*)(scp + 4 * (64 * j + lane)); }
        for (int r = r0; r < r0 + rows_per; ++r) {
            const f32x4* xr = (const f32x4*)(kin(I_X) + (size_t)r * D) + lane;
            u32x2* hr = (u32x2*)(Hb + (size_t)r * D) + lane;
#pragma unroll
            for (int j = 0; j < 4; ++j) { const f32x4 v = xr[64 * j]; const f32x4 h = v * (sc[j] + 1.0f) + sh[j];
                if (FP8_INP) ((unsigned*)(ws + WS_H8 + (size_t)r * D) + lane)[64 * j] = pk4_fp8(h[0], h[1], h[2], h[3]);
                else { u32x2 w; w.x = pk2(h[0], h[1]); w.y = pk2(h[2], h[3]); hr[64 * j] = w; } }
        }
        if (ROUTER_X) {
            bf16_t* BRB = (bf16_t*)(ws + WS_BRB);
            const float* rwp = kin(I_RW);
            for (int i = vcu * 512 + tid; i < 4 * 32 * 1024; i += G * 512) {
                const int l = i >> 15, e = (i >> 10) & 31, k = i & 1023;
                const float w = rwp[((size_t)l * 1024 + k) * 32 + e];
#pragma unroll 4
                for (int bq = 0; bq < 16; ++bq) {
                    const float wm = w * (1.0f + MOD[((size_t)(2 * l + 1) * 16 + bq) * 3072 + 1024 + k]);
                    const unsigned h = f2bf(wm), lo2 = f2bf(wm - __builtin_bit_cast(float, h << 16));
                    bf16_t* o = BRB + (((size_t)l * 16 + bq) * 64 + e) * 1024 + k; o[0] = (bf16_t)h; o[32 * 1024] = (bf16_t)lo2; }
            }
            for (int i = vcu * 512 + tid; i < 192 * 1024 / 2; i += G * 512) ((unsigned*)(BRB + (size_t)4 * 16 * 64 * 1024))[i] = 0u;
            const int it = vcu + G * wave;
            if (it < 512) {
                const int l = it >> 7, bq = (it >> 3) & 15, eq = it & 7;
                const float* shq = MOD + ((size_t)(2 * l + 1) * 16 + bq) * 3072;
                const f32x4* rw4 = (const f32x4*)(kin(I_RW) + (size_t)l * 1024 * 32) + eq;
                float sa[4] = {0.f, 0.f, 0.f, 0.f};
#pragma unroll
                for (int i2 = 0; i2 < 16; ++i2) { const int k = lane + 64 * i2; const f32x4 wv4 = rw4[(size_t)k * 8]; const float sk = shq[k]; sa[0] += wv4[0] * sk; sa[1] += wv4[1] * sk; sa[2] += wv4[2] * sk; sa[3] += wv4[3] * sk; }
#pragma unroll
                for (int o = 1; o < 64; o <<= 1) {
#pragma unroll
                    for (int c4 = 0; c4 < 4; ++c4) sa[c4] += __builtin_bit_cast(float, __builtin_amdgcn_ds_bpermute((lane ^ o) << 2, __builtin_bit_cast(int, sa[c4])));
                }
                const f32x4 rb4 = *(const f32x4*)(kin(I_RB) + l * 32 + 4 * eq);
                *(f32x4*)((float*)(ws + WS_CB) + (l * 16 + bq) * 32 + 4 * eq) = (f32x4){sa[0] + rb4[0], sa[1] + rb4[1], sa[2] + rb4[2], sa[3] + rb4[3]};
            }
        }
        SEAM(PH_H0);
    }

    layer_body<0>(lds, LCTL, lo, hi, G, bar, wave0); layer_body<1>(lds, LCTL, lo, hi, G, bar, wave0); layer_body<2>(lds, LCTL, lo, hi, G, bar, wave0); layer_body<3>(lds, LCTL, lo, hi, G, bar, wave0);
}
#undef IN
#undef SEAM

#ifdef DUMP_SPEC
struct DumpSrc { size_t off; int ld; int col0; };
__global__ void dump_kernel(const unsigned char* ws, float* out) {
    const DumpSrc srcs[8] = DUMP_SPEC;
    const size_t i = (size_t)blockIdx.x * blockDim.x + threadIdx.x;
    const int r = (int)(i >> 10), c = (int)(i & 1023), blk = c >> 7, cc = c & 127;
    const DumpSrc d = srcs[blk];
    const bf16_t* p = (const bf16_t*)(ws + d.off);
    out[i] = bf2f(p[(size_t)r * d.ld + d.col0 + cc]);
}
#endif
extern "C" void kernel_launch(void* const* d_in, const int* in_sizes, int n_in, void* d_out, int out_size, void* d_ws, size_t ws_size, hipStream_t stream) {
    static int grid = 0;
    if (grid == 0) {
        if (n_in != 32 || out_size != T * D || ws_size < WS_END) { fprintf(stderr, "kernel_launch: unexpected problem (n_in %d, out %d, ws %zu)\n", n_in, out_size, ws_size); grid = -1; return; }
        int dev = 0, cus = 0, per_cu = 0;
        if (hipGetDevice(&dev) != hipSuccess || hipDeviceGetAttribute(&cus, hipDeviceAttributeMultiprocessorCount, dev) != hipSuccess) { grid = -1; return; }
        if (hipFuncSetAttribute((const void*)fwd_kernel, hipFuncAttributeMaxDynamicSharedMemorySize, LDS_BYTES) != hipSuccess) { fprintf(stderr, "kernel_launch: hipFuncSetAttribute failed\n"); grid = -1; return; }
        if (hipOccupancyMaxActiveBlocksPerMultiprocessor(&per_cu, (const void*)fwd_kernel, 512, LDS_BYTES) != hipSuccess || per_cu < 1) fprintf(stderr, "kernel_launch: occupancy query says %d\n", per_cu);
        (void)hipGetLastError();
        grid = cus;
        if (grid * 8 > T || (T % (grid * 8)) != 0) { fprintf(stderr, "kernel_launch: grid %d does not divide the rows\n", grid); grid = -1; return; }
    }
    if (grid < 0) return;
    (void)hipMemsetAsync((char*)d_ws + WS_CTL, 0, CTL_ZERO_BYTES, stream);
    Args a{};
    for (int i = 0; i < 32; ++i) a.in[i] = (const float*)d_in[i];
    a.out = (float*)d_out; a.ws = (unsigned char*)d_ws;
#if MK_ONE_LAUNCH
    a.ph_lo = 0; a.ph_hi = NPH;
    hipLaunchKernelGGL(fwd_kernel, dim3(grid), dim3(512), LDS_BYTES, stream, a);
#else
#ifndef STOP_PH
#define STOP_PH NPH
#endif
    for (int ph = 0; ph < STOP_PH; ++ph) {
        if (!phase_exists(ph)) continue;
        a.ph_lo = ph; a.ph_hi = ph + 1;
        hipLaunchKernelGGL(fwd_kernel, dim3(grid), dim3(512), LDS_BYTES, stream, a);
#ifdef REP_SLOTS
        { const int slot = ph < PH_L0 ? ph : 2 + (ph - PH_L0) % PH_PER_LAYER; if ((REP_SLOTS >> slot) & 1) {
#ifdef PROBE_VARIANTS
            a.variant = PROBE_VARIANTS;
#endif
            hipLaunchKernelGGL(fwd_kernel, dim3(grid), dim3(512), LDS_BYTES, stream, a); a.variant = 0; } }
#endif
    }
#ifdef DUMP_SPEC
    hipLaunchKernelGGL(dump_kernel, dim3(T * 1024 / 256), dim3(256), 0, stream, (const unsigned char*)d_ws, (float*)d_out);
#endif
#endif
}
```

```cpp
#include <hip/hip_runtime.h>
#include <cstdio>
#include <cstdint>

#ifndef PIN_ACC
#define PIN_ACC 0
#endif
#ifndef FP8_M1
#define FP8_M1 1
#endif
#ifndef FP8_M2
#define FP8_M2 1
#endif
#ifndef FP8_YS
#define FP8_INP_EVEN 0
#define FP8_INP_ODD 1
#define FP8_OUTP 1
#define WIDE_EPI 1
#define FUSE_LOCAL 1
#define ROUTER_X 1
#define FP8_YS 1
#endif
#ifndef MK_ONE_LAUNCH
#define MK_ONE_LAUNCH 1
#endif

#ifndef PHMASK
#define PHMASK 0xFFFFF
#endif
#define PHEN(k) (((PHMASK) >> (k)) & 1)
#define LAS __attribute__((address_space(3)))
#define GAS __attribute__((address_space(1)))
typedef unsigned short bf16_t;
typedef short bf16x8 __attribute__((ext_vector_type(8)));
typedef float f32x4 __attribute__((ext_vector_type(4)));
typedef float f32x2 __attribute__((ext_vector_type(2)));
typedef unsigned u32x4 __attribute__((ext_vector_type(4)));
typedef unsigned u32x2 __attribute__((ext_vector_type(2)));

constexpr int D = 1024, NBATCH = 16, SEQ = 4096, T = NBATCH * SEQ, DEPTH = 4;
constexpr int NE = 32, TOPK = 4, TKTOT = T * TOPK;
constexpr int DPOOL = 512, DREC = 512, DINAB = 1536;
constexpr float LN_EPS = 1e-5f;
constexpr float DN_ALPHA = 1.6817928305074292f;

constexpr size_t MiB = 1ull << 20;
constexpr size_t WS_CTL = 0, CTL_ZERO_BYTES = 1 * MiB;
constexpr size_t WS_MOD = 1 * MiB;
constexpr size_t WS_BR = 3 * MiB;
constexpr size_t WS_BPOOL = 5 * MiB;
constexpr size_t WS_BGATE = 6 * MiB;
constexpr size_t WS_WSM = 8 * MiB;
constexpr size_t WS_BIASRI = 8 * MiB + 512 * 1024;
constexpr size_t WS_B1P = 9 * MiB;
constexpr size_t WS_SUMM = 10 * MiB;
constexpr size_t WS_TOPG = 12 * MiB;
constexpr size_t WS_ABIN = 16 * MiB;
constexpr size_t WS_ABOUT = 22 * MiB;
constexpr size_t WS_SGIN = 26 * MiB;
constexpr size_t WS_SGOUT = 34 * MiB;
constexpr size_t WS_LOG = 40 * MiB;
constexpr size_t WS_LIST = 64 * MiB;
constexpr size_t WS_BRB = 128 * MiB;
constexpr size_t WS_CB = 140 * MiB;
constexpr size_t WS_W1T = 128 * MiB;
constexpr size_t WS_W2T = 640 * MiB;
constexpr size_t WS_H = 896 * MiB;
constexpr size_t WS_Z = 1024 * MiB;
constexpr size_t WS_A2 = 1280 * MiB;
constexpr size_t WS_RI = 1408 * MiB;
constexpr size_t WS_YMIX = 1536 * MiB;
constexpr size_t WS_Y = 1664 * MiB;
constexpr size_t WS_ACT = 1792 * MiB;
constexpr size_t WS_YS = 2304 * MiB;
constexpr size_t WS_W1T8 = 2944 * MiB;
constexpr size_t WS_W2T8 = 3200 * MiB;
constexpr size_t WS_H8 = 3328 * MiB;
constexpr size_t WS_ACT8 = 3392 * MiB;
constexpr size_t WS_XB = 2816 * MiB;
constexpr size_t WS_END = 3648 * MiB;

constexpr int CW_BAR = 4096;
constexpr int CW_CNT = 16384;

constexpr int PH_CONV = 0, PH_H0 = 1, PH_L0 = 2, PH_PER_LAYER = 12, NPH = PH_L0 + PH_PER_LAYER * DEPTH;
__host__ __device__ constexpr bool phase_exists(int ph) {
    if (ph < PH_L0) return true;
    const int l = (ph - PH_L0) / PH_PER_LAYER, s = (ph - PH_L0) % PH_PER_LAYER;
    if ((l & 1) && (s == 2 || s == 3 || s == 4)) return false;
    return true;
}

constexpr int LDS_BYTES = 155648;
constexpr int LDSCTL_OFF = 154624;
constexpr int NXT_OFF = 131072;
constexpr int TAB_OFF = 147456;
constexpr int UTAB_OFF = 153600;

__device__ __forceinline__ unsigned f2bf(float f) { unsigned u = __builtin_bit_cast(unsigned, f); return (u + 0x7fffu + ((u >> 16) & 1u)) >> 16; }
typedef __bf16 bf16v2_t __attribute__((ext_vector_type(2)));
__device__ __forceinline__ unsigned pk2(float lo, float hi) { const f32x2 f = {lo, hi}; return __builtin_bit_cast(unsigned, __builtin_convertvector(f, bf16v2_t)); }
__device__ __forceinline__ float bflo(unsigned w) { return __builtin_bit_cast(float, w << 16); }
__device__ __forceinline__ float bfhi(unsigned w) { return __builtin_bit_cast(float, w & 0xffff0000u); }
__device__ __forceinline__ float bf2f(bf16_t h) { return __builtin_bit_cast(float, ((unsigned)h) << 16); }
__device__ __forceinline__ unsigned cvt_pk_bf16(float lo, float hi) { return pk2(lo, hi); }
__device__ __forceinline__ unsigned pk4_fp8(float a, float b, float c, float d) { int w = 0; w = __builtin_amdgcn_cvt_pk_fp8_f32(a, b, w, false); w = __builtin_amdgcn_cvt_pk_fp8_f32(c, d, w, true); return (unsigned)w; }
__device__ __forceinline__ float fast_sigmoid(float x) { return __builtin_amdgcn_rcpf(1.0f + __builtin_amdgcn_exp2f(-1.4426950408889634f * x)); }
__device__ __forceinline__ float gelu_tanh(float x) { const float u = x * (1.5957691216057308f + 0.07135481627362202f * x * x); return x * fast_sigmoid(u); }
__device__ __forceinline__ f32x2 pk_sigmoid_scaled(f32x2 x, float nk) {
    const f32x2 t = x * nk; f32x2 e; e.x = __builtin_amdgcn_exp2f(t.x); e.y = __builtin_amdgcn_exp2f(t.y);
    const f32x2 d = e + 1.0f; f32x2 r; r.x = __builtin_amdgcn_rcpf(d.x); r.y = __builtin_amdgcn_rcpf(d.y); return r; }
__device__ __forceinline__ f32x2 pk_gelu_tanh(f32x2 x) {
    const f32x2 t = x * ((x * x) * (-0.07135481627362202f * 1.4426950408889634f) + (-1.5957691216057308f * 1.4426950408889634f));
    f32x2 e; e.x = __builtin_amdgcn_exp2f(t.x); e.y = __builtin_amdgcn_exp2f(t.y);
    const f32x2 d = e + 1.0f; f32x2 r; r.x = __builtin_amdgcn_rcpf(d.x); r.y = __builtin_amdgcn_rcpf(d.y); return x * r; }
__device__ __forceinline__ float wave_sum(float v, int lane) {
#pragma unroll
    for (int o = 1; o < 64; o <<= 1) v += __builtin_bit_cast(float, __builtin_amdgcn_ds_bpermute((lane ^ o) << 2, __builtin_bit_cast(int, v)));
    return v;
}

__device__ __forceinline__ int lane_id_asm() { int l; asm volatile("v_mbcnt_lo_u32_b32 %0, -1, 0\n\tv_mbcnt_hi_u32_b32 %0, -1, %0" : "=v"(l)); return l; }
#define XB_TMO      128
#define XB_XCNT(j)  (256  + 64 * (j))
#define XB_XSUB(j)  (1280 + 64 * (j))
#define XB_XGEN(j)  (2304 + 64 * (j))
#define XB_TOP      3328
#define XB_TOPGEN   3392
#define XCD_BAR_WORDS 3456
#define XB_SPIN_CAP (1u << 18)

__device__ __forceinline__ unsigned xb_ld(unsigned* p)              { return __hip_atomic_load(p, __ATOMIC_RELAXED, __HIP_MEMORY_SCOPE_AGENT); }
__device__ __forceinline__ unsigned xb_add(unsigned* p, unsigned v) { return __hip_atomic_fetch_add(p, v, __ATOMIC_RELAXED, __HIP_MEMORY_SCOPE_AGENT); }
__device__ __forceinline__ unsigned xb_xcc_id() { return (unsigned)__builtin_amdgcn_s_getreg((3 << 11) | 20) & 0xFu; }
#define XB_SPIN(cond, bar) do { unsigned _sp = 0; while (cond) { __builtin_amdgcn_s_sleep(1); \
    if ((++_sp & 255u) == 0u) { if (xb_ld(&(bar)[XB_TMO])) break; if (_sp > XB_SPIN_CAP) { atomicAdd(&(bar)[XB_TMO], 1u); break; } } } } while (0)

struct XcdBarrier {
    unsigned* bar; unsigned x; int wv;
    volatile LAS unsigned* st;
};

__device__ __forceinline__ XcdBarrier xcd_barrier_post(unsigned* bar, volatile LAS unsigned* st, int wv) {
    XcdBarrier b; b.bar = bar; b.x = xb_xcc_id(); b.st = st; b.wv = wv;
    if (wv == 0 && lane_id_asm() == 0) (void)xb_add(&bar[XB_XCNT(b.x)], 1u);
    return b;
}
__device__ __forceinline__ void xcd_barrier_complete(unsigned* bar, unsigned x, unsigned& nloc, unsigned& nx) {
    const unsigned G = gridDim.x * gridDim.y * gridDim.z;
    unsigned sum, cnt, mine, sp = 0u;
    for (;;) {
        sum = 0u; cnt = 0u; mine = 0u;
#pragma unroll
        for (unsigned j = 0; j < 16; ++j) { const unsigned c = xb_ld(&bar[XB_XCNT(j)]); sum += c; cnt += (c > 0u) ? 1u : 0u; mine = (j == x) ? c : mine; }
        if (sum == G) break;
        __builtin_amdgcn_s_sleep(1);
        if ((++sp & 255u) == 0u) { if (xb_ld(&bar[XB_TMO])) break; if (sp > XB_SPIN_CAP) { atomicAdd(&bar[XB_TMO], 1u); break; } }
    }
    nloc = mine > 0u ? mine : 1u; nx = cnt > 0u ? cnt : 1u;
}

__device__ __forceinline__ void xcd_barrier(const XcdBarrier& b) {
    asm volatile("s_waitcnt vmcnt(0)" ::: "memory");
    __syncthreads();
    if (b.wv == 0 && lane_id_asm() == 0) {
        unsigned* bar = b.bar;
        __builtin_amdgcn_s_waitcnt(0);
        unsigned nloc = b.st[0], nx = b.st[1];
        if (nloc == 0u) { xcd_barrier_complete(bar, b.x, nloc, nx); b.st[0] = nloc; b.st[1] = nx; }
        const unsigned old = xb_add(&bar[XB_XSUB(b.x)], 1u);
        const unsigned gen = old / nloc;
        if (old + 1u == (gen + 1u) * nloc) {
            __builtin_amdgcn_fence(__ATOMIC_RELEASE, "agent");
            asm volatile("s_waitcnt vmcnt(0)" ::: "memory");
            const unsigned og = xb_add(&bar[XB_TOP], 1u);
            const unsigned tg = og / nx;
            if (og + 1u == (tg + 1u) * nx) xb_add(&bar[XB_TOPGEN], 1u);
            else XB_SPIN(xb_ld(&bar[XB_TOPGEN]) == tg, bar);
            __builtin_amdgcn_fence(__ATOMIC_ACQUIRE, "agent");
            xb_add(&bar[XB_XGEN(b.x)], 1u);
            asm volatile("s_waitcnt vmcnt(0)" ::: "memory");
        } else {
            XB_SPIN(xb_ld(&bar[XB_XGEN(b.x)]) == gen, bar);
            __builtin_amdgcn_fence(__ATOMIC_ACQUIRE, "agent");
            asm volatile("s_waitcnt vmcnt(0)" ::: "memory");
        }
    }
    __syncthreads();
}

#ifdef PROBE_VARIANTS
__device__ __forceinline__ int kvariant() { return *(const __attribute__((address_space(4))) int*)((const __attribute__((address_space(4))) unsigned char*)__builtin_amdgcn_kernarg_segment_ptr() + 280); }
#endif
__device__ __forceinline__ void glds16(const char* sbase, unsigned voff, unsigned lds_dst) {
    unsigned keep;
    asm volatile("s_mov_b32 %0, m0\n\ts_mov_b32 m0, %3\n\ts_nop 0\n\tglobal_load_lds_dwordx4 %1, %2\n\ts_mov_b32 m0, %0" : "=&s"(keep) : "v"(voff), "s"(sbase), "s"(lds_dst) : "memory");
}
__device__ __forceinline__ void glds4(const char* sbase, unsigned voff, unsigned lds_dst) {
    unsigned keep;
    asm volatile("s_mov_b32 %0, m0\n\ts_mov_b32 m0, %3\n\ts_nop 0\n\tglobal_load_lds_dword %1, %2\n\ts_mov_b32 m0, %0" : "=&s"(keep) : "v"(voff), "s"(sbase), "s"(lds_dst) : "memory");
}
namespace pg8 {
constexpr int BM = 256, BK = 64, HALF = 128, HTB = HALF * BK * 2, STAGE_BYTES = 8 * HTB, NXCD = 8, WGM = 8;
__host__ __device__ __forceinline__ int perm32(int rho) { const int n = rho >> 4, i = rho & 15; return 8 * (i >> 2) + 4 * n + (i & 3); }

template <bool F8> __host__ __device__ __forceinline__ int chunk_xor(int r15) { const int rp = (r15 >> 1) & 7; return F8 ? ((rp & 4) | ((rp & 1) << 1) | ((rp >> 1) & 1)) : rp; }
struct Unit { int arow, brow, pn, e, rt, cnt, slot, koff; };
struct Gemm { const void* A; const void* Bt; int lda, ldb, K, wscale; };
typedef int i32x4 __attribute__((ext_vector_type(4)));
typedef int i32x8 __attribute__((ext_vector_type(8)));
__device__ __forceinline__ i32x8 cat8(bf16x8 lo, bf16x8 hi) { return __builtin_shufflevector(__builtin_bit_cast(i32x4, lo), __builtin_bit_cast(i32x4, hi), 0, 1, 2, 3, 4, 5, 6, 7); }

struct DenseSched {
    static constexpr bool GATHER = false;
    int nM, nN, nwg, G, c, kblk = 0, bb = 0, rowm = 0;
    __device__ __forceinline__ void init(int M, int N, int G_, int c_) { nM = M / BM; nN = N / BM; nwg = nM * nN; G = G_; c = c_; }
    __device__ __forceinline__ bool next(int i, Unit& u) const {
        int pm, pn;
        if (rowm) { if (i >= nN) return false; pm = (c % NXCD) * (G / NXCD) + c / NXCD; pn = i; }
        else {
        const long L = (long)i * G + c; if (L >= nwg) return false;
        int wgid = (int)L; { const int q = nwg / NXCD, r = nwg % NXCD, xcd = wgid % NXCD, off = wgid / NXCD; wgid = (xcd < r ? xcd * (q + 1) : r * (q + 1) + (xcd - r) * q) + off; }
        const int nig = WGM * nN, gid = wgid / nig, fm = gid * WGM, gsz = (nM - fm) < WGM ? (nM - fm) : WGM;
        pm = fm + ((wgid % nig) % gsz); pn = (wgid % nig) / gsz; }
        u.arow = pm * BM; u.brow = pn * BM; u.pn = pn; u.e = 0; u.rt = pm; u.cnt = BM; u.slot = 0; u.koff = (pn & 1) * kblk; u.brow += ((pm * BM) >> 12) * bb; return true;
    }
    __device__ __forceinline__ void a_off(const Unit& u, LAS unsigned char*, int R0, int C0, int lda2, unsigned (&off)[2][2]) const {
#pragma unroll
        for (int h = 0; h < 2; ++h)
#pragma unroll
            for (int i = 0; i < 2; ++i) off[h][i] = (unsigned)((u.arow + 128 * h + 64 * i + R0) * lda2 + C0);
    }
};

struct MoeSched {
    static constexpr bool GATHER = true;
    const LAS int* utab;
    const int* list;
    const float* bias;
    int nunits, nexp_rows, shift;
    __device__ __forceinline__ bool next(int i, Unit& u) const {
        if (i >= nunits) return false;
        const LAS int* p = utab + 4 * i;
        u.e = __builtin_amdgcn_readfirstlane(p[0]); u.rt = __builtin_amdgcn_readfirstlane(p[1]); u.pn = __builtin_amdgcn_readfirstlane(p[2]); u.cnt = __builtin_amdgcn_readfirstlane(p[3]);
        u.arow = 0; u.brow = u.e * nexp_rows + u.pn * BM; u.slot = i % 3; u.koff = 0; return true;
    }
    __device__ __forceinline__ void tab_issue(const Unit& u, unsigned ldsb, int wid, int lane) const {
        if (wid < 4) { int p = u.rt * BM + 64 * wid + lane; p = p < u.cnt ? p : u.cnt - 1;
            glds4((const char*)(list + (size_t)u.e * TKTOT), (unsigned)p * 4u, ldsb + TAB_OFF + u.slot * 1024 + wid * 256); }
        else glds4((const char*)(bias + (size_t)u.e * nexp_rows + u.pn * BM), (unsigned)(64 * (wid - 4) + lane) * 4u, ldsb + TAB_OFF + 3072 + u.slot * 1024 + (wid - 4) * 256);
    }
    __device__ __forceinline__ void a_off(const Unit& u, LAS unsigned char* lds, int R0, int C0, int lda2, unsigned (&off)[2][2]) const {
        const LAS int* ids = (const LAS int*)(lds + TAB_OFF + u.slot * 1024);
#pragma unroll
        for (int h = 0; h < 2; ++h)
#pragma unroll
            for (int i = 0; i < 2; ++i) off[h][i] = (unsigned)((ids[128 * h + 64 * i + R0] >> shift) * lda2 + C0);
    }
};
__device__ __forceinline__ int moe_build_units(LAS int* utab, const volatile LAS int* tstart, const volatile LAS int* cnts, int NP, int G, int c, int tid) {
    const int total = tstart[NE] * NP;
    if (tid < 64) { const int L = tid * G + c;
        if (L < total) { int e = 0;
            for (int q = 0; q < NE - 1; ++q) if (tstart[q + 1] * NP <= L) e = q + 1;
            const int t0 = tstart[e], nte = tstart[e + 1] - t0, idx = L - t0 * NP;
            utab[4 * tid + 0] = e; utab[4 * tid + 1] = idx % nte; utab[4 * tid + 2] = idx / nte; utab[4 * tid + 3] = cnts[e]; } }
    return total > c ? (total - c + G - 1) / G : 0;
}

template <int ACT  , bool HAS_BIAS, bool HAS_SCALE, bool OSC = false, bool OUT8 = false> struct EpiDense {
    static constexpr int PERM = WIDE_EPI ? 2 : 1;
    bf16_t* O; int ldc; const float* bias; const float* scale; float oscale;
    __device__ __forceinline__ void operator()(const f32x4 (&acc)[2][2][4][2], const Unit& u, int wr, int wc, int fr, int fq) const {
        const int row0 = u.arow + wr * 64 + fr, col0 = PERM == 2 ? u.pn * BM + wc * 64 + 16 * fq : u.pn * BM + wc * 32 + 8 * fq;
        constexpr int BJS = PERM == 2 ? 8 : HALF;
        f32x4 bv[2][2], sv[2][2];
#pragma unroll
        for (int bj = 0; bj < 2; ++bj)
#pragma unroll
            for (int n = 0; n < 2; ++n) {
                if (HAS_BIAS) bv[bj][n] = *(const f32x4*)(bias + col0 + bj * BJS + 4 * n);
                if (HAS_SCALE) sv[bj][n] = *(const f32x4*)(scale + col0 + bj * BJS + 4 * n);
            }
#pragma unroll
        for (int ai = 0; ai < 2; ++ai)
#pragma unroll
            for (int m = 0; m < 4; ++m) { bf16_t* rowp = O + (size_t)(row0 + ai * HALF + m * 16) * ldc + col0; unsigned char* rowp8 = (unsigned char*)O + (size_t)(row0 + ai * HALF + m * 16) * ldc + col0;
                u32x4 w8;
#pragma unroll
                for (int bj = 0; bj < 2; ++bj) { f32x4 v0 = acc[ai][bj][m][0], v1 = acc[ai][bj][m][1];
                    if (OSC) { v0 = v0 * oscale; v1 = v1 * oscale; }
                    if (HAS_BIAS) { v0 = v0 + bv[bj][0]; v1 = v1 + bv[bj][1]; }
                    if (ACT == 1) { const f32x2 a = pk_gelu_tanh((f32x2){v0[0], v0[1]}), b = pk_gelu_tanh((f32x2){v0[2], v0[3]}), c = pk_gelu_tanh((f32x2){v1[0], v1[1]}), d = pk_gelu_tanh((f32x2){v1[2], v1[3]});
                        v0 = (f32x4){a.x, a.y, b.x, b.y}; v1 = (f32x4){c.x, c.y, d.x, d.y}; }
                    if (ACT == 2) { const float nk = -1.4426950408889634f;
                        const f32x2 a = pk_sigmoid_scaled((f32x2){v0[0], v0[1]}, nk), b = pk_sigmoid_scaled((f32x2){v0[2], v0[3]}, nk), c = pk_sigmoid_scaled((f32x2){v1[0], v1[1]}, nk), d = pk_sigmoid_scaled((f32x2){v1[2], v1[3]}, nk);
                        v0 = (f32x4){a.x, a.y, b.x, b.y}; v1 = (f32x4){c.x, c.y, d.x, d.y}; }
                    if (HAS_SCALE) { v0 = v0 * sv[bj][0]; v1 = v1 * sv[bj][1]; }
                    if constexpr (OUT8) { const unsigned p0 = pk4_fp8(v0[0], v0[1], v0[2], v0[3]), p1 = pk4_fp8(v1[0], v1[1], v1[2], v1[3]);
                        if constexpr (PERM == 2) { if (bj == 0) { w8.x = p0; w8.y = p1; } else { w8.z = p0; w8.w = p1; *(u32x4*)rowp8 = w8; } }
                        else { u32x2 w; w.x = p0; w.y = p1; *(u32x2*)(rowp8 + bj * HALF) = w; } }
                    else { u32x4 w; w.x = cvt_pk_bf16(v0[0], v0[1]); w.y = cvt_pk_bf16(v0[2], v0[3]); w.z = cvt_pk_bf16(v1[0], v1[1]); w.w = cvt_pk_bf16(v1[2], v1[3]);
                    *(u32x4*)(rowp + bj * BJS) = w; } } }
    }
};
struct EpiRouter {
    static constexpr int PERM = 0;
    float* LOG;
    __device__ __forceinline__ void operator()(const f32x4 (&acc)[2][2][4][2], const Unit& u, int wr, int wc, int fr, int fq) const {
        if (wc < 2) {
#pragma unroll
            for (int ai = 0; ai < 2; ++ai)
#pragma unroll
                for (int m = 0; m < 4; ++m) { float* rowp = LOG + (size_t)(u.arow + ai * HALF + wr * 64 + m * 16 + fr) * 64 + wc * 32 + 4 * fq;
#pragma unroll
                    for (int n = 0; n < 2; ++n) *(f32x4*)(rowp + 16 * n) = acc[ai][0][m][n]; }
        }
    }
};
template <bool OUT8> struct EpiMoe1 {
    static constexpr int PERM = 0;
    bf16_t* ACT; LAS unsigned char* lds; float oscale;
    __device__ __forceinline__ void operator()(const f32x4 (&acc)[2][2][4][2], const Unit& u, int wr, int wc, int fr, int fq) const {
        const LAS int* ids = (const LAS int*)(lds + TAB_OFF + u.slot * 1024);
        const LAS float* bp = (const LAS float*)(lds + TAB_OFF + 3072 + u.slot * 1024) + wc * 32 + 4 * fq;
        f32x4 bg[2], bl[2];
#pragma unroll
        for (int bj = 0; bj < 2; ++bj) { bg[bj] = *(const LAS f32x4*)(bp + bj * HALF); bl[bj] = *(const LAS f32x4*)(bp + bj * HALF + 16) + 1.0f; }
        const int j0 = u.pn * 128 + wc * 32 + 8 * fq;
#pragma unroll
        for (int ai = 0; ai < 2; ++ai)
#pragma unroll
            for (int m = 0; m < 4; ++m) {
                const int pl = ai * HALF + wr * 64 + m * 16 + fr;
                if (u.rt * BM + pl < u.cnt) {
                    const int flat = ids[pl];
                    float o[8];
#pragma unroll
                    for (int bj = 0; bj < 2; ++bj) { const f32x4 g = acc[ai][bj][m][0] * oscale + bg[bj], l = acc[ai][bj][m][1] * oscale + bl[bj];
#pragma unroll
                        for (int hh = 0; hh < 2; ++hh) {
                            const f32x2 xg = {fminf(g[2 * hh], 7.0f), fminf(g[2 * hh + 1], 7.0f)};
                            const f32x2 xl = {__builtin_amdgcn_fmed3f(l[2 * hh], -6.0f, 8.0f), __builtin_amdgcn_fmed3f(l[2 * hh + 1], -6.0f, 8.0f)};
                            const f32x2 r = pk_sigmoid_scaled(xg, -1.702f * 1.4426950408889634f), oo = (xg * xl) * r;
                            o[bj * 4 + 2 * hh] = oo.x; o[bj * 4 + 2 * hh + 1] = oo.y; } }
                    if constexpr (OUT8) { u32x2 w; w.x = pk4_fp8(o[0], o[1], o[2], o[3]); w.y = pk4_fp8(o[4], o[5], o[6], o[7]);
                        *(u32x2*)((unsigned char*)ACT + (size_t)flat * 1024 + j0) = w; }
                    else { u32x4 w; w.x = cvt_pk_bf16(o[0], o[1]); w.y = cvt_pk_bf16(o[2], o[3]); w.z = cvt_pk_bf16(o[4], o[5]); w.w = cvt_pk_bf16(o[6], o[7]);
                        *(u32x4*)(ACT + (size_t)flat * 1024 + j0) = w; }
                }
            }
    }
};
struct EpiMoe2 {
    static constexpr int PERM = (WIDE_EPI && FP8_YS) ? 2 : 1;
    bf16_t* YS; LAS unsigned char* lds; float oscale;
    __device__ __forceinline__ void operator()(const f32x4 (&acc)[2][2][4][2], const Unit& u, int wr, int wc, int fr, int fq) const {
        const LAS int* ids = (const LAS int*)(lds + TAB_OFF + u.slot * 1024);
        if constexpr (PERM == 2) {
            const LAS float* bp = (const LAS float*)(lds + TAB_OFF + 3072 + u.slot * 1024) + wc * 64 + 16 * fq;
            const int col0 = u.pn * BM + wc * 64 + 16 * fq;
            const float os = 16.0f * oscale;
#pragma unroll
            for (int ai = 0; ai < 2; ++ai) {
                const f32x4 b00 = *(const LAS f32x4*)(bp) * 16.0f, b01 = *(const LAS f32x4*)(bp + 4) * 16.0f, b10 = *(const LAS f32x4*)(bp + 8) * 16.0f, b11 = *(const LAS f32x4*)(bp + 12) * 16.0f;
#pragma unroll
                for (int m = 0; m < 4; ++m) {
                    const int pl = ai * HALF + wr * 64 + m * 16 + fr;
                    if (u.rt * BM + pl < u.cnt) {
                        const int flat = ids[pl];
                        const f32x4 v00 = acc[ai][0][m][0] * os + b00, v01 = acc[ai][0][m][1] * os + b01, v10 = acc[ai][1][m][0] * os + b10, v11 = acc[ai][1][m][1] * os + b11;
                        u32x4 w; w.x = pk4_fp8(v00[0], v00[1], v00[2], v00[3]); w.y = pk4_fp8(v01[0], v01[1], v01[2], v01[3]); w.z = pk4_fp8(v10[0], v10[1], v10[2], v10[3]); w.w = pk4_fp8(v11[0], v11[1], v11[2], v11[3]);
                        *(u32x4*)((unsigned char*)YS + (size_t)flat * 1024 + col0) = w;
                    }
                }
            }
        } else {
        const LAS float* bp = (const LAS float*)(lds + TAB_OFF + 3072 + u.slot * 1024) + wc * 32 + 8 * fq;
        const int col0 = u.pn * BM + wc * 32 + 8 * fq;
#pragma unroll
        for (int bj = 0; bj < 2; ++bj) {
            const float os = FP8_YS ? 16.0f * oscale : oscale;
            const f32x4 b0 = *(const LAS f32x4*)(bp + bj * HALF) * (FP8_YS ? 16.0f : 1.0f), b1 = *(const LAS f32x4*)(bp + bj * HALF + 4) * (FP8_YS ? 16.0f : 1.0f);
#pragma unroll
            for (int ai = 0; ai < 2; ++ai)
#pragma unroll
                for (int m = 0; m < 4; ++m) {
                    const int pl = ai * HALF + wr * 64 + m * 16 + fr;
                    if (u.rt * BM + pl < u.cnt) {
                        const int flat = ids[pl];
                        const f32x4 v0 = acc[ai][bj][m][0] * os + b0, v1 = acc[ai][bj][m][1] * os + b1;
                        if (FP8_YS) { u32x2 w; w.x = pk4_fp8(v0[0], v0[1], v0[2], v0[3]); w.y = pk4_fp8(v1[0], v1[1], v1[2], v1[3]);
                            *(u32x2*)((unsigned char*)YS + (size_t)flat * 1024 + col0 + bj * HALF) = w; }
                        else { u32x4 w; w.x = cvt_pk_bf16(v0[0], v0[1]); w.y = cvt_pk_bf16(v0[2], v0[3]); w.z = cvt_pk_bf16(v1[0], v1[1]); w.w = cvt_pk_bf16(v1[2], v1[3]);
                            *(u32x4*)(YS + (size_t)flat * 1024 + col0 + bj * HALF) = w; }
                    }
                }
        }
        }
    }
};

template <bool F8, class Epi, class Sched>
__device__ __forceinline__ void gemm_phase(LAS unsigned char* lds, const Gemm g, const Sched& S, const Epi& E, const int wave0) {
    const int tid = (wave0 << 6) | lane_id_asm();
    const int wid = __builtin_amdgcn_readfirstlane(tid >> 6), lane = tid & 63, wr = wid >> 2, wc = wid & 3, fr = lane & 15, fq = lane >> 4;
    constexpr unsigned ESZ = F8 ? 1u : 2u;
    const int nt = (int)((unsigned)g.K * ESZ / 128u);
    int R0, C0;
    R0 = 8 * wid + (lane >> 3); C0 = 16 * ((lane & 7) ^ chunk_xor<F8>(R0 & 15));
    const unsigned lda2 = (unsigned)g.lda * ESZ, ldb2 = (unsigned)g.ldb * ESZ;
    const unsigned voffB = (unsigned)((Epi::PERM == 2 ? (64 * (R0 >> 5) + 16 * ((R0 >> 2) & 3) + 4 * ((R0 >> 4) & 1) + (R0 & 3)) : Epi::PERM == 1 ? ((R0 & ~31) + perm32(R0 & 31)) : R0) * (int)ldb2 + C0);
    constexpr int PIECE_B = Epi::PERM == 2 ? 128 : 64;
    const unsigned aoffl = (unsigned)(R0 * (int)lda2 + C0);
    const unsigned kstep = 128;
    const size_t hstepB = (size_t)(Epi::PERM == 2 ? 8 : HALF) * ldb2;
    const unsigned ldsw = (unsigned)wid * 1024u;
    const int ab = fr * 128 + 16 * ((F8 ? 2 * fq : fq) ^ chunk_xor<F8>(fr));
    const int aoff0 = wr * 8192 + ab, boff0 = wc * 4096 + ab;
    constexpr int KX = F8 ? 16 : 64;
    const char* const Abase = (const char*)g.A;
    const unsigned ldsb = (unsigned)(size_t)lds;
#define PG8_SA(b, h) (((b) * 2 + (h)) * HTB)
#define PG8_SB(b, h) ((4 + (b) * 2 + (h)) * HTB)
#define PG8_GOFF(h, NXT) do { if constexpr (Sched::GATHER) go = *(const LAS u32x2*)(lds + NXT_OFF + ((((NXT) ? ui + 1 : ui) & 1) << 13) + tid * 16 + (h) * 8); } while (0)
#define PG8_STAGE_A(bufoff, h, NXT, kb) do { _Pragma("unroll") for (int _i = 0; _i < 2; ++_i) { \
        if constexpr (Sched::GATHER) glds16(Abase + (kb), _i ? go.y : go.x, ldsb + (bufoff) + ldsw + _i * 8192); \
        else glds16(Abase + ((NXT) ? nxtA : curA) + (size_t)((h) * 128 + _i * 64) * lda2 + (kb), aoffl, ldsb + (bufoff) + ldsw + _i * 8192); } } while (0)
#define PG8_STAGE_B(bufoff, bptr, kb) do { _Pragma("unroll") for (int _i = 0; _i < 2; ++_i) \
        glds16((bptr) + (size_t)(_i * PIECE_B) * ldb2 + (kb), voffB, ldsb + (bufoff) + ldsw + _i * 8192); } while (0)
#define PG8_LDA(dst, b, h) do { int _a1 = aoff0 ^ KX; asm volatile("" : "+v"(_a1)); \
        _Pragma("unroll") for (int m = 0; m < 4; ++m) _Pragma("unroll") for (int k = 0; k < 2; ++k) dst[m][k] = *(const LAS bf16x8*)(lds + PG8_SA(b, h) + (k ? _a1 : aoff0) + m * 2048); } while (0)
#define PG8_LDB(dst, b, h) do { int _b1 = boff0 ^ KX; asm volatile("" : "+v"(_b1)); \
        _Pragma("unroll") for (int n = 0; n < 2; ++n) _Pragma("unroll") for (int k = 0; k < 2; ++k) dst[n][k] = *(const LAS bf16x8*)(lds + PG8_SB(b, h) + (k ? _b1 : boff0) + n * 2048); } while (0)
#define PG8_MMA(ai, bj, At, Bt) do { __builtin_amdgcn_s_setprio(1); _Pragma("unroll") for (int m = 0; m < 4; ++m) _Pragma("unroll") for (int n = 0; n < 2; ++n) { \
        if constexpr (F8) acc[ai][bj][m][n] = __builtin_amdgcn_mfma_scale_f32_16x16x128_f8f6f4(cat8(Bt[n][0], Bt[n][1]), cat8(At[m][0], At[m][1]), acc[ai][bj][m][n], 0, 0, 0, 0, 0, 0); \
        else { _Pragma("unroll") for (int k = 0; k < 2; ++k) acc[ai][bj][m][n] = __builtin_amdgcn_mfma_f32_16x16x32_bf16(Bt[n][k], At[m][k], acc[ai][bj][m][n], 0, 0, 0); } } \
        __builtin_amdgcn_s_setprio(0); } while (0)
#define PG8_WAIT_V(n) asm volatile("s_waitcnt vmcnt(" #n ")" ::: "memory")
#define PG8_WAIT_L(n) asm volatile("s_waitcnt lgkmcnt(" #n ")" ::: "memory")
#define PG8_BAR __builtin_amdgcn_s_barrier()
#define PG8_SCHED __builtin_amdgcn_sched_barrier(0)
#define PG8_KITER(k1, b2, NXT, k2, k3) do { \
        PG8_GOFF(1, 0); PG8_LDB(B0, 0, 0); PG8_LDB(B1, 0, 1); PG8_SCHED; PG8_LDA(At, 0, 0); PG8_STAGE_A(PG8_SA(1, 1), 1, 0, (k1)); \
        PG8_WAIT_V(8); PG8_WAIT_L(0); PG8_BAR; PG8_MMA(0, 0, At, B0); PG8_MMA(0, 1, At, B1); PG8_BAR; PG8_SCHED; \
        PG8_GOFF(0, NXT); PG8_LDA(At, 0, 1); PG8_STAGE_B(PG8_SB(0, 0), (b2), (k2)); PG8_STAGE_B(PG8_SB(0, 1), (b2) + hstepB, (k2)); PG8_STAGE_A(PG8_SA(0, 0), 0, NXT, (k2)); \
        PG8_WAIT_V(8); PG8_WAIT_L(0); PG8_BAR; PG8_MMA(1, 0, At, B0); PG8_MMA(1, 1, At, B1); PG8_BAR; PG8_SCHED; \
        PG8_GOFF(1, NXT); PG8_LDB(B0, 1, 0); PG8_LDB(B1, 1, 1); PG8_SCHED; PG8_LDA(At, 1, 0); PG8_STAGE_A(PG8_SA(0, 1), 1, NXT, (k2)); \
        PG8_WAIT_V(8); PG8_WAIT_L(0); PG8_BAR; PG8_MMA(0, 0, At, B0); PG8_MMA(0, 1, At, B1); PG8_BAR; PG8_SCHED; \
        PG8_GOFF(0, NXT); PG8_LDA(At, 1, 1); PG8_STAGE_B(PG8_SB(1, 0), (b2), (k3)); PG8_STAGE_B(PG8_SB(1, 1), (b2) + hstepB, (k3)); PG8_STAGE_A(PG8_SA(1, 0), 0, NXT, (k3)); \
        PG8_WAIT_V(8); PG8_WAIT_L(0); PG8_BAR; PG8_MMA(1, 0, At, B0); PG8_MMA(1, 1, At, B1); PG8_BAR; PG8_SCHED; } while (0)

    Unit cur, nxt; int ui = 0;
    if (!S.next(0, cur)) return;
    unsigned curoff[2][2], nxtoff[2][2];
    size_t curA = 0, nxtA = 0;
    bool has_next = S.next(1, nxt);
#define PG8_NXT_SLOT ((LAS u32x4*)(lds + NXT_OFF) + tid)
    if constexpr (Sched::GATHER) {
        S.tab_issue(cur, ldsb, wid, lane); if (has_next) S.tab_issue(nxt, ldsb, wid, lane);
        asm volatile("s_waitcnt vmcnt(0)" ::: "memory"); __builtin_amdgcn_s_barrier(); asm volatile("" ::: "memory");
        S.a_off(cur, lds, R0, C0, (int)lda2, curoff);
        if (has_next) S.a_off(nxt, lds, R0, C0, (int)lda2, nxtoff);
        else {
#pragma unroll
            for (int h = 0; h < 2; ++h)
#pragma unroll
                for (int i = 0; i < 2; ++i) nxtoff[h][i] = curoff[h][i]; }
        ((LAS u32x4*)(lds + NXT_OFF))[tid] = (u32x4){curoff[0][0], curoff[0][1], curoff[1][0], curoff[1][1]};
        ((LAS u32x4*)(lds + NXT_OFF + 8192))[tid] = (u32x4){nxtoff[0][0], nxtoff[0][1], nxtoff[1][0], nxtoff[1][1]};
    } else { curA = (size_t)cur.arow * lda2 + cur.koff; nxtA = has_next ? (size_t)nxt.arow * lda2 + nxt.koff : curA; }
    f32x4 acc[2][2][4][2];
#pragma unroll
    for (int a = 0; a < 2; ++a)
#pragma unroll
        for (int b = 0; b < 2; ++b)
#pragma unroll
            for (int m = 0; m < 4; ++m)
#pragma unroll
                for (int n = 0; n < 2; ++n) acc[a][b][m][n] = (f32x4){0.f, 0.f, 0.f, 0.f};
    bf16x8 At[4][2], B0[2][2], B1[2][2];
    const char* cB = (const char*)g.Bt + (size_t)cur.brow * ldb2 + cur.koff;
    u32x2 go = {0u, 0u};
    PG8_STAGE_B(PG8_SB(0, 0), cB, 0u); PG8_STAGE_B(PG8_SB(0, 1), cB + hstepB, 0u); PG8_GOFF(0, 0); PG8_STAGE_A(PG8_SA(0, 0), 0, 0, 0u); PG8_GOFF(1, 0); PG8_STAGE_A(PG8_SA(0, 1), 1, 0, 0u);
    if (wr == 1) PG8_BAR;
    PG8_WAIT_V(2); PG8_BAR;
    PG8_GOFF(0, 0); PG8_STAGE_B(PG8_SB(1, 0), cB, kstep); PG8_STAGE_A(PG8_SA(1, 0), 0, 0, kstep); PG8_STAGE_B(PG8_SB(1, 1), cB + hstepB, kstep);
    PG8_WAIT_V(6); PG8_BAR;
    for (;;) {
        const char* nB = has_next ? (const char*)g.Bt + (size_t)nxt.brow * ldb2 + nxt.koff : cB;
        Unit u2; bool has2 = false;
        if constexpr (Sched::GATHER) has2 = has_next && S.next(ui + 2, u2);
#pragma unroll 1
        for (int t = 0; t < nt - 2; t += 2) {
            const unsigned k1 = (unsigned)(t + 1) * kstep, k2 = (unsigned)(t + 2) * kstep, k3 = (unsigned)(t + 3) * kstep;
            if constexpr (Sched::GATHER) { if (t == 2 && has2) S.tab_issue(u2, ldsb, wid, lane); }
            PG8_KITER(k1, cB, 0, k2, k3);
        }
        { const unsigned k1 = (unsigned)(nt - 1) * kstep; PG8_KITER(k1, nB, 1, 0u, kstep); }
#if PIN_ACC
#pragma unroll
        for (int a = 0; a < 2; ++a)
#pragma unroll
            for (int b = 0; b < 2; ++b)
#pragma unroll
                for (int m = 0; m < 4; ++m) asm volatile("" : "+v"(acc[a][b][m][0]), "+v"(acc[a][b][m][1]));
#endif
        if (wr == 0) PG8_BAR;
#ifdef PROBE_VARIANTS
        if (!(kvariant() & 4))
#endif
        { const int l2 = lane_id_asm(); E(acc, cur, wr, wc, l2 & 15, l2 >> 4); }
        if (!has_next) break;
#pragma unroll
        for (int a = 0; a < 2; ++a)
#pragma unroll
            for (int b = 0; b < 2; ++b)
#pragma unroll
                for (int m = 0; m < 4; ++m)
#pragma unroll
                    for (int n = 0; n < 2; ++n) acc[a][b][m][n] = (f32x4){0.f, 0.f, 0.f, 0.f};
        cur = nxt; cB = nB; ++ui; curA = nxtA;
        has_next = S.next(ui + 1, nxt);
        if (has_next) {
            if constexpr (Sched::GATHER) { const int tz = (wave0 << 6) | lane_id_asm(); int R0z, C0z;
                { const int lz = tz & 63; R0z = 8 * wid + (lz >> 3); C0z = 16 * ((lz & 7) ^ chunk_xor<F8>(R0z & 15)); }
                S.a_off(nxt, lds, R0z, C0z, (int)lda2, nxtoff);
                ((LAS u32x4*)(lds + NXT_OFF + (((ui + 1) & 1) << 13)))[tz] = (u32x4){nxtoff[0][0], nxtoff[0][1], nxtoff[1][0], nxtoff[1][1]}; }
            else nxtA = (size_t)nxt.arow * lda2 + nxt.koff;
        } else if constexpr (Sched::GATHER) { const int tz = (wave0 << 6) | lane_id_asm();
            ((LAS u32x4*)(lds + NXT_OFF + (((ui + 1) & 1) << 13)))[tz] = ((const LAS u32x4*)(lds + NXT_OFF + ((ui & 1) << 13)))[tz]; }
        if (wr == 1) PG8_BAR;
    }
    PG8_WAIT_V(0);
    PG8_BAR;
#undef PG8_SA
#undef PG8_SB
#undef PG8_STAGE_A
#undef PG8_GOFF
#undef PG8_STAGE_B
#undef PG8_LDA
#undef PG8_LDB
#undef PG8_MMA
#undef PG8_WAIT_V
#undef PG8_WAIT_L
#undef PG8_BAR
#undef PG8_SCHED
#undef PG8_KITER
#undef PG8_NXT_SLOT
}
}

struct Args { const float* in[32]; float* out; unsigned char* ws; int ph_lo, ph_hi, variant, pad; };
typedef const __attribute__((address_space(4))) unsigned char* kptr_t;
__device__ __forceinline__ const float* kin(int i) { kptr_t p = (kptr_t)__builtin_amdgcn_kernarg_segment_ptr(); asm volatile("" : "+s"(p)); return *(const float* const __attribute__((address_space(4)))*)(p + 8 * i); }
enum { I_X = 0, I_C, I_MODW, I_MODB, I_LNG, I_LNB, I_ABWIN, I_POOLW, I_POOLS, I_CONVW, I_CONVB, I_WA, I_BA, I_WX, I_BX, I_LAM, I_ABWOUT, I_ABBOUT,
       I_SGWIN, I_SGBIN, I_SGLNG, I_SGLNB, I_SGWS, I_SGBS, I_SGWOUT, I_SGBOUT, I_RW, I_RB, I_W1, I_B1, I_W2, I_B2 };

__device__ __forceinline__ int w1_rho(int n) { const int nn = n & 1, j = n >> 1; return ((j >> 7) << 8) | (((j >> 2) & 1) << 7) | (((j >> 5) & 3) << 5) | (nn << 4) | (((j >> 3) & 3) << 2) | (j & 3); }
__device__ __forceinline__ int w1_n_of_rho(int rho) { const int pn = rho >> 8, bj = (rho >> 7) & 1, wc = (rho >> 5) & 3, nn = (rho >> 4) & 1, fq = (rho >> 2) & 3, i = rho & 3; return 2 * (128 * pn + 32 * wc + 8 * fq + 4 * bj + i) + nn; }
template <bool W1MAP>
__device__ __forceinline__ void conv_item(const float* W, int N, bf16_t* WT, int item, int lane) {
    const int nblk = N >> 5, kb = item / nblk, nb = item - kb * nblk;
    const int kg = lane >> 3, nl = lane & 7, k0 = kb * 64 + kg * 8, n0 = nb * 32 + nl * 4;
    f32x4 v[8];
#pragma unroll
    for (int q = 0; q < 8; ++q) v[q] = *(const f32x4*)(W + (size_t)(k0 + q) * N + n0);
#pragma unroll
    for (int i = 0; i < 4; ++i) {
        const int n = n0 + i, row = W1MAP ? w1_rho(n) : n;
        u32x4 o; o.x = pk2(v[0][i], v[1][i]); o.y = pk2(v[2][i], v[3][i]); o.z = pk2(v[4][i], v[5][i]); o.w = pk2(v[6][i], v[7][i]);
        *(u32x4*)(WT + (size_t)row * 1024 + k0) = o;
    }
}

template <bool W1MAP>
__device__ __forceinline__ void conv_item_f8(const float* W, int N, unsigned char* WT8, int item, int lane, float scale) {
    const int nblk = N >> 5, kb = item / nblk, nb = item - kb * nblk;
    const int kg = lane >> 3, nl = lane & 7, k0 = kb * 128 + kg * 16, n0 = nb * 32 + nl * 4;
    f32x4 v[16];
#pragma unroll
    for (int q = 0; q < 16; ++q) v[q] = *(const f32x4*)(W + (size_t)(k0 + q) * N + n0) * scale;
#pragma unroll
    for (int i = 0; i < 4; ++i) {
        const int n = n0 + i, row = W1MAP ? w1_rho(n) : n;
        u32x4 o; o.x = pk4_fp8(v[0][i], v[1][i], v[2][i], v[3][i]); o.y = pk4_fp8(v[4][i], v[5][i], v[6][i], v[7][i]);
        o.z = pk4_fp8(v[8][i], v[9][i], v[10][i], v[11][i]); o.w = pk4_fp8(v[12][i], v[13][i], v[14][i], v[15][i]);
        *(u32x4*)(WT8 + (size_t)row * 1024 + k0) = o;
    }
}

#define IN(k) (lo <= (k) && (k) < hi)
#define SEAM(k) do { if ((k) + 1 < hi) xcd_barrier(bar); } while (0)
#define LSEAM(k) do { if ((k) + 1 < hi) { if (FUSE_LOCAL && G == 256) { __builtin_amdgcn_fence(__ATOMIC_RELEASE, "workgroup"); __syncthreads(); __builtin_amdgcn_fence(__ATOMIC_ACQUIRE, "workgroup"); } else xcd_barrier(bar); } } while (0)
#define PH_LOCALS \
    const int tid = (wave0 << 6) | lane_id_asm(); \
    const int lane = tid & 63, wave = wave0; \
    int bx = blockIdx.x; asm volatile("" : "+s"(bx)); \
    const int vcu = (G % 8 == 0) ? (bx % 8) * (G / 8) + bx / 8 : bx; \
    const int gw = vcu * 8 + wave, NGW = G * 8; \
    unsigned char* ws; { kptr_t kp_ = (kptr_t)__builtin_amdgcn_kernarg_segment_ptr(); asm volatile("" : "+s"(kp_)); ws = *(unsigned char* const __attribute__((address_space(4)))*)(kp_ + 264); } \
    float* Xf; { kptr_t kp_ = (kptr_t)__builtin_amdgcn_kernarg_segment_ptr(); asm volatile("" : "+s"(kp_)); Xf = *(float* const __attribute__((address_space(4)))*)(kp_ + 256); } \
    unsigned* const ctl = (unsigned*)(ws + WS_CTL); \
    float* const MOD = (float*)(ws + WS_MOD); bf16_t* const Hb = (bf16_t*)(ws + WS_H); bf16_t* const Zb = (bf16_t*)(ws + WS_Z); bf16_t* const A2b = (bf16_t*)(ws + WS_A2); \
    bf16_t* const RIb = (bf16_t*)(ws + WS_RI); bf16_t* const YMb = (bf16_t*)(ws + WS_YMIX); bf16_t* const Yb = (bf16_t*)(ws + WS_Y); bf16_t* const ACTb = (bf16_t*)(ws + WS_ACT); \
    bf16_t* const YSb = (bf16_t*)(ws + WS_YS); float* const LOGf = (float*)(ws + WS_LOG); float* const TOPG = (float*)(ws + WS_TOPG); int* const LIST = (int*)(ws + WS_LIST); \
    float* const SUMM = (float*)(ws + WS_SUMM); \
    (void)lane; (void)wave; (void)gw; (void)NGW; (void)ctl; (void)MOD; (void)Hb; (void)Zb; (void)A2b; (void)RIb; (void)YMb; (void)Yb; (void)ACTb; (void)YSb; (void)LOGf; (void)TOPG; (void)LIST; (void)SUMM; (void)Xf; (void)vcu


template <int L, int PASS>
__device__ __forceinline__ void scan_phase(const int lo, const int hi, const int G, const XcdBarrier& bar, const int wave0) {
    constexpr int l = L, pass = PASS, P = PH_L0 + PH_PER_LAYER * L, jj = L >> 1; constexpr bool odd = (L & 1) != 0;
            if (PHEN(6) && !odd && IN(P + 3 + pass)) {
            PH_LOCALS;
                for (int it = gw; it < 16 * 32 * 4; it += NGW) {
                    const int b = it >> 7, n = (it >> 2) & 31, cg = it & 3;
                    const int ch = cg * 128 + 2 * lane;
                    float sp[2];
#pragma unroll
                    for (int q = 0; q < 2; ++q) { const float x = -kin(I_LAM)[jj * 512 + ch + q]; sp[q] = 8.0f * 1.4426950408889634f * (fmaxf(x, 0.f) + log1pf(__expf(-fabsf(x)))); }
                    float one = 1.0f; asm volatile("" : "+v"(one));
                    float h0 = 0.f, h1 = 0.f, p0 = one, p1 = one;
                    if (pass == 1) {
#pragma unroll 1
                        for (int m = 0; m < n; ++m) { const f32x4 s = *(const f32x4*)(SUMM + (((size_t)b * 32 + m) * 512 + ch) * 2); h0 = s[0] * h0 + s[1]; h1 = s[2] * h1 + s[3]; }
                    }
                    const size_t row0 = (size_t)b * SEQ + n * 128;
#pragma unroll 4
                    for (int t = 0; t < 128; ++t) {
                        const size_t r = row0 + t;
                        const unsigned rw = *(const unsigned*)(RIb + r * 1024 + ch), iw = *(const unsigned*)(RIb + r * 1024 + 512 + ch), xw = *(const unsigned*)(A2b + r * 1024 + 512 + ch);
                        const float a0 = __builtin_amdgcn_exp2f(-bflo(rw) * sp[0]), a1 = __builtin_amdgcn_exp2f(-bfhi(rw) * sp[1]);
                        const float m0 = __builtin_amdgcn_sqrtf(fmaxf(__builtin_fmaf(-a0, a0, 1.0f), 0.f)), m1 = __builtin_amdgcn_sqrtf(fmaxf(__builtin_fmaf(-a1, a1, 1.0f), 0.f));
                        h0 = a0 * h0 + m0 * (bflo(iw) * bflo(xw)); h1 = a1 * h1 + m1 * (bfhi(iw) * bfhi(xw));
                        if (pass == 0) { p0 *= a0; p1 *= a1; }
                        else { const unsigned gwd = *(const unsigned*)(Zb + r * DINAB + 1024 + ch);
                            if (FP8_OUTP) *(unsigned short*)((unsigned char*)YMb + r * 1024 + 512 + ch) = (unsigned short)pk4_fp8(h0 * gelu_tanh(bflo(gwd)), h1 * gelu_tanh(bfhi(gwd)), 0.f, 0.f);
                            else *(unsigned*)(YMb + r * 1024 + 512 + ch) = pk2(h0 * gelu_tanh(bflo(gwd)), h1 * gelu_tanh(bfhi(gwd))); }
                    }
                    if (pass == 0) *(f32x4*)(SUMM + (((size_t)b * 32 + n) * 512 + ch) * 2) = (f32x4){p0, h0, p1, h1};
                }
                SEAM(P + 3 + pass);
            }
}

template <int L, int SUB>
__device__ __forceinline__ void ln_phase(const int lo, const int hi, const int G, const XcdBarrier& bar, const int wave0) {
    constexpr int l = L, sub = SUB, P = PH_L0 + PH_PER_LAYER * L; constexpr int ph = SUB == 0 ? P + 6 : P + 11;
    constexpr bool XIN_F32 = (L == 0 && SUB == 0), XOUT_F32 = (L == DEPTH - 1 && SUB == 1);
    if (PHEN(8) && IN(ph)) {
        PH_LOCALS;
        const int rows_per = T / NGW, r0 = gw * rows_per, b = r0 / SEQ;
        constexpr int ls = 2 * l + sub, lsn = ls + 1;
        const float* gp = MOD + ((size_t)ls * 16 + b) * 3072 + 2048;
        const float* lgp = kin(I_LNG) + ls * 1024, * lbp = kin(I_LNB) + ls * 1024;
        constexpr bool has_nextmod = lsn < 2 * DEPTH;
        const float* nsh = MOD + ((size_t)(has_nextmod ? lsn : 0) * 16 + b) * 3072, * nsc = nsh + 1024;
        f32x4 gt[4], lg[4], lb[4], sh[4], sc[4];
#pragma unroll
        for (int j = 0; j < 4; ++j) { const int o = 4 * (64 * j + lane); gt[j] = *(const f32x4*)(gp + o) + 1.0f; lg[j] = *(const f32x4*)(lgp + o); lb[j] = *(const f32x4*)(lbp + o);
            sh[j] = *(const f32x4*)(nsh + o); sc[j] = *(const f32x4*)(nsc + o) + 1.0f; }
        const float* xin32 = kin(I_X);
        bf16_t* const Xb = (bf16_t*)(ws + WS_XB);
        constexpr bool NEXT_INP8 = ((l + 1) & 1) ? (FP8_INP_ODD != 0) : (FP8_INP_EVEN != 0);
        constexpr int RPI = 2;
        for (int r = r0; r < r0 + rows_per; r += RPI) {
            f32x4 xf[XIN_F32 ? RPI : 1][4]; u32x2 xb[XIN_F32 ? 1 : RPI][4]; u32x2 yv[sub == 0 ? RPI : 1][4]; u32x2 ys[sub == 0 ? 1 : RPI][4][4]; f32x4 gk[RPI];
#pragma unroll
            for (int q = 0; q < RPI; ++q) {
                if constexpr (XIN_F32) { const f32x4* xr = (const f32x4*)(xin32 + (size_t)(r + q) * D) + lane;
#pragma unroll
                    for (int j = 0; j < 4; ++j) xf[q][j] = xr[64 * j]; }
                else { const u32x2* xr = (const u32x2*)(Xb + (size_t)(r + q) * D) + lane;
#pragma unroll
                    for (int j = 0; j < 4; ++j) xb[q][j] = xr[64 * j]; }
                if constexpr (sub == 0) { const u32x2* yr = (const u32x2*)(Yb + (size_t)(r + q) * D) + lane;
#pragma unroll
                    for (int j = 0; j < 4; ++j) yv[q][j] = yr[64 * j]; }
                else { gk[q] = *(const f32x4*)(TOPG + (size_t)(r + q) * 4);
#pragma unroll
                    for (int k = 0; k < 4; ++k) {
                        if (FP8_YS) { const unsigned* yr = (const unsigned*)((const unsigned char*)YSb + ((size_t)(r + q) * 4 + k) * D) + lane;
#pragma unroll
                            for (int j = 0; j < 4; ++j) ys[q][k][j].x = yr[64 * j]; }
                        else { const u32x2* yr = (const u32x2*)(YSb + ((size_t)(r + q) * 4 + k) * D) + lane;
#pragma unroll
                            for (int j = 0; j < 4; ++j) ys[q][k][j] = yr[64 * j]; } } }
            }
            f32x4 v[RPI][4]; float s[RPI];
#pragma unroll
            for (int q = 0; q < RPI; ++q) {
                s[q] = 0.f;
#pragma unroll
                for (int j = 0; j < 4; ++j) {
                    f32x4 y, x;
                    if constexpr (XIN_F32) x = xf[q][j]; else x = (f32x4){bflo(xb[q][j].x), bfhi(xb[q][j].x), bflo(xb[q][j].y), bfhi(xb[q][j].y)};
                    if constexpr (sub == 0) y = (f32x4){bflo(yv[q][j].x), bfhi(yv[q][j].x), bflo(yv[q][j].y), bfhi(yv[q][j].y)};
                    else { y = (f32x4){0.f, 0.f, 0.f, 0.f};
#pragma unroll
                        for (int k = 0; k < 4; ++k) { const u32x2 w = ys[q][k][j];
                            if (FP8_YS) { const f32x2 lo2 = __builtin_amdgcn_cvt_pk_f32_fp8((int)w.x, false), hi2 = __builtin_amdgcn_cvt_pk_f32_fp8((int)w.x, true);
                                y = y + (f32x4){lo2.x, lo2.y, hi2.x, hi2.y} * (gk[q][k] * 0.0625f); }
                            else y = y + (f32x4){bflo(w.x), bfhi(w.x), bflo(w.y), bfhi(w.y)} * gk[q][k]; } }
                    v[q][j] = x * DN_ALPHA + gt[j] * y;
                    s[q] += (v[q][j][0] + v[q][j][1]) + (v[q][j][2] + v[q][j][3]);
                }
            }
#pragma unroll
            for (int o = 1; o < 64; o <<= 1) {
#pragma unroll
                for (int q = 0; q < RPI; ++q) s[q] += __builtin_bit_cast(float, __builtin_amdgcn_ds_bpermute((lane ^ o) << 2, __builtin_bit_cast(int, s[q])));
            }
            float s2[RPI];
#pragma unroll
            for (int q = 0; q < RPI; ++q) { const float mean = s[q] * (1.0f / D); s2[q] = 0.f;
#pragma unroll
                for (int j = 0; j < 4; ++j) { v[q][j] = v[q][j] - mean; s2[q] += (v[q][j][0] * v[q][j][0] + v[q][j][1] * v[q][j][1]) + (v[q][j][2] * v[q][j][2] + v[q][j][3] * v[q][j][3]); } }
#pragma unroll
            for (int o = 1; o < 64; o <<= 1) {
#pragma unroll
                for (int q = 0; q < RPI; ++q) s2[q] += __builtin_bit_cast(float, __builtin_amdgcn_ds_bpermute((lane ^ o) << 2, __builtin_bit_cast(int, s2[q])));
            }
#pragma unroll
            for (int q = 0; q < RPI; ++q) {
                const float rstd = 1.0f / sqrtf(s2[q] * (1.0f / D) + LN_EPS);
                u32x2* hr = (u32x2*)(Hb + (size_t)(r + q) * D) + lane;
#pragma unroll
                for (int j = 0; j < 4; ++j) { const f32x4 xn = v[q][j] * rstd * lg[j] + lb[j];
                    if (XOUT_F32) ((f32x4*)(Xf + (size_t)(r + q) * D) + lane)[64 * j] = xn;
                    else { u32x2 w; w.x = pk2(xn[0], xn[1]); w.y = pk2(xn[2], xn[3]); ((u32x2*)(Xb + (size_t)(r + q) * D) + lane)[64 * j] = w; }
                    if (has_nextmod) { const f32x4 h = xn * sc[j] + sh[j];
                        if (!(NEXT_INP8 && sub == 1) && !(ROUTER_X && sub == 0)) { u32x2 w; w.x = pk2(h[0], h[1]); w.y = pk2(h[2], h[3]); hr[64 * j] = w; }
                        if ((FP8_M1 && sub == 0) || (NEXT_INP8 && sub == 1)) ((unsigned*)(ws + WS_H8 + (size_t)(r + q) * D) + lane)[64 * j] = pk4_fp8(h[0], h[1], h[2], h[3]); } }
            }
        }
        if (ph + 1 < NPH) { if (sub == 0) LSEAM(ph); else SEAM(ph); }
    }
}

template <int L>
__device__ __forceinline__ void layer_body(LAS unsigned char* const lds, volatile LAS unsigned* const LCTL, const int lo, const int hi, const int G, const XcdBarrier& bar, const int wave0) {
    constexpr int l = L;
        const int P = PH_L0 + PH_PER_LAYER * l, jj = l >> 1;
        const bool odd = (l & 1) != 0;
        if (PHEN(2) && IN(P + 0)) {
            PH_LOCALS;
            if (!odd) {
                pg8::DenseSched S; S.init(T, 1536, G, bx);
                if (FP8_INP_EVEN) { pg8::Gemm g{ws + WS_H8, ws + WS_ABIN + (size_t)jj * 1536 * 1024, 1024, 1024, 1024, 122};
                    pg8::EpiDense<0, false, false, true> E{Zb, 1536, nullptr, nullptr, 1.0f / 32.0f};
                    pg8::gemm_phase<true>(lds, g, S, E, wave0); }
                else { pg8::Gemm g{Hb, (const bf16_t*)(ws + WS_ABIN) + (size_t)jj * 1536 * 1024, 1024, 1024, 1024, 127};
                    pg8::EpiDense<0, false, false> E{Zb, 1536, nullptr, nullptr, 0.f};
                    pg8::gemm_phase<false>(lds, g, S, E, wave0); }
            } else {
                pg8::DenseSched S; S.init(T, 2048, G, bx);
                if (FP8_INP_ODD) { pg8::Gemm g{ws + WS_H8, ws + WS_SGIN + (size_t)jj * 2048 * 1024, 1024, 1024, 1024, 122};
                    pg8::EpiDense<1, true, false, true> E{Zb, 2048, kin(I_SGBIN) + jj * 2048, nullptr, 1.0f / 32.0f};
                    pg8::gemm_phase<true>(lds, g, S, E, wave0); }
                else { pg8::Gemm g{Hb, (const bf16_t*)(ws + WS_SGIN) + (size_t)jj * 2048 * 1024, 1024, 1024, 1024, 127};
                    pg8::EpiDense<1, true, false> E{Zb, 2048, kin(I_SGBIN) + jj * 2048, nullptr, 0.f};
                    pg8::gemm_phase<false>(lds, g, S, E, wave0); }
            }
            SEAM(P + 0);
        }
        if (PHEN(3) && !odd && IN(P + 1)) {
            PH_LOCALS;
            const int rows_per = T / NGW, r0 = gw * rows_per;
            const int g4 = lane >> 4, w = 2 << g4;
            float cw[4][8], cb[8];
#pragma unroll
            for (int k = 0; k < 4; ++k)
#pragma unroll
                for (int q = 0; q < 8; ++q) cw[k][q] = kin(I_CONVW)[((size_t)jj * 4 + k) * 512 + 8 * lane + q];
#pragma unroll
            for (int q = 0; q < 8; ++q) cb[q] = kin(I_CONVB)[jj * 512 + 8 * lane + q];
            const int ts0 = r0 & (SEQ - 1);
            u32x4 ring[16], cr[3];
            float sw[8];
#pragma unroll
            for (int q = 0; q < 8; ++q) sw[q] = 0.f;
#pragma unroll
            for (int d = 0; d < 16; ++d) {
                const int k = 15 - d;
                u32x4 v = {0u, 0u, 0u, 0u};
                if (ts0 > d) v = *(const u32x4*)(Zb + (size_t)(r0 - 1 - d) * DINAB + 8 * lane);
                ring[k] = v;
                if (d + 1 < w) { const float f[8] = {bflo(v.x), bfhi(v.x), bflo(v.y), bfhi(v.y), bflo(v.z), bfhi(v.z), bflo(v.w), bfhi(v.w)};
#pragma unroll
                    for (int q = 0; q < 8; ++q) sw[q] += f[q]; }
            }
#pragma unroll
            for (int d = 0; d < 3; ++d) { u32x4 v = {0u, 0u, 0u, 0u}; if (ts0 > d) v = *(const u32x4*)(Zb + (size_t)(r0 - 1 - d) * DINAB + 512 + 8 * lane); cr[2 - d] = v; }
#pragma unroll 1
            for (int rb = 0; rb < rows_per; rb += 16) {
#pragma unroll
                for (int i = 0; i < 16; ++i) {
                    const int r = r0 + rb + i, ts = r & (SEQ - 1);
                    const u32x4 vn = *(const u32x4*)(Zb + (size_t)r * DINAB + 8 * lane), cn = *(const u32x4*)(Zb + (size_t)r * DINAB + 512 + 8 * lane);
                    const u32x4 c2 = ring[(i + 15) & 15], c4 = ring[(i + 13) & 15], c8 = ring[(i + 9) & 15], c16 = ring[(i + 1) & 15];
                    u32x4 vo;
                    vo.x = g4 == 0 ? c2.x : g4 == 1 ? c4.x : g4 == 2 ? c8.x : c16.x; vo.y = g4 == 0 ? c2.y : g4 == 1 ? c4.y : g4 == 2 ? c8.y : c16.y;
                    vo.z = g4 == 0 ? c2.z : g4 == 1 ? c4.z : g4 == 2 ? c8.z : c16.z; vo.w = g4 == 0 ? c2.w : g4 == 1 ? c4.w : g4 == 2 ? c8.w : c16.w;
                    ring[i] = vn;
                    const float fn[8] = {bflo(vn.x), bfhi(vn.x), bflo(vn.y), bfhi(vn.y), bflo(vn.z), bfhi(vn.z), bflo(vn.w), bfhi(vn.w)};
                    const float fo[8] = {bflo(vo.x), bfhi(vo.x), bflo(vo.y), bfhi(vo.y), bflo(vo.z), bfhi(vo.z), bflo(vo.w), bfhi(vo.w)};
                    const int cntw = (ts + 1) < w ? (ts + 1) : w;
                    const float inv = __builtin_amdgcn_rcpf((float)cntw);
                    float pz[8];
#pragma unroll
                    for (int q = 0; q < 8; ++q) { sw[q] += fn[q]; pz[q] = sw[q] * inv - fn[q]; sw[q] -= fo[q]; }
                    u32x4 o; o.x = pk2(pz[0], pz[1]); o.y = pk2(pz[2], pz[3]); o.z = pk2(pz[4], pz[5]); o.w = pk2(pz[6], pz[7]);
                    *(u32x4*)(A2b + (size_t)r * 1024 + 8 * lane) = o;
                    float xc[8];
                    const u32x4 t0 = cr[0], t1 = cr[1], t2 = cr[2];
                    const float f0[8] = {bflo(t0.x), bfhi(t0.x), bflo(t0.y), bfhi(t0.y), bflo(t0.z), bfhi(t0.z), bflo(t0.w), bfhi(t0.w)};
                    const float f1[8] = {bflo(t1.x), bfhi(t1.x), bflo(t1.y), bfhi(t1.y), bflo(t1.z), bfhi(t1.z), bflo(t1.w), bfhi(t1.w)};
                    const float f2[8] = {bflo(t2.x), bfhi(t2.x), bflo(t2.y), bfhi(t2.y), bflo(t2.z), bfhi(t2.z), bflo(t2.w), bfhi(t2.w)};
                    const float f3[8] = {bflo(cn.x), bfhi(cn.x), bflo(cn.y), bfhi(cn.y), bflo(cn.z), bfhi(cn.z), bflo(cn.w), bfhi(cn.w)};
#pragma unroll
                    for (int q = 0; q < 8; ++q) xc[q] = cb[q] + f0[q] * cw[0][q] + f1[q] * cw[1][q] + f2[q] * cw[2][q] + f3[q] * cw[3][q];
                    cr[0] = t1; cr[1] = t2; cr[2] = cn;
                    u32x4 o2; o2.x = pk2(xc[0], xc[1]); o2.y = pk2(xc[2], xc[3]); o2.z = pk2(xc[4], xc[5]); o2.w = pk2(xc[6], xc[7]);
                    *(u32x4*)(A2b + (size_t)r * 1024 + 512 + 8 * lane) = o2;
                }
            }
            LSEAM(P + 1);
        }
        if (PHEN(4) && odd && IN(P + 1)) {
            PH_LOCALS;
            LAS float* STAT = (LAS float*)lds;
            LAS unsigned char* WSS = lds + 1024;
            LAS unsigned char* VT = lds + 1024 + 34816;
            const float* lng = kin(I_SGLNG) + jj * 1024, * lnb = kin(I_SGLNB) + jj * 1024;
            const bf16_t* WSMp = (const bf16_t*)(ws + WS_WSM) + (size_t)jj * 8 * 128 * 128;
            const float* bs = kin(I_SGBS) + jj * 8 * 128;
            const int fr = lane & 15, fq = lane >> 4;
            for (int it = vcu; it < T / 128; it += G) {
                const size_t row0 = (size_t)it * 128;
#pragma unroll 1
                for (int rb = 0; rb < 2; ++rb) {
                    u32x4 a8[8], b8[8];
#pragma unroll
                    for (int q = 0; q < 8; ++q) { const bf16_t* vp = Zb + (row0 + wave * 16 + rb * 8 + q) * 2048 + 1024; a8[q] = *(const u32x4*)(vp + 8 * lane); b8[q] = *(const u32x4*)(vp + 512 + 8 * lane); }
                    float sm[8], sq[8];
#pragma unroll
                    for (int q = 0; q < 8; ++q) {
                        const float f[16] = {bflo(a8[q].x), bfhi(a8[q].x), bflo(a8[q].y), bfhi(a8[q].y), bflo(a8[q].z), bfhi(a8[q].z), bflo(a8[q].w), bfhi(a8[q].w),
                                             bflo(b8[q].x), bfhi(b8[q].x), bflo(b8[q].y), bfhi(b8[q].y), bflo(b8[q].z), bfhi(b8[q].z), bflo(b8[q].w), bfhi(b8[q].w)};
                        float s1 = 0.f, s2 = 0.f;
#pragma unroll
                        for (int e = 0; e < 16; ++e) { s1 += f[e]; s2 += f[e] * f[e]; }
                        sm[q] = s1; sq[q] = s2;
                    }
#pragma unroll
                    for (int o = 1; o < 64; o <<= 1) {
#pragma unroll
                        for (int q = 0; q < 8; ++q) { sm[q] += __builtin_bit_cast(float, __builtin_amdgcn_ds_bpermute((lane ^ o) << 2, __builtin_bit_cast(int, sm[q])));
                            sq[q] += __builtin_bit_cast(float, __builtin_amdgcn_ds_bpermute((lane ^ o) << 2, __builtin_bit_cast(int, sq[q]))); }
                    }
                    if (lane < 8) { float m_ = sm[0], q_ = sq[0];
#pragma unroll
                        for (int q = 1; q < 8; ++q) { m_ = lane == q ? sm[q] : m_; q_ = lane == q ? sq[q] : q_; }
                        const float mean = m_ * (1.0f / 1024.0f), var = fmaxf(q_ * (1.0f / 1024.0f) - mean * mean, 0.f);
                        const int r = wave * 16 + rb * 8 + lane; STAT[2 * r] = mean; STAT[2 * r + 1] = 1.0f / sqrtf(var + LN_EPS); }
                }
                __syncthreads();
                u32x4 wv[4], vv[4];
#pragma unroll
                for (int i = 0; i < 4; ++i) { const int q = tid + 512 * i, row = q >> 4, c16 = q & 15;
                    wv[i] = *(const u32x4*)(WSMp + ((size_t)0 * 128 + row) * 128 + c16 * 8);
                    vv[i] = *(const u32x4*)(Zb + (row0 + row) * 2048 + 1024 + 0 * 128 + c16 * 8); }
#pragma unroll 1
                for (int hd = 0; hd < 8; ++hd) {
#pragma unroll
                    for (int i = 0; i < 4; ++i) {
                        const int q = tid + 512 * i, row = q >> 4, c16 = q & 15;
                        *(LAS u32x4*)(WSS + row * 272 + c16 * 16) = wv[i];
                        const u32x4 v4 = vv[i];
                        const float mean = STAT[2 * row], rstd = STAT[2 * row + 1];
                        const float f[8] = {bflo(v4.x), bfhi(v4.x), bflo(v4.y), bfhi(v4.y), bflo(v4.z), bfhi(v4.z), bflo(v4.w), bfhi(v4.w)};
                        const f32x4 g0 = *(const f32x4*)(lng + hd * 128 + c16 * 8), g1 = *(const f32x4*)(lng + hd * 128 + c16 * 8 + 4);
                        const f32x4 b0 = *(const f32x4*)(lnb + hd * 128 + c16 * 8), b1 = *(const f32x4*)(lnb + hd * 128 + c16 * 8 + 4);
                        const float gg[8] = {g0[0], g0[1], g0[2], g0[3], g1[0], g1[1], g1[2], g1[3]}, bb[8] = {b0[0], b0[1], b0[2], b0[3], b1[0], b1[1], b1[2], b1[3]};
#pragma unroll
                        for (int q2 = 0; q2 < 8; ++q2) {
                            const int c = c16 * 8 + q2;
                            const int rho = (c & ~31) | (((c >> 2) & 1) << 4) | (((c >> 3) & 3) << 2) | (c & 3);
                            *(LAS bf16_t*)(VT + rho * 272 + row * 2) = (bf16_t)f2bf((f[q2] - mean) * rstd * gg[q2] + bb[q2]);
                        }
                    }
                    const int hn = hd < 7 ? hd + 1 : 7;
#pragma unroll
                    for (int i = 0; i < 4; ++i) { const int q = tid + 512 * i, row = q >> 4, c16 = q & 15;
                        wv[i] = *(const u32x4*)(WSMp + ((size_t)hn * 128 + row) * 128 + c16 * 8);
                        vv[i] = *(const u32x4*)(Zb + (row0 + row) * 2048 + 1024 + hn * 128 + c16 * 8); }
                    const int t = 16 * wave + fr; const float bst = bs[hd * 128 + t];
                    const size_t rowg = row0 + t;
                    u32x4 uv[4];
#pragma unroll
                    for (int q = 0; q < 4; ++q) uv[q] = *(const u32x4*)(Zb + rowg * 2048 + hd * 128 + 32 * q + 8 * fq);
                    __syncthreads();
                    bf16x8 afr[4];
#pragma unroll
                    for (int ks = 0; ks < 4; ++ks) afr[ks] = *(const LAS bf16x8*)(WSS + (16 * wave + fr) * 272 + (32 * ks + 8 * fq) * 2);
                    f32x4 acc[8];
#pragma unroll
                    for (int tn = 0; tn < 8; ++tn) { acc[tn] = (f32x4){0.f, 0.f, 0.f, 0.f};
#pragma unroll
                        for (int ks = 0; ks < 4; ++ks) { const bf16x8 vfr = *(const LAS bf16x8*)(VT + (16 * tn + fr) * 272 + (32 * ks + 8 * fq) * 2);
                            acc[tn] = __builtin_amdgcn_mfma_f32_16x16x32_bf16(vfr, afr[ks], acc[tn], 0, 0, 0); } }
#pragma unroll
                    for (int q = 0; q < 4; ++q) {
                        const int c0 = hd * 128 + 32 * q + 8 * fq;
                        const u32x4 u4 = uv[q];
                        const f32x4 s0 = acc[2 * q] + bst, s1 = acc[2 * q + 1] + bst;
                        if (FP8_OUTP) { u32x2 o; o.x = pk4_fp8(bflo(u4.x) * s0[0], bfhi(u4.x) * s0[1], bflo(u4.y) * s0[2], bfhi(u4.y) * s0[3]);
                            o.y = pk4_fp8(bflo(u4.z) * s1[0], bfhi(u4.z) * s1[1], bflo(u4.w) * s1[2], bfhi(u4.w) * s1[3]);
                            *(u32x2*)((unsigned char*)YMb + rowg * 1024 + c0) = o; }
                        else { u32x4 o; o.x = pk2(bflo(u4.x) * s0[0], bfhi(u4.x) * s0[1]); o.y = pk2(bflo(u4.y) * s0[2], bfhi(u4.y) * s0[3]);
                        o.z = pk2(bflo(u4.z) * s1[0], bfhi(u4.z) * s1[1]); o.w = pk2(bflo(u4.w) * s1[2], bfhi(u4.w) * s1[3]);
                        *(u32x4*)(YMb + rowg * 1024 + c0) = o; }
                    }
                    __syncthreads();
                }
            }
            SEAM(P + 1);
        }
        if (PHEN(5) && !odd && IN(P + 2)) {
            PH_LOCALS;
            {
                pg8::Gemm g{A2b, (const bf16_t*)(ws + WS_BPOOL) + (size_t)jj * 512 * 512, 1024, 512, 256, 127};
                pg8::DenseSched S; S.init(T, 512, G, bx); S.kblk = 512; S.rowm = (FUSE_LOCAL && G == 256) ? 1 : 0;
                pg8::EpiDense<0, false, true, false, FP8_OUTP != 0> E{YMb, 1024, nullptr, kin(I_POOLS) + jj * 512, 0.f};
                pg8::gemm_phase<false>(lds, g, S, E, wave0);
            }
            {
                pg8::Gemm g{A2b + 512, (const bf16_t*)(ws + WS_BGATE) + (size_t)jj * 1024 * 512, 1024, 512, 256, 127};
                pg8::DenseSched S; S.init(T, 1024, G, bx); S.kblk = 512; S.rowm = (FUSE_LOCAL && G == 256) ? 1 : 0;
                pg8::EpiDense<2, true, false> E{RIb, 1024, (const float*)(ws + WS_BIASRI) + jj * 1024, nullptr, 0.f};
                pg8::gemm_phase<false>(lds, g, S, E, wave0);
            }
            SEAM(P + 2);
        }
        scan_phase<L, 0>(lo, hi, G, bar, wave0); scan_phase<L, 1>(lo, hi, G, bar, wave0);
        if (PHEN(7) && IN(P + 5)) {
            PH_LOCALS;
            const float* bo = odd ? kin(I_SGBOUT) + jj * 1024 : kin(I_ABBOUT) + jj * 1024;
            pg8::DenseSched S; S.init(T, 1024, G, bx);
            if (FP8_OUTP) { const unsigned char* wt = odd ? ws + WS_SGOUT + (size_t)jj * 1024 * 1024 : ws + WS_ABOUT + (size_t)jj * 1024 * 1024;
                pg8::Gemm g{YMb, wt, 1024, 1024, 1024, 121};
                pg8::EpiDense<0, true, false, true> E{Yb, 1024, bo, nullptr, 1.0f / 64.0f};
                pg8::gemm_phase<true>(lds, g, S, E, wave0); }
            else { const bf16_t* wt = odd ? (const bf16_t*)(ws + WS_SGOUT) + (size_t)jj * 1024 * 1024 : (const bf16_t*)(ws + WS_ABOUT) + (size_t)jj * 1024 * 1024;
                pg8::Gemm g{YMb, wt, 1024, 1024, 1024, 127};
                pg8::EpiDense<0, true, false> E{Yb, 1024, bo, nullptr, 0.f};
                pg8::gemm_phase<false>(lds, g, S, E, wave0); }
            SEAM(P + 5);
        }
        ln_phase<L, 0>(lo, hi, G, bar, wave0);
            if (PHEN(9) && IN(P + 7)) {
            PH_LOCALS;
                pg8::Gemm g{ROUTER_X ? (const bf16_t*)(ws + WS_XB) : Hb, ROUTER_X ? (const bf16_t*)(ws + WS_BRB) + (size_t)l * 16 * 64 * 1024 : (const bf16_t*)(ws + WS_BR) + (size_t)l * 256 * 1024, 1024, 1024, 1024, 127};
                pg8::DenseSched S; S.init(T, 256, G, bx); if (ROUTER_X) S.bb = 64;
                pg8::EpiRouter E{LOGf};
                pg8::gemm_phase<false>(lds, g, S, E, wave0);
                LSEAM(P + 7);
            }
            if (PHEN(10) && IN(P + 8)) {
            PH_LOCALS;
                volatile LAS unsigned* hist = LCTL + 96; volatile LAS unsigned* basev = LCTL + 128;
                unsigned* gcnt = ctl + CW_CNT + 64 * l;
                const int TPB = (FUSE_LOCAL && G == 256) ? 256 : 512;
                for (int t0 = vcu * TPB; t0 < T; t0 += G * TPB) {
                    if (tid < 32) hist[tid] = 0u;
                    __syncthreads();
                    const bool act = tid < TPB;
                    const int tok = t0 + (act ? tid : 0);
                    float lv[32];
                    { const f32x4* lp = (const f32x4*)(LOGf + (size_t)tok * 64);
#pragma unroll
                      for (int q = 0; q < 8; ++q) { const f32x4 a = lp[q], b2 = lp[8 + q], rb = ROUTER_X ? *(const f32x4*)((const float*)(ws + WS_CB) + (l * 16 + (t0 >> 12)) * 32 + 4 * q) : *(const f32x4*)(kin(I_RB) + l * 32 + 4 * q);
                          lv[4 * q + 0] = a[0] + b2[0] + rb[0]; lv[4 * q + 1] = a[1] + b2[1] + rb[1]; lv[4 * q + 2] = a[2] + b2[2] + rb[2]; lv[4 * q + 3] = a[3] + b2[3] + rb[3]; } }
                    float v0 = -3.0e38f, v1 = -3.0e38f, v2 = -3.0e38f, v3 = -3.0e38f; int i0 = 0, i1 = 0, i2 = 0, i3 = 0;
#pragma unroll
                    for (int e = 0; e < 32; ++e) {
                        const float x = lv[e];
                        if (x > v3) {
                            if (x > v0) { v3 = v2; i3 = i2; v2 = v1; i2 = i1; v1 = v0; i1 = i0; v0 = x; i0 = e; }
                            else if (x > v1) { v3 = v2; i3 = i2; v2 = v1; i2 = i1; v1 = x; i1 = e; }
                            else if (x > v2) { v3 = v2; i3 = i2; v2 = x; i2 = e; }
                            else { v3 = x; i3 = e; }
                        }
                    }
                    const float e1 = __expf(v1 - v0), e2 = __expf(v2 - v0), e3 = __expf(v3 - v0), inv = 1.0f / (1.0f + e1 + e2 + e3);
                    if (act) *(f32x4*)(TOPG + (size_t)tok * 4) = (f32x4){inv, e1 * inv, e2 * inv, e3 * inv};
                    LAS unsigned* hp = (LAS unsigned*)hist;
                    unsigned r0 = 0u, r1 = 0u, r2 = 0u, r3 = 0u;
                    if (act) { r0 = __hip_atomic_fetch_add(hp + i0, 1u, __ATOMIC_RELAXED, __HIP_MEMORY_SCOPE_WORKGROUP); r1 = __hip_atomic_fetch_add(hp + i1, 1u, __ATOMIC_RELAXED, __HIP_MEMORY_SCOPE_WORKGROUP);
                        r2 = __hip_atomic_fetch_add(hp + i2, 1u, __ATOMIC_RELAXED, __HIP_MEMORY_SCOPE_WORKGROUP); r3 = __hip_atomic_fetch_add(hp + i3, 1u, __ATOMIC_RELAXED, __HIP_MEMORY_SCOPE_WORKGROUP); }
                    __syncthreads();
                    if (tid < 32) basev[tid] = __hip_atomic_fetch_add(gcnt + tid, hist[tid], __ATOMIC_RELAXED, __HIP_MEMORY_SCOPE_AGENT);
                    __syncthreads();
                    if (act) {
                    LIST[(size_t)i0 * TKTOT + basev[i0] + r0] = tok * 4 + 0;
                    LIST[(size_t)i1 * TKTOT + basev[i1] + r1] = tok * 4 + 1;
                    LIST[(size_t)i2 * TKTOT + basev[i2] + r2] = tok * 4 + 2;
                    LIST[(size_t)i3 * TKTOT + basev[i3] + r3] = tok * 4 + 3; }
                    __syncthreads();
                }
                SEAM(P + 8);
            }
            if (PHEN(11) && IN(P + 9)) {
                PH_LOCALS;
                volatile LAS int* cnts = (volatile LAS int*)(LCTL + 16); volatile LAS int* tstart = (volatile LAS int*)(LCTL + 48);
                if (tid < 32) cnts[tid] = (int)__hip_atomic_load(ctl + CW_CNT + 64 * l + tid, __ATOMIC_RELAXED, __HIP_MEMORY_SCOPE_AGENT);
                __syncthreads();
                if (tid == 0) { int s = 0; for (int e = 0; e < 32; ++e) { tstart[e] = s; s += (cnts[e] + 255) >> 8; } tstart[32] = s; }
                __syncthreads();
                LAS int* const utab = (LAS int*)(lds + UTAB_OFF);
                const int nunits = pg8::moe_build_units(utab, tstart, cnts, 8, G, bx, tid);
                __syncthreads();
                pg8::MoeSched S{(const LAS int*)utab, LIST, (const float*)(ws + WS_B1P) + (size_t)l * 32 * 2048, nunits, 2048, 2};
                pg8::EpiMoe1<FP8_M2 != 0> E{FP8_M2 ? (bf16_t*)(ws + WS_ACT8) : ACTb, lds, FP8_M1 ? 1.0f / 32.0f : 1.0f};
                if (FP8_M1) { pg8::Gemm g{ws + WS_H8, ws + WS_W1T8 + (size_t)l * 32 * 2048 * 1024, 1024, 1024, 1024, 122};
                    pg8::gemm_phase<true>(lds, g, S, E, wave0); }
                else { pg8::Gemm g{Hb, (const bf16_t*)(ws + WS_W1T) + (size_t)l * 32 * 2048 * 1024, 1024, 1024, 1024, 127};
                    pg8::gemm_phase<false>(lds, g, S, E, wave0); }
                SEAM(P + 9);
            }
            if (PHEN(12) && IN(P + 10)) {
                PH_LOCALS;
                volatile LAS int* cnts = (volatile LAS int*)(LCTL + 16); volatile LAS int* tstart = (volatile LAS int*)(LCTL + 48);
                __syncthreads();
                if (tid < 32) cnts[tid] = (int)__hip_atomic_load(ctl + CW_CNT + 64 * l + tid, __ATOMIC_RELAXED, __HIP_MEMORY_SCOPE_AGENT);
                __syncthreads();
                if (tid == 0) { int s = 0; for (int e = 0; e < 32; ++e) { tstart[e] = s; s += (cnts[e] + 255) >> 8; } tstart[32] = s; }
                __syncthreads();
                LAS int* const utab = (LAS int*)(lds + UTAB_OFF);
                const int nunits = pg8::moe_build_units(utab, tstart, cnts, 4, G, bx, tid);
                __syncthreads();
                pg8::MoeSched S{(const LAS int*)utab, LIST, kin(I_B2) + (size_t)l * 32 * 1024, nunits, 1024, 0};
                pg8::EpiMoe2 E{YSb, lds, FP8_M2 ? 1.0f / 64.0f : 1.0f};
                if (FP8_M2) { pg8::Gemm g{ws + WS_ACT8, ws + WS_W2T8 + (size_t)l * 32 * 1024 * 1024, 1024, 1024, 1024, 121};
                    pg8::gemm_phase<true>(lds, g, S, E, wave0); }
                else { pg8::Gemm g{ACTb, (const bf16_t*)(ws + WS_W2T) + (size_t)l * 32 * 1024 * 1024, 1024, 1024, 1024, 127};
                    pg8::gemm_phase<false>(lds, g, S, E, wave0); }
                SEAM(P + 10);
            }
        ln_phase<L, 1>(lo, hi, G, bar, wave0);
}

__global__ void __launch_bounds__(512, 2) fwd_kernel(Args args) {
    extern __shared__ __attribute__((aligned(16))) unsigned char lds_raw[];
    LAS unsigned char* const lds = (LAS unsigned char*)lds_raw;
    volatile LAS unsigned* const LCTL = (volatile LAS unsigned*)(lds + LDSCTL_OFF);
    const int G = gridDim.x;
    int lo, hi; unsigned* ctl0;
    { kptr_t kp = (kptr_t)__builtin_amdgcn_kernarg_segment_ptr(); lo = *(const __attribute__((address_space(4))) int*)(kp + 272); hi = *(const __attribute__((address_space(4))) int*)(kp + 276);
      ctl0 = (unsigned*)(*(unsigned char* const __attribute__((address_space(4)))*)(kp + 264) + WS_CTL); }
    const int wave0 = __builtin_amdgcn_readfirstlane((int)threadIdx.x >> 6);
    for (int u = threadIdx.x; u < (LDS_BYTES - LDSCTL_OFF) / 4; u += 512) LCTL[u] = 0u;
    __syncthreads();
    XcdBarrier bar; bar.bar = ctl0 + CW_BAR; bar.x = 0; bar.st = LCTL; bar.wv = wave0;
    if (hi - lo > 1) bar = xcd_barrier_post(ctl0 + CW_BAR, LCTL, wave0);
    if (PHEN(0) && IN(PH_CONV)) {
            PH_LOCALS;
        {
            LAS float* cact = (LAS float*)lds;
            LAS float* part = (LAS float*)(lds + 65536);
            if (bx < 384) {
                for (int i = tid; i < 16 * 1024; i += 512) { const float c = kin(I_C)[i]; cact[i] = c / (1.0f + __expf(-c)); }
                __syncthreads();
                for (int it = bx; it < 384; it += G) {
                    const int ls = it / 48, col0 = (it % 48) * 64;
                    const int kq = tid >> 6, cl = tid & 63;
                    const float* wp = kin(I_MODW) + (size_t)ls * 1024 * 3072 + col0 + cl;
                    float a[16];
#pragma unroll
                    for (int b = 0; b < 16; ++b) a[b] = 0.f;
#pragma unroll 4
                    for (int k = kq * 128; k < kq * 128 + 128; ++k) {
                        const float w = wp[(size_t)k * 3072];
#pragma unroll
                        for (int b = 0; b < 16; ++b) a[b] += cact[b * 1024 + k] * w;
                    }
#pragma unroll
                    for (int b = 0; b < 16; ++b) part[(kq * 16 + b) * 64 + cl] = a[b];
                    __syncthreads();
                    for (int o = tid; o < 1024; o += 512) {
                        const int b = o >> 6, c2 = o & 63; float s = 0.f;
#pragma unroll
                        for (int q = 0; q < 8; ++q) s += part[(q * 16 + b) * 64 + c2];
                        MOD[((size_t)ls * 16 + b) * 3072 + col0 + c2] = s + kin(I_MODB)[ls * 3072 + col0 + c2];
                    }
                    __syncthreads();
                }
            }
        }
        {
            constexpr int IT_ABIN = 2 * (FP8_INP_EVEN ? 8 : 16) * 48, IT_ABOUT = 2 * (FP8_OUTP ? 8 : 16) * 32, IT_SGIN = 2 * (FP8_INP_ODD ? 8 : 16) * 64, IT_SGOUT = 2 * (FP8_OUTP ? 8 : 16) * 32, IT_W1 = 128 * (FP8_M1 ? 8 : 16) * 64, IT_W2 = 128 * (FP8_M2 ? 8 : 16) * 32;
            constexpr int IT_ALL = IT_ABIN + IT_ABOUT + IT_SGIN + IT_SGOUT + IT_W1 + IT_W2;
            for (int it = gw; it < IT_ALL; it += NGW) {
                int r = it;
                if (r < IT_ABIN) { if (FP8_INP_EVEN) { const int mat = r / (8 * 48); conv_item_f8<false>(kin(I_ABWIN) + (size_t)mat * 1024 * 1536, 1536, ws + WS_ABIN + (size_t)mat * 1536 * 1024, r % (8 * 48), lane, 32.0f); }
                    else { const int mat = r / (16 * 48); conv_item<false>(kin(I_ABWIN) + (size_t)mat * 1024 * 1536, 1536, (bf16_t*)(ws + WS_ABIN) + (size_t)mat * 1536 * 1024, r % (16 * 48), lane); } continue; } r -= IT_ABIN;
                if (r < IT_ABOUT) { if (FP8_OUTP) { const int mat = r / (8 * 32); conv_item_f8<false>(kin(I_ABWOUT) + (size_t)mat * 1024 * 1024, 1024, ws + WS_ABOUT + (size_t)mat * 1024 * 1024, r % (8 * 32), lane, 64.0f); }
                    else { const int mat = r / (16 * 32); conv_item<false>(kin(I_ABWOUT) + (size_t)mat * 1024 * 1024, 1024, (bf16_t*)(ws + WS_ABOUT) + (size_t)mat * 1024 * 1024, r % (16 * 32), lane); } continue; } r -= IT_ABOUT;
                if (r < IT_SGIN) { if (FP8_INP_ODD) { const int mat = r / (8 * 64); conv_item_f8<false>(kin(I_SGWIN) + (size_t)mat * 1024 * 2048, 2048, ws + WS_SGIN + (size_t)mat * 2048 * 1024, r % (8 * 64), lane, 32.0f); }
                    else { const int mat = r / (16 * 64); conv_item<false>(kin(I_SGWIN) + (size_t)mat * 1024 * 2048, 2048, (bf16_t*)(ws + WS_SGIN) + (size_t)mat * 2048 * 1024, r % (16 * 64), lane); } continue; } r -= IT_SGIN;
                if (r < IT_SGOUT) { if (FP8_OUTP) { const int mat = r / (8 * 32); conv_item_f8<false>(kin(I_SGWOUT) + (size_t)mat * 1024 * 1024, 1024, ws + WS_SGOUT + (size_t)mat * 1024 * 1024, r % (8 * 32), lane, 64.0f); }
                    else { const int mat = r / (16 * 32); conv_item<false>(kin(I_SGWOUT) + (size_t)mat * 1024 * 1024, 1024, (bf16_t*)(ws + WS_SGOUT) + (size_t)mat * 1024 * 1024, r % (16 * 32), lane); } continue; } r -= IT_SGOUT;
                if (r < IT_W1) {
                    if (FP8_M1) { const int mat = r / (8 * 64); conv_item_f8<true>(kin(I_W1) + (size_t)mat * 1024 * 2048, 2048, ws + WS_W1T8 + (size_t)mat * 2048 * 1024, r % (8 * 64), lane, 32.0f); }
                    else { const int mat = r / (16 * 64); conv_item<true>(kin(I_W1) + (size_t)mat * 1024 * 2048, 2048, (bf16_t*)(ws + WS_W1T) + (size_t)mat * 2048 * 1024, r % (16 * 64), lane); }
                    continue; } r -= IT_W1;
                if (FP8_M2) { const int mat = r / (8 * 32); conv_item_f8<false>(kin(I_W2) + (size_t)mat * 1024 * 1024, 1024, ws + WS_W2T8 + (size_t)mat * 1024 * 1024, r % (8 * 32), lane, 64.0f); }
                else { const int mat = r / (16 * 32); conv_item<false>(kin(I_W2) + (size_t)mat * 1024 * 1024, 1024, (bf16_t*)(ws + WS_W2T) + (size_t)mat * 1024 * 1024, r % (16 * 32), lane); }
            }
        }
        {
            const int gt = vcu * 512 + tid, NGT = G * 512;
            bf16_t* BR = (bf16_t*)(ws + WS_BR);
            if (!ROUTER_X) for (int i = gt; i < 4 * 256 * 1024; i += NGT) {
                const int l = i >> 18, n = (i >> 10) & 255, k = i & 1023; unsigned v = 0;
                if (n < 64) { const float w = kin(I_RW)[((size_t)l * 1024 + k) * 32 + (n & 31)]; const unsigned h = f2bf(w); v = h;
                    if (n >= 32) v = f2bf(w - __builtin_bit_cast(float, h << 16)); }
                BR[i] = (bf16_t)v;
            }
            bf16_t* BP = (bf16_t*)(ws + WS_BPOOL);
            for (int i = gt; i < 2 * 512 * 512; i += NGT) {
                const int j = i >> 18, n = (i >> 9) & 511, k = i & 511; unsigned v = 0;
                if ((n >> 7) == (k >> 7)) v = f2bf(kin(I_POOLW)[(((size_t)j * 4 + (n >> 7)) * 128 + (k & 127)) * 128 + (n & 127)]);
                BP[i] = (bf16_t)v;
            }
            bf16_t* BG = (bf16_t*)(ws + WS_BGATE);
            for (int i = gt; i < 2 * 1024 * 512; i += NGT) {
                const int j = i >> 19, n = (i >> 9) & 1023, k = i & 511; unsigned v = 0; const int nn = n & 511;
                if ((nn >> 6) == (k >> 6)) { const float* w = (n < 512) ? kin(I_WA) : kin(I_WX); v = f2bf(w[(((size_t)j * 8 + (nn >> 6)) * 64 + (k & 63)) * 64 + (nn & 63)]); }
                BG[i] = (bf16_t)v;
            }
            bf16_t* WSMp = (bf16_t*)(ws + WS_WSM);
            for (int i = gt; i < 2 * 8 * 128 * 128; i += NGT) {
                const int t = (i >> 7) & 127, s = i & 127; WSMp[i] = (bf16_t)((s <= t) ? f2bf(kin(I_SGWS)[i]) : 0u);
            }
            float* BRI = (float*)(ws + WS_BIASRI);
            for (int i = gt; i < 2 * 1024; i += NGT) { const int j = i >> 10, n = i & 1023; BRI[i] = (n < 512) ? kin(I_BA)[j * 512 + n] : kin(I_BX)[j * 512 + n - 512]; }
            float* B1P = (float*)(ws + WS_B1P);
            for (int i = gt; i < 4 * 32 * 2048; i += NGT) { const int le = i >> 11, rho = i & 2047; B1P[i] = kin(I_B1)[(size_t)le * 2048 + w1_n_of_rho(rho)]; }
        }
        SEAM(PH_CONV);
    }

    if (PHEN(1) && IN(PH_H0)) {
            PH_LOCALS;
        const int rows_per = T / NGW, r0 = gw * rows_per;
        const int b = r0 / SEQ;
        const float* shp = MOD + ((size_t)0 * 16 + b) * 3072, * scp = shp + 1024;
        f32x4 sh[4], sc[4];
#pragma unroll
        for (int j = 0; j < 4; ++j) { sh[j] = *(const f32x4*)(shp + 4 * (64 * j + lane)); sc[j] = *(const f32x4*)(scp + 4 * (64 * j + lane)); }
        for (int r = r0; r < r0 + rows_per; ++r) {
            const f32x4* xr = (const f32x4*)(kin(I_X) + (size_t)r * D) + lane;
            u32x2* hr = (u32x2*)(Hb + (size_t)r * D) + lane;
#pragma unroll
            for (int j = 0; j < 4; ++j) { const f32x4 v = xr[64 * j]; const f32x4 h = v * (sc[j] + 1.0f) + sh[j];
                if (FP8_INP_EVEN) ((unsigned*)(ws + WS_H8 + (size_t)r * D) + lane)[64 * j] = pk4_fp8(h[0], h[1], h[2], h[3]);
                else { u32x2 w; w.x = pk2(h[0], h[1]); w.y = pk2(h[2], h[3]); hr[64 * j] = w; } }
        }
        if (ROUTER_X) {
            bf16_t* BRB = (bf16_t*)(ws + WS_BRB);
            const float* rwp = kin(I_RW);
            for (int i = vcu * 512 + tid; i < 4 * 32 * 1024; i += G * 512) {
                const int l = i >> 15, e = (i >> 10) & 31, k = i & 1023;
                const float w = rwp[((size_t)l * 1024 + k) * 32 + e];
#pragma unroll 4
                for (int bq = 0; bq < 16; ++bq) {
                    const float wm = w * (1.0f + MOD[((size_t)(2 * l + 1) * 16 + bq) * 3072 + 1024 + k]);
                    const unsigned h = f2bf(wm), lo2 = f2bf(wm - __builtin_bit_cast(float, h << 16));
                    bf16_t* o = BRB + (((size_t)l * 16 + bq) * 64 + e) * 1024 + k; o[0] = (bf16_t)h; o[32 * 1024] = (bf16_t)lo2; }
            }
            for (int i = vcu * 512 + tid; i < 192 * 1024 / 2; i += G * 512) ((unsigned*)(BRB + (size_t)4 * 16 * 64 * 1024))[i] = 0u;
            const int it = vcu + G * wave;
            if (it < 512) {
                const int l = it >> 7, bq = (it >> 3) & 15, eq = it & 7;
                const float* shq = MOD + ((size_t)(2 * l + 1) * 16 + bq) * 3072;
                const f32x4* rw4 = (const f32x4*)(kin(I_RW) + (size_t)l * 1024 * 32) + eq;
                float sa[4] = {0.f, 0.f, 0.f, 0.f};
#pragma unroll
                for (int i2 = 0; i2 < 16; ++i2) { const int k = lane + 64 * i2; const f32x4 wv4 = rw4[(size_t)k * 8]; const float sk = shq[k]; sa[0] += wv4[0] * sk; sa[1] += wv4[1] * sk; sa[2] += wv4[2] * sk; sa[3] += wv4[3] * sk; }
#pragma unroll
                for (int o = 1; o < 64; o <<= 1) {
#pragma unroll
                    for (int c4 = 0; c4 < 4; ++c4) sa[c4] += __builtin_bit_cast(float, __builtin_amdgcn_ds_bpermute((lane ^ o) << 2, __builtin_bit_cast(int, sa[c4])));
                }
                const f32x4 rb4 = *(const f32x4*)(kin(I_RB) + l * 32 + 4 * eq);
                *(f32x4*)((float*)(ws + WS_CB) + (l * 16 + bq) * 32 + 4 * eq) = (f32x4){sa[0] + rb4[0], sa[1] + rb4[1], sa[2] + rb4[2], sa[3] + rb4[3]};
            }
        }
        SEAM(PH_H0);
    }

    layer_body<0>(lds, LCTL, lo, hi, G, bar, wave0); layer_body<1>(lds, LCTL, lo, hi, G, bar, wave0); layer_body<2>(lds, LCTL, lo, hi, G, bar, wave0); layer_body<3>(lds, LCTL, lo, hi, G, bar, wave0);
}
#undef IN
#undef SEAM

#ifdef DUMP_SPEC
struct DumpSrc { size_t off; int ld; int col0; };
__global__ void dump_kernel(const unsigned char* ws, float* out) {
    const DumpSrc srcs[8] = DUMP_SPEC;
    const size_t i = (size_t)blockIdx.x * blockDim.x + threadIdx.x;
    const int r = (int)(i >> 10), c = (int)(i & 1023), blk = c >> 7, cc = c & 127;
    const DumpSrc d = srcs[blk];
    const bf16_t* p = (const bf16_t*)(ws + d.off);
    out[i] = bf2f(p[(size_t)r * d.ld + d.col0 + cc]);
}
#endif
extern "C" void kernel_launch(void* const* d_in, const int* in_sizes, int n_in, void* d_out, int out_size, void* d_ws, size_t ws_size, hipStream_t stream) {
    static int grid = 0;
    if (grid == 0) {
        if (n_in != 32 || out_size != T * D || ws_size < WS_END) { fprintf(stderr, "kernel_launch: unexpected problem (n_in %d, out %d, ws %zu)\n", n_in, out_size, ws_size); grid = -1; return; }
        int dev = 0, cus = 0, per_cu = 0;
        if (hipGetDevice(&dev) != hipSuccess || hipDeviceGetAttribute(&cus, hipDeviceAttributeMultiprocessorCount, dev) != hipSuccess) { grid = -1; return; }
        if (hipFuncSetAttribute((const void*)fwd_kernel, hipFuncAttributeMaxDynamicSharedMemorySize, LDS_BYTES) != hipSuccess) { fprintf(stderr, "kernel_launch: hipFuncSetAttribute failed\n"); grid = -1; return; }
        if (hipOccupancyMaxActiveBlocksPerMultiprocessor(&per_cu, (const void*)fwd_kernel, 512, LDS_BYTES) != hipSuccess || per_cu < 1) fprintf(stderr, "kernel_launch: occupancy query says %d\n", per_cu);
        (void)hipGetLastError();
        grid = cus;
        if (grid * 8 > T || (T % (grid * 8)) != 0) { fprintf(stderr, "kernel_launch: grid %d does not divide the rows\n", grid); grid = -1; return; }
    }
    if (grid < 0) return;
    (void)hipMemsetAsync((char*)d_ws + WS_CTL, 0, CTL_ZERO_BYTES, stream);
    Args a{};
    for (int i = 0; i < 32; ++i) a.in[i] = (const float*)d_in[i];
    a.out = (float*)d_out; a.ws = (unsigned char*)d_ws;
#if MK_ONE_LAUNCH
    a.ph_lo = 0; a.ph_hi = NPH;
    hipLaunchKernelGGL(fwd_kernel, dim3(grid), dim3(512), LDS_BYTES, stream, a);
#else
#ifndef STOP_PH
#define STOP_PH NPH
#endif
    for (int ph = 0; ph < STOP_PH; ++ph) {
        if (!phase_exists(ph)) continue;
        a.ph_lo = ph; a.ph_hi = ph + 1;
        hipLaunchKernelGGL(fwd_kernel, dim3(grid), dim3(512), LDS_BYTES, stream, a);
#ifdef REP_SLOTS
        { const int slot = ph < PH_L0 ? ph : 2 + (ph - PH_L0) % PH_PER_LAYER; if ((REP_SLOTS >> slot) & 1) {
#ifdef PROBE_VARIANTS
            a.variant = PROBE_VARIANTS;
#endif
            hipLaunchKernelGGL(fwd_kernel, dim3(grid), dim3(512), LDS_BYTES, stream, a); a.variant = 0; } }
#endif
    }
#ifdef DUMP_SPEC
    hipLaunchKernelGGL(dump_kernel, dim3(T * 1024 / 256), dim3(256), 0, stream, (const unsigned char*)d_ws, (float*)d_out);
#endif
#endif
}
```

```cpp
#include <hip/hip_runtime.h>
#include <cstdio>
#include <cstdint>

#ifndef PIN_ACC
#define PIN_ACC 0
#endif
#ifndef FP8_M1
#define FP8_M1 1
#endif
#ifndef FP8_M2
#define FP8_M2 1
#endif
#ifndef FP8_YS
#define FP8_INP_EVEN 0
#define FP8_INP_ODD 1
#define FP8_OUTP 1
#define WIDE_EPI 1
#define FUSE_LOCAL 1
#define ROUTER_X 1
#define FP8_YS 1
#endif
#ifndef MK_ONE_LAUNCH
#define MK_ONE_LAUNCH 1
#endif

#ifndef PHMASK
#define PHMASK 0xFFFFF
#endif
#define PHEN(k) (((PHMASK) >> (k)) & 1)
#define LAS __attribute__((address_space(3)))
#define GAS __attribute__((address_space(1)))
typedef unsigned short bf16_t;
typedef short bf16x8 __attribute__((ext_vector_type(8)));
typedef float f32x4 __attribute__((ext_vector_type(4)));
typedef float f32x2 __attribute__((ext_vector_type(2)));
typedef unsigned u32x4 __attribute__((ext_vector_type(4)));
typedef unsigned u32x2 __attribute__((ext_vector_type(2)));

constexpr int D = 1024, NBATCH = 16, SEQ = 4096, T = NBATCH * SEQ, DEPTH = 4;
constexpr int NE = 32, TOPK = 4, TKTOT = T * TOPK;
constexpr int DPOOL = 512, DREC = 512, DINAB = 1536;
constexpr float LN_EPS = 1e-5f;
constexpr float DN_ALPHA = 1.6817928305074292f;

constexpr size_t MiB = 1ull << 20;
constexpr size_t WS_CTL = 0, CTL_ZERO_BYTES = 1 * MiB;
constexpr size_t WS_MOD = 1 * MiB;
constexpr size_t WS_BR = 3 * MiB;
constexpr size_t WS_BPOOL = 5 * MiB;
constexpr size_t WS_BGATE = 6 * MiB;
constexpr size_t WS_WSM = 8 * MiB;
constexpr size_t WS_BIASRI = 8 * MiB + 512 * 1024;
constexpr size_t WS_B1P = 9 * MiB;
constexpr size_t WS_SUMM = 10 * MiB;
constexpr size_t WS_TOPG = 12 * MiB;
constexpr size_t WS_ABIN = 16 * MiB;
constexpr size_t WS_ABOUT = 22 * MiB;
constexpr size_t WS_SGIN = 26 * MiB;
constexpr size_t WS_SGOUT = 34 * MiB;
constexpr size_t WS_LOG = 40 * MiB;
constexpr size_t WS_LIST = 64 * MiB;
constexpr size_t WS_BRB = 128 * MiB;
constexpr size_t WS_CB = 140 * MiB;
constexpr size_t WS_W1T = 128 * MiB;
constexpr size_t WS_W2T = 640 * MiB;
constexpr size_t WS_H = 896 * MiB;
constexpr size_t WS_Z = 1024 * MiB;
constexpr size_t WS_A2 = 1280 * MiB;
constexpr size_t WS_RI = 1408 * MiB;
constexpr size_t WS_YMIX = 1536 * MiB;
constexpr size_t WS_Y = 1664 * MiB;
constexpr size_t WS_ACT = 1792 * MiB;
constexpr size_t WS_YS = 2304 * MiB;
constexpr size_t WS_W1T8 = 2944 * MiB;
constexpr size_t WS_W2T8 = 3200 * MiB;
constexpr size_t WS_H8 = 3328 * MiB;
constexpr size_t WS_ACT8 = 3392 * MiB;
constexpr size_t WS_XB = 2816 * MiB;
constexpr size_t WS_END = 3648 * MiB;

constexpr int CW_BAR = 4096;
constexpr int CW_CNT = 16384;

constexpr int PH_CONV = 0, PH_H0 = 1, PH_L0 = 2, PH_PER_LAYER = 12, NPH = PH_L0 + PH_PER_LAYER * DEPTH;
__host__ __device__ constexpr bool phase_exists(int ph) {
    if (ph < PH_L0) return true;
    const int l = (ph - PH_L0) / PH_PER_LAYER, s = (ph - PH_L0) % PH_PER_LAYER;
    if ((l & 1) && (s == 2 || s == 3 || s == 4)) return false;
    return true;
}

constexpr int LDS_BYTES = 155648;
constexpr int LDSCTL_OFF = 154624;
constexpr int NXT_OFF = 131072;
constexpr int TAB_OFF = 147456;
constexpr int UTAB_OFF = 153600;

__device__ __forceinline__ unsigned f2bf(float f) { unsigned u = __builtin_bit_cast(unsigned, f); return (u + 0x7fffu + ((u >> 16) & 1u)) >> 16; }
typedef __bf16 bf16v2_t __attribute__((ext_vector_type(2)));
__device__ __forceinline__ unsigned pk2(float lo, float hi) { const f32x2 f = {lo, hi}; return __builtin_bit_cast(unsigned, __builtin_convertvector(f, bf16v2_t)); }
__device__ __forceinline__ float bflo(unsigned w) { return __builtin_bit_cast(float, w << 16); }
__device__ __forceinline__ float bfhi(unsigned w) { return __builtin_bit_cast(float, w & 0xffff0000u); }
__device__ __forceinline__ float bf2f(bf16_t h) { return __builtin_bit_cast(float, ((unsigned)h) << 16); }
__device__ __forceinline__ unsigned cvt_pk_bf16(float lo, float hi) { return pk2(lo, hi); }
__device__ __forceinline__ unsigned pk4_fp8(float a, float b, float c, float d) { int w = 0; w = __builtin_amdgcn_cvt_pk_fp8_f32(a, b, w, false); w = __builtin_amdgcn_cvt_pk_fp8_f32(c, d, w, true); return (unsigned)w; }
__device__ __forceinline__ float fast_sigmoid(float x) { return __builtin_amdgcn_rcpf(1.0f + __builtin_amdgcn_exp2f(-1.4426950408889634f * x)); }
__device__ __forceinline__ float gelu_tanh(float x) { const float u = x * (1.5957691216057308f + 0.07135481627362202f * x * x); return x * fast_sigmoid(u); }
__device__ __forceinline__ f32x2 pk_sigmoid_scaled(f32x2 x, float nk) {
    const f32x2 t = x * nk; f32x2 e; e.x = __builtin_amdgcn_exp2f(t.x); e.y = __builtin_amdgcn_exp2f(t.y);
    const f32x2 d = e + 1.0f; f32x2 r; r.x = __builtin_amdgcn_rcpf(d.x); r.y = __builtin_amdgcn_rcpf(d.y); return r; }
__device__ __forceinline__ f32x2 pk_gelu_tanh(f32x2 x) {
    const f32x2 t = x * ((x * x) * (-0.07135481627362202f * 1.4426950408889634f) + (-1.5957691216057308f * 1.4426950408889634f));
    f32x2 e; e.x = __builtin_amdgcn_exp2f(t.x); e.y = __builtin_amdgcn_exp2f(t.y);
    const f32x2 d = e + 1.0f; f32x2 r; r.x = __builtin_amdgcn_rcpf(d.x); r.y = __builtin_amdgcn_rcpf(d.y); return x * r; }
__device__ __forceinline__ float wave_sum(float v, int lane) {
#pragma unroll
    for (int o = 1; o < 64; o <<= 1) v += __builtin_bit_cast(float, __builtin_amdgcn_ds_bpermute((lane ^ o) << 2, __builtin_bit_cast(int, v)));
    return v;
}

__device__ __forceinline__ int lane_id_asm() { int l; asm volatile("v_mbcnt_lo_u32_b32 %0, -1, 0\n\tv_mbcnt_hi_u32_b32 %0, -1, %0" : "=v"(l)); return l; }
#define XB_TMO      128
#define XB_XCNT(j)  (256  + 64 * (j))
#define XB_XSUB(j)  (1280 + 64 * (j))
#define XB_XGEN(j)  (2304 + 64 * (j))
#define XB_TOP      3328
#define XB_TOPGEN   3392
#define XCD_BAR_WORDS 3456
#define XB_SPIN_CAP (1u << 18)

__device__ __forceinline__ unsigned xb_ld(unsigned* p)              { return __hip_atomic_load(p, __ATOMIC_RELAXED, __HIP_MEMORY_SCOPE_AGENT); }
__device__ __forceinline__ unsigned xb_add(unsigned* p, unsigned v) { return __hip_atomic_fetch_add(p, v, __ATOMIC_RELAXED, __HIP_MEMORY_SCOPE_AGENT); }
__device__ __forceinline__ unsigned xb_xcc_id() { return (unsigned)__builtin_amdgcn_s_getreg((3 << 11) | 20) & 0xFu; }
#define XB_SPIN(cond, bar) do { unsigned _sp = 0; while (cond) { __builtin_amdgcn_s_sleep(1); \
    if ((++_sp & 255u) == 0u) { if (xb_ld(&(bar)[XB_TMO])) break; if (_sp > XB_SPIN_CAP) { atomicAdd(&(bar)[XB_TMO], 1u); break; } } } } while (0)

struct XcdBarrier {
    unsigned* bar; unsigned x; int wv;
    volatile LAS unsigned* st;
};

__device__ __forceinline__ XcdBarrier xcd_barrier_post(unsigned* bar, volatile LAS unsigned* st, int wv) {
    XcdBarrier b; b.bar = bar; b.x = xb_xcc_id(); b.st = st; b.wv = wv;
    if (wv == 0 && lane_id_asm() == 0) (void)xb_add(&bar[XB_XCNT(b.x)], 1u);
    return b;
}
__device__ __forceinline__ void xcd_barrier_complete(unsigned* bar, unsigned x, unsigned& nloc, unsigned& nx) {
    const unsigned G = gridDim.x * gridDim.y * gridDim.z;
    unsigned sum, cnt, mine, sp = 0u;
    for (;;) {
        sum = 0u; cnt = 0u; mine = 0u;
#pragma unroll
        for (unsigned j = 0; j < 16; ++j) { const unsigned c = xb_ld(&bar[XB_XCNT(j)]); sum += c; cnt += (c > 0u) ? 1u : 0u; mine = (j == x) ? c : mine; }
        if (sum == G) break;
        __builtin_amdgcn_s_sleep(1);
        if ((++sp & 255u) == 0u) { if (xb_ld(&bar[XB_TMO])) break; if (sp > XB_SPIN_CAP) { atomicAdd(&bar[XB_TMO], 1u); break; } }
    }
    nloc = mine > 0u ? mine : 1u; nx = cnt > 0u ? cnt : 1u;
}

__device__ __forceinline__ void xcd_barrier(const XcdBarrier& b) {
    asm volatile("s_waitcnt vmcnt(0)" ::: "memory");
    __syncthreads();
    if (b.wv == 0 && lane_id_asm() == 0) {
        unsigned* bar = b.bar;
        __builtin_amdgcn_s_waitcnt(0);
        unsigned nloc = b.st[0], nx = b.st[1];
        if (nloc == 0u) { xcd_barrier_complete(bar, b.x, nloc, nx); b.st[0] = nloc; b.st[1] = nx; }
        const unsigned old = xb_add(&bar[XB_XSUB(b.x)], 1u);
        const unsigned gen = old / nloc;
        if (old + 1u == (gen + 1u) * nloc) {
            __builtin_amdgcn_fence(__ATOMIC_RELEASE, "agent");
            asm volatile("s_waitcnt vmcnt(0)" ::: "memory");
            const unsigned og = xb_add(&bar[XB_TOP], 1u);
            const unsigned tg = og / nx;
            if (og + 1u == (tg + 1u) * nx) xb_add(&bar[XB_TOPGEN], 1u);
            else XB_SPIN(xb_ld(&bar[XB_TOPGEN]) == tg, bar);
            __builtin_amdgcn_fence(__ATOMIC_ACQUIRE, "agent");
            xb_add(&bar[XB_XGEN(b.x)], 1u);
            asm volatile("s_waitcnt vmcnt(0)" ::: "memory");
        } else {
            XB_SPIN(xb_ld(&bar[XB_XGEN(b.x)]) == gen, bar);
            __builtin_amdgcn_fence(__ATOMIC_ACQUIRE, "agent");
            asm volatile("s_waitcnt vmcnt(0)" ::: "memory");
        }
    }
    __syncthreads();
}

#ifdef PROBE_VARIANTS
__device__ __forceinline__ int kvariant() { return *(const __attribute__((address_space(4))) int*)((const __attribute__((address_space(4))) unsigned char*)__builtin_amdgcn_kernarg_segment_ptr() + 280); }
#endif
__device__ __forceinline__ void glds16(const char* sbase, unsigned voff, unsigned lds_dst) {
    unsigned keep;
    asm volatile("s_mov_b32 %0, m0\n\ts_mov_b32 m0, %3\n\ts_nop 0\n\tglobal_load_lds_dwordx4 %1, %2\n\ts_mov_b32 m0, %0" : "=&s"(keep) : "v"(voff), "s"(sbase), "s"(lds_dst) : "memory");
}
__device__ __forceinline__ void glds4(const char* sbase, unsigned voff, unsigned lds_dst) {
    unsigned keep;
    asm volatile("s_mov_b32 %0, m0\n\ts_mov_b32 m0, %3\n\ts_nop 0\n\tglobal_load_lds_dword %1, %2\n\ts_mov_b32 m0, %0" : "=&s"(keep) : "v"(voff), "s"(sbase), "s"(lds_dst) : "memory");
}
namespace pg8 {
constexpr int BM = 256, BK = 64, HALF = 128, HTB = HALF * BK * 2, STAGE_BYTES = 8 * HTB, NXCD = 8, WGM = 8;
__host__ __device__ __forceinline__ int perm32(int rho) { const int n = rho >> 4, i = rho & 15; return 8 * (i >> 2) + 4 * n + (i & 3); }

template <bool F8> __host__ __device__ __forceinline__ int chunk_xor(int r15) { const int rp = (r15 >> 1) & 7; return F8 ? ((rp & 4) | ((rp & 1) << 1) | ((rp >> 1) & 1)) : rp; }
struct Unit { int arow, brow, pn, e, rt, cnt, slot, koff; };
struct Gemm { const void* A; const void* Bt; int lda, ldb, K, wscale; };
typedef int i32x4 __attribute__((ext_vector_type(4)));
typedef int i32x8 __attribute__((ext_vector_type(8)));
__device__ __forceinline__ i32x8 cat8(bf16x8 lo, bf16x8 hi) { return __builtin_shufflevector(__builtin_bit_cast(i32x4, lo), __builtin_bit_cast(i32x4, hi), 0, 1, 2, 3, 4, 5, 6, 7); }

struct DenseSched {
    static constexpr bool GATHER = false;
    int nM, nN, nwg, G, c, kblk = 0, bb = 0, rowm = 0;
    __device__ __forceinline__ void init(int M, int N, int G_, int c_) { nM = M / BM; nN = N / BM; nwg = nM * nN; G = G_; c = c_; }
    __device__ __forceinline__ bool next(int i, Unit& u) const {
        int pm, pn;
        if (rowm) { if (i >= nN) return false; pm = (c % NXCD) * (G / NXCD) + c / NXCD; pn = i; }
        else {
        const long L = (long)i * G + c; if (L >= nwg) return false;
        int wgid = (int)L; { const int q = nwg / NXCD, r = nwg % NXCD, xcd = wgid % NXCD, off = wgid / NXCD; wgid = (xcd < r ? xcd * (q + 1) : r * (q + 1) + (xcd - r) * q) + off; }
        const int nig = WGM * nN, gid = wgid / nig, fm = gid * WGM, gsz = (nM - fm) < WGM ? (nM - fm) : WGM;
        pm = fm + ((wgid % nig) % gsz); pn = (wgid % nig) / gsz; }
        u.arow = pm * BM; u.brow = pn * BM; u.pn = pn; u.e = 0; u.rt = pm; u.cnt = BM; u.slot = 0; u.koff = (pn & 1) * kblk; u.brow += ((pm * BM) >> 12) * bb; return true;
    }
    __device__ __forceinline__ void a_off(const Unit& u, LAS unsigned char*, int R0, int C0, int lda2, unsigned (&off)[2][2]) const {
#pragma unroll
        for (int h = 0; h < 2; ++h)
#pragma unroll
            for (int i = 0; i < 2; ++i) off[h][i] = (unsigned)((u.arow + 128 * h + 64 * i + R0) * lda2 + C0);
    }
};

struct MoeSched {
    static constexpr bool GATHER = true;
    const LAS int* utab;
    const int* list;
    const float* bias;
    int nunits, nexp_rows, shift;
    __device__ __forceinline__ bool next(int i, Unit& u) const {
        if (i >= nunits) return false;
        const LAS int* p = utab + 4 * i;
        u.e = __builtin_amdgcn_readfirstlane(p[0]); u.rt = __builtin_amdgcn_readfirstlane(p[1]); u.pn = __builtin_amdgcn_readfirstlane(p[2]); u.cnt = __builtin_amdgcn_readfirstlane(p[3]);
        u.arow = 0; u.brow = u.e * nexp_rows + u.pn * BM; u.slot = i % 3; u.koff = 0; return true;
    }
    __device__ __forceinline__ void tab_issue(const Unit& u, unsigned ldsb, int wid, int lane) const {
        if (wid < 4) { int p = u.rt * BM + 64 * wid + lane; p = p < u.cnt ? p : u.cnt - 1;
            glds4((const char*)(list + (size_t)u.e * TKTOT), (unsigned)p * 4u, ldsb + TAB_OFF + u.slot * 1024 + wid * 256); }
        else glds4((const char*)(bias + (size_t)u.e * nexp_rows + u.pn * BM), (unsigned)(64 * (wid - 4) + lane) * 4u, ldsb + TAB_OFF + 3072 + u.slot * 1024 + (wid - 4) * 256);
    }
    __device__ __forceinline__ void a_off(const Unit& u, LAS unsigned char* lds, int R0, int C0, int lda2, unsigned (&off)[2][2]) const {
        const LAS int* ids = (const LAS int*)(lds + TAB_OFF + u.slot * 1024);
#pragma unroll
        for (int h = 0; h < 2; ++h)
#pragma unroll
            for (int i = 0; i < 2; ++i) off[h][i] = (unsigned)((ids[128 * h + 64 * i + R0] >> shift) * lda2 + C0);
    }
};
__device__ __forceinline__ int moe_build_units(LAS int* utab, const volatile LAS int* tstart, const volatile LAS int* cnts, int NP, int G, int c, int tid) {
    const int total = tstart[NE] * NP;
    if (tid < 64) { const int L = tid * G + c;
        if (L < total) { int e = 0;
            for (int q = 0; q < NE - 1; ++q) if (tstart[q + 1] * NP <= L) e = q + 1;
            const int t0 = tstart[e], nte = tstart[e + 1] - t0, idx = L - t0 * NP;
            utab[4 * tid + 0] = e; utab[4 * tid + 1] = idx % nte; utab[4 * tid + 2] = idx / nte; utab[4 * tid + 3] = cnts[e]; } }
    return total > c ? (total - c + G - 1) / G : 0;
}

template <int ACT  , bool HAS_BIAS, bool HAS_SCALE, bool OSC = false, bool OUT8 = false> struct EpiDense {
    static constexpr int PERM = WIDE_EPI ? 2 : 1;
    bf16_t* O; int ldc; const float* bias; const float* scale; float oscale;
    __device__ __forceinline__ void operator()(const f32x4 (&acc)[2][2][4][2], const Unit& u, int wr, int wc, int fr, int fq) const {
        const int row0 = u.arow + wr * 64 + fr, col0 = PERM == 2 ? u.pn * BM + wc * 64 + 16 * fq : u.pn * BM + wc * 32 + 8 * fq;
        constexpr int BJS = PERM == 2 ? 8 : HALF;
        f32x4 bv[2][2], sv[2][2];
#pragma unroll
        for (int bj = 0; bj < 2; ++bj)
#pragma unroll
            for (int n = 0; n < 2; ++n) {
                if (HAS_BIAS) bv[bj][n] = *(const f32x4*)(bias + col0 + bj * BJS + 4 * n);
                if (HAS_SCALE) sv[bj][n] = *(const f32x4*)(scale + col0 + bj * BJS + 4 * n);
            }
#pragma unroll
        for (int ai = 0; ai < 2; ++ai)
#pragma unroll
            for (int m = 0; m < 4; ++m) { bf16_t* rowp = O + (size_t)(row0 + ai * HALF + m * 16) * ldc + col0; unsigned char* rowp8 = (unsigned char*)O + (size_t)(row0 + ai * HALF + m * 16) * ldc + col0;
                u32x4 w8;
#pragma unroll
                for (int bj = 0; bj < 2; ++bj) { f32x4 v0 = acc[ai][bj][m][0], v1 = acc[ai][bj][m][1];
                    if (OSC) { v0 = v0 * oscale; v1 = v1 * oscale; }
                    if (HAS_BIAS) { v0 = v0 + bv[bj][0]; v1 = v1 + bv[bj][1]; }
                    if (ACT == 1) { const f32x2 a = pk_gelu_tanh((f32x2){v0[0], v0[1]}), b = pk_gelu_tanh((f32x2){v0[2], v0[3]}), c = pk_gelu_tanh((f32x2){v1[0], v1[1]}), d = pk_gelu_tanh((f32x2){v1[2], v1[3]});
                        v0 = (f32x4){a.x, a.y, b.x, b.y}; v1 = (f32x4){c.x, c.y, d.x, d.y}; }
                    if (ACT == 2) { const float nk = -1.4426950408889634f;
                        const f32x2 a = pk_sigmoid_scaled((f32x2){v0[0], v0[1]}, nk), b = pk_sigmoid_scaled((f32x2){v0[2], v0[3]}, nk), c = pk_sigmoid_scaled((f32x2){v1[0], v1[1]}, nk), d = pk_sigmoid_scaled((f32x2){v1[2], v1[3]}, nk);
                        v0 = (f32x4){a.x, a.y, b.x, b.y}; v1 = (f32x4){c.x, c.y, d.x, d.y}; }
                    if (HAS_SCALE) { v0 = v0 * sv[bj][0]; v1 = v1 * sv[bj][1]; }
                    if constexpr (OUT8) { const unsigned p0 = pk4_fp8(v0[0], v0[1], v0[2], v0[3]), p1 = pk4_fp8(v1[0], v1[1], v1[2], v1[3]);
                        if constexpr (PERM == 2) { if (bj == 0) { w8.x = p0; w8.y = p1; } else { w8.z = p0; w8.w = p1; *(u32x4*)rowp8 = w8; } }
                        else { u32x2 w; w.x = p0; w.y = p1; *(u32x2*)(rowp8 + bj * HALF) = w; } }
                    else { u32x4 w; w.x = cvt_pk_bf16(v0[0], v0[1]); w.y = cvt_pk_bf16(v0[2], v0[3]); w.z = cvt_pk_bf16(v1[0], v1[1]); w.w = cvt_pk_bf16(v1[2], v1[3]);
                    *(u32x4*)(rowp + bj * BJS) = w; } } }
    }
};
struct EpiRouter {
    static constexpr int PERM = 0;
    float* LOG;
    __device__ __forceinline__ void operator()(const f32x4 (&acc)[2][2][4][2], const Unit& u, int wr, int wc, int fr, int fq) const {
        if (wc < 2) {
#pragma unroll
            for (int ai = 0; ai < 2; ++ai)
#pragma unroll
                for (int m = 0; m < 4; ++m) { float* rowp = LOG + (size_t)(u.arow + ai * HALF + wr * 64 + m * 16 + fr) * 64 + wc * 32 + 4 * fq;
#pragma unroll
                    for (int n = 0; n < 2; ++n) *(f32x4*)(rowp + 16 * n) = acc[ai][0][m][n]; }
        }
    }
};
template <bool OUT8> struct EpiMoe1 {
    static constexpr int PERM = 0;
    bf16_t* ACT; LAS unsigned char* lds; float oscale;
    __device__ __forceinline__ void operator()(const f32x4 (&acc)[2][2][4][2], const Unit& u, int wr, int wc, int fr, int fq) const {
        const LAS int* ids = (const LAS int*)(lds + TAB_OFF + u.slot * 1024);
        const LAS float* bp = (const LAS float*)(lds + TAB_OFF + 3072 + u.slot * 1024) + wc * 32 + 4 * fq;
        f32x4 bg[2], bl[2];
#pragma unroll
        for (int bj = 0; bj < 2; ++bj) { bg[bj] = *(const LAS f32x4*)(bp + bj * HALF); bl[bj] = *(const LAS f32x4*)(bp + bj * HALF + 16) + 1.0f; }
        const int j0 = u.pn * 128 + wc * 32 + 8 * fq;
#pragma unroll
        for (int ai = 0; ai < 2; ++ai)
#pragma unroll
            for (int m = 0; m < 4; ++m) {
                const int pl = ai * HALF + wr * 64 + m * 16 + fr;
                if (u.rt * BM + pl < u.cnt) {
                    const int flat = ids[pl];
                    float o[8];
#pragma unroll
                    for (int bj = 0; bj < 2; ++bj) { const f32x4 g = acc[ai][bj][m][0] * oscale + bg[bj], l = acc[ai][bj][m][1] * oscale + bl[bj];
#pragma unroll
                        for (int hh = 0; hh < 2; ++hh) {
                            const f32x2 xg = {fminf(g[2 * hh], 7.0f), fminf(g[2 * hh + 1], 7.0f)};
                            const f32x2 xl = {__builtin_amdgcn_fmed3f(l[2 * hh], -6.0f, 8.0f), __builtin_amdgcn_fmed3f(l[2 * hh + 1], -6.0f, 8.0f)};
                            const f32x2 r = pk_sigmoid_scaled(xg, -1.702f * 1.4426950408889634f), oo = (xg * xl) * r;
                            o[bj * 4 + 2 * hh] = oo.x; o[bj * 4 + 2 * hh + 1] = oo.y; } }
                    if constexpr (OUT8) { u32x2 w; w.x = pk4_fp8(o[0], o[1], o[2], o[3]); w.y = pk4_fp8(o[4], o[5], o[6], o[7]);
                        *(u32x2*)((unsigned char*)ACT + (size_t)flat * 1024 + j0) = w; }
                    else { u32x4 w; w.x = cvt_pk_bf16(o[0], o[1]); w.y = cvt_pk_bf16(o[2], o[3]); w.z = cvt_pk_bf16(o[4], o[5]); w.w = cvt_pk_bf16(o[6], o[7]);
                        *(u32x4*)(ACT + (size_t)flat * 1024 + j0) = w; }
                }
            }
    }
};
struct EpiMoe2 {
    static constexpr int PERM = (WIDE_EPI && FP8_YS) ? 2 : 1;
    bf16_t* YS; LAS unsigned char* lds; float oscale;
    __device__ __forceinline__ void operator()(const f32x4 (&acc)[2][2][4][2], const Unit& u, int wr, int wc, int fr, int fq) const {
        const LAS int* ids = (const LAS int*)(lds + TAB_OFF + u.slot * 1024);
        if constexpr (PERM == 2) {
            const LAS float* bp = (const LAS float*)(lds + TAB_OFF + 3072 + u.slot * 1024) + wc * 64 + 16 * fq;
            const int col0 = u.pn * BM + wc * 64 + 16 * fq;
            const float os = 16.0f * oscale;
#pragma unroll
            for (int ai = 0; ai < 2; ++ai) {
                const f32x4 b00 = *(const LAS f32x4*)(bp) * 16.0f, b01 = *(const LAS f32x4*)(bp + 4) * 16.0f, b10 = *(const LAS f32x4*)(bp + 8) * 16.0f, b11 = *(const LAS f32x4*)(bp + 12) * 16.0f;
#pragma unroll
                for (int m = 0; m < 4; ++m) {
                    const int pl = ai * HALF + wr * 64 + m * 16 + fr;
                    if (u.rt * BM + pl < u.cnt) {
                        const int flat = ids[pl];
                        const f32x4 v00 = acc[ai][0][m][0] * os + b00, v01 = acc[ai][0][m][1] * os + b01, v10 = acc[ai][1][m][0] * os + b10, v11 = acc[ai][1][m][1] * os + b11;
                        u32x4 w; w.x = pk4_fp8(v00[0], v00[1], v00[2], v00[3]); w.y = pk4_fp8(v01[0], v01[1], v01[2], v01[3]); w.z = pk4_fp8(v10[0], v10[1], v10[2], v10[3]); w.w = pk4_fp8(v11[0], v11[1], v11[2], v11[3]);
                        *(u32x4*)((unsigned char*)YS + (size_t)flat * 1024 + col0) = w;
                    }
                }
            }
        } else {
        const LAS float* bp = (const LAS float*)(lds + TAB_OFF + 3072 + u.slot * 1024) + wc * 32 + 8 * fq;
        const int col0 = u.pn * BM + wc * 32 + 8 * fq;
#pragma unroll
        for (int bj = 0; bj < 2; ++bj) {
            const float os = FP8_YS ? 16.0f * oscale : oscale;
            const f32x4 b0 = *(const LAS f32x4*)(bp + bj * HALF) * (FP8_YS ? 16.0f : 1.0f), b1 = *(const LAS f32x4*)(bp + bj * HALF + 4) * (FP8_YS ? 16.0f : 1.0f);
#pragma unroll
            for (int ai = 0; ai < 2; ++ai)
#pragma unroll
                for (int m = 0; m < 4; ++m) {
                    const int pl = ai * HALF + wr * 64 + m * 16 + fr;
                    if (u.rt * BM + pl < u.cnt) {
                        const int flat = ids[pl];
                        const f32x4 v0 = acc[ai][bj][m][0] * os + b0, v1 = acc[ai][bj][m][1] * os + b1;
                        if (FP8_YS) { u32x2 w; w.x = pk4_fp8(v0[0], v0[1], v0[2], v0[3]); w.y = pk4_fp8(v1[0], v1[1], v1[2], v1[3]);
                            *(u32x2*)((unsigned char*)YS + (size_t)flat * 1024 + col0 + bj * HALF) = w; }
                        else { u32x4 w; w.x = cvt_pk_bf16(v0[0], v0[1]); w.y = cvt_pk_bf16(v0[2], v0[3]); w.z = cvt_pk_bf16(v1[0], v1[1]); w.w = cvt_pk_bf16(v1[2], v1[3]);
                            *(u32x4*)(YS + (size_t)flat * 1024 + col0 + bj * HALF) = w; }
                    }
                }
        }
        }
    }
};

template <bool F8, class Epi, class Sched>
__device__ __forceinline__ void gemm_phase(LAS unsigned char* lds, const Gemm g, const Sched& S, const Epi& E, const int wave0) {
    const int tid = (wave0 << 6) | lane_id_asm();
    const int wid = __builtin_amdgcn_readfirstlane(tid >> 6), lane = tid & 63, wr = wid >> 2, wc = wid & 3, fr = lane & 15, fq = lane >> 4;
    constexpr unsigned ESZ = F8 ? 1u : 2u;
    const int nt = (int)((unsigned)g.K * ESZ / 128u);
    int R0, C0;
    R0 = 8 * wid + (lane >> 3); C0 = 16 * ((lane & 7) ^ chunk_xor<F8>(R0 & 15));
    const unsigned lda2 = (unsigned)g.lda * ESZ, ldb2 = (unsigned)g.ldb * ESZ;
    const unsigned voffB = (unsigned)((Epi::PERM == 2 ? (64 * (R0 >> 5) + 16 * ((R0 >> 2) & 3) + 4 * ((R0 >> 4) & 1) + (R0 & 3)) : Epi::PERM == 1 ? ((R0 & ~31) + perm32(R0 & 31)) : R0) * (int)ldb2 + C0);
    constexpr int PIECE_B = Epi::PERM == 2 ? 128 : 64;
    const unsigned aoffl = (unsigned)(R0 * (int)lda2 + C0);
    const unsigned kstep = 128;
    const size_t hstepB = (size_t)(Epi::PERM == 2 ? 8 : HALF) * ldb2;
    const unsigned ldsw = (unsigned)wid * 1024u;
    const int ab = fr * 128 + 16 * ((F8 ? 2 * fq : fq) ^ chunk_xor<F8>(fr));
    const int aoff0 = wr * 8192 + ab, boff0 = wc * 4096 + ab;
    constexpr int KX = F8 ? 16 : 64;
    const char* const Abase = (const char*)g.A;
    const unsigned ldsb = (unsigned)(size_t)lds;
#define PG8_SA(b, h) (((b) * 2 + (h)) * HTB)
#define PG8_SB(b, h) ((4 + (b) * 2 + (h)) * HTB)
#define PG8_GOFF(h, NXT) do { if constexpr (Sched::GATHER) go = *(const LAS u32x2*)(lds + NXT_OFF + ((((NXT) ? ui + 1 : ui) & 1) << 13) + tid * 16 + (h) * 8); } while (0)
#define PG8_STAGE_A(bufoff, h, NXT, kb) do { _Pragma("unroll") for (int _i = 0; _i < 2; ++_i) { \
        if constexpr (Sched::GATHER) glds16(Abase + (kb), _i ? go.y : go.x, ldsb + (bufoff) + ldsw + _i * 8192); \
        else glds16(Abase + ((NXT) ? nxtA : curA) + (size_t)((h) * 128 + _i * 64) * lda2 + (kb), aoffl, ldsb + (bufoff) + ldsw + _i * 8192); } } while (0)
#define PG8_STAGE_B(bufoff, bptr, kb) do { _Pragma("unroll") for (int _i = 0; _i < 2; ++_i) \
        glds16((bptr) + (size_t)(_i * PIECE_B) * ldb2 + (kb), voffB, ldsb + (bufoff) + ldsw + _i * 8192); } while (0)
#define PG8_LDA(dst, b, h) do { int _a1 = aoff0 ^ KX; asm volatile("" : "+v"(_a1)); \
        _Pragma("unroll") for (int m = 0; m < 4; ++m) _Pragma("unroll") for (int k = 0; k < 2; ++k) dst[m][k] = *(const LAS bf16x8*)(lds + PG8_SA(b, h) + (k ? _a1 : aoff0) + m * 2048); } while (0)
#define PG8_LDB(dst, b, h) do { int _b1 = boff0 ^ KX; asm volatile("" : "+v"(_b1)); \
        _Pragma("unroll") for (int n = 0; n < 2; ++n) _Pragma("unroll") for (int k = 0; k < 2; ++k) dst[n][k] = *(const LAS bf16x8*)(lds + PG8_SB(b, h) + (k ? _b1 : boff0) + n * 2048); } while (0)
#define PG8_MMA(ai, bj, At, Bt) do { __builtin_amdgcn_s_setprio(1); _Pragma("unroll") for (int m = 0; m < 4; ++m) _Pragma("unroll") for (int n = 0; n < 2; ++n) { \
        if constexpr (F8) acc[ai][bj][m][n] = __builtin_amdgcn_mfma_scale_f32_16x16x128_f8f6f4(cat8(Bt[n][0], Bt[n][1]), cat8(At[m][0], At[m][1]), acc[ai][bj][m][n], 0, 0, 0, 0, 0, 0); \
        else { _Pragma("unroll") for (int k = 0; k < 2; ++k) acc[ai][bj][m][n] = __builtin_amdgcn_mfma_f32_16x16x32_bf16(Bt[n][k], At[m][k], acc[ai][bj][m][n], 0, 0, 0); } } \
        __builtin_amdgcn_s_setprio(0); } while (0)
#define PG8_WAIT_V(n) asm volatile("s_waitcnt vmcnt(" #n ")" ::: "memory")
#define PG8_WAIT_L(n) asm volatile("s_waitcnt lgkmcnt(" #n ")" ::: "memory")
#define PG8_BAR __builtin_amdgcn_s_barrier()
#define PG8_SCHED __builtin_amdgcn_sched_barrier(0)
#define PG8_KITER(k1, b2, NXT, k2, k3) do { \
        PG8_GOFF(1, 0); PG8_LDB(B0, 0, 0); PG8_LDB(B1, 0, 1); PG8_SCHED; PG8_LDA(At, 0, 0); PG8_STAGE_A(PG8_SA(1, 1), 1, 0, (k1)); \
        PG8_WAIT_V(8); PG8_WAIT_L(0); PG8_BAR; PG8_MMA(0, 0, At, B0); PG8_MMA(0, 1, At, B1); PG8_BAR; PG8_SCHED; \
        PG8_GOFF(0, NXT); PG8_LDA(At, 0, 1); PG8_STAGE_B(PG8_SB(0, 0), (b2), (k2)); PG8_STAGE_B(PG8_SB(0, 1), (b2) + hstepB, (k2)); PG8_STAGE_A(PG8_SA(0, 0), 0, NXT, (k2)); \
        PG8_WAIT_V(8); PG8_WAIT_L(0); PG8_BAR; PG8_MMA(1, 0, At, B0); PG8_MMA(1, 1, At, B1); PG8_BAR; PG8_SCHED; \
        PG8_GOFF(1, NXT); PG8_LDB(B0, 1, 0); PG8_LDB(B1, 1, 1); PG8_SCHED; PG8_LDA(At, 1, 0); PG8_STAGE_A(PG8_SA(0, 1), 1, NXT, (k2)); \
        PG8_WAIT_V(8); PG8_WAIT_L(0); PG8_BAR; PG8_MMA(0, 0, At, B0); PG8_MMA(0, 1, At, B1); PG8_BAR; PG8_SCHED; \
        PG8_GOFF(0, NXT); PG8_LDA(At, 1, 1); PG8_STAGE_B(PG8_SB(1, 0), (b2), (k3)); PG8_STAGE_B(PG8_SB(1, 1), (b2) + hstepB, (k3)); PG8_STAGE_A(PG8_SA(1, 0), 0, NXT, (k3)); \
        PG8_WAIT_V(8); PG8_WAIT_L(0); PG8_BAR; PG8_MMA(1, 0, At, B0); PG8_MMA(1, 1, At, B1); PG8_BAR; PG8_SCHED; } while (0)

    Unit cur, nxt; int ui = 0;
    if (!S.next(0, cur)) return;
    unsigned curoff[2][2], nxtoff[2][2];
    size_t curA = 0, nxtA = 0;
    bool has_next = S.next(1, nxt);
#define PG8_NXT_SLOT ((LAS u32x4*)(lds + NXT_OFF) + tid)
    if constexpr (Sched::GATHER) {
        S.tab_issue(cur, ldsb, wid, lane); if (has_next) S.tab_issue(nxt, ldsb, wid, lane);
        asm volatile("s_waitcnt vmcnt(0)" ::: "memory"); __builtin_amdgcn_s_barrier(); asm volatile("" ::: "memory");
        S.a_off(cur, lds, R0, C0, (int)lda2, curoff);
        if (has_next) S.a_off(nxt, lds, R0, C0, (int)lda2, nxtoff);
        else {
#pragma unroll
            for (int h = 0; h < 2; ++h)
#pragma unroll
                for (int i = 0; i < 2; ++i) nxtoff[h][i] = curoff[h][i]; }
        ((LAS u32x4*)(lds + NXT_OFF))[tid] = (u32x4){curoff[0][0], curoff[0][1], curoff[1][0], curoff[1][1]};
        ((LAS u32x4*)(lds + NXT_OFF + 8192))[tid] = (u32x4){nxtoff[0][0], nxtoff[0][1], nxtoff[1][0], nxtoff[1][1]};
    } else { curA = (size_t)cur.arow * lda2 + cur.koff; nxtA = has_next ? (size_t)nxt.arow * lda2 + nxt.koff : curA; }
    f32x4 acc[2][2][4][2];
#pragma unroll
    for (int a = 0; a < 2; ++a)
#pragma unroll
        for (int b = 0; b < 2; ++b)
#pragma unroll
            for (int m = 0; m < 4; ++m)
#pragma unroll
                for (int n = 0; n < 2; ++n) acc[a][b][m][n] = (f32x4){0.f, 0.f, 0.f, 0.f};
    bf16x8 At[4][2], B0[2][2], B1[2][2];
    const char* cB = (const char*)g.Bt + (size_t)cur.brow * ldb2 + cur.koff;
    u32x2 go = {0u, 0u};
    PG8_STAGE_B(PG8_SB(0, 0), cB, 0u); PG8_STAGE_B(PG8_SB(0, 1), cB + hstepB, 0u); PG8_GOFF(0, 0); PG8_STAGE_A(PG8_SA(0, 0), 0, 0, 0u); PG8_GOFF(1, 0); PG8_STAGE_A(PG8_SA(0, 1), 1, 0, 0u);
    if (wr == 1) PG8_BAR;
    PG8_WAIT_V(2); PG8_BAR;
    PG8_GOFF(0, 0); PG8_STAGE_B(PG8_SB(1, 0), cB, kstep); PG8_STAGE_A(PG8_SA(1, 0), 0, 0, kstep); PG8_STAGE_B(PG8_SB(1, 1), cB + hstepB, kstep);
    PG8_WAIT_V(6); PG8_BAR;
    for (;;) {
        const char* nB = has_next ? (const char*)g.Bt + (size_t)nxt.brow * ldb2 + nxt.koff : cB;
        Unit u2; bool has2 = false;
        if constexpr (Sched::GATHER) has2 = has_next && S.next(ui + 2, u2);
#pragma unroll 1
        for (int t = 0; t < nt - 2; t += 2) {
            const unsigned k1 = (unsigned)(t + 1) * kstep, k2 = (unsigned)(t + 2) * kstep, k3 = (unsigned)(t + 3) * kstep;
            if constexpr (Sched::GATHER) { if (t == 2 && has2) S.tab_issue(u2, ldsb, wid, lane); }
            PG8_KITER(k1, cB, 0, k2, k3);
        }
        { const unsigned k1 = (unsigned)(nt - 1) * kstep; PG8_KITER(k1, nB, 1, 0u, kstep); }
#if PIN_ACC
#pragma unroll
        for (int a = 0; a < 2; ++a)
#pragma unroll
            for (int b = 0; b < 2; ++b)
#pragma unroll
                for (int m = 0; m < 4; ++m) asm volatile("" : "+v"(acc[a][b][m][0]), "+v"(acc[a][b][m][1]));
#endif
        if (wr == 0) PG8_BAR;
#ifdef PROBE_VARIANTS
        if (!(kvariant() & 4))
#endif
        { const int l2 = lane_id_asm(); E(acc, cur, wr, wc, l2 & 15, l2 >> 4); }
        if (!has_next) break;
#pragma unroll
        for (int a = 0; a < 2; ++a)
#pragma unroll
            for (int b = 0; b < 2; ++b)
#pragma unroll
                for (int m = 0; m < 4; ++m)
#pragma unroll
                    for (int n = 0; n < 2; ++n) acc[a][b][m][n] = (f32x4){0.f, 0.f, 0.f, 0.f};
        cur = nxt; cB = nB; ++ui; curA = nxtA;
        has_next = S.next(ui + 1, nxt);
        if (has_next) {
            if constexpr (Sched::GATHER) { const int tz = (wave0 << 6) | lane_id_asm(); int R0z, C0z;
                { const int lz = tz & 63; R0z = 8 * wid + (lz >> 3); C0z = 16 * ((lz & 7) ^ chunk_xor<F8>(R0z & 15)); }
                S.a_off(nxt, lds, R0z, C0z, (int)lda2, nxtoff);
                ((LAS u32x4*)(lds + NXT_OFF + (((ui + 1) & 1) << 13)))[tz] = (u32x4){nxtoff[0][0], nxtoff[0][1], nxtoff[1][0], nxtoff[1][1]}; }
            else nxtA = (size_t)nxt.arow * lda2 + nxt.koff;
        } else if constexpr (Sched::GATHER) { const int tz = (wave0 << 6) | lane_id_asm();
            ((LAS u32x4*)(lds + NXT_OFF + (((ui + 1) & 1) << 13)))[tz] = ((const LAS u32x4*)(lds + NXT_OFF + ((ui & 1) << 13)))[tz]; }
        if (wr == 1) PG8_BAR;
    }
    PG8_WAIT_V(0);
    PG8_BAR;
#undef PG8_SA
#undef PG8_SB
#undef PG8_STAGE_A
#undef PG8_GOFF
#undef PG8_STAGE_B
#undef PG8_LDA
#undef PG8_LDB
#undef PG8_MMA
#undef PG8_WAIT_V
#undef PG8_WAIT_L
#undef PG8_BAR
#undef PG8_SCHED
#undef PG8_KITER
#undef PG8_NXT_SLOT
}
}

struct Args { const float* in[32]; float* out; unsigned char* ws; int ph_lo, ph_hi, variant, pad; };
typedef const __attribute__((address_space(4))) unsigned char* kptr_t;
__device__ __forceinline__ const float* kin(int i) { kptr_t p = (kptr_t)__builtin_amdgcn_kernarg_segment_ptr(); asm volatile("" : "+s"(p)); return *(const float* const __attribute__((address_space(4)))*)(p + 8 * i); }
enum { I_X = 0, I_C, I_MODW, I_MODB, I_LNG, I_LNB, I_ABWIN, I_POOLW, I_POOLS, I_CONVW, I_CONVB, I_WA, I_BA, I_WX, I_BX, I_LAM, I_ABWOUT, I_ABBOUT,
       I_SGWIN, I_SGBIN, I_SGLNG, I_SGLNB, I_SGWS, I_SGBS, I_SGWOUT, I_SGBOUT, I_RW, I_RB, I_W1, I_B1, I_W2, I_B2 };

__device__ __forceinline__ int w1_rho(int n) { const int nn = n & 1, j = n >> 1; return ((j >> 7) << 8) | (((j >> 2) & 1) << 7) | (((j >> 5) & 3) << 5) | (nn << 4) | (((j >> 3) & 3) << 2) | (j & 3); }
__device__ __forceinline__ int w1_n_of_rho(int rho) { const int pn = rho >> 8, bj = (rho >> 7) & 1, wc = (rho >> 5) & 3, nn = (rho >> 4) & 1, fq = (rho >> 2) & 3, i = rho & 3; return 2 * (128 * pn + 32 * wc + 8 * fq + 4 * bj + i) + nn; }
template <bool W1MAP>
__device__ __forceinline__ void conv_item(const float* W, int N, bf16_t* WT, int item, int lane) {
    const int nblk = N >> 5, kb = item / nblk, nb = item - kb * nblk;
    const int kg = lane >> 3, nl = lane & 7, k0 = kb * 64 + kg * 8, n0 = nb * 32 + nl * 4;
    f32x4 v[8];
#pragma unroll
    for (int q = 0; q < 8; ++q) v[q] = *(const f32x4*)(W + (size_t)(k0 + q) * N + n0);
#pragma unroll
    for (int i = 0; i < 4; ++i) {
        const int n = n0 + i, row = W1MAP ? w1_rho(n) : n;
        u32x4 o; o.x = pk2(v[0][i], v[1][i]); o.y = pk2(v[2][i], v[3][i]); o.z = pk2(v[4][i], v[5][i]); o.w = pk2(v[6][i], v[7][i]);
        *(u32x4*)(WT + (size_t)row * 1024 + k0) = o;
    }
}

template <bool W1MAP>
__device__ __forceinline__ void conv_item_f8(const float* W, int N, unsigned char* WT8, int item, int lane, float scale) {
    const int nblk = N >> 5, kb = item / nblk, nb = item - kb * nblk;
    const int kg = lane >> 3, nl = lane & 7, k0 = kb * 128 + kg * 16, n0 = nb * 32 + nl * 4;
    f32x4 v[16];
#pragma unroll
    for (int q = 0; q < 16; ++q) v[q] = *(const f32x4*)(W + (size_t)(k0 + q) * N + n0) * scale;
#pragma unroll
    for (int i = 0; i < 4; ++i) {
        const int n = n0 + i, row = W1MAP ? w1_rho(n) : n;
        u32x4 o; o.x = pk4_fp8(v[0][i], v[1][i], v[2][i], v[3][i]); o.y = pk4_fp8(v[4][i], v[5][i], v[6][i], v[7][i]);
        o.z = pk4_fp8(v[8][i], v[9][i], v[10][i], v[11][i]); o.w = pk4_fp8(v[12][i], v[13][i], v[14][i], v[15][i]);
        *(u32x4*)(WT8 + (size_t)row * 1024 + k0) = o;
    }
}

#define IN(k) (lo <= (k) && (k) < hi)
#define SEAM(k) do { if ((k) + 1 < hi) xcd_barrier(bar); } while (0)
#define LSEAM(k) do { if ((k) + 1 < hi) { if (FUSE_LOCAL && G == 256) { __builtin_amdgcn_fence(__ATOMIC_RELEASE, "workgroup"); __syncthreads(); __builtin_amdgcn_fence(__ATOMIC_ACQUIRE, "workgroup"); } else xcd_barrier(bar); } } while (0)
#define PH_LOCALS \
    const int tid = (wave0 << 6) | lane_id_asm(); \
    const int lane = tid & 63, wave = wave0; \
    int bx = blockIdx.x; asm volatile("" : "+s"(bx)); \
    const int vcu = (G % 8 == 0) ? (bx % 8) * (G / 8) + bx / 8 : bx; \
    const int gw = vcu * 8 + wave, NGW = G * 8; \
    unsigned char* ws; { kptr_t kp_ = (kptr_t)__builtin_amdgcn_kernarg_segment_ptr(); asm volatile("" : "+s"(kp_)); ws = *(unsigned char* const __attribute__((address_space(4)))*)(kp_ + 264); } \
    float* Xf; { kptr_t kp_ = (kptr_t)__builtin_amdgcn_kernarg_segment_ptr(); asm volatile("" : "+s"(kp_)); Xf = *(float* const __attribute__((address_space(4)))*)(kp_ + 256); } \
    unsigned* const ctl = (unsigned*)(ws + WS_CTL); \
    float* const MOD = (float*)(ws + WS_MOD); bf16_t* const Hb = (bf16_t*)(ws + WS_H); bf16_t* const Zb = (bf16_t*)(ws + WS_Z); bf16_t* const A2b = (bf16_t*)(ws + WS_A2); \
    bf16_t* const RIb = (bf16_t*)(ws + WS_RI); bf16_t* const YMb = (bf16_t*)(ws + WS_YMIX); bf16_t* const Yb = (bf16_t*)(ws + WS_Y); bf16_t* const ACTb = (bf16_t*)(ws + WS_ACT); \
    bf16_t* const YSb = (bf16_t*)(ws + WS_YS); float* const LOGf = (float*)(ws + WS_LOG); float* const TOPG = (float*)(ws + WS_TOPG); int* const LIST = (int*)(ws + WS_LIST); \
    float* const SUMM = (float*)(ws + WS_SUMM); \
    (void)lane; (void)wave; (void)gw; (void)NGW; (void)ctl; (void)MOD; (void)Hb; (void)Zb; (void)A2b; (void)RIb; (void)YMb; (void)Yb; (void)ACTb; (void)YSb; (void)LOGf; (void)TOPG; (void)LIST; (void)SUMM; (void)Xf; (void)vcu


template <int L, int PASS>
__device__ __forceinline__ void scan_phase(const int lo, const int hi, const int G, const XcdBarrier& bar, const int wave0) {
    constexpr int l = L, pass = PASS, P = PH_L0 + PH_PER_LAYER * L, jj = L >> 1; constexpr bool odd = (L & 1) != 0;
            if (PHEN(6) && !odd && IN(P + 3 + pass)) {
            PH_LOCALS;
                for (int it = gw; it < 16 * 32 * 4; it += NGW) {
                    const int b = it >> 7, n = (it >> 2) & 31, cg = it & 3;
                    const int ch = cg * 128 + 2 * lane;
                    float sp[2];
#pragma unroll
                    for (int q = 0; q < 2; ++q) { const float x = -kin(I_LAM)[jj * 512 + ch + q]; sp[q] = 8.0f * 1.4426950408889634f * (fmaxf(x, 0.f) + log1pf(__expf(-fabsf(x)))); }
                    float one = 1.0f; asm volatile("" : "+v"(one));
                    float h0 = 0.f, h1 = 0.f, p0 = one, p1 = one;
                    if (pass == 1) {
#pragma unroll 1
                        for (int m = 0; m < n; ++m) { const f32x4 s = *(const f32x4*)(SUMM + (((size_t)b * 32 + m) * 512 + ch) * 2); h0 = s[0] * h0 + s[1]; h1 = s[2] * h1 + s[3]; }
                    }
                    const size_t row0 = (size_t)b * SEQ + n * 128;
#pragma unroll 4
                    for (int t = 0; t < 128; ++t) {
                        const size_t r = row0 + t;
                        const unsigned rw = *(const unsigned*)(RIb + r * 1024 + ch), iw = *(const unsigned*)(RIb + r * 1024 + 512 + ch), xw = *(const unsigned*)(A2b + r * 1024 + 512 + ch);
                        const float a0 = __builtin_amdgcn_exp2f(-bflo(rw) * sp[0]), a1 = __builtin_amdgcn_exp2f(-bfhi(rw) * sp[1]);
                        const float m0 = __builtin_amdgcn_sqrtf(fmaxf(__builtin_fmaf(-a0, a0, 1.0f), 0.f)), m1 = __builtin_amdgcn_sqrtf(fmaxf(__builtin_fmaf(-a1, a1, 1.0f), 0.f));
                        h0 = a0 * h0 + m0 * (bflo(iw) * bflo(xw)); h1 = a1 * h1 + m1 * (bfhi(iw) * bfhi(xw));
                        if (pass == 0) { p0 *= a0; p1 *= a1; }
                        else { const unsigned gwd = *(const unsigned*)(Zb + r * DINAB + 1024 + ch);
                            if (FP8_OUTP) *(unsigned short*)((unsigned char*)YMb + r * 1024 + 512 + ch) = (unsigned short)pk4_fp8(h0 * gelu_tanh(bflo(gwd)), h1 * gelu_tanh(bfhi(gwd)), 0.f, 0.f);
                            else *(unsigned*)(YMb + r * 1024 + 512 + ch) = pk2(h0 * gelu_tanh(bflo(gwd)), h1 * gelu_tanh(bfhi(gwd))); }
                    }
                    if (pass == 0) *(f32x4*)(SUMM + (((size_t)b * 32 + n) * 512 + ch) * 2) = (f32x4){p0, h0, p1, h1};
                }
                SEAM(P + 3 + pass);
            }
}

template <int L, int SUB>
__device__ __forceinline__ void ln_phase(const int lo, const int hi, const int G, const XcdBarrier& bar, const int wave0) {
    constexpr int l = L, sub = SUB, P = PH_L0 + PH_PER_LAYER * L; constexpr int ph = SUB == 0 ? P + 6 : P + 11;
    constexpr bool XIN_F32 = (L == 0 && SUB == 0), XOUT_F32 = (L == DEPTH - 1 && SUB == 1);
    if (PHEN(8) && IN(ph)) {
        PH_LOCALS;
        const int rows_per = T / NGW, r0 = gw * rows_per, b = r0 / SEQ;
        constexpr int ls = 2 * l + sub, lsn = ls + 1;
        const float* gp = MOD + ((size_t)ls * 16 + b) * 3072 + 2048;
        const float* lgp = kin(I_LNG) + ls * 1024, * lbp = kin(I_LNB) + ls * 1024;
        constexpr bool has_nextmod = lsn < 2 * DEPTH;
        const float* nsh = MOD + ((size_t)(has_nextmod ? lsn : 0) * 16 + b) * 3072, * nsc = nsh + 1024;
        f32x4 gt[4], lg[4], lb[4], sh[4], sc[4];
#pragma unroll
        for (int j = 0; j < 4; ++j) { const int o = 4 * (64 * j + lane); gt[j] = *(const f32x4*)(gp + o) + 1.0f; lg[j] = *(const f32x4*)(lgp + o); lb[j] = *(const f32x4*)(lbp + o);
            sh[j] = *(const f32x4*)(nsh + o); sc[j] = *(const f32x4*)(nsc + o) + 1.0f; }
        const float* xin32 = kin(I_X);
        bf16_t* const Xb = (bf16_t*)(ws + WS_XB);
        constexpr bool NEXT_INP8 = ((l + 1) & 1) ? (FP8_INP_ODD != 0) : (FP8_INP_EVEN != 0);
        constexpr int RPI = 2;
        for (int r = (r0 - wave * rows_per) + wave * RPI, rend = (r0 - wave * rows_per) + 8 * rows_per; r < rend; r += 8 * RPI) {
            f32x4 xf[XIN_F32 ? RPI : 1][4]; u32x2 xb[XIN_F32 ? 1 : RPI][4]; u32x2 yv[sub == 0 ? RPI : 1][4]; u32x2 ys[sub == 0 ? 1 : RPI][4][4]; f32x4 gk[RPI];
#pragma unroll
            for (int q = 0; q < RPI; ++q) {
                if constexpr (XIN_F32) { const f32x4* xr = (const f32x4*)(xin32 + (size_t)(r + q) * D) + lane;
#pragma unroll
                    for (int j = 0; j < 4; ++j) xf[q][j] = xr[64 * j]; }
                else { const u32x2* xr = (const u32x2*)(Xb + (size_t)(r + q) * D) + lane;
#pragma unroll
                    for (int j = 0; j < 4; ++j) xb[q][j] = xr[64 * j]; }
                if constexpr (sub == 0) { const u32x2* yr = (const u32x2*)(Yb + (size_t)(r + q) * D) + lane;
#pragma unroll
                    for (int j = 0; j < 4; ++j) yv[q][j] = yr[64 * j]; }
                else { gk[q] = *(const f32x4*)(TOPG + (size_t)(r + q) * 4);
#pragma unroll
                    for (int k = 0; k < 4; ++k) {
                        if (FP8_YS) { const unsigned* yr = (const unsigned*)((const unsigned char*)YSb + ((size_t)(r + q) * 4 + k) * D) + lane;
#pragma unroll
                            for (int j = 0; j < 4; ++j) ys[q][k][j].x = yr[64 * j]; }
                        else { const u32x2* yr = (const u32x2*)(YSb + ((size_t)(r + q) * 4 + k) * D) + lane;
#pragma unroll
                            for (int j = 0; j < 4; ++j) ys[q][k][j] = yr[64 * j]; } } }
            }
            f32x4 v[RPI][4]; float s[RPI];
#pragma unroll
            for (int q = 0; q < RPI; ++q) {
                s[q] = 0.f;
#pragma unroll
                for (int j = 0; j < 4; ++j) {
                    f32x4 y, x;
                    if constexpr (XIN_F32) x = xf[q][j]; else x = (f32x4){bflo(xb[q][j].x), bfhi(xb[q][j].x), bflo(xb[q][j].y), bfhi(xb[q][j].y)};
                    if constexpr (sub == 0) y = (f32x4){bflo(yv[q][j].x), bfhi(yv[q][j].x), bflo(yv[q][j].y), bfhi(yv[q][j].y)};
                    else { y = (f32x4){0.f, 0.f, 0.f, 0.f};
#pragma unroll
                        for (int k = 0; k < 4; ++k) { const u32x2 w = ys[q][k][j];
                            if (FP8_YS) { const f32x2 lo2 = __builtin_amdgcn_cvt_pk_f32_fp8((int)w.x, false), hi2 = __builtin_amdgcn_cvt_pk_f32_fp8((int)w.x, true);
                                y = y + (f32x4){lo2.x, lo2.y, hi2.x, hi2.y} * (gk[q][k] * 0.0625f); }
                            else y = y + (f32x4){bflo(w.x), bfhi(w.x), bflo(w.y), bfhi(w.y)} * gk[q][k]; } }
                    v[q][j] = x * DN_ALPHA + gt[j] * y;
                    s[q] += (v[q][j][0] + v[q][j][1]) + (v[q][j][2] + v[q][j][3]);
                }
            }
#pragma unroll
            for (int o = 1; o < 64; o <<= 1) {
#pragma unroll
                for (int q = 0; q < RPI; ++q) s[q] += __builtin_bit_cast(float, __builtin_amdgcn_ds_bpermute((lane ^ o) << 2, __builtin_bit_cast(int, s[q])));
            }
            float s2[RPI];
#pragma unroll
            for (int q = 0; q < RPI; ++q) { const float mean = s[q] * (1.0f / D); s2[q] = 0.f;
#pragma unroll
                for (int j = 0; j < 4; ++j) { v[q][j] = v[q][j] - mean; s2[q] += (v[q][j][0] * v[q][j][0] + v[q][j][1] * v[q][j][1]) + (v[q][j][2] * v[q][j][2] + v[q][j][3] * v[q][j][3]); } }
#pragma unroll
            for (int o = 1; o < 64; o <<= 1) {
#pragma unroll
                for (int q = 0; q < RPI; ++q) s2[q] += __builtin_bit_cast(float, __builtin_amdgcn_ds_bpermute((lane ^ o) << 2, __builtin_bit_cast(int, s2[q])));
            }
#pragma unroll
            for (int q = 0; q < RPI; ++q) {
                const float rstd = 1.0f / sqrtf(s2[q] * (1.0f / D) + LN_EPS);
                u32x2* hr = (u32x2*)(Hb + (size_t)(r + q) * D) + lane;
#pragma unroll
                for (int j = 0; j < 4; ++j) { const f32x4 xn = v[q][j] * rstd * lg[j] + lb[j];
                    if (XOUT_F32) ((f32x4*)(Xf + (size_t)(r + q) * D) + lane)[64 * j] = xn;
                    else { u32x2 w; w.x = pk2(xn[0], xn[1]); w.y = pk2(xn[2], xn[3]); ((u32x2*)(Xb + (size_t)(r + q) * D) + lane)[64 * j] = w; }
                    if (has_nextmod) { const f32x4 h = xn * sc[j] + sh[j];
                        if (!(NEXT_INP8 && sub == 1) && !(ROUTER_X && sub == 0)) { u32x2 w; w.x = pk2(h[0], h[1]); w.y = pk2(h[2], h[3]); hr[64 * j] = w; }
                        if ((FP8_M1 && sub == 0) || (NEXT_INP8 && sub == 1)) ((unsigned*)(ws + WS_H8 + (size_t)(r + q) * D) + lane)[64 * j] = pk4_fp8(h[0], h[1], h[2], h[3]); } }
            }
        }
        if (ph + 1 < NPH) { if (sub == 0) LSEAM(ph); else SEAM(ph); }
    }
}

template <int L>
__device__ __forceinline__ void layer_body(LAS unsigned char* const lds, volatile LAS unsigned* const LCTL, const int lo, const int hi, const int G, const XcdBarrier& bar, const int wave0) {
    constexpr int l = L;
        const int P = PH_L0 + PH_PER_LAYER * l, jj = l >> 1;
        const bool odd = (l & 1) != 0;
        if (PHEN(2) && IN(P + 0)) {
            PH_LOCALS;
            if (!odd) {
                pg8::DenseSched S; S.init(T, 1536, G, bx);
                if (FP8_INP_EVEN) { pg8::Gemm g{ws + WS_H8, ws + WS_ABIN + (size_t)jj * 1536 * 1024, 1024, 1024, 1024, 122};
                    pg8::EpiDense<0, false, false, true> E{Zb, 1536, nullptr, nullptr, 1.0f / 32.0f};
                    pg8::gemm_phase<true>(lds, g, S, E, wave0); }
                else { pg8::Gemm g{Hb, (const bf16_t*)(ws + WS_ABIN) + (size_t)jj * 1536 * 1024, 1024, 1024, 1024, 127};
                    pg8::EpiDense<0, false, false> E{Zb, 1536, nullptr, nullptr, 0.f};
                    pg8::gemm_phase<false>(lds, g, S, E, wave0); }
            } else {
                pg8::DenseSched S; S.init(T, 2048, G, bx);
                if (FP8_INP_ODD) { pg8::Gemm g{ws + WS_H8, ws + WS_SGIN + (size_t)jj * 2048 * 1024, 1024, 1024, 1024, 122};
                    pg8::EpiDense<1, true, false, true> E{Zb, 2048, kin(I_SGBIN) + jj * 2048, nullptr, 1.0f / 32.0f};
                    pg8::gemm_phase<true>(lds, g, S, E, wave0); }
                else { pg8::Gemm g{Hb, (const bf16_t*)(ws + WS_SGIN) + (size_t)jj * 2048 * 1024, 1024, 1024, 1024, 127};
                    pg8::EpiDense<1, true, false> E{Zb, 2048, kin(I_SGBIN) + jj * 2048, nullptr, 0.f};
                    pg8::gemm_phase<false>(lds, g, S, E, wave0); }
            }
            SEAM(P + 0);
        }
        if (PHEN(3) && !odd && IN(P + 1)) {
            PH_LOCALS;
            const int rows_per = T / NGW, r0 = gw * rows_per;
            const int g4 = lane >> 4, w = 2 << g4;
            float cw[4][8], cb[8];
#pragma unroll
            for (int k = 0; k < 4; ++k)
#pragma unroll
                for (int q = 0; q < 8; ++q) cw[k][q] = kin(I_CONVW)[((size_t)jj * 4 + k) * 512 + 8 * lane + q];
#pragma unroll
            for (int q = 0; q < 8; ++q) cb[q] = kin(I_CONVB)[jj * 512 + 8 * lane + q];
            const int ts0 = r0 & (SEQ - 1);
            u32x4 ring[16], cr[3];
            float sw[8];
#pragma unroll
            for (int q = 0; q < 8; ++q) sw[q] = 0.f;
#pragma unroll
            for (int d = 0; d < 16; ++d) {
                const int k = 15 - d;
                u32x4 v = {0u, 0u, 0u, 0u};
                if (ts0 > d) v = *(const u32x4*)(Zb + (size_t)(r0 - 1 - d) * DINAB + 8 * lane);
                ring[k] = v;
                if (d + 1 < w) { const float f[8] = {bflo(v.x), bfhi(v.x), bflo(v.y), bfhi(v.y), bflo(v.z), bfhi(v.z), bflo(v.w), bfhi(v.w)};
#pragma unroll
                    for (int q = 0; q < 8; ++q) sw[q] += f[q]; }
            }
#pragma unroll
            for (int d = 0; d < 3; ++d) { u32x4 v = {0u, 0u, 0u, 0u}; if (ts0 > d) v = *(const u32x4*)(Zb + (size_t)(r0 - 1 - d) * DINAB + 512 + 8 * lane); cr[2 - d] = v; }
#pragma unroll 1
            for (int rb = 0; rb < rows_per; rb += 16) {
#pragma unroll
                for (int i = 0; i < 16; ++i) {
                    const int r = r0 + rb + i, ts = r & (SEQ - 1);
                    const u32x4 vn = *(const u32x4*)(Zb + (size_t)r * DINAB + 8 * lane), cn = *(const u32x4*)(Zb + (size_t)r * DINAB + 512 + 8 * lane);
                    const u32x4 c2 = ring[(i + 15) & 15], c4 = ring[(i + 13) & 15], c8 = ring[(i + 9) & 15], c16 = ring[(i + 1) & 15];
                    u32x4 vo;
                    vo.x = g4 == 0 ? c2.x : g4 == 1 ? c4.x : g4 == 2 ? c8.x : c16.x; vo.y = g4 == 0 ? c2.y : g4 == 1 ? c4.y : g4 == 2 ? c8.y : c16.y;
                    vo.z = g4 == 0 ? c2.z : g4 == 1 ? c4.z : g4 == 2 ? c8.z : c16.z; vo.w = g4 == 0 ? c2.w : g4 == 1 ? c4.w : g4 == 2 ? c8.w : c16.w;
                    ring[i] = vn;
                    const float fn[8] = {bflo(vn.x), bfhi(vn.x), bflo(vn.y), bfhi(vn.y), bflo(vn.z), bfhi(vn.z), bflo(vn.w), bfhi(vn.w)};
                    const float fo[8] = {bflo(vo.x), bfhi(vo.x), bflo(vo.y), bfhi(vo.y), bflo(vo.z), bfhi(vo.z), bflo(vo.w), bfhi(vo.w)};
                    const int cntw = (ts + 1) < w ? (ts + 1) : w;
                    const float inv = __builtin_amdgcn_rcpf((float)cntw);
                    float pz[8];
#pragma unroll
                    for (int q = 0; q < 8; ++q) { sw[q] += fn[q]; pz[q] = sw[q] * inv - fn[q]; sw[q] -= fo[q]; }
                    u32x4 o; o.x = pk2(pz[0], pz[1]); o.y = pk2(pz[2], pz[3]); o.z = pk2(pz[4], pz[5]); o.w = pk2(pz[6], pz[7]);
                    *(u32x4*)(A2b + (size_t)r * 1024 + 8 * lane) = o;
                    float xc[8];
                    const u32x4 t0 = cr[0], t1 = cr[1], t2 = cr[2];
                    const float f0[8] = {bflo(t0.x), bfhi(t0.x), bflo(t0.y), bfhi(t0.y), bflo(t0.z), bfhi(t0.z), bflo(t0.w), bfhi(t0.w)};
                    const float f1[8] = {bflo(t1.x), bfhi(t1.x), bflo(t1.y), bfhi(t1.y), bflo(t1.z), bfhi(t1.z), bflo(t1.w), bfhi(t1.w)};
                    const float f2[8] = {bflo(t2.x), bfhi(t2.x), bflo(t2.y), bfhi(t2.y), bflo(t2.z), bfhi(t2.z), bflo(t2.w), bfhi(t2.w)};
                    const float f3[8] = {bflo(cn.x), bfhi(cn.x), bflo(cn.y), bfhi(cn.y), bflo(cn.z), bfhi(cn.z), bflo(cn.w), bfhi(cn.w)};
#pragma unroll
                    for (int q = 0; q < 8; ++q) xc[q] = cb[q] + f0[q] * cw[0][q] + f1[q] * cw[1][q] + f2[q] * cw[2][q] + f3[q] * cw[3][q];
                    cr[0] = t1; cr[1] = t2; cr[2] = cn;
                    u32x4 o2; o2.x = pk2(xc[0], xc[1]); o2.y = pk2(xc[2], xc[3]); o2.z = pk2(xc[4], xc[5]); o2.w = pk2(xc[6], xc[7]);
                    *(u32x4*)(A2b + (size_t)r * 1024 + 512 + 8 * lane) = o2;
                }
            }
            LSEAM(P + 1);
        }
        if (PHEN(4) && odd && IN(P + 1)) {
            PH_LOCALS;
            LAS float* STAT = (LAS float*)lds;
            LAS unsigned char* WSS = lds + 1024;
            LAS unsigned char* VT = lds + 1024 + 34816;
            const float* lng = kin(I_SGLNG) + jj * 1024, * lnb = kin(I_SGLNB) + jj * 1024;
            const bf16_t* WSMp = (const bf16_t*)(ws + WS_WSM) + (size_t)jj * 8 * 128 * 128;
            const float* bs = kin(I_SGBS) + jj * 8 * 128;
            const int fr = lane & 15, fq = lane >> 4;
            for (int it = vcu; it < T / 128; it += G) {
                const size_t row0 = (size_t)it * 128;
#pragma unroll 1
                for (int rb = 0; rb < 2; ++rb) {
                    u32x4 a8[8], b8[8];
#pragma unroll
                    for (int q = 0; q < 8; ++q) { const bf16_t* vp = Zb + (row0 + wave * 16 + rb * 8 + q) * 2048 + 1024; a8[q] = *(const u32x4*)(vp + 8 * lane); b8[q] = *(const u32x4*)(vp + 512 + 8 * lane); }
                    float sm[8], sq[8];
#pragma unroll
                    for (int q = 0; q < 8; ++q) {
                        const float f[16] = {bflo(a8[q].x), bfhi(a8[q].x), bflo(a8[q].y), bfhi(a8[q].y), bflo(a8[q].z), bfhi(a8[q].z), bflo(a8[q].w), bfhi(a8[q].w),
                                             bflo(b8[q].x), bfhi(b8[q].x), bflo(b8[q].y), bfhi(b8[q].y), bflo(b8[q].z), bfhi(b8[q].z), bflo(b8[q].w), bfhi(b8[q].w)};
                        float s1 = 0.f, s2 = 0.f;
#pragma unroll
                        for (int e = 0; e < 16; ++e) { s1 += f[e]; s2 += f[e] * f[e]; }
                        sm[q] = s1; sq[q] = s2;
                    }
#pragma unroll
                    for (int o = 1; o < 64; o <<= 1) {
#pragma unroll
                        for (int q = 0; q < 8; ++q) { sm[q] += __builtin_bit_cast(float, __builtin_amdgcn_ds_bpermute((lane ^ o) << 2, __builtin_bit_cast(int, sm[q])));
                            sq[q] += __builtin_bit_cast(float, __builtin_amdgcn_ds_bpermute((lane ^ o) << 2, __builtin_bit_cast(int, sq[q]))); }
                    }
                    if (lane < 8) { float m_ = sm[0], q_ = sq[0];
#pragma unroll
                        for (int q = 1; q < 8; ++q) { m_ = lane == q ? sm[q] : m_; q_ = lane == q ? sq[q] : q_; }
                        const float mean = m_ * (1.0f / 1024.0f), var = fmaxf(q_ * (1.0f / 1024.0f) - mean * mean, 0.f);
                        const int r = wave * 16 + rb * 8 + lane; STAT[2 * r] = mean; STAT[2 * r + 1] = 1.0f / sqrtf(var + LN_EPS); }
                }
                __syncthreads();
                u32x4 wv[4], vv[4];
#pragma unroll
                for (int i = 0; i < 4; ++i) { const int q = tid + 512 * i, row = q >> 4, c16 = q & 15;
                    wv[i] = *(const u32x4*)(WSMp + ((size_t)0 * 128 + row) * 128 + c16 * 8);
                    vv[i] = *(const u32x4*)(Zb + (row0 + row) * 2048 + 1024 + 0 * 128 + c16 * 8); }
#pragma unroll 1
                for (int hd = 0; hd < 8; ++hd) {
#pragma unroll
                    for (int i = 0; i < 4; ++i) {
                        const int q = tid + 512 * i, row = q >> 4, c16 = q & 15;
                        *(LAS u32x4*)(WSS + row * 272 + c16 * 16) = wv[i];
                        const u32x4 v4 = vv[i];
                        const float mean = STAT[2 * row], rstd = STAT[2 * row + 1];
                        const float f[8] = {bflo(v4.x), bfhi(v4.x), bflo(v4.y), bfhi(v4.y), bflo(v4.z), bfhi(v4.z), bflo(v4.w), bfhi(v4.w)};
                        const f32x4 g0 = *(const f32x4*)(lng + hd * 128 + c16 * 8), g1 = *(const f32x4*)(lng + hd * 128 + c16 * 8 + 4);
                        const f32x4 b0 = *(const f32x4*)(lnb + hd * 128 + c16 * 8), b1 = *(const f32x4*)(lnb + hd * 128 + c16 * 8 + 4);
                        const float gg[8] = {g0[0], g0[1], g0[2], g0[3], g1[0], g1[1], g1[2], g1[3]}, bb[8] = {b0[0], b0[1], b0[2], b0[3], b1[0], b1[1], b1[2], b1[3]};
#pragma unroll
                        for (int q2 = 0; q2 < 8; ++q2) {
                            const int c = c16 * 8 + q2;
                            const int rho = (c & ~31) | (((c >> 2) & 1) << 4) | (((c >> 3) & 3) << 2) | (c & 3);
                            *(LAS bf16_t*)(VT + rho * 272 + row * 2) = (bf16_t)f2bf((f[q2] - mean) * rstd * gg[q2] + bb[q2]);
                        }
                    }
                    const int hn = hd < 7 ? hd + 1 : 7;
#pragma unroll
                    for (int i = 0; i < 4; ++i) { const int q = tid + 512 * i, row = q >> 4, c16 = q & 15;
                        wv[i] = *(const u32x4*)(WSMp + ((size_t)hn * 128 + row) * 128 + c16 * 8);
                        vv[i] = *(const u32x4*)(Zb + (row0 + row) * 2048 + 1024 + hn * 128 + c16 * 8); }
                    const int t = 16 * wave + fr; const float bst = bs[hd * 128 + t];
                    const size_t rowg = row0 + t;
                    u32x4 uv[4];
#pragma unroll
                    for (int q = 0; q < 4; ++q) uv[q] = *(const u32x4*)(Zb + rowg * 2048 + hd * 128 + 32 * q + 8 * fq);
                    __syncthreads();
                    bf16x8 afr[4];
#pragma unroll
                    for (int ks = 0; ks < 4; ++ks) afr[ks] = *(const LAS bf16x8*)(WSS + (16 * wave + fr) * 272 + (32 * ks + 8 * fq) * 2);
                    f32x4 acc[8];
#pragma unroll
                    for (int tn = 0; tn < 8; ++tn) { acc[tn] = (f32x4){0.f, 0.f, 0.f, 0.f};
#pragma unroll
                        for (int ks = 0; ks < 4; ++ks) { const bf16x8 vfr = *(const LAS bf16x8*)(VT + (16 * tn + fr) * 272 + (32 * ks + 8 * fq) * 2);
                            acc[tn] = __builtin_amdgcn_mfma_f32_16x16x32_bf16(vfr, afr[ks], acc[tn], 0, 0, 0); } }
#pragma unroll
                    for (int q = 0; q < 4; ++q) {
                        const int c0 = hd * 128 + 32 * q + 8 * fq;
                        const u32x4 u4 = uv[q];
                        const f32x4 s0 = acc[2 * q] + bst, s1 = acc[2 * q + 1] + bst;
                        if (FP8_OUTP) { u32x2 o; o.x = pk4_fp8(bflo(u4.x) * s0[0], bfhi(u4.x) * s0[1], bflo(u4.y) * s0[2], bfhi(u4.y) * s0[3]);
                            o.y = pk4_fp8(bflo(u4.z) * s1[0], bfhi(u4.z) * s1[1], bflo(u4.w) * s1[2], bfhi(u4.w) * s1[3]);
                            *(u32x2*)((unsigned char*)YMb + rowg * 1024 + c0) = o; }
                        else { u32x4 o; o.x = pk2(bflo(u4.x) * s0[0], bfhi(u4.x) * s0[1]); o.y = pk2(bflo(u4.y) * s0[2], bfhi(u4.y) * s0[3]);
                        o.z = pk2(bflo(u4.z) * s1[0], bfhi(u4.z) * s1[1]); o.w = pk2(bflo(u4.w) * s1[2], bfhi(u4.w) * s1[3]);
                        *(u32x4*)(YMb + rowg * 1024 + c0) = o; }
                    }
                    __syncthreads();
                }
            }
            SEAM(P + 1);
        }
        if (PHEN(5) && !odd && IN(P + 2)) {
            PH_LOCALS;
            {
                pg8::Gemm g{A2b, (const bf16_t*)(ws + WS_BPOOL) + (size_t)jj * 512 * 512, 1024, 512, 256, 127};
                pg8::DenseSched S; S.init(T, 512, G, bx); S.kblk = 512; S.rowm = (FUSE_LOCAL && G == 256) ? 1 : 0;
                pg8::EpiDense<0, false, true, false, FP8_OUTP != 0> E{YMb, 1024, nullptr, kin(I_POOLS) + jj * 512, 0.f};
                pg8::gemm_phase<false>(lds, g, S, E, wave0);
            }
            {
                pg8::Gemm g{A2b + 512, (const bf16_t*)(ws + WS_BGATE) + (size_t)jj * 1024 * 512, 1024, 512, 256, 127};
                pg8::DenseSched S; S.init(T, 1024, G, bx); S.kblk = 512; S.rowm = (FUSE_LOCAL && G == 256) ? 1 : 0;
                pg8::EpiDense<2, true, false> E{RIb, 1024, (const float*)(ws + WS_BIASRI) + jj * 1024, nullptr, 0.f};
                pg8::gemm_phase<false>(lds, g, S, E, wave0);
            }
            SEAM(P + 2);
        }
        scan_phase<L, 0>(lo, hi, G, bar, wave0); scan_phase<L, 1>(lo, hi, G, bar, wave0);
        if (PHEN(7) && IN(P + 5)) {
            PH_LOCALS;
            const float* bo = odd ? kin(I_SGBOUT) + jj * 1024 : kin(I_ABBOUT) + jj * 1024;
            pg8::DenseSched S; S.init(T, 1024, G, bx);
            if (FP8_OUTP) { const unsigned char* wt = odd ? ws + WS_SGOUT + (size_t)jj * 1024 * 1024 : ws + WS_ABOUT + (size_t)jj * 1024 * 1024;
                pg8::Gemm g{YMb, wt, 1024, 1024, 1024, 121};
                pg8::EpiDense<0, true, false, true> E{Yb, 1024, bo, nullptr, 1.0f / 64.0f};
                pg8::gemm_phase<true>(lds, g, S, E, wave0); }
            else { const bf16_t* wt = odd ? (const bf16_t*)(ws + WS_SGOUT) + (size_t)jj * 1024 * 1024 : (const bf16_t*)(ws + WS_ABOUT) + (size_t)jj * 1024 * 1024;
                pg8::Gemm g{YMb, wt, 1024, 1024, 1024, 127};
                pg8::EpiDense<0, true, false> E{Yb, 1024, bo, nullptr, 0.f};
                pg8::gemm_phase<false>(lds, g, S, E, wave0); }
            SEAM(P + 5);
        }
        ln_phase<L, 0>(lo, hi, G, bar, wave0);
            if (PHEN(9) && IN(P + 7)) {
            PH_LOCALS;
                pg8::Gemm g{ROUTER_X ? (const bf16_t*)(ws + WS_XB) : Hb, ROUTER_X ? (const bf16_t*)(ws + WS_BRB) + (size_t)l * 16 * 64 * 1024 : (const bf16_t*)(ws + WS_BR) + (size_t)l * 256 * 1024, 1024, 1024, 1024, 127};
                pg8::DenseSched S; S.init(T, 256, G, bx); if (ROUTER_X) S.bb = 64;
                pg8::EpiRouter E{LOGf};
                pg8::gemm_phase<false>(lds, g, S, E, wave0);
                LSEAM(P + 7);
            }
            if (PHEN(10) && IN(P + 8)) {
            PH_LOCALS;
                volatile LAS unsigned* hist = LCTL + 96; volatile LAS unsigned* basev = LCTL + 128;
                unsigned* gcnt = ctl + CW_CNT + 64 * l;
                const int TPB = (FUSE_LOCAL && G == 256) ? 256 : 512;
                for (int t0 = vcu * TPB; t0 < T; t0 += G * TPB) {
                    if (tid < 32) hist[tid] = 0u;
                    __syncthreads();
                    const bool act = tid < TPB;
                    const int tok = t0 + (act ? tid : 0);
                    float lv[32];
                    { const f32x4* lp = (const f32x4*)(LOGf + (size_t)tok * 64);
#pragma unroll
                      for (int q = 0; q < 8; ++q) { const f32x4 a = lp[q], b2 = lp[8 + q], rb = ROUTER_X ? *(const f32x4*)((const float*)(ws + WS_CB) + (l * 16 + (t0 >> 12)) * 32 + 4 * q) : *(const f32x4*)(kin(I_RB) + l * 32 + 4 * q);
                          lv[4 * q + 0] = a[0] + b2[0] + rb[0]; lv[4 * q + 1] = a[1] + b2[1] + rb[1]; lv[4 * q + 2] = a[2] + b2[2] + rb[2]; lv[4 * q + 3] = a[3] + b2[3] + rb[3]; } }
                    float v0 = -3.0e38f, v1 = -3.0e38f, v2 = -3.0e38f, v3 = -3.0e38f; int i0 = 0, i1 = 0, i2 = 0, i3 = 0;
#pragma unroll
                    for (int e = 0; e < 32; ++e) {
                        const float x = lv[e];
                        if (x > v3) {
                            if (x > v0) { v3 = v2; i3 = i2; v2 = v1; i2 = i1; v1 = v0; i1 = i0; v0 = x; i0 = e; }
                            else if (x > v1) { v3 = v2; i3 = i2; v2 = v1; i2 = i1; v1 = x; i1 = e; }
                            else if (x > v2) { v3 = v2; i3 = i2; v2 = x; i2 = e; }
                            else { v3 = x; i3 = e; }
                        }
                    }
                    const float e1 = __expf(v1 - v0), e2 = __expf(v2 - v0), e3 = __expf(v3 - v0), inv = 1.0f / (1.0f + e1 + e2 + e3);
                    if (act) *(f32x4*)(TOPG + (size_t)tok * 4) = (f32x4){inv, e1 * inv, e2 * inv, e3 * inv};
                    LAS unsigned* hp = (LAS unsigned*)hist;
                    unsigned r0 = 0u, r1 = 0u, r2 = 0u, r3 = 0u;
                    if (act) { r0 = __hip_atomic_fetch_add(hp + i0, 1u, __ATOMIC_RELAXED, __HIP_MEMORY_SCOPE_WORKGROUP); r1 = __hip_atomic_fetch_add(hp + i1, 1u, __ATOMIC_RELAXED, __HIP_MEMORY_SCOPE_WORKGROUP);
                        r2 = __hip_atomic_fetch_add(hp + i2, 1u, __ATOMIC_RELAXED, __HIP_MEMORY_SCOPE_WORKGROUP); r3 = __hip_atomic_fetch_add(hp + i3, 1u, __ATOMIC_RELAXED, __HIP_MEMORY_SCOPE_WORKGROUP); }
                    __syncthreads();
                    if (tid < 32) basev[tid] = __hip_atomic_fetch_add(gcnt + tid, hist[tid], __ATOMIC_RELAXED, __HIP_MEMORY_SCOPE_AGENT);
                    __syncthreads();
                    if (act) {
                    LIST[(size_t)i0 * TKTOT + basev[i0] + r0] = tok * 4 + 0;
                    LIST[(size_t)i1 * TKTOT + basev[i1] + r1] = tok * 4 + 1;
                    LIST[(size_t)i2 * TKTOT + basev[i2] + r2] = tok * 4 + 2;
                    LIST[(size_t)i3 * TKTOT + basev[i3] + r3] = tok * 4 + 3; }
                    __syncthreads();
                }
                SEAM(P + 8);
            }
            if (PHEN(11) && IN(P + 9)) {
                PH_LOCALS;
                volatile LAS int* cnts = (volatile LAS int*)(LCTL + 16); volatile LAS int* tstart = (volatile LAS int*)(LCTL + 48);
                if (tid < 32) cnts[tid] = (int)__hip_atomic_load(ctl + CW_CNT + 64 * l + tid, __ATOMIC_RELAXED, __HIP_MEMORY_SCOPE_AGENT);
                __syncthreads();
                if (tid == 0) { int s = 0; for (int e = 0; e < 32; ++e) { tstart[e] = s; s += (cnts[e] + 255) >> 8; } tstart[32] = s; }
                __syncthreads();
                LAS int* const utab = (LAS int*)(lds + UTAB_OFF);
                const int nunits = pg8::moe_build_units(utab, tstart, cnts, 8, G, bx, tid);
                __syncthreads();
                pg8::MoeSched S{(const LAS int*)utab, LIST, (const float*)(ws + WS_B1P) + (size_t)l * 32 * 2048, nunits, 2048, 2};
                pg8::EpiMoe1<FP8_M2 != 0> E{FP8_M2 ? (bf16_t*)(ws + WS_ACT8) : ACTb, lds, FP8_M1 ? 1.0f / 32.0f : 1.0f};
                if (FP8_M1) { pg8::Gemm g{ws + WS_H8, ws + WS_W1T8 + (size_t)l * 32 * 2048 * 1024, 1024, 1024, 1024, 122};
                    pg8::gemm_phase<true>(lds, g, S, E, wave0); }
                else { pg8::Gemm g{Hb, (const bf16_t*)(ws + WS_W1T) + (size_t)l * 32 * 2048 * 1024, 1024, 1024, 1024, 127};
                    pg8::gemm_phase<false>(lds, g, S, E, wave0); }
                SEAM(P + 9);
            }
            if (PHEN(12) && IN(P + 10)) {
                PH_LOCALS;
                volatile LAS int* cnts = (volatile LAS int*)(LCTL + 16); volatile LAS int* tstart = (volatile LAS int*)(LCTL + 48);
                __syncthreads();
                if (tid < 32) cnts[tid] = (int)__hip_atomic_load(ctl + CW_CNT + 64 * l + tid, __ATOMIC_RELAXED, __HIP_MEMORY_SCOPE_AGENT);
                __syncthreads();
                if (tid == 0) { int s = 0; for (int e = 0; e < 32; ++e) { tstart[e] = s; s += (cnts[e] + 255) >> 8; } tstart[32] = s; }
                __syncthreads();
                LAS int* const utab = (LAS int*)(lds + UTAB_OFF);
                const int nunits = pg8::moe_build_units(utab, tstart, cnts, 4, G, bx, tid);
                __syncthreads();
                pg8::MoeSched S{(const LAS int*)utab, LIST, kin(I_B2) + (size_t)l * 32 * 1024, nunits, 1024, 0};
                pg8::EpiMoe2 E{YSb, lds, FP8_M2 ? 1.0f / 64.0f : 1.0f};
                if (FP8_M2) { pg8::Gemm g{ws + WS_ACT8, ws + WS_W2T8 + (size_t)l * 32 * 1024 * 1024, 1024, 1024, 1024, 121};
                    pg8::gemm_phase<true>(lds, g, S, E, wave0); }
                else { pg8::Gemm g{ACTb, (const bf16_t*)(ws + WS_W2T) + (size_t)l * 32 * 1024 * 1024, 1024, 1024, 1024, 127};
                    pg8::gemm_phase<false>(lds, g, S, E, wave0); }
                SEAM(P + 10);
            }
        ln_phase<L, 1>(lo, hi, G, bar, wave0);
}

__global__ void __launch_bounds__(512, 2) fwd_kernel(Args args) {
    extern __shared__ __attribute__((aligned(16))) unsigned char lds_raw[];
    LAS unsigned char* const lds = (LAS unsigned char*)lds_raw;
    volatile LAS unsigned* const LCTL = (volatile LAS unsigned*)(lds + LDSCTL_OFF);
    const int G = gridDim.x;
    int lo, hi; unsigned* ctl0;
    { kptr_t kp = (kptr_t)__builtin_amdgcn_kernarg_segment_ptr(); lo = *(const __attribute__((address_space(4))) int*)(kp + 272); hi = *(const __attribute__((address_space(4))) int*)(kp + 276);
      ctl0 = (unsigned*)(*(unsigned char* const __attribute__((address_space(4)))*)(kp + 264) + WS_CTL); }
    const int wave0 = __builtin_amdgcn_readfirstlane((int)threadIdx.x >> 6);
    for (int u = threadIdx.x; u < (LDS_BYTES - LDSCTL_OFF) / 4; u += 512) LCTL[u] = 0u;
    __syncthreads();
    XcdBarrier bar; bar.bar = ctl0 + CW_BAR; bar.x = 0; bar.st = LCTL; bar.wv = wave0;
    if (hi - lo > 1) bar = xcd_barrier_post(ctl0 + CW_BAR, LCTL, wave0);
    if (PHEN(0) && IN(PH_CONV)) {
            PH_LOCALS;
        {
            LAS float* cact = (LAS float*)lds;
            LAS float* part = (LAS float*)(lds + 65536);
            if (bx < 384) {
                for (int i = tid; i < 16 * 1024; i += 512) { const float c = kin(I_C)[i]; cact[i] = c / (1.0f + __expf(-c)); }
                __syncthreads();
                for (int it = bx; it < 384; it += G) {
                    const int ls = it / 48, col0 = (it % 48) * 64;
                    const int kq = tid >> 6, cl = tid & 63;
                    const float* wp = kin(I_MODW) + (size_t)ls * 1024 * 3072 + col0 + cl;
                    float a[16];
#pragma unroll
                    for (int b = 0; b < 16; ++b) a[b] = 0.f;
#pragma unroll 4
                    for (int k = kq * 128; k < kq * 128 + 128; ++k) {
                        const float w = wp[(size_t)k * 3072];
#pragma unroll
                        for (int b = 0; b < 16; ++b) a[b] += cact[b * 1024 + k] * w;
                    }
#pragma unroll
                    for (int b = 0; b < 16; ++b) part[(kq * 16 + b) * 64 + cl] = a[b];
                    __syncthreads();
                    for (int o = tid; o < 1024; o += 512) {
                        const int b = o >> 6, c2 = o & 63; float s = 0.f;
#pragma unroll
                        for (int q = 0; q < 8; ++q) s += part[(q * 16 + b) * 64 + c2];
                        MOD[((size_t)ls * 16 + b) * 3072 + col0 + c2] = s + kin(I_MODB)[ls * 3072 + col0 + c2];
                    }
                    __syncthreads();
                }
            }
        }
        {
            constexpr int IT_ABIN = 2 * (FP8_INP_EVEN ? 8 : 16) * 48, IT_ABOUT = 2 * (FP8_OUTP ? 8 : 16) * 32, IT_SGIN = 2 * (FP8_INP_ODD ? 8 : 16) * 64, IT_SGOUT = 2 * (FP8_OUTP ? 8 : 16) * 32, IT_W1 = 128 * (FP8_M1 ? 8 : 16) * 64, IT_W2 = 128 * (FP8_M2 ? 8 : 16) * 32;
            constexpr int IT_ALL = IT_ABIN + IT_ABOUT + IT_SGIN + IT_SGOUT + IT_W1 + IT_W2;
            for (int it = gw; it < IT_ALL; it += NGW) {
                int r = it;
                if (r < IT_ABIN) { if (FP8_INP_EVEN) { const int mat = r / (8 * 48); conv_item_f8<false>(kin(I_ABWIN) + (size_t)mat * 1024 * 1536, 1536, ws + WS_ABIN + (size_t)mat * 1536 * 1024, r % (8 * 48), lane, 32.0f); }
                    else { const int mat = r / (16 * 48); conv_item<false>(kin(I_ABWIN) + (size_t)mat * 1024 * 1536, 1536, (bf16_t*)(ws + WS_ABIN) + (size_t)mat * 1536 * 1024, r % (16 * 48), lane); } continue; } r -= IT_ABIN;
                if (r < IT_ABOUT) { if (FP8_OUTP) { const int mat = r / (8 * 32); conv_item_f8<false>(kin(I_ABWOUT) + (size_t)mat * 1024 * 1024, 1024, ws + WS_ABOUT + (size_t)mat * 1024 * 1024, r % (8 * 32), lane, 64.0f); }
                    else { const int mat = r / (16 * 32); conv_item<false>(kin(I_ABWOUT) + (size_t)mat * 1024 * 1024, 1024, (bf16_t*)(ws + WS_ABOUT) + (size_t)mat * 1024 * 1024, r % (16 * 32), lane); } continue; } r -= IT_ABOUT;
                if (r < IT_SGIN) { if (FP8_INP_ODD) { const int mat = r / (8 * 64); conv_item_f8<false>(kin(I_SGWIN) + (size_t)mat * 1024 * 2048, 2048, ws + WS_SGIN + (size_t)mat * 2048 * 1024, r % (8 * 64), lane, 32.0f); }
                    else { const int mat = r / (16 * 64); conv_item<false>(kin(I_SGWIN) + (size_t)mat * 1024 * 2048, 2048, (bf16_t*)(ws + WS_SGIN) + (size_t)mat * 2048 * 1024, r % (16 * 64), lane); } continue; } r -= IT_SGIN;
                if (r < IT_SGOUT) { if (FP8_OUTP) { const int mat = r / (8 * 32); conv_item_f8<false>(kin(I_SGWOUT) + (size_t)mat * 1024 * 1024, 1024, ws + WS_SGOUT + (size_t)mat * 1024 * 1024, r % (8 * 32), lane, 64.0f); }
                    else { const int mat = r / (16 * 32); conv_item<false>(kin(I_SGWOUT) + (size_t)mat * 1024 * 1024, 1024, (bf16_t*)(ws + WS_SGOUT) + (size_t)mat * 1024 * 1024, r % (16 * 32), lane); } continue; } r -= IT_SGOUT;
                if (r < IT_W1) {
                    if (FP8_M1) { const int mat = r / (8 * 64); conv_item_f8<true>(kin(I_W1) + (size_t)mat * 1024 * 2048, 2048, ws + WS_W1T8 + (size_t)mat * 2048 * 1024, r % (8 * 64), lane, 32.0f); }
                    else { const int mat = r / (16 * 64); conv_item<true>(kin(I_W1) + (size_t)mat * 1024 * 2048, 2048, (bf16_t*)(ws + WS_W1T) + (size_t)mat * 2048 * 1024, r % (16 * 64), lane); }
                    continue; } r -= IT_W1;
                if (FP8_M2) { const int mat = r / (8 * 32); conv_item_f8<false>(kin(I_W2) + (size_t)mat * 1024 * 1024, 1024, ws + WS_W2T8 + (size_t)mat * 1024 * 1024, r % (8 * 32), lane, 64.0f); }
                else { const int mat = r / (16 * 32); conv_item<false>(kin(I_W2) + (size_t)mat * 1024 * 1024, 1024, (bf16_t*)(ws + WS_W2T) + (size_t)mat * 1024 * 1024, r % (16 * 32), lane); }
            }
        }
        {
            const int gt = vcu * 512 + tid, NGT = G * 512;
            bf16_t* BR = (bf16_t*)(ws + WS_BR);
            if (!ROUTER_X) for (int i = gt; i < 4 * 256 * 1024; i += NGT) {
                const int l = i >> 18, n = (i >> 10) & 255, k = i & 1023; unsigned v = 0;
                if (n < 64) { const float w = kin(I_RW)[((size_t)l * 1024 + k) * 32 + (n & 31)]; const unsigned h = f2bf(w); v = h;
                    if (n >= 32) v = f2bf(w - __builtin_bit_cast(float, h << 16)); }
                BR[i] = (bf16_t)v;
            }
            bf16_t* BP = (bf16_t*)(ws + WS_BPOOL);
            for (int i = gt; i < 2 * 512 * 512; i += NGT) {
                const int j = i >> 18, n = (i >> 9) & 511, k = i & 511; unsigned v = 0;
                if ((n >> 7) == (k >> 7)) v = f2bf(kin(I_POOLW)[(((size_t)j * 4 + (n >> 7)) * 128 + (k & 127)) * 128 + (n & 127)]);
                BP[i] = (bf16_t)v;
            }
            bf16_t* BG = (bf16_t*)(ws + WS_BGATE);
            for (int i = gt; i < 2 * 1024 * 512; i += NGT) {
                const int j = i >> 19, n = (i >> 9) & 1023, k = i & 511; unsigned v = 0; const int nn = n & 511;
                if ((nn >> 6) == (k >> 6)) { const float* w = (n < 512) ? kin(I_WA) : kin(I_WX); v = f2bf(w[(((size_t)j * 8 + (nn >> 6)) * 64 + (k & 63)) * 64 + (nn & 63)]); }
                BG[i] = (bf16_t)v;
            }
            bf16_t* WSMp = (bf16_t*)(ws + WS_WSM);
            for (int i = gt; i < 2 * 8 * 128 * 128; i += NGT) {
                const int t = (i >> 7) & 127, s = i & 127; WSMp[i] = (bf16_t)((s <= t) ? f2bf(kin(I_SGWS)[i]) : 0u);
            }
            float* BRI = (float*)(ws + WS_BIASRI);
            for (int i = gt; i < 2 * 1024; i += NGT) { const int j = i >> 10, n = i & 1023; BRI[i] = (n < 512) ? kin(I_BA)[j * 512 + n] : kin(I_BX)[j * 512 + n - 512]; }
            float* B1P = (float*)(ws + WS_B1P);
            for (int i = gt; i < 4 * 32 * 2048; i += NGT) { const int le = i >> 11, rho = i & 2047; B1P[i] = kin(I_B1)[(size_t)le * 2048 + w1_n_of_rho(rho)]; }
        }
        SEAM(PH_CONV);
    }

    if (PHEN(1) && IN(PH_H0)) {
            PH_LOCALS;
        const int rows_per = T / NGW, r0 = gw * rows_per;
        const int b = r0 / SEQ;
        const float* shp = MOD + ((size_t)0 * 16 + b) * 3072, * scp = shp + 1024;
        f32x4 sh[4], sc[4];
#pragma unroll
        for (int j = 0; j < 4; ++j) { sh[j] = *(const f32x4*)(shp + 4 * (64 * j + lane)); sc[j] = *(const f32x4*)(scp + 4 * (64 * j + lane)); }
        for (int r = r0; r < r0 + rows_per; ++r) {
            const f32x4* xr = (const f32x4*)(kin(I_X) + (size_t)r * D) + lane;
            u32x2* hr = (u32x2*)(Hb + (size_t)r * D) + lane;
#pragma unroll
            for (int j = 0; j < 4; ++j) { const f32x4 v = xr[64 * j]; const f32x4 h = v * (sc[j] + 1.0f) + sh[j];
                if (FP8_INP_EVEN) ((unsigned*)(ws + WS_H8 + (size_t)r * D) + lane)[64 * j] = pk4_fp8(h[0], h[1], h[2], h[3]);
                else { u32x2 w; w.x = pk2(h[0], h[1]); w.y = pk2(h[2], h[3]); hr[64 * j] = w; } }
        }
        if (ROUTER_X) {
            bf16_t* BRB = (bf16_t*)(ws + WS_BRB);
            const float* rwp = kin(I_RW);
            for (int i = vcu * 512 + tid; i < 4 * 32 * 1024; i += G * 512) {
                const int l = i >> 15, e = (i >> 10) & 31, k = i & 1023;
                const float w = rwp[((size_t)l * 1024 + k) * 32 + e];
#pragma unroll 4
                for (int bq = 0; bq < 16; ++bq) {
                    const float wm = w * (1.0f + MOD[((size_t)(2 * l + 1) * 16 + bq) * 3072 + 1024 + k]);
                    const unsigned h = f2bf(wm), lo2 = f2bf(wm - __builtin_bit_cast(float, h << 16));
                    bf16_t* o = BRB + (((size_t)l * 16 + bq) * 64 + e) * 1024 + k; o[0] = (bf16_t)h; o[32 * 1024] = (bf16_t)lo2; }
            }
            for (int i = vcu * 512 + tid; i < 192 * 1024 / 2; i += G * 512) ((unsigned*)(BRB + (size_t)4 * 16 * 64 * 1024))[i] = 0u;
            const int it = vcu + G * wave;
            if (it < 512) {
                const int l = it >> 7, bq = (it >> 3) & 15, eq = it & 7;
                const float* shq = MOD + ((size_t)(2 * l + 1) * 16 + bq) * 3072;
                const f32x4* rw4 = (const f32x4*)(kin(I_RW) + (size_t)l * 1024 * 32) + eq;
                float sa[4] = {0.f, 0.f, 0.f, 0.f};
#pragma unroll
                for (int i2 = 0; i2 < 16; ++i2) { const int k = lane + 64 * i2; const f32x4 wv4 = rw4[(size_t)k * 8]; const float sk = shq[k]; sa[0] += wv4[0] * sk; sa[1] += wv4[1] * sk; sa[2] += wv4[2] * sk; sa[3] += wv4[3] * sk; }
#pragma unroll
                for (int o = 1; o < 64; o <<= 1) {
#pragma unroll
                    for (int c4 = 0; c4 < 4; ++c4) sa[c4] += __builtin_bit_cast(float, __builtin_amdgcn_ds_bpermute((lane ^ o) << 2, __builtin_bit_cast(int, sa[c4])));
                }
                const f32x4 rb4 = *(const f32x4*)(kin(I_RB) + l * 32 + 4 * eq);
                *(f32x4*)((float*)(ws + WS_CB) + (l * 16 + bq) * 32 + 4 * eq) = (f32x4){sa[0] + rb4[0], sa[1] + rb4[1], sa[2] + rb4[2], sa[3] + rb4[3]};
            }
        }
        SEAM(PH_H0);
    }

    layer_body<0>(lds, LCTL, lo, hi, G, bar, wave0); layer_body<1>(lds, LCTL, lo, hi, G, bar, wave0); layer_body<2>(lds, LCTL, lo, hi, G, bar, wave0); layer_body<3>(lds, LCTL, lo, hi, G, bar, wave0);
}
#undef IN
#undef SEAM

#ifdef DUMP_SPEC
struct DumpSrc { size_t off; int ld; int col0; };
__global__ void dump_kernel(const unsigned char* ws, float* out) {
    const DumpSrc srcs[8] = DUMP_SPEC;
    const size_t i = (size_t)blockIdx.x * blockDim.x + threadIdx.x;
    const int r = (int)(i >> 10), c = (int)(i & 1023), blk = c >> 7, cc = c & 127;
    const DumpSrc d = srcs[blk];
    const bf16_t* p = (const bf16_t*)(ws + d.off);
    out[i] = bf2f(p[(size_t)r * d.ld + d.col0 + cc]);
}
#endif
extern "C" void kernel_launch(void* const* d_in, const int* in_sizes, int n_in, void* d_out, int out_size, void* d_ws, size_t ws_size, hipStream_t stream) {
    static int grid = 0;
    if (grid == 0) {
        if (n_in != 32 || out_size != T * D || ws_size < WS_END) { fprintf(stderr, "kernel_launch: unexpected problem (n_in %d, out %d, ws %zu)\n", n_in, out_size, ws_size); grid = -1; return; }
        int dev = 0, cus = 0, per_cu = 0;
        if (hipGetDevice(&dev) != hipSuccess || hipDeviceGetAttribute(&cus, hipDeviceAttributeMultiprocessorCount, dev) != hipSuccess) { grid = -1; return; }
        if (hipFuncSetAttribute((const void*)fwd_kernel, hipFuncAttributeMaxDynamicSharedMemorySize, LDS_BYTES) != hipSuccess) { fprintf(stderr, "kernel_launch: hipFuncSetAttribute failed\n"); grid = -1; return; }
        if (hipOccupancyMaxActiveBlocksPerMultiprocessor(&per_cu, (const void*)fwd_kernel, 512, LDS_BYTES) != hipSuccess || per_cu < 1) fprintf(stderr, "kernel_launch: occupancy query says %d\n", per_cu);
        (void)hipGetLastError();
        grid = cus;
        if (grid * 8 > T || (T % (grid * 8)) != 0) { fprintf(stderr, "kernel_launch: grid %d does not divide the rows\n", grid); grid = -1; return; }
    }
    if (grid < 0) return;
    (void)hipMemsetAsync((char*)d_ws + WS_CTL, 0, CTL_ZERO_BYTES, stream);
    Args a{};
    for (int i = 0; i < 32; ++i) a.in[i] = (const float*)d_in[i];
    a.out = (float*)d_out; a.ws = (unsigned char*)d_ws;
#if MK_ONE_LAUNCH
    a.ph_lo = 0; a.ph_hi = NPH;
    hipLaunchKernelGGL(fwd_kernel, dim3(grid), dim3(512), LDS_BYTES, stream, a);
#else
#ifndef STOP_PH
#define STOP_PH NPH
#endif
    for (int ph = 0; ph < STOP_PH; ++ph) {
        if (!phase_exists(ph)) continue;
        a.ph_lo = ph; a.ph_hi = ph + 1;
        hipLaunchKernelGGL(fwd_kernel, dim3(grid), dim3(512), LDS_BYTES, stream, a);
#ifdef REP_SLOTS
        { const int slot = ph < PH_L0 ? ph : 2 + (ph - PH_L0) % PH_PER_LAYER; if ((REP_SLOTS >> slot) & 1) {
#ifdef PROBE_VARIANTS
            a.variant = PROBE_VARIANTS;
#endif
            hipLaunchKernelGGL(fwd_kernel, dim3(grid), dim3(512), LDS_BYTES, stream, a); a.variant = 0; } }
#endif
    }
#ifdef DUMP_SPEC
    hipLaunchKernelGGL(dump_kernel, dim3(T * 1024 / 256), dim3(256), 0, stream, (const unsigned char*)d_ws, (float*)d_out);
#endif
#endif
}
```

```cpp
#include <hip/hip_runtime.h>
#include <cstdio>
#include <cstdint>

#ifndef PIN_ACC
#define PIN_ACC 0
#endif
#ifndef FP8_M1
#define FP8_M1 1
#endif
#ifndef FP8_M2
#define FP8_M2 1
#endif
#ifndef FP8_YS
#define FP8_INP_EVEN 0
#define FP8_INP_ODD 1
#define FP8_OUTP 1
#define WIDE_EPI 1
#define MOE_PN_FAST 1
#define FUSE_LOCAL 1
#define ROUTER_X 1
#define FP8_YS 1
#endif
#ifndef MK_ONE_LAUNCH
#define MK_ONE_LAUNCH 1
#endif

#ifndef PHMASK
#define PHMASK 0xFFFFF
#endif
#define PHEN(k) (((PHMASK) >> (k)) & 1)
#define LAS __attribute__((address_space(3)))
#define GAS __attribute__((address_space(1)))
typedef unsigned short bf16_t;
typedef short bf16x8 __attribute__((ext_vector_type(8)));
typedef float f32x4 __attribute__((ext_vector_type(4)));
typedef float f32x2 __attribute__((ext_vector_type(2)));
typedef unsigned u32x4 __attribute__((ext_vector_type(4)));
typedef unsigned u32x2 __attribute__((ext_vector_type(2)));

constexpr int D = 1024, NBATCH = 16, SEQ = 4096, T = NBATCH * SEQ, DEPTH = 4;
constexpr int NE = 32, TOPK = 4, TKTOT = T * TOPK;
constexpr int DPOOL = 512, DREC = 512, DINAB = 1536;
constexpr float LN_EPS = 1e-5f;
constexpr float DN_ALPHA = 1.6817928305074292f;

constexpr size_t MiB = 1ull << 20;
constexpr size_t WS_CTL = 0, CTL_ZERO_BYTES = 1 * MiB;
constexpr size_t WS_MOD = 1 * MiB;
constexpr size_t WS_BR = 3 * MiB;
constexpr size_t WS_BPOOL = 5 * MiB;
constexpr size_t WS_BGATE = 6 * MiB;
constexpr size_t WS_WSM = 8 * MiB;
constexpr size_t WS_BIASRI = 8 * MiB + 512 * 1024;
constexpr size_t WS_B1P = 9 * MiB;
constexpr size_t WS_SUMM = 10 * MiB;
constexpr size_t WS_TOPG = 12 * MiB;
constexpr size_t WS_ABIN = 16 * MiB;
constexpr size_t WS_ABOUT = 22 * MiB;
constexpr size_t WS_SGIN = 26 * MiB;
constexpr size_t WS_SGOUT = 34 * MiB;
constexpr size_t WS_LOG = 40 * MiB;
constexpr size_t WS_LIST = 64 * MiB;
constexpr size_t WS_BRB = 128 * MiB;
constexpr size_t WS_CB = 140 * MiB;
constexpr size_t WS_W1T = 128 * MiB;
constexpr size_t WS_W2T = 640 * MiB;
constexpr size_t WS_H = 896 * MiB;
constexpr size_t WS_Z = 1024 * MiB;
constexpr size_t WS_A2 = 1280 * MiB;
constexpr size_t WS_RI = 1408 * MiB;
constexpr size_t WS_YMIX = 1536 * MiB;
constexpr size_t WS_Y = 1664 * MiB;
constexpr size_t WS_ACT = 1792 * MiB;
constexpr size_t WS_YS = 2304 * MiB;
constexpr size_t WS_W1T8 = 2944 * MiB;
constexpr size_t WS_W2T8 = 3200 * MiB;
constexpr size_t WS_H8 = 3328 * MiB;
constexpr size_t WS_ACT8 = 3392 * MiB;
constexpr size_t WS_XB = 2816 * MiB;
constexpr size_t WS_END = 3648 * MiB;

constexpr int CW_BAR = 4096;
constexpr int CW_CNT = 16384;

constexpr int PH_CONV = 0, PH_H0 = 1, PH_L0 = 2, PH_PER_LAYER = 12, NPH = PH_L0 + PH_PER_LAYER * DEPTH;
__host__ __device__ constexpr bool phase_exists(int ph) {
    if (ph < PH_L0) return true;
    const int l = (ph - PH_L0) / PH_PER_LAYER, s = (ph - PH_L0) % PH_PER_LAYER;
    if ((l & 1) && (s == 2 || s == 3 || s == 4)) return false;
    return true;
}

constexpr int LDS_BYTES = 155648;
constexpr int LDSCTL_OFF = 154624;
constexpr int NXT_OFF = 131072;
constexpr int TAB_OFF = 147456;
constexpr int UTAB_OFF = 153600;

__device__ __forceinline__ unsigned f2bf(float f) { unsigned u = __builtin_bit_cast(unsigned, f); return (u + 0x7fffu + ((u >> 16) & 1u)) >> 16; }
typedef __bf16 bf16v2_t __attribute__((ext_vector_type(2)));
__device__ __forceinline__ unsigned pk2(float lo, float hi) { const f32x2 f = {lo, hi}; return __builtin_bit_cast(unsigned, __builtin_convertvector(f, bf16v2_t)); }
__device__ __forceinline__ float bflo(unsigned w) { return __builtin_bit_cast(float, w << 16); }
__device__ __forceinline__ float bfhi(unsigned w) { return __builtin_bit_cast(float, w & 0xffff0000u); }
__device__ __forceinline__ float bf2f(bf16_t h) { return __builtin_bit_cast(float, ((unsigned)h) << 16); }
__device__ __forceinline__ unsigned cvt_pk_bf16(float lo, float hi) { return pk2(lo, hi); }
__device__ __forceinline__ unsigned pk4_fp8(float a, float b, float c, float d) { int w = 0; w = __builtin_amdgcn_cvt_pk_fp8_f32(a, b, w, false); w = __builtin_amdgcn_cvt_pk_fp8_f32(c, d, w, true); return (unsigned)w; }
__device__ __forceinline__ float fast_sigmoid(float x) { return __builtin_amdgcn_rcpf(1.0f + __builtin_amdgcn_exp2f(-1.4426950408889634f * x)); }
__device__ __forceinline__ float gelu_tanh(float x) { const float u = x * (1.5957691216057308f + 0.07135481627362202f * x * x); return x * fast_sigmoid(u); }
__device__ __forceinline__ f32x2 pk_sigmoid_scaled(f32x2 x, float nk) {
    const f32x2 t = x * nk; f32x2 e; e.x = __builtin_amdgcn_exp2f(t.x); e.y = __builtin_amdgcn_exp2f(t.y);
    const f32x2 d = e + 1.0f; f32x2 r; r.x = __builtin_amdgcn_rcpf(d.x); r.y = __builtin_amdgcn_rcpf(d.y); return r; }
__device__ __forceinline__ f32x2 pk_gelu_tanh(f32x2 x) {
    const f32x2 t = x * ((x * x) * (-0.07135481627362202f * 1.4426950408889634f) + (-1.5957691216057308f * 1.4426950408889634f));
    f32x2 e; e.x = __builtin_amdgcn_exp2f(t.x); e.y = __builtin_amdgcn_exp2f(t.y);
    const f32x2 d = e + 1.0f; f32x2 r; r.x = __builtin_amdgcn_rcpf(d.x); r.y = __builtin_amdgcn_rcpf(d.y); return x * r; }
__device__ __forceinline__ float wave_sum(float v, int lane) {
#pragma unroll
    for (int o = 1; o < 64; o <<= 1) v += __builtin_bit_cast(float, __builtin_amdgcn_ds_bpermute((lane ^ o) << 2, __builtin_bit_cast(int, v)));
    return v;
}

__device__ __forceinline__ int lane_id_asm() { int l; asm volatile("v_mbcnt_lo_u32_b32 %0, -1, 0\n\tv_mbcnt_hi_u32_b32 %0, -1, %0" : "=v"(l)); return l; }
#define XB_TMO      128
#define XB_XCNT(j)  (256  + 64 * (j))
#define XB_XSUB(j)  (1280 + 64 * (j))
#define XB_XGEN(j)  (2304 + 64 * (j))
#define XB_TOP      3328
#define XB_TOPGEN   3392
#define XCD_BAR_WORDS 3456
#define XB_SPIN_CAP (1u << 18)

__device__ __forceinline__ unsigned xb_ld(unsigned* p)              { return __hip_atomic_load(p, __ATOMIC_RELAXED, __HIP_MEMORY_SCOPE_AGENT); }
__device__ __forceinline__ unsigned xb_add(unsigned* p, unsigned v) { return __hip_atomic_fetch_add(p, v, __ATOMIC_RELAXED, __HIP_MEMORY_SCOPE_AGENT); }
__device__ __forceinline__ unsigned xb_xcc_id() { return (unsigned)__builtin_amdgcn_s_getreg((3 << 11) | 20) & 0xFu; }
#define XB_SPIN(cond, bar) do { unsigned _sp = 0; while (cond) { __builtin_amdgcn_s_sleep(1); \
    if ((++_sp & 255u) == 0u) { if (xb_ld(&(bar)[XB_TMO])) break; if (_sp > XB_SPIN_CAP) { atomicAdd(&(bar)[XB_TMO], 1u); break; } } } } while (0)

struct XcdBarrier {
    unsigned* bar; unsigned x; int wv;
    volatile LAS unsigned* st;
};

__device__ __forceinline__ XcdBarrier xcd_barrier_post(unsigned* bar, volatile LAS unsigned* st, int wv) {
    XcdBarrier b; b.bar = bar; b.x = xb_xcc_id(); b.st = st; b.wv = wv;
    if (wv == 0 && lane_id_asm() == 0) (void)xb_add(&bar[XB_XCNT(b.x)], 1u);
    return b;
}
__device__ __forceinline__ void xcd_barrier_complete(unsigned* bar, unsigned x, unsigned& nloc, unsigned& nx) {
    const unsigned G = gridDim.x * gridDim.y * gridDim.z;
    unsigned sum, cnt, mine, sp = 0u;
    for (;;) {
        sum = 0u; cnt = 0u; mine = 0u;
#pragma unroll
        for (unsigned j = 0; j < 16; ++j) { const unsigned c = xb_ld(&bar[XB_XCNT(j)]); sum += c; cnt += (c > 0u) ? 1u : 0u; mine = (j == x) ? c : mine; }
        if (sum == G) break;
        __builtin_amdgcn_s_sleep(1);
        if ((++sp & 255u) == 0u) { if (xb_ld(&bar[XB_TMO])) break; if (sp > XB_SPIN_CAP) { atomicAdd(&bar[XB_TMO], 1u); break; } }
    }
    nloc = mine > 0u ? mine : 1u; nx = cnt > 0u ? cnt : 1u;
}

__device__ __forceinline__ void xcd_barrier(const XcdBarrier& b) {
    asm volatile("s_waitcnt vmcnt(0)" ::: "memory");
    __syncthreads();
    if (b.wv == 0 && lane_id_asm() == 0) {
        unsigned* bar = b.bar;
        __builtin_amdgcn_s_waitcnt(0);
        unsigned nloc = b.st[0], nx = b.st[1];
        if (nloc == 0u) { xcd_barrier_complete(bar, b.x, nloc, nx); b.st[0] = nloc; b.st[1] = nx; }
        const unsigned old = xb_add(&bar[XB_XSUB(b.x)], 1u);
        const unsigned gen = old / nloc;
        if (old + 1u == (gen + 1u) * nloc) {
            __builtin_amdgcn_fence(__ATOMIC_RELEASE, "agent");
            asm volatile("s_waitcnt vmcnt(0)" ::: "memory");
            const unsigned og = xb_add(&bar[XB_TOP], 1u);
            const unsigned tg = og / nx;
            if (og + 1u == (tg + 1u) * nx) xb_add(&bar[XB_TOPGEN], 1u);
            else XB_SPIN(xb_ld(&bar[XB_TOPGEN]) == tg, bar);
            __builtin_amdgcn_fence(__ATOMIC_ACQUIRE, "agent");
            xb_add(&bar[XB_XGEN(b.x)], 1u);
            asm volatile("s_waitcnt vmcnt(0)" ::: "memory");
        } else {
            XB_SPIN(xb_ld(&bar[XB_XGEN(b.x)]) == gen, bar);
            __builtin_amdgcn_fence(__ATOMIC_ACQUIRE, "agent");
            asm volatile("s_waitcnt vmcnt(0)" ::: "memory");
        }
    }
    __syncthreads();
}

#ifdef PROBE_VARIANTS
__device__ __forceinline__ int kvariant() { return *(const __attribute__((address_space(4))) int*)((const __attribute__((address_space(4))) unsigned char*)__builtin_amdgcn_kernarg_segment_ptr() + 280); }
#endif
__device__ __forceinline__ void glds16(const char* sbase, unsigned voff, unsigned lds_dst) {
    unsigned keep;
    asm volatile("s_mov_b32 %0, m0\n\ts_mov_b32 m0, %3\n\ts_nop 0\n\tglobal_load_lds_dwordx4 %1, %2\n\ts_mov_b32 m0, %0" : "=&s"(keep) : "v"(voff), "s"(sbase), "s"(lds_dst) : "memory");
}
__device__ __forceinline__ void glds4(const char* sbase, unsigned voff, unsigned lds_dst) {
    unsigned keep;
    asm volatile("s_mov_b32 %0, m0\n\ts_mov_b32 m0, %3\n\ts_nop 0\n\tglobal_load_lds_dword %1, %2\n\ts_mov_b32 m0, %0" : "=&s"(keep) : "v"(voff), "s"(sbase), "s"(lds_dst) : "memory");
}
namespace pg8 {
constexpr int BM = 256, BK = 64, HALF = 128, HTB = HALF * BK * 2, STAGE_BYTES = 8 * HTB, NXCD = 8, WGM = 8;
__host__ __device__ __forceinline__ int perm32(int rho) { const int n = rho >> 4, i = rho & 15; return 8 * (i >> 2) + 4 * n + (i & 3); }

template <bool F8> __host__ __device__ __forceinline__ int chunk_xor(int r15) { const int rp = (r15 >> 1) & 7; return F8 ? ((rp & 4) | ((rp & 1) << 1) | ((rp >> 1) & 1)) : rp; }
struct Unit { int arow, brow, pn, e, rt, cnt, slot, koff; };
struct Gemm { const void* A; const void* Bt; int lda, ldb, K, wscale; };
typedef int i32x4 __attribute__((ext_vector_type(4)));
typedef int i32x8 __attribute__((ext_vector_type(8)));
__device__ __forceinline__ i32x8 cat8(bf16x8 lo, bf16x8 hi) { return __builtin_shufflevector(__builtin_bit_cast(i32x4, lo), __builtin_bit_cast(i32x4, hi), 0, 1, 2, 3, 4, 5, 6, 7); }

struct DenseSched {
    static constexpr bool GATHER = false;
    int nM, nN, nwg, G, c, kblk = 0, bb = 0, rowm = 0;
    __device__ __forceinline__ void init(int M, int N, int G_, int c_) { nM = M / BM; nN = N / BM; nwg = nM * nN; G = G_; c = c_; }
    __device__ __forceinline__ bool next(int i, Unit& u) const {
        int pm, pn;
        if (rowm) { if (i >= nN) return false; pm = (c % NXCD) * (G / NXCD) + c / NXCD; pn = i; }
        else {
        const long L = (long)i * G + c; if (L >= nwg) return false;
        int wgid = (int)L; { const int q = nwg / NXCD, r = nwg % NXCD, xcd = wgid % NXCD, off = wgid / NXCD; wgid = (xcd < r ? xcd * (q + 1) : r * (q + 1) + (xcd - r) * q) + off; }
        const int nig = WGM * nN, gid = wgid / nig, fm = gid * WGM, gsz = (nM - fm) < WGM ? (nM - fm) : WGM;
        pm = fm + ((wgid % nig) % gsz); pn = (wgid % nig) / gsz; }
        u.arow = pm * BM; u.brow = pn * BM; u.pn = pn; u.e = 0; u.rt = pm; u.cnt = BM; u.slot = 0; u.koff = (pn & 1) * kblk; u.brow += ((pm * BM) >> 12) * bb; return true;
    }
    __device__ __forceinline__ void a_off(const Unit& u, LAS unsigned char*, int R0, int C0, int lda2, unsigned (&off)[2][2]) const {
#pragma unroll
        for (int h = 0; h < 2; ++h)
#pragma unroll
            for (int i = 0; i < 2; ++i) off[h][i] = (unsigned)((u.arow + 128 * h + 64 * i + R0) * lda2 + C0);
    }
};

struct MoeSched {
    static constexpr bool GATHER = true;
    const LAS int* utab;
    const int* list;
    const float* bias;
    int nunits, nexp_rows, shift;
    __device__ __forceinline__ bool next(int i, Unit& u) const {
        if (i >= nunits) return false;
        const LAS int* p = utab + 4 * i;
        u.e = __builtin_amdgcn_readfirstlane(p[0]); u.rt = __builtin_amdgcn_readfirstlane(p[1]); u.pn = __builtin_amdgcn_readfirstlane(p[2]); u.cnt = __builtin_amdgcn_readfirstlane(p[3]);
        u.arow = 0; u.brow = u.e * nexp_rows + u.pn * BM; u.slot = i % 3; u.koff = 0; return true;
    }
    __device__ __forceinline__ void tab_issue(const Unit& u, unsigned ldsb, int wid, int lane) const {
        if (wid < 4) { int p = u.rt * BM + 64 * wid + lane; p = p < u.cnt ? p : u.cnt - 1;
            glds4((const char*)(list + (size_t)u.e * TKTOT), (unsigned)p * 4u, ldsb + TAB_OFF + u.slot * 1024 + wid * 256); }
        else glds4((const char*)(bias + (size_t)u.e * nexp_rows + u.pn * BM), (unsigned)(64 * (wid - 4) + lane) * 4u, ldsb + TAB_OFF + 3072 + u.slot * 1024 + (wid - 4) * 256);
    }
    __device__ __forceinline__ void a_off(const Unit& u, LAS unsigned char* lds, int R0, int C0, int lda2, unsigned (&off)[2][2]) const {
        const LAS int* ids = (const LAS int*)(lds + TAB_OFF + u.slot * 1024);
#pragma unroll
        for (int h = 0; h < 2; ++h)
#pragma unroll
            for (int i = 0; i < 2; ++i) off[h][i] = (unsigned)((ids[128 * h + 64 * i + R0] >> shift) * lda2 + C0);
    }
};
__device__ __forceinline__ int moe_build_units(LAS int* utab, const volatile LAS int* tstart, const volatile LAS int* cnts, int NP, int G, int c, int tid) {
    const int total = tstart[NE] * NP;
    if (tid < 64) { const int L = tid * G + c;
        if (L < total) { int e = 0;
            for (int q = 0; q < NE - 1; ++q) if (tstart[q + 1] * NP <= L) e = q + 1;
            const int t0 = tstart[e], nte = tstart[e + 1] - t0, idx = L - t0 * NP;
            utab[4 * tid + 0] = e; utab[4 * tid + 1] = MOE_PN_FAST ? idx / NP : idx % nte; utab[4 * tid + 2] = MOE_PN_FAST ? idx % NP : idx / nte; utab[4 * tid + 3] = cnts[e]; } }
    return total > c ? (total - c + G - 1) / G : 0;
}

template <int ACT  , bool HAS_BIAS, bool HAS_SCALE, bool OSC = false, bool OUT8 = false> struct EpiDense {
    static constexpr int PERM = WIDE_EPI ? 2 : 1;
    bf16_t* O; int ldc; const float* bias; const float* scale; float oscale;
    __device__ __forceinline__ void operator()(const f32x4 (&acc)[2][2][4][2], const Unit& u, int wr, int wc, int fr, int fq) const {
        const int row0 = u.arow + wr * 64 + fr, col0 = PERM == 2 ? u.pn * BM + wc * 64 + 16 * fq : u.pn * BM + wc * 32 + 8 * fq;
        constexpr int BJS = PERM == 2 ? 8 : HALF;
        f32x4 bv[2][2], sv[2][2];
#pragma unroll
        for (int bj = 0; bj < 2; ++bj)
#pragma unroll
            for (int n = 0; n < 2; ++n) {
                if (HAS_BIAS) bv[bj][n] = *(const f32x4*)(bias + col0 + bj * BJS + 4 * n);
                if (HAS_SCALE) sv[bj][n] = *(const f32x4*)(scale + col0 + bj * BJS + 4 * n);
            }
#pragma unroll
        for (int ai = 0; ai < 2; ++ai)
#pragma unroll
            for (int m = 0; m < 4; ++m) { bf16_t* rowp = O + (size_t)(row0 + ai * HALF + m * 16) * ldc + col0; unsigned char* rowp8 = (unsigned char*)O + (size_t)(row0 + ai * HALF + m * 16) * ldc + col0;
                u32x4 w8;
#pragma unroll
                for (int bj = 0; bj < 2; ++bj) { f32x4 v0 = acc[ai][bj][m][0], v1 = acc[ai][bj][m][1];
                    if (OSC) { v0 = v0 * oscale; v1 = v1 * oscale; }
                    if (HAS_BIAS) { v0 = v0 + bv[bj][0]; v1 = v1 + bv[bj][1]; }
                    if (ACT == 1) { const f32x2 a = pk_gelu_tanh((f32x2){v0[0], v0[1]}), b = pk_gelu_tanh((f32x2){v0[2], v0[3]}), c = pk_gelu_tanh((f32x2){v1[0], v1[1]}), d = pk_gelu_tanh((f32x2){v1[2], v1[3]});
                        v0 = (f32x4){a.x, a.y, b.x, b.y}; v1 = (f32x4){c.x, c.y, d.x, d.y}; }
                    if (ACT == 2) { const float nk = -1.4426950408889634f;
                        const f32x2 a = pk_sigmoid_scaled((f32x2){v0[0], v0[1]}, nk), b = pk_sigmoid_scaled((f32x2){v0[2], v0[3]}, nk), c = pk_sigmoid_scaled((f32x2){v1[0], v1[1]}, nk), d = pk_sigmoid_scaled((f32x2){v1[2], v1[3]}, nk);
                        v0 = (f32x4){a.x, a.y, b.x, b.y}; v1 = (f32x4){c.x, c.y, d.x, d.y}; }
                    if (HAS_SCALE) { v0 = v0 * sv[bj][0]; v1 = v1 * sv[bj][1]; }
                    if constexpr (OUT8) { const unsigned p0 = pk4_fp8(v0[0], v0[1], v0[2], v0[3]), p1 = pk4_fp8(v1[0], v1[1], v1[2], v1[3]);
                        if constexpr (PERM == 2) { if (bj == 0) { w8.x = p0; w8.y = p1; } else { w8.z = p0; w8.w = p1; *(u32x4*)rowp8 = w8; } }
                        else { u32x2 w; w.x = p0; w.y = p1; *(u32x2*)(rowp8 + bj * HALF) = w; } }
                    else { u32x4 w; w.x = cvt_pk_bf16(v0[0], v0[1]); w.y = cvt_pk_bf16(v0[2], v0[3]); w.z = cvt_pk_bf16(v1[0], v1[1]); w.w = cvt_pk_bf16(v1[2], v1[3]);
                    *(u32x4*)(rowp + bj * BJS) = w; } } }
    }
};
struct EpiRouter {
    static constexpr int PERM = 0;
    float* LOG;
    __device__ __forceinline__ void operator()(const f32x4 (&acc)[2][2][4][2], const Unit& u, int wr, int wc, int fr, int fq) const {
        if (wc < 2) {
#pragma unroll
            for (int ai = 0; ai < 2; ++ai)
#pragma unroll
                for (int m = 0; m < 4; ++m) { float* rowp = LOG + (size_t)(u.arow + ai * HALF + wr * 64 + m * 16 + fr) * 64 + wc * 32 + 4 * fq;
#pragma unroll
                    for (int n = 0; n < 2; ++n) *(f32x4*)(rowp + 16 * n) = acc[ai][0][m][n]; }
        }
    }
};
template <bool OUT8> struct EpiMoe1 {
    static constexpr int PERM = 0;
    bf16_t* ACT; LAS unsigned char* lds; float oscale;
    __device__ __forceinline__ void operator()(const f32x4 (&acc)[2][2][4][2], const Unit& u, int wr, int wc, int fr, int fq) const {
        const LAS int* ids = (const LAS int*)(lds + TAB_OFF + u.slot * 1024);
        const LAS float* bp = (const LAS float*)(lds + TAB_OFF + 3072 + u.slot * 1024) + wc * 32 + 4 * fq;
        f32x4 bg[2], bl[2];
#pragma unroll
        for (int bj = 0; bj < 2; ++bj) { bg[bj] = *(const LAS f32x4*)(bp + bj * HALF); bl[bj] = *(const LAS f32x4*)(bp + bj * HALF + 16) + 1.0f; }
        const int j0 = u.pn * 128 + wc * 32 + 8 * fq;
#pragma unroll
        for (int ai = 0; ai < 2; ++ai)
#pragma unroll
            for (int m = 0; m < 4; ++m) {
                const int pl = ai * HALF + wr * 64 + m * 16 + fr;
                if (u.rt * BM + pl < u.cnt) {
                    const int flat = ids[pl];
                    float o[8];
#pragma unroll
                    for (int bj = 0; bj < 2; ++bj) { const f32x4 g = acc[ai][bj][m][0] * oscale + bg[bj], l = acc[ai][bj][m][1] * oscale + bl[bj];
#pragma unroll
                        for (int hh = 0; hh < 2; ++hh) {
                            const f32x2 xg = {fminf(g[2 * hh], 7.0f), fminf(g[2 * hh + 1], 7.0f)};
                            const f32x2 xl = {__builtin_amdgcn_fmed3f(l[2 * hh], -6.0f, 8.0f), __builtin_amdgcn_fmed3f(l[2 * hh + 1], -6.0f, 8.0f)};
                            const f32x2 r = pk_sigmoid_scaled(xg, -1.702f * 1.4426950408889634f), oo = (xg * xl) * r;
                            o[bj * 4 + 2 * hh] = oo.x; o[bj * 4 + 2 * hh + 1] = oo.y; } }
                    if constexpr (OUT8) { u32x2 w; w.x = pk4_fp8(o[0], o[1], o[2], o[3]); w.y = pk4_fp8(o[4], o[5], o[6], o[7]);
                        *(u32x2*)((unsigned char*)ACT + (size_t)flat * 1024 + j0) = w; }
                    else { u32x4 w; w.x = cvt_pk_bf16(o[0], o[1]); w.y = cvt_pk_bf16(o[2], o[3]); w.z = cvt_pk_bf16(o[4], o[5]); w.w = cvt_pk_bf16(o[6], o[7]);
                        *(u32x4*)(ACT + (size_t)flat * 1024 + j0) = w; }
                }
            }
    }
};
struct EpiMoe2 {
    static constexpr int PERM = (WIDE_EPI && FP8_YS) ? 2 : 1;
    bf16_t* YS; LAS unsigned char* lds; float oscale;
    __device__ __forceinline__ void operator()(const f32x4 (&acc)[2][2][4][2], const Unit& u, int wr, int wc, int fr, int fq) const {
        const LAS int* ids = (const LAS int*)(lds + TAB_OFF + u.slot * 1024);
        if constexpr (PERM == 2) {
            const LAS float* bp = (const LAS float*)(lds + TAB_OFF + 3072 + u.slot * 1024) + wc * 64 + 16 * fq;
            const int col0 = u.pn * BM + wc * 64 + 16 * fq;
            const float os = 16.0f * oscale;
#pragma unroll
            for (int ai = 0; ai < 2; ++ai) {
                const f32x4 b00 = *(const LAS f32x4*)(bp) * 16.0f, b01 = *(const LAS f32x4*)(bp + 4) * 16.0f, b10 = *(const LAS f32x4*)(bp + 8) * 16.0f, b11 = *(const LAS f32x4*)(bp + 12) * 16.0f;
#pragma unroll
                for (int m = 0; m < 4; ++m) {
                    const int pl = ai * HALF + wr * 64 + m * 16 + fr;
                    if (u.rt * BM + pl < u.cnt) {
                        const int flat = ids[pl];
                        const f32x4 v00 = acc[ai][0][m][0] * os + b00, v01 = acc[ai][0][m][1] * os + b01, v10 = acc[ai][1][m][0] * os + b10, v11 = acc[ai][1][m][1] * os + b11;
                        u32x4 w; w.x = pk4_fp8(v00[0], v00[1], v00[2], v00[3]); w.y = pk4_fp8(v01[0], v01[1], v01[2], v01[3]); w.z = pk4_fp8(v10[0], v10[1], v10[2], v10[3]); w.w = pk4_fp8(v11[0], v11[1], v11[2], v11[3]);
                        *(u32x4*)((unsigned char*)YS + (size_t)flat * 1024 + col0) = w;
                    }
                }
            }
        } else {
        const LAS float* bp = (const LAS float*)(lds + TAB_OFF + 3072 + u.slot * 1024) + wc * 32 + 8 * fq;
        const int col0 = u.pn * BM + wc * 32 + 8 * fq;
#pragma unroll
        for (int bj = 0; bj < 2; ++bj) {
            const float os = FP8_YS ? 16.0f * oscale : oscale;
            const f32x4 b0 = *(const LAS f32x4*)(bp + bj * HALF) * (FP8_YS ? 16.0f : 1.0f), b1 = *(const LAS f32x4*)(bp + bj * HALF + 4) * (FP8_YS ? 16.0f : 1.0f);
#pragma unroll
            for (int ai = 0; ai < 2; ++ai)
#pragma unroll
                for (int m = 0; m < 4; ++m) {
                    const int pl = ai * HALF + wr * 64 + m * 16 + fr;
                    if (u.rt * BM + pl < u.cnt) {
                        const int flat = ids[pl];
                        const f32x4 v0 = acc[ai][bj][m][0] * os + b0, v1 = acc[ai][bj][m][1] * os + b1;
                        if (FP8_YS) { u32x2 w; w.x = pk4_fp8(v0[0], v0[1], v0[2], v0[3]); w.y = pk4_fp8(v1[0], v1[1], v1[2], v1[3]);
                            *(u32x2*)((unsigned char*)YS + (size_t)flat * 1024 + col0 + bj * HALF) = w; }
                        else { u32x4 w; w.x = cvt_pk_bf16(v0[0], v0[1]); w.y = cvt_pk_bf16(v0[2], v0[3]); w.z = cvt_pk_bf16(v1[0], v1[1]); w.w = cvt_pk_bf16(v1[2], v1[3]);
                            *(u32x4*)(YS + (size_t)flat * 1024 + col0 + bj * HALF) = w; }
                    }
                }
        }
        }
    }
};

template <bool F8, class Epi, class Sched>
__device__ __forceinline__ void gemm_phase(LAS unsigned char* lds, const Gemm g, const Sched& S, const Epi& E, const int wave0) {
    const int tid = (wave0 << 6) | lane_id_asm();
    const int wid = __builtin_amdgcn_readfirstlane(tid >> 6), lane = tid & 63, wr = wid >> 2, wc = wid & 3, fr = lane & 15, fq = lane >> 4;
    constexpr unsigned ESZ = F8 ? 1u : 2u;
    const int nt = (int)((unsigned)g.K * ESZ / 128u);
    int R0, C0;
    R0 = 8 * wid + (lane >> 3); C0 = 16 * ((lane & 7) ^ chunk_xor<F8>(R0 & 15));
    const unsigned lda2 = (unsigned)g.lda * ESZ, ldb2 = (unsigned)g.ldb * ESZ;
    const unsigned voffB = (unsigned)((Epi::PERM == 2 ? (64 * (R0 >> 5) + 16 * ((R0 >> 2) & 3) + 4 * ((R0 >> 4) & 1) + (R0 & 3)) : Epi::PERM == 1 ? ((R0 & ~31) + perm32(R0 & 31)) : R0) * (int)ldb2 + C0);
    constexpr int PIECE_B = Epi::PERM == 2 ? 128 : 64;
    const unsigned aoffl = (unsigned)(R0 * (int)lda2 + C0);
    const unsigned kstep = 128;
    const size_t hstepB = (size_t)(Epi::PERM == 2 ? 8 : HALF) * ldb2;
    const unsigned ldsw = (unsigned)wid * 1024u;
    const int ab = fr * 128 + 16 * ((F8 ? 2 * fq : fq) ^ chunk_xor<F8>(fr));
    const int aoff0 = wr * 8192 + ab, boff0 = wc * 4096 + ab;
    constexpr int KX = F8 ? 16 : 64;
    const char* const Abase = (const char*)g.A;
    const unsigned ldsb = (unsigned)(size_t)lds;
#define PG8_SA(b, h) (((b) * 2 + (h)) * HTB)
#define PG8_SB(b, h) ((4 + (b) * 2 + (h)) * HTB)
#define PG8_GOFF(h, NXT) do { if constexpr (Sched::GATHER) go = *(const LAS u32x2*)(lds + NXT_OFF + ((((NXT) ? ui + 1 : ui) & 1) << 13) + tid * 16 + (h) * 8); } while (0)
#define PG8_STAGE_A(bufoff, h, NXT, kb) do { _Pragma("unroll") for (int _i = 0; _i < 2; ++_i) { \
        if constexpr (Sched::GATHER) glds16(Abase + (kb), _i ? go.y : go.x, ldsb + (bufoff) + ldsw + _i * 8192); \
        else glds16(Abase + ((NXT) ? nxtA : curA) + (size_t)((h) * 128 + _i * 64) * lda2 + (kb), aoffl, ldsb + (bufoff) + ldsw + _i * 8192); } } while (0)
#define PG8_STAGE_B(bufoff, bptr, kb) do { _Pragma("unroll") for (int _i = 0; _i < 2; ++_i) \
        glds16((bptr) + (size_t)(_i * PIECE_B) * ldb2 + (kb), voffB, ldsb + (bufoff) + ldsw + _i * 8192); } while (0)
#define PG8_LDA(dst, b, h) do { int _a1 = aoff0 ^ KX; asm volatile("" : "+v"(_a1)); \
        _Pragma("unroll") for (int m = 0; m < 4; ++m) _Pragma("unroll") for (int k = 0; k < 2; ++k) dst[m][k] = *(const LAS bf16x8*)(lds + PG8_SA(b, h) + (k ? _a1 : aoff0) + m * 2048); } while (0)
#define PG8_LDB(dst, b, h) do { int _b1 = boff0 ^ KX; asm volatile("" : "+v"(_b1)); \
        _Pragma("unroll") for (int n = 0; n < 2; ++n) _Pragma("unroll") for (int k = 0; k < 2; ++k) dst[n][k] = *(const LAS bf16x8*)(lds + PG8_SB(b, h) + (k ? _b1 : boff0) + n * 2048); } while (0)
#define PG8_MMA(ai, bj, At, Bt) do { __builtin_amdgcn_s_setprio(1); _Pragma("unroll") for (int m = 0; m < 4; ++m) _Pragma("unroll") for (int n = 0; n < 2; ++n) { \
        if constexpr (F8) acc[ai][bj][m][n] = __builtin_amdgcn_mfma_scale_f32_16x16x128_f8f6f4(cat8(Bt[n][0], Bt[n][1]), cat8(At[m][0], At[m][1]), acc[ai][bj][m][n], 0, 0, 0, 0, 0, 0); \
        else { _Pragma("unroll") for (int k = 0; k < 2; ++k) acc[ai][bj][m][n] = __builtin_amdgcn_mfma_f32_16x16x32_bf16(Bt[n][k], At[m][k], acc[ai][bj][m][n], 0, 0, 0); } } \
        __builtin_amdgcn_s_setprio(0); } while (0)
#define PG8_WAIT_V(n) asm volatile("s_waitcnt vmcnt(" #n ")" ::: "memory")
#define PG8_WAIT_L(n) asm volatile("s_waitcnt lgkmcnt(" #n ")" ::: "memory")
#define PG8_BAR __builtin_amdgcn_s_barrier()
#define PG8_SCHED __builtin_amdgcn_sched_barrier(0)
#define PG8_KITER(k1, b2, NXT, k2, k3) do { \
        PG8_GOFF(1, 0); PG8_LDB(B0, 0, 0); PG8_LDB(B1, 0, 1); PG8_SCHED; PG8_LDA(At, 0, 0); PG8_STAGE_A(PG8_SA(1, 1), 1, 0, (k1)); \
        PG8_WAIT_V(8); PG8_WAIT_L(0); PG8_BAR; PG8_MMA(0, 0, At, B0); PG8_MMA(0, 1, At, B1); PG8_BAR; PG8_SCHED; \
        PG8_GOFF(0, NXT); PG8_LDA(At, 0, 1); PG8_STAGE_B(PG8_SB(0, 0), (b2), (k2)); PG8_STAGE_B(PG8_SB(0, 1), (b2) + hstepB, (k2)); PG8_STAGE_A(PG8_SA(0, 0), 0, NXT, (k2)); \
        PG8_WAIT_V(8); PG8_WAIT_L(0); PG8_BAR; PG8_MMA(1, 0, At, B0); PG8_MMA(1, 1, At, B1); PG8_BAR; PG8_SCHED; \
        PG8_GOFF(1, NXT); PG8_LDB(B0, 1, 0); PG8_LDB(B1, 1, 1); PG8_SCHED; PG8_LDA(At, 1, 0); PG8_STAGE_A(PG8_SA(0, 1), 1, NXT, (k2)); \
        PG8_WAIT_V(8); PG8_WAIT_L(0); PG8_BAR; PG8_MMA(0, 0, At, B0); PG8_MMA(0, 1, At, B1); PG8_BAR; PG8_SCHED; \
        PG8_GOFF(0, NXT); PG8_LDA(At, 1, 1); PG8_STAGE_B(PG8_SB(1, 0), (b2), (k3)); PG8_STAGE_B(PG8_SB(1, 1), (b2) + hstepB, (k3)); PG8_STAGE_A(PG8_SA(1, 0), 0, NXT, (k3)); \
        PG8_WAIT_V(8); PG8_WAIT_L(0); PG8_BAR; PG8_MMA(1, 0, At, B0); PG8_MMA(1, 1, At, B1); PG8_BAR; PG8_SCHED; } while (0)

    Unit cur, nxt; int ui = 0;
    if (!S.next(0, cur)) return;
    unsigned curoff[2][2], nxtoff[2][2];
    size_t curA = 0, nxtA = 0;
    bool has_next = S.next(1, nxt);
#define PG8_NXT_SLOT ((LAS u32x4*)(lds + NXT_OFF) + tid)
    if constexpr (Sched::GATHER) {
        S.tab_issue(cur, ldsb, wid, lane); if (has_next) S.tab_issue(nxt, ldsb, wid, lane);
        asm volatile("s_waitcnt vmcnt(0)" ::: "memory"); __builtin_amdgcn_s_barrier(); asm volatile("" ::: "memory");
        S.a_off(cur, lds, R0, C0, (int)lda2, curoff);
        if (has_next) S.a_off(nxt, lds, R0, C0, (int)lda2, nxtoff);
        else {
#pragma unroll
            for (int h = 0; h < 2; ++h)
#pragma unroll
                for (int i = 0; i < 2; ++i) nxtoff[h][i] = curoff[h][i]; }
        ((LAS u32x4*)(lds + NXT_OFF))[tid] = (u32x4){curoff[0][0], curoff[0][1], curoff[1][0], curoff[1][1]};
        ((LAS u32x4*)(lds + NXT_OFF + 8192))[tid] = (u32x4){nxtoff[0][0], nxtoff[0][1], nxtoff[1][0], nxtoff[1][1]};
    } else { curA = (size_t)cur.arow * lda2 + cur.koff; nxtA = has_next ? (size_t)nxt.arow * lda2 + nxt.koff : curA; }
    f32x4 acc[2][2][4][2];
#pragma unroll
    for (int a = 0; a < 2; ++a)
#pragma unroll
        for (int b = 0; b < 2; ++b)
#pragma unroll
            for (int m = 0; m < 4; ++m)
#pragma unroll
                for (int n = 0; n < 2; ++n) acc[a][b][m][n] = (f32x4){0.f, 0.f, 0.f, 0.f};
    bf16x8 At[4][2], B0[2][2], B1[2][2];
    const char* cB = (const char*)g.Bt + (size_t)cur.brow * ldb2 + cur.koff;
    u32x2 go = {0u, 0u};
    PG8_STAGE_B(PG8_SB(0, 0), cB, 0u); PG8_STAGE_B(PG8_SB(0, 1), cB + hstepB, 0u); PG8_GOFF(0, 0); PG8_STAGE_A(PG8_SA(0, 0), 0, 0, 0u); PG8_GOFF(1, 0); PG8_STAGE_A(PG8_SA(0, 1), 1, 0, 0u);
    if (wr == 1) PG8_BAR;
    PG8_WAIT_V(2); PG8_BAR;
    PG8_GOFF(0, 0); PG8_STAGE_B(PG8_SB(1, 0), cB, kstep); PG8_STAGE_A(PG8_SA(1, 0), 0, 0, kstep); PG8_STAGE_B(PG8_SB(1, 1), cB + hstepB, kstep);
    PG8_WAIT_V(6); PG8_BAR;
    for (;;) {
        const char* nB = has_next ? (const char*)g.Bt + (size_t)nxt.brow * ldb2 + nxt.koff : cB;
        Unit u2; bool has2 = false;
        if constexpr (Sched::GATHER) has2 = has_next && S.next(ui + 2, u2);
#pragma unroll 1
        for (int t = 0; t < nt - 2; t += 2) {
            const unsigned k1 = (unsigned)(t + 1) * kstep, k2 = (unsigned)(t + 2) * kstep, k3 = (unsigned)(t + 3) * kstep;
            if constexpr (Sched::GATHER) { if (t == 2 && has2) S.tab_issue(u2, ldsb, wid, lane); }
            PG8_KITER(k1, cB, 0, k2, k3);
        }
        { const unsigned k1 = (unsigned)(nt - 1) * kstep; PG8_KITER(k1, nB, 1, 0u, kstep); }
#if PIN_ACC
#pragma unroll
        for (int a = 0; a < 2; ++a)
#pragma unroll
            for (int b = 0; b < 2; ++b)
#pragma unroll
                for (int m = 0; m < 4; ++m) asm volatile("" : "+v"(acc[a][b][m][0]), "+v"(acc[a][b][m][1]));
#endif
        if (wr == 0) PG8_BAR;
#ifdef PROBE_VARIANTS
        if (!(kvariant() & 4))
#endif
        { const int l2 = lane_id_asm(); E(acc, cur, wr, wc, l2 & 15, l2 >> 4); }
        if (!has_next) break;
#pragma unroll
        for (int a = 0; a < 2; ++a)
#pragma unroll
            for (int b = 0; b < 2; ++b)
#pragma unroll
                for (int m = 0; m < 4; ++m)
#pragma unroll
                    for (int n = 0; n < 2; ++n) acc[a][b][m][n] = (f32x4){0.f, 0.f, 0.f, 0.f};
        cur = nxt; cB = nB; ++ui; curA = nxtA;
        has_next = S.next(ui + 1, nxt);
        if (has_next) {
            if constexpr (Sched::GATHER) { const int tz = (wave0 << 6) | lane_id_asm(); int R0z, C0z;
                { const int lz = tz & 63; R0z = 8 * wid + (lz >> 3); C0z = 16 * ((lz & 7) ^ chunk_xor<F8>(R0z & 15)); }
                S.a_off(nxt, lds, R0z, C0z, (int)lda2, nxtoff);
                ((LAS u32x4*)(lds + NXT_OFF + (((ui + 1) & 1) << 13)))[tz] = (u32x4){nxtoff[0][0], nxtoff[0][1], nxtoff[1][0], nxtoff[1][1]}; }
            else nxtA = (size_t)nxt.arow * lda2 + nxt.koff;
        } else if constexpr (Sched::GATHER) { const int tz = (wave0 << 6) | lane_id_asm();
            ((LAS u32x4*)(lds + NXT_OFF + (((ui + 1) & 1) << 13)))[tz] = ((const LAS u32x4*)(lds + NXT_OFF + ((ui & 1) << 13)))[tz]; }
        if (wr == 1) PG8_BAR;
    }
    PG8_WAIT_V(0);
    PG8_BAR;
#undef PG8_SA
#undef PG8_SB
#undef PG8_STAGE_A
#undef PG8_GOFF
#undef PG8_STAGE_B
#undef PG8_LDA
#undef PG8_LDB
#undef PG8_MMA
#undef PG8_WAIT_V
#undef PG8_WAIT_L
#undef PG8_BAR
#undef PG8_SCHED
#undef PG8_KITER
#undef PG8_NXT_SLOT
}
}

struct Args { const float* in[32]; float* out; unsigned char* ws; int ph_lo, ph_hi, variant, pad; };
typedef const __attribute__((address_space(4))) unsigned char* kptr_t;
__device__ __forceinline__ const float* kin(int i) { kptr_t p = (kptr_t)__builtin_amdgcn_kernarg_segment_ptr(); asm volatile("" : "+s"(p)); return *(const float* const __attribute__((address_space(4)))*)(p + 8 * i); }
enum { I_X = 0, I_C, I_MODW, I_MODB, I_LNG, I_LNB, I_ABWIN, I_POOLW, I_POOLS, I_CONVW, I_CONVB, I_WA, I_BA, I_WX, I_BX, I_LAM, I_ABWOUT, I_ABBOUT,
       I_SGWIN, I_SGBIN, I_SGLNG, I_SGLNB, I_SGWS, I_SGBS, I_SGWOUT, I_SGBOUT, I_RW, I_RB, I_W1, I_B1, I_W2, I_B2 };

__device__ __forceinline__ int w1_rho(int n) { const int nn = n & 1, j = n >> 1; return ((j >> 7) << 8) | (((j >> 2) & 1) << 7) | (((j >> 5) & 3) << 5) | (nn << 4) | (((j >> 3) & 3) << 2) | (j & 3); }
__device__ __forceinline__ int w1_n_of_rho(int rho) { const int pn = rho >> 8, bj = (rho >> 7) & 1, wc = (rho >> 5) & 3, nn = (rho >> 4) & 1, fq = (rho >> 2) & 3, i = rho & 3; return 2 * (128 * pn + 32 * wc + 8 * fq + 4 * bj + i) + nn; }
template <bool W1MAP>
__device__ __forceinline__ void conv_item(const float* W, int N, bf16_t* WT, int item, int lane) {
    const int nblk = N >> 5, kb = item / nblk, nb = item - kb * nblk;
    const int kg = lane >> 3, nl = lane & 7, k0 = kb * 64 + kg * 8, n0 = nb * 32 + nl * 4;
    f32x4 v[8];
#pragma unroll
    for (int q = 0; q < 8; ++q) v[q] = *(const f32x4*)(W + (size_t)(k0 + q) * N + n0);
#pragma unroll
    for (int i = 0; i < 4; ++i) {
        const int n = n0 + i, row = W1MAP ? w1_rho(n) : n;
        u32x4 o; o.x = pk2(v[0][i], v[1][i]); o.y = pk2(v[2][i], v[3][i]); o.z = pk2(v[4][i], v[5][i]); o.w = pk2(v[6][i], v[7][i]);
        *(u32x4*)(WT + (size_t)row * 1024 + k0) = o;
    }
}

template <bool W1MAP>
__device__ __forceinline__ void conv_item_f8(const float* W, int N, unsigned char* WT8, int item, int lane, float scale) {
    const int nblk = N >> 5, kb = item / nblk, nb = item - kb * nblk;
    const int kg = lane >> 3, nl = lane & 7, k0 = kb * 128 + kg * 16, n0 = nb * 32 + nl * 4;
    f32x4 v[16];
#pragma unroll
    for (int q = 0; q < 16; ++q) v[q] = *(const f32x4*)(W + (size_t)(k0 + q) * N + n0) * scale;
#pragma unroll
    for (int i = 0; i < 4; ++i) {
        const int n = n0 + i, row = W1MAP ? w1_rho(n) : n;
        u32x4 o; o.x = pk4_fp8(v[0][i], v[1][i], v[2][i], v[3][i]); o.y = pk4_fp8(v[4][i], v[5][i], v[6][i], v[7][i]);
        o.z = pk4_fp8(v[8][i], v[9][i], v[10][i], v[11][i]); o.w = pk4_fp8(v[12][i], v[13][i], v[14][i], v[15][i]);
        *(u32x4*)(WT8 + (size_t)row * 1024 + k0) = o;
    }
}

#define IN(k) (lo <= (k) && (k) < hi)
#define SEAM(k) do { if ((k) + 1 < hi) xcd_barrier(bar); } while (0)
#define LSEAM(k) do { if ((k) + 1 < hi) { if (FUSE_LOCAL && G == 256) { __builtin_amdgcn_fence(__ATOMIC_RELEASE, "workgroup"); __syncthreads(); __builtin_amdgcn_fence(__ATOMIC_ACQUIRE, "workgroup"); } else xcd_barrier(bar); } } while (0)
#define PH_LOCALS \
    const int tid = (wave0 << 6) | lane_id_asm(); \
    const int lane = tid & 63, wave = wave0; \
    int bx = blockIdx.x; asm volatile("" : "+s"(bx)); \
    const int vcu = (G % 8 == 0) ? (bx % 8) * (G / 8) + bx / 8 : bx; \
    const int gw = vcu * 8 + wave, NGW = G * 8; \
    unsigned char* ws; { kptr_t kp_ = (kptr_t)__builtin_amdgcn_kernarg_segment_ptr(); asm volatile("" : "+s"(kp_)); ws = *(unsigned char* const __attribute__((address_space(4)))*)(kp_ + 264); } \
    float* Xf; { kptr_t kp_ = (kptr_t)__builtin_amdgcn_kernarg_segment_ptr(); asm volatile("" : "+s"(kp_)); Xf = *(float* const __attribute__((address_space(4)))*)(kp_ + 256); } \
    unsigned* const ctl = (unsigned*)(ws + WS_CTL); \
    float* const MOD = (float*)(ws + WS_MOD); bf16_t* const Hb = (bf16_t*)(ws + WS_H); bf16_t* const Zb = (bf16_t*)(ws + WS_Z); bf16_t* const A2b = (bf16_t*)(ws + WS_A2); \
    bf16_t* const RIb = (bf16_t*)(ws + WS_RI); bf16_t* const YMb = (bf16_t*)(ws + WS_YMIX); bf16_t* const Yb = (bf16_t*)(ws + WS_Y); bf16_t* const ACTb = (bf16_t*)(ws + WS_ACT); \
    bf16_t* const YSb = (bf16_t*)(ws + WS_YS); float* const LOGf = (float*)(ws + WS_LOG); float* const TOPG = (float*)(ws + WS_TOPG); int* const LIST = (int*)(ws + WS_LIST); \
    float* const SUMM = (float*)(ws + WS_SUMM); \
    (void)lane; (void)wave; (void)gw; (void)NGW; (void)ctl; (void)MOD; (void)Hb; (void)Zb; (void)A2b; (void)RIb; (void)YMb; (void)Yb; (void)ACTb; (void)YSb; (void)LOGf; (void)TOPG; (void)LIST; (void)SUMM; (void)Xf; (void)vcu


template <int L, int PASS>
__device__ __forceinline__ void scan_phase(const int lo, const int hi, const int G, const XcdBarrier& bar, const int wave0) {
    constexpr int l = L, pass = PASS, P = PH_L0 + PH_PER_LAYER * L, jj = L >> 1; constexpr bool odd = (L & 1) != 0;
            if (PHEN(6) && !odd && IN(P + 3 + pass)) {
            PH_LOCALS;
                for (int it = gw; it < 16 * 32 * 4; it += NGW) {
                    const int b = it >> 7, n = (it >> 2) & 31, cg = it & 3;
                    const int ch = cg * 128 + 2 * lane;
                    float sp[2];
#pragma unroll
                    for (int q = 0; q < 2; ++q) { const float x = -kin(I_LAM)[jj * 512 + ch + q]; sp[q] = 8.0f * 1.4426950408889634f * (fmaxf(x, 0.f) + log1pf(__expf(-fabsf(x)))); }
                    float one = 1.0f; asm volatile("" : "+v"(one));
                    float h0 = 0.f, h1 = 0.f, p0 = one, p1 = one;
                    if (pass == 1) {
#pragma unroll 1
                        for (int m = 0; m < n; ++m) { const f32x4 s = *(const f32x4*)(SUMM + (((size_t)b * 32 + m) * 512 + ch) * 2); h0 = s[0] * h0 + s[1]; h1 = s[2] * h1 + s[3]; }
                    }
                    const size_t row0 = (size_t)b * SEQ + n * 128;
#pragma unroll 4
                    for (int t = 0; t < 128; ++t) {
                        const size_t r = row0 + t;
                        const unsigned rw = *(const unsigned*)(RIb + r * 1024 + ch), iw = *(const unsigned*)(RIb + r * 1024 + 512 + ch), xw = *(const unsigned*)(A2b + r * 1024 + 512 + ch);
                        const float a0 = __builtin_amdgcn_exp2f(-bflo(rw) * sp[0]), a1 = __builtin_amdgcn_exp2f(-bfhi(rw) * sp[1]);
                        const float m0 = __builtin_amdgcn_sqrtf(fmaxf(__builtin_fmaf(-a0, a0, 1.0f), 0.f)), m1 = __builtin_amdgcn_sqrtf(fmaxf(__builtin_fmaf(-a1, a1, 1.0f), 0.f));
                        h0 = a0 * h0 + m0 * (bflo(iw) * bflo(xw)); h1 = a1 * h1 + m1 * (bfhi(iw) * bfhi(xw));
                        if (pass == 0) { p0 *= a0; p1 *= a1; }
                        else { const unsigned gwd = *(const unsigned*)(Zb + r * DINAB + 1024 + ch);
                            if (FP8_OUTP) *(unsigned short*)((unsigned char*)YMb + r * 1024 + 512 + ch) = (unsigned short)pk4_fp8(h0 * gelu_tanh(bflo(gwd)), h1 * gelu_tanh(bfhi(gwd)), 0.f, 0.f);
                            else *(unsigned*)(YMb + r * 1024 + 512 + ch) = pk2(h0 * gelu_tanh(bflo(gwd)), h1 * gelu_tanh(bfhi(gwd))); }
                    }
                    if (pass == 0) *(f32x4*)(SUMM + (((size_t)b * 32 + n) * 512 + ch) * 2) = (f32x4){p0, h0, p1, h1};
                }
                SEAM(P + 3 + pass);
            }
}

template <int L, int SUB>
__device__ __forceinline__ void ln_phase(const int lo, const int hi, const int G, const XcdBarrier& bar, const int wave0) {
    constexpr int l = L, sub = SUB, P = PH_L0 + PH_PER_LAYER * L; constexpr int ph = SUB == 0 ? P + 6 : P + 11;
    constexpr bool XIN_F32 = (L == 0 && SUB == 0), XOUT_F32 = (L == DEPTH - 1 && SUB == 1);
    if (PHEN(8) && IN(ph)) {
        PH_LOCALS;
        const int rows_per = T / NGW, r0 = gw * rows_per, b = r0 / SEQ;
        constexpr int ls = 2 * l + sub, lsn = ls + 1;
        const float* gp = MOD + ((size_t)ls * 16 + b) * 3072 + 2048;
        const float* lgp = kin(I_LNG) + ls * 1024, * lbp = kin(I_LNB) + ls * 1024;
        constexpr bool has_nextmod = lsn < 2 * DEPTH;
        const float* nsh = MOD + ((size_t)(has_nextmod ? lsn : 0) * 16 + b) * 3072, * nsc = nsh + 1024;
        f32x4 gt[4], lg[4], lb[4], sh[4], sc[4];
#pragma unroll
        for (int j = 0; j < 4; ++j) { const int o = 4 * (64 * j + lane); gt[j] = *(const f32x4*)(gp + o) + 1.0f; lg[j] = *(const f32x4*)(lgp + o); lb[j] = *(const f32x4*)(lbp + o);
            sh[j] = *(const f32x4*)(nsh + o); sc[j] = *(const f32x4*)(nsc + o) + 1.0f; }
        const float* xin32 = kin(I_X);
        bf16_t* const Xb = (bf16_t*)(ws + WS_XB);
        constexpr bool NEXT_INP8 = ((l + 1) & 1) ? (FP8_INP_ODD != 0) : (FP8_INP_EVEN != 0);
        constexpr int RPI = 2;
        for (int r = (r0 - wave * rows_per) + wave * RPI, rend = (r0 - wave * rows_per) + 8 * rows_per; r < rend; r += 8 * RPI) {
            f32x4 xf[XIN_F32 ? RPI : 1][4]; u32x2 xb[XIN_F32 ? 1 : RPI][4]; u32x2 yv[sub == 0 ? RPI : 1][4]; u32x2 ys[sub == 0 ? 1 : RPI][4][4]; f32x4 gk[RPI];
#pragma unroll
            for (int q = 0; q < RPI; ++q) {
                if constexpr (XIN_F32) { const f32x4* xr = (const f32x4*)(xin32 + (size_t)(r + q) * D) + lane;
#pragma unroll
                    for (int j = 0; j < 4; ++j) xf[q][j] = xr[64 * j]; }
                else { const u32x2* xr = (const u32x2*)(Xb + (size_t)(r + q) * D) + lane;
#pragma unroll
                    for (int j = 0; j < 4; ++j) xb[q][j] = xr[64 * j]; }
                if constexpr (sub == 0) { const u32x2* yr = (const u32x2*)(Yb + (size_t)(r + q) * D) + lane;
#pragma unroll
                    for (int j = 0; j < 4; ++j) yv[q][j] = yr[64 * j]; }
                else { gk[q] = *(const f32x4*)(TOPG + (size_t)(r + q) * 4);
#pragma unroll
                    for (int k = 0; k < 4; ++k) {
                        if (FP8_YS) { const unsigned* yr = (const unsigned*)((const unsigned char*)YSb + ((size_t)(r + q) * 4 + k) * D) + lane;
#pragma unroll
                            for (int j = 0; j < 4; ++j) ys[q][k][j].x = yr[64 * j]; }
                        else { const u32x2* yr = (const u32x2*)(YSb + ((size_t)(r + q) * 4 + k) * D) + lane;
#pragma unroll
                            for (int j = 0; j < 4; ++j) ys[q][k][j] = yr[64 * j]; } } }
            }
            f32x4 v[RPI][4]; float s[RPI];
#pragma unroll
            for (int q = 0; q < RPI; ++q) {
                s[q] = 0.f;
#pragma unroll
                for (int j = 0; j < 4; ++j) {
                    f32x4 y, x;
                    if constexpr (XIN_F32) x = xf[q][j]; else x = (f32x4){bflo(xb[q][j].x), bfhi(xb[q][j].x), bflo(xb[q][j].y), bfhi(xb[q][j].y)};
                    if constexpr (sub == 0) y = (f32x4){bflo(yv[q][j].x), bfhi(yv[q][j].x), bflo(yv[q][j].y), bfhi(yv[q][j].y)};
                    else { y = (f32x4){0.f, 0.f, 0.f, 0.f};
#pragma unroll
                        for (int k = 0; k < 4; ++k) { const u32x2 w = ys[q][k][j];
                            if (FP8_YS) { const f32x2 lo2 = __builtin_amdgcn_cvt_pk_f32_fp8((int)w.x, false), hi2 = __builtin_amdgcn_cvt_pk_f32_fp8((int)w.x, true);
                                y = y + (f32x4){lo2.x, lo2.y, hi2.x, hi2.y} * (gk[q][k] * 0.0625f); }
                            else y = y + (f32x4){bflo(w.x), bfhi(w.x), bflo(w.y), bfhi(w.y)} * gk[q][k]; } }
                    v[q][j] = x * DN_ALPHA + gt[j] * y;
                    s[q] += (v[q][j][0] + v[q][j][1]) + (v[q][j][2] + v[q][j][3]);
                }
            }
#pragma unroll
            for (int o = 1; o < 64; o <<= 1) {
#pragma unroll
                for (int q = 0; q < RPI; ++q) s[q] += __builtin_bit_cast(float, __builtin_amdgcn_ds_bpermute((lane ^ o) << 2, __builtin_bit_cast(int, s[q])));
            }
            float s2[RPI];
#pragma unroll
            for (int q = 0; q < RPI; ++q) { const float mean = s[q] * (1.0f / D); s2[q] = 0.f;
#pragma unroll
                for (int j = 0; j < 4; ++j) { v[q][j] = v[q][j] - mean; s2[q] += (v[q][j][0] * v[q][j][0] + v[q][j][1] * v[q][j][1]) + (v[q][j][2] * v[q][j][2] + v[q][j][3] * v[q][j][3]); } }
#pragma unroll
            for (int o = 1; o < 64; o <<= 1) {
#pragma unroll
                for (int q = 0; q < RPI; ++q) s2[q] += __builtin_bit_cast(float, __builtin_amdgcn_ds_bpermute((lane ^ o) << 2, __builtin_bit_cast(int, s2[q])));
            }
#pragma unroll
            for (int q = 0; q < RPI; ++q) {
                const float rstd = 1.0f / sqrtf(s2[q] * (1.0f / D) + LN_EPS);
                u32x2* hr = (u32x2*)(Hb + (size_t)(r + q) * D) + lane;
#pragma unroll
                for (int j = 0; j < 4; ++j) { const f32x4 xn = v[q][j] * rstd * lg[j] + lb[j];
                    if (XOUT_F32) ((f32x4*)(Xf + (size_t)(r + q) * D) + lane)[64 * j] = xn;
                    else { u32x2 w; w.x = pk2(xn[0], xn[1]); w.y = pk2(xn[2], xn[3]); ((u32x2*)(Xb + (size_t)(r + q) * D) + lane)[64 * j] = w; }
                    if (has_nextmod) { const f32x4 h = xn * sc[j] + sh[j];
                        if (!(NEXT_INP8 && sub == 1) && !(ROUTER_X && sub == 0)) { u32x2 w; w.x = pk2(h[0], h[1]); w.y = pk2(h[2], h[3]); hr[64 * j] = w; }
                        if ((FP8_M1 && sub == 0) || (NEXT_INP8 && sub == 1)) ((unsigned*)(ws + WS_H8 + (size_t)(r + q) * D) + lane)[64 * j] = pk4_fp8(h[0], h[1], h[2], h[3]); } }
            }
        }
        if (ph + 1 < NPH) { if (sub == 0) LSEAM(ph); else SEAM(ph); }
    }
}

template <int L>
__device__ __forceinline__ void layer_body(LAS unsigned char* const lds, volatile LAS unsigned* const LCTL, const int lo, const int hi, const int G, const XcdBarrier& bar, const int wave0) {
    constexpr int l = L;
        const int P = PH_L0 + PH_PER_LAYER * l, jj = l >> 1;
        const bool odd = (l & 1) != 0;
        if (PHEN(2) && IN(P + 0)) {
            PH_LOCALS;
            if (!odd) {
                pg8::DenseSched S; S.init(T, 1536, G, bx);
                if (FP8_INP_EVEN) { pg8::Gemm g{ws + WS_H8, ws + WS_ABIN + (size_t)jj * 1536 * 1024, 1024, 1024, 1024, 122};
                    pg8::EpiDense<0, false, false, true> E{Zb, 1536, nullptr, nullptr, 1.0f / 32.0f};
                    pg8::gemm_phase<true>(lds, g, S, E, wave0); }
                else { pg8::Gemm g{Hb, (const bf16_t*)(ws + WS_ABIN) + (size_t)jj * 1536 * 1024, 1024, 1024, 1024, 127};
                    pg8::EpiDense<0, false, false> E{Zb, 1536, nullptr, nullptr, 0.f};
                    pg8::gemm_phase<false>(lds, g, S, E, wave0); }
            } else {
                pg8::DenseSched S; S.init(T, 2048, G, bx);
                if (FP8_INP_ODD) { pg8::Gemm g{ws + WS_H8, ws + WS_SGIN + (size_t)jj * 2048 * 1024, 1024, 1024, 1024, 122};
                    pg8::EpiDense<1, true, false, true> E{Zb, 2048, kin(I_SGBIN) + jj * 2048, nullptr, 1.0f / 32.0f};
                    pg8::gemm_phase<true>(lds, g, S, E, wave0); }
                else { pg8::Gemm g{Hb, (const bf16_t*)(ws + WS_SGIN) + (size_t)jj * 2048 * 1024, 1024, 1024, 1024, 127};
                    pg8::EpiDense<1, true, false> E{Zb, 2048, kin(I_SGBIN) + jj * 2048, nullptr, 0.f};
                    pg8::gemm_phase<false>(lds, g, S, E, wave0); }
            }
            SEAM(P + 0);
        }
        if (PHEN(3) && !odd && IN(P + 1)) {
            PH_LOCALS;
            const int rows_per = T / NGW, r0 = gw * rows_per;
            const int g4 = lane >> 4, w = 2 << g4;
            float cw[4][8], cb[8];
#pragma unroll
            for (int k = 0; k < 4; ++k)
#pragma unroll
                for (int q = 0; q < 8; ++q) cw[k][q] = kin(I_CONVW)[((size_t)jj * 4 + k) * 512 + 8 * lane + q];
#pragma unroll
            for (int q = 0; q < 8; ++q) cb[q] = kin(I_CONVB)[jj * 512 + 8 * lane + q];
            const int ts0 = r0 & (SEQ - 1);
            u32x4 ring[16], cr[3];
            float sw[8];
#pragma unroll
            for (int q = 0; q < 8; ++q) sw[q] = 0.f;
#pragma unroll
            for (int d = 0; d < 16; ++d) {
                const int k = 15 - d;
                u32x4 v = {0u, 0u, 0u, 0u};
                if (ts0 > d) v = *(const u32x4*)(Zb + (size_t)(r0 - 1 - d) * DINAB + 8 * lane);
                ring[k] = v;
                if (d + 1 < w) { const float f[8] = {bflo(v.x), bfhi(v.x), bflo(v.y), bfhi(v.y), bflo(v.z), bfhi(v.z), bflo(v.w), bfhi(v.w)};
#pragma unroll
                    for (int q = 0; q < 8; ++q) sw[q] += f[q]; }
            }
#pragma unroll
            for (int d = 0; d < 3; ++d) { u32x4 v = {0u, 0u, 0u, 0u}; if (ts0 > d) v = *(const u32x4*)(Zb + (size_t)(r0 - 1 - d) * DINAB + 512 + 8 * lane); cr[2 - d] = v; }
#pragma unroll 1
            for (int rb = 0; rb < rows_per; rb += 16) {
#pragma unroll
                for (int i = 0; i < 16; ++i) {
                    const int r = r0 + rb + i, ts = r & (SEQ - 1);
                    const u32x4 vn = *(const u32x4*)(Zb + (size_t)r * DINAB + 8 * lane), cn = *(const u32x4*)(Zb + (size_t)r * DINAB + 512 + 8 * lane);
                    const u32x4 c2 = ring[(i + 15) & 15], c4 = ring[(i + 13) & 15], c8 = ring[(i + 9) & 15], c16 = ring[(i + 1) & 15];
                    u32x4 vo;
                    vo.x = g4 == 0 ? c2.x : g4 == 1 ? c4.x : g4 == 2 ? c8.x : c16.x; vo.y = g4 == 0 ? c2.y : g4 == 1 ? c4.y : g4 == 2 ? c8.y : c16.y;
                    vo.z = g4 == 0 ? c2.z : g4 == 1 ? c4.z : g4 == 2 ? c8.z : c16.z; vo.w = g4 == 0 ? c2.w : g4 == 1 ? c4.w : g4 == 2 ? c8.w : c16.w;
                    ring[i] = vn;
                    const float fn[8] = {bflo(vn.x), bfhi(vn.x), bflo(vn.y), bfhi(vn.y), bflo(vn.z), bfhi(vn.z), bflo(vn.w), bfhi(vn.w)};
                    const float fo[8] = {bflo(vo.x), bfhi(vo.x), bflo(vo.y), bfhi(vo.y), bflo(vo.z), bfhi(vo.z), bflo(vo.w), bfhi(vo.w)};
                    const int cntw = (ts + 1) < w ? (ts + 1) : w;
                    const float inv = __builtin_amdgcn_rcpf((float)cntw);
                    float pz[8];
#pragma unroll
                    for (int q = 0; q < 8; ++q) { sw[q] += fn[q]; pz[q] = sw[q] * inv - fn[q]; sw[q] -= fo[q]; }
                    u32x4 o; o.x = pk2(pz[0], pz[1]); o.y = pk2(pz[2], pz[3]); o.z = pk2(pz[4], pz[5]); o.w = pk2(pz[6], pz[7]);
                    *(u32x4*)(A2b + (size_t)r * 1024 + 8 * lane) = o;
                    float xc[8];
                    const u32x4 t0 = cr[0], t1 = cr[1], t2 = cr[2];
                    const float f0[8] = {bflo(t0.x), bfhi(t0.x), bflo(t0.y), bfhi(t0.y), bflo(t0.z), bfhi(t0.z), bflo(t0.w), bfhi(t0.w)};
                    const float f1[8] = {bflo(t1.x), bfhi(t1.x), bflo(t1.y), bfhi(t1.y), bflo(t1.z), bfhi(t1.z), bflo(t1.w), bfhi(t1.w)};
                    const float f2[8] = {bflo(t2.x), bfhi(t2.x), bflo(t2.y), bfhi(t2.y), bflo(t2.z), bfhi(t2.z), bflo(t2.w), bfhi(t2.w)};
                    const float f3[8] = {bflo(cn.x), bfhi(cn.x), bflo(cn.y), bfhi(cn.y), bflo(cn.z), bfhi(cn.z), bflo(cn.w), bfhi(cn.w)};
#pragma unroll
                    for (int q = 0; q < 8; ++q) xc[q] = cb[q] + f0[q] * cw[0][q] + f1[q] * cw[1][q] + f2[q] * cw[2][q] + f3[q] * cw[3][q];
                    cr[0] = t1; cr[1] = t2; cr[2] = cn;
                    u32x4 o2; o2.x = pk2(xc[0], xc[1]); o2.y = pk2(xc[2], xc[3]); o2.z = pk2(xc[4], xc[5]); o2.w = pk2(xc[6], xc[7]);
                    *(u32x4*)(A2b + (size_t)r * 1024 + 512 + 8 * lane) = o2;
                }
            }
            LSEAM(P + 1);
        }
        if (PHEN(4) && odd && IN(P + 1)) {
            PH_LOCALS;
            LAS float* STAT = (LAS float*)lds;
            LAS unsigned char* WSS = lds + 1024;
            LAS unsigned char* VT = lds + 1024 + 34816;
            const float* lng = kin(I_SGLNG) + jj * 1024, * lnb = kin(I_SGLNB) + jj * 1024;
            const bf16_t* WSMp = (const bf16_t*)(ws + WS_WSM) + (size_t)jj * 8 * 128 * 128;
            const float* bs = kin(I_SGBS) + jj * 8 * 128;
            const int fr = lane & 15, fq = lane >> 4;
            for (int it = vcu; it < T / 128; it += G) {
                const size_t row0 = (size_t)it * 128;
#pragma unroll 1
                for (int rb = 0; rb < 2; ++rb) {
                    u32x4 a8[8], b8[8];
#pragma unroll
                    for (int q = 0; q < 8; ++q) { const bf16_t* vp = Zb + (row0 + wave * 16 + rb * 8 + q) * 2048 + 1024; a8[q] = *(const u32x4*)(vp + 8 * lane); b8[q] = *(const u32x4*)(vp + 512 + 8 * lane); }
                    float sm[8], sq[8];
#pragma unroll
                    for (int q = 0; q < 8; ++q) {
                        const float f[16] = {bflo(a8[q].x), bfhi(a8[q].x), bflo(a8[q].y), bfhi(a8[q].y), bflo(a8[q].z), bfhi(a8[q].z), bflo(a8[q].w), bfhi(a8[q].w),
                                             bflo(b8[q].x), bfhi(b8[q].x), bflo(b8[q].y), bfhi(b8[q].y), bflo(b8[q].z), bfhi(b8[q].z), bflo(b8[q].w), bfhi(b8[q].w)};
                        float s1 = 0.f, s2 = 0.f;
#pragma unroll
                        for (int e = 0; e < 16; ++e) { s1 += f[e]; s2 += f[e] * f[e]; }
                        sm[q] = s1; sq[q] = s2;
                    }
#pragma unroll
                    for (int o = 1; o < 64; o <<= 1) {
#pragma unroll
                        for (int q = 0; q < 8; ++q) { sm[q] += __builtin_bit_cast(float, __builtin_amdgcn_ds_bpermute((lane ^ o) << 2, __builtin_bit_cast(int, sm[q])));
                            sq[q] += __builtin_bit_cast(float, __builtin_amdgcn_ds_bpermute((lane ^ o) << 2, __builtin_bit_cast(int, sq[q]))); }
                    }
                    if (lane < 8) { float m_ = sm[0], q_ = sq[0];
#pragma unroll
                        for (int q = 1; q < 8; ++q) { m_ = lane == q ? sm[q] : m_; q_ = lane == q ? sq[q] : q_; }
                        const float mean = m_ * (1.0f / 1024.0f), var = fmaxf(q_ * (1.0f / 1024.0f) - mean * mean, 0.f);
                        const int r = wave * 16 + rb * 8 + lane; STAT[2 * r] = mean; STAT[2 * r + 1] = 1.0f / sqrtf(var + LN_EPS); }
                }
                __syncthreads();
                u32x4 wv[4], vv[4];
#pragma unroll
                for (int i = 0; i < 4; ++i) { const int q = tid + 512 * i, row = q >> 4, c16 = q & 15;
                    wv[i] = *(const u32x4*)(WSMp + ((size_t)0 * 128 + row) * 128 + c16 * 8);
                    vv[i] = *(const u32x4*)(Zb + (row0 + row) * 2048 + 1024 + 0 * 128 + c16 * 8); }
#pragma unroll 1
                for (int hd = 0; hd < 8; ++hd) {
#pragma unroll
                    for (int i = 0; i < 4; ++i) {
                        const int q = tid + 512 * i, row = q >> 4, c16 = q & 15;
                        *(LAS u32x4*)(WSS + row * 272 + c16 * 16) = wv[i];
                        const u32x4 v4 = vv[i];
                        const float mean = STAT[2 * row], rstd = STAT[2 * row + 1];
                        const float f[8] = {bflo(v4.x), bfhi(v4.x), bflo(v4.y), bfhi(v4.y), bflo(v4.z), bfhi(v4.z), bflo(v4.w), bfhi(v4.w)};
                        const f32x4 g0 = *(const f32x4*)(lng + hd * 128 + c16 * 8), g1 = *(const f32x4*)(lng + hd * 128 + c16 * 8 + 4);
                        const f32x4 b0 = *(const f32x4*)(lnb + hd * 128 + c16 * 8), b1 = *(const f32x4*)(lnb + hd * 128 + c16 * 8 + 4);
                        const float gg[8] = {g0[0], g0[1], g0[2], g0[3], g1[0], g1[1], g1[2], g1[3]}, bb[8] = {b0[0], b0[1], b0[2], b0[3], b1[0], b1[1], b1[2], b1[3]};
#pragma unroll
                        for (int q2 = 0; q2 < 8; ++q2) {
                            const int c = c16 * 8 + q2;
                            const int rho = (c & ~31) | (((c >> 2) & 1) << 4) | (((c >> 3) & 3) << 2) | (c & 3);
                            *(LAS bf16_t*)(VT + rho * 272 + row * 2) = (bf16_t)f2bf((f[q2] - mean) * rstd * gg[q2] + bb[q2]);
                        }
                    }
                    const int hn = hd < 7 ? hd + 1 : 7;
#pragma unroll
                    for (int i = 0; i < 4; ++i) { const int q = tid + 512 * i, row = q >> 4, c16 = q & 15;
                        wv[i] = *(const u32x4*)(WSMp + ((size_t)hn * 128 + row) * 128 + c16 * 8);
                        vv[i] = *(const u32x4*)(Zb + (row0 + row) * 2048 + 1024 + hn * 128 + c16 * 8); }
                    const int t = 16 * wave + fr; const float bst = bs[hd * 128 + t];
                    const size_t rowg = row0 + t;
                    u32x4 uv[4];
#pragma unroll
                    for (int q = 0; q < 4; ++q) uv[q] = *(const u32x4*)(Zb + rowg * 2048 + hd * 128 + 32 * q + 8 * fq);
                    __syncthreads();
                    bf16x8 afr[4];
#pragma unroll
                    for (int ks = 0; ks < 4; ++ks) afr[ks] = *(const LAS bf16x8*)(WSS + (16 * wave + fr) * 272 + (32 * ks + 8 * fq) * 2);
                    f32x4 acc[8];
#pragma unroll
                    for (int tn = 0; tn < 8; ++tn) { acc[tn] = (f32x4){0.f, 0.f, 0.f, 0.f};
#pragma unroll
                        for (int ks = 0; ks < 4; ++ks) { const bf16x8 vfr = *(const LAS bf16x8*)(VT + (16 * tn + fr) * 272 + (32 * ks + 8 * fq) * 2);
                            acc[tn] = __builtin_amdgcn_mfma_f32_16x16x32_bf16(vfr, afr[ks], acc[tn], 0, 0, 0); } }
#pragma unroll
                    for (int q = 0; q < 4; ++q) {
                        const int c0 = hd * 128 + 32 * q + 8 * fq;
                        const u32x4 u4 = uv[q];
                        const f32x4 s0 = acc[2 * q] + bst, s1 = acc[2 * q + 1] + bst;
                        if (FP8_OUTP) { u32x2 o; o.x = pk4_fp8(bflo(u4.x) * s0[0], bfhi(u4.x) * s0[1], bflo(u4.y) * s0[2], bfhi(u4.y) * s0[3]);
                            o.y = pk4_fp8(bflo(u4.z) * s1[0], bfhi(u4.z) * s1[1], bflo(u4.w) * s1[2], bfhi(u4.w) * s1[3]);
                            *(u32x2*)((unsigned char*)YMb + rowg * 1024 + c0) = o; }
                        else { u32x4 o; o.x = pk2(bflo(u4.x) * s0[0], bfhi(u4.x) * s0[1]); o.y = pk2(bflo(u4.y) * s0[2], bfhi(u4.y) * s0[3]);
                        o.z = pk2(bflo(u4.z) * s1[0], bfhi(u4.z) * s1[1]); o.w = pk2(bflo(u4.w) * s1[2], bfhi(u4.w) * s1[3]);
                        *(u32x4*)(YMb + rowg * 1024 + c0) = o; }
                    }
                    __syncthreads();
                }
            }
            SEAM(P + 1);
        }
        if (PHEN(5) && !odd && IN(P + 2)) {
            PH_LOCALS;
            {
                pg8::Gemm g{A2b, (const bf16_t*)(ws + WS_BPOOL) + (size_t)jj * 512 * 512, 1024, 512, 256, 127};
                pg8::DenseSched S; S.init(T, 512, G, bx); S.kblk = 512; S.rowm = (FUSE_LOCAL && G == 256) ? 1 : 0;
                pg8::EpiDense<0, false, true, false, FP8_OUTP != 0> E{YMb, 1024, nullptr, kin(I_POOLS) + jj * 512, 0.f};
                pg8::gemm_phase<false>(lds, g, S, E, wave0);
            }
            {
                pg8::Gemm g{A2b + 512, (const bf16_t*)(ws + WS_BGATE) + (size_t)jj * 1024 * 512, 1024, 512, 256, 127};
                pg8::DenseSched S; S.init(T, 1024, G, bx); S.kblk = 512; S.rowm = (FUSE_LOCAL && G == 256) ? 1 : 0;
                pg8::EpiDense<2, true, false> E{RIb, 1024, (const float*)(ws + WS_BIASRI) + jj * 1024, nullptr, 0.f};
                pg8::gemm_phase<false>(lds, g, S, E, wave0);
            }
            SEAM(P + 2);
        }
        scan_phase<L, 0>(lo, hi, G, bar, wave0); scan_phase<L, 1>(lo, hi, G, bar, wave0);
        if (PHEN(7) && IN(P + 5)) {
            PH_LOCALS;
            const float* bo = odd ? kin(I_SGBOUT) + jj * 1024 : kin(I_ABBOUT) + jj * 1024;
            pg8::DenseSched S; S.init(T, 1024, G, bx);
            if (FP8_OUTP) { const unsigned char* wt = odd ? ws + WS_SGOUT + (size_t)jj * 1024 * 1024 : ws + WS_ABOUT + (size_t)jj * 1024 * 1024;
                pg8::Gemm g{YMb, wt, 1024, 1024, 1024, 121};
                pg8::EpiDense<0, true, false, true> E{Yb, 1024, bo, nullptr, 1.0f / 64.0f};
                pg8::gemm_phase<true>(lds, g, S, E, wave0); }
            else { const bf16_t* wt = odd ? (const bf16_t*)(ws + WS_SGOUT) + (size_t)jj * 1024 * 1024 : (const bf16_t*)(ws + WS_ABOUT) + (size_t)jj * 1024 * 1024;
                pg8::Gemm g{YMb, wt, 1024, 1024, 1024, 127};
                pg8::EpiDense<0, true, false> E{Yb, 1024, bo, nullptr, 0.f};
                pg8::gemm_phase<false>(lds, g, S, E, wave0); }
            SEAM(P + 5);
        }
        ln_phase<L, 0>(lo, hi, G, bar, wave0);
            if (PHEN(9) && IN(P + 7)) {
            PH_LOCALS;
                pg8::Gemm g{ROUTER_X ? (const bf16_t*)(ws + WS_XB) : Hb, ROUTER_X ? (const bf16_t*)(ws + WS_BRB) + (size_t)l * 16 * 64 * 1024 : (const bf16_t*)(ws + WS_BR) + (size_t)l * 256 * 1024, 1024, 1024, 1024, 127};
                pg8::DenseSched S; S.init(T, 256, G, bx); if (ROUTER_X) S.bb = 64;
                pg8::EpiRouter E{LOGf};
                pg8::gemm_phase<false>(lds, g, S, E, wave0);
                LSEAM(P + 7);
            }
            if (PHEN(10) && IN(P + 8)) {
            PH_LOCALS;
                volatile LAS unsigned* hist = LCTL + 96; volatile LAS unsigned* basev = LCTL + 128;
                unsigned* gcnt = ctl + CW_CNT + 64 * l;
                const int TPB = (FUSE_LOCAL && G == 256) ? 256 : 512;
                for (int t0 = vcu * TPB; t0 < T; t0 += G * TPB) {
                    if (tid < 32) hist[tid] = 0u;
                    __syncthreads();
                    const bool act = tid < TPB;
                    const int tok = t0 + (act ? tid : 0);
                    float lv[32];
                    { const f32x4* lp = (const f32x4*)(LOGf + (size_t)tok * 64);
#pragma unroll
                      for (int q = 0; q < 8; ++q) { const f32x4 a = lp[q], b2 = lp[8 + q], rb = ROUTER_X ? *(const f32x4*)((const float*)(ws + WS_CB) + (l * 16 + (t0 >> 12)) * 32 + 4 * q) : *(const f32x4*)(kin(I_RB) + l * 32 + 4 * q);
                          lv[4 * q + 0] = a[0] + b2[0] + rb[0]; lv[4 * q + 1] = a[1] + b2[1] + rb[1]; lv[4 * q + 2] = a[2] + b2[2] + rb[2]; lv[4 * q + 3] = a[3] + b2[3] + rb[3]; } }
                    float v0 = -3.0e38f, v1 = -3.0e38f, v2 = -3.0e38f, v3 = -3.0e38f; int i0 = 0, i1 = 0, i2 = 0, i3 = 0;
#pragma unroll
                    for (int e = 0; e < 32; ++e) {
                        const float x = lv[e];
                        if (x > v3) {
                            if (x > v0) { v3 = v2; i3 = i2; v2 = v1; i2 = i1; v1 = v0; i1 = i0; v0 = x; i0 = e; }
                            else if (x > v1) { v3 = v2; i3 = i2; v2 = v1; i2 = i1; v1 = x; i1 = e; }
                            else if (x > v2) { v3 = v2; i3 = i2; v2 = x; i2 = e; }
                            else { v3 = x; i3 = e; }
                        }
                    }
                    const float e1 = __expf(v1 - v0), e2 = __expf(v2 - v0), e3 = __expf(v3 - v0), inv = 1.0f / (1.0f + e1 + e2 + e3);
                    if (act) *(f32x4*)(TOPG + (size_t)tok * 4) = (f32x4){inv, e1 * inv, e2 * inv, e3 * inv};
                    LAS unsigned* hp = (LAS unsigned*)hist;
                    unsigned r0 = 0u, r1 = 0u, r2 = 0u, r3 = 0u;
                    if (act) { r0 = __hip_atomic_fetch_add(hp + i0, 1u, __ATOMIC_RELAXED, __HIP_MEMORY_SCOPE_WORKGROUP); r1 = __hip_atomic_fetch_add(hp + i1, 1u, __ATOMIC_RELAXED, __HIP_MEMORY_SCOPE_WORKGROUP);
                        r2 = __hip_atomic_fetch_add(hp + i2, 1u, __ATOMIC_RELAXED, __HIP_MEMORY_SCOPE_WORKGROUP); r3 = __hip_atomic_fetch_add(hp + i3, 1u, __ATOMIC_RELAXED, __HIP_MEMORY_SCOPE_WORKGROUP); }
                    __syncthreads();
                    if (tid < 32) basev[tid] = __hip_atomic_fetch_add(gcnt + tid, hist[tid], __ATOMIC_RELAXED, __HIP_MEMORY_SCOPE_AGENT);
                    __syncthreads();
                    if (act) {
                    LIST[(size_t)i0 * TKTOT + basev[i0] + r0] = tok * 4 + 0;
                    LIST[(size_t)i1 * TKTOT + basev[i1] + r1] = tok * 4 + 1;
                    LIST[(size_t)i2 * TKTOT + basev[i2] + r2] = tok * 4 + 2;
                    LIST[(size_t)i3 * TKTOT + basev[i3] + r3] = tok * 4 + 3; }
                    __syncthreads();
                }
                SEAM(P + 8);
            }
            if (PHEN(11) && IN(P + 9)) {
                PH_LOCALS;
                volatile LAS int* cnts = (volatile LAS int*)(LCTL + 16); volatile LAS int* tstart = (volatile LAS int*)(LCTL + 48);
                if (tid < 32) cnts[tid] = (int)__hip_atomic_load(ctl + CW_CNT + 64 * l + tid, __ATOMIC_RELAXED, __HIP_MEMORY_SCOPE_AGENT);
                __syncthreads();
                if (tid == 0) { int s = 0; for (int e = 0; e < 32; ++e) { tstart[e] = s; s += (cnts[e] + 255) >> 8; } tstart[32] = s; }
                __syncthreads();
                LAS int* const utab = (LAS int*)(lds + UTAB_OFF);
                const int nunits = pg8::moe_build_units(utab, tstart, cnts, 8, G, MOE_PN_FAST ? vcu : bx, tid);
                __syncthreads();
                pg8::MoeSched S{(const LAS int*)utab, LIST, (const float*)(ws + WS_B1P) + (size_t)l * 32 * 2048, nunits, 2048, 2};
                pg8::EpiMoe1<FP8_M2 != 0> E{FP8_M2 ? (bf16_t*)(ws + WS_ACT8) : ACTb, lds, FP8_M1 ? 1.0f / 32.0f : 1.0f};
                if (FP8_M1) { pg8::Gemm g{ws + WS_H8, ws + WS_W1T8 + (size_t)l * 32 * 2048 * 1024, 1024, 1024, 1024, 122};
                    pg8::gemm_phase<true>(lds, g, S, E, wave0); }
                else { pg8::Gemm g{Hb, (const bf16_t*)(ws + WS_W1T) + (size_t)l * 32 * 2048 * 1024, 1024, 1024, 1024, 127};
                    pg8::gemm_phase<false>(lds, g, S, E, wave0); }
                SEAM(P + 9);
            }
            if (PHEN(12) && IN(P + 10)) {
                PH_LOCALS;
                volatile LAS int* cnts = (volatile LAS int*)(LCTL + 16); volatile LAS int* tstart = (volatile LAS int*)(LCTL + 48);
                __syncthreads();
                if (tid < 32) cnts[tid] = (int)__hip_atomic_load(ctl + CW_CNT + 64 * l + tid, __ATOMIC_RELAXED, __HIP_MEMORY_SCOPE_AGENT);
                __syncthreads();
                if (tid == 0) { int s = 0; for (int e = 0; e < 32; ++e) { tstart[e] = s; s += (cnts[e] + 255) >> 8; } tstart[32] = s; }
                __syncthreads();
                LAS int* const utab = (LAS int*)(lds + UTAB_OFF);
                const int nunits = pg8::moe_build_units(utab, tstart, cnts, 4, G, MOE_PN_FAST ? vcu : bx, tid);
                __syncthreads();
                pg8::MoeSched S{(const LAS int*)utab, LIST, kin(I_B2) + (size_t)l * 32 * 1024, nunits, 1024, 0};
                pg8::EpiMoe2 E{YSb, lds, FP8_M2 ? 1.0f / 64.0f : 1.0f};
                if (FP8_M2) { pg8::Gemm g{ws + WS_ACT8, ws + WS_W2T8 + (size_t)l * 32 * 1024 * 1024, 1024, 1024, 1024, 121};
                    pg8::gemm_phase<true>(lds, g, S, E, wave0); }
                else { pg8::Gemm g{ACTb, (const bf16_t*)(ws + WS_W2T) + (size_t)l * 32 * 1024 * 1024, 1024, 1024, 1024, 127};
                    pg8::gemm_phase<false>(lds, g, S, E, wave0); }
                SEAM(P + 10);
            }
        ln_phase<L, 1>(lo, hi, G, bar, wave0);
}

__global__ void __launch_bounds__(512, 2) fwd_kernel(Args args) {
    extern __shared__ __attribute__((aligned(16))) unsigned char lds_raw[];
    LAS unsigned char* const lds = (LAS unsigned char*)lds_raw;
    volatile LAS unsigned* const LCTL = (volatile LAS unsigned*)(lds + LDSCTL_OFF);
    const int G = gridDim.x;
    int lo, hi; unsigned* ctl0;
    { kptr_t kp = (kptr_t)__builtin_amdgcn_kernarg_segment_ptr(); lo = *(const __attribute__((address_space(4))) int*)(kp + 272); hi = *(const __attribute__((address_space(4))) int*)(kp + 276);
      ctl0 = (unsigned*)(*(unsigned char* const __attribute__((address_space(4)))*)(kp + 264) + WS_CTL); }
    const int wave0 = __builtin_amdgcn_readfirstlane((int)threadIdx.x >> 6);
    for (int u = threadIdx.x; u < (LDS_BYTES - LDSCTL_OFF) / 4; u += 512) LCTL[u] = 0u;
    __syncthreads();
    XcdBarrier bar; bar.bar = ctl0 + CW_BAR; bar.x = 0; bar.st = LCTL; bar.wv = wave0;
    if (hi - lo > 1) bar = xcd_barrier_post(ctl0 + CW_BAR, LCTL, wave0);
    if (PHEN(0) && IN(PH_CONV)) {
            PH_LOCALS;
        {
            LAS float* cact = (LAS float*)lds;
            LAS float* part = (LAS float*)(lds + 65536);
            if (bx < 384) {
                for (int i = tid; i < 16 * 1024; i += 512) { const float c = kin(I_C)[i]; cact[i] = c / (1.0f + __expf(-c)); }
                __syncthreads();
                for (int it = bx; it < 384; it += G) {
                    const int ls = it / 48, col0 = (it % 48) * 64;
                    const int kq = tid >> 6, cl = tid & 63;
                    const float* wp = kin(I_MODW) + (size_t)ls * 1024 * 3072 + col0 + cl;
                    float a[16];
#pragma unroll
                    for (int b = 0; b < 16; ++b) a[b] = 0.f;
#pragma unroll 4
                    for (int k = kq * 128; k < kq * 128 + 128; ++k) {
                        const float w = wp[(size_t)k * 3072];
#pragma unroll
                        for (int b = 0; b < 16; ++b) a[b] += cact[b * 1024 + k] * w;
                    }
#pragma unroll
                    for (int b = 0; b < 16; ++b) part[(kq * 16 + b) * 64 + cl] = a[b];
                    __syncthreads();
                    for (int o = tid; o < 1024; o += 512) {
                        const int b = o >> 6, c2 = o & 63; float s = 0.f;
#pragma unroll
                        for (int q = 0; q < 8; ++q) s += part[(q * 16 + b) * 64 + c2];
                        MOD[((size_t)ls * 16 + b) * 3072 + col0 + c2] = s + kin(I_MODB)[ls * 3072 + col0 + c2];
                    }
                    __syncthreads();
                }
            }
        }
        {
            constexpr int IT_ABIN = 2 * (FP8_INP_EVEN ? 8 : 16) * 48, IT_ABOUT = 2 * (FP8_OUTP ? 8 : 16) * 32, IT_SGIN = 2 * (FP8_INP_ODD ? 8 : 16) * 64, IT_SGOUT = 2 * (FP8_OUTP ? 8 : 16) * 32, IT_W1 = 128 * (FP8_M1 ? 8 : 16) * 64, IT_W2 = 128 * (FP8_M2 ? 8 : 16) * 32;
            constexpr int IT_ALL = IT_ABIN + IT_ABOUT + IT_SGIN + IT_SGOUT + IT_W1 + IT_W2;
            for (int it = gw; it < IT_ALL; it += NGW) {
                int r = it;
                if (r < IT_ABIN) { if (FP8_INP_EVEN) { const int mat = r / (8 * 48); conv_item_f8<false>(kin(I_ABWIN) + (size_t)mat * 1024 * 1536, 1536, ws + WS_ABIN + (size_t)mat * 1536 * 1024, r % (8 * 48), lane, 32.0f); }
                    else { const int mat = r / (16 * 48); conv_item<false>(kin(I_ABWIN) + (size_t)mat * 1024 * 1536, 1536, (bf16_t*)(ws + WS_ABIN) + (size_t)mat * 1536 * 1024, r % (16 * 48), lane); } continue; } r -= IT_ABIN;
                if (r < IT_ABOUT) { if (FP8_OUTP) { const int mat = r / (8 * 32); conv_item_f8<false>(kin(I_ABWOUT) + (size_t)mat * 1024 * 1024, 1024, ws + WS_ABOUT + (size_t)mat * 1024 * 1024, r % (8 * 32), lane, 64.0f); }
                    else { const int mat = r / (16 * 32); conv_item<false>(kin(I_ABWOUT) + (size_t)mat * 1024 * 1024, 1024, (bf16_t*)(ws + WS_ABOUT) + (size_t)mat * 1024 * 1024, r % (16 * 32), lane); } continue; } r -= IT_ABOUT;
                if (r < IT_SGIN) { if (FP8_INP_ODD) { const int mat = r / (8 * 64); conv_item_f8<false>(kin(I_SGWIN) + (size_t)mat * 1024 * 2048, 2048, ws + WS_SGIN + (size_t)mat * 2048 * 1024, r % (8 * 64), lane, 32.0f); }
                    else { const int mat = r / (16 * 64); conv_item<false>(kin(I_SGWIN) + (size_t)mat * 1024 * 2048, 2048, (bf16_t*)(ws + WS_SGIN) + (size_t)mat * 2048 * 1024, r % (16 * 64), lane); } continue; } r -= IT_SGIN;
                if (r < IT_SGOUT) { if (FP8_OUTP) { const int mat = r / (8 * 32); conv_item_f8<false>(kin(I_SGWOUT) + (size_t)mat * 1024 * 1024, 1024, ws + WS_SGOUT + (size_t)mat * 1024 * 1024, r % (8 * 32), lane, 64.0f); }
                    else { const int mat = r / (16 * 32); conv_item<false>(kin(I_SGWOUT) + (size_t)mat * 1024 * 1024, 1024, (bf16_t*)(ws + WS_SGOUT) + (size_t)mat * 1024 * 1024, r % (16 * 32), lane); } continue; } r -= IT_SGOUT;
                if (r < IT_W1) {
                    if (FP8_M1) { const int mat = r / (8 * 64); conv_item_f8<true>(kin(I_W1) + (size_t)mat * 1024 * 2048, 2048, ws + WS_W1T8 + (size_t)mat * 2048 * 1024, r % (8 * 64), lane, 32.0f); }
                    else { const int mat = r / (16 * 64); conv_item<true>(kin(I_W1) + (size_t)mat * 1024 * 2048, 2048, (bf16_t*)(ws + WS_W1T) + (size_t)mat * 2048 * 1024, r % (16 * 64), lane); }
                    continue; } r -= IT_W1;
                if (FP8_M2) { const int mat = r / (8 * 32); conv_item_f8<false>(kin(I_W2) + (size_t)mat * 1024 * 1024, 1024, ws + WS_W2T8 + (size_t)mat * 1024 * 1024, r % (8 * 32), lane, 64.0f); }
                else { const int mat = r / (16 * 32); conv_item<false>(kin(I_W2) + (size_t)mat * 1024 * 1024, 1024, (bf16_t*)(ws + WS_W2T) + (size_t)mat * 1024 * 1024, r % (16 * 32), lane); }
            }
        }
        {
            const int gt = vcu * 512 + tid, NGT = G * 512;
            bf16_t* BR = (bf16_t*)(ws + WS_BR);
            if (!ROUTER_X) for (int i = gt; i < 4 * 256 * 1024; i += NGT) {
                const int l = i >> 18, n = (i >> 10) & 255, k = i & 1023; unsigned v = 0;
                if (n < 64) { const float w = kin(I_RW)[((size_t)l * 1024 + k) * 32 + (n & 31)]; const unsigned h = f2bf(w); v = h;
                    if (n >= 32) v = f2bf(w - __builtin_bit_cast(float, h << 16)); }
                BR[i] = (bf16_t)v;
            }
            bf16_t* BP = (bf16_t*)(ws + WS_BPOOL);
            for (int i = gt; i < 2 * 512 * 512; i += NGT) {
                const int j = i >> 18, n = (i >> 9) & 511, k = i & 511; unsigned v = 0;
                if ((n >> 7) == (k >> 7)) v = f2bf(kin(I_POOLW)[(((size_t)j * 4 + (n >> 7)) * 128 + (k & 127)) * 128 + (n & 127)]);
                BP[i] = (bf16_t)v;
            }
            bf16_t* BG = (bf16_t*)(ws + WS_BGATE);
            for (int i = gt; i < 2 * 1024 * 512; i += NGT) {
                const int j = i >> 19, n = (i >> 9) & 1023, k = i & 511; unsigned v = 0; const int nn = n & 511;
                if ((nn >> 6) == (k >> 6)) { const float* w = (n < 512) ? kin(I_WA) : kin(I_WX); v = f2bf(w[(((size_t)j * 8 + (nn >> 6)) * 64 + (k & 63)) * 64 + (nn & 63)]); }
                BG[i] = (bf16_t)v;
            }
            bf16_t* WSMp = (bf16_t*)(ws + WS_WSM);
            for (int i = gt; i < 2 * 8 * 128 * 128; i += NGT) {
                const int t = (i >> 7) & 127, s = i & 127; WSMp[i] = (bf16_t)((s <= t) ? f2bf(kin(I_SGWS)[i]) : 0u);
            }
            float* BRI = (float*)(ws + WS_BIASRI);
            for (int i = gt; i < 2 * 1024; i += NGT) { const int j = i >> 10, n = i & 1023; BRI[i] = (n < 512) ? kin(I_BA)[j * 512 + n] : kin(I_BX)[j * 512 + n - 512]; }
            float* B1P = (float*)(ws + WS_B1P);
            for (int i = gt; i < 4 * 32 * 2048; i += NGT) { const int le = i >> 11, rho = i & 2047; B1P[i] = kin(I_B1)[(size_t)le * 2048 + w1_n_of_rho(rho)]; }
        }
        SEAM(PH_CONV);
    }

    if (PHEN(1) && IN(PH_H0)) {
            PH_LOCALS;
        const int rows_per = T / NGW, r0 = gw * rows_per;
        const int b = r0 / SEQ;
        const float* shp = MOD + ((size_t)0 * 16 + b) * 3072, * scp = shp + 1024;
        f32x4 sh[4], sc[4];
#pragma unroll
        for (int j = 0; j < 4; ++j) { sh[j] = *(const f32x4*)(shp + 4 * (64 * j + lane)); sc[j] = *(const f32x4*)(scp + 4 * (64 * j + lane)); }
        for (int r = r0; r < r0 + rows_per; ++r) {
            const f32x4* xr = (const f32x4*)(kin(I_X) + (size_t)r * D) + lane;
            u32x2* hr = (u32x2*)(Hb + (size_t)r * D) + lane;
#pragma unroll
            for (int j = 0; j < 4; ++j) { const f32x4 v = xr[64 * j]; const f32x4 h = v * (sc[j] + 1.0f) + sh[j];
                if (FP8_INP_EVEN) ((unsigned*)(ws + WS_H8 + (size_t)r * D) + lane)[64 * j] = pk4_fp8(h[0], h[1], h[2], h[3]);
                else { u32x2 w; w.x = pk2(h[0], h[1]); w.y = pk2(h[2], h[3]); hr[64 * j] = w; } }
        }
        if (ROUTER_X) {
            bf16_t* BRB = (bf16_t*)(ws + WS_BRB);
            const float* rwp = kin(I_RW);
            for (int i = vcu * 512 + tid; i < 4 * 32 * 1024; i += G * 512) {
                const int l = i >> 15, e = (i >> 10) & 31, k = i & 1023;
                const float w = rwp[((size_t)l * 1024 + k) * 32 + e];
#pragma unroll 4
                for (int bq = 0; bq < 16; ++bq) {
                    const float wm = w * (1.0f + MOD[((size_t)(2 * l + 1) * 16 + bq) * 3072 + 1024 + k]);
                    const unsigned h = f2bf(wm), lo2 = f2bf(wm - __builtin_bit_cast(float, h << 16));
                    bf16_t* o = BRB + (((size_t)l * 16 + bq) * 64 + e) * 1024 + k; o[0] = (bf16_t)h; o[32 * 1024] = (bf16_t)lo2; }
            }
            for (int i = vcu * 512 + tid; i < 192 * 1024 / 2; i += G * 512) ((unsigned*)(BRB + (size_t)4 * 16 * 64 * 1024))[i] = 0u;
            const int it = vcu + G * wave;
            if (it < 512) {
                const int l = it >> 7, bq = (it >> 3) & 15, eq = it & 7;
                const float* shq = MOD + ((size_t)(2 * l + 1) * 16 + bq) * 3072;
                const f32x4* rw4 = (const f32x4*)(kin(I_RW) + (size_t)l * 1024 * 32) + eq;
                float sa[4] = {0.f, 0.f, 0.f, 0.f};
#pragma unroll
                for (int i2 = 0; i2 < 16; ++i2) { const int k = lane + 64 * i2; const f32x4 wv4 = rw4[(size_t)k * 8]; const float sk = shq[k]; sa[0] += wv4[0] * sk; sa[1] += wv4[1] * sk; sa[2] += wv4[2] * sk; sa[3] += wv4[3] * sk; }
#pragma unroll
                for (int o = 1; o < 64; o <<= 1) {
#pragma unroll
                    for (int c4 = 0; c4 < 4; ++c4) sa[c4] += __builtin_bit_cast(float, __builtin_amdgcn_ds_bpermute((lane ^ o) << 2, __builtin_bit_cast(int, sa[c4])));
                }
                const f32x4 rb4 = *(const f32x4*)(kin(I_RB) + l * 32 + 4 * eq);
                *(f32x4*)((float*)(ws + WS_CB) + (l * 16 + bq) * 32 + 4 * eq) = (f32x4){sa[0] + rb4[0], sa[1] + rb4[1], sa[2] + rb4[2], sa[3] + rb4[3]};
            }
        }
        SEAM(PH_H0);
    }

    layer_body<0>(lds, LCTL, lo, hi, G, bar, wave0); layer_body<1>(lds, LCTL, lo, hi, G, bar, wave0); layer_body<2>(lds, LCTL, lo, hi, G, bar, wave0); layer_body<3>(lds, LCTL, lo, hi, G, bar, wave0);
}
#undef IN
#undef SEAM

#ifdef DUMP_SPEC
struct DumpSrc { size_t off; int ld; int col0; };
__global__ void dump_kernel(const unsigned char* ws, float* out) {
    const DumpSrc srcs[8] = DUMP_SPEC;
    const size_t i = (size_t)blockIdx.x * blockDim.x + threadIdx.x;
    const int r = (int)(i >> 10), c = (int)(i & 1023), blk = c >> 7, cc = c & 127;
    const DumpSrc d = srcs[blk];
    const bf16_t* p = (const bf16_t*)(ws + d.off);
    out[i] = bf2f(p[(size_t)r * d.ld + d.col0 + cc]);
}
#endif
extern "C" void kernel_launch(void* const* d_in, const int* in_sizes, int n_in, void* d_out, int out_size, void* d_ws, size_t ws_size, hipStream_t stream) {
    static int grid = 0;
    if (grid == 0) {
        if (n_in != 32 || out_size != T * D || ws_size < WS_END) { fprintf(stderr, "kernel_launch: unexpected problem (n_in %d, out %d, ws %zu)\n", n_in, out_size, ws_size); grid = -1; return; }
        int dev = 0, cus = 0, per_cu = 0;
        if (hipGetDevice(&dev) != hipSuccess || hipDeviceGetAttribute(&cus, hipDeviceAttributeMultiprocessorCount, dev) != hipSuccess) { grid = -1; return; }
        if (hipFuncSetAttribute((const void*)fwd_kernel, hipFuncAttributeMaxDynamicSharedMemorySize, LDS_BYTES) != hipSuccess) { fprintf(stderr, "kernel_launch: hipFuncSetAttribute failed\n"); grid = -1; return; }
        if (hipOccupancyMaxActiveBlocksPerMultiprocessor(&per_cu, (const void*)fwd_kernel, 512, LDS_BYTES) != hipSuccess || per_cu < 1) fprintf(stderr, "kernel_launch: occupancy query says %d\n", per_cu);
        (void)hipGetLastError();
        grid = cus;
        if (grid * 8 > T || (T % (grid * 8)) != 0) { fprintf(stderr, "kernel_launch: grid %d does not divide the rows\n", grid); grid = -1; return; }
    }
    if (grid < 0) return;
    (void)hipMemsetAsync((char*)d_ws + WS_CTL, 0, CTL_ZERO_BYTES, stream);
    Args a{};
    for (int i = 0; i < 32; ++i) a.in[i] = (const float*)d_in[i];
    a.out = (float*)d_out; a.ws = (unsigned char*)d_ws;
#if MK_ONE_LAUNCH
    a.ph_lo = 0; a.ph_hi = NPH;
    hipLaunchKernelGGL(fwd_kernel, dim3(grid), dim3(512), LDS_BYTES, stream, a);
#else
#ifndef STOP_PH
#define STOP_PH NPH
#endif
    for (int ph = 0; ph < STOP_PH; ++ph) {
        if (!phase_exists(ph)) continue;
        a.ph_lo = ph; a.ph_hi = ph + 1;
        hipLaunchKernelGGL(fwd_kernel, dim3(grid), dim3(512), LDS_BYTES, stream, a);
#ifdef REP_SLOTS
        { const int slot = ph < PH_L0 ? ph : 2 + (ph - PH_L0) % PH_PER_LAYER; if ((REP_SLOTS >> slot) & 1) {
#ifdef PROBE_VARIANTS
            a.variant = PROBE_VARIANTS;
#endif
            hipLaunchKernelGGL(fwd_kernel, dim3(grid), dim3(512), LDS_BYTES, stream, a); a.variant = 0; } }
#endif
    }
#ifdef DUMP_SPEC
    hipLaunchKernelGGL(dump_kernel, dim3(T * 1024 / 256), dim3(256), 0, stream, (const unsigned char*)d_ws, (float*)d_out);
#endif
#endif
}
```

```cpp
#include <hip/hip_runtime.h>
#include <cstdio>
#include <cstdint>

#ifndef PIN_ACC
#define PIN_ACC 0
#endif
#ifndef FP8_M1
#define FP8_M1 1
#endif
#ifndef FP8_M2
#define FP8_M2 1
#endif
#ifndef FP8_YS
#define FP8_INP_EVEN 0
#define FP8_INP_ODD 1
#define FP8_OUTP 1
#define WIDE_EPI 1
#define MOE_PN_FAST 1
#define MOE_XCD_OWN 1
#define FUSE_LOCAL 1
#define ROUTER_X 1
#define FP8_YS 1
#endif
#ifndef MK_ONE_LAUNCH
#define MK_ONE_LAUNCH 1
#endif

#ifndef PHMASK
#define PHMASK 0xFFFFF
#endif
#define PHEN(k) (((PHMASK) >> (k)) & 1)
#define LAS __attribute__((address_space(3)))
#define GAS __attribute__((address_space(1)))
typedef unsigned short bf16_t;
typedef short bf16x8 __attribute__((ext_vector_type(8)));
typedef float f32x4 __attribute__((ext_vector_type(4)));
typedef float f32x2 __attribute__((ext_vector_type(2)));
typedef unsigned u32x4 __attribute__((ext_vector_type(4)));
typedef unsigned u32x2 __attribute__((ext_vector_type(2)));

constexpr int D = 1024, NBATCH = 16, SEQ = 4096, T = NBATCH * SEQ, DEPTH = 4;
constexpr int NE = 32, TOPK = 4, TKTOT = T * TOPK;
constexpr int DPOOL = 512, DREC = 512, DINAB = 1536;
constexpr float LN_EPS = 1e-5f;
constexpr float DN_ALPHA = 1.6817928305074292f;

constexpr size_t MiB = 1ull << 20;
constexpr size_t WS_CTL = 0, CTL_ZERO_BYTES = 1 * MiB;
constexpr size_t WS_MOD = 1 * MiB;
constexpr size_t WS_BR = 3 * MiB;
constexpr size_t WS_BPOOL = 5 * MiB;
constexpr size_t WS_BGATE = 6 * MiB;
constexpr size_t WS_WSM = 8 * MiB;
constexpr size_t WS_BIASRI = 8 * MiB + 512 * 1024;
constexpr size_t WS_B1P = 9 * MiB;
constexpr size_t WS_SUMM = 10 * MiB;
constexpr size_t WS_TOPG = 12 * MiB;
constexpr size_t WS_ABIN = 16 * MiB;
constexpr size_t WS_ABOUT = 22 * MiB;
constexpr size_t WS_SGIN = 26 * MiB;
constexpr size_t WS_SGOUT = 34 * MiB;
constexpr size_t WS_LOG = 40 * MiB;
constexpr size_t WS_LIST = 64 * MiB;
constexpr size_t WS_BRB = 128 * MiB;
constexpr size_t WS_CB = 140 * MiB;
constexpr size_t WS_W1T = 128 * MiB;
constexpr size_t WS_W2T = 640 * MiB;
constexpr size_t WS_H = 896 * MiB;
constexpr size_t WS_Z = 1024 * MiB;
constexpr size_t WS_A2 = 1280 * MiB;
constexpr size_t WS_RI = 1408 * MiB;
constexpr size_t WS_YMIX = 1536 * MiB;
constexpr size_t WS_Y = 1664 * MiB;
constexpr size_t WS_ACT = 1792 * MiB;
constexpr size_t WS_YS = 2304 * MiB;
constexpr size_t WS_W1T8 = 2944 * MiB;
constexpr size_t WS_W2T8 = 3200 * MiB;
constexpr size_t WS_H8 = 3328 * MiB;
constexpr size_t WS_ACT8 = 3392 * MiB;
constexpr size_t WS_XB = 2816 * MiB;
constexpr size_t WS_END = 3648 * MiB;

constexpr int CW_BAR = 4096;
constexpr int CW_CNT = 16384;

constexpr int PH_CONV = 0, PH_H0 = 1, PH_L0 = 2, PH_PER_LAYER = 12, NPH = PH_L0 + PH_PER_LAYER * DEPTH;
__host__ __device__ constexpr bool phase_exists(int ph) {
    if (ph < PH_L0) return true;
    const int l = (ph - PH_L0) / PH_PER_LAYER, s = (ph - PH_L0) % PH_PER_LAYER;
    if ((l & 1) && (s == 2 || s == 3 || s == 4)) return false;
    return true;
}

constexpr int LDS_BYTES = 155648;
constexpr int LDSCTL_OFF = 154624;
constexpr int NXT_OFF = 131072;
constexpr int TAB_OFF = 147456;
constexpr int UTAB_OFF = 153600;

__device__ __forceinline__ unsigned f2bf(float f) { unsigned u = __builtin_bit_cast(unsigned, f); return (u + 0x7fffu + ((u >> 16) & 1u)) >> 16; }
typedef __bf16 bf16v2_t __attribute__((ext_vector_type(2)));
__device__ __forceinline__ unsigned pk2(float lo, float hi) { const f32x2 f = {lo, hi}; return __builtin_bit_cast(unsigned, __builtin_convertvector(f, bf16v2_t)); }
__device__ __forceinline__ float bflo(unsigned w) { return __builtin_bit_cast(float, w << 16); }
__device__ __forceinline__ float bfhi(unsigned w) { return __builtin_bit_cast(float, w & 0xffff0000u); }
__device__ __forceinline__ float bf2f(bf16_t h) { return __builtin_bit_cast(float, ((unsigned)h) << 16); }
__device__ __forceinline__ unsigned cvt_pk_bf16(float lo, float hi) { return pk2(lo, hi); }
__device__ __forceinline__ unsigned pk4_fp8(float a, float b, float c, float d) { int w = 0; w = __builtin_amdgcn_cvt_pk_fp8_f32(a, b, w, false); w = __builtin_amdgcn_cvt_pk_fp8_f32(c, d, w, true); return (unsigned)w; }
__device__ __forceinline__ float fast_sigmoid(float x) { return __builtin_amdgcn_rcpf(1.0f + __builtin_amdgcn_exp2f(-1.4426950408889634f * x)); }
__device__ __forceinline__ float gelu_tanh(float x) { const float u = x * (1.5957691216057308f + 0.07135481627362202f * x * x); return x * fast_sigmoid(u); }
__device__ __forceinline__ f32x2 pk_sigmoid_scaled(f32x2 x, float nk) {
    const f32x2 t = x * nk; f32x2 e; e.x = __builtin_amdgcn_exp2f(t.x); e.y = __builtin_amdgcn_exp2f(t.y);
    const f32x2 d = e + 1.0f; f32x2 r; r.x = __builtin_amdgcn_rcpf(d.x); r.y = __builtin_amdgcn_rcpf(d.y); return r; }
__device__ __forceinline__ f32x2 pk_gelu_tanh(f32x2 x) {
    const f32x2 t = x * ((x * x) * (-0.07135481627362202f * 1.4426950408889634f) + (-1.5957691216057308f * 1.4426950408889634f));
    f32x2 e; e.x = __builtin_amdgcn_exp2f(t.x); e.y = __builtin_amdgcn_exp2f(t.y);
    const f32x2 d = e + 1.0f; f32x2 r; r.x = __builtin_amdgcn_rcpf(d.x); r.y = __builtin_amdgcn_rcpf(d.y); return x * r; }
__device__ __forceinline__ float wave_sum(float v, int lane) {
#pragma unroll
    for (int o = 1; o < 64; o <<= 1) v += __builtin_bit_cast(float, __builtin_amdgcn_ds_bpermute((lane ^ o) << 2, __builtin_bit_cast(int, v)));
    return v;
}

__device__ __forceinline__ int lane_id_asm() { int l; asm volatile("v_mbcnt_lo_u32_b32 %0, -1, 0\n\tv_mbcnt_hi_u32_b32 %0, -1, %0" : "=v"(l)); return l; }
#define XB_TMO      128
#define XB_XCNT(j)  (256  + 64 * (j))
#define XB_XSUB(j)  (1280 + 64 * (j))
#define XB_XGEN(j)  (2304 + 64 * (j))
#define XB_TOP      3328
#define XB_TOPGEN   3392
#define XCD_BAR_WORDS 3456
#define XB_SPIN_CAP (1u << 18)

__device__ __forceinline__ unsigned xb_ld(unsigned* p)              { return __hip_atomic_load(p, __ATOMIC_RELAXED, __HIP_MEMORY_SCOPE_AGENT); }
__device__ __forceinline__ unsigned xb_add(unsigned* p, unsigned v) { return __hip_atomic_fetch_add(p, v, __ATOMIC_RELAXED, __HIP_MEMORY_SCOPE_AGENT); }
__device__ __forceinline__ unsigned xb_xcc_id() { return (unsigned)__builtin_amdgcn_s_getreg((3 << 11) | 20) & 0xFu; }
#define XB_SPIN(cond, bar) do { unsigned _sp = 0; while (cond) { __builtin_amdgcn_s_sleep(1); \
    if ((++_sp & 255u) == 0u) { if (xb_ld(&(bar)[XB_TMO])) break; if (_sp > XB_SPIN_CAP) { atomicAdd(&(bar)[XB_TMO], 1u); break; } } } } while (0)

struct XcdBarrier {
    unsigned* bar; unsigned x; int wv;
    volatile LAS unsigned* st;
};

__device__ __forceinline__ XcdBarrier xcd_barrier_post(unsigned* bar, volatile LAS unsigned* st, int wv) {
    XcdBarrier b; b.bar = bar; b.x = xb_xcc_id(); b.st = st; b.wv = wv;
    if (wv == 0 && lane_id_asm() == 0) (void)xb_add(&bar[XB_XCNT(b.x)], 1u);
    return b;
}
__device__ __forceinline__ void xcd_barrier_complete(unsigned* bar, unsigned x, unsigned& nloc, unsigned& nx) {
    const unsigned G = gridDim.x * gridDim.y * gridDim.z;
    unsigned sum, cnt, mine, sp = 0u;
    for (;;) {
        sum = 0u; cnt = 0u; mine = 0u;
#pragma unroll
        for (unsigned j = 0; j < 16; ++j) { const unsigned c = xb_ld(&bar[XB_XCNT(j)]); sum += c; cnt += (c > 0u) ? 1u : 0u; mine = (j == x) ? c : mine; }
        if (sum == G) break;
        __builtin_amdgcn_s_sleep(1);
        if ((++sp & 255u) == 0u) { if (xb_ld(&bar[XB_TMO])) break; if (sp > XB_SPIN_CAP) { atomicAdd(&bar[XB_TMO], 1u); break; } }
    }
    nloc = mine > 0u ? mine : 1u; nx = cnt > 0u ? cnt : 1u;
}

__device__ __forceinline__ void xcd_barrier(const XcdBarrier& b) {
    asm volatile("s_waitcnt vmcnt(0)" ::: "memory");
    __syncthreads();
    if (b.wv == 0 && lane_id_asm() == 0) {
        unsigned* bar = b.bar;
        __builtin_amdgcn_s_waitcnt(0);
        unsigned nloc = b.st[0], nx = b.st[1];
        if (nloc == 0u) { xcd_barrier_complete(bar, b.x, nloc, nx); b.st[0] = nloc; b.st[1] = nx; }
        const unsigned old = xb_add(&bar[XB_XSUB(b.x)], 1u);
        const unsigned gen = old / nloc;
        if (old + 1u == (gen + 1u) * nloc) {
            __builtin_amdgcn_fence(__ATOMIC_RELEASE, "agent");
            asm volatile("s_waitcnt vmcnt(0)" ::: "memory");
            const unsigned og = xb_add(&bar[XB_TOP], 1u);
            const unsigned tg = og / nx;
            if (og + 1u == (tg + 1u) * nx) xb_add(&bar[XB_TOPGEN], 1u);
            else XB_SPIN(xb_ld(&bar[XB_TOPGEN]) == tg, bar);
            __builtin_amdgcn_fence(__ATOMIC_ACQUIRE, "agent");
            xb_add(&bar[XB_XGEN(b.x)], 1u);
            asm volatile("s_waitcnt vmcnt(0)" ::: "memory");
        } else {
            XB_SPIN(xb_ld(&bar[XB_XGEN(b.x)]) == gen, bar);
            __builtin_amdgcn_fence(__ATOMIC_ACQUIRE, "agent");
            asm volatile("s_waitcnt vmcnt(0)" ::: "memory");
        }
    }
    __syncthreads();
}

#ifdef PROBE_VARIANTS
__device__ __forceinline__ int kvariant() { return *(const __attribute__((address_space(4))) int*)((const __attribute__((address_space(4))) unsigned char*)__builtin_amdgcn_kernarg_segment_ptr() + 280); }
#endif
__device__ __forceinline__ void glds16(const char* sbase, unsigned voff, unsigned lds_dst) {
    unsigned keep;
    asm volatile("s_mov_b32 %0, m0\n\ts_mov_b32 m0, %3\n\ts_nop 0\n\tglobal_load_lds_dwordx4 %1, %2\n\ts_mov_b32 m0, %0" : "=&s"(keep) : "v"(voff), "s"(sbase), "s"(lds_dst) : "memory");
}
__device__ __forceinline__ void glds4(const char* sbase, unsigned voff, unsigned lds_dst) {
    unsigned keep;
    asm volatile("s_mov_b32 %0, m0\n\ts_mov_b32 m0, %3\n\ts_nop 0\n\tglobal_load_lds_dword %1, %2\n\ts_mov_b32 m0, %0" : "=&s"(keep) : "v"(voff), "s"(sbase), "s"(lds_dst) : "memory");
}
namespace pg8 {
constexpr int BM = 256, BK = 64, HALF = 128, HTB = HALF * BK * 2, STAGE_BYTES = 8 * HTB, NXCD = 8, WGM = 8;
__host__ __device__ __forceinline__ int perm32(int rho) { const int n = rho >> 4, i = rho & 15; return 8 * (i >> 2) + 4 * n + (i & 3); }

template <bool F8> __host__ __device__ __forceinline__ int chunk_xor(int r15) { const int rp = (r15 >> 1) & 7; return F8 ? ((rp & 4) | ((rp & 1) << 1) | ((rp >> 1) & 1)) : rp; }
struct Unit { int arow, brow, pn, e, rt, cnt, slot, koff; };
struct Gemm { const void* A; const void* Bt; int lda, ldb, K, wscale; };
typedef int i32x4 __attribute__((ext_vector_type(4)));
typedef int i32x8 __attribute__((ext_vector_type(8)));
__device__ __forceinline__ i32x8 cat8(bf16x8 lo, bf16x8 hi) { return __builtin_shufflevector(__builtin_bit_cast(i32x4, lo), __builtin_bit_cast(i32x4, hi), 0, 1, 2, 3, 4, 5, 6, 7); }

struct DenseSched {
    static constexpr bool GATHER = false;
    int nM, nN, nwg, G, c, kblk = 0, bb = 0, rowm = 0;
    __device__ __forceinline__ void init(int M, int N, int G_, int c_) { nM = M / BM; nN = N / BM; nwg = nM * nN; G = G_; c = c_; }
    __device__ __forceinline__ bool next(int i, Unit& u) const {
        int pm, pn;
        if (rowm) { if (i >= nN) return false; pm = (c % NXCD) * (G / NXCD) + c / NXCD; pn = i; }
        else {
        const long L = (long)i * G + c; if (L >= nwg) return false;
        int wgid = (int)L; { const int q = nwg / NXCD, r = nwg % NXCD, xcd = wgid % NXCD, off = wgid / NXCD; wgid = (xcd < r ? xcd * (q + 1) : r * (q + 1) + (xcd - r) * q) + off; }
        const int nig = WGM * nN, gid = wgid / nig, fm = gid * WGM, gsz = (nM - fm) < WGM ? (nM - fm) : WGM;
        pm = fm + ((wgid % nig) % gsz); pn = (wgid % nig) / gsz; }
        u.arow = pm * BM; u.brow = pn * BM; u.pn = pn; u.e = 0; u.rt = pm; u.cnt = BM; u.slot = 0; u.koff = (pn & 1) * kblk; u.brow += ((pm * BM) >> 12) * bb; return true;
    }
    __device__ __forceinline__ void a_off(const Unit& u, LAS unsigned char*, int R0, int C0, int lda2, unsigned (&off)[2][2]) const {
#pragma unroll
        for (int h = 0; h < 2; ++h)
#pragma unroll
            for (int i = 0; i < 2; ++i) off[h][i] = (unsigned)((u.arow + 128 * h + 64 * i + R0) * lda2 + C0);
    }
};

struct MoeSched {
    static constexpr bool GATHER = true;
    const LAS int* utab;
    const int* list;
    const float* bias;
    int nunits, nexp_rows, shift;
    __device__ __forceinline__ bool next(int i, Unit& u) const {
        if (i >= nunits) return false;
        const LAS int* p = utab + 4 * i;
        u.e = __builtin_amdgcn_readfirstlane(p[0]); u.rt = __builtin_amdgcn_readfirstlane(p[1]); u.pn = __builtin_amdgcn_readfirstlane(p[2]); u.cnt = __builtin_amdgcn_readfirstlane(p[3]);
        u.arow = 0; u.brow = u.e * nexp_rows + u.pn * BM; u.slot = i % 3; u.koff = 0; return true;
    }
    __device__ __forceinline__ void tab_issue(const Unit& u, unsigned ldsb, int wid, int lane) const {
        if (wid < 4) { int p = u.rt * BM + 64 * wid + lane; p = p < u.cnt ? p : u.cnt - 1;
            glds4((const char*)(list + (size_t)u.e * TKTOT), (unsigned)p * 4u, ldsb + TAB_OFF + u.slot * 1024 + wid * 256); }
        else glds4((const char*)(bias + (size_t)u.e * nexp_rows + u.pn * BM), (unsigned)(64 * (wid - 4) + lane) * 4u, ldsb + TAB_OFF + 3072 + u.slot * 1024 + (wid - 4) * 256);
    }
    __device__ __forceinline__ void a_off(const Unit& u, LAS unsigned char* lds, int R0, int C0, int lda2, unsigned (&off)[2][2]) const {
        const LAS int* ids = (const LAS int*)(lds + TAB_OFF + u.slot * 1024);
#pragma unroll
        for (int h = 0; h < 2; ++h)
#pragma unroll
            for (int i = 0; i < 2; ++i) off[h][i] = (unsigned)((ids[128 * h + 64 * i + R0] >> shift) * lda2 + C0);
    }
};
__device__ __forceinline__ int moe_build_units(LAS int* utab, const volatile LAS int* tstart, const volatile LAS int* cnts, int NP, int G, int c, int tid) {
    if (MOE_XCD_OWN && (G % NXCD) == 0) {
        const int CX = G / NXCD, x = c / CX, j = c - x * CX, ttot = tstart[NE];
        const int glo = (int)((long)x * ttot / NXCD), ghi = (int)((long)(x + 1) * ttot / NXCD), total = (ghi - glo) * NP;
        if (tid < 64) { const int L = tid * CX + j;
            if (L < total) { const int g = glo + L / NP; int e = 0;
                for (int q = 0; q < NE - 1; ++q) if (tstart[q + 1] <= g) e = q + 1;
                utab[4 * tid + 0] = e; utab[4 * tid + 1] = g - tstart[e]; utab[4 * tid + 2] = L % NP; utab[4 * tid + 3] = cnts[e]; } }
        return total > j ? (total - j + CX - 1) / CX : 0;
    }
    const int total = tstart[NE] * NP;
    if (tid < 64) { const int L = tid * G + c;
        if (L < total) { int e = 0;
            for (int q = 0; q < NE - 1; ++q) if (tstart[q + 1] * NP <= L) e = q + 1;
            const int t0 = tstart[e], nte = tstart[e + 1] - t0, idx = L - t0 * NP;
            utab[4 * tid + 0] = e; utab[4 * tid + 1] = MOE_PN_FAST ? idx / NP : idx % nte; utab[4 * tid + 2] = MOE_PN_FAST ? idx % NP : idx / nte; utab[4 * tid + 3] = cnts[e]; } }
    return total > c ? (total - c + G - 1) / G : 0;
}

template <int ACT  , bool HAS_BIAS, bool HAS_SCALE, bool OSC = false, bool OUT8 = false> struct EpiDense {
    static constexpr int PERM = WIDE_EPI ? 2 : 1;
    bf16_t* O; int ldc; const float* bias; const float* scale; float oscale;
    __device__ __forceinline__ void operator()(const f32x4 (&acc)[2][2][4][2], const Unit& u, int wr, int wc, int fr, int fq) const {
        const int row0 = u.arow + wr * 64 + fr, col0 = PERM == 2 ? u.pn * BM + wc * 64 + 16 * fq : u.pn * BM + wc * 32 + 8 * fq;
        constexpr int BJS = PERM == 2 ? 8 : HALF;
        f32x4 bv[2][2], sv[2][2];
#pragma unroll
        for (int bj = 0; bj < 2; ++bj)
#pragma unroll
            for (int n = 0; n < 2; ++n) {
                if (HAS_BIAS) bv[bj][n] = *(const f32x4*)(bias + col0 + bj * BJS + 4 * n);
                if (HAS_SCALE) sv[bj][n] = *(const f32x4*)(scale + col0 + bj * BJS + 4 * n);
            }
#pragma unroll
        for (int ai = 0; ai < 2; ++ai)
#pragma unroll
            for (int m = 0; m < 4; ++m) { bf16_t* rowp = O + (size_t)(row0 + ai * HALF + m * 16) * ldc + col0; unsigned char* rowp8 = (unsigned char*)O + (size_t)(row0 + ai * HALF + m * 16) * ldc + col0;
                u32x4 w8;
#pragma unroll
                for (int bj = 0; bj < 2; ++bj) { f32x4 v0 = acc[ai][bj][m][0], v1 = acc[ai][bj][m][1];
                    if (OSC) { v0 = v0 * oscale; v1 = v1 * oscale; }
                    if (HAS_BIAS) { v0 = v0 + bv[bj][0]; v1 = v1 + bv[bj][1]; }
                    if (ACT == 1) { const f32x2 a = pk_gelu_tanh((f32x2){v0[0], v0[1]}), b = pk_gelu_tanh((f32x2){v0[2], v0[3]}), c = pk_gelu_tanh((f32x2){v1[0], v1[1]}), d = pk_gelu_tanh((f32x2){v1[2], v1[3]});
                        v0 = (f32x4){a.x, a.y, b.x, b.y}; v1 = (f32x4){c.x, c.y, d.x, d.y}; }
                    if (ACT == 2) { const float nk = -1.4426950408889634f;
                        const f32x2 a = pk_sigmoid_scaled((f32x2){v0[0], v0[1]}, nk), b = pk_sigmoid_scaled((f32x2){v0[2], v0[3]}, nk), c = pk_sigmoid_scaled((f32x2){v1[0], v1[1]}, nk), d = pk_sigmoid_scaled((f32x2){v1[2], v1[3]}, nk);
                        v0 = (f32x4){a.x, a.y, b.x, b.y}; v1 = (f32x4){c.x, c.y, d.x, d.y}; }
                    if (HAS_SCALE) { v0 = v0 * sv[bj][0]; v1 = v1 * sv[bj][1]; }
                    if constexpr (OUT8) { const unsigned p0 = pk4_fp8(v0[0], v0[1], v0[2], v0[3]), p1 = pk4_fp8(v1[0], v1[1], v1[2], v1[3]);
                        if constexpr (PERM == 2) { if (bj == 0) { w8.x = p0; w8.y = p1; } else { w8.z = p0; w8.w = p1; *(u32x4*)rowp8 = w8; } }
                        else { u32x2 w; w.x = p0; w.y = p1; *(u32x2*)(rowp8 + bj * HALF) = w; } }
                    else { u32x4 w; w.x = cvt_pk_bf16(v0[0], v0[1]); w.y = cvt_pk_bf16(v0[2], v0[3]); w.z = cvt_pk_bf16(v1[0], v1[1]); w.w = cvt_pk_bf16(v1[2], v1[3]);
                    *(u32x4*)(rowp + bj * BJS) = w; } } }
    }
};
struct EpiRouter {
    static constexpr int PERM = 0;
    float* LOG;
    __device__ __forceinline__ void operator()(const f32x4 (&acc)[2][2][4][2], const Unit& u, int wr, int wc, int fr, int fq) const {
        if (wc < 2) {
#pragma unroll
            for (int ai = 0; ai < 2; ++ai)
#pragma unroll
                for (int m = 0; m < 4; ++m) { float* rowp = LOG + (size_t)(u.arow + ai * HALF + wr * 64 + m * 16 + fr) * 64 + wc * 32 + 4 * fq;
#pragma unroll
                    for (int n = 0; n < 2; ++n) *(f32x4*)(rowp + 16 * n) = acc[ai][0][m][n]; }
        }
    }
};
template <bool OUT8> struct EpiMoe1 {
    static constexpr int PERM = 0;
    bf16_t* ACT; LAS unsigned char* lds; float oscale;
    __device__ __forceinline__ void operator()(const f32x4 (&acc)[2][2][4][2], const Unit& u, int wr, int wc, int fr, int fq) const {
        const LAS int* ids = (const LAS int*)(lds + TAB_OFF + u.slot * 1024);
        const LAS float* bp = (const LAS float*)(lds + TAB_OFF + 3072 + u.slot * 1024) + wc * 32 + 4 * fq;
        f32x4 bg[2], bl[2];
#pragma unroll
        for (int bj = 0; bj < 2; ++bj) { bg[bj] = *(const LAS f32x4*)(bp + bj * HALF); bl[bj] = *(const LAS f32x4*)(bp + bj * HALF + 16) + 1.0f; }
        const int j0 = u.pn * 128 + wc * 32 + 8 * fq;
#pragma unroll
        for (int ai = 0; ai < 2; ++ai)
#pragma unroll
            for (int m = 0; m < 4; ++m) {
                const int pl = ai * HALF + wr * 64 + m * 16 + fr;
                if (u.rt * BM + pl < u.cnt) {
                    const int flat = ids[pl];
                    float o[8];
#pragma unroll
                    for (int bj = 0; bj < 2; ++bj) { const f32x4 g = acc[ai][bj][m][0] * oscale + bg[bj], l = acc[ai][bj][m][1] * oscale + bl[bj];
#pragma unroll
                        for (int hh = 0; hh < 2; ++hh) {
                            const f32x2 xg = {fminf(g[2 * hh], 7.0f), fminf(g[2 * hh + 1], 7.0f)};
                            const f32x2 xl = {__builtin_amdgcn_fmed3f(l[2 * hh], -6.0f, 8.0f), __builtin_amdgcn_fmed3f(l[2 * hh + 1], -6.0f, 8.0f)};
                            const f32x2 r = pk_sigmoid_scaled(xg, -1.702f * 1.4426950408889634f), oo = (xg * xl) * r;
                            o[bj * 4 + 2 * hh] = oo.x; o[bj * 4 + 2 * hh + 1] = oo.y; } }
                    if constexpr (OUT8) { u32x2 w; w.x = pk4_fp8(o[0], o[1], o[2], o[3]); w.y = pk4_fp8(o[4], o[5], o[6], o[7]);
                        *(u32x2*)((unsigned char*)ACT + (size_t)flat * 1024 + j0) = w; }
                    else { u32x4 w; w.x = cvt_pk_bf16(o[0], o[1]); w.y = cvt_pk_bf16(o[2], o[3]); w.z = cvt_pk_bf16(o[4], o[5]); w.w = cvt_pk_bf16(o[6], o[7]);
                        *(u32x4*)(ACT + (size_t)flat * 1024 + j0) = w; }
                }
            }
    }
};
struct EpiMoe2 {
    static constexpr int PERM = (WIDE_EPI && FP8_YS) ? 2 : 1;
    bf16_t* YS; LAS unsigned char* lds; float oscale;
    __device__ __forceinline__ void operator()(const f32x4 (&acc)[2][2][4][2], const Unit& u, int wr, int wc, int fr, int fq) const {
        const LAS int* ids = (const LAS int*)(lds + TAB_OFF + u.slot * 1024);
        if constexpr (PERM == 2) {
            const LAS float* bp = (const LAS float*)(lds + TAB_OFF + 3072 + u.slot * 1024) + wc * 64 + 16 * fq;
            const int col0 = u.pn * BM + wc * 64 + 16 * fq;
            const float os = 16.0f * oscale;
#pragma unroll
            for (int ai = 0; ai < 2; ++ai) {
                const f32x4 b00 = *(const LAS f32x4*)(bp) * 16.0f, b01 = *(const LAS f32x4*)(bp + 4) * 16.0f, b10 = *(const LAS f32x4*)(bp + 8) * 16.0f, b11 = *(const LAS f32x4*)(bp + 12) * 16.0f;
#pragma unroll
                for (int m = 0; m < 4; ++m) {
                    const int pl = ai * HALF + wr * 64 + m * 16 + fr;
                    if (u.rt * BM + pl < u.cnt) {
                        const int flat = ids[pl];
                        const f32x4 v00 = acc[ai][0][m][0] * os + b00, v01 = acc[ai][0][m][1] * os + b01, v10 = acc[ai][1][m][0] * os + b10, v11 = acc[ai][1][m][1] * os + b11;
                        u32x4 w; w.x = pk4_fp8(v00[0], v00[1], v00[2], v00[3]); w.y = pk4_fp8(v01[0], v01[1], v01[2], v01[3]); w.z = pk4_fp8(v10[0], v10[1], v10[2], v10[3]); w.w = pk4_fp8(v11[0], v11[1], v11[2], v11[3]);
                        *(u32x4*)((unsigned char*)YS + (size_t)flat * 1024 + col0) = w;
                    }
                }
            }
        } else {
        const LAS float* bp = (const LAS float*)(lds + TAB_OFF + 3072 + u.slot * 1024) + wc * 32 + 8 * fq;
        const int col0 = u.pn * BM + wc * 32 + 8 * fq;
#pragma unroll
        for (int bj = 0; bj < 2; ++bj) {
            const float os = FP8_YS ? 16.0f * oscale : oscale;
            const f32x4 b0 = *(const LAS f32x4*)(bp + bj * HALF) * (FP8_YS ? 16.0f : 1.0f), b1 = *(const LAS f32x4*)(bp + bj * HALF + 4) * (FP8_YS ? 16.0f : 1.0f);
#pragma unroll
            for (int ai = 0; ai < 2; ++ai)
#pragma unroll
                for (int m = 0; m < 4; ++m) {
                    const int pl = ai * HALF + wr * 64 + m * 16 + fr;
                    if (u.rt * BM + pl < u.cnt) {
                        const int flat = ids[pl];
                        const f32x4 v0 = acc[ai][bj][m][0] * os + b0, v1 = acc[ai][bj][m][1] * os + b1;
                        if (FP8_YS) { u32x2 w; w.x = pk4_fp8(v0[0], v0[1], v0[2], v0[3]); w.y = pk4_fp8(v1[0], v1[1], v1[2], v1[3]);
                            *(u32x2*)((unsigned char*)YS + (size_t)flat * 1024 + col0 + bj * HALF) = w; }
                        else { u32x4 w; w.x = cvt_pk_bf16(v0[0], v0[1]); w.y = cvt_pk_bf16(v0[2], v0[3]); w.z = cvt_pk_bf16(v1[0], v1[1]); w.w = cvt_pk_bf16(v1[2], v1[3]);
                            *(u32x4*)(YS + (size_t)flat * 1024 + col0 + bj * HALF) = w; }
                    }
                }
        }
        }
    }
};

template <bool F8, class Epi, class Sched>
__device__ __forceinline__ void gemm_phase(LAS unsigned char* lds, const Gemm g, const Sched& S, const Epi& E, const int wave0) {
    const int tid = (wave0 << 6) | lane_id_asm();
    const int wid = __builtin_amdgcn_readfirstlane(tid >> 6), lane = tid & 63, wr = wid >> 2, wc = wid & 3, fr = lane & 15, fq = lane >> 4;
    constexpr unsigned ESZ = F8 ? 1u : 2u;
    const int nt = (int)((unsigned)g.K * ESZ / 128u);
    int R0, C0;
    R0 = 8 * wid + (lane >> 3); C0 = 16 * ((lane & 7) ^ chunk_xor<F8>(R0 & 15));
    const unsigned lda2 = (unsigned)g.lda * ESZ, ldb2 = (unsigned)g.ldb * ESZ;
    const unsigned voffB = (unsigned)((Epi::PERM == 2 ? (64 * (R0 >> 5) + 16 * ((R0 >> 2) & 3) + 4 * ((R0 >> 4) & 1) + (R0 & 3)) : Epi::PERM == 1 ? ((R0 & ~31) + perm32(R0 & 31)) : R0) * (int)ldb2 + C0);
    constexpr int PIECE_B = Epi::PERM == 2 ? 128 : 64;
    const unsigned aoffl = (unsigned)(R0 * (int)lda2 + C0);
    const unsigned kstep = 128;
    const size_t hstepB = (size_t)(Epi::PERM == 2 ? 8 : HALF) * ldb2;
    const unsigned ldsw = (unsigned)wid * 1024u;
    const int ab = fr * 128 + 16 * ((F8 ? 2 * fq : fq) ^ chunk_xor<F8>(fr));
    const int aoff0 = wr * 8192 + ab, boff0 = wc * 4096 + ab;
    constexpr int KX = F8 ? 16 : 64;
    const char* const Abase = (const char*)g.A;
    const unsigned ldsb = (unsigned)(size_t)lds;
#define PG8_SA(b, h) (((b) * 2 + (h)) * HTB)
#define PG8_SB(b, h) ((4 + (b) * 2 + (h)) * HTB)
#define PG8_GOFF(h, NXT) do { if constexpr (Sched::GATHER) go = *(const LAS u32x2*)(lds + NXT_OFF + ((((NXT) ? ui + 1 : ui) & 1) << 13) + tid * 16 + (h) * 8); } while (0)
#define PG8_STAGE_A(bufoff, h, NXT, kb) do { _Pragma("unroll") for (int _i = 0; _i < 2; ++_i) { \
        if constexpr (Sched::GATHER) glds16(Abase + (kb), _i ? go.y : go.x, ldsb + (bufoff) + ldsw + _i * 8192); \
        else glds16(Abase + ((NXT) ? nxtA : curA) + (size_t)((h) * 128 + _i * 64) * lda2 + (kb), aoffl, ldsb + (bufoff) + ldsw + _i * 8192); } } while (0)
#define PG8_STAGE_B(bufoff, bptr, kb) do { _Pragma("unroll") for (int _i = 0; _i < 2; ++_i) \
        glds16((bptr) + (size_t)(_i * PIECE_B) * ldb2 + (kb), voffB, ldsb + (bufoff) + ldsw + _i * 8192); } while (0)
#define PG8_LDA(dst, b, h) do { int _a1 = aoff0 ^ KX; asm volatile("" : "+v"(_a1)); \
        _Pragma("unroll") for (int m = 0; m < 4; ++m) _Pragma("unroll") for (int k = 0; k < 2; ++k) dst[m][k] = *(const LAS bf16x8*)(lds + PG8_SA(b, h) + (k ? _a1 : aoff0) + m * 2048); } while (0)
#define PG8_LDB(dst, b, h) do { int _b1 = boff0 ^ KX; asm volatile("" : "+v"(_b1)); \
        _Pragma("unroll") for (int n = 0; n < 2; ++n) _Pragma("unroll") for (int k = 0; k < 2; ++k) dst[n][k] = *(const LAS bf16x8*)(lds + PG8_SB(b, h) + (k ? _b1 : boff0) + n * 2048); } while (0)
#define PG8_MMA(ai, bj, At, Bt) do { __builtin_amdgcn_s_setprio(1); _Pragma("unroll") for (int m = 0; m < 4; ++m) _Pragma("unroll") for (int n = 0; n < 2; ++n) { \
        if constexpr (F8) acc[ai][bj][m][n] = __builtin_amdgcn_mfma_scale_f32_16x16x128_f8f6f4(cat8(Bt[n][0], Bt[n][1]), cat8(At[m][0], At[m][1]), acc[ai][bj][m][n], 0, 0, 0, 0, 0, 0); \
        else { _Pragma("unroll") for (int k = 0; k < 2; ++k) acc[ai][bj][m][n] = __builtin_amdgcn_mfma_f32_16x16x32_bf16(Bt[n][k], At[m][k], acc[ai][bj][m][n], 0, 0, 0); } } \
        __builtin_amdgcn_s_setprio(0); } while (0)
#define PG8_WAIT_V(n) asm volatile("s_waitcnt vmcnt(" #n ")" ::: "memory")
#define PG8_WAIT_L(n) asm volatile("s_waitcnt lgkmcnt(" #n ")" ::: "memory")
#define PG8_BAR __builtin_amdgcn_s_barrier()
#define PG8_SCHED __builtin_amdgcn_sched_barrier(0)
#define PG8_KITER(k1, b2, NXT, k2, k3) do { \
        PG8_GOFF(1, 0); PG8_LDB(B0, 0, 0); PG8_LDB(B1, 0, 1); PG8_SCHED; PG8_LDA(At, 0, 0); PG8_STAGE_A(PG8_SA(1, 1), 1, 0, (k1)); \
        PG8_WAIT_V(8); PG8_WAIT_L(0); PG8_BAR; PG8_MMA(0, 0, At, B0); PG8_MMA(0, 1, At, B1); PG8_BAR; PG8_SCHED; \
        PG8_GOFF(0, NXT); PG8_LDA(At, 0, 1); PG8_STAGE_B(PG8_SB(0, 0), (b2), (k2)); PG8_STAGE_B(PG8_SB(0, 1), (b2) + hstepB, (k2)); PG8_STAGE_A(PG8_SA(0, 0), 0, NXT, (k2)); \
        PG8_WAIT_V(8); PG8_WAIT_L(0); PG8_BAR; PG8_MMA(1, 0, At, B0); PG8_MMA(1, 1, At, B1); PG8_BAR; PG8_SCHED; \
        PG8_GOFF(1, NXT); PG8_LDB(B0, 1, 0); PG8_LDB(B1, 1, 1); PG8_SCHED; PG8_LDA(At, 1, 0); PG8_STAGE_A(PG8_SA(0, 1), 1, NXT, (k2)); \
        PG8_WAIT_V(8); PG8_WAIT_L(0); PG8_BAR; PG8_MMA(0, 0, At, B0); PG8_MMA(0, 1, At, B1); PG8_BAR; PG8_SCHED; \
        PG8_GOFF(0, NXT); PG8_LDA(At, 1, 1); PG8_STAGE_B(PG8_SB(1, 0), (b2), (k3)); PG8_STAGE_B(PG8_SB(1, 1), (b2) + hstepB, (k3)); PG8_STAGE_A(PG8_SA(1, 0), 0, NXT, (k3)); \
        PG8_WAIT_V(8); PG8_WAIT_L(0); PG8_BAR; PG8_MMA(1, 0, At, B0); PG8_MMA(1, 1, At, B1); PG8_BAR; PG8_SCHED; } while (0)

    Unit cur, nxt; int ui = 0;
    if (!S.next(0, cur)) return;
    unsigned curoff[2][2], nxtoff[2][2];
    size_t curA = 0, nxtA = 0;
    bool has_next = S.next(1, nxt);
#define PG8_NXT_SLOT ((LAS u32x4*)(lds + NXT_OFF) + tid)
    if constexpr (Sched::GATHER) {
        S.tab_issue(cur, ldsb, wid, lane); if (has_next) S.tab_issue(nxt, ldsb, wid, lane);
        asm volatile("s_waitcnt vmcnt(0)" ::: "memory"); __builtin_amdgcn_s_barrier(); asm volatile("" ::: "memory");
        S.a_off(cur, lds, R0, C0, (int)lda2, curoff);
        if (has_next) S.a_off(nxt, lds, R0, C0, (int)lda2, nxtoff);
        else {
#pragma unroll
            for (int h = 0; h < 2; ++h)
#pragma unroll
                for (int i = 0; i < 2; ++i) nxtoff[h][i] = curoff[h][i]; }
        ((LAS u32x4*)(lds + NXT_OFF))[tid] = (u32x4){curoff[0][0], curoff[0][1], curoff[1][0], curoff[1][1]};
        ((LAS u32x4*)(lds + NXT_OFF + 8192))[tid] = (u32x4){nxtoff[0][0], nxtoff[0][1], nxtoff[1][0], nxtoff[1][1]};
    } else { curA = (size_t)cur.arow * lda2 + cur.koff; nxtA = has_next ? (size_t)nxt.arow * lda2 + nxt.koff : curA; }
    f32x4 acc[2][2][4][2];
#pragma unroll
    for (int a = 0; a < 2; ++a)
#pragma unroll
        for (int b = 0; b < 2; ++b)
#pragma unroll
            for (int m = 0; m < 4; ++m)
#pragma unroll
                for (int n = 0; n < 2; ++n) acc[a][b][m][n] = (f32x4){0.f, 0.f, 0.f, 0.f};
    bf16x8 At[4][2], B0[2][2], B1[2][2];
    const char* cB = (const char*)g.Bt + (size_t)cur.brow * ldb2 + cur.koff;
    u32x2 go = {0u, 0u};
    PG8_STAGE_B(PG8_SB(0, 0), cB, 0u); PG8_STAGE_B(PG8_SB(0, 1), cB + hstepB, 0u); PG8_GOFF(0, 0); PG8_STAGE_A(PG8_SA(0, 0), 0, 0, 0u); PG8_GOFF(1, 0); PG8_STAGE_A(PG8_SA(0, 1), 1, 0, 0u);
    if (wr == 1) PG8_BAR;
    PG8_WAIT_V(2); PG8_BAR;
    PG8_GOFF(0, 0); PG8_STAGE_B(PG8_SB(1, 0), cB, kstep); PG8_STAGE_A(PG8_SA(1, 0), 0, 0, kstep); PG8_STAGE_B(PG8_SB(1, 1), cB + hstepB, kstep);
    PG8_WAIT_V(6); PG8_BAR;
    for (;;) {
        const char* nB = has_next ? (const char*)g.Bt + (size_t)nxt.brow * ldb2 + nxt.koff : cB;
        Unit u2; bool has2 = false;
        if constexpr (Sched::GATHER) has2 = has_next && S.next(ui + 2, u2);
#pragma unroll 1
        for (int t = 0; t < nt - 2; t += 2) {
            const unsigned k1 = (unsigned)(t + 1) * kstep, k2 = (unsigned)(t + 2) * kstep, k3 = (unsigned)(t + 3) * kstep;
            if constexpr (Sched::GATHER) { if (t == 2 && has2) S.tab_issue(u2, ldsb, wid, lane); }
            PG8_KITER(k1, cB, 0, k2, k3);
        }
        { const unsigned k1 = (unsigned)(nt - 1) * kstep; PG8_KITER(k1, nB, 1, 0u, kstep); }
#if PIN_ACC
#pragma unroll
        for (int a = 0; a < 2; ++a)
#pragma unroll
            for (int b = 0; b < 2; ++b)
#pragma unroll
                for (int m = 0; m < 4; ++m) asm volatile("" : "+v"(acc[a][b][m][0]), "+v"(acc[a][b][m][1]));
#endif
        if (wr == 0) PG8_BAR;
#ifdef PROBE_VARIANTS
        if (!(kvariant() & 4))
#endif
        { const int l2 = lane_id_asm(); E(acc, cur, wr, wc, l2 & 15, l2 >> 4); }
        if (!has_next) break;
#pragma unroll
        for (int a = 0; a < 2; ++a)
#pragma unroll
            for (int b = 0; b < 2; ++b)
#pragma unroll
                for (int m = 0; m < 4; ++m)
#pragma unroll
                    for (int n = 0; n < 2; ++n) acc[a][b][m][n] = (f32x4){0.f, 0.f, 0.f, 0.f};
        cur = nxt; cB = nB; ++ui; curA = nxtA;
        has_next = S.next(ui + 1, nxt);
        if (has_next) {
            if constexpr (Sched::GATHER) { const int tz = (wave0 << 6) | lane_id_asm(); int R0z, C0z;
                { const int lz = tz & 63; R0z = 8 * wid + (lz >> 3); C0z = 16 * ((lz & 7) ^ chunk_xor<F8>(R0z & 15)); }
                S.a_off(nxt, lds, R0z, C0z, (int)lda2, nxtoff);
                ((LAS u32x4*)(lds + NXT_OFF + (((ui + 1) & 1) << 13)))[tz] = (u32x4){nxtoff[0][0], nxtoff[0][1], nxtoff[1][0], nxtoff[1][1]}; }
            else nxtA = (size_t)nxt.arow * lda2 + nxt.koff;
        } else if constexpr (Sched::GATHER) { const int tz = (wave0 << 6) | lane_id_asm();
            ((LAS u32x4*)(lds + NXT_OFF + (((ui + 1) & 1) << 13)))[tz] = ((const LAS u32x4*)(lds + NXT_OFF + ((ui & 1) << 13)))[tz]; }
        if (wr == 1) PG8_BAR;
    }
    PG8_WAIT_V(0);
    PG8_BAR;
#undef PG8_SA
#undef PG8_SB
#undef PG8_STAGE_A
#undef PG8_GOFF
#undef PG8_STAGE_B
#undef PG8_LDA
#undef PG8_LDB
#undef PG8_MMA
#undef PG8_WAIT_V
#undef PG8_WAIT_L
#undef PG8_BAR
#undef PG8_SCHED
#undef PG8_KITER
#undef PG8_NXT_SLOT
}
}

struct Args { const float* in[32]; float* out; unsigned char* ws; int ph_lo, ph_hi, variant, pad; };
typedef const __attribute__((address_space(4))) unsigned char* kptr_t;
__device__ __forceinline__ const float* kin(int i) { kptr_t p = (kptr_t)__builtin_amdgcn_kernarg_segment_ptr(); asm volatile("" : "+s"(p)); return *(const float* const __attribute__((address_space(4)))*)(p + 8 * i); }
enum { I_X = 0, I_C, I_MODW, I_MODB, I_LNG, I_LNB, I_ABWIN, I_POOLW, I_POOLS, I_CONVW, I_CONVB, I_WA, I_BA, I_WX, I_BX, I_LAM, I_ABWOUT, I_ABBOUT,
       I_SGWIN, I_SGBIN, I_SGLNG, I_SGLNB, I_SGWS, I_SGBS, I_SGWOUT, I_SGBOUT, I_RW, I_RB, I_W1, I_B1, I_W2, I_B2 };

__device__ __forceinline__ int w1_rho(int n) { const int nn = n & 1, j = n >> 1; return ((j >> 7) << 8) | (((j >> 2) & 1) << 7) | (((j >> 5) & 3) << 5) | (nn << 4) | (((j >> 3) & 3) << 2) | (j & 3); }
__device__ __forceinline__ int w1_n_of_rho(int rho) { const int pn = rho >> 8, bj = (rho >> 7) & 1, wc = (rho >> 5) & 3, nn = (rho >> 4) & 1, fq = (rho >> 2) & 3, i = rho & 3; return 2 * (128 * pn + 32 * wc + 8 * fq + 4 * bj + i) + nn; }
template <bool W1MAP>
__device__ __forceinline__ void conv_item(const float* W, int N, bf16_t* WT, int item, int lane) {
    const int nblk = N >> 5, kb = item / nblk, nb = item - kb * nblk;
    const int kg = lane >> 3, nl = lane & 7, k0 = kb * 64 + kg * 8, n0 = nb * 32 + nl * 4;
    f32x4 v[8];
#pragma unroll
    for (int q = 0; q < 8; ++q) v[q] = *(const f32x4*)(W + (size_t)(k0 + q) * N + n0);
#pragma unroll
    for (int i = 0; i < 4; ++i) {
        const int n = n0 + i, row = W1MAP ? w1_rho(n) : n;
        u32x4 o; o.x = pk2(v[0][i], v[1][i]); o.y = pk2(v[2][i], v[3][i]); o.z = pk2(v[4][i], v[5][i]); o.w = pk2(v[6][i], v[7][i]);
        *(u32x4*)(WT + (size_t)row * 1024 + k0) = o;
    }
}

template <bool W1MAP>
__device__ __forceinline__ void conv_item_f8(const float* W, int N, unsigned char* WT8, int item, int lane, float scale) {
    const int nblk = N >> 5, kb = item / nblk, nb = item - kb * nblk;
    const int kg = lane >> 3, nl = lane & 7, k0 = kb * 128 + kg * 16, n0 = nb * 32 + nl * 4;
    f32x4 v[16];
#pragma unroll
    for (int q = 0; q < 16; ++q) v[q] = *(const f32x4*)(W + (size_t)(k0 + q) * N + n0) * scale;
#pragma unroll
    for (int i = 0; i < 4; ++i) {
        const int n = n0 + i, row = W1MAP ? w1_rho(n) : n;
        u32x4 o; o.x = pk4_fp8(v[0][i], v[1][i], v[2][i], v[3][i]); o.y = pk4_fp8(v[4][i], v[5][i], v[6][i], v[7][i]);
        o.z = pk4_fp8(v[8][i], v[9][i], v[10][i], v[11][i]); o.w = pk4_fp8(v[12][i], v[13][i], v[14][i], v[15][i]);
        *(u32x4*)(WT8 + (size_t)row * 1024 + k0) = o;
    }
}

#define IN(k) (lo <= (k) && (k) < hi)
#define SEAM(k) do { if ((k) + 1 < hi) xcd_barrier(bar); } while (0)
#define LSEAM(k) do { if ((k) + 1 < hi) { if (FUSE_LOCAL && G == 256) { __builtin_amdgcn_fence(__ATOMIC_RELEASE, "workgroup"); __syncthreads(); __builtin_amdgcn_fence(__ATOMIC_ACQUIRE, "workgroup"); } else xcd_barrier(bar); } } while (0)
#define PH_LOCALS \
    const int tid = (wave0 << 6) | lane_id_asm(); \
    const int lane = tid & 63, wave = wave0; \
    int bx = blockIdx.x; asm volatile("" : "+s"(bx)); \
    const int vcu = (G % 8 == 0) ? (bx % 8) * (G / 8) + bx / 8 : bx; \
    const int gw = vcu * 8 + wave, NGW = G * 8; \
    unsigned char* ws; { kptr_t kp_ = (kptr_t)__builtin_amdgcn_kernarg_segment_ptr(); asm volatile("" : "+s"(kp_)); ws = *(unsigned char* const __attribute__((address_space(4)))*)(kp_ + 264); } \
    float* Xf; { kptr_t kp_ = (kptr_t)__builtin_amdgcn_kernarg_segment_ptr(); asm volatile("" : "+s"(kp_)); Xf = *(float* const __attribute__((address_space(4)))*)(kp_ + 256); } \
    unsigned* const ctl = (unsigned*)(ws + WS_CTL); \
    float* const MOD = (float*)(ws + WS_MOD); bf16_t* const Hb = (bf16_t*)(ws + WS_H); bf16_t* const Zb = (bf16_t*)(ws + WS_Z); bf16_t* const A2b = (bf16_t*)(ws + WS_A2); \
    bf16_t* const RIb = (bf16_t*)(ws + WS_RI); bf16_t* const YMb = (bf16_t*)(ws + WS_YMIX); bf16_t* const Yb = (bf16_t*)(ws + WS_Y); bf16_t* const ACTb = (bf16_t*)(ws + WS_ACT); \
    bf16_t* const YSb = (bf16_t*)(ws + WS_YS); float* const LOGf = (float*)(ws + WS_LOG); float* const TOPG = (float*)(ws + WS_TOPG); int* const LIST = (int*)(ws + WS_LIST); \
    float* const SUMM = (float*)(ws + WS_SUMM); \
    (void)lane; (void)wave; (void)gw; (void)NGW; (void)ctl; (void)MOD; (void)Hb; (void)Zb; (void)A2b; (void)RIb; (void)YMb; (void)Yb; (void)ACTb; (void)YSb; (void)LOGf; (void)TOPG; (void)LIST; (void)SUMM; (void)Xf; (void)vcu


template <int L, int PASS>
__device__ __forceinline__ void scan_phase(const int lo, const int hi, const int G, const XcdBarrier& bar, const int wave0) {
    constexpr int l = L, pass = PASS, P = PH_L0 + PH_PER_LAYER * L, jj = L >> 1; constexpr bool odd = (L & 1) != 0;
            if (PHEN(6) && !odd && IN(P + 3 + pass)) {
            PH_LOCALS;
                for (int it = gw; it < 16 * 32 * 4; it += NGW) {
                    const int b = it >> 7, n = (it >> 2) & 31, cg = it & 3;
                    const int ch = cg * 128 + 2 * lane;
                    float sp[2];
#pragma unroll
                    for (int q = 0; q < 2; ++q) { const float x = -kin(I_LAM)[jj * 512 + ch + q]; sp[q] = 8.0f * 1.4426950408889634f * (fmaxf(x, 0.f) + log1pf(__expf(-fabsf(x)))); }
                    float one = 1.0f; asm volatile("" : "+v"(one));
                    float h0 = 0.f, h1 = 0.f, p0 = one, p1 = one;
                    if (pass == 1) {
#pragma unroll 1
                        for (int m = 0; m < n; ++m) { const f32x4 s = *(const f32x4*)(SUMM + (((size_t)b * 32 + m) * 512 + ch) * 2); h0 = s[0] * h0 + s[1]; h1 = s[2] * h1 + s[3]; }
                    }
                    const size_t row0 = (size_t)b * SEQ + n * 128;
#pragma unroll 4
                    for (int t = 0; t < 128; ++t) {
                        const size_t r = row0 + t;
                        const unsigned rw = *(const unsigned*)(RIb + r * 1024 + ch), iw = *(const unsigned*)(RIb + r * 1024 + 512 + ch), xw = *(const unsigned*)(A2b + r * 1024 + 512 + ch);
                        const float a0 = __builtin_amdgcn_exp2f(-bflo(rw) * sp[0]), a1 = __builtin_amdgcn_exp2f(-bfhi(rw) * sp[1]);
                        const float m0 = __builtin_amdgcn_sqrtf(fmaxf(__builtin_fmaf(-a0, a0, 1.0f), 0.f)), m1 = __builtin_amdgcn_sqrtf(fmaxf(__builtin_fmaf(-a1, a1, 1.0f), 0.f));
                        h0 = a0 * h0 + m0 * (bflo(iw) * bflo(xw)); h1 = a1 * h1 + m1 * (bfhi(iw) * bfhi(xw));
                        if (pass == 0) { p0 *= a0; p1 *= a1; }
                        else { const unsigned gwd = *(const unsigned*)(Zb + r * DINAB + 1024 + ch);
                            if (FP8_OUTP) *(unsigned short*)((unsigned char*)YMb + r * 1024 + 512 + ch) = (unsigned short)pk4_fp8(h0 * gelu_tanh(bflo(gwd)), h1 * gelu_tanh(bfhi(gwd)), 0.f, 0.f);
                            else *(unsigned*)(YMb + r * 1024 + 512 + ch) = pk2(h0 * gelu_tanh(bflo(gwd)), h1 * gelu_tanh(bfhi(gwd))); }
                    }
                    if (pass == 0) *(f32x4*)(SUMM + (((size_t)b * 32 + n) * 512 + ch) * 2) = (f32x4){p0, h0, p1, h1};
                }
                SEAM(P + 3 + pass);
            }
}

template <int L, int SUB>
__device__ __forceinline__ void ln_phase(const int lo, const int hi, const int G, const XcdBarrier& bar, const int wave0) {
    constexpr int l = L, sub = SUB, P = PH_L0 + PH_PER_LAYER * L; constexpr int ph = SUB == 0 ? P + 6 : P + 11;
    constexpr bool XIN_F32 = (L == 0 && SUB == 0), XOUT_F32 = (L == DEPTH - 1 && SUB == 1);
    if (PHEN(8) && IN(ph)) {
        PH_LOCALS;
        const int rows_per = T / NGW, r0 = gw * rows_per, b = r0 / SEQ;
        constexpr int ls = 2 * l + sub, lsn = ls + 1;
        const float* gp = MOD + ((size_t)ls * 16 + b) * 3072 + 2048;
        const float* lgp = kin(I_LNG) + ls * 1024, * lbp = kin(I_LNB) + ls * 1024;
        constexpr bool has_nextmod = lsn < 2 * DEPTH;
        const float* nsh = MOD + ((size_t)(has_nextmod ? lsn : 0) * 16 + b) * 3072, * nsc = nsh + 1024;
        f32x4 gt[4], lg[4], lb[4], sh[4], sc[4];
#pragma unroll
        for (int j = 0; j < 4; ++j) { const int o = 4 * (64 * j + lane); gt[j] = *(const f32x4*)(gp + o) + 1.0f; lg[j] = *(const f32x4*)(lgp + o); lb[j] = *(const f32x4*)(lbp + o);
            sh[j] = *(const f32x4*)(nsh + o); sc[j] = *(const f32x4*)(nsc + o) + 1.0f; }
        const float* xin32 = kin(I_X);
        bf16_t* const Xb = (bf16_t*)(ws + WS_XB);
        constexpr bool NEXT_INP8 = ((l + 1) & 1) ? (FP8_INP_ODD != 0) : (FP8_INP_EVEN != 0);
        constexpr int RPI = 2;
        for (int r = (r0 - wave * rows_per) + wave * RPI, rend = (r0 - wave * rows_per) + 8 * rows_per; r < rend; r += 8 * RPI) {
            f32x4 xf[XIN_F32 ? RPI : 1][4]; u32x2 xb[XIN_F32 ? 1 : RPI][4]; u32x2 yv[sub == 0 ? RPI : 1][4]; u32x2 ys[sub == 0 ? 1 : RPI][4][4]; f32x4 gk[RPI];
#pragma unroll
            for (int q = 0; q < RPI; ++q) {
                if constexpr (XIN_F32) { const f32x4* xr = (const f32x4*)(xin32 + (size_t)(r + q) * D) + lane;
#pragma unroll
                    for (int j = 0; j < 4; ++j) xf[q][j] = xr[64 * j]; }
                else { const u32x2* xr = (const u32x2*)(Xb + (size_t)(r + q) * D) + lane;
#pragma unroll
                    for (int j = 0; j < 4; ++j) xb[q][j] = xr[64 * j]; }
                if constexpr (sub == 0) { const u32x2* yr = (const u32x2*)(Yb + (size_t)(r + q) * D) + lane;
#pragma unroll
                    for (int j = 0; j < 4; ++j) yv[q][j] = yr[64 * j]; }
                else { gk[q] = *(const f32x4*)(TOPG + (size_t)(r + q) * 4);
#pragma unroll
                    for (int k = 0; k < 4; ++k) {
                        if (FP8_YS) { const unsigned* yr = (const unsigned*)((const unsigned char*)YSb + ((size_t)(r + q) * 4 + k) * D) + lane;
#pragma unroll
                            for (int j = 0; j < 4; ++j) ys[q][k][j].x = yr[64 * j]; }
                        else { const u32x2* yr = (const u32x2*)(YSb + ((size_t)(r + q) * 4 + k) * D) + lane;
#pragma unroll
                            for (int j = 0; j < 4; ++j) ys[q][k][j] = yr[64 * j]; } } }
            }
            f32x4 v[RPI][4]; float s[RPI];
#pragma unroll
            for (int q = 0; q < RPI; ++q) {
                s[q] = 0.f;
#pragma unroll
                for (int j = 0; j < 4; ++j) {
                    f32x4 y, x;
                    if constexpr (XIN_F32) x = xf[q][j]; else x = (f32x4){bflo(xb[q][j].x), bfhi(xb[q][j].x), bflo(xb[q][j].y), bfhi(xb[q][j].y)};
                    if constexpr (sub == 0) y = (f32x4){bflo(yv[q][j].x), bfhi(yv[q][j].x), bflo(yv[q][j].y), bfhi(yv[q][j].y)};
                    else { y = (f32x4){0.f, 0.f, 0.f, 0.f};
#pragma unroll
                        for (int k = 0; k < 4; ++k) { const u32x2 w = ys[q][k][j];
                            if (FP8_YS) { const f32x2 lo2 = __builtin_amdgcn_cvt_pk_f32_fp8((int)w.x, false), hi2 = __builtin_amdgcn_cvt_pk_f32_fp8((int)w.x, true);
                                y = y + (f32x4){lo2.x, lo2.y, hi2.x, hi2.y} * (gk[q][k] * 0.0625f); }
                            else y = y + (f32x4){bflo(w.x), bfhi(w.x), bflo(w.y), bfhi(w.y)} * gk[q][k]; } }
                    v[q][j] = x * DN_ALPHA + gt[j] * y;
                    s[q] += (v[q][j][0] + v[q][j][1]) + (v[q][j][2] + v[q][j][3]);
                }
            }
#pragma unroll
            for (int o = 1; o < 64; o <<= 1) {
#pragma unroll
                for (int q = 0; q < RPI; ++q) s[q] += __builtin_bit_cast(float, __builtin_amdgcn_ds_bpermute((lane ^ o) << 2, __builtin_bit_cast(int, s[q])));
            }
            float s2[RPI];
#pragma unroll
            for (int q = 0; q < RPI; ++q) { const float mean = s[q] * (1.0f / D); s2[q] = 0.f;
#pragma unroll
                for (int j = 0; j < 4; ++j) { v[q][j] = v[q][j] - mean; s2[q] += (v[q][j][0] * v[q][j][0] + v[q][j][1] * v[q][j][1]) + (v[q][j][2] * v[q][j][2] + v[q][j][3] * v[q][j][3]); } }
#pragma unroll
            for (int o = 1; o < 64; o <<= 1) {
#pragma unroll
                for (int q = 0; q < RPI; ++q) s2[q] += __builtin_bit_cast(float, __builtin_amdgcn_ds_bpermute((lane ^ o) << 2, __builtin_bit_cast(int, s2[q])));
            }
#pragma unroll
            for (int q = 0; q < RPI; ++q) {
                const float rstd = 1.0f / sqrtf(s2[q] * (1.0f / D) + LN_EPS);
                u32x2* hr = (u32x2*)(Hb + (size_t)(r + q) * D) + lane;
#pragma unroll
                for (int j = 0; j < 4; ++j) { const f32x4 xn = v[q][j] * rstd * lg[j] + lb[j];
                    if (XOUT_F32) ((f32x4*)(Xf + (size_t)(r + q) * D) + lane)[64 * j] = xn;
                    else { u32x2 w; w.x = pk2(xn[0], xn[1]); w.y = pk2(xn[2], xn[3]); ((u32x2*)(Xb + (size_t)(r + q) * D) + lane)[64 * j] = w; }
                    if (has_nextmod) { const f32x4 h = xn * sc[j] + sh[j];
                        if (!(NEXT_INP8 && sub == 1) && !(ROUTER_X && sub == 0)) { u32x2 w; w.x = pk2(h[0], h[1]); w.y = pk2(h[2], h[3]); hr[64 * j] = w; }
                        if ((FP8_M1 && sub == 0) || (NEXT_INP8 && sub == 1)) ((unsigned*)(ws + WS_H8 + (size_t)(r + q) * D) + lane)[64 * j] = pk4_fp8(h[0], h[1], h[2], h[3]); } }
            }
        }
        if (ph + 1 < NPH) { if (sub == 0) LSEAM(ph); else SEAM(ph); }
    }
}

template <int L>
__device__ __forceinline__ void layer_body(LAS unsigned char* const lds, volatile LAS unsigned* const LCTL, const int lo, const int hi, const int G, const XcdBarrier& bar, const int wave0) {
    constexpr int l = L;
        const int P = PH_L0 + PH_PER_LAYER * l, jj = l >> 1;
        const bool odd = (l & 1) != 0;
        if (PHEN(2) && IN(P + 0)) {
            PH_LOCALS;
            if (!odd) {
                pg8::DenseSched S; S.init(T, 1536, G, bx);
                if (FP8_INP_EVEN) { pg8::Gemm g{ws + WS_H8, ws + WS_ABIN + (size_t)jj * 1536 * 1024, 1024, 1024, 1024, 122};
                    pg8::EpiDense<0, false, false, true> E{Zb, 1536, nullptr, nullptr, 1.0f / 32.0f};
                    pg8::gemm_phase<true>(lds, g, S, E, wave0); }
                else { pg8::Gemm g{Hb, (const bf16_t*)(ws + WS_ABIN) + (size_t)jj * 1536 * 1024, 1024, 1024, 1024, 127};
                    pg8::EpiDense<0, false, false> E{Zb, 1536, nullptr, nullptr, 0.f};
                    pg8::gemm_phase<false>(lds, g, S, E, wave0); }
            } else {
                pg8::DenseSched S; S.init(T, 2048, G, bx);
                if (FP8_INP_ODD) { pg8::Gemm g{ws + WS_H8, ws + WS_SGIN + (size_t)jj * 2048 * 1024, 1024, 1024, 1024, 122};
                    pg8::EpiDense<1, true, false, true> E{Zb, 2048, kin(I_SGBIN) + jj * 2048, nullptr, 1.0f / 32.0f};
                    pg8::gemm_phase<true>(lds, g, S, E, wave0); }
                else { pg8::Gemm g{Hb, (const bf16_t*)(ws + WS_SGIN) + (size_t)jj * 2048 * 1024, 1024, 1024, 1024, 127};
                    pg8::EpiDense<1, true, false> E{Zb, 2048, kin(I_SGBIN) + jj * 2048, nullptr, 0.f};
                    pg8::gemm_phase<false>(lds, g, S, E, wave0); }
            }
            SEAM(P + 0);
        }
        if (PHEN(3) && !odd && IN(P + 1)) {
            PH_LOCALS;
            const int rows_per = T / NGW, r0 = gw * rows_per;
            const int g4 = lane >> 4, w = 2 << g4;
            float cw[4][8], cb[8];
#pragma unroll
            for (int k = 0; k < 4; ++k)
#pragma unroll
                for (int q = 0; q < 8; ++q) cw[k][q] = kin(I_CONVW)[((size_t)jj * 4 + k) * 512 + 8 * lane + q];
#pragma unroll
            for (int q = 0; q < 8; ++q) cb[q] = kin(I_CONVB)[jj * 512 + 8 * lane + q];
            const int ts0 = r0 & (SEQ - 1);
            u32x4 ring[16], cr[3];
            float sw[8];
#pragma unroll
            for (int q = 0; q < 8; ++q) sw[q] = 0.f;
#pragma unroll
            for (int d = 0; d < 16; ++d) {
                const int k = 15 - d;
                u32x4 v = {0u, 0u, 0u, 0u};
                if (ts0 > d) v = *(const u32x4*)(Zb + (size_t)(r0 - 1 - d) * DINAB + 8 * lane);
                ring[k] = v;
                if (d + 1 < w) { const float f[8] = {bflo(v.x), bfhi(v.x), bflo(v.y), bfhi(v.y), bflo(v.z), bfhi(v.z), bflo(v.w), bfhi(v.w)};
#pragma unroll
                    for (int q = 0; q < 8; ++q) sw[q] += f[q]; }
            }
#pragma unroll
            for (int d = 0; d < 3; ++d) { u32x4 v = {0u, 0u, 0u, 0u}; if (ts0 > d) v = *(const u32x4*)(Zb + (size_t)(r0 - 1 - d) * DINAB + 512 + 8 * lane); cr[2 - d] = v; }
#pragma unroll 1
            for (int rb = 0; rb < rows_per; rb += 16) {
#pragma unroll
                for (int i = 0; i < 16; ++i) {
                    const int r = r0 + rb + i, ts = r & (SEQ - 1);
                    const u32x4 vn = *(const u32x4*)(Zb + (size_t)r * DINAB + 8 * lane), cn = *(const u32x4*)(Zb + (size_t)r * DINAB + 512 + 8 * lane);
                    const u32x4 c2 = ring[(i + 15) & 15], c4 = ring[(i + 13) & 15], c8 = ring[(i + 9) & 15], c16 = ring[(i + 1) & 15];
                    u32x4 vo;
                    vo.x = g4 == 0 ? c2.x : g4 == 1 ? c4.x : g4 == 2 ? c8.x : c16.x; vo.y = g4 == 0 ? c2.y : g4 == 1 ? c4.y : g4 == 2 ? c8.y : c16.y;
                    vo.z = g4 == 0 ? c2.z : g4 == 1 ? c4.z : g4 == 2 ? c8.z : c16.z; vo.w = g4 == 0 ? c2.w : g4 == 1 ? c4.w : g4 == 2 ? c8.w : c16.w;
                    ring[i] = vn;
                    const float fn[8] = {bflo(vn.x), bfhi(vn.x), bflo(vn.y), bfhi(vn.y), bflo(vn.z), bfhi(vn.z), bflo(vn.w), bfhi(vn.w)};
                    const float fo[8] = {bflo(vo.x), bfhi(vo.x), bflo(vo.y), bfhi(vo.y), bflo(vo.z), bfhi(vo.z), bflo(vo.w), bfhi(vo.w)};
                    const int cntw = (ts + 1) < w ? (ts + 1) : w;
                    const float inv = __builtin_amdgcn_rcpf((float)cntw);
                    float pz[8];
#pragma unroll
                    for (int q = 0; q < 8; ++q) { sw[q] += fn[q]; pz[q] = sw[q] * inv - fn[q]; sw[q] -= fo[q]; }
                    u32x4 o; o.x = pk2(pz[0], pz[1]); o.y = pk2(pz[2], pz[3]); o.z = pk2(pz[4], pz[5]); o.w = pk2(pz[6], pz[7]);
                    *(u32x4*)(A2b + (size_t)r * 1024 + 8 * lane) = o;
                    float xc[8];
                    const u32x4 t0 = cr[0], t1 = cr[1], t2 = cr[2];
                    const float f0[8] = {bflo(t0.x), bfhi(t0.x), bflo(t0.y), bfhi(t0.y), bflo(t0.z), bfhi(t0.z), bflo(t0.w), bfhi(t0.w)};
                    const float f1[8] = {bflo(t1.x), bfhi(t1.x), bflo(t1.y), bfhi(t1.y), bflo(t1.z), bfhi(t1.z), bflo(t1.w), bfhi(t1.w)};
                    const float f2[8] = {bflo(t2.x), bfhi(t2.x), bflo(t2.y), bfhi(t2.y), bflo(t2.z), bfhi(t2.z), bflo(t2.w), bfhi(t2.w)};
                    const float f3[8] = {bflo(cn.x), bfhi(cn.x), bflo(cn.y), bfhi(cn.y), bflo(cn.z), bfhi(cn.z), bflo(cn.w), bfhi(cn.w)};
#pragma unroll
                    for (int q = 0; q < 8; ++q) xc[q] = cb[q] + f0[q] * cw[0][q] + f1[q] * cw[1][q] + f2[q] * cw[2][q] + f3[q] * cw[3][q];
                    cr[0] = t1; cr[1] = t2; cr[2] = cn;
                    u32x4 o2; o2.x = pk2(xc[0], xc[1]); o2.y = pk2(xc[2], xc[3]); o2.z = pk2(xc[4], xc[5]); o2.w = pk2(xc[6], xc[7]);
                    *(u32x4*)(A2b + (size_t)r * 1024 + 512 + 8 * lane) = o2;
                }
            }
            LSEAM(P + 1);
        }
        if (PHEN(4) && odd && IN(P + 1)) {
            PH_LOCALS;
            LAS float* STAT = (LAS float*)lds;
            LAS unsigned char* WSS = lds + 1024;
            LAS unsigned char* VT = lds + 1024 + 34816;
            const float* lng = kin(I_SGLNG) + jj * 1024, * lnb = kin(I_SGLNB) + jj * 1024;
            const bf16_t* WSMp = (const bf16_t*)(ws + WS_WSM) + (size_t)jj * 8 * 128 * 128;
            const float* bs = kin(I_SGBS) + jj * 8 * 128;
            const int fr = lane & 15, fq = lane >> 4;
            for (int it = vcu; it < T / 128; it += G) {
                const size_t row0 = (size_t)it * 128;
#pragma unroll 1
                for (int rb = 0; rb < 2; ++rb) {
                    u32x4 a8[8], b8[8];
#pragma unroll
                    for (int q = 0; q < 8; ++q) { const bf16_t* vp = Zb + (row0 + wave * 16 + rb * 8 + q) * 2048 + 1024; a8[q] = *(const u32x4*)(vp + 8 * lane); b8[q] = *(const u32x4*)(vp + 512 + 8 * lane); }
                    float sm[8], sq[8];
#pragma unroll
                    for (int q = 0; q < 8; ++q) {
                        const float f[16] = {bflo(a8[q].x), bfhi(a8[q].x), bflo(a8[q].y), bfhi(a8[q].y), bflo(a8[q].z), bfhi(a8[q].z), bflo(a8[q].w), bfhi(a8[q].w),
                                             bflo(b8[q].x), bfhi(b8[q].x), bflo(b8[q].y), bfhi(b8[q].y), bflo(b8[q].z), bfhi(b8[q].z), bflo(b8[q].w), bfhi(b8[q].w)};
                        float s1 = 0.f, s2 = 0.f;
#pragma unroll
                        for (int e = 0; e < 16; ++e) { s1 += f[e]; s2 += f[e] * f[e]; }
                        sm[q] = s1; sq[q] = s2;
                    }
#pragma unroll
                    for (int o = 1; o < 64; o <<= 1) {
#pragma unroll
                        for (int q = 0; q < 8; ++q) { sm[q] += __builtin_bit_cast(float, __builtin_amdgcn_ds_bpermute((lane ^ o) << 2, __builtin_bit_cast(int, sm[q])));
                            sq[q] += __builtin_bit_cast(float, __builtin_amdgcn_ds_bpermute((lane ^ o) << 2, __builtin_bit_cast(int, sq[q]))); }
                    }
                    if (lane < 8) { float m_ = sm[0], q_ = sq[0];
#pragma unroll
                        for (int q = 1; q < 8; ++q) { m_ = lane == q ? sm[q] : m_; q_ = lane == q ? sq[q] : q_; }
                        const float mean = m_ * (1.0f / 1024.0f), var = fmaxf(q_ * (1.0f / 1024.0f) - mean * mean, 0.f);
                        const int r = wave * 16 + rb * 8 + lane; STAT[2 * r] = mean; STAT[2 * r + 1] = 1.0f / sqrtf(var + LN_EPS); }
                }
                __syncthreads();
                u32x4 wv[4], vv[4];
#pragma unroll
                for (int i = 0; i < 4; ++i) { const int q = tid + 512 * i, row = q >> 4, c16 = q & 15;
                    wv[i] = *(const u32x4*)(WSMp + ((size_t)0 * 128 + row) * 128 + c16 * 8);
                    vv[i] = *(const u32x4*)(Zb + (row0 + row) * 2048 + 1024 + 0 * 128 + c16 * 8); }
#pragma unroll 1
                for (int hd = 0; hd < 8; ++hd) {
#pragma unroll
                    for (int i = 0; i < 4; ++i) {
                        const int q = tid + 512 * i, row = q >> 4, c16 = q & 15;
                        *(LAS u32x4*)(WSS + row * 272 + c16 * 16) = wv[i];
                        const u32x4 v4 = vv[i];
                        const float mean = STAT[2 * row], rstd = STAT[2 * row + 1];
                        const float f[8] = {bflo(v4.x), bfhi(v4.x), bflo(v4.y), bfhi(v4.y), bflo(v4.z), bfhi(v4.z), bflo(v4.w), bfhi(v4.w)};
                        const f32x4 g0 = *(const f32x4*)(lng + hd * 128 + c16 * 8), g1 = *(const f32x4*)(lng + hd * 128 + c16 * 8 + 4);
                        const f32x4 b0 = *(const f32x4*)(lnb + hd * 128 + c16 * 8), b1 = *(const f32x4*)(lnb + hd * 128 + c16 * 8 + 4);
                        const float gg[8] = {g0[0], g0[1], g0[2], g0[3], g1[0], g1[1], g1[2], g1[3]}, bb[8] = {b0[0], b0[1], b0[2], b0[3], b1[0], b1[1], b1[2], b1[3]};
#pragma unroll
                        for (int q2 = 0; q2 < 8; ++q2) {
                            const int c = c16 * 8 + q2;
                            const int rho = (c & ~31) | (((c >> 2) & 1) << 4) | (((c >> 3) & 3) << 2) | (c & 3);
                            *(LAS bf16_t*)(VT + rho * 272 + row * 2) = (bf16_t)f2bf((f[q2] - mean) * rstd * gg[q2] + bb[q2]);
                        }
                    }
                    const int hn = hd < 7 ? hd + 1 : 7;
#pragma unroll
                    for (int i = 0; i < 4; ++i) { const int q = tid + 512 * i, row = q >> 4, c16 = q & 15;
                        wv[i] = *(const u32x4*)(WSMp + ((size_t)hn * 128 + row) * 128 + c16 * 8);
                        vv[i] = *(const u32x4*)(Zb + (row0 + row) * 2048 + 1024 + hn * 128 + c16 * 8); }
                    const int t = 16 * wave + fr; const float bst = bs[hd * 128 + t];
                    const size_t rowg = row0 + t;
                    u32x4 uv[4];
#pragma unroll
                    for (int q = 0; q < 4; ++q) uv[q] = *(const u32x4*)(Zb + rowg * 2048 + hd * 128 + 32 * q + 8 * fq);
                    __syncthreads();
                    bf16x8 afr[4];
#pragma unroll
                    for (int ks = 0; ks < 4; ++ks) afr[ks] = *(const LAS bf16x8*)(WSS + (16 * wave + fr) * 272 + (32 * ks + 8 * fq) * 2);
                    f32x4 acc[8];
#pragma unroll
                    for (int tn = 0; tn < 8; ++tn) { acc[tn] = (f32x4){0.f, 0.f, 0.f, 0.f};
#pragma unroll
                        for (int ks = 0; ks < 4; ++ks) { const bf16x8 vfr = *(const LAS bf16x8*)(VT + (16 * tn + fr) * 272 + (32 * ks + 8 * fq) * 2);
                            acc[tn] = __builtin_amdgcn_mfma_f32_16x16x32_bf16(vfr, afr[ks], acc[tn], 0, 0, 0); } }
#pragma unroll
                    for (int q = 0; q < 4; ++q) {
                        const int c0 = hd * 128 + 32 * q + 8 * fq;
                        const u32x4 u4 = uv[q];
                        const f32x4 s0 = acc[2 * q] + bst, s1 = acc[2 * q + 1] + bst;
                        if (FP8_OUTP) { u32x2 o; o.x = pk4_fp8(bflo(u4.x) * s0[0], bfhi(u4.x) * s0[1], bflo(u4.y) * s0[2], bfhi(u4.y) * s0[3]);
                            o.y = pk4_fp8(bflo(u4.z) * s1[0], bfhi(u4.z) * s1[1], bflo(u4.w) * s1[2], bfhi(u4.w) * s1[3]);
                            *(u32x2*)((unsigned char*)YMb + rowg * 1024 + c0) = o; }
                        else { u32x4 o; o.x = pk2(bflo(u4.x) * s0[0], bfhi(u4.x) * s0[1]); o.y = pk2(bflo(u4.y) * s0[2], bfhi(u4.y) * s0[3]);
                        o.z = pk2(bflo(u4.z) * s1[0], bfhi(u4.z) * s1[1]); o.w = pk2(bflo(u4.w) * s1[2], bfhi(u4.w) * s1[3]);
                        *(u32x4*)(YMb + rowg * 1024 + c0) = o; }
                    }
                    __syncthreads();
                }
            }
            SEAM(P + 1);
        }
        if (PHEN(5) && !odd && IN(P + 2)) {
            PH_LOCALS;
            {
                pg8::Gemm g{A2b, (const bf16_t*)(ws + WS_BPOOL) + (size_t)jj * 512 * 512, 1024, 512, 256, 127};
                pg8::DenseSched S; S.init(T, 512, G, bx); S.kblk = 512; S.rowm = (FUSE_LOCAL && G == 256) ? 1 : 0;
                pg8::EpiDense<0, false, true, false, FP8_OUTP != 0> E{YMb, 1024, nullptr, kin(I_POOLS) + jj * 512, 0.f};
                pg8::gemm_phase<false>(lds, g, S, E, wave0);
            }
            {
                pg8::Gemm g{A2b + 512, (const bf16_t*)(ws + WS_BGATE) + (size_t)jj * 1024 * 512, 1024, 512, 256, 127};
                pg8::DenseSched S; S.init(T, 1024, G, bx); S.kblk = 512; S.rowm = (FUSE_LOCAL && G == 256) ? 1 : 0;
                pg8::EpiDense<2, true, false> E{RIb, 1024, (const float*)(ws + WS_BIASRI) + jj * 1024, nullptr, 0.f};
                pg8::gemm_phase<false>(lds, g, S, E, wave0);
            }
            SEAM(P + 2);
        }
        scan_phase<L, 0>(lo, hi, G, bar, wave0); scan_phase<L, 1>(lo, hi, G, bar, wave0);
        if (PHEN(7) && IN(P + 5)) {
            PH_LOCALS;
            const float* bo = odd ? kin(I_SGBOUT) + jj * 1024 : kin(I_ABBOUT) + jj * 1024;
            pg8::DenseSched S; S.init(T, 1024, G, bx);
            if (FP8_OUTP) { const unsigned char* wt = odd ? ws + WS_SGOUT + (size_t)jj * 1024 * 1024 : ws + WS_ABOUT + (size_t)jj * 1024 * 1024;
                pg8::Gemm g{YMb, wt, 1024, 1024, 1024, 121};
                pg8::EpiDense<0, true, false, true> E{Yb, 1024, bo, nullptr, 1.0f / 64.0f};
                pg8::gemm_phase<true>(lds, g, S, E, wave0); }
            else { const bf16_t* wt = odd ? (const bf16_t*)(ws + WS_SGOUT) + (size_t)jj * 1024 * 1024 : (const bf16_t*)(ws + WS_ABOUT) + (size_t)jj * 1024 * 1024;
                pg8::Gemm g{YMb, wt, 1024, 1024, 1024, 127};
                pg8::EpiDense<0, true, false> E{Yb, 1024, bo, nullptr, 0.f};
                pg8::gemm_phase<false>(lds, g, S, E, wave0); }
            SEAM(P + 5);
        }
        ln_phase<L, 0>(lo, hi, G, bar, wave0);
            if (PHEN(9) && IN(P + 7)) {
            PH_LOCALS;
                pg8::Gemm g{ROUTER_X ? (const bf16_t*)(ws + WS_XB) : Hb, ROUTER_X ? (const bf16_t*)(ws + WS_BRB) + (size_t)l * 16 * 64 * 1024 : (const bf16_t*)(ws + WS_BR) + (size_t)l * 256 * 1024, 1024, 1024, 1024, 127};
                pg8::DenseSched S; S.init(T, 256, G, bx); if (ROUTER_X) S.bb = 64;
                pg8::EpiRouter E{LOGf};
                pg8::gemm_phase<false>(lds, g, S, E, wave0);
                LSEAM(P + 7);
            }
            if (PHEN(10) && IN(P + 8)) {
            PH_LOCALS;
                volatile LAS unsigned* hist = LCTL + 96; volatile LAS unsigned* basev = LCTL + 128;
                unsigned* gcnt = ctl + CW_CNT + 64 * l;
                const int TPB = (FUSE_LOCAL && G == 256) ? 256 : 512;
                for (int t0 = vcu * TPB; t0 < T; t0 += G * TPB) {
                    if (tid < 32) hist[tid] = 0u;
                    __syncthreads();
                    const bool act = tid < TPB;
                    const int tok = t0 + (act ? tid : 0);
                    float lv[32];
                    { const f32x4* lp = (const f32x4*)(LOGf + (size_t)tok * 64);
#pragma unroll
                      for (int q = 0; q < 8; ++q) { const f32x4 a = lp[q], b2 = lp[8 + q], rb = ROUTER_X ? *(const f32x4*)((const float*)(ws + WS_CB) + (l * 16 + (t0 >> 12)) * 32 + 4 * q) : *(const f32x4*)(kin(I_RB) + l * 32 + 4 * q);
                          lv[4 * q + 0] = a[0] + b2[0] + rb[0]; lv[4 * q + 1] = a[1] + b2[1] + rb[1]; lv[4 * q + 2] = a[2] + b2[2] + rb[2]; lv[4 * q + 3] = a[3] + b2[3] + rb[3]; } }
                    float v0 = -3.0e38f, v1 = -3.0e38f, v2 = -3.0e38f, v3 = -3.0e38f; int i0 = 0, i1 = 0, i2 = 0, i3 = 0;
#pragma unroll
                    for (int e = 0; e < 32; ++e) {
                        const float x = lv[e];
                        if (x > v3) {
                            if (x > v0) { v3 = v2; i3 = i2; v2 = v1; i2 = i1; v1 = v0; i1 = i0; v0 = x; i0 = e; }
                            else if (x > v1) { v3 = v2; i3 = i2; v2 = v1; i2 = i1; v1 = x; i1 = e; }
                            else if (x > v2) { v3 = v2; i3 = i2; v2 = x; i2 = e; }
                            else { v3 = x; i3 = e; }
                        }
                    }
                    const float e1 = __expf(v1 - v0), e2 = __expf(v2 - v0), e3 = __expf(v3 - v0), inv = 1.0f / (1.0f + e1 + e2 + e3);
                    if (act) *(f32x4*)(TOPG + (size_t)tok * 4) = (f32x4){inv, e1 * inv, e2 * inv, e3 * inv};
                    LAS unsigned* hp = (LAS unsigned*)hist;
                    unsigned r0 = 0u, r1 = 0u, r2 = 0u, r3 = 0u;
                    if (act) { r0 = __hip_atomic_fetch_add(hp + i0, 1u, __ATOMIC_RELAXED, __HIP_MEMORY_SCOPE_WORKGROUP); r1 = __hip_atomic_fetch_add(hp + i1, 1u, __ATOMIC_RELAXED, __HIP_MEMORY_SCOPE_WORKGROUP);
                        r2 = __hip_atomic_fetch_add(hp + i2, 1u, __ATOMIC_RELAXED, __HIP_MEMORY_SCOPE_WORKGROUP); r3 = __hip_atomic_fetch_add(hp + i3, 1u, __ATOMIC_RELAXED, __HIP_MEMORY_SCOPE_WORKGROUP); }
                    __syncthreads();
                    if (tid < 32) basev[tid] = __hip_atomic_fetch_add(gcnt + tid, hist[tid], __ATOMIC_RELAXED, __HIP_MEMORY_SCOPE_AGENT);
                    __syncthreads();
                    if (act) {
                    LIST[(size_t)i0 * TKTOT + basev[i0] + r0] = tok * 4 + 0;
                    LIST[(size_t)i1 * TKTOT + basev[i1] + r1] = tok * 4 + 1;
                    LIST[(size_t)i2 * TKTOT + basev[i2] + r2] = tok * 4 + 2;
                    LIST[(size_t)i3 * TKTOT + basev[i3] + r3] = tok * 4 + 3; }
                    __syncthreads();
                }
                SEAM(P + 8);
            }
            if (PHEN(11) && IN(P + 9)) {
                PH_LOCALS;
                volatile LAS int* cnts = (volatile LAS int*)(LCTL + 16); volatile LAS int* tstart = (volatile LAS int*)(LCTL + 48);
                if (tid < 32) cnts[tid] = (int)__hip_atomic_load(ctl + CW_CNT + 64 * l + tid, __ATOMIC_RELAXED, __HIP_MEMORY_SCOPE_AGENT);
                __syncthreads();
                if (tid == 0) { int s = 0; for (int e = 0; e < 32; ++e) { tstart[e] = s; s += (cnts[e] + 255) >> 8; } tstart[32] = s; }
                __syncthreads();
                LAS int* const utab = (LAS int*)(lds + UTAB_OFF);
                const int nunits = pg8::moe_build_units(utab, tstart, cnts, 8, G, MOE_PN_FAST ? vcu : bx, tid);
                __syncthreads();
                pg8::MoeSched S{(const LAS int*)utab, LIST, (const float*)(ws + WS_B1P) + (size_t)l * 32 * 2048, nunits, 2048, 2};
                pg8::EpiMoe1<FP8_M2 != 0> E{FP8_M2 ? (bf16_t*)(ws + WS_ACT8) : ACTb, lds, FP8_M1 ? 1.0f / 32.0f : 1.0f};
                if (FP8_M1) { pg8::Gemm g{ws + WS_H8, ws + WS_W1T8 + (size_t)l * 32 * 2048 * 1024, 1024, 1024, 1024, 122};
                    pg8::gemm_phase<true>(lds, g, S, E, wave0); }
                else { pg8::Gemm g{Hb, (const bf16_t*)(ws + WS_W1T) + (size_t)l * 32 * 2048 * 1024, 1024, 1024, 1024, 127};
                    pg8::gemm_phase<false>(lds, g, S, E, wave0); }
                SEAM(P + 9);
            }
            if (PHEN(12) && IN(P + 10)) {
                PH_LOCALS;
                volatile LAS int* cnts = (volatile LAS int*)(LCTL + 16); volatile LAS int* tstart = (volatile LAS int*)(LCTL + 48);
                __syncthreads();
                if (tid < 32) cnts[tid] = (int)__hip_atomic_load(ctl + CW_CNT + 64 * l + tid, __ATOMIC_RELAXED, __HIP_MEMORY_SCOPE_AGENT);
                __syncthreads();
                if (tid == 0) { int s = 0; for (int e = 0; e < 32; ++e) { tstart[e] = s; s += (cnts[e] + 255) >> 8; } tstart[32] = s; }
                __syncthreads();
                LAS int* const utab = (LAS int*)(lds + UTAB_OFF);
                const int nunits = pg8::moe_build_units(utab, tstart, cnts, 4, G, MOE_PN_FAST ? vcu : bx, tid);
                __syncthreads();
                pg8::MoeSched S{(const LAS int*)utab, LIST, kin(I_B2) + (size_t)l * 32 * 1024, nunits, 1024, 0};
                pg8::EpiMoe2 E{YSb, lds, FP8_M2 ? 1.0f / 64.0f : 1.0f};
                if (FP8_M2) { pg8::Gemm g{ws + WS_ACT8, ws + WS_W2T8 + (size_t)l * 32 * 1024 * 1024, 1024, 1024, 1024, 121};
                    pg8::gemm_phase<true>(lds, g, S, E, wave0); }
                else { pg8::Gemm g{ACTb, (const bf16_t*)(ws + WS_W2T) + (size_t)l * 32 * 1024 * 1024, 1024, 1024, 1024, 127};
                    pg8::gemm_phase<false>(lds, g, S, E, wave0); }
                SEAM(P + 10);
            }
        ln_phase<L, 1>(lo, hi, G, bar, wave0);
}

__global__ void __launch_bounds__(512, 2) fwd_kernel(Args args) {
    extern __shared__ __attribute__((aligned(16))) unsigned char lds_raw[];
    LAS unsigned char* const lds = (LAS unsigned char*)lds_raw;
    volatile LAS unsigned* const LCTL = (volatile LAS unsigned*)(lds + LDSCTL_OFF);
    const int G = gridDim.x;
    int lo, hi; unsigned* ctl0;
    { kptr_t kp = (kptr_t)__builtin_amdgcn_kernarg_segment_ptr(); lo = *(const __attribute__((address_space(4))) int*)(kp + 272); hi = *(const __attribute__((address_space(4))) int*)(kp + 276);
      ctl0 = (unsigned*)(*(unsigned char* const __attribute__((address_space(4)))*)(kp + 264) + WS_CTL); }
    const int wave0 = __builtin_amdgcn_readfirstlane((int)threadIdx.x >> 6);
    for (int u = threadIdx.x; u < (LDS_BYTES - LDSCTL_OFF) / 4; u += 512) LCTL[u] = 0u;
    __syncthreads();
    XcdBarrier bar; bar.bar = ctl0 + CW_BAR; bar.x = 0; bar.st = LCTL; bar.wv = wave0;
    if (hi - lo > 1) bar = xcd_barrier_post(ctl0 + CW_BAR, LCTL, wave0);
    if (PHEN(0) && IN(PH_CONV)) {
            PH_LOCALS;
        {
            LAS float* cact = (LAS float*)lds;
            LAS float* part = (LAS float*)(lds + 65536);
            if (bx < 384) {
                for (int i = tid; i < 16 * 1024; i += 512) { const float c = kin(I_C)[i]; cact[i] = c / (1.0f + __expf(-c)); }
                __syncthreads();
                for (int it = bx; it < 384; it += G) {
                    const int ls = it / 48, col0 = (it % 48) * 64;
                    const int kq = tid >> 6, cl = tid & 63;
                    const float* wp = kin(I_MODW) + (size_t)ls * 1024 * 3072 + col0 + cl;
                    float a[16];
#pragma unroll
                    for (int b = 0; b < 16; ++b) a[b] = 0.f;
#pragma unroll 4
                    for (int k = kq * 128; k < kq * 128 + 128; ++k) {
                        const float w = wp[(size_t)k * 3072];
#pragma unroll
                        for (int b = 0; b < 16; ++b) a[b] += cact[b * 1024 + k] * w;
                    }
#pragma unroll
                    for (int b = 0; b < 16; ++b) part[(kq * 16 + b) * 64 + cl] = a[b];
                    __syncthreads();
                    for (int o = tid; o < 1024; o += 512) {
                        const int b = o >> 6, c2 = o & 63; float s = 0.f;
#pragma unroll
                        for (int q = 0; q < 8; ++q) s += part[(q * 16 + b) * 64 + c2];
                        MOD[((size_t)ls * 16 + b) * 3072 + col0 + c2] = s + kin(I_MODB)[ls * 3072 + col0 + c2];
                    }
                    __syncthreads();
                }
            }
        }
        {
            constexpr int IT_ABIN = 2 * (FP8_INP_EVEN ? 8 : 16) * 48, IT_ABOUT = 2 * (FP8_OUTP ? 8 : 16) * 32, IT_SGIN = 2 * (FP8_INP_ODD ? 8 : 16) * 64, IT_SGOUT = 2 * (FP8_OUTP ? 8 : 16) * 32, IT_W1 = 128 * (FP8_M1 ? 8 : 16) * 64, IT_W2 = 128 * (FP8_M2 ? 8 : 16) * 32;
            constexpr int IT_ALL = IT_ABIN + IT_ABOUT + IT_SGIN + IT_SGOUT + IT_W1 + IT_W2;
            for (int it = gw; it < IT_ALL; it += NGW) {
                int r = it;
                if (r < IT_ABIN) { if (FP8_INP_EVEN) { const int mat = r / (8 * 48); conv_item_f8<false>(kin(I_ABWIN) + (size_t)mat * 1024 * 1536, 1536, ws + WS_ABIN + (size_t)mat * 1536 * 1024, r % (8 * 48), lane, 32.0f); }
                    else { const int mat = r / (16 * 48); conv_item<false>(kin(I_ABWIN) + (size_t)mat * 1024 * 1536, 1536, (bf16_t*)(ws + WS_ABIN) + (size_t)mat * 1536 * 1024, r % (16 * 48), lane); } continue; } r -= IT_ABIN;
                if (r < IT_ABOUT) { if (FP8_OUTP) { const int mat = r / (8 * 32); conv_item_f8<false>(kin(I_ABWOUT) + (size_t)mat * 1024 * 1024, 1024, ws + WS_ABOUT + (size_t)mat * 1024 * 1024, r % (8 * 32), lane, 64.0f); }
                    else { const int mat = r / (16 * 32); conv_item<false>(kin(I_ABWOUT) + (size_t)mat * 1024 * 1024, 1024, (bf16_t*)(ws + WS_ABOUT) + (size_t)mat * 1024 * 1024, r % (16 * 32), lane); } continue; } r -= IT_ABOUT;
                if (r < IT_SGIN) { if (FP8_INP_ODD) { const int mat = r / (8 * 64); conv_item_f8<false>(kin(I_SGWIN) + (size_t)mat * 1024 * 2048, 2048, ws + WS_SGIN + (size_t)mat * 2048 * 1024, r % (8 * 64), lane, 32.0f); }
                    else { const int mat = r / (16 * 64); conv_item<false>(kin(I_SGWIN) + (size_t)mat * 1024 * 2048, 2048, (bf16_t*)(ws + WS_SGIN) + (size_t)mat * 2048 * 1024, r % (16 * 64), lane); } continue; } r -= IT_SGIN;
                if (r < IT_SGOUT) { if (FP8_OUTP) { const int mat = r / (8 * 32); conv_item_f8<false>(kin(I_SGWOUT) + (size_t)mat * 1024 * 1024, 1024, ws + WS_SGOUT + (size_t)mat * 1024 * 1024, r % (8 * 32), lane, 64.0f); }
                    else { const int mat = r / (16 * 32); conv_item<false>(kin(I_SGWOUT) + (size_t)mat * 1024 * 1024, 1024, (bf16_t*)(ws + WS_SGOUT) + (size_t)mat * 1024 * 1024, r % (16 * 32), lane); } continue; } r -= IT_SGOUT;
                if (r < IT_W1) {
                    if (FP8_M1) { const int mat = r / (8 * 64); conv_item_f8<true>(kin(I_W1) + (size_t)mat * 1024 * 2048, 2048, ws + WS_W1T8 + (size_t)mat * 2048 * 1024, r % (8 * 64), lane, 32.0f); }
                    else { const int mat = r / (16 * 64); conv_item<true>(kin(I_W1) + (size_t)mat * 1024 * 2048, 2048, (bf16_t*)(ws + WS_W1T) + (size_t)mat * 2048 * 1024, r % (16 * 64), lane); }
                    continue; } r -= IT_W1;
                if (FP8_M2) { const int mat = r / (8 * 32); conv_item_f8<false>(kin(I_W2) + (size_t)mat * 1024 * 1024, 1024, ws + WS_W2T8 + (size_t)mat * 1024 * 1024, r % (8 * 32), lane, 64.0f); }
                else { const int mat = r / (16 * 32); conv_item<false>(kin(I_W2) + (size_t)mat * 1024 * 1024, 1024, (bf16_t*)(ws + WS_W2T) + (size_t)mat * 1024 * 1024, r % (16 * 32), lane); }
            }
        }
        {
            const int gt = vcu * 512 + tid, NGT = G * 512;
            bf16_t* BR = (bf16_t*)(ws + WS_BR);
            if (!ROUTER_X) for (int i = gt; i < 4 * 256 * 1024; i += NGT) {
                const int l = i >> 18, n = (i >> 10) & 255, k = i & 1023; unsigned v = 0;
                if (n < 64) { const float w = kin(I_RW)[((size_t)l * 1024 + k) * 32 + (n & 31)]; const unsigned h = f2bf(w); v = h;
                    if (n >= 32) v = f2bf(w - __builtin_bit_cast(float, h << 16)); }
                BR[i] = (bf16_t)v;
            }
            bf16_t* BP = (bf16_t*)(ws + WS_BPOOL);
            for (int i = gt; i < 2 * 512 * 512; i += NGT) {
                const int j = i >> 18, n = (i >> 9) & 511, k = i & 511; unsigned v = 0;
                if ((n >> 7) == (k >> 7)) v = f2bf(kin(I_POOLW)[(((size_t)j * 4 + (n >> 7)) * 128 + (k & 127)) * 128 + (n & 127)]);
                BP[i] = (bf16_t)v;
            }
            bf16_t* BG = (bf16_t*)(ws + WS_BGATE);
            for (int i = gt; i < 2 * 1024 * 512; i += NGT) {
                const int j = i >> 19, n = (i >> 9) & 1023, k = i & 511; unsigned v = 0; const int nn = n & 511;
                if ((nn >> 6) == (k >> 6)) { const float* w = (n < 512) ? kin(I_WA) : kin(I_WX); v = f2bf(w[(((size_t)j * 8 + (nn >> 6)) * 64 + (k & 63)) * 64 + (nn & 63)]); }
                BG[i] = (bf16_t)v;
            }
            bf16_t* WSMp = (bf16_t*)(ws + WS_WSM);
            for (int i = gt; i < 2 * 8 * 128 * 128; i += NGT) {
                const int t = (i >> 7) & 127, s = i & 127; WSMp[i] = (bf16_t)((s <= t) ? f2bf(kin(I_SGWS)[i]) : 0u);
            }
            float* BRI = (float*)(ws + WS_BIASRI);
            for (int i = gt; i < 2 * 1024; i += NGT) { const int j = i >> 10, n = i & 1023; BRI[i] = (n < 512) ? kin(I_BA)[j * 512 + n] : kin(I_BX)[j * 512 + n - 512]; }
            float* B1P = (float*)(ws + WS_B1P);
            for (int i = gt; i < 4 * 32 * 2048; i += NGT) { const int le = i >> 11, rho = i & 2047; B1P[i] = kin(I_B1)[(size_t)le * 2048 + w1_n_of_rho(rho)]; }
        }
        SEAM(PH_CONV);
    }

    if (PHEN(1) && IN(PH_H0)) {
            PH_LOCALS;
        const int rows_per = T / NGW, r0 = gw * rows_per;
        const int b = r0 / SEQ;
        const float* shp = MOD + ((size_t)0 * 16 + b) * 3072, * scp = shp + 1024;
        f32x4 sh[4], sc[4];
#pragma unroll
        for (int j = 0; j < 4; ++j) { sh[j] = *(const f32x4*)(shp + 4 * (64 * j + lane)); sc[j] = *(const f32x4*)(scp + 4 * (64 * j + lane)); }
        for (int r = r0; r < r0 + rows_per; ++r) {
            const f32x4* xr = (const f32x4*)(kin(I_X) + (size_t)r * D) + lane;
            u32x2* hr = (u32x2*)(Hb + (size_t)r * D) + lane;
#pragma unroll
            for (int j = 0; j < 4; ++j) { const f32x4 v = xr[64 * j]; const f32x4 h = v * (sc[j] + 1.0f) + sh[j];
                if (FP8_INP_EVEN) ((unsigned*)(ws + WS_H8 + (size_t)r * D) + lane)[64 * j] = pk4_fp8(h[0], h[1], h[2], h[3]);
                else { u32x2 w; w.x = pk2(h[0], h[1]); w.y = pk2(h[2], h[3]); hr[64 * j] = w; } }
        }
        if (ROUTER_X) {
            bf16_t* BRB = (bf16_t*)(ws + WS_BRB);
            const float* rwp = kin(I_RW);
            for (int i = vcu * 512 + tid; i < 4 * 32 * 1024; i += G * 512) {
                const int l = i >> 15, e = (i >> 10) & 31, k = i & 1023;
                const float w = rwp[((size_t)l * 1024 + k) * 32 + e];
#pragma unroll 4
                for (int bq = 0; bq < 16; ++bq) {
                    const float wm = w * (1.0f + MOD[((size_t)(2 * l + 1) * 16 + bq) * 3072 + 1024 + k]);
                    const unsigned h = f2bf(wm), lo2 = f2bf(wm - __builtin_bit_cast(float, h << 16));
                    bf16_t* o = BRB + (((size_t)l * 16 + bq) * 64 + e) * 1024 + k; o[0] = (bf16_t)h; o[32 * 1024] = (bf16_t)lo2; }
            }
            for (int i = vcu * 512 + tid; i < 192 * 1024 / 2; i += G * 512) ((unsigned*)(BRB + (size_t)4 * 16 * 64 * 1024))[i] = 0u;
            const int it = vcu + G * wave;
            if (it < 512) {
                const int l = it >> 7, bq = (it >> 3) & 15, eq = it & 7;
                const float* shq = MOD + ((size_t)(2 * l + 1) * 16 + bq) * 3072;
                const f32x4* rw4 = (const f32x4*)(kin(I_RW) + (size_t)l * 1024 * 32) + eq;
                float sa[4] = {0.f, 0.f, 0.f, 0.f};
#pragma unroll
                for (int i2 = 0; i2 < 16; ++i2) { const int k = lane + 64 * i2; const f32x4 wv4 = rw4[(size_t)k * 8]; const float sk = shq[k]; sa[0] += wv4[0] * sk; sa[1] += wv4[1] * sk; sa[2] += wv4[2] * sk; sa[3] += wv4[3] * sk; }
#pragma unroll
                for (int o = 1; o < 64; o <<= 1) {
#pragma unroll
                    for (int c4 = 0; c4 < 4; ++c4) sa[c4] += __builtin_bit_cast(float, __builtin_amdgcn_ds_bpermute((lane ^ o) << 2, __builtin_bit_cast(int, sa[c4])));
                }
                const f32x4 rb4 = *(const f32x4*)(kin(I_RB) + l * 32 + 4 * eq);
                *(f32x4*)((float*)(ws + WS_CB) + (l * 16 + bq) * 32 + 4 * eq) = (f32x4){sa[0] + rb4[0], sa[1] + rb4[1], sa[2] + rb4[2], sa[3] + rb4[3]};
            }
        }
        SEAM(PH_H0);
    }

    layer_body<0>(lds, LCTL, lo, hi, G, bar, wave0); layer_body<1>(lds, LCTL, lo, hi, G, bar, wave0); layer_body<2>(lds, LCTL, lo, hi, G, bar, wave0); layer_body<3>(lds, LCTL, lo, hi, G, bar, wave0);
}
#undef IN
#undef SEAM

#ifdef DUMP_SPEC
struct DumpSrc { size_t off; int ld; int col0; };
__global__ void dump_kernel(const unsigned char* ws, float* out) {
    const DumpSrc srcs[8] = DUMP_SPEC;
    const size_t i = (size_t)blockIdx.x * blockDim.x + threadIdx.x;
    const int r = (int)(i >> 10), c = (int)(i & 1023), blk = c >> 7, cc = c & 127;
    const DumpSrc d = srcs[blk];
    const bf16_t* p = (const bf16_t*)(ws + d.off);
    out[i] = bf2f(p[(size_t)r * d.ld + d.col0 + cc]);
}
#endif
extern "C" void kernel_launch(void* const* d_in, const int* in_sizes, int n_in, void* d_out, int out_size, void* d_ws, size_t ws_size, hipStream_t stream) {
    static int grid = 0;
    if (grid == 0) {
        if (n_in != 32 || out_size != T * D || ws_size < WS_END) { fprintf(stderr, "kernel_launch: unexpected problem (n_in %d, out %d, ws %zu)\n", n_in, out_size, ws_size); grid = -1; return; }
        int dev = 0, cus = 0, per_cu = 0;
        if (hipGetDevice(&dev) != hipSuccess || hipDeviceGetAttribute(&cus, hipDeviceAttributeMultiprocessorCount, dev) != hipSuccess) { grid = -1; return; }
        if (hipFuncSetAttribute((const void*)fwd_kernel, hipFuncAttributeMaxDynamicSharedMemorySize, LDS_BYTES) != hipSuccess) { fprintf(stderr, "kernel_launch: hipFuncSetAttribute failed\n"); grid = -1; return; }
        if (hipOccupancyMaxActiveBlocksPerMultiprocessor(&per_cu, (const void*)fwd_kernel, 512, LDS_BYTES) != hipSuccess || per_cu < 1) fprintf(stderr, "kernel_launch: occupancy query says %d\n", per_cu);
        (void)hipGetLastError();
        grid = cus;
        if (grid * 8 > T || (T % (grid * 8)) != 0) { fprintf(stderr, "kernel_launch: grid %d does not divide the rows\n", grid); grid = -1; return; }
    }
    if (grid < 0) return;
    (void)hipMemsetAsync((char*)d_ws + WS_CTL, 0, CTL_ZERO_BYTES, stream);
    Args a{};
    for (int i = 0; i < 32; ++i) a.in[i] = (const float*)d_in[i];
    a.out = (float*)d_out; a.ws = (unsigned char*)d_ws;
#if MK_ONE_LAUNCH
    a.ph_lo = 0; a.ph_hi = NPH;
    hipLaunchKernelGGL(fwd_kernel, dim3(grid), dim3(512), LDS_BYTES, stream, a);
#else
#ifndef STOP_PH
#define STOP_PH NPH
#endif
    for (int ph = 0; ph < STOP_PH; ++ph) {
        if (!phase_exists(ph)) continue;
        a.ph_lo = ph; a.ph_hi = ph + 1;
        hipLaunchKernelGGL(fwd_kernel, dim3(grid), dim3(512), LDS_BYTES, stream, a);
#ifdef REP_SLOTS
        { const int slot = ph < PH_L0 ? ph : 2 + (ph - PH_L0) % PH_PER_LAYER; if ((REP_SLOTS >> slot) & 1) {
#ifdef PROBE_VARIANTS
            a.variant = PROBE_VARIANTS;
#endif
            hipLaunchKernelGGL(fwd_kernel, dim3(grid), dim3(512), LDS_BYTES, stream, a); a.variant = 0; } }
#endif
    }
#ifdef DUMP_SPEC
    hipLaunchKernelGGL(dump_kernel, dim3(T * 1024 / 256), dim3(256), 0, stream, (const unsigned char*)d_ws, (float*)d_out);
#endif
#endif
}
```

```cpp
#include <hip/hip_runtime.h>
#include <cstdio>
#include <cstdint>

#ifndef PIN_ACC
#define PIN_ACC 0
#endif
#ifndef FP8_M1
#define FP8_M1 1
#endif
#ifndef FP8_M2
#define FP8_M2 1
#endif
#ifndef FP8_YS
#define FP8_INP_EVEN 0
#define FP8_INP_ODD 1
#define FP8_OUTP 1
#define WIDE_EPI 1
#define MOE_PN_FAST 1
#define MOE_XCD_OWN 1
#define FUSE_LOCAL 1
#define ROUTER_X 1
#define FP8_YS 1
#endif
#ifndef MK_ONE_LAUNCH
#define MK_ONE_LAUNCH 1
#endif

#ifndef PHMASK
#define PHMASK 0xFFFFF
#endif
#define PHEN(k) (((PHMASK) >> (k)) & 1)
#define LAS __attribute__((address_space(3)))
#define GAS __attribute__((address_space(1)))
typedef unsigned short bf16_t;
typedef short bf16x8 __attribute__((ext_vector_type(8)));
typedef float f32x4 __attribute__((ext_vector_type(4)));
typedef float f32x2 __attribute__((ext_vector_type(2)));
typedef unsigned u32x4 __attribute__((ext_vector_type(4)));
typedef unsigned u32x2 __attribute__((ext_vector_type(2)));

constexpr int D = 1024, NBATCH = 16, SEQ = 4096, T = NBATCH * SEQ, DEPTH = 4;
constexpr int NE = 32, TOPK = 4, TKTOT = T * TOPK;
constexpr int DPOOL = 512, DREC = 512, DINAB = 1536;
constexpr float LN_EPS = 1e-5f;
constexpr float DN_ALPHA = 1.6817928305074292f;

constexpr size_t MiB = 1ull << 20;
constexpr size_t WS_CTL = 0, CTL_ZERO_BYTES = 1 * MiB;
constexpr size_t WS_MOD = 1 * MiB;
constexpr size_t WS_BR = 3 * MiB;
constexpr size_t WS_BPOOL = 5 * MiB;
constexpr size_t WS_BGATE = 6 * MiB;
constexpr size_t WS_WSM = 8 * MiB;
constexpr size_t WS_BIASRI = 8 * MiB + 512 * 1024;
constexpr size_t WS_B1P = 9 * MiB;
constexpr size_t WS_SUMM = 10 * MiB;
constexpr size_t WS_TOPG = 12 * MiB;
constexpr size_t WS_ABIN = 16 * MiB;
constexpr size_t WS_ABOUT = 22 * MiB;
constexpr size_t WS_SGIN = 26 * MiB;
constexpr size_t WS_SGOUT = 34 * MiB;
constexpr size_t WS_LOG = 40 * MiB;
constexpr size_t WS_LIST = 64 * MiB;
constexpr size_t WS_BRB = 128 * MiB;
constexpr size_t WS_CB = 140 * MiB;
constexpr size_t WS_W1T = 128 * MiB;
constexpr size_t WS_W2T = 640 * MiB;
constexpr size_t WS_H = 896 * MiB;
constexpr size_t WS_Z = 1024 * MiB;
constexpr size_t WS_A2 = 1280 * MiB;
constexpr size_t WS_RI = 1408 * MiB;
constexpr size_t WS_YMIX = 1536 * MiB;
constexpr size_t WS_Y = 1664 * MiB;
constexpr size_t WS_ACT = 1792 * MiB;
constexpr size_t WS_YS = 2304 * MiB;
constexpr size_t WS_W1T8 = 2944 * MiB;
constexpr size_t WS_W2T8 = 3200 * MiB;
constexpr size_t WS_H8 = 3328 * MiB;
constexpr size_t WS_ACT8 = 3392 * MiB;
constexpr size_t WS_XB = 2816 * MiB;
constexpr size_t WS_END = 3648 * MiB;

constexpr int CW_BAR = 4096;
constexpr int CW_CNT = 16384;

constexpr int PH_CONV = 0, PH_H0 = 1, PH_L0 = 2, PH_PER_LAYER = 12, NPH = PH_L0 + PH_PER_LAYER * DEPTH;
__host__ __device__ constexpr bool phase_exists(int ph) {
    if (ph < PH_L0) return true;
    const int l = (ph - PH_L0) / PH_PER_LAYER, s = (ph - PH_L0) % PH_PER_LAYER;
    if ((l & 1) && (s == 2 || s == 3 || s == 4)) return false;
    return true;
}

constexpr int LDS_BYTES = 155648;
constexpr int LDSCTL_OFF = 154624;
constexpr int NXT_OFF = 131072;
constexpr int TAB_OFF = 147456;
constexpr int UTAB_OFF = 153600;

__device__ __forceinline__ unsigned f2bf(float f) { unsigned u = __builtin_bit_cast(unsigned, f); return (u + 0x7fffu + ((u >> 16) & 1u)) >> 16; }
typedef __bf16 bf16v2_t __attribute__((ext_vector_type(2)));
__device__ __forceinline__ unsigned pk2(float lo, float hi) { const f32x2 f = {lo, hi}; return __builtin_bit_cast(unsigned, __builtin_convertvector(f, bf16v2_t)); }
__device__ __forceinline__ float bflo(unsigned w) { return __builtin_bit_cast(float, w << 16); }
__device__ __forceinline__ float bfhi(unsigned w) { return __builtin_bit_cast(float, w & 0xffff0000u); }
__device__ __forceinline__ float bf2f(bf16_t h) { return __builtin_bit_cast(float, ((unsigned)h) << 16); }
__device__ __forceinline__ unsigned cvt_pk_bf16(float lo, float hi) { return pk2(lo, hi); }
__device__ __forceinline__ unsigned pk4_fp8(float a, float b, float c, float d) { int w = 0; w = __builtin_amdgcn_cvt_pk_fp8_f32(a, b, w, false); w = __builtin_amdgcn_cvt_pk_fp8_f32(c, d, w, true); return (unsigned)w; }
__device__ __forceinline__ float fast_sigmoid(float x) { return __builtin_amdgcn_rcpf(1.0f + __builtin_amdgcn_exp2f(-1.4426950408889634f * x)); }
__device__ __forceinline__ float gelu_tanh(float x) { const float u = x * (1.5957691216057308f + 0.07135481627362202f * x * x); return x * fast_sigmoid(u); }
__device__ __forceinline__ f32x2 pk_sigmoid_scaled(f32x2 x, float nk) {
    const f32x2 t = x * nk; f32x2 e; e.x = __builtin_amdgcn_exp2f(t.x); e.y = __builtin_amdgcn_exp2f(t.y);
    const f32x2 d = e + 1.0f; f32x2 r; r.x = __builtin_amdgcn_rcpf(d.x); r.y = __builtin_amdgcn_rcpf(d.y); return r; }
__device__ __forceinline__ f32x2 pk_gelu_tanh(f32x2 x) {
    const f32x2 t = x * ((x * x) * (-0.07135481627362202f * 1.4426950408889634f) + (-1.5957691216057308f * 1.4426950408889634f));
    f32x2 e; e.x = __builtin_amdgcn_exp2f(t.x); e.y = __builtin_amdgcn_exp2f(t.y);
    const f32x2 d = e + 1.0f; f32x2 r; r.x = __builtin_amdgcn_rcpf(d.x); r.y = __builtin_amdgcn_rcpf(d.y); return x * r; }
__device__ __forceinline__ float wave_sum(float v, int lane) {
#pragma unroll
    for (int o = 1; o < 64; o <<= 1) v += __builtin_bit_cast(float, __builtin_amdgcn_ds_bpermute((lane ^ o) << 2, __builtin_bit_cast(int, v)));
    return v;
}

__device__ __forceinline__ int lane_id_asm() { int l; asm volatile("v_mbcnt_lo_u32_b32 %0, -1, 0\n\tv_mbcnt_hi_u32_b32 %0, -1, %0" : "=v"(l)); return l; }
#define XB_TMO      128
#define XB_XCNT(j)  (256  + 64 * (j))
#define XB_XSUB(j)  (1280 + 64 * (j))
#define XB_XGEN(j)  (2304 + 64 * (j))
#define XB_TOP      3328
#define XB_TOPGEN   3392
#define XCD_BAR_WORDS 3456
#define XB_SPIN_CAP (1u << 18)

__device__ __forceinline__ unsigned xb_ld(unsigned* p)              { return __hip_atomic_load(p, __ATOMIC_RELAXED, __HIP_MEMORY_SCOPE_AGENT); }
__device__ __forceinline__ unsigned xb_add(unsigned* p, unsigned v) { return __hip_atomic_fetch_add(p, v, __ATOMIC_RELAXED, __HIP_MEMORY_SCOPE_AGENT); }
__device__ __forceinline__ unsigned xb_xcc_id() { return (unsigned)__builtin_amdgcn_s_getreg((3 << 11) | 20) & 0xFu; }
#define XB_SPIN(cond, bar) do { unsigned _sp = 0; while (cond) { __builtin_amdgcn_s_sleep(1); \
    if ((++_sp & 255u) == 0u) { if (xb_ld(&(bar)[XB_TMO])) break; if (_sp > XB_SPIN_CAP) { atomicAdd(&(bar)[XB_TMO], 1u); break; } } } } while (0)

struct XcdBarrier {
    unsigned* bar; unsigned x; int wv;
    volatile LAS unsigned* st;
};

__device__ __forceinline__ XcdBarrier xcd_barrier_post(unsigned* bar, volatile LAS unsigned* st, int wv) {
    XcdBarrier b; b.bar = bar; b.x = xb_xcc_id(); b.st = st; b.wv = wv;
    if (wv == 0 && lane_id_asm() == 0) (void)xb_add(&bar[XB_XCNT(b.x)], 1u);
    return b;
}
__device__ __forceinline__ void xcd_barrier_complete(unsigned* bar, unsigned x, unsigned& nloc, unsigned& nx) {
    const unsigned G = gridDim.x * gridDim.y * gridDim.z;
    unsigned sum, cnt, mine, sp = 0u;
    for (;;) {
        sum = 0u; cnt = 0u; mine = 0u;
#pragma unroll
        for (unsigned j = 0; j < 16; ++j) { const unsigned c = xb_ld(&bar[XB_XCNT(j)]); sum += c; cnt += (c > 0u) ? 1u : 0u; mine = (j == x) ? c : mine; }
        if (sum == G) break;
        __builtin_amdgcn_s_sleep(1);
        if ((++sp & 255u) == 0u) { if (xb_ld(&bar[XB_TMO])) break; if (sp > XB_SPIN_CAP) { atomicAdd(&bar[XB_TMO], 1u); break; } }
    }
    nloc = mine > 0u ? mine : 1u; nx = cnt > 0u ? cnt : 1u;
}

__device__ __forceinline__ void xcd_barrier(const XcdBarrier& b) {
    asm volatile("s_waitcnt vmcnt(0)" ::: "memory");
    __syncthreads();
    if (b.wv == 0 && lane_id_asm() == 0) {
        unsigned* bar = b.bar;
        __builtin_amdgcn_s_waitcnt(0);
        unsigned nloc = b.st[0], nx = b.st[1];
        if (nloc == 0u) { xcd_barrier_complete(bar, b.x, nloc, nx); b.st[0] = nloc; b.st[1] = nx; }
        const unsigned old = xb_add(&bar[XB_XSUB(b.x)], 1u);
        const unsigned gen = old / nloc;
        if (old + 1u == (gen + 1u) * nloc) {
            __builtin_amdgcn_fence(__ATOMIC_RELEASE, "agent");
            asm volatile("s_waitcnt vmcnt(0)" ::: "memory");
            const unsigned og = xb_add(&bar[XB_TOP], 1u);
            const unsigned tg = og / nx;
            if (og + 1u == (tg + 1u) * nx) xb_add(&bar[XB_TOPGEN], 1u);
            else XB_SPIN(xb_ld(&bar[XB_TOPGEN]) == tg, bar);
            __builtin_amdgcn_fence(__ATOMIC_ACQUIRE, "agent");
            xb_add(&bar[XB_XGEN(b.x)], 1u);
            asm volatile("s_waitcnt vmcnt(0)" ::: "memory");
        } else {
            XB_SPIN(xb_ld(&bar[XB_XGEN(b.x)]) == gen, bar);
            __builtin_amdgcn_fence(__ATOMIC_ACQUIRE, "agent");
            asm volatile("s_waitcnt vmcnt(0)" ::: "memory");
        }
    }
    __syncthreads();
}

#ifdef PROBE_VARIANTS
__device__ __forceinline__ int kvariant() { return *(const __attribute__((address_space(4))) int*)((const __attribute__((address_space(4))) unsigned char*)__builtin_amdgcn_kernarg_segment_ptr() + 280); }
#endif
__device__ __forceinline__ void glds16(const char* sbase, unsigned voff, unsigned lds_dst) {
    unsigned keep;
    asm volatile("s_mov_b32 %0, m0\n\ts_mov_b32 m0, %3\n\ts_nop 0\n\tglobal_load_lds_dwordx4 %1, %2\n\ts_mov_b32 m0, %0" : "=&s"(keep) : "v"(voff), "s"(sbase), "s"(lds_dst) : "memory");
}
__device__ __forceinline__ void glds4(const char* sbase, unsigned voff, unsigned lds_dst) {
    unsigned keep;
    asm volatile("s_mov_b32 %0, m0\n\ts_mov_b32 m0, %3\n\ts_nop 0\n\tglobal_load_lds_dword %1, %2\n\ts_mov_b32 m0, %0" : "=&s"(keep) : "v"(voff), "s"(sbase), "s"(lds_dst) : "memory");
}
namespace pg8 {
constexpr int BM = 256, BK = 64, HALF = 128, HTB = HALF * BK * 2, STAGE_BYTES = 8 * HTB, NXCD = 8, WGM = 8;
__host__ __device__ __forceinline__ int perm32(int rho) { const int n = rho >> 4, i = rho & 15; return 8 * (i >> 2) + 4 * n + (i & 3); }

template <bool F8> __host__ __device__ __forceinline__ int chunk_xor(int r15) { const int rp = (r15 >> 1) & 7; return F8 ? ((rp & 4) | ((rp & 1) << 1) | ((rp >> 1) & 1)) : rp; }
struct Unit { int arow, brow, pn, e, rt, cnt, slot, koff; };
struct Gemm { const void* A; const void* Bt; int lda, ldb, K, wscale; };
typedef int i32x4 __attribute__((ext_vector_type(4)));
typedef int i32x8 __attribute__((ext_vector_type(8)));
__device__ __forceinline__ i32x8 cat8(bf16x8 lo, bf16x8 hi) { return __builtin_shufflevector(__builtin_bit_cast(i32x4, lo), __builtin_bit_cast(i32x4, hi), 0, 1, 2, 3, 4, 5, 6, 7); }

struct DenseSched {
    static constexpr bool GATHER = false;
    int nM, nN, nwg, G, c, kblk = 0, bb = 0, rowm = 0;
    __device__ __forceinline__ void init(int M, int N, int G_, int c_) { nM = M / BM; nN = N / BM; nwg = nM * nN; G = G_; c = c_; }
    __device__ __forceinline__ bool next(int i, Unit& u) const {
        int pm, pn;
        if (rowm) { if (i >= nN) return false; pm = (c % NXCD) * (G / NXCD) + c / NXCD; pn = i; }
        else {
        const long L = (long)i * G + c; if (L >= nwg) return false;
        int wgid = (int)L; { const int q = nwg / NXCD, r = nwg % NXCD, xcd = wgid % NXCD, off = wgid / NXCD; wgid = (xcd < r ? xcd * (q + 1) : r * (q + 1) + (xcd - r) * q) + off; }
        const int nig = WGM * nN, gid = wgid / nig, fm = gid * WGM, gsz = (nM - fm) < WGM ? (nM - fm) : WGM;
        pm = fm + ((wgid % nig) % gsz); pn = (wgid % nig) / gsz; }
        u.arow = pm * BM; u.brow = pn * BM; u.pn = pn; u.e = 0; u.rt = pm; u.cnt = BM; u.slot = 0; u.koff = (pn & 1) * kblk; u.brow += ((pm * BM) >> 12) * bb; return true;
    }
    __device__ __forceinline__ void a_off(const Unit& u, LAS unsigned char*, int R0, int C0, int lda2, unsigned (&off)[2][2]) const {
#pragma unroll
        for (int h = 0; h < 2; ++h)
#pragma unroll
            for (int i = 0; i < 2; ++i) off[h][i] = (unsigned)((u.arow + 128 * h + 64 * i + R0) * lda2 + C0);
    }
};

struct MoeSched {
    static constexpr bool GATHER = true;
    const LAS int* utab;
    const int* list;
    const float* bias;
    int nunits, nexp_rows, shift;
    __device__ __forceinline__ bool next(int i, Unit& u) const {
        if (i >= nunits) return false;
        const LAS int* p = utab + 4 * i;
        u.e = __builtin_amdgcn_readfirstlane(p[0]); u.rt = __builtin_amdgcn_readfirstlane(p[1]); u.pn = __builtin_amdgcn_readfirstlane(p[2]); u.cnt = __builtin_amdgcn_readfirstlane(p[3]);
        u.arow = 0; u.brow = u.e * nexp_rows + u.pn * BM; u.slot = i % 3; u.koff = 0; return true;
    }
    __device__ __forceinline__ void tab_issue(const Unit& u, unsigned ldsb, int wid, int lane) const {
        if (wid < 4) { int p = u.rt * BM + 64 * wid + lane; p = p < u.cnt ? p : u.cnt - 1;
            glds4((const char*)(list + (size_t)u.e * TKTOT), (unsigned)p * 4u, ldsb + TAB_OFF + u.slot * 1024 + wid * 256); }
        else glds4((const char*)(bias + (size_t)u.e * nexp_rows + u.pn * BM), (unsigned)(64 * (wid - 4) + lane) * 4u, ldsb + TAB_OFF + 3072 + u.slot * 1024 + (wid - 4) * 256);
    }
    __device__ __forceinline__ void a_off(const Unit& u, LAS unsigned char* lds, int R0, int C0, int lda2, unsigned (&off)[2][2]) const {
        const LAS int* ids = (const LAS int*)(lds + TAB_OFF + u.slot * 1024);
#pragma unroll
        for (int h = 0; h < 2; ++h)
#pragma unroll
            for (int i = 0; i < 2; ++i) off[h][i] = (unsigned)((ids[128 * h + 64 * i + R0] >> shift) * lda2 + C0);
    }
};
__device__ __forceinline__ int moe_build_units(LAS int* utab, const volatile LAS int* tstart, const volatile LAS int* cnts, int NP, int G, int c, int tid) {
    if (MOE_XCD_OWN && (G % NXCD) == 0) {
        const int CX = G / NXCD, x = c / CX, j = c - x * CX, ttot = tstart[NE];
        const int glo = (int)((long)x * ttot / NXCD), ghi = (int)((long)(x + 1) * ttot / NXCD), total = (ghi - glo) * NP;
        if (tid < 64) { const int L = tid * CX + j;
            if (L < total) { const int g = glo + L / NP; int e = 0;
                for (int q = 0; q < NE - 1; ++q) if (tstart[q + 1] <= g) e = q + 1;
                utab[4 * tid + 0] = e; utab[4 * tid + 1] = g - tstart[e]; utab[4 * tid + 2] = L % NP; utab[4 * tid + 3] = cnts[e]; } }
        return total > j ? (total - j + CX - 1) / CX : 0;
    }
    const int total = tstart[NE] * NP;
    if (tid < 64) { const int L = tid * G + c;
        if (L < total) { int e = 0;
            for (int q = 0; q < NE - 1; ++q) if (tstart[q + 1] * NP <= L) e = q + 1;
            const int t0 = tstart[e], nte = tstart[e + 1] - t0, idx = L - t0 * NP;
            utab[4 * tid + 0] = e; utab[4 * tid + 1] = MOE_PN_FAST ? idx / NP : idx % nte; utab[4 * tid + 2] = MOE_PN_FAST ? idx % NP : idx / nte; utab[4 * tid + 3] = cnts[e]; } }
    return total > c ? (total - c + G - 1) / G : 0;
}

template <int ACT  , bool HAS_BIAS, bool HAS_SCALE, bool OSC = false, bool OUT8 = false> struct EpiDense {
    static constexpr int PERM = WIDE_EPI ? 2 : 1;
    bf16_t* O; int ldc; const float* bias; const float* scale; float oscale;
    __device__ __forceinline__ void operator()(const f32x4 (&acc)[2][2][4][2], const Unit& u, int wr, int wc, int fr, int fq) const {
        const int row0 = u.arow + wr * 64 + fr, col0 = PERM == 2 ? u.pn * BM + wc * 64 + 16 * fq : u.pn * BM + wc * 32 + 8 * fq;
        constexpr int BJS = PERM == 2 ? 8 : HALF;
        f32x4 bv[2][2], sv[2][2];
#pragma unroll
        for (int bj = 0; bj < 2; ++bj)
#pragma unroll
            for (int n = 0; n < 2; ++n) {
                if (HAS_BIAS) bv[bj][n] = *(const f32x4*)(bias + col0 + bj * BJS + 4 * n);
                if (HAS_SCALE) sv[bj][n] = *(const f32x4*)(scale + col0 + bj * BJS + 4 * n);
            }
#pragma unroll
        for (int ai = 0; ai < 2; ++ai)
#pragma unroll
            for (int m = 0; m < 4; ++m) { bf16_t* rowp = O + (size_t)(row0 + ai * HALF + m * 16) * ldc + col0; unsigned char* rowp8 = (unsigned char*)O + (size_t)(row0 + ai * HALF + m * 16) * ldc + col0;
                u32x4 w8;
#pragma unroll
                for (int bj = 0; bj < 2; ++bj) { f32x4 v0 = acc[ai][bj][m][0], v1 = acc[ai][bj][m][1];
                    if (OSC) { v0 = v0 * oscale; v1 = v1 * oscale; }
                    if (HAS_BIAS) { v0 = v0 + bv[bj][0]; v1 = v1 + bv[bj][1]; }
                    if (ACT == 1) { const f32x2 a = pk_gelu_tanh((f32x2){v0[0], v0[1]}), b = pk_gelu_tanh((f32x2){v0[2], v0[3]}), c = pk_gelu_tanh((f32x2){v1[0], v1[1]}), d = pk_gelu_tanh((f32x2){v1[2], v1[3]});
                        v0 = (f32x4){a.x, a.y, b.x, b.y}; v1 = (f32x4){c.x, c.y, d.x, d.y}; }
                    if (ACT == 2) { const float nk = -1.4426950408889634f;
                        const f32x2 a = pk_sigmoid_scaled((f32x2){v0[0], v0[1]}, nk), b = pk_sigmoid_scaled((f32x2){v0[2], v0[3]}, nk), c = pk_sigmoid_scaled((f32x2){v1[0], v1[1]}, nk), d = pk_sigmoid_scaled((f32x2){v1[2], v1[3]}, nk);
                        v0 = (f32x4){a.x, a.y, b.x, b.y}; v1 = (f32x4){c.x, c.y, d.x, d.y}; }
                    if (HAS_SCALE) { v0 = v0 * sv[bj][0]; v1 = v1 * sv[bj][1]; }
                    if constexpr (OUT8) { const unsigned p0 = pk4_fp8(v0[0], v0[1], v0[2], v0[3]), p1 = pk4_fp8(v1[0], v1[1], v1[2], v1[3]);
                        if constexpr (PERM == 2) { if (bj == 0) { w8.x = p0; w8.y = p1; } else { w8.z = p0; w8.w = p1; *(u32x4*)rowp8 = w8; } }
                        else { u32x2 w; w.x = p0; w.y = p1; *(u32x2*)(rowp8 + bj * HALF) = w; } }
                    else { u32x4 w; w.x = cvt_pk_bf16(v0[0], v0[1]); w.y = cvt_pk_bf16(v0[2], v0[3]); w.z = cvt_pk_bf16(v1[0], v1[1]); w.w = cvt_pk_bf16(v1[2], v1[3]);
                    *(u32x4*)(rowp + bj * BJS) = w; } } }
    }
};
struct EpiRouter {
    static constexpr int PERM = 0;
    float* LOG;
    __device__ __forceinline__ void operator()(const f32x4 (&acc)[2][2][4][2], const Unit& u, int wr, int wc, int fr, int fq) const {
        if (wc < 2) {
#pragma unroll
            for (int ai = 0; ai < 2; ++ai)
#pragma unroll
                for (int m = 0; m < 4; ++m) { float* rowp = LOG + (size_t)(u.arow + ai * HALF + wr * 64 + m * 16 + fr) * 64 + wc * 32 + 4 * fq;
#pragma unroll
                    for (int n = 0; n < 2; ++n) *(f32x4*)(rowp + 16 * n) = acc[ai][0][m][n]; }
        }
    }
};
template <bool OUT8> struct EpiMoe1 {
    static constexpr int PERM = 0;
    bf16_t* ACT; LAS unsigned char* lds; float oscale;
    __device__ __forceinline__ void operator()(const f32x4 (&acc)[2][2][4][2], const Unit& u, int wr, int wc, int fr, int fq) const {
        const LAS int* ids = (const LAS int*)(lds + TAB_OFF + u.slot * 1024);
        const LAS float* bp = (const LAS float*)(lds + TAB_OFF + 3072 + u.slot * 1024) + wc * 32 + 4 * fq;
        f32x4 bg[2], bl[2];
#pragma unroll
        for (int bj = 0; bj < 2; ++bj) { bg[bj] = *(const LAS f32x4*)(bp + bj * HALF); bl[bj] = *(const LAS f32x4*)(bp + bj * HALF + 16) + 1.0f; }
        const int j0 = u.pn * 128 + wc * 32 + 8 * fq;
#pragma unroll
        for (int ai = 0; ai < 2; ++ai)
#pragma unroll
            for (int m = 0; m < 4; ++m) {
                const int pl = ai * HALF + wr * 64 + m * 16 + fr;
                if (u.rt * BM + pl < u.cnt) {
                    const int flat = ids[pl];
                    float o[8];
#pragma unroll
                    for (int bj = 0; bj < 2; ++bj) { const f32x4 g = acc[ai][bj][m][0] * oscale + bg[bj], l = acc[ai][bj][m][1] * oscale + bl[bj];
#pragma unroll
                        for (int hh = 0; hh < 2; ++hh) {
                            const f32x2 xg = {fminf(g[2 * hh], 7.0f), fminf(g[2 * hh + 1], 7.0f)};
                            const f32x2 xl = {__builtin_amdgcn_fmed3f(l[2 * hh], -6.0f, 8.0f), __builtin_amdgcn_fmed3f(l[2 * hh + 1], -6.0f, 8.0f)};
                            const f32x2 r = pk_sigmoid_scaled(xg, -1.702f * 1.4426950408889634f), oo = (xg * xl) * r;
                            o[bj * 4 + 2 * hh] = oo.x; o[bj * 4 + 2 * hh + 1] = oo.y; } }
                    if constexpr (OUT8) { u32x2 w; w.x = pk4_fp8(o[0], o[1], o[2], o[3]); w.y = pk4_fp8(o[4], o[5], o[6], o[7]);
                        *(u32x2*)((unsigned char*)ACT + (size_t)flat * 1024 + j0) = w; }
                    else { u32x4 w; w.x = cvt_pk_bf16(o[0], o[1]); w.y = cvt_pk_bf16(o[2], o[3]); w.z = cvt_pk_bf16(o[4], o[5]); w.w = cvt_pk_bf16(o[6], o[7]);
                        *(u32x4*)(ACT + (size_t)flat * 1024 + j0) = w; }
                }
            }
    }
};
struct EpiMoe2 {
    static constexpr int PERM = (WIDE_EPI && FP8_YS) ? 2 : 1;
    bf16_t* YS; LAS unsigned char* lds; float oscale;
    __device__ __forceinline__ void operator()(const f32x4 (&acc)[2][2][4][2], const Unit& u, int wr, int wc, int fr, int fq) const {
        const LAS int* ids = (const LAS int*)(lds + TAB_OFF + u.slot * 1024);
        if constexpr (PERM == 2) {
            const LAS float* bp = (const LAS float*)(lds + TAB_OFF + 3072 + u.slot * 1024) + wc * 64 + 16 * fq;
            const int col0 = u.pn * BM + wc * 64 + 16 * fq;
            const float os = 16.0f * oscale;
#pragma unroll
            for (int ai = 0; ai < 2; ++ai) {
                const f32x4 b00 = *(const LAS f32x4*)(bp) * 16.0f, b01 = *(const LAS f32x4*)(bp + 4) * 16.0f, b10 = *(const LAS f32x4*)(bp + 8) * 16.0f, b11 = *(const LAS f32x4*)(bp + 12) * 16.0f;
#pragma unroll
                for (int m = 0; m < 4; ++m) {
                    const int pl = ai * HALF + wr * 64 + m * 16 + fr;
                    if (u.rt * BM + pl < u.cnt) {
                        const int flat = ids[pl];
                        const f32x4 v00 = acc[ai][0][m][0] * os + b00, v01 = acc[ai][0][m][1] * os + b01, v10 = acc[ai][1][m][0] * os + b10, v11 = acc[ai][1][m][1] * os + b11;
                        u32x4 w; w.x = pk4_fp8(v00[0], v00[1], v00[2], v00[3]); w.y = pk4_fp8(v01[0], v01[1], v01[2], v01[3]); w.z = pk4_fp8(v10[0], v10[1], v10[2], v10[3]); w.w = pk4_fp8(v11[0], v11[1], v11[2], v11[3]);
                        *(u32x4*)((unsigned char*)YS + (size_t)flat * 1024 + col0) = w;
                    }
                }
            }
        } else {
        const LAS float* bp = (const LAS float*)(lds + TAB_OFF + 3072 + u.slot * 1024) + wc * 32 + 8 * fq;
        const int col0 = u.pn * BM + wc * 32 + 8 * fq;
#pragma unroll
        for (int bj = 0; bj < 2; ++bj) {
            const float os = FP8_YS ? 16.0f * oscale : oscale;
            const f32x4 b0 = *(const LAS f32x4*)(bp + bj * HALF) * (FP8_YS ? 16.0f : 1.0f), b1 = *(const LAS f32x4*)(bp + bj * HALF + 4) * (FP8_YS ? 16.0f : 1.0f);
#pragma unroll
            for (int ai = 0; ai < 2; ++ai)
#pragma unroll
                for (int m = 0; m < 4; ++m) {
                    const int pl = ai * HALF + wr * 64 + m * 16 + fr;
                    if (u.rt * BM + pl < u.cnt) {
                        const int flat = ids[pl];
                        const f32x4 v0 = acc[ai][bj][m][0] * os + b0, v1 = acc[ai][bj][m][1] * os + b1;
                        if (FP8_YS) { u32x2 w; w.x = pk4_fp8(v0[0], v0[1], v0[2], v0[3]); w.y = pk4_fp8(v1[0], v1[1], v1[2], v1[3]);
                            *(u32x2*)((unsigned char*)YS + (size_t)flat * 1024 + col0 + bj * HALF) = w; }
                        else { u32x4 w; w.x = cvt_pk_bf16(v0[0], v0[1]); w.y = cvt_pk_bf16(v0[2], v0[3]); w.z = cvt_pk_bf16(v1[0], v1[1]); w.w = cvt_pk_bf16(v1[2], v1[3]);
                            *(u32x4*)(YS + (size_t)flat * 1024 + col0 + bj * HALF) = w; }
                    }
                }
        }
        }
    }
};

template <bool F8, class Epi, class Sched>
__device__ __forceinline__ void gemm_phase(LAS unsigned char* lds, const Gemm g, const Sched& S, const Epi& E, const int wave0) {
    const int tid = (wave0 << 6) | lane_id_asm();
    const int wid = __builtin_amdgcn_readfirstlane(tid >> 6), lane = tid & 63, wr = wid >> 2, wc = wid & 3, fr = lane & 15, fq = lane >> 4;
    constexpr unsigned ESZ = F8 ? 1u : 2u;
    const int nt = (int)((unsigned)g.K * ESZ / 128u);
    int R0, C0;
    R0 = 8 * wid + (lane >> 3); C0 = 16 * ((lane & 7) ^ chunk_xor<F8>(R0 & 15));
    const unsigned lda2 = (unsigned)g.lda * ESZ, ldb2 = (unsigned)g.ldb * ESZ;
    const unsigned voffB = (unsigned)((Epi::PERM == 2 ? (64 * (R0 >> 5) + 16 * ((R0 >> 2) & 3) + 4 * ((R0 >> 4) & 1) + (R0 & 3)) : Epi::PERM == 1 ? ((R0 & ~31) + perm32(R0 & 31)) : R0) * (int)ldb2 + C0);
    constexpr int PIECE_B = Epi::PERM == 2 ? 128 : 64;
    const unsigned aoffl = (unsigned)(R0 * (int)lda2 + C0);
    const unsigned kstep = 128;
    const size_t hstepB = (size_t)(Epi::PERM == 2 ? 8 : HALF) * ldb2;
    const unsigned ldsw = (unsigned)wid * 1024u;
    const int ab = fr * 128 + 16 * ((F8 ? 2 * fq : fq) ^ chunk_xor<F8>(fr));
    const int aoff0 = wr * 8192 + ab, boff0 = wc * 4096 + ab;
    constexpr int KX = F8 ? 16 : 64;
    const char* const Abase = (const char*)g.A;
    const unsigned ldsb = (unsigned)(size_t)lds;
#define PG8_SA(b, h) (((b) * 2 + (h)) * HTB)
#define PG8_SB(b, h) ((4 + (b) * 2 + (h)) * HTB)
#define PG8_GOFF(h, NXT) do { if constexpr (Sched::GATHER) go = *(const LAS u32x2*)(lds + NXT_OFF + ((((NXT) ? ui + 1 : ui) & 1) << 13) + tid * 16 + (h) * 8); } while (0)
#define PG8_STAGE_A(bufoff, h, NXT, kb) do { _Pragma("unroll") for (int _i = 0; _i < 2; ++_i) { \
        if constexpr (Sched::GATHER) glds16(Abase + (kb), _i ? go.y : go.x, ldsb + (bufoff) + ldsw + _i * 8192); \
        else glds16(Abase + ((NXT) ? nxtA : curA) + (size_t)((h) * 128 + _i * 64) * lda2 + (kb), aoffl, ldsb + (bufoff) + ldsw + _i * 8192); } } while (0)
#define PG8_STAGE_B(bufoff, bptr, kb) do { _Pragma("unroll") for (int _i = 0; _i < 2; ++_i) \
        glds16((bptr) + (size_t)(_i * PIECE_B) * ldb2 + (kb), voffB, ldsb + (bufoff) + ldsw + _i * 8192); } while (0)
#define PG8_LDA(dst, b, h) do { int _a1 = aoff0 ^ KX; asm volatile("" : "+v"(_a1)); \
        _Pragma("unroll") for (int m = 0; m < 4; ++m) _Pragma("unroll") for (int k = 0; k < 2; ++k) dst[m][k] = *(const LAS bf16x8*)(lds + PG8_SA(b, h) + (k ? _a1 : aoff0) + m * 2048); } while (0)
#define PG8_LDB(dst, b, h) do { int _b1 = boff0 ^ KX; asm volatile("" : "+v"(_b1)); \
        _Pragma("unroll") for (int n = 0; n < 2; ++n) _Pragma("unroll") for (int k = 0; k < 2; ++k) dst[n][k] = *(const LAS bf16x8*)(lds + PG8_SB(b, h) + (k ? _b1 : boff0) + n * 2048); } while (0)
#define PG8_MMA(ai, bj, At, Bt) do { __builtin_amdgcn_s_setprio(1); _Pragma("unroll") for (int m = 0; m < 4; ++m) _Pragma("unroll") for (int n = 0; n < 2; ++n) { \
        if constexpr (F8) acc[ai][bj][m][n] = __builtin_amdgcn_mfma_scale_f32_16x16x128_f8f6f4(cat8(Bt[n][0], Bt[n][1]), cat8(At[m][0], At[m][1]), acc[ai][bj][m][n], 0, 0, 0, 0, 0, 0); \
        else { _Pragma("unroll") for (int k = 0; k < 2; ++k) acc[ai][bj][m][n] = __builtin_amdgcn_mfma_f32_16x16x32_bf16(Bt[n][k], At[m][k], acc[ai][bj][m][n], 0, 0, 0); } } \
        __builtin_amdgcn_s_setprio(0); } while (0)
#define PG8_WAIT_V(n) asm volatile("s_waitcnt vmcnt(" #n ")" ::: "memory")
#define PG8_WAIT_L(n) asm volatile("s_waitcnt lgkmcnt(" #n ")" ::: "memory")
#define PG8_BAR __builtin_amdgcn_s_barrier()
#define PG8_SCHED __builtin_amdgcn_sched_barrier(0)
#define PG8_KITER(k1, b2, NXT, k2, k3) do { \
        PG8_GOFF(1, 0); PG8_LDB(B0, 0, 0); PG8_LDB(B1, 0, 1); PG8_SCHED; PG8_LDA(At, 0, 0); PG8_STAGE_A(PG8_SA(1, 1), 1, 0, (k1)); \
        PG8_WAIT_V(8); PG8_WAIT_L(0); PG8_BAR; PG8_MMA(0, 0, At, B0); PG8_MMA(0, 1, At, B1); PG8_BAR; PG8_SCHED; \
        PG8_GOFF(0, NXT); PG8_LDA(At, 0, 1); PG8_STAGE_B(PG8_SB(0, 0), (b2), (k2)); PG8_STAGE_B(PG8_SB(0, 1), (b2) + hstepB, (k2)); PG8_STAGE_A(PG8_SA(0, 0), 0, NXT, (k2)); \
        PG8_WAIT_V(8); PG8_WAIT_L(0); PG8_BAR; PG8_MMA(1, 0, At, B0); PG8_MMA(1, 1, At, B1); PG8_BAR; PG8_SCHED; \
        PG8_GOFF(1, NXT); PG8_LDB(B0, 1, 0); PG8_LDB(B1, 1, 1); PG8_SCHED; PG8_LDA(At, 1, 0); PG8_STAGE_A(PG8_SA(0, 1), 1, NXT, (k2)); \
        PG8_WAIT_V(8); PG8_WAIT_L(0); PG8_BAR; PG8_MMA(0, 0, At, B0); PG8_MMA(0, 1, At, B1); PG8_BAR; PG8_SCHED; \
        PG8_GOFF(0, NXT); PG8_LDA(At, 1, 1); PG8_STAGE_B(PG8_SB(1, 0), (b2), (k3)); PG8_STAGE_B(PG8_SB(1, 1), (b2) + hstepB, (k3)); PG8_STAGE_A(PG8_SA(1, 0), 0, NXT, (k3)); \
        PG8_WAIT_V(8); PG8_WAIT_L(0); PG8_BAR; PG8_MMA(1, 0, At, B0); PG8_MMA(1, 1, At, B1); PG8_BAR; PG8_SCHED; } while (0)

    Unit cur, nxt; int ui = 0;
    if (!S.next(0, cur)) return;
    unsigned curoff[2][2], nxtoff[2][2];
    size_t curA = 0, nxtA = 0;
    bool has_next = S.next(1, nxt);
#define PG8_NXT_SLOT ((LAS u32x4*)(lds + NXT_OFF) + tid)
    if constexpr (Sched::GATHER) {
        S.tab_issue(cur, ldsb, wid, lane); if (has_next) S.tab_issue(nxt, ldsb, wid, lane);
        asm volatile("s_waitcnt vmcnt(0)" ::: "memory"); __builtin_amdgcn_s_barrier(); asm volatile("" ::: "memory");
        S.a_off(cur, lds, R0, C0, (int)lda2, curoff);
        if (has_next) S.a_off(nxt, lds, R0, C0, (int)lda2, nxtoff);
        else {
#pragma unroll
            for (int h = 0; h < 2; ++h)
#pragma unroll
                for (int i = 0; i < 2; ++i) nxtoff[h][i] = curoff[h][i]; }
        ((LAS u32x4*)(lds + NXT_OFF))[tid] = (u32x4){curoff[0][0], curoff[0][1], curoff[1][0], curoff[1][1]};
        ((LAS u32x4*)(lds + NXT_OFF + 8192))[tid] = (u32x4){nxtoff[0][0], nxtoff[0][1], nxtoff[1][0], nxtoff[1][1]};
    } else { curA = (size_t)cur.arow * lda2 + cur.koff; nxtA = has_next ? (size_t)nxt.arow * lda2 + nxt.koff : curA; }
    f32x4 acc[2][2][4][2];
#pragma unroll
    for (int a = 0; a < 2; ++a)
#pragma unroll
        for (int b = 0; b < 2; ++b)
#pragma unroll
            for (int m = 0; m < 4; ++m)
#pragma unroll
                for (int n = 0; n < 2; ++n) acc[a][b][m][n] = (f32x4){0.f, 0.f, 0.f, 0.f};
    bf16x8 At[4][2], B0[2][2], B1[2][2];
    const char* cB = (const char*)g.Bt + (size_t)cur.brow * ldb2 + cur.koff;
    u32x2 go = {0u, 0u};
    PG8_STAGE_B(PG8_SB(0, 0), cB, 0u); PG8_STAGE_B(PG8_SB(0, 1), cB + hstepB, 0u); PG8_GOFF(0, 0); PG8_STAGE_A(PG8_SA(0, 0), 0, 0, 0u); PG8_GOFF(1, 0); PG8_STAGE_A(PG8_SA(0, 1), 1, 0, 0u);
    if (wr == 1) PG8_BAR;
    PG8_WAIT_V(2); PG8_BAR;
    PG8_GOFF(0, 0); PG8_STAGE_B(PG8_SB(1, 0), cB, kstep); PG8_STAGE_A(PG8_SA(1, 0), 0, 0, kstep); PG8_STAGE_B(PG8_SB(1, 1), cB + hstepB, kstep);
    PG8_WAIT_V(6); PG8_BAR;
    for (;;) {
        const char* nB = has_next ? (const char*)g.Bt + (size_t)nxt.brow * ldb2 + nxt.koff : cB;
        Unit u2; bool has2 = false;
        if constexpr (Sched::GATHER) has2 = has_next && S.next(ui + 2, u2);
#pragma unroll 1
        for (int t = 0; t < nt - 2; t += 2) {
            const unsigned k1 = (unsigned)(t + 1) * kstep, k2 = (unsigned)(t + 2) * kstep, k3 = (unsigned)(t + 3) * kstep;
            if constexpr (Sched::GATHER) { if (t == 2 && has2) S.tab_issue(u2, ldsb, wid, lane); }
            PG8_KITER(k1, cB, 0, k2, k3);
        }
        { const unsigned k1 = (unsigned)(nt - 1) * kstep; PG8_KITER(k1, nB, 1, 0u, kstep); }
#if PIN_ACC
#pragma unroll
        for (int a = 0; a < 2; ++a)
#pragma unroll
            for (int b = 0; b < 2; ++b)
#pragma unroll
                for (int m = 0; m < 4; ++m) asm volatile("" : "+v"(acc[a][b][m][0]), "+v"(acc[a][b][m][1]));
#endif
        if (wr == 0) PG8_BAR;
#ifdef PROBE_VARIANTS
        if (!(kvariant() & 4))
#endif
        { const int l2 = lane_id_asm(); E(acc, cur, wr, wc, l2 & 15, l2 >> 4); }
        if (!has_next) break;
#pragma unroll
        for (int a = 0; a < 2; ++a)
#pragma unroll
            for (int b = 0; b < 2; ++b)
#pragma unroll
                for (int m = 0; m < 4; ++m)
#pragma unroll
                    for (int n = 0; n < 2; ++n) acc[a][b][m][n] = (f32x4){0.f, 0.f, 0.f, 0.f};
        cur = nxt; cB = nB; ++ui; curA = nxtA;
        has_next = S.next(ui + 1, nxt);
        if (has_next) {
            if constexpr (Sched::GATHER) { const int tz = (wave0 << 6) | lane_id_asm(); int R0z, C0z;
                { const int lz = tz & 63; R0z = 8 * wid + (lz >> 3); C0z = 16 * ((lz & 7) ^ chunk_xor<F8>(R0z & 15)); }
                S.a_off(nxt, lds, R0z, C0z, (int)lda2, nxtoff);
                ((LAS u32x4*)(lds + NXT_OFF + (((ui + 1) & 1) << 13)))[tz] = (u32x4){nxtoff[0][0], nxtoff[0][1], nxtoff[1][0], nxtoff[1][1]}; }
            else nxtA = (size_t)nxt.arow * lda2 + nxt.koff;
        } else if constexpr (Sched::GATHER) { const int tz = (wave0 << 6) | lane_id_asm();
            ((LAS u32x4*)(lds + NXT_OFF + (((ui + 1) & 1) << 13)))[tz] = ((const LAS u32x4*)(lds + NXT_OFF + ((ui & 1) << 13)))[tz]; }
        if (wr == 1) PG8_BAR;
    }
    PG8_WAIT_V(0);
    PG8_BAR;
#undef PG8_SA
#undef PG8_SB
#undef PG8_STAGE_A
#undef PG8_GOFF
#undef PG8_STAGE_B
#undef PG8_LDA
#undef PG8_LDB
#undef PG8_MMA
#undef PG8_WAIT_V
#undef PG8_WAIT_L
#undef PG8_BAR
#undef PG8_SCHED
#undef PG8_KITER
#undef PG8_NXT_SLOT
}
}

struct Args { const float* in[32]; float* out; unsigned char* ws; int ph_lo, ph_hi, variant, pad; };
typedef const __attribute__((address_space(4))) unsigned char* kptr_t;
__device__ __forceinline__ const float* kin(int i) { kptr_t p = (kptr_t)__builtin_amdgcn_kernarg_segment_ptr(); asm volatile("" : "+s"(p)); return *(const float* const __attribute__((address_space(4)))*)(p + 8 * i); }
enum { I_X = 0, I_C, I_MODW, I_MODB, I_LNG, I_LNB, I_ABWIN, I_POOLW, I_POOLS, I_CONVW, I_CONVB, I_WA, I_BA, I_WX, I_BX, I_LAM, I_ABWOUT, I_ABBOUT,
       I_SGWIN, I_SGBIN, I_SGLNG, I_SGLNB, I_SGWS, I_SGBS, I_SGWOUT, I_SGBOUT, I_RW, I_RB, I_W1, I_B1, I_W2, I_B2 };

__device__ __forceinline__ int w1_rho(int n) { const int nn = n & 1, j = n >> 1; return ((j >> 7) << 8) | (((j >> 2) & 1) << 7) | (((j >> 5) & 3) << 5) | (nn << 4) | (((j >> 3) & 3) << 2) | (j & 3); }
__device__ __forceinline__ int w1_n_of_rho(int rho) { const int pn = rho >> 8, bj = (rho >> 7) & 1, wc = (rho >> 5) & 3, nn = (rho >> 4) & 1, fq = (rho >> 2) & 3, i = rho & 3; return 2 * (128 * pn + 32 * wc + 8 * fq + 4 * bj + i) + nn; }
template <bool W1MAP>
__device__ __forceinline__ void conv_item(const float* W, int N, bf16_t* WT, int item, int lane) {
    const int nblk = N >> 5, kb = item / nblk, nb = item - kb * nblk;
    const int kg = lane >> 3, nl = lane & 7, k0 = kb * 64 + kg * 8, n0 = nb * 32 + nl * 4;
    f32x4 v[8];
#pragma unroll
    for (int q = 0; q < 8; ++q) v[q] = *(const f32x4*)(W + (size_t)(k0 + q) * N + n0);
#pragma unroll
    for (int i = 0; i < 4; ++i) {
        const int n = n0 + i, row = W1MAP ? w1_rho(n) : n;
        u32x4 o; o.x = pk2(v[0][i], v[1][i]); o.y = pk2(v[2][i], v[3][i]); o.z = pk2(v[4][i], v[5][i]); o.w = pk2(v[6][i], v[7][i]);
        *(u32x4*)(WT + (size_t)row * 1024 + k0) = o;
    }
}

template <bool W1MAP>
__device__ __forceinline__ void conv_item_f8(const float* W, int N, unsigned char* WT8, int item, int lane, float scale) {
    const int nblk = N >> 5, kb = item / nblk, nb = item - kb * nblk;
    const int kg = lane >> 3, nl = lane & 7, k0 = kb * 128 + kg * 16, n0 = nb * 32 + nl * 4;
    f32x4 v[16];
#pragma unroll
    for (int q = 0; q < 16; ++q) v[q] = *(const f32x4*)(W + (size_t)(k0 + q) * N + n0) * scale;
#pragma unroll
    for (int i = 0; i < 4; ++i) {
        const int n = n0 + i, row = W1MAP ? w1_rho(n) : n;
        u32x4 o; o.x = pk4_fp8(v[0][i], v[1][i], v[2][i], v[3][i]); o.y = pk4_fp8(v[4][i], v[5][i], v[6][i], v[7][i]);
        o.z = pk4_fp8(v[8][i], v[9][i], v[10][i], v[11][i]); o.w = pk4_fp8(v[12][i], v[13][i], v[14][i], v[15][i]);
        *(u32x4*)(WT8 + (size_t)row * 1024 + k0) = o;
    }
}

#define IN(k) (lo <= (k) && (k) < hi)
#define SEAM(k) do { if ((k) + 1 < hi) xcd_barrier(bar); } while (0)
#define LSEAM(k) do { if ((k) + 1 < hi) { if (FUSE_LOCAL && G == 256) { __builtin_amdgcn_fence(__ATOMIC_RELEASE, "workgroup"); __syncthreads(); __builtin_amdgcn_fence(__ATOMIC_ACQUIRE, "workgroup"); } else xcd_barrier(bar); } } while (0)
#define PH_LOCALS \
    const int tid = (wave0 << 6) | lane_id_asm(); \
    const int lane = tid & 63, wave = wave0; \
    int bx = blockIdx.x; asm volatile("" : "+s"(bx)); \
    const int vcu = (G % 8 == 0) ? (bx % 8) * (G / 8) + bx / 8 : bx; \
    const int gw = vcu * 8 + wave, NGW = G * 8; \
    unsigned char* ws; { kptr_t kp_ = (kptr_t)__builtin_amdgcn_kernarg_segment_ptr(); asm volatile("" : "+s"(kp_)); ws = *(unsigned char* const __attribute__((address_space(4)))*)(kp_ + 264); } \
    float* Xf; { kptr_t kp_ = (kptr_t)__builtin_amdgcn_kernarg_segment_ptr(); asm volatile("" : "+s"(kp_)); Xf = *(float* const __attribute__((address_space(4)))*)(kp_ + 256); } \
    unsigned* const ctl = (unsigned*)(ws + WS_CTL); \
    float* const MOD = (float*)(ws + WS_MOD); bf16_t* const Hb = (bf16_t*)(ws + WS_H); bf16_t* const Zb = (bf16_t*)(ws + WS_Z); bf16_t* const A2b = (bf16_t*)(ws + WS_A2); \
    bf16_t* const RIb = (bf16_t*)(ws + WS_RI); bf16_t* const YMb = (bf16_t*)(ws + WS_YMIX); bf16_t* const Yb = (bf16_t*)(ws + WS_Y); bf16_t* const ACTb = (bf16_t*)(ws + WS_ACT); \
    bf16_t* const YSb = (bf16_t*)(ws + WS_YS); float* const LOGf = (float*)(ws + WS_LOG); float* const TOPG = (float*)(ws + WS_TOPG); int* const LIST = (int*)(ws + WS_LIST); \
    float* const SUMM = (float*)(ws + WS_SUMM); \
    (void)lane; (void)wave; (void)gw; (void)NGW; (void)ctl; (void)MOD; (void)Hb; (void)Zb; (void)A2b; (void)RIb; (void)YMb; (void)Yb; (void)ACTb; (void)YSb; (void)LOGf; (void)TOPG; (void)LIST; (void)SUMM; (void)Xf; (void)vcu


template <int L, int PASS>
__device__ __forceinline__ void scan_phase(const int lo, const int hi, const int G, const XcdBarrier& bar, const int wave0) {
    constexpr int l = L, pass = PASS, P = PH_L0 + PH_PER_LAYER * L, jj = L >> 1; constexpr bool odd = (L & 1) != 0;
            if (PHEN(6) && !odd && IN(P + 3 + pass)) {
            PH_LOCALS;
                for (int it = gw; it < 16 * 32 * 4; it += NGW) {
                    const int b = it >> 7, n = (it >> 2) & 31, cg = it & 3;
                    const int ch = cg * 128 + 2 * lane;
                    float sp[2];
#pragma unroll
                    for (int q = 0; q < 2; ++q) { const float x = -kin(I_LAM)[jj * 512 + ch + q]; sp[q] = 8.0f * 1.4426950408889634f * (fmaxf(x, 0.f) + log1pf(__expf(-fabsf(x)))); }
                    float one = 1.0f; asm volatile("" : "+v"(one));
                    float h0 = 0.f, h1 = 0.f, p0 = one, p1 = one;
                    if (pass == 1) {
#pragma unroll 1
                        for (int m = 0; m < n; ++m) { const f32x4 s = *(const f32x4*)(SUMM + (((size_t)b * 32 + m) * 512 + ch) * 2); h0 = s[0] * h0 + s[1]; h1 = s[2] * h1 + s[3]; }
                    }
                    const size_t row0 = (size_t)b * SEQ + n * 128;
#pragma unroll 4
                    for (int t = 0; t < 128; ++t) {
                        const size_t r = row0 + t;
                        const unsigned rw = *(const unsigned*)(RIb + r * 1024 + ch), iw = *(const unsigned*)(RIb + r * 1024 + 512 + ch), xw = *(const unsigned*)(A2b + r * 1024 + 512 + ch);
                        const float a0 = __builtin_amdgcn_exp2f(-bflo(rw) * sp[0]), a1 = __builtin_amdgcn_exp2f(-bfhi(rw) * sp[1]);
                        const float m0 = __builtin_amdgcn_sqrtf(fmaxf(__builtin_fmaf(-a0, a0, 1.0f), 0.f)), m1 = __builtin_amdgcn_sqrtf(fmaxf(__builtin_fmaf(-a1, a1, 1.0f), 0.f));
                        h0 = a0 * h0 + m0 * (bflo(iw) * bflo(xw)); h1 = a1 * h1 + m1 * (bfhi(iw) * bfhi(xw));
                        if (pass == 0) { p0 *= a0; p1 *= a1; }
                        else { const unsigned gwd = *(const unsigned*)(Zb + r * DINAB + 1024 + ch);
                            if (FP8_OUTP) *(unsigned short*)((unsigned char*)YMb + r * 1024 + 512 + ch) = (unsigned short)pk4_fp8(h0 * gelu_tanh(bflo(gwd)), h1 * gelu_tanh(bfhi(gwd)), 0.f, 0.f);
                            else *(unsigned*)(YMb + r * 1024 + 512 + ch) = pk2(h0 * gelu_tanh(bflo(gwd)), h1 * gelu_tanh(bfhi(gwd))); }
                    }
                    if (pass == 0) *(f32x4*)(SUMM + (((size_t)b * 32 + n) * 512 + ch) * 2) = (f32x4){p0, h0, p1, h1};
                }
                SEAM(P + 3 + pass);
            }
}

template <int L, int SUB>
__device__ __forceinline__ void ln_phase(const int lo, const int hi, const int G, const XcdBarrier& bar, const int wave0) {
    constexpr int l = L, sub = SUB, P = PH_L0 + PH_PER_LAYER * L; constexpr int ph = SUB == 0 ? P + 6 : P + 11;
    constexpr bool XIN_F32 = (L == 0 && SUB == 0), XOUT_F32 = (L == DEPTH - 1 && SUB == 1);
    if (PHEN(8) && IN(ph)) {
        PH_LOCALS;
        const int rows_per = T / NGW, r0 = gw * rows_per, b = r0 / SEQ;
        constexpr int ls = 2 * l + sub, lsn = ls + 1;
        const float* gp = MOD + ((size_t)ls * 16 + b) * 3072 + 2048;
        const float* lgp = kin(I_LNG) + ls * 1024, * lbp = kin(I_LNB) + ls * 1024;
        constexpr bool has_nextmod = lsn < 2 * DEPTH;
        const float* nsh = MOD + ((size_t)(has_nextmod ? lsn : 0) * 16 + b) * 3072, * nsc = nsh + 1024;
        f32x4 gt[4], lg[4], lb[4], sh[4], sc[4];
#pragma unroll
        for (int j = 0; j < 4; ++j) { const int o = 4 * (64 * j + lane); gt[j] = *(const f32x4*)(gp + o) + 1.0f; lg[j] = *(const f32x4*)(lgp + o); lb[j] = *(const f32x4*)(lbp + o);
            sh[j] = *(const f32x4*)(nsh + o); sc[j] = *(const f32x4*)(nsc + o) + 1.0f; }
        const float* xin32 = kin(I_X);
        bf16_t* const Xb = (bf16_t*)(ws + WS_XB);
        constexpr bool NEXT_INP8 = ((l + 1) & 1) ? (FP8_INP_ODD != 0) : (FP8_INP_EVEN != 0);
        constexpr int RPI = 2;
        for (int r = (r0 - wave * rows_per) + wave * RPI, rend = (r0 - wave * rows_per) + 8 * rows_per; r < rend; r += 8 * RPI) {
            f32x4 xf[XIN_F32 ? RPI : 1][4]; u32x2 xb[XIN_F32 ? 1 : RPI][4]; u32x2 yv[sub == 0 ? RPI : 1][4]; u32x2 ys[sub == 0 ? 1 : RPI][4][4]; f32x4 gk[RPI];
#pragma unroll
            for (int q = 0; q < RPI; ++q) {
                if constexpr (XIN_F32) { const f32x4* xr = (const f32x4*)(xin32 + (size_t)(r + q) * D) + lane;
#pragma unroll
                    for (int j = 0; j < 4; ++j) xf[q][j] = xr[64 * j]; }
                else { const u32x2* xr = (const u32x2*)(Xb + (size_t)(r + q) * D) + lane;
#pragma unroll
                    for (int j = 0; j < 4; ++j) xb[q][j] = xr[64 * j]; }
                if constexpr (sub == 0) { const u32x2* yr = (const u32x2*)(Yb + (size_t)(r + q) * D) + lane;
#pragma unroll
                    for (int j = 0; j < 4; ++j) yv[q][j] = yr[64 * j]; }
                else { gk[q] = *(const f32x4*)(TOPG + (size_t)(r + q) * 4);
#pragma unroll
                    for (int k = 0; k < 4; ++k) {
                        if (FP8_YS) { const unsigned* yr = (const unsigned*)((const unsigned char*)YSb + ((size_t)(r + q) * 4 + k) * D) + lane;
#pragma unroll
                            for (int j = 0; j < 4; ++j) ys[q][k][j].x = yr[64 * j]; }
                        else { const u32x2* yr = (const u32x2*)(YSb + ((size_t)(r + q) * 4 + k) * D) + lane;
#pragma unroll
                            for (int j = 0; j < 4; ++j) ys[q][k][j] = yr[64 * j]; } } }
            }
            f32x4 v[RPI][4]; float s[RPI];
#pragma unroll
            for (int q = 0; q < RPI; ++q) {
                s[q] = 0.f;
#pragma unroll
                for (int j = 0; j < 4; ++j) {
                    f32x4 y, x;
                    if constexpr (XIN_F32) x = xf[q][j]; else x = (f32x4){bflo(xb[q][j].x), bfhi(xb[q][j].x), bflo(xb[q][j].y), bfhi(xb[q][j].y)};
                    if constexpr (sub == 0) y = (f32x4){bflo(yv[q][j].x), bfhi(yv[q][j].x), bflo(yv[q][j].y), bfhi(yv[q][j].y)};
                    else { y = (f32x4){0.f, 0.f, 0.f, 0.f};
#pragma unroll
                        for (int k = 0; k < 4; ++k) { const u32x2 w = ys[q][k][j];
                            if (FP8_YS) { const f32x2 lo2 = __builtin_amdgcn_cvt_pk_f32_fp8((int)w.x, false), hi2 = __builtin_amdgcn_cvt_pk_f32_fp8((int)w.x, true);
                                y = y + (f32x4){lo2.x, lo2.y, hi2.x, hi2.y} * (gk[q][k] * 0.0625f); }
                            else y = y + (f32x4){bflo(w.x), bfhi(w.x), bflo(w.y), bfhi(w.y)} * gk[q][k]; } }
                    v[q][j] = x * DN_ALPHA + gt[j] * y;
                    s[q] += (v[q][j][0] + v[q][j][1]) + (v[q][j][2] + v[q][j][3]);
                }
            }
#pragma unroll
            for (int o = 1; o < 64; o <<= 1) {
#pragma unroll
                for (int q = 0; q < RPI; ++q) s[q] += __builtin_bit_cast(float, __builtin_amdgcn_ds_bpermute((lane ^ o) << 2, __builtin_bit_cast(int, s[q])));
            }
            float s2[RPI];
#pragma unroll
            for (int q = 0; q < RPI; ++q) { const float mean = s[q] * (1.0f / D); s2[q] = 0.f;
#pragma unroll
                for (int j = 0; j < 4; ++j) { v[q][j] = v[q][j] - mean; s2[q] += (v[q][j][0] * v[q][j][0] + v[q][j][1] * v[q][j][1]) + (v[q][j][2] * v[q][j][2] + v[q][j][3] * v[q][j][3]); } }
#pragma unroll
            for (int o = 1; o < 64; o <<= 1) {
#pragma unroll
                for (int q = 0; q < RPI; ++q) s2[q] += __builtin_bit_cast(float, __builtin_amdgcn_ds_bpermute((lane ^ o) << 2, __builtin_bit_cast(int, s2[q])));
            }
#pragma unroll
            for (int q = 0; q < RPI; ++q) {
                const float rstd = 1.0f / sqrtf(s2[q] * (1.0f / D) + LN_EPS);
                u32x2* hr = (u32x2*)(Hb + (size_t)(r + q) * D) + lane;
#pragma unroll
                for (int j = 0; j < 4; ++j) { const f32x4 xn = v[q][j] * rstd * lg[j] + lb[j];
                    if (XOUT_F32) ((f32x4*)(Xf + (size_t)(r + q) * D) + lane)[64 * j] = xn;
                    else { u32x2 w; w.x = pk2(xn[0], xn[1]); w.y = pk2(xn[2], xn[3]); ((u32x2*)(Xb + (size_t)(r + q) * D) + lane)[64 * j] = w; }
                    if (has_nextmod) { const f32x4 h = xn * sc[j] + sh[j];
                        if (!(NEXT_INP8 && sub == 1) && !(ROUTER_X && sub == 0)) { u32x2 w; w.x = pk2(h[0], h[1]); w.y = pk2(h[2], h[3]); hr[64 * j] = w; }
                        if ((FP8_M1 && sub == 0) || (NEXT_INP8 && sub == 1)) ((unsigned*)(ws + WS_H8 + (size_t)(r + q) * D) + lane)[64 * j] = pk4_fp8(h[0], h[1], h[2], h[3]); } }
            }
        }
        if (ph + 1 < NPH) { if (sub == 0) LSEAM(ph); else SEAM(ph); }
    }
}

template <int L>
__device__ __forceinline__ void layer_body(LAS unsigned char* const lds, volatile LAS unsigned* const LCTL, const int lo, const int hi, const int G, const XcdBarrier& bar, const int wave0) {
    constexpr int l = L;
        const int P = PH_L0 + PH_PER_LAYER * l, jj = l >> 1;
        const bool odd = (l & 1) != 0;
        if (PHEN(2) && IN(P + 0)) {
            PH_LOCALS;
            if (!odd) {
                pg8::DenseSched S; S.init(T, 1536, G, bx);
                if (FP8_INP_EVEN) { pg8::Gemm g{ws + WS_H8, ws + WS_ABIN + (size_t)jj * 1536 * 1024, 1024, 1024, 1024, 122};
                    pg8::EpiDense<0, false, false, true> E{Zb, 1536, nullptr, nullptr, 1.0f / 32.0f};
                    pg8::gemm_phase<true>(lds, g, S, E, wave0); }
                else { pg8::Gemm g{Hb, (const bf16_t*)(ws + WS_ABIN) + (size_t)jj * 1536 * 1024, 1024, 1024, 1024, 127};
                    pg8::EpiDense<0, false, false> E{Zb, 1536, nullptr, nullptr, 0.f};
                    pg8::gemm_phase<false>(lds, g, S, E, wave0); }
            } else {
                pg8::DenseSched S; S.init(T, 2048, G, bx);
                if (FP8_INP_ODD) { pg8::Gemm g{ws + WS_H8, ws + WS_SGIN + (size_t)jj * 2048 * 1024, 1024, 1024, 1024, 122};
                    pg8::EpiDense<1, true, false, true> E{Zb, 2048, kin(I_SGBIN) + jj * 2048, nullptr, 1.0f / 32.0f};
                    pg8::gemm_phase<true>(lds, g, S, E, wave0); }
                else { pg8::Gemm g{Hb, (const bf16_t*)(ws + WS_SGIN) + (size_t)jj * 2048 * 1024, 1024, 1024, 1024, 127};
                    pg8::EpiDense<1, true, false> E{Zb, 2048, kin(I_SGBIN) + jj * 2048, nullptr, 0.f};
                    pg8::gemm_phase<false>(lds, g, S, E, wave0); }
            }
            SEAM(P + 0);
        }
        if (PHEN(3) && !odd && IN(P + 1)) {
            PH_LOCALS;
            const int rows_per = T / NGW, r0 = gw * rows_per;
            const int g4 = lane >> 4, w = 2 << g4;
            float cw[4][8], cb[8];
#pragma unroll
            for (int k = 0; k < 4; ++k)
#pragma unroll
                for (int q = 0; q < 8; ++q) cw[k][q] = kin(I_CONVW)[((size_t)jj * 4 + k) * 512 + 8 * lane + q];
#pragma unroll
            for (int q = 0; q < 8; ++q) cb[q] = kin(I_CONVB)[jj * 512 + 8 * lane + q];
            const int ts0 = r0 & (SEQ - 1);
            u32x4 ring[16], cr[3];
            float sw[8];
#pragma unroll
            for (int q = 0; q < 8; ++q) sw[q] = 0.f;
#pragma unroll
            for (int d = 0; d < 16; ++d) {
                const int k = 15 - d;
                u32x4 v = {0u, 0u, 0u, 0u};
                if (ts0 > d) v = *(const u32x4*)(Zb + (size_t)(r0 - 1 - d) * DINAB + 8 * lane);
                ring[k] = v;
                if (d + 1 < w) { const float f[8] = {bflo(v.x), bfhi(v.x), bflo(v.y), bfhi(v.y), bflo(v.z), bfhi(v.z), bflo(v.w), bfhi(v.w)};
#pragma unroll
                    for (int q = 0; q < 8; ++q) sw[q] += f[q]; }
            }
#pragma unroll
            for (int d = 0; d < 3; ++d) { u32x4 v = {0u, 0u, 0u, 0u}; if (ts0 > d) v = *(const u32x4*)(Zb + (size_t)(r0 - 1 - d) * DINAB + 512 + 8 * lane); cr[2 - d] = v; }
#pragma unroll 1
            for (int rb = 0; rb < rows_per; rb += 16) {
#pragma unroll
                for (int i = 0; i < 16; ++i) {
                    const int r = r0 + rb + i, ts = r & (SEQ - 1);
                    const u32x4 vn = *(const u32x4*)(Zb + (size_t)r * DINAB + 8 * lane), cn = *(const u32x4*)(Zb + (size_t)r * DINAB + 512 + 8 * lane);
                    const u32x4 c2 = ring[(i + 15) & 15], c4 = ring[(i + 13) & 15], c8 = ring[(i + 9) & 15], c16 = ring[(i + 1) & 15];
                    u32x4 vo;
                    vo.x = g4 == 0 ? c2.x : g4 == 1 ? c4.x : g4 == 2 ? c8.x : c16.x; vo.y = g4 == 0 ? c2.y : g4 == 1 ? c4.y : g4 == 2 ? c8.y : c16.y;
                    vo.z = g4 == 0 ? c2.z : g4 == 1 ? c4.z : g4 == 2 ? c8.z : c16.z; vo.w = g4 == 0 ? c2.w : g4 == 1 ? c4.w : g4 == 2 ? c8.w : c16.w;
                    ring[i] = vn;
                    const float fn[8] = {bflo(vn.x), bfhi(vn.x), bflo(vn.y), bfhi(vn.y), bflo(vn.z), bfhi(vn.z), bflo(vn.w), bfhi(vn.w)};
                    const float fo[8] = {bflo(vo.x), bfhi(vo.x), bflo(vo.y), bfhi(vo.y), bflo(vo.z), bfhi(vo.z), bflo(vo.w), bfhi(vo.w)};
                    const int cntw = (ts + 1) < w ? (ts + 1) : w;
                    const float inv = __builtin_amdgcn_rcpf((float)cntw);
                    float pz[8];
#pragma unroll
                    for (int q = 0; q < 8; ++q) { sw[q] += fn[q]; pz[q] = sw[q] * inv - fn[q]; sw[q] -= fo[q]; }
                    u32x4 o; o.x = pk2(pz[0], pz[1]); o.y = pk2(pz[2], pz[3]); o.z = pk2(pz[4], pz[5]); o.w = pk2(pz[6], pz[7]);
                    *(u32x4*)(A2b + (size_t)r * 1024 + 8 * lane) = o;
                    float xc[8];
                    const u32x4 t0 = cr[0], t1 = cr[1], t2 = cr[2];
                    const float f0[8] = {bflo(t0.x), bfhi(t0.x), bflo(t0.y), bfhi(t0.y), bflo(t0.z), bfhi(t0.z), bflo(t0.w), bfhi(t0.w)};
                    const float f1[8] = {bflo(t1.x), bfhi(t1.x), bflo(t1.y), bfhi(t1.y), bflo(t1.z), bfhi(t1.z), bflo(t1.w), bfhi(t1.w)};
                    const float f2[8] = {bflo(t2.x), bfhi(t2.x), bflo(t2.y), bfhi(t2.y), bflo(t2.z), bfhi(t2.z), bflo(t2.w), bfhi(t2.w)};
                    const float f3[8] = {bflo(cn.x), bfhi(cn.x), bflo(cn.y), bfhi(cn.y), bflo(cn.z), bfhi(cn.z), bflo(cn.w), bfhi(cn.w)};
#pragma unroll
                    for (int q = 0; q < 8; ++q) xc[q] = cb[q] + f0[q] * cw[0][q] + f1[q] * cw[1][q] + f2[q] * cw[2][q] + f3[q] * cw[3][q];
                    cr[0] = t1; cr[1] = t2; cr[2] = cn;
                    u32x4 o2; o2.x = pk2(xc[0], xc[1]); o2.y = pk2(xc[2], xc[3]); o2.z = pk2(xc[4], xc[5]); o2.w = pk2(xc[6], xc[7]);
                    *(u32x4*)(A2b + (size_t)r * 1024 + 512 + 8 * lane) = o2;
                }
            }
            LSEAM(P + 1);
        }
        if (PHEN(4) && odd && IN(P + 1)) {
            PH_LOCALS;
            LAS float* STAT = (LAS float*)lds;
            LAS unsigned char* WSS = lds + 1024;
            LAS unsigned char* VT = lds + 1024 + 34816;
            const float* lng = kin(I_SGLNG) + jj * 1024, * lnb = kin(I_SGLNB) + jj * 1024;
            const bf16_t* WSMp = (const bf16_t*)(ws + WS_WSM) + (size_t)jj * 8 * 128 * 128;
            const float* bs = kin(I_SGBS) + jj * 8 * 128;
            const int fr = lane & 15, fq = lane >> 4;
            for (int it = vcu; it < T / 128; it += G) {
                const size_t row0 = (size_t)it * 128;
#pragma unroll 1
                for (int rb = 0; rb < 2; ++rb) {
                    u32x4 a8[8], b8[8];
#pragma unroll
                    for (int q = 0; q < 8; ++q) { const bf16_t* vp = Zb + (row0 + wave * 16 + rb * 8 + q) * 2048 + 1024; a8[q] = *(const u32x4*)(vp + 8 * lane); b8[q] = *(const u32x4*)(vp + 512 + 8 * lane); }
                    float sm[8], sq[8];
#pragma unroll
                    for (int q = 0; q < 8; ++q) {
                        const float f[16] = {bflo(a8[q].x), bfhi(a8[q].x), bflo(a8[q].y), bfhi(a8[q].y), bflo(a8[q].z), bfhi(a8[q].z), bflo(a8[q].w), bfhi(a8[q].w),
                                             bflo(b8[q].x), bfhi(b8[q].x), bflo(b8[q].y), bfhi(b8[q].y), bflo(b8[q].z), bfhi(b8[q].z), bflo(b8[q].w), bfhi(b8[q].w)};
                        float s1 = 0.f, s2 = 0.f;
#pragma unroll
                        for (int e = 0; e < 16; ++e) { s1 += f[e]; s2 += f[e] * f[e]; }
                        sm[q] = s1; sq[q] = s2;
                    }
#pragma unroll
                    for (int o = 1; o < 64; o <<= 1) {
#pragma unroll
                        for (int q = 0; q < 8; ++q) { sm[q] += __builtin_bit_cast(float, __builtin_amdgcn_ds_bpermute((lane ^ o) << 2, __builtin_bit_cast(int, sm[q])));
                            sq[q] += __builtin_bit_cast(float, __builtin_amdgcn_ds_bpermute((lane ^ o) << 2, __builtin_bit_cast(int, sq[q]))); }
                    }
                    if (lane < 8) { float m_ = sm[0], q_ = sq[0];
#pragma unroll
                        for (int q = 1; q < 8; ++q) { m_ = lane == q ? sm[q] : m_; q_ = lane == q ? sq[q] : q_; }
                        const float mean = m_ * (1.0f / 1024.0f), var = fmaxf(q_ * (1.0f / 1024.0f) - mean * mean, 0.f);
                        const int r = wave * 16 + rb * 8 + lane; STAT[2 * r] = mean; STAT[2 * r + 1] = 1.0f / sqrtf(var + LN_EPS); }
                }
                __syncthreads();
                u32x4 wv[4], vv[4];
#pragma unroll
                for (int i = 0; i < 4; ++i) { const int q = tid + 512 * i, row = q >> 4, c16 = q & 15;
                    wv[i] = *(const u32x4*)(WSMp + ((size_t)0 * 128 + row) * 128 + c16 * 8);
                    vv[i] = *(const u32x4*)(Zb + (row0 + row) * 2048 + 1024 + 0 * 128 + c16 * 8); }
#pragma unroll 1
                for (int hd = 0; hd < 8; ++hd) {
#pragma unroll
                    for (int i = 0; i < 4; ++i) {
                        const int q = tid + 512 * i, row = q >> 4, c16 = q & 15;
                        *(LAS u32x4*)(WSS + row * 272 + c16 * 16) = wv[i];
                        const u32x4 v4 = vv[i];
                        const float mean = STAT[2 * row], rstd = STAT[2 * row + 1];
                        const float f[8] = {bflo(v4.x), bfhi(v4.x), bflo(v4.y), bfhi(v4.y), bflo(v4.z), bfhi(v4.z), bflo(v4.w), bfhi(v4.w)};
                        const f32x4 g0 = *(const f32x4*)(lng + hd * 128 + c16 * 8), g1 = *(const f32x4*)(lng + hd * 128 + c16 * 8 + 4);
                        const f32x4 b0 = *(const f32x4*)(lnb + hd * 128 + c16 * 8), b1 = *(const f32x4*)(lnb + hd * 128 + c16 * 8 + 4);
                        const float gg[8] = {g0[0], g0[1], g0[2], g0[3], g1[0], g1[1], g1[2], g1[3]}, bb[8] = {b0[0], b0[1], b0[2], b0[3], b1[0], b1[1], b1[2], b1[3]};
#pragma unroll
                        for (int q2 = 0; q2 < 8; ++q2) {
                            const int c = c16 * 8 + q2;
                            const int rho = (c & ~31) | (((c >> 2) & 1) << 4) | (((c >> 3) & 3) << 2) | (c & 3);
                            *(LAS bf16_t*)(VT + rho * 272 + row * 2) = (bf16_t)f2bf((f[q2] - mean) * rstd * gg[q2] + bb[q2]);
                        }
                    }
                    const int hn = hd < 7 ? hd + 1 : 7;
#pragma unroll
                    for (int i = 0; i < 4; ++i) { const int q = tid + 512 * i, row = q >> 4, c16 = q & 15;
                        wv[i] = *(const u32x4*)(WSMp + ((size_t)hn * 128 + row) * 128 + c16 * 8);
                        vv[i] = *(const u32x4*)(Zb + (row0 + row) * 2048 + 1024 + hn * 128 + c16 * 8); }
                    const int t = 16 * wave + fr; const float bst = bs[hd * 128 + t];
                    const size_t rowg = row0 + t;
                    u32x4 uv[4];
#pragma unroll
                    for (int q = 0; q < 4; ++q) uv[q] = *(const u32x4*)(Zb + rowg * 2048 + hd * 128 + 32 * q + 8 * fq);
                    __syncthreads();
                    bf16x8 afr[4];
#pragma unroll
                    for (int ks = 0; ks < 4; ++ks) afr[ks] = *(const LAS bf16x8*)(WSS + (16 * wave + fr) * 272 + (32 * ks + 8 * fq) * 2);
                    f32x4 acc[8];
#pragma unroll
                    for (int tn = 0; tn < 8; ++tn) { acc[tn] = (f32x4){0.f, 0.f, 0.f, 0.f};
#pragma unroll
                        for (int ks = 0; ks < 4; ++ks) { const bf16x8 vfr = *(const LAS bf16x8*)(VT + (16 * tn + fr) * 272 + (32 * ks + 8 * fq) * 2);
                            acc[tn] = __builtin_amdgcn_mfma_f32_16x16x32_bf16(vfr, afr[ks], acc[tn], 0, 0, 0); } }
#pragma unroll
                    for (int q = 0; q < 4; ++q) {
                        const int c0 = hd * 128 + 32 * q + 8 * fq;
                        const u32x4 u4 = uv[q];
                        const f32x4 s0 = acc[2 * q] + bst, s1 = acc[2 * q + 1] + bst;
                        if (FP8_OUTP) { u32x2 o; o.x = pk4_fp8(bflo(u4.x) * s0[0], bfhi(u4.x) * s0[1], bflo(u4.y) * s0[2], bfhi(u4.y) * s0[3]);
                            o.y = pk4_fp8(bflo(u4.z) * s1[0], bfhi(u4.z) * s1[1], bflo(u4.w) * s1[2], bfhi(u4.w) * s1[3]);
                            *(u32x2*)((unsigned char*)YMb + rowg * 1024 + c0) = o; }
                        else { u32x4 o; o.x = pk2(bflo(u4.x) * s0[0], bfhi(u4.x) * s0[1]); o.y = pk2(bflo(u4.y) * s0[2], bfhi(u4.y) * s0[3]);
                        o.z = pk2(bflo(u4.z) * s1[0], bfhi(u4.z) * s1[1]); o.w = pk2(bflo(u4.w) * s1[2], bfhi(u4.w) * s1[3]);
                        *(u32x4*)(YMb + rowg * 1024 + c0) = o; }
                    }
                    __syncthreads();
                }
            }
            SEAM(P + 1);
        }
        if (PHEN(5) && !odd && IN(P + 2)) {
            PH_LOCALS;
            {
                pg8::Gemm g{A2b, (const bf16_t*)(ws + WS_BPOOL) + (size_t)jj * 512 * 512, 1024, 512, 256, 127};
                pg8::DenseSched S; S.init(T, 512, G, bx); S.kblk = 512; S.rowm = (FUSE_LOCAL && G == 256) ? 1 : 0;
                pg8::EpiDense<0, false, true, false, FP8_OUTP != 0> E{YMb, 1024, nullptr, kin(I_POOLS) + jj * 512, 0.f};
                pg8::gemm_phase<false>(lds, g, S, E, wave0);
            }
            {
                pg8::Gemm g{A2b + 512, (const bf16_t*)(ws + WS_BGATE) + (size_t)jj * 1024 * 512, 1024, 512, 256, 127};
                pg8::DenseSched S; S.init(T, 1024, G, bx); S.kblk = 512; S.rowm = (FUSE_LOCAL && G == 256) ? 1 : 0;
                pg8::EpiDense<2, true, false> E{RIb, 1024, (const float*)(ws + WS_BIASRI) + jj * 1024, nullptr, 0.f};
                pg8::gemm_phase<false>(lds, g, S, E, wave0);
            }
            LSEAM(P + 2);
        }
        scan_phase<L, 0>(lo, hi, G, bar, wave0); scan_phase<L, 1>(lo, hi, G, bar, wave0);
        if (PHEN(7) && IN(P + 5)) {
            PH_LOCALS;
            const float* bo = odd ? kin(I_SGBOUT) + jj * 1024 : kin(I_ABBOUT) + jj * 1024;
            pg8::DenseSched S; S.init(T, 1024, G, bx);
            if (FP8_OUTP) { const unsigned char* wt = odd ? ws + WS_SGOUT + (size_t)jj * 1024 * 1024 : ws + WS_ABOUT + (size_t)jj * 1024 * 1024;
                pg8::Gemm g{YMb, wt, 1024, 1024, 1024, 121};
                pg8::EpiDense<0, true, false, true> E{Yb, 1024, bo, nullptr, 1.0f / 64.0f};
                pg8::gemm_phase<true>(lds, g, S, E, wave0); }
            else { const bf16_t* wt = odd ? (const bf16_t*)(ws + WS_SGOUT) + (size_t)jj * 1024 * 1024 : (const bf16_t*)(ws + WS_ABOUT) + (size_t)jj * 1024 * 1024;
                pg8::Gemm g{YMb, wt, 1024, 1024, 1024, 127};
                pg8::EpiDense<0, true, false> E{Yb, 1024, bo, nullptr, 0.f};
                pg8::gemm_phase<false>(lds, g, S, E, wave0); }
            SEAM(P + 5);
        }
        ln_phase<L, 0>(lo, hi, G, bar, wave0);
            if (PHEN(9) && IN(P + 7)) {
            PH_LOCALS;
                pg8::Gemm g{ROUTER_X ? (const bf16_t*)(ws + WS_XB) : Hb, ROUTER_X ? (const bf16_t*)(ws + WS_BRB) + (size_t)l * 16 * 64 * 1024 : (const bf16_t*)(ws + WS_BR) + (size_t)l * 256 * 1024, 1024, 1024, 1024, 127};
                pg8::DenseSched S; S.init(T, 256, G, bx); if (ROUTER_X) S.bb = 64;
                pg8::EpiRouter E{LOGf};
                pg8::gemm_phase<false>(lds, g, S, E, wave0);
                LSEAM(P + 7);
            }
            if (PHEN(10) && IN(P + 8)) {
            PH_LOCALS;
                volatile LAS unsigned* hist = LCTL + 96; volatile LAS unsigned* basev = LCTL + 128;
                unsigned* gcnt = ctl + CW_CNT + 64 * l;
                const int TPB = (FUSE_LOCAL && G == 256) ? 256 : 512;
                for (int t0 = vcu * TPB; t0 < T; t0 += G * TPB) {
                    if (tid < 32) hist[tid] = 0u;
                    __syncthreads();
                    const bool act = tid < TPB;
                    const int tok = t0 + (act ? tid : 0);
                    float lv[32];
                    { const f32x4* lp = (const f32x4*)(LOGf + (size_t)tok * 64);
#pragma unroll
                      for (int q = 0; q < 8; ++q) { const f32x4 a = lp[q], b2 = lp[8 + q], rb = ROUTER_X ? *(const f32x4*)((const float*)(ws + WS_CB) + (l * 16 + (t0 >> 12)) * 32 + 4 * q) : *(const f32x4*)(kin(I_RB) + l * 32 + 4 * q);
                          lv[4 * q + 0] = a[0] + b2[0] + rb[0]; lv[4 * q + 1] = a[1] + b2[1] + rb[1]; lv[4 * q + 2] = a[2] + b2[2] + rb[2]; lv[4 * q + 3] = a[3] + b2[3] + rb[3]; } }
                    float v0 = -3.0e38f, v1 = -3.0e38f, v2 = -3.0e38f, v3 = -3.0e38f; int i0 = 0, i1 = 0, i2 = 0, i3 = 0;
#pragma unroll
                    for (int e = 0; e < 32; ++e) {
                        const float x = lv[e];
                        if (x > v3) {
                            if (x > v0) { v3 = v2; i3 = i2; v2 = v1; i2 = i1; v1 = v0; i1 = i0; v0 = x; i0 = e; }
                            else if (x > v1) { v3 = v2; i3 = i2; v2 = v1; i2 = i1; v1 = x; i1 = e; }
                            else if (x > v2) { v3 = v2; i3 = i2; v2 = x; i2 = e; }
                            else { v3 = x; i3 = e; }
                        }
                    }
                    const float e1 = __expf(v1 - v0), e2 = __expf(v2 - v0), e3 = __expf(v3 - v0), inv = 1.0f / (1.0f + e1 + e2 + e3);
                    if (act) *(f32x4*)(TOPG + (size_t)tok * 4) = (f32x4){inv, e1 * inv, e2 * inv, e3 * inv};
                    LAS unsigned* hp = (LAS unsigned*)hist;
                    unsigned r0 = 0u, r1 = 0u, r2 = 0u, r3 = 0u;
                    if (act) { r0 = __hip_atomic_fetch_add(hp + i0, 1u, __ATOMIC_RELAXED, __HIP_MEMORY_SCOPE_WORKGROUP); r1 = __hip_atomic_fetch_add(hp + i1, 1u, __ATOMIC_RELAXED, __HIP_MEMORY_SCOPE_WORKGROUP);
                        r2 = __hip_atomic_fetch_add(hp + i2, 1u, __ATOMIC_RELAXED, __HIP_MEMORY_SCOPE_WORKGROUP); r3 = __hip_atomic_fetch_add(hp + i3, 1u, __ATOMIC_RELAXED, __HIP_MEMORY_SCOPE_WORKGROUP); }
                    __syncthreads();
                    if (tid < 32) basev[tid] = __hip_atomic_fetch_add(gcnt + tid, hist[tid], __ATOMIC_RELAXED, __HIP_MEMORY_SCOPE_AGENT);
                    __syncthreads();
                    if (act) {
                    LIST[(size_t)i0 * TKTOT + basev[i0] + r0] = tok * 4 + 0;
                    LIST[(size_t)i1 * TKTOT + basev[i1] + r1] = tok * 4 + 1;
                    LIST[(size_t)i2 * TKTOT + basev[i2] + r2] = tok * 4 + 2;
                    LIST[(size_t)i3 * TKTOT + basev[i3] + r3] = tok * 4 + 3; }
                    __syncthreads();
                }
                SEAM(P + 8);
            }
            if (PHEN(11) && IN(P + 9)) {
                PH_LOCALS;
                volatile LAS int* cnts = (volatile LAS int*)(LCTL + 16); volatile LAS int* tstart = (volatile LAS int*)(LCTL + 48);
                if (tid < 32) cnts[tid] = (int)__hip_atomic_load(ctl + CW_CNT + 64 * l + tid, __ATOMIC_RELAXED, __HIP_MEMORY_SCOPE_AGENT);
                __syncthreads();
                if (tid == 0) { int s = 0; for (int e = 0; e < 32; ++e) { tstart[e] = s; s += (cnts[e] + 255) >> 8; } tstart[32] = s; }
                __syncthreads();
                LAS int* const utab = (LAS int*)(lds + UTAB_OFF);
                const int nunits = pg8::moe_build_units(utab, tstart, cnts, 8, G, MOE_PN_FAST ? vcu : bx, tid);
                __syncthreads();
                pg8::MoeSched S{(const LAS int*)utab, LIST, (const float*)(ws + WS_B1P) + (size_t)l * 32 * 2048, nunits, 2048, 2};
                pg8::EpiMoe1<FP8_M2 != 0> E{FP8_M2 ? (bf16_t*)(ws + WS_ACT8) : ACTb, lds, FP8_M1 ? 1.0f / 32.0f : 1.0f};
                if (FP8_M1) { pg8::Gemm g{ws + WS_H8, ws + WS_W1T8 + (size_t)l * 32 * 2048 * 1024, 1024, 1024, 1024, 122};
                    pg8::gemm_phase<true>(lds, g, S, E, wave0); }
                else { pg8::Gemm g{Hb, (const bf16_t*)(ws + WS_W1T) + (size_t)l * 32 * 2048 * 1024, 1024, 1024, 1024, 127};
                    pg8::gemm_phase<false>(lds, g, S, E, wave0); }
                SEAM(P + 9);
            }
            if (PHEN(12) && IN(P + 10)) {
                PH_LOCALS;
                volatile LAS int* cnts = (volatile LAS int*)(LCTL + 16); volatile LAS int* tstart = (volatile LAS int*)(LCTL + 48);
                __syncthreads();
                if (tid < 32) cnts[tid] = (int)__hip_atomic_load(ctl + CW_CNT + 64 * l + tid, __ATOMIC_RELAXED, __HIP_MEMORY_SCOPE_AGENT);
                __syncthreads();
                if (tid == 0) { int s = 0; for (int e = 0; e < 32; ++e) { tstart[e] = s; s += (cnts[e] + 255) >> 8; } tstart[32] = s; }
                __syncthreads();
                LAS int* const utab = (LAS int*)(lds + UTAB_OFF);
                const int nunits = pg8::moe_build_units(utab, tstart, cnts, 4, G, MOE_PN_FAST ? vcu : bx, tid);
                __syncthreads();
                pg8::MoeSched S{(const LAS int*)utab, LIST, kin(I_B2) + (size_t)l * 32 * 1024, nunits, 1024, 0};
                pg8::EpiMoe2 E{YSb, lds, FP8_M2 ? 1.0f / 64.0f : 1.0f};
                if (FP8_M2) { pg8::Gemm g{ws + WS_ACT8, ws + WS_W2T8 + (size_t)l * 32 * 1024 * 1024, 1024, 1024, 1024, 121};
                    pg8::gemm_phase<true>(lds, g, S, E, wave0); }
                else { pg8::Gemm g{ACTb, (const bf16_t*)(ws + WS_W2T) + (size_t)l * 32 * 1024 * 1024, 1024, 1024, 1024, 127};
                    pg8::gemm_phase<false>(lds, g, S, E, wave0); }
                SEAM(P + 10);
            }
        ln_phase<L, 1>(lo, hi, G, bar, wave0);
}

__global__ void __launch_bounds__(512, 2) fwd_kernel(Args args) {
    extern __shared__ __attribute__((aligned(16))) unsigned char lds_raw[];
    LAS unsigned char* const lds = (LAS unsigned char*)lds_raw;
    volatile LAS unsigned* const LCTL = (volatile LAS unsigned*)(lds + LDSCTL_OFF);
    const int G = gridDim.x;
    int lo, hi; unsigned* ctl0;
    { kptr_t kp = (kptr_t)__builtin_amdgcn_kernarg_segment_ptr(); lo = *(const __attribute__((address_space(4))) int*)(kp + 272); hi = *(const __attribute__((address_space(4))) int*)(kp + 276);
      ctl0 = (unsigned*)(*(unsigned char* const __attribute__((address_space(4)))*)(kp + 264) + WS_CTL); }
    const int wave0 = __builtin_amdgcn_readfirstlane((int)threadIdx.x >> 6);
    for (int u = threadIdx.x; u < (LDS_BYTES - LDSCTL_OFF) / 4; u += 512) LCTL[u] = 0u;
    __syncthreads();
    XcdBarrier bar; bar.bar = ctl0 + CW_BAR; bar.x = 0; bar.st = LCTL; bar.wv = wave0;
    if (hi - lo > 1) bar = xcd_barrier_post(ctl0 + CW_BAR, LCTL, wave0);
    if (PHEN(0) && IN(PH_CONV)) {
            PH_LOCALS;
        {
            LAS float* cact = (LAS float*)lds;
            LAS float* part = (LAS float*)(lds + 65536);
            if (bx < 384) {
                for (int i = tid; i < 16 * 1024; i += 512) { const float c = kin(I_C)[i]; cact[i] = c / (1.0f + __expf(-c)); }
                __syncthreads();
                for (int it = bx; it < 384; it += G) {
                    const int ls = it / 48, col0 = (it % 48) * 64;
                    const int kq = tid >> 6, cl = tid & 63;
                    const float* wp = kin(I_MODW) + (size_t)ls * 1024 * 3072 + col0 + cl;
                    float a[16];
#pragma unroll
                    for (int b = 0; b < 16; ++b) a[b] = 0.f;
#pragma unroll 4
                    for (int k = kq * 128; k < kq * 128 + 128; ++k) {
                        const float w = wp[(size_t)k * 3072];
#pragma unroll
                        for (int b = 0; b < 16; ++b) a[b] += cact[b * 1024 + k] * w;
                    }
#pragma unroll
                    for (int b = 0; b < 16; ++b) part[(kq * 16 + b) * 64 + cl] = a[b];
                    __syncthreads();
                    for (int o = tid; o < 1024; o += 512) {
                        const int b = o >> 6, c2 = o & 63; float s = 0.f;
#pragma unroll
                        for (int q = 0; q < 8; ++q) s += part[(q * 16 + b) * 64 + c2];
                        MOD[((size_t)ls * 16 + b) * 3072 + col0 + c2] = s + kin(I_MODB)[ls * 3072 + col0 + c2];
                    }
                    __syncthreads();
                }
            }
        }
        {
            constexpr int IT_ABIN = 2 * (FP8_INP_EVEN ? 8 : 16) * 48, IT_ABOUT = 2 * (FP8_OUTP ? 8 : 16) * 32, IT_SGIN = 2 * (FP8_INP_ODD ? 8 : 16) * 64, IT_SGOUT = 2 * (FP8_OUTP ? 8 : 16) * 32, IT_W1 = 128 * (FP8_M1 ? 8 : 16) * 64, IT_W2 = 128 * (FP8_M2 ? 8 : 16) * 32;
            constexpr int IT_ALL = IT_ABIN + IT_ABOUT + IT_SGIN + IT_SGOUT + IT_W1 + IT_W2;
            for (int it = gw; it < IT_ALL; it += NGW) {
                int r = it;
                if (r < IT_ABIN) { if (FP8_INP_EVEN) { const int mat = r / (8 * 48); conv_item_f8<false>(kin(I_ABWIN) + (size_t)mat * 1024 * 1536, 1536, ws + WS_ABIN + (size_t)mat * 1536 * 1024, r % (8 * 48), lane, 32.0f); }
                    else { const int mat = r / (16 * 48); conv_item<false>(kin(I_ABWIN) + (size_t)mat * 1024 * 1536, 1536, (bf16_t*)(ws + WS_ABIN) + (size_t)mat * 1536 * 1024, r % (16 * 48), lane); } continue; } r -= IT_ABIN;
                if (r < IT_ABOUT) { if (FP8_OUTP) { const int mat = r / (8 * 32); conv_item_f8<false>(kin(I_ABWOUT) + (size_t)mat * 1024 * 1024, 1024, ws + WS_ABOUT + (size_t)mat * 1024 * 1024, r % (8 * 32), lane, 64.0f); }
                    else { const int mat = r / (16 * 32); conv_item<false>(kin(I_ABWOUT) + (size_t)mat * 1024 * 1024, 1024, (bf16_t*)(ws + WS_ABOUT) + (size_t)mat * 1024 * 1024, r % (16 * 32), lane); } continue; } r -= IT_ABOUT;
                if (r < IT_SGIN) { if (FP8_INP_ODD) { const int mat = r / (8 * 64); conv_item_f8<false>(kin(I_SGWIN) + (size_t)mat * 1024 * 2048, 2048, ws + WS_SGIN + (size_t)mat * 2048 * 1024, r % (8 * 64), lane, 32.0f); }
                    else { const int mat = r / (16 * 64); conv_item<false>(kin(I_SGWIN) + (size_t)mat * 1024 * 2048, 2048, (bf16_t*)(ws + WS_SGIN) + (size_t)mat * 2048 * 1024, r % (16 * 64), lane); } continue; } r -= IT_SGIN;
                if (r < IT_SGOUT) { if (FP8_OUTP) { const int mat = r / (8 * 32); conv_item_f8<false>(kin(I_SGWOUT) + (size_t)mat * 1024 * 1024, 1024, ws + WS_SGOUT + (size_t)mat * 1024 * 1024, r % (8 * 32), lane, 64.0f); }
                    else { const int mat = r / (16 * 32); conv_item<false>(kin(I_SGWOUT) + (size_t)mat * 1024 * 1024, 1024, (bf16_t*)(ws + WS_SGOUT) + (size_t)mat * 1024 * 1024, r % (16 * 32), lane); } continue; } r -= IT_SGOUT;
                if (r < IT_W1) {
                    if (FP8_M1) { const int mat = r / (8 * 64); conv_item_f8<true>(kin(I_W1) + (size_t)mat * 1024 * 2048, 2048, ws + WS_W1T8 + (size_t)mat * 2048 * 1024, r % (8 * 64), lane, 32.0f); }
                    else { const int mat = r / (16 * 64); conv_item<true>(kin(I_W1) + (size_t)mat * 1024 * 2048, 2048, (bf16_t*)(ws + WS_W1T) + (size_t)mat * 2048 * 1024, r % (16 * 64), lane); }
                    continue; } r -= IT_W1;
                if (FP8_M2) { const int mat = r / (8 * 32); conv_item_f8<false>(kin(I_W2) + (size_t)mat * 1024 * 1024, 1024, ws + WS_W2T8 + (size_t)mat * 1024 * 1024, r % (8 * 32), lane, 64.0f); }
                else { const int mat = r / (16 * 32); conv_item<false>(kin(I_W2) + (size_t)mat * 1024 * 1024, 1024, (bf16_t*)(ws + WS_W2T) + (size_t)mat * 1024 * 1024, r % (16 * 32), lane); }
            }
        }
        {
            const int gt = vcu * 512 + tid, NGT = G * 512;
            bf16_t* BR = (bf16_t*)(ws + WS_BR);
            if (!ROUTER_X) for (int i = gt; i < 4 * 256 * 1024; i += NGT) {
                const int l = i >> 18, n = (i >> 10) & 255, k = i & 1023; unsigned v = 0;
                if (n < 64) { const float w = kin(I_RW)[((size_t)l * 1024 + k) * 32 + (n & 31)]; const unsigned h = f2bf(w); v = h;
                    if (n >= 32) v = f2bf(w - __builtin_bit_cast(float, h << 16)); }
                BR[i] = (bf16_t)v;
            }
            bf16_t* BP = (bf16_t*)(ws + WS_BPOOL);
            for (int i = gt; i < 2 * 512 * 512; i += NGT) {
                const int j = i >> 18, n = (i >> 9) & 511, k = i & 511; unsigned v = 0;
                if ((n >> 7) == (k >> 7)) v = f2bf(kin(I_POOLW)[(((size_t)j * 4 + (n >> 7)) * 128 + (k & 127)) * 128 + (n & 127)]);
                BP[i] = (bf16_t)v;
            }
            bf16_t* BG = (bf16_t*)(ws + WS_BGATE);
            for (int i = gt; i < 2 * 1024 * 512; i += NGT) {
                const int j = i >> 19, n = (i >> 9) & 1023, k = i & 511; unsigned v = 0; const int nn = n & 511;
                if ((nn >> 6) == (k >> 6)) { const float* w = (n < 512) ? kin(I_WA) : kin(I_WX); v = f2bf(w[(((size_t)j * 8 + (nn >> 6)) * 64 + (k & 63)) * 64 + (nn & 63)]); }
                BG[i] = (bf16_t)v;
            }
            bf16_t* WSMp = (bf16_t*)(ws + WS_WSM);
            for (int i = gt; i < 2 * 8 * 128 * 128; i += NGT) {
                const int t = (i >> 7) & 127, s = i & 127; WSMp[i] = (bf16_t)((s <= t) ? f2bf(kin(I_SGWS)[i]) : 0u);
            }
            float* BRI = (float*)(ws + WS_BIASRI);
            for (int i = gt; i < 2 * 1024; i += NGT) { const int j = i >> 10, n = i & 1023; BRI[i] = (n < 512) ? kin(I_BA)[j * 512 + n] : kin(I_BX)[j * 512 + n - 512]; }
            float* B1P = (float*)(ws + WS_B1P);
            for (int i = gt; i < 4 * 32 * 2048; i += NGT) { const int le = i >> 11, rho = i & 2047; B1P[i] = kin(I_B1)[(size_t)le * 2048 + w1_n_of_rho(rho)]; }
        }
        SEAM(PH_CONV);
    }

    if (PHEN(1) && IN(PH_H0)) {
            PH_LOCALS;
        const int rows_per = T / NGW, r0 = gw * rows_per;
        const int b = r0 / SEQ;
        const float* shp = MOD + ((size_t)0 * 16 + b) * 3072, * scp = shp + 1024;
        f32x4 sh[4], sc[4];
#pragma unroll
        for (int j = 0; j < 4; ++j) { sh[j] = *(const f32x4*)(shp + 4 * (64 * j + lane)); sc[j] = *(const f32x4*)(scp + 4 * (64 * j + lane)); }
        for (int r = r0; r < r0 + rows_per; ++r) {
            const f32x4* xr = (const f32x4*)(kin(I_X) + (size_t)r * D) + lane;
            u32x2* hr = (u32x2*)(Hb + (size_t)r * D) + lane;
#pragma unroll
            for (int j = 0; j < 4; ++j) { const f32x4 v = xr[64 * j]; const f32x4 h = v * (sc[j] + 1.0f) + sh[j];
                if (FP8_INP_EVEN) ((unsigned*)(ws + WS_H8 + (size_t)r * D) + lane)[64 * j] = pk4_fp8(h[0], h[1], h[2], h[3]);
                else { u32x2 w; w.x = pk2(h[0], h[1]); w.y = pk2(h[2], h[3]); hr[64 * j] = w; } }
        }
        if (ROUTER_X) {
            bf16_t* BRB = (bf16_t*)(ws + WS_BRB);
            const float* rwp = kin(I_RW);
            for (int i = vcu * 512 + tid; i < 4 * 32 * 1024; i += G * 512) {
                const int l = i >> 15, e = (i >> 10) & 31, k = i & 1023;
                const float w = rwp[((size_t)l * 1024 + k) * 32 + e];
#pragma unroll 4
                for (int bq = 0; bq < 16; ++bq) {
                    const float wm = w * (1.0f + MOD[((size_t)(2 * l + 1) * 16 + bq) * 3072 + 1024 + k]);
                    const unsigned h = f2bf(wm), lo2 = f2bf(wm - __builtin_bit_cast(float, h << 16));
                    bf16_t* o = BRB + (((size_t)l * 16 + bq) * 64 + e) * 1024 + k; o[0] = (bf16_t)h; o[32 * 1024] = (bf16_t)lo2; }
            }
            for (int i = vcu * 512 + tid; i < 192 * 1024 / 2; i += G * 512) ((unsigned*)(BRB + (size_t)4 * 16 * 64 * 1024))[i] = 0u;
            const int it = vcu + G * wave;
            if (it < 512) {
                const int l = it >> 7, bq = (it >> 3) & 15, eq = it & 7;
                const float* shq = MOD + ((size_t)(2 * l + 1) * 16 + bq) * 3072;
                const f32x4* rw4 = (const f32x4*)(kin(I_RW) + (size_t)l * 1024 * 32) + eq;
                float sa[4] = {0.f, 0.f, 0.f, 0.f};
#pragma unroll
                for (int i2 = 0; i2 < 16; ++i2) { const int k = lane + 64 * i2; const f32x4 wv4 = rw4[(size_t)k * 8]; const float sk = shq[k]; sa[0] += wv4[0] * sk; sa[1] += wv4[1] * sk; sa[2] += wv4[2] * sk; sa[3] += wv4[3] * sk; }
#pragma unroll
                for (int o = 1; o < 64; o <<= 1) {
#pragma unroll
                    for (int c4 = 0; c4 < 4; ++c4) sa[c4] += __builtin_bit_cast(float, __builtin_amdgcn_ds_bpermute((lane ^ o) << 2, __builtin_bit_cast(int, sa[c4])));
                }
                const f32x4 rb4 = *(const f32x4*)(kin(I_RB) + l * 32 + 4 * eq);
                *(f32x4*)((float*)(ws + WS_CB) + (l * 16 + bq) * 32 + 4 * eq) = (f32x4){sa[0] + rb4[0], sa[1] + rb4[1], sa[2] + rb4[2], sa[3] + rb4[3]};
            }
        }
        SEAM(PH_H0);
    }

    layer_body<0>(lds, LCTL, lo, hi, G, bar, wave0); layer_body<1>(lds, LCTL, lo, hi, G, bar, wave0); layer_body<2>(lds, LCTL, lo, hi, G, bar, wave0); layer_body<3>(lds, LCTL, lo, hi, G, bar, wave0);
}
#undef IN
#undef SEAM

#ifdef DUMP_SPEC
struct DumpSrc { size_t off; int ld; int col0; };
__global__ void dump_kernel(const unsigned char* ws, float* out) {
    const DumpSrc srcs[8] = DUMP_SPEC;
    const size_t i = (size_t)blockIdx.x * blockDim.x + threadIdx.x;
    const int r = (int)(i >> 10), c = (int)(i & 1023), blk = c >> 7, cc = c & 127;
    const DumpSrc d = srcs[blk];
    const bf16_t* p = (const bf16_t*)(ws + d.off);
    out[i] = bf2f(p[(size_t)r * d.ld + d.col0 + cc]);
}
#endif
extern "C" void kernel_launch(void* const* d_in, const int* in_sizes, int n_in, void* d_out, int out_size, void* d_ws, size_t ws_size, hipStream_t stream) {
    static int grid = 0;
    if (grid == 0) {
        if (n_in != 32 || out_size != T * D || ws_size < WS_END) { fprintf(stderr, "kernel_launch: unexpected problem (n_in %d, out %d, ws %zu)\n", n_in, out_size, ws_size); grid = -1; return; }
        int dev = 0, cus = 0, per_cu = 0;
        if (hipGetDevice(&dev) != hipSuccess || hipDeviceGetAttribute(&cus, hipDeviceAttributeMultiprocessorCount, dev) != hipSuccess) { grid = -1; return; }
        if (hipFuncSetAttribute((const void*)fwd_kernel, hipFuncAttributeMaxDynamicSharedMemorySize, LDS_BYTES) != hipSuccess) { fprintf(stderr, "kernel_launch: hipFuncSetAttribute failed\n"); grid = -1; return; }
        if (hipOccupancyMaxActiveBlocksPerMultiprocessor(&per_cu, (const void*)fwd_kernel, 512, LDS_BYTES) != hipSuccess || per_cu < 1) fprintf(stderr, "kernel_launch: occupancy query says %d\n", per_cu);
        (void)hipGetLastError();
        grid = cus;
        if (grid * 8 > T || (T % (grid * 8)) != 0) { fprintf(stderr, "kernel_launch: grid %d does not divide the rows\n", grid); grid = -1; return; }
    }
    if (grid < 0) return;
    (void)hipMemsetAsync((char*)d_ws + WS_CTL, 0, CTL_ZERO_BYTES, stream);
    Args a{};
    for (int i = 0; i < 32; ++i) a.in[i] = (const float*)d_in[i];
    a.out = (float*)d_out; a.ws = (unsigned char*)d_ws;
#if MK_ONE_LAUNCH
    a.ph_lo = 0; a.ph_hi = NPH;
    hipLaunchKernelGGL(fwd_kernel, dim3(grid), dim3(512), LDS_BYTES, stream, a);
#else
#ifndef STOP_PH
#define STOP_PH NPH
#endif
    for (int ph = 0; ph < STOP_PH; ++ph) {
        if (!phase_exists(ph)) continue;
        a.ph_lo = ph; a.ph_hi = ph + 1;
        hipLaunchKernelGGL(fwd_kernel, dim3(grid), dim3(512), LDS_BYTES, stream, a);
#ifdef REP_SLOTS
        { const int slot = ph < PH_L0 ? ph : 2 + (ph - PH_L0) % PH_PER_LAYER; if ((REP_SLOTS >> slot) & 1) {
#ifdef PROBE_VARIANTS
            a.variant = PROBE_VARIANTS;
#endif
            hipLaunchKernelGGL(fwd_kernel, dim3(grid), dim3(512), LDS_BYTES, stream, a); a.variant = 0; } }
#endif
    }
#ifdef DUMP_SPEC
    hipLaunchKernelGGL(dump_kernel, dim3(T * 1024 / 256), dim3(256), 0, stream, (const unsigned char*)d_ws, (float*)d_out);
#endif
#endif
}
```

```cpp
#include <hip/hip_runtime.h>
#include <cstdio>
#include <cstdint>

#ifndef PIN_ACC
#define PIN_ACC 0
#endif
#ifndef FP8_M1
#define FP8_M1 1
#endif
#ifndef FP8_M2
#define FP8_M2 1
#endif
#ifndef FP8_YS
#define FP8_INP_EVEN 0
#define FP8_INP_ODD 1
#define FP8_OUTP 1
#define WIDE_EPI 1
#define MOE_PN_FAST 1
#define MOE_XCD_OWN 1
#define FUSE_OUTP 1
#define FUSE_LOCAL 1
#define ROUTER_X 1
#define FP8_YS 1
#endif
#ifndef MK_ONE_LAUNCH
#define MK_ONE_LAUNCH 1
#endif

#ifndef PHMASK
#define PHMASK 0xFFFFF
#endif
#define PHEN(k) (((PHMASK) >> (k)) & 1)
#define LAS __attribute__((address_space(3)))
#define GAS __attribute__((address_space(1)))
typedef unsigned short bf16_t;
typedef short bf16x8 __attribute__((ext_vector_type(8)));
typedef float f32x4 __attribute__((ext_vector_type(4)));
typedef float f32x2 __attribute__((ext_vector_type(2)));
typedef unsigned u32x4 __attribute__((ext_vector_type(4)));
typedef unsigned u32x2 __attribute__((ext_vector_type(2)));

constexpr int D = 1024, NBATCH = 16, SEQ = 4096, T = NBATCH * SEQ, DEPTH = 4;
constexpr int NE = 32, TOPK = 4, TKTOT = T * TOPK;
constexpr int DPOOL = 512, DREC = 512, DINAB = 1536;
constexpr float LN_EPS = 1e-5f;
constexpr float DN_ALPHA = 1.6817928305074292f;

constexpr size_t MiB = 1ull << 20;
constexpr size_t WS_CTL = 0, CTL_ZERO_BYTES = 1 * MiB;
constexpr size_t WS_MOD = 1 * MiB;
constexpr size_t WS_BR = 3 * MiB;
constexpr size_t WS_BPOOL = 5 * MiB;
constexpr size_t WS_BGATE = 6 * MiB;
constexpr size_t WS_WSM = 8 * MiB;
constexpr size_t WS_BIASRI = 8 * MiB + 512 * 1024;
constexpr size_t WS_B1P = 9 * MiB;
constexpr size_t WS_SUMM = 10 * MiB;
constexpr size_t WS_TOPG = 12 * MiB;
constexpr size_t WS_ABIN = 16 * MiB;
constexpr size_t WS_ABOUT = 22 * MiB;
constexpr size_t WS_SGIN = 26 * MiB;
constexpr size_t WS_SGOUT = 34 * MiB;
constexpr size_t WS_LOG = 40 * MiB;
constexpr size_t WS_LIST = 64 * MiB;
constexpr size_t WS_BRB = 128 * MiB;
constexpr size_t WS_CB = 140 * MiB;
constexpr size_t WS_W1T = 128 * MiB;
constexpr size_t WS_W2T = 640 * MiB;
constexpr size_t WS_H = 896 * MiB;
constexpr size_t WS_Z = 1024 * MiB;
constexpr size_t WS_A2 = 1280 * MiB;
constexpr size_t WS_RI = 1408 * MiB;
constexpr size_t WS_YMIX = 1536 * MiB;
constexpr size_t WS_Y = 1664 * MiB;
constexpr size_t WS_ACT = 1792 * MiB;
constexpr size_t WS_YS = 2304 * MiB;
constexpr size_t WS_W1T8 = 2944 * MiB;
constexpr size_t WS_W2T8 = 3200 * MiB;
constexpr size_t WS_H8 = 3328 * MiB;
constexpr size_t WS_ACT8 = 3392 * MiB;
constexpr size_t WS_XB = 2816 * MiB;
constexpr size_t WS_END = 3648 * MiB;

constexpr int CW_BAR = 4096;
constexpr int CW_CNT = 16384;

constexpr int PH_CONV = 0, PH_H0 = 1, PH_L0 = 2, PH_PER_LAYER = 12, NPH = PH_L0 + PH_PER_LAYER * DEPTH;
__host__ __device__ constexpr bool phase_exists(int ph) {
    if (ph < PH_L0) return true;
    const int l = (ph - PH_L0) / PH_PER_LAYER, s = (ph - PH_L0) % PH_PER_LAYER;
    if ((l & 1) && (s == 2 || s == 3 || s == 4)) return false;
    return true;
}

constexpr int LDS_BYTES = 155648;
constexpr int LDSCTL_OFF = 154624;
constexpr int NXT_OFF = 131072;
constexpr int TAB_OFF = 147456;
constexpr int UTAB_OFF = 153600;

__device__ __forceinline__ unsigned f2bf(float f) { unsigned u = __builtin_bit_cast(unsigned, f); return (u + 0x7fffu + ((u >> 16) & 1u)) >> 16; }
typedef __bf16 bf16v2_t __attribute__((ext_vector_type(2)));
__device__ __forceinline__ unsigned pk2(float lo, float hi) { const f32x2 f = {lo, hi}; return __builtin_bit_cast(unsigned, __builtin_convertvector(f, bf16v2_t)); }
__device__ __forceinline__ float bflo(unsigned w) { return __builtin_bit_cast(float, w << 16); }
__device__ __forceinline__ float bfhi(unsigned w) { return __builtin_bit_cast(float, w & 0xffff0000u); }
__device__ __forceinline__ float bf2f(bf16_t h) { return __builtin_bit_cast(float, ((unsigned)h) << 16); }
__device__ __forceinline__ unsigned cvt_pk_bf16(float lo, float hi) { return pk2(lo, hi); }
__device__ __forceinline__ unsigned pk4_fp8(float a, float b, float c, float d) { int w = 0; w = __builtin_amdgcn_cvt_pk_fp8_f32(a, b, w, false); w = __builtin_amdgcn_cvt_pk_fp8_f32(c, d, w, true); return (unsigned)w; }
__device__ __forceinline__ float fast_sigmoid(float x) { return __builtin_amdgcn_rcpf(1.0f + __builtin_amdgcn_exp2f(-1.4426950408889634f * x)); }
__device__ __forceinline__ float gelu_tanh(float x) { const float u = x * (1.5957691216057308f + 0.07135481627362202f * x * x); return x * fast_sigmoid(u); }
__device__ __forceinline__ f32x2 pk_sigmoid_scaled(f32x2 x, float nk) {
    const f32x2 t = x * nk; f32x2 e; e.x = __builtin_amdgcn_exp2f(t.x); e.y = __builtin_amdgcn_exp2f(t.y);
    const f32x2 d = e + 1.0f; f32x2 r; r.x = __builtin_amdgcn_rcpf(d.x); r.y = __builtin_amdgcn_rcpf(d.y); return r; }
__device__ __forceinline__ f32x2 pk_gelu_tanh(f32x2 x) {
    const f32x2 t = x * ((x * x) * (-0.07135481627362202f * 1.4426950408889634f) + (-1.5957691216057308f * 1.4426950408889634f));
    f32x2 e; e.x = __builtin_amdgcn_exp2f(t.x); e.y = __builtin_amdgcn_exp2f(t.y);
    const f32x2 d = e + 1.0f; f32x2 r; r.x = __builtin_amdgcn_rcpf(d.x); r.y = __builtin_amdgcn_rcpf(d.y); return x * r; }
__device__ __forceinline__ float wave_sum(float v, int lane) {
#pragma unroll
    for (int o = 1; o < 64; o <<= 1) v += __builtin_bit_cast(float, __builtin_amdgcn_ds_bpermute((lane ^ o) << 2, __builtin_bit_cast(int, v)));
    return v;
}

__device__ __forceinline__ int lane_id_asm() { int l; asm volatile("v_mbcnt_lo_u32_b32 %0, -1, 0\n\tv_mbcnt_hi_u32_b32 %0, -1, %0" : "=v"(l)); return l; }
#define XB_TMO      128
#define XB_XCNT(j)  (256  + 64 * (j))
#define XB_XSUB(j)  (1280 + 64 * (j))
#define XB_XGEN(j)  (2304 + 64 * (j))
#define XB_TOP      3328
#define XB_TOPGEN   3392
#define XCD_BAR_WORDS 3456
#define XB_SPIN_CAP (1u << 18)

__device__ __forceinline__ unsigned xb_ld(unsigned* p)              { return __hip_atomic_load(p, __ATOMIC_RELAXED, __HIP_MEMORY_SCOPE_AGENT); }
__device__ __forceinline__ unsigned xb_add(unsigned* p, unsigned v) { return __hip_atomic_fetch_add(p, v, __ATOMIC_RELAXED, __HIP_MEMORY_SCOPE_AGENT); }
__device__ __forceinline__ unsigned xb_xcc_id() { return (unsigned)__builtin_amdgcn_s_getreg((3 << 11) | 20) & 0xFu; }
#define XB_SPIN(cond, bar) do { unsigned _sp = 0; while (cond) { __builtin_amdgcn_s_sleep(1); \
    if ((++_sp & 255u) == 0u) { if (xb_ld(&(bar)[XB_TMO])) break; if (_sp > XB_SPIN_CAP) { atomicAdd(&(bar)[XB_TMO], 1u); break; } } } } while (0)

struct XcdBarrier {
    unsigned* bar; unsigned x; int wv;
    volatile LAS unsigned* st;
};

__device__ __forceinline__ XcdBarrier xcd_barrier_post(unsigned* bar, volatile LAS unsigned* st, int wv) {
    XcdBarrier b; b.bar = bar; b.x = xb_xcc_id(); b.st = st; b.wv = wv;
    if (wv == 0 && lane_id_asm() == 0) (void)xb_add(&bar[XB_XCNT(b.x)], 1u);
    return b;
}
__device__ __forceinline__ void xcd_barrier_complete(unsigned* bar, unsigned x, unsigned& nloc, unsigned& nx) {
    const unsigned G = gridDim.x * gridDim.y * gridDim.z;
    unsigned sum, cnt, mine, sp = 0u;
    for (;;) {
        sum = 0u; cnt = 0u; mine = 0u;
#pragma unroll
        for (unsigned j = 0; j < 16; ++j) { const unsigned c = xb_ld(&bar[XB_XCNT(j)]); sum += c; cnt += (c > 0u) ? 1u : 0u; mine = (j == x) ? c : mine; }
        if (sum == G) break;
        __builtin_amdgcn_s_sleep(1);
        if ((++sp & 255u) == 0u) { if (xb_ld(&bar[XB_TMO])) break; if (sp > XB_SPIN_CAP) { atomicAdd(&bar[XB_TMO], 1u); break; } }
    }
    nloc = mine > 0u ? mine : 1u; nx = cnt > 0u ? cnt : 1u;
}

__device__ __forceinline__ void xcd_barrier(const XcdBarrier& b) {
    asm volatile("s_waitcnt vmcnt(0)" ::: "memory");
    __syncthreads();
    if (b.wv == 0 && lane_id_asm() == 0) {
        unsigned* bar = b.bar;
        __builtin_amdgcn_s_waitcnt(0);
        unsigned nloc = b.st[0], nx = b.st[1];
        if (nloc == 0u) { xcd_barrier_complete(bar, b.x, nloc, nx); b.st[0] = nloc; b.st[1] = nx; }
        const unsigned old = xb_add(&bar[XB_XSUB(b.x)], 1u);
        const unsigned gen = old / nloc;
        if (old + 1u == (gen + 1u) * nloc) {
            __builtin_amdgcn_fence(__ATOMIC_RELEASE, "agent");
            asm volatile("s_waitcnt vmcnt(0)" ::: "memory");
            const unsigned og = xb_add(&bar[XB_TOP], 1u);
            const unsigned tg = og / nx;
            if (og + 1u == (tg + 1u) * nx) xb_add(&bar[XB_TOPGEN], 1u);
            else XB_SPIN(xb_ld(&bar[XB_TOPGEN]) == tg, bar);
            __builtin_amdgcn_fence(__ATOMIC_ACQUIRE, "agent");
            xb_add(&bar[XB_XGEN(b.x)], 1u);
            asm volatile("s_waitcnt vmcnt(0)" ::: "memory");
        } else {
            XB_SPIN(xb_ld(&bar[XB_XGEN(b.x)]) == gen, bar);
            __builtin_amdgcn_fence(__ATOMIC_ACQUIRE, "agent");
            asm volatile("s_waitcnt vmcnt(0)" ::: "memory");
        }
    }
    __syncthreads();
}

#ifdef PROBE_VARIANTS
__device__ __forceinline__ int kvariant() { return *(const __attribute__((address_space(4))) int*)((const __attribute__((address_space(4))) unsigned char*)__builtin_amdgcn_kernarg_segment_ptr() + 280); }
#endif
__device__ __forceinline__ void glds16(const char* sbase, unsigned voff, unsigned lds_dst) {
    unsigned keep;
    asm volatile("s_mov_b32 %0, m0\n\ts_mov_b32 m0, %3\n\ts_nop 0\n\tglobal_load_lds_dwordx4 %1, %2\n\ts_mov_b32 m0, %0" : "=&s"(keep) : "v"(voff), "s"(sbase), "s"(lds_dst) : "memory");
}
__device__ __forceinline__ void glds4(const char* sbase, unsigned voff, unsigned lds_dst) {
    unsigned keep;
    asm volatile("s_mov_b32 %0, m0\n\ts_mov_b32 m0, %3\n\ts_nop 0\n\tglobal_load_lds_dword %1, %2\n\ts_mov_b32 m0, %0" : "=&s"(keep) : "v"(voff), "s"(sbase), "s"(lds_dst) : "memory");
}
namespace pg8 {
constexpr int BM = 256, BK = 64, HALF = 128, HTB = HALF * BK * 2, STAGE_BYTES = 8 * HTB, NXCD = 8, WGM = 8;
__host__ __device__ __forceinline__ int perm32(int rho) { const int n = rho >> 4, i = rho & 15; return 8 * (i >> 2) + 4 * n + (i & 3); }

template <bool F8> __host__ __device__ __forceinline__ int chunk_xor(int r15) { const int rp = (r15 >> 1) & 7; return F8 ? ((rp & 4) | ((rp & 1) << 1) | ((rp >> 1) & 1)) : rp; }
struct Unit { int arow, brow, pn, e, rt, cnt, slot, koff; };
struct Gemm { const void* A; const void* Bt; int lda, ldb, K, wscale; };
typedef int i32x4 __attribute__((ext_vector_type(4)));
typedef int i32x8 __attribute__((ext_vector_type(8)));
__device__ __forceinline__ i32x8 cat8(bf16x8 lo, bf16x8 hi) { return __builtin_shufflevector(__builtin_bit_cast(i32x4, lo), __builtin_bit_cast(i32x4, hi), 0, 1, 2, 3, 4, 5, 6, 7); }

struct DenseSched {
    static constexpr bool GATHER = false;
    int nM, nN, nwg, G, c, kblk = 0, bb = 0, rowm = 0;
    __device__ __forceinline__ void init(int M, int N, int G_, int c_) { nM = M / BM; nN = N / BM; nwg = nM * nN; G = G_; c = c_; }
    __device__ __forceinline__ bool next(int i, Unit& u) const {
        int pm, pn;
        if (rowm) { if (i >= nN) return false; pm = (c % NXCD) * (G / NXCD) + c / NXCD; pn = i; }
        else {
        const long L = (long)i * G + c; if (L >= nwg) return false;
        int wgid = (int)L; { const int q = nwg / NXCD, r = nwg % NXCD, xcd = wgid % NXCD, off = wgid / NXCD; wgid = (xcd < r ? xcd * (q + 1) : r * (q + 1) + (xcd - r) * q) + off; }
        const int nig = WGM * nN, gid = wgid / nig, fm = gid * WGM, gsz = (nM - fm) < WGM ? (nM - fm) : WGM;
        pm = fm + ((wgid % nig) % gsz); pn = (wgid % nig) / gsz; }
        u.arow = pm * BM; u.brow = pn * BM; u.pn = pn; u.e = 0; u.rt = pm; u.cnt = BM; u.slot = 0; u.koff = (pn & 1) * kblk; u.brow += ((pm * BM) >> 12) * bb; return true;
    }
    __device__ __forceinline__ void a_off(const Unit& u, LAS unsigned char*, int R0, int C0, int lda2, unsigned (&off)[2][2]) const {
#pragma unroll
        for (int h = 0; h < 2; ++h)
#pragma unroll
            for (int i = 0; i < 2; ++i) off[h][i] = (unsigned)((u.arow + 128 * h + 64 * i + R0) * lda2 + C0);
    }
};

struct MoeSched {
    static constexpr bool GATHER = true;
    const LAS int* utab;
    const int* list;
    const float* bias;
    int nunits, nexp_rows, shift;
    __device__ __forceinline__ bool next(int i, Unit& u) const {
        if (i >= nunits) return false;
        const LAS int* p = utab + 4 * i;
        u.e = __builtin_amdgcn_readfirstlane(p[0]); u.rt = __builtin_amdgcn_readfirstlane(p[1]); u.pn = __builtin_amdgcn_readfirstlane(p[2]); u.cnt = __builtin_amdgcn_readfirstlane(p[3]);
        u.arow = 0; u.brow = u.e * nexp_rows + u.pn * BM; u.slot = i % 3; u.koff = 0; return true;
    }
    __device__ __forceinline__ void tab_issue(const Unit& u, unsigned ldsb, int wid, int lane) const {
        if (wid < 4) { int p = u.rt * BM + 64 * wid + lane; p = p < u.cnt ? p : u.cnt - 1;
            glds4((const char*)(list + (size_t)u.e * TKTOT), (unsigned)p * 4u, ldsb + TAB_OFF + u.slot * 1024 + wid * 256); }
        else glds4((const char*)(bias + (size_t)u.e * nexp_rows + u.pn * BM), (unsigned)(64 * (wid - 4) + lane) * 4u, ldsb + TAB_OFF + 3072 + u.slot * 1024 + (wid - 4) * 256);
    }
    __device__ __forceinline__ void a_off(const Unit& u, LAS unsigned char* lds, int R0, int C0, int lda2, unsigned (&off)[2][2]) const {
        const LAS int* ids = (const LAS int*)(lds + TAB_OFF + u.slot * 1024);
#pragma unroll
        for (int h = 0; h < 2; ++h)
#pragma unroll
            for (int i = 0; i < 2; ++i) off[h][i] = (unsigned)((ids[128 * h + 64 * i + R0] >> shift) * lda2 + C0);
    }
};
__device__ __forceinline__ int moe_build_units(LAS int* utab, const volatile LAS int* tstart, const volatile LAS int* cnts, int NP, int G, int c, int tid) {
    if (MOE_XCD_OWN && (G % NXCD) == 0) {
        const int CX = G / NXCD, x = c / CX, j = c - x * CX, ttot = tstart[NE];
        const int glo = (int)((long)x * ttot / NXCD), ghi = (int)((long)(x + 1) * ttot / NXCD), total = (ghi - glo) * NP;
        if (tid < 64) { const int L = tid * CX + j;
            if (L < total) { const int g = glo + L / NP; int e = 0;
                for (int q = 0; q < NE - 1; ++q) if (tstart[q + 1] <= g) e = q + 1;
                utab[4 * tid + 0] = e; utab[4 * tid + 1] = g - tstart[e]; utab[4 * tid + 2] = L % NP; utab[4 * tid + 3] = cnts[e]; } }
        return total > j ? (total - j + CX - 1) / CX : 0;
    }
    const int total = tstart[NE] * NP;
    if (tid < 64) { const int L = tid * G + c;
        if (L < total) { int e = 0;
            for (int q = 0; q < NE - 1; ++q) if (tstart[q + 1] * NP <= L) e = q + 1;
            const int t0 = tstart[e], nte = tstart[e + 1] - t0, idx = L - t0 * NP;
            utab[4 * tid + 0] = e; utab[4 * tid + 1] = MOE_PN_FAST ? idx / NP : idx % nte; utab[4 * tid + 2] = MOE_PN_FAST ? idx % NP : idx / nte; utab[4 * tid + 3] = cnts[e]; } }
    return total > c ? (total - c + G - 1) / G : 0;
}

template <int ACT  , bool HAS_BIAS, bool HAS_SCALE, bool OSC = false, bool OUT8 = false> struct EpiDense {
    static constexpr int PERM = WIDE_EPI ? 2 : 1;
    bf16_t* O; int ldc; const float* bias; const float* scale; float oscale;
    __device__ __forceinline__ void operator()(const f32x4 (&acc)[2][2][4][2], const Unit& u, int wr, int wc, int fr, int fq) const {
        const int row0 = u.arow + wr * 64 + fr, col0 = PERM == 2 ? u.pn * BM + wc * 64 + 16 * fq : u.pn * BM + wc * 32 + 8 * fq;
        constexpr int BJS = PERM == 2 ? 8 : HALF;
        f32x4 bv[2][2], sv[2][2];
#pragma unroll
        for (int bj = 0; bj < 2; ++bj)
#pragma unroll
            for (int n = 0; n < 2; ++n) {
                if (HAS_BIAS) bv[bj][n] = *(const f32x4*)(bias + col0 + bj * BJS + 4 * n);
                if (HAS_SCALE) sv[bj][n] = *(const f32x4*)(scale + col0 + bj * BJS + 4 * n);
            }
#pragma unroll
        for (int ai = 0; ai < 2; ++ai)
#pragma unroll
            for (int m = 0; m < 4; ++m) { bf16_t* rowp = O + (size_t)(row0 + ai * HALF + m * 16) * ldc + col0; unsigned char* rowp8 = (unsigned char*)O + (size_t)(row0 + ai * HALF + m * 16) * ldc + col0;
                u32x4 w8;
#pragma unroll
                for (int bj = 0; bj < 2; ++bj) { f32x4 v0 = acc[ai][bj][m][0], v1 = acc[ai][bj][m][1];
                    if (OSC) { v0 = v0 * oscale; v1 = v1 * oscale; }
                    if (HAS_BIAS) { v0 = v0 + bv[bj][0]; v1 = v1 + bv[bj][1]; }
                    if (ACT == 1) { const f32x2 a = pk_gelu_tanh((f32x2){v0[0], v0[1]}), b = pk_gelu_tanh((f32x2){v0[2], v0[3]}), c = pk_gelu_tanh((f32x2){v1[0], v1[1]}), d = pk_gelu_tanh((f32x2){v1[2], v1[3]});
                        v0 = (f32x4){a.x, a.y, b.x, b.y}; v1 = (f32x4){c.x, c.y, d.x, d.y}; }
                    if (ACT == 2) { const float nk = -1.4426950408889634f;
                        const f32x2 a = pk_sigmoid_scaled((f32x2){v0[0], v0[1]}, nk), b = pk_sigmoid_scaled((f32x2){v0[2], v0[3]}, nk), c = pk_sigmoid_scaled((f32x2){v1[0], v1[1]}, nk), d = pk_sigmoid_scaled((f32x2){v1[2], v1[3]}, nk);
                        v0 = (f32x4){a.x, a.y, b.x, b.y}; v1 = (f32x4){c.x, c.y, d.x, d.y}; }
                    if (HAS_SCALE) { v0 = v0 * sv[bj][0]; v1 = v1 * sv[bj][1]; }
                    if constexpr (OUT8) { const unsigned p0 = pk4_fp8(v0[0], v0[1], v0[2], v0[3]), p1 = pk4_fp8(v1[0], v1[1], v1[2], v1[3]);
                        if constexpr (PERM == 2) { if (bj == 0) { w8.x = p0; w8.y = p1; } else { w8.z = p0; w8.w = p1; *(u32x4*)rowp8 = w8; } }
                        else { u32x2 w; w.x = p0; w.y = p1; *(u32x2*)(rowp8 + bj * HALF) = w; } }
                    else { u32x4 w; w.x = cvt_pk_bf16(v0[0], v0[1]); w.y = cvt_pk_bf16(v0[2], v0[3]); w.z = cvt_pk_bf16(v1[0], v1[1]); w.w = cvt_pk_bf16(v1[2], v1[3]);
                    *(u32x4*)(rowp + bj * BJS) = w; } } }
    }
};
struct EpiRouter {
    static constexpr int PERM = 0;
    float* LOG;
    __device__ __forceinline__ void operator()(const f32x4 (&acc)[2][2][4][2], const Unit& u, int wr, int wc, int fr, int fq) const {
        if (wc < 2) {
#pragma unroll
            for (int ai = 0; ai < 2; ++ai)
#pragma unroll
                for (int m = 0; m < 4; ++m) { float* rowp = LOG + (size_t)(u.arow + ai * HALF + wr * 64 + m * 16 + fr) * 64 + wc * 32 + 4 * fq;
#pragma unroll
                    for (int n = 0; n < 2; ++n) *(f32x4*)(rowp + 16 * n) = acc[ai][0][m][n]; }
        }
    }
};
template <bool OUT8> struct EpiMoe1 {
    static constexpr int PERM = 0;
    bf16_t* ACT; LAS unsigned char* lds; float oscale;
    __device__ __forceinline__ void operator()(const f32x4 (&acc)[2][2][4][2], const Unit& u, int wr, int wc, int fr, int fq) const {
        const LAS int* ids = (const LAS int*)(lds + TAB_OFF + u.slot * 1024);
        const LAS float* bp = (const LAS float*)(lds + TAB_OFF + 3072 + u.slot * 1024) + wc * 32 + 4 * fq;
        f32x4 bg[2], bl[2];
#pragma unroll
        for (int bj = 0; bj < 2; ++bj) { bg[bj] = *(const LAS f32x4*)(bp + bj * HALF); bl[bj] = *(const LAS f32x4*)(bp + bj * HALF + 16) + 1.0f; }
        const int j0 = u.pn * 128 + wc * 32 + 8 * fq;
#pragma unroll
        for (int ai = 0; ai < 2; ++ai)
#pragma unroll
            for (int m = 0; m < 4; ++m) {
                const int pl = ai * HALF + wr * 64 + m * 16 + fr;
                if (u.rt * BM + pl < u.cnt) {
                    const int flat = ids[pl];
                    float o[8];
#pragma unroll
                    for (int bj = 0; bj < 2; ++bj) { const f32x4 g = acc[ai][bj][m][0] * oscale + bg[bj], l = acc[ai][bj][m][1] * oscale + bl[bj];
#pragma unroll
                        for (int hh = 0; hh < 2; ++hh) {
                            const f32x2 xg = {fminf(g[2 * hh], 7.0f), fminf(g[2 * hh + 1], 7.0f)};
                            const f32x2 xl = {__builtin_amdgcn_fmed3f(l[2 * hh], -6.0f, 8.0f), __builtin_amdgcn_fmed3f(l[2 * hh + 1], -6.0f, 8.0f)};
                            const f32x2 r = pk_sigmoid_scaled(xg, -1.702f * 1.4426950408889634f), oo = (xg * xl) * r;
                            o[bj * 4 + 2 * hh] = oo.x; o[bj * 4 + 2 * hh + 1] = oo.y; } }
                    if constexpr (OUT8) { u32x2 w; w.x = pk4_fp8(o[0], o[1], o[2], o[3]); w.y = pk4_fp8(o[4], o[5], o[6], o[7]);
                        *(u32x2*)((unsigned char*)ACT + (size_t)flat * 1024 + j0) = w; }
                    else { u32x4 w; w.x = cvt_pk_bf16(o[0], o[1]); w.y = cvt_pk_bf16(o[2], o[3]); w.z = cvt_pk_bf16(o[4], o[5]); w.w = cvt_pk_bf16(o[6], o[7]);
                        *(u32x4*)(ACT + (size_t)flat * 1024 + j0) = w; }
                }
            }
    }
};
struct EpiMoe2 {
    static constexpr int PERM = (WIDE_EPI && FP8_YS) ? 2 : 1;
    bf16_t* YS; LAS unsigned char* lds; float oscale;
    __device__ __forceinline__ void operator()(const f32x4 (&acc)[2][2][4][2], const Unit& u, int wr, int wc, int fr, int fq) const {
        const LAS int* ids = (const LAS int*)(lds + TAB_OFF + u.slot * 1024);
        if constexpr (PERM == 2) {
            const LAS float* bp = (const LAS float*)(lds + TAB_OFF + 3072 + u.slot * 1024) + wc * 64 + 16 * fq;
            const int col0 = u.pn * BM + wc * 64 + 16 * fq;
            const float os = 16.0f * oscale;
#pragma unroll
            for (int ai = 0; ai < 2; ++ai) {
                const f32x4 b00 = *(const LAS f32x4*)(bp) * 16.0f, b01 = *(const LAS f32x4*)(bp + 4) * 16.0f, b10 = *(const LAS f32x4*)(bp + 8) * 16.0f, b11 = *(const LAS f32x4*)(bp + 12) * 16.0f;
#pragma unroll
                for (int m = 0; m < 4; ++m) {
                    const int pl = ai * HALF + wr * 64 + m * 16 + fr;
                    if (u.rt * BM + pl < u.cnt) {
                        const int flat = ids[pl];
                        const f32x4 v00 = acc[ai][0][m][0] * os + b00, v01 = acc[ai][0][m][1] * os + b01, v10 = acc[ai][1][m][0] * os + b10, v11 = acc[ai][1][m][1] * os + b11;
                        u32x4 w; w.x = pk4_fp8(v00[0], v00[1], v00[2], v00[3]); w.y = pk4_fp8(v01[0], v01[1], v01[2], v01[3]); w.z = pk4_fp8(v10[0], v10[1], v10[2], v10[3]); w.w = pk4_fp8(v11[0], v11[1], v11[2], v11[3]);
                        *(u32x4*)((unsigned char*)YS + (size_t)flat * 1024 + col0) = w;
                    }
                }
            }
        } else {
        const LAS float* bp = (const LAS float*)(lds + TAB_OFF + 3072 + u.slot * 1024) + wc * 32 + 8 * fq;
        const int col0 = u.pn * BM + wc * 32 + 8 * fq;
#pragma unroll
        for (int bj = 0; bj < 2; ++bj) {
            const float os = FP8_YS ? 16.0f * oscale : oscale;
            const f32x4 b0 = *(const LAS f32x4*)(bp + bj * HALF) * (FP8_YS ? 16.0f : 1.0f), b1 = *(const LAS f32x4*)(bp + bj * HALF + 4) * (FP8_YS ? 16.0f : 1.0f);
#pragma unroll
            for (int ai = 0; ai < 2; ++ai)
#pragma unroll
                for (int m = 0; m < 4; ++m) {
                    const int pl = ai * HALF + wr * 64 + m * 16 + fr;
                    if (u.rt * BM + pl < u.cnt) {
                        const int flat = ids[pl];
                        const f32x4 v0 = acc[ai][bj][m][0] * os + b0, v1 = acc[ai][bj][m][1] * os + b1;
                        if (FP8_YS) { u32x2 w; w.x = pk4_fp8(v0[0], v0[1], v0[2], v0[3]); w.y = pk4_fp8(v1[0], v1[1], v1[2], v1[3]);
                            *(u32x2*)((unsigned char*)YS + (size_t)flat * 1024 + col0 + bj * HALF) = w; }
                        else { u32x4 w; w.x = cvt_pk_bf16(v0[0], v0[1]); w.y = cvt_pk_bf16(v0[2], v0[3]); w.z = cvt_pk_bf16(v1[0], v1[1]); w.w = cvt_pk_bf16(v1[2], v1[3]);
                            *(u32x4*)(YS + (size_t)flat * 1024 + col0 + bj * HALF) = w; }
                    }
                }
        }
        }
    }
};

template <bool F8, class Epi, class Sched>
__device__ __forceinline__ void gemm_phase(LAS unsigned char* lds, const Gemm g, const Sched& S, const Epi& E, const int wave0) {
    const int tid = (wave0 << 6) | lane_id_asm();
    const int wid = __builtin_amdgcn_readfirstlane(tid >> 6), lane = tid & 63, wr = wid >> 2, wc = wid & 3, fr = lane & 15, fq = lane >> 4;
    constexpr unsigned ESZ = F8 ? 1u : 2u;
    const int nt = (int)((unsigned)g.K * ESZ / 128u);
    int R0, C0;
    R0 = 8 * wid + (lane >> 3); C0 = 16 * ((lane & 7) ^ chunk_xor<F8>(R0 & 15));
    const unsigned lda2 = (unsigned)g.lda * ESZ, ldb2 = (unsigned)g.ldb * ESZ;
    const unsigned voffB = (unsigned)((Epi::PERM == 2 ? (64 * (R0 >> 5) + 16 * ((R0 >> 2) & 3) + 4 * ((R0 >> 4) & 1) + (R0 & 3)) : Epi::PERM == 1 ? ((R0 & ~31) + perm32(R0 & 31)) : R0) * (int)ldb2 + C0);
    constexpr int PIECE_B = Epi::PERM == 2 ? 128 : 64;
    const unsigned aoffl = (unsigned)(R0 * (int)lda2 + C0);
    const unsigned kstep = 128;
    const size_t hstepB = (size_t)(Epi::PERM == 2 ? 8 : HALF) * ldb2;
    const unsigned ldsw = (unsigned)wid * 1024u;
    const int ab = fr * 128 + 16 * ((F8 ? 2 * fq : fq) ^ chunk_xor<F8>(fr));
    const int aoff0 = wr * 8192 + ab, boff0 = wc * 4096 + ab;
    constexpr int KX = F8 ? 16 : 64;
    const char* const Abase = (const char*)g.A;
    const unsigned ldsb = (unsigned)(size_t)lds;
#define PG8_SA(b, h) (((b) * 2 + (h)) * HTB)
#define PG8_SB(b, h) ((4 + (b) * 2 + (h)) * HTB)
#define PG8_GOFF(h, NXT) do { if constexpr (Sched::GATHER) go = *(const LAS u32x2*)(lds + NXT_OFF + ((((NXT) ? ui + 1 : ui) & 1) << 13) + tid * 16 + (h) * 8); } while (0)
#define PG8_STAGE_A(bufoff, h, NXT, kb) do { _Pragma("unroll") for (int _i = 0; _i < 2; ++_i) { \
        if constexpr (Sched::GATHER) glds16(Abase + (kb), _i ? go.y : go.x, ldsb + (bufoff) + ldsw + _i * 8192); \
        else glds16(Abase + ((NXT) ? nxtA : curA) + (size_t)((h) * 128 + _i * 64) * lda2 + (kb), aoffl, ldsb + (bufoff) + ldsw + _i * 8192); } } while (0)
#define PG8_STAGE_B(bufoff, bptr, kb) do { _Pragma("unroll") for (int _i = 0; _i < 2; ++_i) \
        glds16((bptr) + (size_t)(_i * PIECE_B) * ldb2 + (kb), voffB, ldsb + (bufoff) + ldsw + _i * 8192); } while (0)
#define PG8_LDA(dst, b, h) do { int _a1 = aoff0 ^ KX; asm volatile("" : "+v"(_a1)); \
        _Pragma("unroll") for (int m = 0; m < 4; ++m) _Pragma("unroll") for (int k = 0; k < 2; ++k) dst[m][k] = *(const LAS bf16x8*)(lds + PG8_SA(b, h) + (k ? _a1 : aoff0) + m * 2048); } while (0)
#define PG8_LDB(dst, b, h) do { int _b1 = boff0 ^ KX; asm volatile("" : "+v"(_b1)); \
        _Pragma("unroll") for (int n = 0; n < 2; ++n) _Pragma("unroll") for (int k = 0; k < 2; ++k) dst[n][k] = *(const LAS bf16x8*)(lds + PG8_SB(b, h) + (k ? _b1 : boff0) + n * 2048); } while (0)
#define PG8_MMA(ai, bj, At, Bt) do { __builtin_amdgcn_s_setprio(1); _Pragma("unroll") for (int m = 0; m < 4; ++m) _Pragma("unroll") for (int n = 0; n < 2; ++n) { \
        if constexpr (F8) acc[ai][bj][m][n] = __builtin_amdgcn_mfma_scale_f32_16x16x128_f8f6f4(cat8(Bt[n][0], Bt[n][1]), cat8(At[m][0], At[m][1]), acc[ai][bj][m][n], 0, 0, 0, 0, 0, 0); \
        else { _Pragma("unroll") for (int k = 0; k < 2; ++k) acc[ai][bj][m][n] = __builtin_amdgcn_mfma_f32_16x16x32_bf16(Bt[n][k], At[m][k], acc[ai][bj][m][n], 0, 0, 0); } } \
        __builtin_amdgcn_s_setprio(0); } while (0)
#define PG8_WAIT_V(n) asm volatile("s_waitcnt vmcnt(" #n ")" ::: "memory")
#define PG8_WAIT_L(n) asm volatile("s_waitcnt lgkmcnt(" #n ")" ::: "memory")
#define PG8_BAR __builtin_amdgcn_s_barrier()
#define PG8_SCHED __builtin_amdgcn_sched_barrier(0)
#define PG8_KITER(k1, b2, NXT, k2, k3) do { \
        PG8_GOFF(1, 0); PG8_LDB(B0, 0, 0); PG8_LDB(B1, 0, 1); PG8_SCHED; PG8_LDA(At, 0, 0); PG8_STAGE_A(PG8_SA(1, 1), 1, 0, (k1)); \
        PG8_WAIT_V(8); PG8_WAIT_L(0); PG8_BAR; PG8_MMA(0, 0, At, B0); PG8_MMA(0, 1, At, B1); PG8_BAR; PG8_SCHED; \
        PG8_GOFF(0, NXT); PG8_LDA(At, 0, 1); PG8_STAGE_B(PG8_SB(0, 0), (b2), (k2)); PG8_STAGE_B(PG8_SB(0, 1), (b2) + hstepB, (k2)); PG8_STAGE_A(PG8_SA(0, 0), 0, NXT, (k2)); \
        PG8_WAIT_V(8); PG8_WAIT_L(0); PG8_BAR; PG8_MMA(1, 0, At, B0); PG8_MMA(1, 1, At, B1); PG8_BAR; PG8_SCHED; \
        PG8_GOFF(1, NXT); PG8_LDB(B0, 1, 0); PG8_LDB(B1, 1, 1); PG8_SCHED; PG8_LDA(At, 1, 0); PG8_STAGE_A(PG8_SA(0, 1), 1, NXT, (k2)); \
        PG8_WAIT_V(8); PG8_WAIT_L(0); PG8_BAR; PG8_MMA(0, 0, At, B0); PG8_MMA(0, 1, At, B1); PG8_BAR; PG8_SCHED; \
        PG8_GOFF(0, NXT); PG8_LDA(At, 1, 1); PG8_STAGE_B(PG8_SB(1, 0), (b2), (k3)); PG8_STAGE_B(PG8_SB(1, 1), (b2) + hstepB, (k3)); PG8_STAGE_A(PG8_SA(1, 0), 0, NXT, (k3)); \
        PG8_WAIT_V(8); PG8_WAIT_L(0); PG8_BAR; PG8_MMA(1, 0, At, B0); PG8_MMA(1, 1, At, B1); PG8_BAR; PG8_SCHED; } while (0)

    Unit cur, nxt; int ui = 0;
    if (!S.next(0, cur)) return;
    unsigned curoff[2][2], nxtoff[2][2];
    size_t curA = 0, nxtA = 0;
    bool has_next = S.next(1, nxt);
#define PG8_NXT_SLOT ((LAS u32x4*)(lds + NXT_OFF) + tid)
    if constexpr (Sched::GATHER) {
        S.tab_issue(cur, ldsb, wid, lane); if (has_next) S.tab_issue(nxt, ldsb, wid, lane);
        asm volatile("s_waitcnt vmcnt(0)" ::: "memory"); __builtin_amdgcn_s_barrier(); asm volatile("" ::: "memory");
        S.a_off(cur, lds, R0, C0, (int)lda2, curoff);
        if (has_next) S.a_off(nxt, lds, R0, C0, (int)lda2, nxtoff);
        else {
#pragma unroll
            for (int h = 0; h < 2; ++h)
#pragma unroll
                for (int i = 0; i < 2; ++i) nxtoff[h][i] = curoff[h][i]; }
        ((LAS u32x4*)(lds + NXT_OFF))[tid] = (u32x4){curoff[0][0], curoff[0][1], curoff[1][0], curoff[1][1]};
        ((LAS u32x4*)(lds + NXT_OFF + 8192))[tid] = (u32x4){nxtoff[0][0], nxtoff[0][1], nxtoff[1][0], nxtoff[1][1]};
    } else { curA = (size_t)cur.arow * lda2 + cur.koff; nxtA = has_next ? (size_t)nxt.arow * lda2 + nxt.koff : curA; }
    f32x4 acc[2][2][4][2];
#pragma unroll
    for (int a = 0; a < 2; ++a)
#pragma unroll
        for (int b = 0; b < 2; ++b)
#pragma unroll
            for (int m = 0; m < 4; ++m)
#pragma unroll
                for (int n = 0; n < 2; ++n) acc[a][b][m][n] = (f32x4){0.f, 0.f, 0.f, 0.f};
    bf16x8 At[4][2], B0[2][2], B1[2][2];
    const char* cB = (const char*)g.Bt + (size_t)cur.brow * ldb2 + cur.koff;
    u32x2 go = {0u, 0u};
    PG8_STAGE_B(PG8_SB(0, 0), cB, 0u); PG8_STAGE_B(PG8_SB(0, 1), cB + hstepB, 0u); PG8_GOFF(0, 0); PG8_STAGE_A(PG8_SA(0, 0), 0, 0, 0u); PG8_GOFF(1, 0); PG8_STAGE_A(PG8_SA(0, 1), 1, 0, 0u);
    if (wr == 1) PG8_BAR;
    PG8_WAIT_V(2); PG8_BAR;
    PG8_GOFF(0, 0); PG8_STAGE_B(PG8_SB(1, 0), cB, kstep); PG8_STAGE_A(PG8_SA(1, 0), 0, 0, kstep); PG8_STAGE_B(PG8_SB(1, 1), cB + hstepB, kstep);
    PG8_WAIT_V(6); PG8_BAR;
    for (;;) {
        const char* nB = has_next ? (const char*)g.Bt + (size_t)nxt.brow * ldb2 + nxt.koff : cB;
        Unit u2; bool has2 = false;
        if constexpr (Sched::GATHER) has2 = has_next && S.next(ui + 2, u2);
#pragma unroll 1
        for (int t = 0; t < nt - 2; t += 2) {
            const unsigned k1 = (unsigned)(t + 1) * kstep, k2 = (unsigned)(t + 2) * kstep, k3 = (unsigned)(t + 3) * kstep;
            if constexpr (Sched::GATHER) { if (t == 2 && has2) S.tab_issue(u2, ldsb, wid, lane); }
            PG8_KITER(k1, cB, 0, k2, k3);
        }
        { const unsigned k1 = (unsigned)(nt - 1) * kstep; PG8_KITER(k1, nB, 1, 0u, kstep); }
#if PIN_ACC
#pragma unroll
        for (int a = 0; a < 2; ++a)
#pragma unroll
            for (int b = 0; b < 2; ++b)
#pragma unroll
                for (int m = 0; m < 4; ++m) asm volatile("" : "+v"(acc[a][b][m][0]), "+v"(acc[a][b][m][1]));
#endif
        if (wr == 0) PG8_BAR;
#ifdef PROBE_VARIANTS
        if (!(kvariant() & 4))
#endif
        { const int l2 = lane_id_asm(); E(acc, cur, wr, wc, l2 & 15, l2 >> 4); }
        if (!has_next) break;
#pragma unroll
        for (int a = 0; a < 2; ++a)
#pragma unroll
            for (int b = 0; b < 2; ++b)
#pragma unroll
                for (int m = 0; m < 4; ++m)
#pragma unroll
                    for (int n = 0; n < 2; ++n) acc[a][b][m][n] = (f32x4){0.f, 0.f, 0.f, 0.f};
        cur = nxt; cB = nB; ++ui; curA = nxtA;
        has_next = S.next(ui + 1, nxt);
        if (has_next) {
            if constexpr (Sched::GATHER) { const int tz = (wave0 << 6) | lane_id_asm(); int R0z, C0z;
                { const int lz = tz & 63; R0z = 8 * wid + (lz >> 3); C0z = 16 * ((lz & 7) ^ chunk_xor<F8>(R0z & 15)); }
                S.a_off(nxt, lds, R0z, C0z, (int)lda2, nxtoff);
                ((LAS u32x4*)(lds + NXT_OFF + (((ui + 1) & 1) << 13)))[tz] = (u32x4){nxtoff[0][0], nxtoff[0][1], nxtoff[1][0], nxtoff[1][1]}; }
            else nxtA = (size_t)nxt.arow * lda2 + nxt.koff;
        } else if constexpr (Sched::GATHER) { const int tz = (wave0 << 6) | lane_id_asm();
            ((LAS u32x4*)(lds + NXT_OFF + (((ui + 1) & 1) << 13)))[tz] = ((const LAS u32x4*)(lds + NXT_OFF + ((ui & 1) << 13)))[tz]; }
        if (wr == 1) PG8_BAR;
    }
    PG8_WAIT_V(0);
    PG8_BAR;
#undef PG8_SA
#undef PG8_SB
#undef PG8_STAGE_A
#undef PG8_GOFF
#undef PG8_STAGE_B
#undef PG8_LDA
#undef PG8_LDB
#undef PG8_MMA
#undef PG8_WAIT_V
#undef PG8_WAIT_L
#undef PG8_BAR
#undef PG8_SCHED
#undef PG8_KITER
#undef PG8_NXT_SLOT
}
}

struct Args { const float* in[32]; float* out; unsigned char* ws; int ph_lo, ph_hi, variant, pad; };
typedef const __attribute__((address_space(4))) unsigned char* kptr_t;
__device__ __forceinline__ const float* kin(int i) { kptr_t p = (kptr_t)__builtin_amdgcn_kernarg_segment_ptr(); asm volatile("" : "+s"(p)); return *(const float* const __attribute__((address_space(4)))*)(p + 8 * i); }
enum { I_X = 0, I_C, I_MODW, I_MODB, I_LNG, I_LNB, I_ABWIN, I_POOLW, I_POOLS, I_CONVW, I_CONVB, I_WA, I_BA, I_WX, I_BX, I_LAM, I_ABWOUT, I_ABBOUT,
       I_SGWIN, I_SGBIN, I_SGLNG, I_SGLNB, I_SGWS, I_SGBS, I_SGWOUT, I_SGBOUT, I_RW, I_RB, I_W1, I_B1, I_W2, I_B2 };

__device__ __forceinline__ int w1_rho(int n) { const int nn = n & 1, j = n >> 1; return ((j >> 7) << 8) | (((j >> 2) & 1) << 7) | (((j >> 5) & 3) << 5) | (nn << 4) | (((j >> 3) & 3) << 2) | (j & 3); }
__device__ __forceinline__ int w1_n_of_rho(int rho) { const int pn = rho >> 8, bj = (rho >> 7) & 1, wc = (rho >> 5) & 3, nn = (rho >> 4) & 1, fq = (rho >> 2) & 3, i = rho & 3; return 2 * (128 * pn + 32 * wc + 8 * fq + 4 * bj + i) + nn; }
template <bool W1MAP>
__device__ __forceinline__ void conv_item(const float* W, int N, bf16_t* WT, int item, int lane) {
    const int nblk = N >> 5, kb = item / nblk, nb = item - kb * nblk;
    const int kg = lane >> 3, nl = lane & 7, k0 = kb * 64 + kg * 8, n0 = nb * 32 + nl * 4;
    f32x4 v[8];
#pragma unroll
    for (int q = 0; q < 8; ++q) v[q] = *(const f32x4*)(W + (size_t)(k0 + q) * N + n0);
#pragma unroll
    for (int i = 0; i < 4; ++i) {
        const int n = n0 + i, row = W1MAP ? w1_rho(n) : n;
        u32x4 o; o.x = pk2(v[0][i], v[1][i]); o.y = pk2(v[2][i], v[3][i]); o.z = pk2(v[4][i], v[5][i]); o.w = pk2(v[6][i], v[7][i]);
        *(u32x4*)(WT + (size_t)row * 1024 + k0) = o;
    }
}

template <bool W1MAP>
__device__ __forceinline__ void conv_item_f8(const float* W, int N, unsigned char* WT8, int item, int lane, float scale) {
    const int nblk = N >> 5, kb = item / nblk, nb = item - kb * nblk;
    const int kg = lane >> 3, nl = lane & 7, k0 = kb * 128 + kg * 16, n0 = nb * 32 + nl * 4;
    f32x4 v[16];
#pragma unroll
    for (int q = 0; q < 16; ++q) v[q] = *(const f32x4*)(W + (size_t)(k0 + q) * N + n0) * scale;
#pragma unroll
    for (int i = 0; i < 4; ++i) {
        const int n = n0 + i, row = W1MAP ? w1_rho(n) : n;
        u32x4 o; o.x = pk4_fp8(v[0][i], v[1][i], v[2][i], v[3][i]); o.y = pk4_fp8(v[4][i], v[5][i], v[6][i], v[7][i]);
        o.z = pk4_fp8(v[8][i], v[9][i], v[10][i], v[11][i]); o.w = pk4_fp8(v[12][i], v[13][i], v[14][i], v[15][i]);
        *(u32x4*)(WT8 + (size_t)row * 1024 + k0) = o;
    }
}

#define IN(k) (lo <= (k) && (k) < hi)
#define SEAM(k) do { if ((k) + 1 < hi) xcd_barrier(bar); } while (0)
#define LSEAM(k) do { if ((k) + 1 < hi) { if (FUSE_LOCAL && G == 256) { __builtin_amdgcn_fence(__ATOMIC_RELEASE, "workgroup"); __syncthreads(); __builtin_amdgcn_fence(__ATOMIC_ACQUIRE, "workgroup"); } else xcd_barrier(bar); } } while (0)
#define PH_LOCALS \
    const int tid = (wave0 << 6) | lane_id_asm(); \
    const int lane = tid & 63, wave = wave0; \
    int bx = blockIdx.x; asm volatile("" : "+s"(bx)); \
    const int vcu = (G % 8 == 0) ? (bx % 8) * (G / 8) + bx / 8 : bx; \
    const int gw = vcu * 8 + wave, NGW = G * 8; \
    unsigned char* ws; { kptr_t kp_ = (kptr_t)__builtin_amdgcn_kernarg_segment_ptr(); asm volatile("" : "+s"(kp_)); ws = *(unsigned char* const __attribute__((address_space(4)))*)(kp_ + 264); } \
    float* Xf; { kptr_t kp_ = (kptr_t)__builtin_amdgcn_kernarg_segment_ptr(); asm volatile("" : "+s"(kp_)); Xf = *(float* const __attribute__((address_space(4)))*)(kp_ + 256); } \
    unsigned* const ctl = (unsigned*)(ws + WS_CTL); \
    float* const MOD = (float*)(ws + WS_MOD); bf16_t* const Hb = (bf16_t*)(ws + WS_H); bf16_t* const Zb = (bf16_t*)(ws + WS_Z); bf16_t* const A2b = (bf16_t*)(ws + WS_A2); \
    bf16_t* const RIb = (bf16_t*)(ws + WS_RI); bf16_t* const YMb = (bf16_t*)(ws + WS_YMIX); bf16_t* const Yb = (bf16_t*)(ws + WS_Y); bf16_t* const ACTb = (bf16_t*)(ws + WS_ACT); \
    bf16_t* const YSb = (bf16_t*)(ws + WS_YS); float* const LOGf = (float*)(ws + WS_LOG); float* const TOPG = (float*)(ws + WS_TOPG); int* const LIST = (int*)(ws + WS_LIST); \
    float* const SUMM = (float*)(ws + WS_SUMM); \
    (void)lane; (void)wave; (void)gw; (void)NGW; (void)ctl; (void)MOD; (void)Hb; (void)Zb; (void)A2b; (void)RIb; (void)YMb; (void)Yb; (void)ACTb; (void)YSb; (void)LOGf; (void)TOPG; (void)LIST; (void)SUMM; (void)Xf; (void)vcu


template <int L, int PASS>
__device__ __forceinline__ void scan_phase(const int lo, const int hi, const int G, const XcdBarrier& bar, const int wave0) {
    constexpr int l = L, pass = PASS, P = PH_L0 + PH_PER_LAYER * L, jj = L >> 1; constexpr bool odd = (L & 1) != 0;
            if (PHEN(6) && !odd && IN(P + 3 + pass)) {
            PH_LOCALS;
                for (int it = gw; it < 16 * 32 * 4; it += NGW) {
                    const int b = it >> 7, n = (it >> 2) & 31, cg = it & 3;
                    const int ch = cg * 128 + 2 * lane;
                    float sp[2];
#pragma unroll
                    for (int q = 0; q < 2; ++q) { const float x = -kin(I_LAM)[jj * 512 + ch + q]; sp[q] = 8.0f * 1.4426950408889634f * (fmaxf(x, 0.f) + log1pf(__expf(-fabsf(x)))); }
                    float one = 1.0f; asm volatile("" : "+v"(one));
                    float h0 = 0.f, h1 = 0.f, p0 = one, p1 = one;
                    if (pass == 1) {
#pragma unroll 1
                        for (int m = 0; m < n; ++m) { const f32x4 s = *(const f32x4*)(SUMM + (((size_t)b * 32 + m) * 512 + ch) * 2); h0 = s[0] * h0 + s[1]; h1 = s[2] * h1 + s[3]; }
                    }
                    const size_t row0 = (size_t)b * SEQ + n * 128;
#pragma unroll 4
                    for (int t = 0; t < 128; ++t) {
                        const size_t r = row0 + t;
                        const unsigned rw = *(const unsigned*)(RIb + r * 1024 + ch), iw = *(const unsigned*)(RIb + r * 1024 + 512 + ch), xw = *(const unsigned*)(A2b + r * 1024 + 512 + ch);
                        const float a0 = __builtin_amdgcn_exp2f(-bflo(rw) * sp[0]), a1 = __builtin_amdgcn_exp2f(-bfhi(rw) * sp[1]);
                        const float m0 = __builtin_amdgcn_sqrtf(fmaxf(__builtin_fmaf(-a0, a0, 1.0f), 0.f)), m1 = __builtin_amdgcn_sqrtf(fmaxf(__builtin_fmaf(-a1, a1, 1.0f), 0.f));
                        h0 = a0 * h0 + m0 * (bflo(iw) * bflo(xw)); h1 = a1 * h1 + m1 * (bfhi(iw) * bfhi(xw));
                        if (pass == 0) { p0 *= a0; p1 *= a1; }
                        else { const unsigned gwd = *(const unsigned*)(Zb + r * DINAB + 1024 + ch);
                            if (FP8_OUTP) *(unsigned short*)((unsigned char*)YMb + r * 1024 + 512 + ch) = (unsigned short)pk4_fp8(h0 * gelu_tanh(bflo(gwd)), h1 * gelu_tanh(bfhi(gwd)), 0.f, 0.f);
                            else *(unsigned*)(YMb + r * 1024 + 512 + ch) = pk2(h0 * gelu_tanh(bflo(gwd)), h1 * gelu_tanh(bfhi(gwd))); }
                    }
                    if (pass == 0) *(f32x4*)(SUMM + (((size_t)b * 32 + n) * 512 + ch) * 2) = (f32x4){p0, h0, p1, h1};
                }
                if (pass == 1 && FUSE_OUTP) LSEAM(P + 3 + pass); else SEAM(P + 3 + pass);
            }
}

template <int L, int SUB>
__device__ __forceinline__ void ln_phase(const int lo, const int hi, const int G, const XcdBarrier& bar, const int wave0) {
    constexpr int l = L, sub = SUB, P = PH_L0 + PH_PER_LAYER * L; constexpr int ph = SUB == 0 ? P + 6 : P + 11;
    constexpr bool XIN_F32 = (L == 0 && SUB == 0), XOUT_F32 = (L == DEPTH - 1 && SUB == 1);
    if (PHEN(8) && IN(ph)) {
        PH_LOCALS;
        const int rows_per = T / NGW, r0 = gw * rows_per, b = r0 / SEQ;
        constexpr int ls = 2 * l + sub, lsn = ls + 1;
        const float* gp = MOD + ((size_t)ls * 16 + b) * 3072 + 2048;
        const float* lgp = kin(I_LNG) + ls * 1024, * lbp = kin(I_LNB) + ls * 1024;
        constexpr bool has_nextmod = lsn < 2 * DEPTH;
        const float* nsh = MOD + ((size_t)(has_nextmod ? lsn : 0) * 16 + b) * 3072, * nsc = nsh + 1024;
        f32x4 gt[4], lg[4], lb[4], sh[4], sc[4];
#pragma unroll
        for (int j = 0; j < 4; ++j) { const int o = 4 * (64 * j + lane); gt[j] = *(const f32x4*)(gp + o) + 1.0f; lg[j] = *(const f32x4*)(lgp + o); lb[j] = *(const f32x4*)(lbp + o);
            sh[j] = *(const f32x4*)(nsh + o); sc[j] = *(const f32x4*)(nsc + o) + 1.0f; }
        const float* xin32 = kin(I_X);
        bf16_t* const Xb = (bf16_t*)(ws + WS_XB);
        constexpr bool NEXT_INP8 = ((l + 1) & 1) ? (FP8_INP_ODD != 0) : (FP8_INP_EVEN != 0);
        constexpr int RPI = 2;
        for (int r = (r0 - wave * rows_per) + wave * RPI, rend = (r0 - wave * rows_per) + 8 * rows_per; r < rend; r += 8 * RPI) {
            f32x4 xf[XIN_F32 ? RPI : 1][4]; u32x2 xb[XIN_F32 ? 1 : RPI][4]; u32x2 yv[sub == 0 ? RPI : 1][4]; u32x2 ys[sub == 0 ? 1 : RPI][4][4]; f32x4 gk[RPI];
#pragma unroll
            for (int q = 0; q < RPI; ++q) {
                if constexpr (XIN_F32) { const f32x4* xr = (const f32x4*)(xin32 + (size_t)(r + q) * D) + lane;
#pragma unroll
                    for (int j = 0; j < 4; ++j) xf[q][j] = xr[64 * j]; }
                else { const u32x2* xr = (const u32x2*)(Xb + (size_t)(r + q) * D) + lane;
#pragma unroll
                    for (int j = 0; j < 4; ++j) xb[q][j] = xr[64 * j]; }
                if constexpr (sub == 0) { const u32x2* yr = (const u32x2*)(Yb + (size_t)(r + q) * D) + lane;
#pragma unroll
                    for (int j = 0; j < 4; ++j) yv[q][j] = yr[64 * j]; }
                else { gk[q] = *(const f32x4*)(TOPG + (size_t)(r + q) * 4);
#pragma unroll
                    for (int k = 0; k < 4; ++k) {
                        if (FP8_YS) { const unsigned* yr = (const unsigned*)((const unsigned char*)YSb + ((size_t)(r + q) * 4 + k) * D) + lane;
#pragma unroll
                            for (int j = 0; j < 4; ++j) ys[q][k][j].x = yr[64 * j]; }
                        else { const u32x2* yr = (const u32x2*)(YSb + ((size_t)(r + q) * 4 + k) * D) + lane;
#pragma unroll
                            for (int j = 0; j < 4; ++j) ys[q][k][j] = yr[64 * j]; } } }
            }
            f32x4 v[RPI][4]; float s[RPI];
#pragma unroll
            for (int q = 0; q < RPI; ++q) {
                s[q] = 0.f;
#pragma unroll
                for (int j = 0; j < 4; ++j) {
                    f32x4 y, x;
                    if constexpr (XIN_F32) x = xf[q][j]; else x = (f32x4){bflo(xb[q][j].x), bfhi(xb[q][j].x), bflo(xb[q][j].y), bfhi(xb[q][j].y)};
                    if constexpr (sub == 0) y = (f32x4){bflo(yv[q][j].x), bfhi(yv[q][j].x), bflo(yv[q][j].y), bfhi(yv[q][j].y)};
                    else { y = (f32x4){0.f, 0.f, 0.f, 0.f};
#pragma unroll
                        for (int k = 0; k < 4; ++k) { const u32x2 w = ys[q][k][j];
                            if (FP8_YS) { const f32x2 lo2 = __builtin_amdgcn_cvt_pk_f32_fp8((int)w.x, false), hi2 = __builtin_amdgcn_cvt_pk_f32_fp8((int)w.x, true);
                                y = y + (f32x4){lo2.x, lo2.y, hi2.x, hi2.y} * (gk[q][k] * 0.0625f); }
                            else y = y + (f32x4){bflo(w.x), bfhi(w.x), bflo(w.y), bfhi(w.y)} * gk[q][k]; } }
                    v[q][j] = x * DN_ALPHA + gt[j] * y;
                    s[q] += (v[q][j][0] + v[q][j][1]) + (v[q][j][2] + v[q][j][3]);
                }
            }
#pragma unroll
            for (int o = 1; o < 64; o <<= 1) {
#pragma unroll
                for (int q = 0; q < RPI; ++q) s[q] += __builtin_bit_cast(float, __builtin_amdgcn_ds_bpermute((lane ^ o) << 2, __builtin_bit_cast(int, s[q])));
            }
            float s2[RPI];
#pragma unroll
            for (int q = 0; q < RPI; ++q) { const float mean = s[q] * (1.0f / D); s2[q] = 0.f;
#pragma unroll
                for (int j = 0; j < 4; ++j) { v[q][j] = v[q][j] - mean; s2[q] += (v[q][j][0] * v[q][j][0] + v[q][j][1] * v[q][j][1]) + (v[q][j][2] * v[q][j][2] + v[q][j][3] * v[q][j][3]); } }
#pragma unroll
            for (int o = 1; o < 64; o <<= 1) {
#pragma unroll
                for (int q = 0; q < RPI; ++q) s2[q] += __builtin_bit_cast(float, __builtin_amdgcn_ds_bpermute((lane ^ o) << 2, __builtin_bit_cast(int, s2[q])));
            }
#pragma unroll
            for (int q = 0; q < RPI; ++q) {
                const float rstd = 1.0f / sqrtf(s2[q] * (1.0f / D) + LN_EPS);
                u32x2* hr = (u32x2*)(Hb + (size_t)(r + q) * D) + lane;
#pragma unroll
                for (int j = 0; j < 4; ++j) { const f32x4 xn = v[q][j] * rstd * lg[j] + lb[j];
                    if (XOUT_F32) ((f32x4*)(Xf + (size_t)(r + q) * D) + lane)[64 * j] = xn;
                    else { u32x2 w; w.x = pk2(xn[0], xn[1]); w.y = pk2(xn[2], xn[3]); ((u32x2*)(Xb + (size_t)(r + q) * D) + lane)[64 * j] = w; }
                    if (has_nextmod) { const f32x4 h = xn * sc[j] + sh[j];
                        if (!(NEXT_INP8 && sub == 1) && !(ROUTER_X && sub == 0)) { u32x2 w; w.x = pk2(h[0], h[1]); w.y = pk2(h[2], h[3]); hr[64 * j] = w; }
                        if ((FP8_M1 && sub == 0) || (NEXT_INP8 && sub == 1)) ((unsigned*)(ws + WS_H8 + (size_t)(r + q) * D) + lane)[64 * j] = pk4_fp8(h[0], h[1], h[2], h[3]); } }
            }
        }
        if (ph + 1 < NPH) { if (sub == 0) LSEAM(ph); else SEAM(ph); }
    }
}

template <int L>
__device__ __forceinline__ void layer_body(LAS unsigned char* const lds, volatile LAS unsigned* const LCTL, const int lo, const int hi, const int G, const XcdBarrier& bar, const int wave0) {
    constexpr int l = L;
        const int P = PH_L0 + PH_PER_LAYER * l, jj = l >> 1;
        const bool odd = (l & 1) != 0;
        if (PHEN(2) && IN(P + 0)) {
            PH_LOCALS;
            if (!odd) {
                pg8::DenseSched S; S.init(T, 1536, G, bx);
                if (FP8_INP_EVEN) { pg8::Gemm g{ws + WS_H8, ws + WS_ABIN + (size_t)jj * 1536 * 1024, 1024, 1024, 1024, 122};
                    pg8::EpiDense<0, false, false, true> E{Zb, 1536, nullptr, nullptr, 1.0f / 32.0f};
                    pg8::gemm_phase<true>(lds, g, S, E, wave0); }
                else { pg8::Gemm g{Hb, (const bf16_t*)(ws + WS_ABIN) + (size_t)jj * 1536 * 1024, 1024, 1024, 1024, 127};
                    pg8::EpiDense<0, false, false> E{Zb, 1536, nullptr, nullptr, 0.f};
                    pg8::gemm_phase<false>(lds, g, S, E, wave0); }
            } else {
                pg8::DenseSched S; S.init(T, 2048, G, bx);
                if (FP8_INP_ODD) { pg8::Gemm g{ws + WS_H8, ws + WS_SGIN + (size_t)jj * 2048 * 1024, 1024, 1024, 1024, 122};
                    pg8::EpiDense<1, true, false, true> E{Zb, 2048, kin(I_SGBIN) + jj * 2048, nullptr, 1.0f / 32.0f};
                    pg8::gemm_phase<true>(lds, g, S, E, wave0); }
                else { pg8::Gemm g{Hb, (const bf16_t*)(ws + WS_SGIN) + (size_t)jj * 2048 * 1024, 1024, 1024, 1024, 127};
                    pg8::EpiDense<1, true, false> E{Zb, 2048, kin(I_SGBIN) + jj * 2048, nullptr, 0.f};
                    pg8::gemm_phase<false>(lds, g, S, E, wave0); }
            }
            SEAM(P + 0);
        }
        if (PHEN(3) && !odd && IN(P + 1)) {
            PH_LOCALS;
            const int rows_per = T / NGW, r0 = gw * rows_per;
            const int g4 = lane >> 4, w = 2 << g4;
            float cw[4][8], cb[8];
#pragma unroll
            for (int k = 0; k < 4; ++k)
#pragma unroll
                for (int q = 0; q < 8; ++q) cw[k][q] = kin(I_CONVW)[((size_t)jj * 4 + k) * 512 + 8 * lane + q];
#pragma unroll
            for (int q = 0; q < 8; ++q) cb[q] = kin(I_CONVB)[jj * 512 + 8 * lane + q];
            const int ts0 = r0 & (SEQ - 1);
            u32x4 ring[16], cr[3];
            float sw[8];
#pragma unroll
            for (int q = 0; q < 8; ++q) sw[q] = 0.f;
#pragma unroll
            for (int d = 0; d < 16; ++d) {
                const int k = 15 - d;
                u32x4 v = {0u, 0u, 0u, 0u};
                if (ts0 > d) v = *(const u32x4*)(Zb + (size_t)(r0 - 1 - d) * DINAB + 8 * lane);
                ring[k] = v;
                if (d + 1 < w) { const float f[8] = {bflo(v.x), bfhi(v.x), bflo(v.y), bfhi(v.y), bflo(v.z), bfhi(v.z), bflo(v.w), bfhi(v.w)};
#pragma unroll
                    for (int q = 0; q < 8; ++q) sw[q] += f[q]; }
            }
#pragma unroll
            for (int d = 0; d < 3; ++d) { u32x4 v = {0u, 0u, 0u, 0u}; if (ts0 > d) v = *(const u32x4*)(Zb + (size_t)(r0 - 1 - d) * DINAB + 512 + 8 * lane); cr[2 - d] = v; }
#pragma unroll 1
            for (int rb = 0; rb < rows_per; rb += 16) {
#pragma unroll
                for (int i = 0; i < 16; ++i) {
                    const int r = r0 + rb + i, ts = r & (SEQ - 1);
                    const u32x4 vn = *(const u32x4*)(Zb + (size_t)r * DINAB + 8 * lane), cn = *(const u32x4*)(Zb + (size_t)r * DINAB + 512 + 8 * lane);
                    const u32x4 c2 = ring[(i + 15) & 15], c4 = ring[(i + 13) & 15], c8 = ring[(i + 9) & 15], c16 = ring[(i + 1) & 15];
                    u32x4 vo;
                    vo.x = g4 == 0 ? c2.x : g4 == 1 ? c4.x : g4 == 2 ? c8.x : c16.x; vo.y = g4 == 0 ? c2.y : g4 == 1 ? c4.y : g4 == 2 ? c8.y : c16.y;
                    vo.z = g4 == 0 ? c2.z : g4 == 1 ? c4.z : g4 == 2 ? c8.z : c16.z; vo.w = g4 == 0 ? c2.w : g4 == 1 ? c4.w : g4 == 2 ? c8.w : c16.w;
                    ring[i] = vn;
                    const float fn[8] = {bflo(vn.x), bfhi(vn.x), bflo(vn.y), bfhi(vn.y), bflo(vn.z), bfhi(vn.z), bflo(vn.w), bfhi(vn.w)};
                    const float fo[8] = {bflo(vo.x), bfhi(vo.x), bflo(vo.y), bfhi(vo.y), bflo(vo.z), bfhi(vo.z), bflo(vo.w), bfhi(vo.w)};
                    const int cntw = (ts + 1) < w ? (ts + 1) : w;
                    const float inv = __builtin_amdgcn_rcpf((float)cntw);
                    float pz[8];
#pragma unroll
                    for (int q = 0; q < 8; ++q) { sw[q] += fn[q]; pz[q] = sw[q] * inv - fn[q]; sw[q] -= fo[q]; }
                    u32x4 o; o.x = pk2(pz[0], pz[1]); o.y = pk2(pz[2], pz[3]); o.z = pk2(pz[4], pz[5]); o.w = pk2(pz[6], pz[7]);
                    *(u32x4*)(A2b + (size_t)r * 1024 + 8 * lane) = o;
                    float xc[8];
                    const u32x4 t0 = cr[0], t1 = cr[1], t2 = cr[2];
                    const float f0[8] = {bflo(t0.x), bfhi(t0.x), bflo(t0.y), bfhi(t0.y), bflo(t0.z), bfhi(t0.z), bflo(t0.w), bfhi(t0.w)};
                    const float f1[8] = {bflo(t1.x), bfhi(t1.x), bflo(t1.y), bfhi(t1.y), bflo(t1.z), bfhi(t1.z), bflo(t1.w), bfhi(t1.w)};
                    const float f2[8] = {bflo(t2.x), bfhi(t2.x), bflo(t2.y), bfhi(t2.y), bflo(t2.z), bfhi(t2.z), bflo(t2.w), bfhi(t2.w)};
                    const float f3[8] = {bflo(cn.x), bfhi(cn.x), bflo(cn.y), bfhi(cn.y), bflo(cn.z), bfhi(cn.z), bflo(cn.w), bfhi(cn.w)};
#pragma unroll
                    for (int q = 0; q < 8; ++q) xc[q] = cb[q] + f0[q] * cw[0][q] + f1[q] * cw[1][q] + f2[q] * cw[2][q] + f3[q] * cw[3][q];
                    cr[0] = t1; cr[1] = t2; cr[2] = cn;
                    u32x4 o2; o2.x = pk2(xc[0], xc[1]); o2.y = pk2(xc[2], xc[3]); o2.z = pk2(xc[4], xc[5]); o2.w = pk2(xc[6], xc[7]);
                    *(u32x4*)(A2b + (size_t)r * 1024 + 512 + 8 * lane) = o2;
                }
            }
            LSEAM(P + 1);
        }
        if (PHEN(4) && odd && IN(P + 1)) {
            PH_LOCALS;
            LAS float* STAT = (LAS float*)lds;
            LAS unsigned char* WSS = lds + 1024;
            LAS unsigned char* VT = lds + 1024 + 34816;
            const float* lng = kin(I_SGLNG) + jj * 1024, * lnb = kin(I_SGLNB) + jj * 1024;
            const bf16_t* WSMp = (const bf16_t*)(ws + WS_WSM) + (size_t)jj * 8 * 128 * 128;
            const float* bs = kin(I_SGBS) + jj * 8 * 128;
            const int fr = lane & 15, fq = lane >> 4;
            const bool sgl = FUSE_LOCAL && FUSE_OUTP && G == 256;
            for (int it = sgl ? 2 * vcu : vcu, ite = sgl ? 2 * vcu + 2 : T / 128, its = sgl ? 1 : G; it < ite; it += its) {
                const size_t row0 = (size_t)it * 128;
#pragma unroll 1
                for (int rb = 0; rb < 2; ++rb) {
                    u32x4 a8[8], b8[8];
#pragma unroll
                    for (int q = 0; q < 8; ++q) { const bf16_t* vp = Zb + (row0 + wave * 16 + rb * 8 + q) * 2048 + 1024; a8[q] = *(const u32x4*)(vp + 8 * lane); b8[q] = *(const u32x4*)(vp + 512 + 8 * lane); }
                    float sm[8], sq[8];
#pragma unroll
                    for (int q = 0; q < 8; ++q) {
                        const float f[16] = {bflo(a8[q].x), bfhi(a8[q].x), bflo(a8[q].y), bfhi(a8[q].y), bflo(a8[q].z), bfhi(a8[q].z), bflo(a8[q].w), bfhi(a8[q].w),
                                             bflo(b8[q].x), bfhi(b8[q].x), bflo(b8[q].y), bfhi(b8[q].y), bflo(b8[q].z), bfhi(b8[q].z), bflo(b8[q].w), bfhi(b8[q].w)};
                        float s1 = 0.f, s2 = 0.f;
#pragma unroll
                        for (int e = 0; e < 16; ++e) { s1 += f[e]; s2 += f[e] * f[e]; }
                        sm[q] = s1; sq[q] = s2;
                    }
#pragma unroll
                    for (int o = 1; o < 64; o <<= 1) {
#pragma unroll
                        for (int q = 0; q < 8; ++q) { sm[q] += __builtin_bit_cast(float, __builtin_amdgcn_ds_bpermute((lane ^ o) << 2, __builtin_bit_cast(int, sm[q])));
                            sq[q] += __builtin_bit_cast(float, __builtin_amdgcn_ds_bpermute((lane ^ o) << 2, __builtin_bit_cast(int, sq[q]))); }
                    }
                    if (lane < 8) { float m_ = sm[0], q_ = sq[0];
#pragma unroll
                        for (int q = 1; q < 8; ++q) { m_ = lane == q ? sm[q] : m_; q_ = lane == q ? sq[q] : q_; }
                        const float mean = m_ * (1.0f / 1024.0f), var = fmaxf(q_ * (1.0f / 1024.0f) - mean * mean, 0.f);
                        const int r = wave * 16 + rb * 8 + lane; STAT[2 * r] = mean; STAT[2 * r + 1] = 1.0f / sqrtf(var + LN_EPS); }
                }
                __syncthreads();
                u32x4 wv[4], vv[4];
#pragma unroll
                for (int i = 0; i < 4; ++i) { const int q = tid + 512 * i, row = q >> 4, c16 = q & 15;
                    wv[i] = *(const u32x4*)(WSMp + ((size_t)0 * 128 + row) * 128 + c16 * 8);
                    vv[i] = *(const u32x4*)(Zb + (row0 + row) * 2048 + 1024 + 0 * 128 + c16 * 8); }
#pragma unroll 1
                for (int hd = 0; hd < 8; ++hd) {
#pragma unroll
                    for (int i = 0; i < 4; ++i) {
                        const int q = tid + 512 * i, row = q >> 4, c16 = q & 15;
                        *(LAS u32x4*)(WSS + row * 272 + c16 * 16) = wv[i];
                        const u32x4 v4 = vv[i];
                        const float mean = STAT[2 * row], rstd = STAT[2 * row + 1];
                        const float f[8] = {bflo(v4.x), bfhi(v4.x), bflo(v4.y), bfhi(v4.y), bflo(v4.z), bfhi(v4.z), bflo(v4.w), bfhi(v4.w)};
                        const f32x4 g0 = *(const f32x4*)(lng + hd * 128 + c16 * 8), g1 = *(const f32x4*)(lng + hd * 128 + c16 * 8 + 4);
                        const f32x4 b0 = *(const f32x4*)(lnb + hd * 128 + c16 * 8), b1 = *(const f32x4*)(lnb + hd * 128 + c16 * 8 + 4);
                        const float gg[8] = {g0[0], g0[1], g0[2], g0[3], g1[0], g1[1], g1[2], g1[3]}, bb[8] = {b0[0], b0[1], b0[2], b0[3], b1[0], b1[1], b1[2], b1[3]};
#pragma unroll
                        for (int q2 = 0; q2 < 8; ++q2) {
                            const int c = c16 * 8 + q2;
                            const int rho = (c & ~31) | (((c >> 2) & 1) << 4) | (((c >> 3) & 3) << 2) | (c & 3);
                            *(LAS bf16_t*)(VT + rho * 272 + row * 2) = (bf16_t)f2bf((f[q2] - mean) * rstd * gg[q2] + bb[q2]);
                        }
                    }
                    const int hn = hd < 7 ? hd + 1 : 7;
#pragma unroll
                    for (int i = 0; i < 4; ++i) { const int q = tid + 512 * i, row = q >> 4, c16 = q & 15;
                        wv[i] = *(const u32x4*)(WSMp + ((size_t)hn * 128 + row) * 128 + c16 * 8);
                        vv[i] = *(const u32x4*)(Zb + (row0 + row) * 2048 + 1024 + hn * 128 + c16 * 8); }
                    const int t = 16 * wave + fr; const float bst = bs[hd * 128 + t];
                    const size_t rowg = row0 + t;
                    u32x4 uv[4];
#pragma unroll
                    for (int q = 0; q < 4; ++q) uv[q] = *(const u32x4*)(Zb + rowg * 2048 + hd * 128 + 32 * q + 8 * fq);
                    __syncthreads();
                    bf16x8 afr[4];
#pragma unroll
                    for (int ks = 0; ks < 4; ++ks) afr[ks] = *(const LAS bf16x8*)(WSS + (16 * wave + fr) * 272 + (32 * ks + 8 * fq) * 2);
                    f32x4 acc[8];
#pragma unroll
                    for (int tn = 0; tn < 8; ++tn) { acc[tn] = (f32x4){0.f, 0.f, 0.f, 0.f};
#pragma unroll
                        for (int ks = 0; ks < 4; ++ks) { const bf16x8 vfr = *(const LAS bf16x8*)(VT + (16 * tn + fr) * 272 + (32 * ks + 8 * fq) * 2);
                            acc[tn] = __builtin_amdgcn_mfma_f32_16x16x32_bf16(vfr, afr[ks], acc[tn], 0, 0, 0); } }
#pragma unroll
                    for (int q = 0; q < 4; ++q) {
                        const int c0 = hd * 128 + 32 * q + 8 * fq;
                        const u32x4 u4 = uv[q];
                        const f32x4 s0 = acc[2 * q] + bst, s1 = acc[2 * q + 1] + bst;
                        if (FP8_OUTP) { u32x2 o; o.x = pk4_fp8(bflo(u4.x) * s0[0], bfhi(u4.x) * s0[1], bflo(u4.y) * s0[2], bfhi(u4.y) * s0[3]);
                            o.y = pk4_fp8(bflo(u4.z) * s1[0], bfhi(u4.z) * s1[1], bflo(u4.w) * s1[2], bfhi(u4.w) * s1[3]);
                            *(u32x2*)((unsigned char*)YMb + rowg * 1024 + c0) = o; }
                        else { u32x4 o; o.x = pk2(bflo(u4.x) * s0[0], bfhi(u4.x) * s0[1]); o.y = pk2(bflo(u4.y) * s0[2], bfhi(u4.y) * s0[3]);
                        o.z = pk2(bflo(u4.z) * s1[0], bfhi(u4.z) * s1[1]); o.w = pk2(bflo(u4.w) * s1[2], bfhi(u4.w) * s1[3]);
                        *(u32x4*)(YMb + rowg * 1024 + c0) = o; }
                    }
                    __syncthreads();
                }
            }
            if (FUSE_OUTP) LSEAM(P + 1); else SEAM(P + 1);
        }
        if (PHEN(5) && !odd && IN(P + 2)) {
            PH_LOCALS;
            {
                pg8::Gemm g{A2b, (const bf16_t*)(ws + WS_BPOOL) + (size_t)jj * 512 * 512, 1024, 512, 256, 127};
                pg8::DenseSched S; S.init(T, 512, G, bx); S.kblk = 512; S.rowm = (FUSE_LOCAL && G == 256) ? 1 : 0;
                pg8::EpiDense<0, false, true, false, FP8_OUTP != 0> E{YMb, 1024, nullptr, kin(I_POOLS) + jj * 512, 0.f};
                pg8::gemm_phase<false>(lds, g, S, E, wave0);
            }
            {
                pg8::Gemm g{A2b + 512, (const bf16_t*)(ws + WS_BGATE) + (size_t)jj * 1024 * 512, 1024, 512, 256, 127};
                pg8::DenseSched S; S.init(T, 1024, G, bx); S.kblk = 512; S.rowm = (FUSE_LOCAL && G == 256) ? 1 : 0;
                pg8::EpiDense<2, true, false> E{RIb, 1024, (const float*)(ws + WS_BIASRI) + jj * 1024, nullptr, 0.f};
                pg8::gemm_phase<false>(lds, g, S, E, wave0);
            }
            LSEAM(P + 2);
        }
        scan_phase<L, 0>(lo, hi, G, bar, wave0); scan_phase<L, 1>(lo, hi, G, bar, wave0);
        if (PHEN(7) && IN(P + 5)) {
            PH_LOCALS;
            const float* bo = odd ? kin(I_SGBOUT) + jj * 1024 : kin(I_ABBOUT) + jj * 1024;
            pg8::DenseSched S; S.init(T, 1024, G, bx); S.rowm = (FUSE_LOCAL && FUSE_OUTP && G == 256) ? 1 : 0;
            if (FP8_OUTP) { const unsigned char* wt = odd ? ws + WS_SGOUT + (size_t)jj * 1024 * 1024 : ws + WS_ABOUT + (size_t)jj * 1024 * 1024;
                pg8::Gemm g{YMb, wt, 1024, 1024, 1024, 121};
                pg8::EpiDense<0, true, false, true> E{Yb, 1024, bo, nullptr, 1.0f / 64.0f};
                pg8::gemm_phase<true>(lds, g, S, E, wave0); }
            else { const bf16_t* wt = odd ? (const bf16_t*)(ws + WS_SGOUT) + (size_t)jj * 1024 * 1024 : (const bf16_t*)(ws + WS_ABOUT) + (size_t)jj * 1024 * 1024;
                pg8::Gemm g{YMb, wt, 1024, 1024, 1024, 127};
                pg8::EpiDense<0, true, false> E{Yb, 1024, bo, nullptr, 0.f};
                pg8::gemm_phase<false>(lds, g, S, E, wave0); }
            if (FUSE_OUTP) LSEAM(P + 5); else SEAM(P + 5);
        }
        ln_phase<L, 0>(lo, hi, G, bar, wave0);
            if (PHEN(9) && IN(P + 7)) {
            PH_LOCALS;
                pg8::Gemm g{ROUTER_X ? (const bf16_t*)(ws + WS_XB) : Hb, ROUTER_X ? (const bf16_t*)(ws + WS_BRB) + (size_t)l * 16 * 64 * 1024 : (const bf16_t*)(ws + WS_BR) + (size_t)l * 256 * 1024, 1024, 1024, 1024, 127};
                pg8::DenseSched S; S.init(T, 256, G, bx); if (ROUTER_X) S.bb = 64;
                pg8::EpiRouter E{LOGf};
                pg8::gemm_phase<false>(lds, g, S, E, wave0);
                LSEAM(P + 7);
            }
            if (PHEN(10) && IN(P + 8)) {
            PH_LOCALS;
                volatile LAS unsigned* hist = LCTL + 96; volatile LAS unsigned* basev = LCTL + 128;
                unsigned* gcnt = ctl + CW_CNT + 64 * l;
                const int TPB = (FUSE_LOCAL && G == 256) ? 256 : 512;
                for (int t0 = vcu * TPB; t0 < T; t0 += G * TPB) {
                    if (tid < 32) hist[tid] = 0u;
                    __syncthreads();
                    const bool act = tid < TPB;
                    const int tok = t0 + (act ? tid : 0);
                    float lv[32];
                    { const f32x4* lp = (const f32x4*)(LOGf + (size_t)tok * 64);
#pragma unroll
                      for (int q = 0; q < 8; ++q) { const f32x4 a = lp[q], b2 = lp[8 + q], rb = ROUTER_X ? *(const f32x4*)((const float*)(ws + WS_CB) + (l * 16 + (t0 >> 12)) * 32 + 4 * q) : *(const f32x4*)(kin(I_RB) + l * 32 + 4 * q);
                          lv[4 * q + 0] = a[0] + b2[0] + rb[0]; lv[4 * q + 1] = a[1] + b2[1] + rb[1]; lv[4 * q + 2] = a[2] + b2[2] + rb[2]; lv[4 * q + 3] = a[3] + b2[3] + rb[3]; } }
                    float v0 = -3.0e38f, v1 = -3.0e38f, v2 = -3.0e38f, v3 = -3.0e38f; int i0 = 0, i1 = 0, i2 = 0, i3 = 0;
#pragma unroll
                    for (int e = 0; e < 32; ++e) {
                        const float x = lv[e];
                        if (x > v3) {
                            if (x > v0) { v3 = v2; i3 = i2; v2 = v1; i2 = i1; v1 = v0; i1 = i0; v0 = x; i0 = e; }
                            else if (x > v1) { v3 = v2; i3 = i2; v2 = v1; i2 = i1; v1 = x; i1 = e; }
                            else if (x > v2) { v3 = v2; i3 = i2; v2 = x; i2 = e; }
                            else { v3 = x; i3 = e; }
                        }
                    }
                    const float e1 = __expf(v1 - v0), e2 = __expf(v2 - v0), e3 = __expf(v3 - v0), inv = 1.0f / (1.0f + e1 + e2 + e3);
                    if (act) *(f32x4*)(TOPG + (size_t)tok * 4) = (f32x4){inv, e1 * inv, e2 * inv, e3 * inv};
                    LAS unsigned* hp = (LAS unsigned*)hist;
                    unsigned r0 = 0u, r1 = 0u, r2 = 0u, r3 = 0u;
                    if (act) { r0 = __hip_atomic_fetch_add(hp + i0, 1u, __ATOMIC_RELAXED, __HIP_MEMORY_SCOPE_WORKGROUP); r1 = __hip_atomic_fetch_add(hp + i1, 1u, __ATOMIC_RELAXED, __HIP_MEMORY_SCOPE_WORKGROUP);
                        r2 = __hip_atomic_fetch_add(hp + i2, 1u, __ATOMIC_RELAXED, __HIP_MEMORY_SCOPE_WORKGROUP); r3 = __hip_atomic_fetch_add(hp + i3, 1u, __ATOMIC_RELAXED, __HIP_MEMORY_SCOPE_WORKGROUP); }
                    __syncthreads();
                    if (tid < 32) basev[tid] = __hip_atomic_fetch_add(gcnt + tid, hist[tid], __ATOMIC_RELAXED, __HIP_MEMORY_SCOPE_AGENT);
                    __syncthreads();
                    if (act) {
                    LIST[(size_t)i0 * TKTOT + basev[i0] + r0] = tok * 4 + 0;
                    LIST[(size_t)i1 * TKTOT + basev[i1] + r1] = tok * 4 + 1;
                    LIST[(size_t)i2 * TKTOT + basev[i2] + r2] = tok * 4 + 2;
                    LIST[(size_t)i3 * TKTOT + basev[i3] + r3] = tok * 4 + 3; }
                    __syncthreads();
                }
                SEAM(P + 8);
            }
            if (PHEN(11) && IN(P + 9)) {
                PH_LOCALS;
                volatile LAS int* cnts = (volatile LAS int*)(LCTL + 16); volatile LAS int* tstart = (volatile LAS int*)(LCTL + 48);
                if (tid < 32) cnts[tid] = (int)__hip_atomic_load(ctl + CW_CNT + 64 * l + tid, __ATOMIC_RELAXED, __HIP_MEMORY_SCOPE_AGENT);
                __syncthreads();
                if (tid == 0) { int s = 0; for (int e = 0; e < 32; ++e) { tstart[e] = s; s += (cnts[e] + 255) >> 8; } tstart[32] = s; }
                __syncthreads();
                LAS int* const utab = (LAS int*)(lds + UTAB_OFF);
                const int nunits = pg8::moe_build_units(utab, tstart, cnts, 8, G, MOE_PN_FAST ? vcu : bx, tid);
                __syncthreads();
                pg8::MoeSched S{(const LAS int*)utab, LIST, (const float*)(ws + WS_B1P) + (size_t)l * 32 * 2048, nunits, 2048, 2};
                pg8::EpiMoe1<FP8_M2 != 0> E{FP8_M2 ? (bf16_t*)(ws + WS_ACT8) : ACTb, lds, FP8_M1 ? 1.0f / 32.0f : 1.0f};
                if (FP8_M1) { pg8::Gemm g{ws + WS_H8, ws + WS_W1T8 + (size_t)l * 32 * 2048 * 1024, 1024, 1024, 1024, 122};
                    pg8::gemm_phase<true>(lds, g, S, E, wave0); }
                else { pg8::Gemm g{Hb, (const bf16_t*)(ws + WS_W1T) + (size_t)l * 32 * 2048 * 1024, 1024, 1024, 1024, 127};
                    pg8::gemm_phase<false>(lds, g, S, E, wave0); }
                SEAM(P + 9);
            }
            if (PHEN(12) && IN(P + 10)) {
                PH_LOCALS;
                volatile LAS int* cnts = (volatile LAS int*)(LCTL + 16); volatile LAS int* tstart = (volatile LAS int*)(LCTL + 48);
                __syncthreads();
                if (tid < 32) cnts[tid] = (int)__hip_atomic_load(ctl + CW_CNT + 64 * l + tid, __ATOMIC_RELAXED, __HIP_MEMORY_SCOPE_AGENT);
                __syncthreads();
                if (tid == 0) { int s = 0; for (int e = 0; e < 32; ++e) { tstart[e] = s; s += (cnts[e] + 255) >> 8; } tstart[32] = s; }
                __syncthreads();
                LAS int* const utab = (LAS int*)(lds + UTAB_OFF);
                const int nunits = pg8::moe_build_units(utab, tstart, cnts, 4, G, MOE_PN_FAST ? vcu : bx, tid);
                __syncthreads();
                pg8::MoeSched S{(const LAS int*)utab, LIST, kin(I_B2) + (size_t)l * 32 * 1024, nunits, 1024, 0};
                pg8::EpiMoe2 E{YSb, lds, FP8_M2 ? 1.0f / 64.0f : 1.0f};
                if (FP8_M2) { pg8::Gemm g{ws + WS_ACT8, ws + WS_W2T8 + (size_t)l * 32 * 1024 * 1024, 1024, 1024, 1024, 121};
                    pg8::gemm_phase<true>(lds, g, S, E, wave0); }
                else { pg8::Gemm g{ACTb, (const bf16_t*)(ws + WS_W2T) + (size_t)l * 32 * 1024 * 1024, 1024, 1024, 1024, 127};
                    pg8::gemm_phase<false>(lds, g, S, E, wave0); }
                SEAM(P + 10);
            }
        ln_phase<L, 1>(lo, hi, G, bar, wave0);
}

__global__ void __launch_bounds__(512, 2) fwd_kernel(Args args) {
    extern __shared__ __attribute__((aligned(16))) unsigned char lds_raw[];
    LAS unsigned char* const lds = (LAS unsigned char*)lds_raw;
    volatile LAS unsigned* const LCTL = (volatile LAS unsigned*)(lds + LDSCTL_OFF);
    const int G = gridDim.x;
    int lo, hi; unsigned* ctl0;
    { kptr_t kp = (kptr_t)__builtin_amdgcn_kernarg_segment_ptr(); lo = *(const __attribute__((address_space(4))) int*)(kp + 272); hi = *(const __attribute__((address_space(4))) int*)(kp + 276);
      ctl0 = (unsigned*)(*(unsigned char* const __attribute__((address_space(4)))*)(kp + 264) + WS_CTL); }
    const int wave0 = __builtin_amdgcn_readfirstlane((int)threadIdx.x >> 6);
    for (int u = threadIdx.x; u < (LDS_BYTES - LDSCTL_OFF) / 4; u += 512) LCTL[u] = 0u;
    __syncthreads();
    XcdBarrier bar; bar.bar = ctl0 + CW_BAR; bar.x = 0; bar.st = LCTL; bar.wv = wave0;
    if (hi - lo > 1) bar = xcd_barrier_post(ctl0 + CW_BAR, LCTL, wave0);
    if (PHEN(0) && IN(PH_CONV)) {
            PH_LOCALS;
        {
            LAS float* cact = (LAS float*)lds;
            LAS float* part = (LAS float*)(lds + 65536);
            if (bx < 384) {
                for (int i = tid; i < 16 * 1024; i += 512) { const float c = kin(I_C)[i]; cact[i] = c / (1.0f + __expf(-c)); }
                __syncthreads();
                for (int it = bx; it < 384; it += G) {
                    const int ls = it / 48, col0 = (it % 48) * 64;
                    const int kq = tid >> 6, cl = tid & 63;
                    const float* wp = kin(I_MODW) + (size_t)ls * 1024 * 3072 + col0 + cl;
                    float a[16];
#pragma unroll
                    for (int b = 0; b < 16; ++b) a[b] = 0.f;
#pragma unroll 4
                    for (int k = kq * 128; k < kq * 128 + 128; ++k) {
                        const float w = wp[(size_t)k * 3072];
#pragma unroll
                        for (int b = 0; b < 16; ++b) a[b] += cact[b * 1024 + k] * w;
                    }
#pragma unroll
                    for (int b = 0; b < 16; ++b) part[(kq * 16 + b) * 64 + cl] = a[b];
                    __syncthreads();
                    for (int o = tid; o < 1024; o += 512) {
                        const int b = o >> 6, c2 = o & 63; float s = 0.f;
#pragma unroll
                        for (int q = 0; q < 8; ++q) s += part[(q * 16 + b) * 64 + c2];
                        MOD[((size_t)ls * 16 + b) * 3072 + col0 + c2] = s + kin(I_MODB)[ls * 3072 + col0 + c2];
                    }
                    __syncthreads();
                }
            }
        }
        {
            constexpr int IT_ABIN = 2 * (FP8_INP_EVEN ? 8 : 16) * 48, IT_ABOUT = 2 * (FP8_OUTP ? 8 : 16) * 32, IT_SGIN = 2 * (FP8_INP_ODD ? 8 : 16) * 64, IT_SGOUT = 2 * (FP8_OUTP ? 8 : 16) * 32, IT_W1 = 128 * (FP8_M1 ? 8 : 16) * 64, IT_W2 = 128 * (FP8_M2 ? 8 : 16) * 32;
            constexpr int IT_ALL = IT_ABIN + IT_ABOUT + IT_SGIN + IT_SGOUT + IT_W1 + IT_W2;
            for (int it = gw; it < IT_ALL; it += NGW) {
                int r = it;
                if (r < IT_ABIN) { if (FP8_INP_EVEN) { const int mat = r / (8 * 48); conv_item_f8<false>(kin(I_ABWIN) + (size_t)mat * 1024 * 1536, 1536, ws + WS_ABIN + (size_t)mat * 1536 * 1024, r % (8 * 48), lane, 32.0f); }
                    else { const int mat = r / (16 * 48); conv_item<false>(kin(I_ABWIN) + (size_t)mat * 1024 * 1536, 1536, (bf16_t*)(ws + WS_ABIN) + (size_t)mat * 1536 * 1024, r % (16 * 48), lane); } continue; } r -= IT_ABIN;
                if (r < IT_ABOUT) { if (FP8_OUTP) { const int mat = r / (8 * 32); conv_item_f8<false>(kin(I_ABWOUT) + (size_t)mat * 1024 * 1024, 1024, ws + WS_ABOUT + (size_t)mat * 1024 * 1024, r % (8 * 32), lane, 64.0f); }
                    else { const int mat = r / (16 * 32); conv_item<false>(kin(I_ABWOUT) + (size_t)mat * 1024 * 1024, 1024, (bf16_t*)(ws + WS_ABOUT) + (size_t)mat * 1024 * 1024, r % (16 * 32), lane); } continue; } r -= IT_ABOUT;
                if (r < IT_SGIN) { if (FP8_INP_ODD) { const int mat = r / (8 * 64); conv_item_f8<false>(kin(I_SGWIN) + (size_t)mat * 1024 * 2048, 2048, ws + WS_SGIN + (size_t)mat * 2048 * 1024, r % (8 * 64), lane, 32.0f); }
                    else { const int mat = r / (16 * 64); conv_item<false>(kin(I_SGWIN) + (size_t)mat * 1024 * 2048, 2048, (bf16_t*)(ws + WS_SGIN) + (size_t)mat * 2048 * 1024, r % (16 * 64), lane); } continue; } r -= IT_SGIN;
                if (r < IT_SGOUT) { if (FP8_OUTP) { const int mat = r / (8 * 32); conv_item_f8<false>(kin(I_SGWOUT) + (size_t)mat * 1024 * 1024, 1024, ws + WS_SGOUT + (size_t)mat * 1024 * 1024, r % (8 * 32), lane, 64.0f); }
                    else { const int mat = r / (16 * 32); conv_item<false>(kin(I_SGWOUT) + (size_t)mat * 1024 * 1024, 1024, (bf16_t*)(ws + WS_SGOUT) + (size_t)mat * 1024 * 1024, r % (16 * 32), lane); } continue; } r -= IT_SGOUT;
                if (r < IT_W1) {
                    if (FP8_M1) { const int mat = r / (8 * 64); conv_item_f8<true>(kin(I_W1) + (size_t)mat * 1024 * 2048, 2048, ws + WS_W1T8 + (size_t)mat * 2048 * 1024, r % (8 * 64), lane, 32.0f); }
                    else { const int mat = r / (16 * 64); conv_item<true>(kin(I_W1) + (size_t)mat * 1024 * 2048, 2048, (bf16_t*)(ws + WS_W1T) + (size_t)mat * 2048 * 1024, r % (16 * 64), lane); }
                    continue; } r -= IT_W1;
                if (FP8_M2) { const int mat = r / (8 * 32); conv_item_f8<false>(kin(I_W2) + (size_t)mat * 1024 * 1024, 1024, ws + WS_W2T8 + (size_t)mat * 1024 * 1024, r % (8 * 32), lane, 64.0f); }
                else { const int mat = r / (16 * 32); conv_item<false>(kin(I_W2) + (size_t)mat * 1024 * 1024, 1024, (bf16_t*)(ws + WS_W2T) + (size_t)mat * 1024 * 1024, r % (16 * 32), lane); }
            }
        }
        {
            const int gt = vcu * 512 + tid, NGT = G * 512;
            bf16_t* BR = (bf16_t*)(ws + WS_BR);
            if (!ROUTER_X) for (int i = gt; i < 4 * 256 * 1024; i += NGT) {
                const int l = i >> 18, n = (i >> 10) & 255, k = i & 1023; unsigned v = 0;
                if (n < 64) { const float w = kin(I_RW)[((size_t)l * 1024 + k) * 32 + (n & 31)]; const unsigned h = f2bf(w); v = h;
                    if (n >= 32) v = f2bf(w - __builtin_bit_cast(float, h << 16)); }
                BR[i] = (bf16_t)v;
            }
            bf16_t* BP = (bf16_t*)(ws + WS_BPOOL);
            for (int i = gt; i < 2 * 512 * 512; i += NGT) {
                const int j = i >> 18, n = (i >> 9) & 511, k = i & 511; unsigned v = 0;
                if ((n >> 7) == (k >> 7)) v = f2bf(kin(I_POOLW)[(((size_t)j * 4 + (n >> 7)) * 128 + (k & 127)) * 128 + (n & 127)]);
                BP[i] = (bf16_t)v;
            }
            bf16_t* BG = (bf16_t*)(ws + WS_BGATE);
            for (int i = gt; i < 2 * 1024 * 512; i += NGT) {
                const int j = i >> 19, n = (i >> 9) & 1023, k = i & 511; unsigned v = 0; const int nn = n & 511;
                if ((nn >> 6) == (k >> 6)) { const float* w = (n < 512) ? kin(I_WA) : kin(I_WX); v = f2bf(w[(((size_t)j * 8 + (nn >> 6)) * 64 + (k & 63)) * 64 + (nn & 63)]); }
                BG[i] = (bf16_t)v;
            }
            bf16_t* WSMp = (bf16_t*)(ws + WS_WSM);
            for (int i = gt; i < 2 * 8 * 128 * 128; i += NGT) {
                const int t = (i >> 7) & 127, s = i & 127; WSMp[i] = (bf16_t)((s <= t) ? f2bf(kin(I_SGWS)[i]) : 0u);
            }
            float* BRI = (float*)(ws + WS_BIASRI);
            for (int i = gt; i < 2 * 1024; i += NGT) { const int j = i >> 10, n = i & 1023; BRI[i] = (n < 512) ? kin(I_BA)[j * 512 + n] : kin(I_BX)[j * 512 + n - 512]; }
            float* B1P = (float*)(ws + WS_B1P);
            for (int i = gt; i < 4 * 32 * 2048; i += NGT) { const int le = i >> 11, rho = i & 2047; B1P[i] = kin(I_B1)[(size_t)le * 2048 + w1_n_of_rho(rho)]; }
        }
        SEAM(PH_CONV);
    }

    if (PHEN(1) && IN(PH_H0)) {
            PH_LOCALS;
        const int rows_per = T / NGW, r0 = gw * rows_per;
        const int b = r0 / SEQ;
        const float* shp = MOD + ((size_t)0 * 16 + b) * 3072, * scp = shp + 1024;
        f32x4 sh[4], sc[4];
#pragma unroll
        for (int j = 0; j < 4; ++j) { sh[j] = *(const f32x4*)(shp + 4 * (64 * j + lane)); sc[j] = *(const f32x4*)(scp + 4 * (64 * j + lane)); }
        for (int r = r0; r < r0 + rows_per; ++r) {
            const f32x4* xr = (const f32x4*)(kin(I_X) + (size_t)r * D) + lane;
            u32x2* hr = (u32x2*)(Hb + (size_t)r * D) + lane;
#pragma unroll
            for (int j = 0; j < 4; ++j) { const f32x4 v = xr[64 * j]; const f32x4 h = v * (sc[j] + 1.0f) + sh[j];
                if (FP8_INP_EVEN) ((unsigned*)(ws + WS_H8 + (size_t)r * D) + lane)[64 * j] = pk4_fp8(h[0], h[1], h[2], h[3]);
                else { u32x2 w; w.x = pk2(h[0], h[1]); w.y = pk2(h[2], h[3]); hr[64 * j] = w; } }
        }
        if (ROUTER_X) {
            bf16_t* BRB = (bf16_t*)(ws + WS_BRB);
            const float* rwp = kin(I_RW);
            for (int i = vcu * 512 + tid; i < 4 * 32 * 1024; i += G * 512) {
                const int l = i >> 15, e = (i >> 10) & 31, k = i & 1023;
                const float w = rwp[((size_t)l * 1024 + k) * 32 + e];
#pragma unroll 4
                for (int bq = 0; bq < 16; ++bq) {
                    const float wm = w * (1.0f + MOD[((size_t)(2 * l + 1) * 16 + bq) * 3072 + 1024 + k]);
                    const unsigned h = f2bf(wm), lo2 = f2bf(wm - __builtin_bit_cast(float, h << 16));
                    bf16_t* o = BRB + (((size_t)l * 16 + bq) * 64 + e) * 1024 + k; o[0] = (bf16_t)h; o[32 * 1024] = (bf16_t)lo2; }
            }
            for (int i = vcu * 512 + tid; i < 192 * 1024 / 2; i += G * 512) ((unsigned*)(BRB + (size_t)4 * 16 * 64 * 1024))[i] = 0u;
            const int it = vcu + G * wave;
            if (it < 512) {
                const int l = it >> 7, bq = (it >> 3) & 15, eq = it & 7;
                const float* shq = MOD + ((size_t)(2 * l + 1) * 16 + bq) * 3072;
                const f32x4* rw4 = (const f32x4*)(kin(I_RW) + (size_t)l * 1024 * 32) + eq;
                float sa[4] = {0.f, 0.f, 0.f, 0.f};
#pragma unroll
                for (int i2 = 0; i2 < 16; ++i2) { const int k = lane + 64 * i2; const f32x4 wv4 = rw4[(size_t)k * 8]; const float sk = shq[k]; sa[0] += wv4[0] * sk; sa[1] += wv4[1] * sk; sa[2] += wv4[2] * sk; sa[3] += wv4[3] * sk; }
#pragma unroll
                for (int o = 1; o < 64; o <<= 1) {
#pragma unroll
                    for (int c4 = 0; c4 < 4; ++c4) sa[c4] += __builtin_bit_cast(float, __builtin_amdgcn_ds_bpermute((lane ^ o) << 2, __builtin_bit_cast(int, sa[c4])));
                }
                const f32x4 rb4 = *(const f32x4*)(kin(I_RB) + l * 32 + 4 * eq);
                *(f32x4*)((float*)(ws + WS_CB) + (l * 16 + bq) * 32 + 4 * eq) = (f32x4){sa[0] + rb4[0], sa[1] + rb4[1], sa[2] + rb4[2], sa[3] + rb4[3]};
            }
        }
        SEAM(PH_H0);
    }

    layer_body<0>(lds, LCTL, lo, hi, G, bar, wave0); layer_body<1>(lds, LCTL, lo, hi, G, bar, wave0); layer_body<2>(lds, LCTL, lo, hi, G, bar, wave0); layer_body<3>(lds, LCTL, lo, hi, G, bar, wave0);
}
#undef IN
#undef SEAM

#ifdef DUMP_SPEC
struct DumpSrc { size_t off; int ld; int col0; };
__global__ void dump_kernel(const unsigned char* ws, float* out) {
    const DumpSrc srcs[8] = DUMP_SPEC;
    const size_t i = (size_t)blockIdx.x * blockDim.x + threadIdx.x;
    const int r = (int)(i >> 10), c = (int)(i & 1023), blk = c >> 7, cc = c & 127;
    const DumpSrc d = srcs[blk];
    const bf16_t* p = (const bf16_t*)(ws + d.off);
    out[i] = bf2f(p[(size_t)r * d.ld + d.col0 + cc]);
}
#endif
extern "C" void kernel_launch(void* const* d_in, const int* in_sizes, int n_in, void* d_out, int out_size, void* d_ws, size_t ws_size, hipStream_t stream) {
    static int grid = 0;
    if (grid == 0) {
        if (n_in != 32 || out_size != T * D || ws_size < WS_END) { fprintf(stderr, "kernel_launch: unexpected problem (n_in %d, out %d, ws %zu)\n", n_in, out_size, ws_size); grid = -1; return; }
        int dev = 0, cus = 0, per_cu = 0;
        if (hipGetDevice(&dev) != hipSuccess || hipDeviceGetAttribute(&cus, hipDeviceAttributeMultiprocessorCount, dev) != hipSuccess) { grid = -1; return; }
        if (hipFuncSetAttribute((const void*)fwd_kernel, hipFuncAttributeMaxDynamicSharedMemorySize, LDS_BYTES) != hipSuccess) { fprintf(stderr, "kernel_launch: hipFuncSetAttribute failed\n"); grid = -1; return; }
        if (hipOccupancyMaxActiveBlocksPerMultiprocessor(&per_cu, (const void*)fwd_kernel, 512, LDS_BYTES) != hipSuccess || per_cu < 1) fprintf(stderr, "kernel_launch: occupancy query says %d\n", per_cu);
        (void)hipGetLastError();
        grid = cus;
        if (grid * 8 > T || (T % (grid * 8)) != 0) { fprintf(stderr, "kernel_launch: grid %d does not divide the rows\n", grid); grid = -1; return; }
    }
    if (grid < 0) return;
    (void)hipMemsetAsync((char*)d_ws + WS_CTL, 0, CTL_ZERO_BYTES, stream);
    Args a{};
    for (int i = 0; i < 32; ++i) a.in[i] = (const float*)d_in[i];
    a.out = (float*)d_out; a.ws = (unsigned char*)d_ws;
#if MK_ONE_LAUNCH
    a.ph_lo = 0; a.ph_hi = NPH;
    hipLaunchKernelGGL(fwd_kernel, dim3(grid), dim3(512), LDS_BYTES, stream, a);
#else
#ifndef STOP_PH
#define STOP_PH NPH
#endif
    for (int ph = 0; ph < STOP_PH; ++ph) {
        if (!phase_exists(ph)) continue;
        a.ph_lo = ph; a.ph_hi = ph + 1;
        hipLaunchKernelGGL(fwd_kernel, dim3(grid), dim3(512), LDS_BYTES, stream, a);
#ifdef REP_SLOTS
        { const int slot = ph < PH_L0 ? ph : 2 + (ph - PH_L0) % PH_PER_LAYER; if ((REP_SLOTS >> slot) & 1) {
#ifdef PROBE_VARIANTS
            a.variant = PROBE_VARIANTS;
#endif
            hipLaunchKernelGGL(fwd_kernel, dim3(grid), dim3(512), LDS_BYTES, stream, a); a.variant = 0; } }
#endif
    }
#ifdef DUMP_SPEC
    hipLaunchKernelGGL(dump_kernel, dim3(T * 1024 / 256), dim3(256), 0, stream, (const unsigned char*)d_ws, (float*)d_out);
#endif
#endif
}
```
